# Optimizing an MI355X kernel written in HIP

```python
import math
import jax
import jax.numpy as jnp
from jax import lax
import numpy as np

D_MODEL = 2048
BATCH = 4
SEQ = 4096
DEPTH = 4

CTX_LEN = 256
GRID_W = 64

MLA_HEADS = 8
MLA_Q_RANK = 512
MLA_KV_RANK = 512
MLA_NOPE = 128
MLA_ROPE = 64
MLA_V = 128
MLA_WIDTH = MLA_HEADS * MLA_V
ROPE_THETA = 10000.0
Q_BLOCK = 128
ATTN_SCALE = (MLA_NOPE + MLA_ROPE) ** -0.5

RWKV_HEADS = 8
RWKV_HEAD = 64
RWKV_WIDTH = RWKV_HEADS * RWKV_HEAD
RWKV_LORA_W = 32
RWKV_LORA_A = 32
RWKV_LORA_G = 96
RWKV_GN_EPS = 64e-5
RWKV_SPLITS = (RWKV_WIDTH, RWKV_WIDTH, RWKV_WIDTH, 2 * RWKV_LORA_W, 2 * RWKV_LORA_A, RWKV_LORA_G)
RWKV_COLS = 3 * RWKV_WIDTH + 2 * RWKV_LORA_W + 2 * RWKV_LORA_A + RWKV_LORA_G

GDN_HEADS = 4
GDN_HEAD = 128
GDN_WIDTH = GDN_HEADS * GDN_HEAD
GDN_CONV = 5
GDN_CHUNK = 64
GDN_SPLITS = (3 * GDN_WIDTH, GDN_WIDTH, 2 * GDN_HEADS, 2 * GDN_HEADS)
GDN_COLS = 4 * GDN_WIDTH + 4 * GDN_HEADS

IN_SPLITS = (MLA_Q_RANK, MLA_KV_RANK, MLA_ROPE, RWKV_COLS, GDN_COLS)
IN_COLS = MLA_Q_RANK + MLA_KV_RANK + MLA_ROPE + RWKV_COLS + GDN_COLS
D_MIX = MLA_WIDTH + RWKV_WIDTH + GDN_WIDTH

D_FF = -(-(8 * D_MODEL) // (3 * 256)) * 256

kernel_name = 'hybrid_mla_rwkv7_gdn_dit_trunk'


def _split(x, sizes):
    return jnp.split(x, [int(s) for s in np.cumsum(sizes)[:-1]], axis=-1)


def _heads(t, n_heads):
    return t.reshape(t.shape[:-1] + (n_heads, t.shape[-1] // n_heads))


def _layer_norm(x, g, b, eps=1e-5):
    xf = x.astype(jnp.float32)
    mu = jnp.mean(xf, -1, keepdims=True)
    var = jnp.mean(jnp.square(xf - mu), -1, keepdims=True)
    return ((xf - mu) * lax.rsqrt(var + eps) * g + b).astype(x.dtype)


def _rms_norm(x, g, eps=1e-6):
    xf = x.astype(jnp.float32)
    return (xf * lax.rsqrt(jnp.mean(jnp.square(xf), -1, keepdims=True) + eps) * g).astype(x.dtype)


def _l2norm(x):
    return x * lax.rsqrt(jnp.sum(x * x, -1, keepdims=True) + 1e-12)


def _modulation(cvec, w_mod, b_mod):
    return jnp.split(jax.nn.silu(cvec) @ w_mod + b_mod, 6, axis=-1)


def _modulate(x, shift, scale):
    return x * (1.0 + scale) + shift


def _swiglu(h, w_gate, w_up, w_down):
    return (jax.nn.silu(h @ w_gate) * (h @ w_up)) @ w_down


def _axial_rope_table(n_tok):
    rows = n_tok // GRID_W
    row = jnp.repeat(jnp.arange(rows), GRID_W)
    col = jnp.tile(jnp.arange(GRID_W), rows)
    pos = jnp.stack([row, col], axis=-1).astype(jnp.float32)
    n_freq = MLA_ROPE // 4
    inv = ROPE_THETA ** (-jnp.arange(n_freq, dtype=jnp.float32) / n_freq)
    ang = pos[..., None] * inv
    return jnp.cos(ang), jnp.sin(ang)


def _apply_axial_rope(x, cos, sin):
    shp = x.shape
    xr = x.reshape(shp[:-1] + (2, 2, MLA_ROPE // 4))
    x1, x2 = xr[..., 0, :], xr[..., 1, :]
    out = jnp.stack([x1 * cos - x2 * sin, x1 * sin + x2 * cos], axis=-2)
    return out.reshape(shp).astype(x.dtype)


def _mla_q(cq, q_norm, w_uq, cos, sin):
    q = _heads(_rms_norm(cq, q_norm) @ w_uq, MLA_HEADS)
    q_nope, q_rot = q[..., :MLA_NOPE], q[..., MLA_NOPE:]
    if cos is not None:
        q_rot = _apply_axial_rope(q_rot, cos[:, None], sin[:, None])
    return jnp.concatenate([q_nope, q_rot], axis=-1)


def _mla_kv(ckv, kr, kv_norm, w_ukv, cos, sin):
    kv = _heads(_rms_norm(ckv, kv_norm) @ w_ukv, MLA_HEADS)
    k_nope, v = kv[..., :MLA_NOPE], kv[..., MLA_NOPE:]
    if cos is not None:
        kr = _apply_axial_rope(kr, cos, sin)
    k_rot = jnp.broadcast_to(kr[:, :, None, :], k_nope.shape[:-1] + (MLA_ROPE,)).astype(k_nope.dtype)
    return jnp.concatenate([k_nope, k_rot], axis=-1), v


def _attend(q, k, v):
    s = jnp.einsum('bqhd,bkhd->bhqk', q, k, preferred_element_type=jnp.float32) * ATTN_SCALE
    p = jax.nn.softmax(s, axis=-1).astype(v.dtype)
    return jnp.einsum('bhqk,bkhd->bqhd', p, v)


def _mla_latent_attention(q, k_all, v_all):
    B, T = q.shape[:2]
    qb = jnp.moveaxis(q.reshape(B, T // Q_BLOCK, Q_BLOCK, MLA_HEADS, q.shape[-1]), 1, 0)
    o = lax.map(lambda qi: _attend(qi, k_all, v_all), qb)
    return jnp.moveaxis(o, 0, 1).reshape(B, T, MLA_WIDTH)


def _bidirectional(run_dir, prep_ctx, prep_lat, s0):
    y_lat, y_ctx = [], []
    for d, reverse in ((0, False), (1, True)):
        yc, s_ctx = run_dir(prep_ctx, d, s0, reverse)
        yl, _ = run_dir(prep_lat, d, s_ctx, reverse)
        y_lat.append(yl)
        y_ctx.append(yc)
    return y_lat[0] + y_lat[1], y_ctx[0] + y_ctx[1]


def _bidir_shift(p):
    z = jnp.zeros_like(p[:, :1])
    return 0.5 * (jnp.concatenate([z, p[:, :-1]], axis=1) + jnp.concatenate([p[:, 1:], z], axis=1))


def _rwkv7_prep(p, mu, w0, w2, a0, a2, k_k, k_a):
    B, T = p.shape[:2]
    p = p + (_bidir_shift(p) - p) * mu
    r, k, v, wd, ad, gd = _split(p, RWKV_SPLITS)
    r, k, v = r.astype(jnp.float32), k.astype(jnp.float32), v.astype(jnp.float32)
    wd = wd.reshape(B, T, 2, RWKV_LORA_W).astype(jnp.float32)
    ad = ad.reshape(B, T, 2, RWKV_LORA_A).astype(jnp.float32)
    w_log = -jax.nn.softplus(-(w0 + jnp.einsum('btdr,drc->btdc', jnp.tanh(wd), w2))) - 0.5
    decay = jnp.exp(-jnp.exp(w_log))
    a_lr = jax.nn.sigmoid(a0 + jnp.einsum('btdr,drc->btdc', ad, a2))
    kk = _l2norm(_heads(k * k_k, RWKV_HEADS))
    k_dir = k[:, :, None, :] * (1.0 + (a_lr - 1.0) * k_a)
    return r, v, kk, decay, a_lr, k_dir, gd


def _wkv7_scan(s0, r, w, k, v, a, b):
    xs = tuple(jnp.moveaxis(t, 1, 0) for t in (r, w, k, v, a, b))

    def step(S, inp):
        r_t, w_t, k_t, v_t, a_t, b_t = inp
        sa = jnp.einsum('bhvk,bhk->bhv', S, a_t)
        S = S * w_t[:, :, None, :] + sa[..., None] * b_t[:, :, None, :] + v_t[..., None] * k_t[:, :, None, :]
        return S, jnp.einsum('bhvk,bhk->bhv', S, r_t)

    S, ys = lax.scan(step, s0, xs)
    return jnp.moveaxis(ys, 0, 1), S


def _rwkv7_dir(prep, d, s0, reverse):
    r, v, kk, decay, a_lr, k_dir, _ = prep
    hd = lambda t: _heads(t, RWKV_HEADS)
    seqs = (hd(r), hd(decay[:, :, d]), hd(k_dir[:, :, d]), hd(v), -kk, kk * hd(a_lr[:, :, d]))
    if reverse:
        seqs = tuple(jnp.flip(t, axis=1) for t in seqs)
    y, s = _wkv7_scan(s0, *seqs)
    if reverse:
        y = jnp.flip(y, axis=1)
    return y, s


def _rwkv7_out(prep, y, r_k, g2, gn_g, gn_b):
    r, v, kk, decay, a_lr, k_dir, gd = prep
    B, T = r.shape[:2]
    mu = jnp.mean(y, -1, keepdims=True)
    var = jnp.mean(jnp.square(y - mu), -1, keepdims=True)
    y = ((y - mu) * lax.rsqrt(var + RWKV_GN_EPS)).reshape(B, T, RWKV_WIDTH) * gn_g + gn_b
    bonus = jnp.einsum('bthn,btdhn,hn->bth', _heads(r, RWKV_HEADS),
                       k_dir.reshape(B, T, 2, RWKV_HEADS, RWKV_HEAD), r_k)[..., None] * _heads(v, RWKV_HEADS)
    g = jax.nn.sigmoid(gd) @ g2
    return (y + bonus.reshape(B, T, RWKV_WIDTH)) * g


def _dwconv_centred(x, w):
    ch = x.shape[-1]
    return lax.conv_general_dilated(x, w.astype(x.dtype)[:, None, :], window_strides=(1,),
                                    padding=[(GDN_CONV // 2, GDN_CONV // 2)],
                                    dimension_numbers=('NWC', 'WIO', 'NWC'), feature_group_count=ch)


def _gdn_prep(p, conv_w, a_log, dt_bias):
    B, T = p.shape[:2]
    qkv, z, a_raw, b_raw = _split(p, GDN_SPLITS)
    qkv = jax.nn.silu(_dwconv_centred(qkv, conv_w))
    q, k, v = jnp.split(qkv.astype(jnp.float32), 3, axis=-1)
    q = _l2norm(_heads(q, GDN_HEADS))
    k = _l2norm(_heads(k, GDN_HEADS))
    v = _heads(v, GDN_HEADS)
    a_raw = a_raw.reshape(B, T, 2, GDN_HEADS).astype(jnp.float32)
    g = -jnp.exp(a_log) * jax.nn.softplus(a_raw + dt_bias)
    beta = jax.nn.sigmoid(b_raw.reshape(B, T, 2, GDN_HEADS).astype(jnp.float32))
    return q, k, v, g, beta, z


def _gated_delta_chunked(s0, q, k, v, g, beta):
    B, T, H, DK = q.shape
    DV = v.shape[-1]
    n = T // GDN_CHUNK

    def to_chunks(t):
        return jnp.moveaxis(t.reshape((B, n, GDN_CHUNK, H) + t.shape[3:]), 3, 1)

    q = to_chunks(q * DK ** -0.5)
    k = to_chunks(k)
    v = to_chunks(v)
    g = jnp.cumsum(to_chunks(g), axis=-1)
    beta = to_chunks(beta)
    idx = jnp.arange(GDN_CHUNK)
    incl = idx[:, None] >= idx[None, :]
    strict = idx[:, None] > idx[None, :]
    decay = jnp.exp(jnp.where(incl, g[..., :, None] - g[..., None, :], -jnp.inf))
    kb = k * beta[..., None]
    m = jnp.where(strict, jnp.einsum('bhnid,bhnjd->bhnij', kb, k) * decay, 0.0)
    eye = jnp.eye(GDN_CHUNK, dtype=m.dtype)
    rhs = jnp.concatenate([v * beta[..., None], kb * jnp.exp(g)[..., None]], axis=-1)
    sol = lax.linalg.triangular_solve(m + eye, rhs, left_side=True, lower=True, unit_diagonal=True)
    u, w = sol[..., :DV], sol[..., DV:]
    a_intra = jnp.where(incl, jnp.einsum('bhnid,bhnjd->bhnij', q, k) * decay, 0.0)
    xs = tuple(jnp.moveaxis(t, 2, 0) for t in (q, k, u, w, g, a_intra))

    def step(S, inp):
        q_i, k_i, u_i, w_i, g_i, a_i = inp
        v_new = u_i - jnp.einsum('bhck,bhkv->bhcv', w_i, S)
        o = (jnp.einsum('bhck,bhkv->bhcv', q_i * jnp.exp(g_i)[..., None], S)
             + jnp.einsum('bhij,bhjv->bhiv', a_i, v_new))
        g_end = g_i[..., -1:]
        S = S * jnp.exp(g_end)[..., None] + jnp.einsum(
            'bhck,bhcv->bhkv', k_i * jnp.exp(g_end - g_i)[..., None], v_new)
        return S, o

    S, o = lax.scan(step, s0, xs)
    o = jnp.moveaxis(o, 0, 2).reshape(B, H, T, DV)
    return jnp.moveaxis(o, 1, 2), S


def _gdn_dir(prep, d, s0, reverse):
    q, k, v, g, beta, _ = prep
    seqs = (q, k, v, g[:, :, d], beta[:, :, d])
    if reverse:
        seqs = tuple(jnp.flip(t, axis=1) for t in seqs)
    o, s = _gated_delta_chunked(s0, *seqs)
    if reverse:
        o = jnp.flip(o, axis=1)
    return o, s


def _gdn_out(prep, o, norm_g):
    z = prep[5]
    B, T = o.shape[:2]
    o = _rms_norm(o, norm_g) * jax.nn.silu(_heads(z.astype(jnp.float32), GDN_HEADS))
    return o.reshape(B, T, GDN_WIDTH)


def _token_mixers(p_lat, p_ctx, cos, sin, mla_q_norm, mla_kv_norm, mla_w_uq, mla_w_ukv,
                  rwkv_mu, rwkv_w0, rwkv_w2, rwkv_a0, rwkv_a2, rwkv_g2, rwkv_k_k, rwkv_k_a, rwkv_r_k,
                  rwkv_gn_g, rwkv_gn_b, gdn_conv, gdn_a_log, gdn_dt_bias, gdn_norm, ctx_out):
    B, n_ctx = p_ctx.shape[:2]
    cq_l, ckv_l, kr_l, pr_l, pg_l = _split(p_lat, IN_SPLITS)
    cq_c, ckv_c, kr_c, pr_c, pg_c = _split(p_ctx, IN_SPLITS)

    k_c, v_c = _mla_kv(ckv_c, kr_c, mla_kv_norm, mla_w_ukv, None, None)
    k_l, v_l = _mla_kv(ckv_l, kr_l, mla_kv_norm, mla_w_ukv, cos, sin)
    q_l = _mla_q(cq_l, mla_q_norm, mla_w_uq, cos, sin)
    a_lat = _mla_latent_attention(q_l, jnp.concatenate([k_c, k_l], axis=1), jnp.concatenate([v_c, v_l], axis=1))

    prep_rc = _rwkv7_prep(pr_c, rwkv_mu, rwkv_w0, rwkv_w2, rwkv_a0, rwkv_a2, rwkv_k_k, rwkv_k_a)
    prep_rl = _rwkv7_prep(pr_l, rwkv_mu, rwkv_w0, rwkv_w2, rwkv_a0, rwkv_a2, rwkv_k_k, rwkv_k_a)
    s0_r = jnp.zeros((B, RWKV_HEADS, RWKV_HEAD, RWKV_HEAD), jnp.float32)
    y_rl, y_rc = _bidirectional(_rwkv7_dir, prep_rc, prep_rl, s0_r)
    b_lat = _rwkv7_out(prep_rl, y_rl, rwkv_r_k, rwkv_g2, rwkv_gn_g, rwkv_gn_b)

    prep_gc = _gdn_prep(pg_c, gdn_conv, gdn_a_log, gdn_dt_bias)
    prep_gl = _gdn_prep(pg_l, gdn_conv, gdn_a_log, gdn_dt_bias)
    s0_g = jnp.zeros((B, GDN_HEADS, GDN_HEAD, GDN_HEAD), jnp.float32)
    o_gl, o_gc = _bidirectional(_gdn_dir, prep_gc, prep_gl, s0_g)
    c_lat = _gdn_out(prep_gl, o_gl, gdn_norm)

    dt = p_lat.dtype
    mix_lat = jnp.concatenate([a_lat.astype(dt), b_lat.astype(dt), c_lat.astype(dt)], axis=-1)
    if not ctx_out:
        return mix_lat, None
    q_c = _mla_q(cq_c, mla_q_norm, mla_w_uq, None, None)
    a_ctx = _attend(q_c, k_c, v_c).reshape(B, n_ctx, MLA_WIDTH)
    b_ctx = _rwkv7_out(prep_rc, y_rc, rwkv_r_k, rwkv_g2, rwkv_gn_g, rwkv_gn_b)
    c_ctx_out = _gdn_out(prep_gc, o_gc, gdn_norm)
    mix_ctx = jnp.concatenate([a_ctx.astype(dt), b_ctx.astype(dt), c_ctx_out.astype(dt)], axis=-1)
    return mix_lat, mix_ctx


def setup_inputs(seed: int = 0) -> dict:
    key = jax.random.key(seed)
    keys = jax.random.split(key, 40)
    counter = [0]

    def nk():
        counter[0] += 1
        return keys[counter[0] - 1]

    def nrm(shape, std):
        return std * jax.random.normal(nk(), shape, jnp.float32)

    L, D = DEPTH, D_MODEL
    beta_init = (8.0 * DEPTH) ** -0.25
    inp = {}
    inp['x'] = nrm((BATCH, SEQ, D), 1.0)
    inp['c'] = nrm((BATCH, D), 1.0)
    inp['ctx'] = nrm((BATCH, CTX_LEN, D), 1.0)
    inp['c_ctx'] = nrm((D,), 1.0)
    inp['w_mod'] = nrm((L, D, 6 * D), 0.5 * D ** -0.5)
    inp['b_mod'] = nrm((L, 6 * D), 0.02)
    inp['w_in'] = nrm((L, D, IN_COLS), D ** -0.5)
    inp['mla_q_norm'] = 1.0 + nrm((L, MLA_Q_RANK), 0.02)
    inp['mla_kv_norm'] = 1.0 + nrm((L, MLA_KV_RANK), 0.02)
    inp['mla_w_uq'] = nrm((L, MLA_Q_RANK, MLA_HEADS * (MLA_NOPE + MLA_ROPE)), MLA_Q_RANK ** -0.5)
    inp['mla_w_ukv'] = nrm((L, MLA_KV_RANK, MLA_HEADS * (MLA_NOPE + MLA_V)), MLA_KV_RANK ** -0.5)
    inp['rwkv_mu'] = jax.random.uniform(nk(), (L, RWKV_COLS), jnp.float32)
    inp['rwkv_w0'] = jax.random.uniform(nk(), (L, 2, RWKV_WIDTH), jnp.float32, -6.0, -1.0)
    inp['rwkv_w2'] = nrm((L, 2, RWKV_LORA_W, RWKV_WIDTH), 0.1 * RWKV_LORA_W ** -0.5)
    inp['rwkv_a0'] = nrm((L, 2, RWKV_WIDTH), 0.1)
    inp['rwkv_a2'] = nrm((L, 2, RWKV_LORA_A, RWKV_WIDTH), RWKV_LORA_A ** -0.5)
    inp['rwkv_g2'] = nrm((L, RWKV_LORA_G, RWKV_WIDTH), RWKV_LORA_G ** -0.5)
    inp['rwkv_k_k'] = 0.85 + nrm((L, RWKV_WIDTH), 0.02)
    inp['rwkv_k_a'] = 1.0 + nrm((L, RWKV_WIDTH), 0.02)
    inp['rwkv_r_k'] = nrm((L, RWKV_HEADS, RWKV_HEAD), 0.1)
    inp['rwkv_gn_g'] = 1.0 + nrm((L, RWKV_WIDTH), 0.02)
    inp['rwkv_gn_b'] = nrm((L, RWKV_WIDTH), 0.02)
    inp['gdn_conv'] = nrm((L, GDN_CONV, 3 * GDN_WIDTH), GDN_CONV ** -0.5)
    inp['gdn_a_log'] = jnp.log(jax.random.uniform(nk(), (L, 2, GDN_HEADS), jnp.float32, 1.0, 16.0))
    dt = jnp.exp(jax.random.uniform(nk(), (L, 2, GDN_HEADS), jnp.float32, math.log(1e-3), math.log(1e-1)))
    inp['gdn_dt_bias'] = dt + jnp.log(-jnp.expm1(-dt))
    inp['gdn_norm'] = 1.0 + nrm((L, GDN_HEAD), 0.02)
    inp['w_out'] = nrm((L, D_MIX, D), beta_init * D_MIX ** -0.5)
    inp['ln1_g'] = 1.0 + nrm((L, D), 0.02)
    inp['ln1_b'] = nrm((L, D), 0.02)
    inp['ffn_w_gate'] = nrm((L, D, D_FF), D ** -0.5)
    inp['ffn_w_up'] = nrm((L, D, D_FF), D ** -0.5)
    inp['ffn_w_down'] = nrm((L, D_FF, D), beta_init * D_FF ** -0.5)
    inp['ln2_g'] = 1.0 + nrm((L, D), 0.02)
    inp['ln2_b'] = nrm((L, D), 0.02)
    return inp


def reference(x, c, ctx, c_ctx, w_mod, b_mod, w_in, mla_q_norm, mla_kv_norm, mla_w_uq, mla_w_ukv,
              rwkv_mu, rwkv_w0, rwkv_w2, rwkv_a0, rwkv_a2, rwkv_g2, rwkv_k_k, rwkv_k_a, rwkv_r_k,
              rwkv_gn_g, rwkv_gn_b, gdn_conv, gdn_a_log, gdn_dt_bias, gdn_norm, w_out, ln1_g, ln1_b,
              ffn_w_gate, ffn_w_up, ffn_w_down, ln2_g, ln2_b):
    alpha = (2.0 * DEPTH) ** 0.25
    cos, sin = _axial_rope_table(x.shape[1])
    cx = ctx
    for l in range(DEPTH):
        ctx_out = l < DEPTH - 1
        sh_m, sc_m, gt_m, sh_f, sc_f, gt_f = [t[:, None, :] for t in _modulation(c, w_mod[l], b_mod[l])]
        csh_m, csc_m, cgt_m, csh_f, csc_f, cgt_f = _modulation(c_ctx, w_mod[l], b_mod[l])
        p_lat = _modulate(x, sh_m, sc_m) @ w_in[l]
        p_ctx = _modulate(cx, csh_m, csc_m) @ w_in[l]
        mix_lat, mix_ctx = _token_mixers(
            p_lat, p_ctx, cos, sin, mla_q_norm[l], mla_kv_norm[l], mla_w_uq[l], mla_w_ukv[l],
            rwkv_mu[l], rwkv_w0[l], rwkv_w2[l], rwkv_a0[l], rwkv_a2[l], rwkv_g2[l], rwkv_k_k[l], rwkv_k_a[l],
            rwkv_r_k[l], rwkv_gn_g[l], rwkv_gn_b[l], gdn_conv[l], gdn_a_log[l], gdn_dt_bias[l], gdn_norm[l],
            ctx_out)
        x = _layer_norm(alpha * x + gt_m * (mix_lat @ w_out[l]), ln1_g[l], ln1_b[l])
        ffn = _swiglu(_modulate(x, sh_f, sc_f), ffn_w_gate[l], ffn_w_up[l], ffn_w_down[l])
        x = _layer_norm(alpha * x + gt_f * ffn, ln2_g[l], ln2_b[l])
        if ctx_out:
            cx = _layer_norm(alpha * cx + cgt_m * (mix_ctx @ w_out[l]), ln1_g[l], ln1_b[l])
            cffn = _swiglu(_modulate(cx, csh_f, csc_f), ffn_w_gate[l], ffn_w_up[l], ffn_w_down[l])
            cx = _layer_norm(alpha * cx + cgt_f * cffn, ln2_g[l], ln2_b[l])
    return x
```

```cpp
#define MK_MULTI 1
#include <hip/hip_runtime.h>
#include <cstdio>
#include <cstdint>

#define DI __device__ __forceinline__
#define LAS __attribute__((address_space(3)))
#define GAS __attribute__((address_space(1)))
typedef unsigned short bf16;
typedef short bf16x8 __attribute__((ext_vector_type(8)));
typedef short s16x4 __attribute__((ext_vector_type(4)));
typedef float f32x4 __attribute__((ext_vector_type(4)));
typedef float f32x2 __attribute__((ext_vector_type(2)));
typedef float f32x16 __attribute__((ext_vector_type(16)));
typedef unsigned u32x4 __attribute__((ext_vector_type(4)));
typedef unsigned u32x2 __attribute__((ext_vector_type(2)));
typedef unsigned char uchar;
typedef __bf16 bf16x2_t __attribute__((ext_vector_type(2)));

namespace pg8 {
typedef unsigned short bf16_t;
#define PG8_LAS __attribute__((address_space(3)))
constexpr int BM = 256, BK = 64, HALF = 128, HTB = HALF * BK * 2  , STAGE_BYTES = 8 * HTB, NXCD = 8, WGM = 8;

__host__ __device__ __forceinline__ int lds_byte(int r, int c) { const int st = (r >> 4) * 2 + (c >> 5), rr = r & 15, cc = c & 31, ob = rr * 64 + cc * 2; return st * 1024 + (ob ^ (((ob >> 9) & 1) << 5)); }
__host__ __device__ __forceinline__ void stage_rc(int b, int& R, int& C) { const int st = b / 1024, sb = b % 1024, swz = sb ^ (((sb >> 9) & 1) << 5); R = (st >> 1) * 16 + swz / 64; C = (st & 1) * 32 + (swz % 64) / 2; }
__host__ __device__ __forceinline__ int perm32(int rho) { const int n = rho >> 4, i = rho & 15; return 8 * (i >> 2) + 4 * n + (i & 3); }

struct Unit { int pm, pn; };
struct Gemm { const bf16_t* A; const bf16_t* Bt; int M, N, K; };

struct StaticOrder {
    int nM, nN, nwg, G, c;
    __host__ __device__ void init(int M, int N, int G_, int c_) { nM = M / BM; nN = N / BM; nwg = nM * nN; G = G_; c = c_; }
    __host__ __device__ bool next(int i, Unit& u) const {
        const long L = (long)i * G + c; if (L >= nwg) return false;
        int wgid = (int)L; { const int q = nwg / NXCD, r = nwg % NXCD, xcd = wgid % NXCD, off = wgid / NXCD; wgid = (xcd < r ? xcd * (q + 1) : r * (q + 1) + (xcd - r) * q) + off; }
        const int nig = WGM * nN, gid = wgid / nig, fm = gid * WGM, gsz = (nM - fm) < WGM ? (nM - fm) : WGM;
        u.pm = fm + ((wgid % nig) % gsz); u.pn = (wgid % nig) / gsz; return true;
    }
    __device__ __forceinline__ void a_ready(const Unit&) const {}
    __device__ __forceinline__ void done(const Unit&) const {}
};

__device__ __forceinline__ unsigned cvt_pk_bf16(float lo, float hi) { const f32x2 v = {lo, hi}; return __builtin_bit_cast(unsigned, __builtin_convertvector(v, bf16x2_t)); }
__device__ __forceinline__ u32x4 pack8(f32x4 v0, f32x4 v1) { u32x4 w; w.x = cvt_pk_bf16(v0[0], v0[1]); w.y = cvt_pk_bf16(v0[2], v0[3]); w.z = cvt_pk_bf16(v1[0], v1[1]); w.w = cvt_pk_bf16(v1[2], v1[3]); return w; }

struct EpiStore {
    static constexpr bool PERM = true, AFTER_DRAIN = false;
    bf16_t* O; int ldc;
    __device__ __forceinline__ void operator()(const f32x4 (&acc)[2][2][4][2], const Unit& u, int wr, int wc, int fr, int fq) const {
        const int row0 = u.pm * BM + wr * 64 + fr, col0 = u.pn * BM + wc * 32 + 8 * fq;
#pragma unroll
        for (int ai = 0; ai < 2; ++ai)
#pragma unroll
            for (int m = 0; m < 4; ++m) { bf16_t* rowp = O + (size_t)(row0 + ai * HALF + m * 16) * ldc + col0;
#pragma unroll
                for (int bj = 0; bj < 2; ++bj) *(u32x4*)(rowp + bj * HALF) = pack8(acc[ai][bj][m][0], acc[ai][bj][m][1]); }
    }
};
struct EpiKV {
    static constexpr bool PERM = true, AFTER_DRAIN = false;
    bf16_t* Kb; bf16_t* Vb;
    __device__ __forceinline__ void operator()(const f32x4 (&acc)[2][2][4][2], const Unit& u, int wr, int wc, int fr, int fq) const {
        const int row0 = u.pm * BM + wr * 64 + fr, c0 = wc * 32 + 8 * fq;
#pragma unroll
        for (int ai = 0; ai < 2; ++ai)
#pragma unroll
            for (int m = 0; m < 4; ++m) { const size_t row = (size_t)(row0 + ai * HALF + m * 16);
                *(u32x4*)(Kb + row * 1536 + u.pn * 192 + c0) = pack8(acc[ai][0][m][0], acc[ai][0][m][1]);
                *(u32x4*)(Vb + row * 1024 + u.pn * 128 + c0) = pack8(acc[ai][1][m][0], acc[ai][1][m][1]); }
    }
};
struct EpiSwiGLU {
    static constexpr bool PERM = true, AFTER_DRAIN = false;
    bf16_t* Hb; int ldh;
    __device__ __forceinline__ void operator()(const f32x4 (&acc)[2][2][4][2], const Unit& u, int wr, int wc, int fr, int fq) const {
        const int row0 = u.pm * BM + wr * 64 + fr, col0 = u.pn * HALF + wc * 32 + 8 * fq;
#pragma unroll
        for (int ai = 0; ai < 2; ++ai)
#pragma unroll
            for (int m = 0; m < 4; ++m) { f32x4 o[2];
#pragma unroll
                for (int n = 0; n < 2; ++n) { const f32x4 g = acc[ai][0][m][n], up = acc[ai][1][m][n];
#pragma unroll
                    for (int e = 0; e < 4; ++e) o[n][e] = g[e] * __builtin_amdgcn_rcpf(1.f + __expf(-g[e])) * up[e]; }
                *(u32x4*)(Hb + (size_t)(row0 + ai * HALF + m * 16) * ldh + col0) = pack8(o[0], o[1]); }
    }
};
struct EpiRes {
    static constexpr bool PERM = true, AFTER_DRAIN = false;
    float* X; const float* gate; int gstride; float alpha;
    __device__ __forceinline__ void operator()(const f32x4 (&acc)[2][2][4][2], const Unit& u, int wr, int wc, int fr, int fq) const {
        const int row0 = u.pm * BM + wr * 64 + fr, col0 = u.pn * BM + wc * 32 + 8 * fq;
        const int vec = (u.pm % 17 == 0) ? 4 : (u.pm / 17);
        const float* gp = gate + (size_t)vec * gstride + col0;
        f32x4 gv[2][2];
#pragma unroll
        for (int bj = 0; bj < 2; ++bj)
#pragma unroll
            for (int n = 0; n < 2; ++n) gv[bj][n] = *(const f32x4*)(gp + bj * HALF + 4 * n);
#pragma unroll
        for (int ai = 0; ai < 2; ++ai)
#pragma unroll
            for (int m = 0; m < 4; ++m) { float* rowp = X + (size_t)(row0 + ai * HALF + m * 16) * 2048 + col0;
#pragma unroll
                for (int bj = 0; bj < 2; ++bj)
#pragma unroll
                    for (int n = 0; n < 2; ++n) { f32x4* p = (f32x4*)(rowp + bj * HALF + 4 * n); const f32x4 x = *p; *p = x * alpha + gv[bj][n] * acc[ai][bj][m][n]; } }
    }
};

template <class Epi, class Sched, bool ALIGN_EPI = false, bool SP2 = false>
__device__ __forceinline__ void gemm_phase(PG8_LAS unsigned char* lds, const Gemm g, const Sched& S, const Epi& E, const int tid) {
    const int wid = __builtin_amdgcn_readfirstlane(tid >> 6), lane = tid & 63, wr = wid >> 2, wc = wid & 3, fr = lane & 15, fq = lane >> 4;
    const int K = g.K, nt = K / BK;
    unsigned voffA[2], voffB[2];
#pragma unroll
    for (int i = 0; i < 2; ++i) { int R, C; stage_rc(tid * 16 + i * 8192, R, C); const int Rb = Epi::PERM ? ((R & ~31) + perm32(R & 31)) : R;
        voffA[i] = (unsigned)(R * K + C) * 2u; voffB[i] = (unsigned)(Rb * K + C) * 2u; }
    const size_t kstep = (size_t)(BK * 2);
    const size_t hstep = (size_t)HALF * K * 2;
    const size_t tstep = 2 * hstep;
    const unsigned ldsw = (unsigned)wid * 1024u;
    const int aoff = lds_byte(wr * 64 + fr, fq * 8), boff = lds_byte(wc * 32 + fr, fq * 8);
#define PG8_SA(b, h) (((b) * 2 + (h)) * HTB)
#define PG8_SB(b, h) ((4 + (b) * 2 + (h)) * HTB)
#define PG8_STAGE(bufoff, gbase, voff) do { _Pragma("unroll") for (int _i = 0; _i < 2; ++_i) \
        __builtin_amdgcn_global_load_lds((const unsigned*)((const char*)(gbase) + (voff)[_i]), (PG8_LAS unsigned*)(lds + (bufoff) + ldsw + _i * 8192), 16, 0, 0); } while (0)
#define PG8_LDA(dst, b, h) do { _Pragma("unroll") for (int m = 0; m < 4; ++m) _Pragma("unroll") for (int k = 0; k < 2; ++k) dst[m][k] = *(const PG8_LAS bf16x8*)(lds + PG8_SA(b, h) + aoff + m * 2048 + k * 1024); } while (0)
#define PG8_LDB(dst, b, h) do { _Pragma("unroll") for (int n = 0; n < 2; ++n) _Pragma("unroll") for (int k = 0; k < 2; ++k) dst[n][k] = *(const PG8_LAS bf16x8*)(lds + PG8_SB(b, h) + boff + n * 2048 + k * 1024); } while (0)
#define PG8_MMA(ai, bj, At, Bt) do { __builtin_amdgcn_s_setprio(1); _Pragma("unroll") for (int m = 0; m < 4; ++m) _Pragma("unroll") for (int n = 0; n < 2; ++n) _Pragma("unroll") for (int k = 0; k < 2; ++k) \
        acc[ai][bj][m][n] = __builtin_amdgcn_mfma_f32_16x16x32_bf16(Bt[n][k], At[m][k], acc[ai][bj][m][n], 0, 0, 0); __builtin_amdgcn_s_setprio(0); } while (0)
#define PG8_WAIT_V(n) asm volatile("s_waitcnt vmcnt(" #n ")" ::: "memory")
#define PG8_WAIT_L(n) asm volatile("s_waitcnt lgkmcnt(" #n ")" ::: "memory")
#define PG8_BAR __builtin_amdgcn_s_barrier()
#define PG8_SCHED __builtin_amdgcn_sched_barrier(0)
    Unit cur, nxt; int ui = 0;
    if (!S.next(0, cur)) return;
    f32x4 acc[2][2][4][2];
#pragma unroll
    for (int a = 0; a < 2; ++a)
#pragma unroll
        for (int b = 0; b < 2; ++b)
#pragma unroll
            for (int m = 0; m < 4; ++m)
#pragma unroll
                for (int n = 0; n < 2; ++n) acc[a][b][m][n] = (f32x4){0.f, 0.f, 0.f, 0.f};
    bf16x8 At[4][2], B0[2][2], B1[2][2];
    const char* cA = (const char*)g.A + (size_t)cur.pm * tstep; const char* cB = (const char*)g.Bt + (size_t)cur.pn * tstep;
    S.a_ready(cur);
    if constexpr (SP2) {
        PG8_STAGE(PG8_SB(0, 0), cB, voffB); PG8_STAGE(PG8_SB(0, 1), cB + hstep, voffB); PG8_STAGE(PG8_SA(0, 0), cA, voffA); PG8_STAGE(PG8_SA(0, 1), cA + hstep, voffA);
        if (wr == 1) PG8_BAR;
        PG8_WAIT_V(2); PG8_BAR;
        PG8_STAGE(PG8_SB(1, 0), cB + kstep, voffB); PG8_STAGE(PG8_SA(1, 0), cA + kstep, voffA); PG8_STAGE(PG8_SB(1, 1), cB + hstep + kstep, voffB);
        PG8_WAIT_V(6); PG8_BAR;
    } else {
        PG8_STAGE(PG8_SB(0, 0), cB, voffB); PG8_STAGE(PG8_SA(0, 0), cA, voffA); PG8_STAGE(PG8_SB(0, 1), cB + hstep, voffB); PG8_STAGE(PG8_SA(0, 1), cA + hstep, voffA);
        if (wr == 1) PG8_BAR;
        PG8_WAIT_V(4); PG8_BAR;
        PG8_STAGE(PG8_SB(1, 0), cB + kstep, voffB); PG8_STAGE(PG8_SA(1, 0), cA + kstep, voffA); PG8_STAGE(PG8_SB(1, 1), cB + hstep + kstep, voffB);
        PG8_WAIT_V(6); PG8_BAR;
    }
    for (;;) {
        const bool has_next = S.next(ui + 1, nxt);
        const char* nA = has_next ? (const char*)g.A + (size_t)nxt.pm * tstep : cA; const char* nB = has_next ? (const char*)g.Bt + (size_t)nxt.pn * tstep : cB;
        for (int t = 0; t < nt; t += 2) {
            const bool last = (t == nt - 2);
            const char* a1 = cA + (size_t)(t + 1) * kstep;
            const char* a2 = last ? nA : cA + (size_t)(t + 2) * kstep; const char* b2 = last ? nB : cB + (size_t)(t + 2) * kstep;
            const char* a3 = a2 + kstep; const char* b3 = b2 + kstep;
            if (last && has_next) S.a_ready(nxt);
            if constexpr (SP2) {
            PG8_LDB(B0, 0, 0); PG8_LDB(B1, 0, 1); PG8_SCHED; PG8_LDA(At, 0, 0); PG8_STAGE(PG8_SA(1, 1), a1 + hstep, voffA);
            PG8_WAIT_V(8); PG8_WAIT_L(0); PG8_BAR; PG8_MMA(0, 0, At, B0); PG8_MMA(0, 1, At, B1); PG8_BAR; PG8_SCHED;
            PG8_LDA(At, 0, 1); PG8_STAGE(PG8_SB(0, 0), b2, voffB); PG8_STAGE(PG8_SB(0, 1), b2 + hstep, voffB); PG8_STAGE(PG8_SA(0, 0), a2, voffA);
            PG8_WAIT_V(8); PG8_WAIT_L(0); PG8_BAR; PG8_MMA(1, 0, At, B0); PG8_MMA(1, 1, At, B1); PG8_BAR; PG8_SCHED;
            PG8_LDB(B0, 1, 0); PG8_LDB(B1, 1, 1); PG8_SCHED; PG8_LDA(At, 1, 0); PG8_STAGE(PG8_SA(0, 1), a2 + hstep, voffA);
            PG8_WAIT_V(8); PG8_WAIT_L(0); PG8_BAR; PG8_MMA(0, 0, At, B0); PG8_MMA(0, 1, At, B1); PG8_BAR; PG8_SCHED;
            PG8_LDA(At, 1, 1); PG8_STAGE(PG8_SB(1, 0), b3, voffB); PG8_STAGE(PG8_SB(1, 1), b3 + hstep, voffB); PG8_STAGE(PG8_SA(1, 0), a3, voffA);
            PG8_WAIT_V(8); PG8_WAIT_L(0); PG8_BAR; PG8_MMA(1, 0, At, B0); PG8_MMA(1, 1, At, B1); PG8_BAR; PG8_SCHED;
            } else {
            PG8_LDB(B0, 0, 0); PG8_SCHED; PG8_LDA(At, 0, 0); PG8_STAGE(PG8_SA(1, 1), a1 + hstep, voffA);
            PG8_WAIT_L(8); PG8_BAR; PG8_WAIT_L(0); PG8_MMA(0, 0, At, B0); PG8_BAR; PG8_SCHED;
            PG8_LDB(B1, 0, 1); PG8_STAGE(PG8_SB(0, 0), b2, voffB);
            PG8_BAR; PG8_WAIT_L(0); PG8_MMA(0, 1, At, B1); PG8_BAR;
            PG8_LDA(At, 0, 1); PG8_STAGE(PG8_SA(0, 0), a2, voffA);
            PG8_BAR; PG8_WAIT_L(0); PG8_MMA(1, 0, At, B0); PG8_BAR; PG8_SCHED;
            PG8_STAGE(PG8_SB(0, 1), b2 + hstep, voffB);
            PG8_WAIT_V(6); PG8_BAR; PG8_MMA(1, 1, At, B1); PG8_BAR;
            PG8_LDB(B0, 1, 0); PG8_SCHED; PG8_LDA(At, 1, 0); PG8_STAGE(PG8_SA(0, 1), a2 + hstep, voffA);
            PG8_WAIT_L(8); PG8_BAR; PG8_WAIT_L(0); PG8_MMA(0, 0, At, B0); PG8_BAR; PG8_SCHED;
            PG8_LDB(B1, 1, 1); PG8_STAGE(PG8_SB(1, 0), b3, voffB);
            PG8_BAR; PG8_WAIT_L(0); PG8_MMA(0, 1, At, B1); PG8_BAR;
            PG8_LDA(At, 1, 1); PG8_STAGE(PG8_SA(1, 0), a3, voffA);
            PG8_BAR; PG8_WAIT_L(0); PG8_MMA(1, 0, At, B0); PG8_BAR; PG8_SCHED;
            PG8_STAGE(PG8_SB(1, 1), b3 + hstep, voffB);
            PG8_WAIT_V(6); PG8_BAR; PG8_MMA(1, 1, At, B1); PG8_BAR;
            }
        }
        if constexpr (ALIGN_EPI) { if (wr == 0) PG8_BAR; }
        if constexpr (!Epi::AFTER_DRAIN) { E(acc, cur, wr, wc, fr, fq); S.done(cur); }
        if (!has_next) break;
#pragma unroll
        for (int a = 0; a < 2; ++a)
#pragma unroll
            for (int b = 0; b < 2; ++b)
#pragma unroll
                for (int m = 0; m < 4; ++m)
#pragma unroll
                    for (int n = 0; n < 2; ++n) acc[a][b][m][n] = (f32x4){0.f, 0.f, 0.f, 0.f};
        cur = nxt; cA = nA; cB = nB; ++ui;
        if constexpr (ALIGN_EPI) { if (wr == 1) PG8_BAR; }
    }
    PG8_WAIT_V(0);
    if constexpr (!ALIGN_EPI) { if (wr == 0) PG8_BAR; }
    PG8_BAR;
    if constexpr (Epi::AFTER_DRAIN) { E.fused(acc, cur, wr, wc, fr, fq, lds, wid, lane); S.done(cur); }
#undef PG8_SA
#undef PG8_SB
#undef PG8_STAGE
#undef PG8_LDA
#undef PG8_LDB
#undef PG8_MMA
#undef PG8_WAIT_V
#undef PG8_WAIT_L
#undef PG8_BAR
#undef PG8_SCHED
}
}
namespace cf {
constexpr int D = 2048, NB = 4, SEQ = 4096, CTX = 256, SEGT = 4352, M = 17408, DEPTH = 4;
constexpr int IN_COLS = 4912, PC = 5120;
constexpr int C_CQ = 0, C_CKV = 512, C_KR = 1024, C_RW = 1088, C_GD = 2848;
constexpr int RW_K = 512, RW_V = 1024, RW_WD = 1536, RW_AD = 1600, RW_GD = 1664, RW_COLS = 1760;
constexpr int GD_K = 512, GD_V = 1024, GD_Z = 1536, GD_A = 2048, GD_B = 2056;
constexpr int DFF = 5632, NCH = 68;
constexpr int QP = 1536, KP = 1536, VP = 1024;
constexpr int MODS = 6 * D;
constexpr float ALPHA = 1.681792830507429f;
constexpr int RW_TASK = 57600, GD_TASK = 74240;
}
constexpr size_t MiB = 1u << 20;
constexpr size_t WS_CTL = 0, WS_MODV = 1 * MiB, ZERO_BYTES = 2 * MiB;
constexpr size_t WS_ROPE = 2 * MiB, WS_W2T = 2 * MiB + 65536, WS_A2T = WS_W2T + 262144, WS_G2T = WS_A2T + 262144;
constexpr size_t WS_WIN = 4 * MiB, WS_WOUT = 84 * MiB, WS_WGU = 116 * MiB, WS_WDN = 292 * MiB, WS_WUQ = 380 * MiB, WS_WUKV = 386 * MiB;
constexpr size_t WS_X = 394 * MiB, WS_XM = 530 * MiB;
constexpr size_t WS_P = 598 * MiB, WS_CQN = 768 * MiB, WS_CKVN = 785 * MiB, WS_Q = 802 * MiB, WS_K = 853 * MiB, WS_V = 904 * MiB;
constexpr size_t WS_RWT = 938 * MiB, WS_GDT = 1178 * MiB, WS_YR = 1333 * MiB, WS_YG = 1401 * MiB, WS_GATE = 1469 * MiB, WS_BONUS = 1503 * MiB, WS_END = 1505 * MiB;
constexpr size_t WS_HFF = 598 * MiB;
static_assert(WS_RWT + (size_t)4352 * cf::RW_TASK <= WS_GDT && WS_GDT + (size_t)2176 * cf::GD_TASK <= WS_YR && WS_HFF + (size_t)cf::M * cf::DFF * 2 <= WS_CKVN, "ws map");
constexpr int CW_TMO = 0, CW_BAR = 4096;
constexpr int LDS_BYTES = 163840, MISC_OFF = LDS_BYTES - 128;

DI float bflo(unsigned w) { return __builtin_bit_cast(float, w << 16); }
DI float bfhi(unsigned w) { return __builtin_bit_cast(float, w & 0xffff0000u); }
DI float bf2f(bf16 h) { return __builtin_bit_cast(float, (unsigned)h << 16); }
DI bf16 f2bf(float f) { unsigned u = __builtin_bit_cast(unsigned, f); return (bf16)((u + 0x7fffu + ((u >> 16) & 1u)) >> 16); }
DI unsigned pk2(float lo, float hi) { const f32x2 v = {lo, hi}; return __builtin_bit_cast(unsigned, __builtin_convertvector(v, bf16x2_t)); }
DI void unpack8(u32x4 w, float (&f)[8]) { f[0] = bflo(w.x); f[1] = bfhi(w.x); f[2] = bflo(w.y); f[3] = bfhi(w.y); f[4] = bflo(w.z); f[5] = bfhi(w.z); f[6] = bflo(w.w); f[7] = bfhi(w.w); }
DI u32x4 pack8f(const float (&f)[8]) { u32x4 w; w.x = pk2(f[0], f[1]); w.y = pk2(f[2], f[3]); w.z = pk2(f[4], f[5]); w.w = pk2(f[6], f[7]); return w; }
template <int X> DI float sx(float v) { return __builtin_bit_cast(float, __builtin_amdgcn_ds_swizzle(__builtin_bit_cast(int, v), 0x1F | (X << 10))); }
DI float lx(float v, int lane, int X) { return __builtin_bit_cast(float, __builtin_amdgcn_ds_bpermute((lane ^ X) << 2, __builtin_bit_cast(int, v))); }
DI float wave_sum(float v, int lane) {
    v += sx<1>(v); v += sx<2>(v); v += sx<4>(v); v += lx(v, lane, 8); v += lx(v, lane, 16); v += lx(v, lane, 32);
    return v;
}
DI float sigmoidf_(float x) { return 1.f / (1.f + __expf(-x)); }
DI float softplusf_(float x) { const float e = __expf(x); return x > 20.f ? x : (x < -9.f ? e * (1.f - 0.5f * e) : __logf(1.f + e)); }
#define LDS_BARRIER() do { asm volatile("s_waitcnt lgkmcnt(0)" ::: "memory"); __builtin_amdgcn_s_barrier(); asm volatile("" ::: "memory"); } while (0)
#define LDS_WAIT() asm volatile("s_waitcnt lgkmcnt(0)" ::: "memory")
#define MFMA16(a, b, c) __builtin_amdgcn_mfma_f32_16x16x32_bf16((a), (b), (c), 0, 0, 0)

#define XB_TMO      128
#define XB_XCNT(j)  (256  + 64 * (j))
#define XB_XSUB(j)  (1280 + 64 * (j))
#define XB_XGEN(j)  (2304 + 64 * (j))
#define XB_TOP      3328
#define XB_TOPGEN   3392
#define XCD_BAR_WORDS 3456
#define XB_SPIN_CAP (1u << 22)
__device__ __forceinline__ unsigned xb_ld(unsigned* p)              { return __hip_atomic_load(p, __ATOMIC_RELAXED, __HIP_MEMORY_SCOPE_AGENT); }
__device__ __forceinline__ unsigned xb_add(unsigned* p, unsigned v) { return __hip_atomic_fetch_add(p, v, __ATOMIC_RELAXED, __HIP_MEMORY_SCOPE_AGENT); }
__device__ __forceinline__ unsigned xb_xcc_id() { return (unsigned)__builtin_amdgcn_s_getreg((3 << 11) | 20) & 0xFu; }
#define XB_SPIN(cond, bar) do { unsigned _sp = 0; while (cond) { __builtin_amdgcn_s_sleep(1); \
    if ((++_sp & 255u) == 0u) { if (xb_ld(&(bar)[XB_TMO])) break; if (_sp > XB_SPIN_CAP) { atomicAdd(&(bar)[XB_TMO], 1u); break; } } } } while (0)
struct XcdBarrier { unsigned* bar; unsigned x; volatile LAS unsigned* st; };
__device__ __forceinline__ XcdBarrier xcd_barrier_post(unsigned* bar, volatile LAS unsigned* st) {
    XcdBarrier b; b.bar = bar; b.x = xb_xcc_id(); b.st = st;
    if (threadIdx.x == 0) (void)xb_add(&bar[XB_XCNT(b.x)], 1u);
    return b;
}
__device__ __forceinline__ void xcd_barrier_complete(unsigned* bar, unsigned x, unsigned& nloc, unsigned& nx) {
    const unsigned G = gridDim.x * gridDim.y * gridDim.z;
    unsigned sum, cnt, mine, sp = 0u;
    for (;;) {
        sum = 0u; cnt = 0u; mine = 0u;
#pragma unroll
        for (unsigned j = 0; j < 16; ++j) { const unsigned c = xb_ld(&bar[XB_XCNT(j)]); sum += c; cnt += (c > 0u) ? 1u : 0u; mine = (j == x) ? c : mine; }
        if (sum == G) break;
        __builtin_amdgcn_s_sleep(1);
        if ((++sp & 255u) == 0u) { if (xb_ld(&bar[XB_TMO])) break; if (sp > XB_SPIN_CAP) { atomicAdd(&bar[XB_TMO], 1u); break; } }
    }
    nloc = mine > 0u ? mine : 1u; nx = cnt > 0u ? cnt : 1u;
}
__device__ __forceinline__ void xcd_barrier(const XcdBarrier& b) {
    asm volatile("s_waitcnt vmcnt(0)" ::: "memory");
    __syncthreads();
    if (threadIdx.x == 0) {
        unsigned* bar = b.bar;
        __builtin_amdgcn_s_waitcnt(0);
        unsigned nloc = b.st[0], nx = b.st[1];
        if (nloc == 0u) { xcd_barrier_complete(bar, b.x, nloc, nx); b.st[0] = nloc; b.st[1] = nx; }
        const unsigned old = xb_add(&bar[XB_XSUB(b.x)], 1u);
        const unsigned gen = old / nloc;
        if (old + 1u == (gen + 1u) * nloc) {
            __builtin_amdgcn_fence(__ATOMIC_RELEASE, "agent");
            asm volatile("s_waitcnt vmcnt(0)" ::: "memory");
            const unsigned og = xb_add(&bar[XB_TOP], 1u);
            const unsigned tg = og / nx;
            if (og + 1u == (tg + 1u) * nx) xb_add(&bar[XB_TOPGEN], 1u);
            else XB_SPIN(xb_ld(&bar[XB_TOPGEN]) == tg, bar);
            __builtin_amdgcn_fence(__ATOMIC_ACQUIRE, "agent");
            xb_add(&bar[XB_XGEN(b.x)], 1u);
            asm volatile("s_waitcnt vmcnt(0)" ::: "memory");
        } else {
            XB_SPIN(xb_ld(&bar[XB_XGEN(b.x)]) == gen, bar);
            __builtin_amdgcn_fence(__ATOMIC_ACQUIRE, "agent");
            asm volatile("s_waitcnt vmcnt(0)" ::: "memory");
        }
    }
    __syncthreads();
}

DI int row_of(int b, int dir, int ci, int i) {
    int s;
    if (dir == 0) s = ci * 64 + i;
    else s = (ci < 4) ? (3 - ci) * 64 + (63 - i) : 256 + (67 - ci) * 64 + (63 - i);
    return b * cf::SEGT + s;
}
DI void transpose_item(const float* W, int K, int N, bf16* WT, int out_row0, int k0, int n0, LAS float* scr, int lane) {
    const int n = n0 + (lane & 31); const bool ok = n < N;
#pragma unroll 8
    for (int i = 0; i < 32; ++i) { const int kk = 2 * i + (lane >> 5); scr[kk * 33 + (lane & 31)] = ok ? W[(size_t)(k0 + kk) * N + n] : 0.f; }
    LDS_WAIT();
    const int c = lane & 7;
#pragma unroll
    for (int j = 0; j < 4; ++j) { const int nn = (lane >> 3) + 8 * j; const LAS float* s = scr + (8 * c) * 33 + nn;
        u32x4 o; o.x = pk2(s[0 * 33], s[1 * 33]); o.y = pk2(s[2 * 33], s[3 * 33]); o.z = pk2(s[4 * 33], s[5 * 33]); o.w = pk2(s[6 * 33], s[7 * 33]);
        *(u32x4*)(WT + (size_t)(out_row0 + nn) * K + k0 + 8 * c) = o; }
    LDS_WAIT();
}

struct In { const float* p[34]; };

DI void phase_prologue(const In& in, uchar* ws, LAS uchar* lds, int G, int bx, int tid) {
    using namespace cf;
    const int lane = tid & 63, wid = tid >> 6, gw = bx * 8 + wid, NGW = G * 8;
    LAS float* scr = (LAS float*)(lds + wid * 16384);
    constexpr int I_IN = 32 * 160, I_OUT = 32 * 64, I_G = 32 * 176, I_DN = 88 * 64, I_UQ = 8 * 48, I_UKV = 8 * 64;
    constexpr int I_LAYER = I_IN + I_OUT + 2 * I_G + I_DN + I_UQ + I_UKV;
    for (int it = gw; it < DEPTH * I_LAYER; it += NGW) {
        const int l = it / I_LAYER; int r = it % I_LAYER;
        if (r < I_IN) { const int kb = r / 160, nb = r % 160; transpose_item(in.p[6] + (size_t)l * D * IN_COLS, D, IN_COLS, (bf16*)(ws + WS_WIN) + (size_t)l * PC * D, nb * 32, kb * 64, nb * 32, scr, lane); continue; } r -= I_IN;
        if (r < I_OUT) { const int kb = r / 64, nb = r % 64; transpose_item(in.p[26] + (size_t)l * D * D, D, D, (bf16*)(ws + WS_WOUT) + (size_t)l * D * D, nb * 32, kb * 64, nb * 32, scr, lane); continue; } r -= I_OUT;
        if (r < 2 * I_G) { const int up = r >= I_G; if (up) r -= I_G; const int kb = r / 176, nb = r % 176, n0 = nb * 32;
            transpose_item(in.p[up ? 30 : 29] + (size_t)l * D * DFF, D, DFF, (bf16*)(ws + WS_WGU) + (size_t)l * 2 * DFF * D, 256 * (n0 / 128) + (n0 % 128) + (up ? 128 : 0), kb * 64, n0, scr, lane); continue; } r -= 2 * I_G;
        if (r < I_DN) { const int kb = r / 64, nb = r % 64; transpose_item(in.p[31] + (size_t)l * DFF * D, DFF, D, (bf16*)(ws + WS_WDN) + (size_t)l * D * DFF, nb * 32, kb * 64, nb * 32, scr, lane); continue; } r -= I_DN;
        if (r < I_UQ) { const int kb = r / 48, nb = r % 48; transpose_item(in.p[9] + (size_t)l * 512 * 1536, 512, 1536, (bf16*)(ws + WS_WUQ) + (size_t)l * 1536 * 512, nb * 32, kb * 64, nb * 32, scr, lane); continue; } r -= I_UQ;
        { const int kb = r / 64, nb = r % 64; transpose_item(in.p[10] + (size_t)l * 512 * 2048, 512, 2048, (bf16*)(ws + WS_WUKV) + (size_t)l * 2048 * 512, nb * 32, kb * 64, nb * 32, scr, lane); }
    }
    float* X = (float*)(ws + WS_X);
    for (int r = gw; r < M; r += NGW) { const int b = r / SEGT, s = r % SEGT;
        const float* src = (s < CTX) ? in.p[2] + ((size_t)b * CTX + s) * D : in.p[0] + ((size_t)b * SEQ + (s - CTX)) * D;
        const f32x4* sp = (const f32x4*)src + lane; f32x4* dp = (f32x4*)(X + (size_t)r * D) + lane;
#pragma unroll
        for (int j = 0; j < 8; ++j) dp[64 * j] = sp[64 * j]; }
    const int gt = bx * 512 + tid, NGT = G * 512;
    float* rope = (float*)(ws + WS_ROPE);
    for (int i = gt; i < 1024; i += NGT) { const int pos = i >> 4, f = i & 15; const float inv = powf(10000.f, -(float)f / 16.f), ang = (float)pos * inv; rope[i] = cosf(ang); rope[1024 + i] = sinf(ang); }
    bf16* W2T = (bf16*)(ws + WS_W2T); bf16* A2T = (bf16*)(ws + WS_A2T); bf16* G2T = (bf16*)(ws + WS_G2T);
    for (int i = gt; i < DEPTH * 2 * 512 * 32; i += NGT) { const int r = i & 31, c = (i >> 5) & 511, ld = i >> 14;
        W2T[i] = f2bf(in.p[13][((size_t)ld * 32 + r) * 512 + c]); A2T[i] = f2bf(in.p[15][((size_t)ld * 32 + r) * 512 + c]); }
    for (int i = gt; i < DEPTH * 512 * 96; i += NGT) { const int k = i % 96, c = (i / 96) % 512, l = i / (96 * 512);
        G2T[i] = f2bf(in.p[16][((size_t)l * 96 + k) * 512 + c]); }
    LAS float* sv = scr;
    for (int it = gw; it < DEPTH * 48 * 16; it += NGW) {
        const int kp = it & 15, ng = (it >> 4) % 48, l = it / (16 * 48);
        for (int i = lane; i < 640; i += 64) { const int v = i >> 7, k = kp * 128 + (i & 127); const float x = (v < 4) ? in.p[1][v * D + k] : in.p[3][k]; sv[i] = x * sigmoidf_(x); }
        LDS_WAIT();
        const int n = ng * 256 + lane * 4;
        const float* wp = in.p[4] + ((size_t)l * D + (size_t)kp * 128) * MODS + n;
        f32x4 acc[5];
#pragma unroll
        for (int v = 0; v < 5; ++v) acc[v] = (f32x4){0.f, 0.f, 0.f, 0.f};
#pragma unroll 8
        for (int kk = 0; kk < 128; ++kk) { const f32x4 w = *(const f32x4*)(wp + (size_t)kk * MODS);
#pragma unroll
            for (int v = 0; v < 5; ++v) acc[v] += w * sv[v * 128 + kk]; }
        float* part = (float*)(ws + WS_P) + (size_t)kp * (DEPTH * 5 * MODS);
#pragma unroll
        for (int v = 0; v < 5; ++v) *(f32x4*)(part + ((size_t)l * 5 + v) * MODS + n) = acc[v];
        LDS_WAIT();
    }
}

DI void phase_modreduce(const In& in, uchar* ws, int G, int bx, int tid) {
    using namespace cf;
    float* modv = (float*)(ws + WS_MODV); const float* part = (const float*)(ws + WS_P);
    for (int i = bx * 512 + tid; i < DEPTH * 5 * MODS / 4; i += G * 512) { const int n4 = i % (MODS / 4), l = i / (5 * MODS / 4);
        f32x4 s = *(const f32x4*)(in.p[5] + (size_t)l * MODS + n4 * 4);
#pragma unroll
        for (int kp = 0; kp < 16; ++kp) s += *(const f32x4*)(part + (size_t)kp * (DEPTH * 5 * MODS) + (size_t)i * 4);
        *(f32x4*)(modv + (size_t)i * 4) = s; }
}

DI void phase_modulate(const float* X, bf16* XM, const float* modl  , int shift_off, int scale_off, int G, int bx, int tid) {
    using namespace cf;
    const int lane = tid & 63, gw = bx * 8 + (tid >> 6), NGW = G * 8;
    for (int r = gw; r < M; r += NGW) { const int b = r / SEGT, s = r % SEGT, vec = (s < CTX) ? 4 : b;
        const f32x4* xp = (const f32x4*)(X + (size_t)r * D) + lane; const f32x4* sh = (const f32x4*)(modl + (size_t)vec * MODS + shift_off) + lane; const f32x4* sc = (const f32x4*)(modl + (size_t)vec * MODS + scale_off) + lane;
        u32x2* op = (u32x2*)(XM + (size_t)r * D) + lane;
#pragma unroll
        for (int j = 0; j < 8; ++j) { const f32x4 v = xp[64 * j] * (sc[64 * j] + 1.f) + sh[64 * j]; u32x2 o; o.x = pk2(v.x, v.y); o.y = pk2(v.z, v.w); op[64 * j] = o; } }
}

DI void phase_ln(float* X, const float* g, const float* bb, bf16* XM, const float* modl, int shift_off, int scale_off, float* out, int G, int bx, int tid) {
    using namespace cf;
    const int lane = tid & 63, gw = bx * 8 + (tid >> 6), NGW = G * 8;
    for (int r = gw; r < M; r += NGW) { const int b = r / SEGT, s = r % SEGT, vec = (s < CTX) ? 4 : b;
        if (out && s < CTX) continue;
        f32x4* xp = (f32x4*)(X + (size_t)r * D) + lane;
        f32x4 v[8]; float sum = 0.f;
#pragma unroll
        for (int j = 0; j < 8; ++j) { v[j] = xp[64 * j]; sum += (v[j].x + v[j].y) + (v[j].z + v[j].w); }
        const float mean = wave_sum(sum, lane) * (1.f / D); float s2 = 0.f;
#pragma unroll
        for (int j = 0; j < 8; ++j) { v[j] = v[j] - mean; s2 += (v[j].x * v[j].x + v[j].y * v[j].y) + (v[j].z * v[j].z + v[j].w * v[j].w); }
        const float rstd = rsqrtf(wave_sum(s2, lane) * (1.f / D) + 1e-5f);
        const f32x4* gp = (const f32x4*)g + lane; const f32x4* bp = (const f32x4*)bb + lane;
#pragma unroll
        for (int j = 0; j < 8; ++j) v[j] = v[j] * rstd * gp[64 * j] + bp[64 * j];
        if (out) { f32x4* op = (f32x4*)(out + ((size_t)b * SEQ + (s - CTX)) * D) + lane;
#pragma unroll
            for (int j = 0; j < 8; ++j) op[64 * j] = v[j];
        } else {
            const f32x4* sh = (const f32x4*)(modl + (size_t)vec * MODS + shift_off) + lane; const f32x4* sc = (const f32x4*)(modl + (size_t)vec * MODS + scale_off) + lane;
            u32x2* op = (u32x2*)(XM + (size_t)r * D) + lane;
#pragma unroll
            for (int j = 0; j < 8; ++j) { xp[64 * j] = v[j]; const f32x4 m = v[j] * (sc[64 * j] + 1.f) + sh[64 * j]; u32x2 o; o.x = pk2(m.x, m.y); o.y = pk2(m.z, m.w); op[64 * j] = o; }
        }
    }
}

DI void mla_prep_rows(const bf16* P, bf16* CQN, bf16* CKVN, bf16* Kb, const float* qn, const float* kvn, const float* rope, int G, int bx, int tid) {
    using namespace cf;
    const int lane = tid & 63, gw = bx * 8 + (tid >> 6), NGW = G * 8;
    for (int r = gw; r < M; r += NGW) { const int s = r % SEGT; const bf16* pr = P + (size_t)r * PC;
#pragma unroll
        for (int part = 0; part < 2; ++part) {
            float x[8]; unpack8(*(const u32x4*)(pr + part * 512 + lane * 8), x);
            float ss = 0.f;
#pragma unroll
            for (int e = 0; e < 8; ++e) ss += x[e] * x[e];
            const float rs = rsqrtf(wave_sum(ss, lane) * (1.f / 512.f) + 1e-6f);
            const float* gp = (part ? kvn : qn) + lane * 8; const f32x4 g0 = *(const f32x4*)gp, g1 = *(const f32x4*)(gp + 4);
            float o[8];
#pragma unroll
            for (int e = 0; e < 8; ++e) o[e] = x[e] * rs * (e < 4 ? g0[e] : g1[e - 4]);
            *(u32x4*)((part ? CKVN : CQN) + (size_t)r * 512 + lane * 8) = pack8f(o);
        }
        float kr = bf2f(pr[C_KR + lane]);
        const float other = lx(kr, lane, 16);
        if (s >= CTX) { const int t = s - CTX, axis = lane >> 5, half = (lane >> 4) & 1, f = lane & 15, pos = axis ? (t & 63) : (t >> 6);
            const float c = rope[pos * 16 + f], sn = rope[1024 + pos * 16 + f];
            kr = half ? (other * sn + kr * c) : (kr * c - other * sn); }
        const bf16 kb = f2bf(kr);
#pragma unroll
        for (int h = 0; h < 8; ++h) Kb[(size_t)r * KP + h * 192 + 128 + lane] = kb;
    }
}

DI void mix_rows(const bf16* P, const float* YR, const float* YG, const float* GATE, const float* BONUS, bf16* MIX,
                 const float* mu, const float* gn_g, const float* gn_b, const float* gdn_norm, int G, int bx, int tid) {
    using namespace cf;
    const int lane = tid & 63, gw = bx * 8 + (tid >> 6), NGW = G * 8;
    for (int r = gw; r < M; r += NGW) { const int s = r % SEGT; const bf16* pr = P + (size_t)r * PC;
        const bool hasp = (s != 0) && (s != CTX), hasn = (s != CTX - 1) && (s != SEGT - 1);
        const int c0 = lane * 8;
        {
            float y[8], v[8];
            { const f32x4 a0 = *(const f32x4*)(YR + (size_t)r * 512 + c0), a1 = *(const f32x4*)(YR + (size_t)r * 512 + c0 + 4);
              const f32x4 b0 = *(const f32x4*)(YR + ((size_t)M + r) * 512 + c0), b1 = *(const f32x4*)(YR + ((size_t)M + r) * 512 + c0 + 4);
#pragma unroll
              for (int e = 0; e < 4; ++e) { y[e] = a0[e] + b0[e]; y[4 + e] = a1[e] + b1[e]; } }
            float sm = 0.f;
#pragma unroll
            for (int e = 0; e < 8; ++e) sm += y[e];
            sm += sx<1>(sm); sm += sx<2>(sm); sm += sx<4>(sm);
            const float mean = sm * (1.f / 64.f); float q = 0.f;
#pragma unroll
            for (int e = 0; e < 8; ++e) { y[e] -= mean; q += y[e] * y[e]; }
            q += sx<1>(q); q += sx<2>(q); q += sx<4>(q);
            const float rstd = rsqrtf(q * (1.f / 64.f) + 64e-5f);
            { float cur[8], prv[8], nxt[8]; const int col = C_RW + RW_V + c0;
              unpack8(*(const u32x4*)(pr + col), cur);
              if (hasp) unpack8(*(const u32x4*)(pr - PC + col), prv); else {
#pragma unroll
                  for (int e = 0; e < 8; ++e) prv[e] = 0.f; }
              if (hasn) unpack8(*(const u32x4*)(pr + PC + col), nxt); else {
#pragma unroll
                  for (int e = 0; e < 8; ++e) nxt[e] = 0.f; }
              const f32x4 m0 = *(const f32x4*)(mu + RW_V + c0), m1 = *(const f32x4*)(mu + RW_V + c0 + 4);
#pragma unroll
              for (int e = 0; e < 8; ++e) v[e] = cur[e] + (0.5f * (prv[e] + nxt[e]) - cur[e]) * (e < 4 ? m0[e] : m1[e - 4]); }
            const int h = lane >> 3;
            const float bonus = BONUS[(size_t)r * 8 + h] + BONUS[((size_t)M + r) * 8 + h];
            const f32x4 gg0 = *(const f32x4*)(gn_g + c0), gg1 = *(const f32x4*)(gn_g + c0 + 4), gb0 = *(const f32x4*)(gn_b + c0), gb1 = *(const f32x4*)(gn_b + c0 + 4);
            const f32x4 gt0 = *(const f32x4*)(GATE + (size_t)r * 512 + c0), gt1 = *(const f32x4*)(GATE + (size_t)r * 512 + c0 + 4);
            float o[8];
#pragma unroll
            for (int e = 0; e < 8; ++e) o[e] = (y[e] * rstd * (e < 4 ? gg0[e] : gg1[e - 4]) + (e < 4 ? gb0[e] : gb1[e - 4]) + bonus * v[e]) * (e < 4 ? gt0[e] : gt1[e - 4]);
            *(u32x4*)(MIX + (size_t)r * D + 1024 + c0) = pack8f(o);
        }
        {
            float y[8], z[8];
            { const f32x4 a0 = *(const f32x4*)(YG + (size_t)r * 512 + c0), a1 = *(const f32x4*)(YG + (size_t)r * 512 + c0 + 4);
              const f32x4 b0 = *(const f32x4*)(YG + ((size_t)M + r) * 512 + c0), b1 = *(const f32x4*)(YG + ((size_t)M + r) * 512 + c0 + 4);
#pragma unroll
              for (int e = 0; e < 4; ++e) { y[e] = a0[e] + b0[e]; y[4 + e] = a1[e] + b1[e]; } }
            float q = 0.f;
#pragma unroll
            for (int e = 0; e < 8; ++e) q += y[e] * y[e];
            q += sx<1>(q); q += sx<2>(q); q += sx<4>(q); q += lx(q, lane, 8);
            const float rs = rsqrtf(q * (1.f / 128.f) + 1e-6f);
            unpack8(*(const u32x4*)(pr + C_GD + GD_Z + c0), z);
            const int cn = c0 & 127; const f32x4 n0 = *(const f32x4*)(gdn_norm + cn), n1 = *(const f32x4*)(gdn_norm + cn + 4);
            float o[8];
#pragma unroll
            for (int e = 0; e < 8; ++e) o[e] = y[e] * rs * (e < 4 ? n0[e] : n1[e - 4]) * (z[e] * sigmoidf_(z[e]));
            *(u32x4*)(MIX + (size_t)r * D + 1536 + c0) = pack8f(o);
        }
    }
}
template <int K> DI f32x4 mm_tile(const LAS bf16* A, int lda, const LAS bf16* Bt, int ldb, int tm, int tn, f32x4 acc, int lane) {
    const int r = lane & 15, q = lane >> 4;
#pragma unroll
    for (int k0 = 0; k0 < K; k0 += 32) {
        const bf16x8 a = *(const LAS bf16x8*)(A + (16 * tm + r) * lda + k0 + q * 8);
        const bf16x8 b = *(const LAS bf16x8*)(Bt + (16 * tn + r) * ldb + k0 + q * 8);
        acc = MFMA16(a, b, acc);
    }
    return acc;
}
DI void inv_offblock(const LAS float* A, LAS float* TF, LAS bf16* TT, LAS float* scr, int i, int j, int lane) {
    const int r = lane & 15, q = lane >> 4;
    float p[4] = {0.f, 0.f, 0.f, 0.f};
    for (int kb = j; kb < i; ++kb) {
#pragma unroll
        for (int s = 0; s < 16; ++s) { const float a = A[(16 * i + r) * 65 + 16 * kb + s]; const LAS float* tp = TF + (16 * kb + s) * 65 + 16 * j + 4 * q;
#pragma unroll
            for (int e = 0; e < 4; ++e) p[e] += a * tp[e]; }
    }
#pragma unroll
    for (int e = 0; e < 4; ++e) scr[r * 17 + 4 * q + e] = p[e];
    LDS_WAIT();
    float o[4] = {0.f, 0.f, 0.f, 0.f};
#pragma unroll
    for (int s = 0; s < 16; ++s) { const float t = TF[(16 * i + r) * 65 + 16 * i + s];
#pragma unroll
        for (int e = 0; e < 4; ++e) o[e] += t * scr[s * 17 + 4 * q + e]; }
#pragma unroll
    for (int e = 0; e < 4; ++e) { TF[(16 * i + r) * 65 + 16 * j + 4 * q + e] = o[e]; TT[(16 * i + r) * 72 + 16 * j + 4 * q + e] = f2bf(o[e]); }
}
DI void inv_blocked(const LAS float* A, LAS float* TF, LAS bf16* TT, LAS float* scr_all, int wid, int lane, int tid) {
    for (int i = tid; i < 64 * 72 / 8; i += 512) ((LAS u32x4*)TT)[i] = (u32x4){0u, 0u, 0u, 0u};
    LDS_BARRIER();
    if (wid < 4 && lane < 16) { const int j = lane, base = 16 * wid; float tc[16];
#pragma unroll
        for (int t = 0; t < 16; ++t) { float acc = (t == j) ? 1.f : 0.f;
#pragma unroll
            for (int s = 0; s < t; ++s) acc += A[(base + t) * 65 + base + s] * tc[s];
            tc[t] = acc; }
#pragma unroll
        for (int t = 0; t < 16; ++t) { TF[(base + t) * 65 + base + j] = tc[t]; TT[(base + t) * 72 + base + j] = f2bf(tc[t]); }
    }
    LDS_BARRIER();
    LAS float* scr = scr_all + wid * 272;
    if (wid < 3) inv_offblock(A, TF, TT, scr, wid + 1, wid, lane);
    LDS_BARRIER();
    if (wid < 2) inv_offblock(A, TF, TT, scr, wid + 2, wid, lane);
    LDS_BARRIER();
    if (wid < 1) inv_offblock(A, TF, TT, scr, 3, 0, lane);
    LDS_BARRIER();
}

struct ScanW {
    const float *mu, *w0, *a0, *k_k, *k_a, *r_k;
    const bf16 *W2T, *A2T, *G2T;
    const float *conv, *a_log, *dt_bias;
};

DI void s1_rwkv(LAS uchar* lds, const bf16* P, const ScanW& sw, uchar* task, float* GATE, float* BONUSd, int b, int h, int dir, int ci, int tid) {
    using namespace cf;
    constexpr int MB = 9216;
    LAS bf16* AT = (LAS bf16*)(lds + 0 * MB); LAS bf16* BT = (LAS bf16*)(lds + 1 * MB); LAS bf16* KT = (LAS bf16*)(lds + 2 * MB); LAS bf16* QT = (LAS bf16*)(lds + 3 * MB);
    LAS bf16* ATT = (LAS bf16*)(lds + 4 * MB); LAS bf16* VT = (LAS bf16*)(lds + 5 * MB); LAS bf16* KHT = (LAS bf16*)(lds + 6 * MB); LAS bf16* BHT = (LAS bf16*)(lds + 7 * MB);
    LAS bf16* AAK = (LAS bf16*)(lds + 8 * MB); LAS bf16* AQK = (LAS bf16*)(lds + 9 * MB); LAS bf16* TT = (LAS bf16*)(lds + 10 * MB); LAS bf16* XT = (LAS bf16*)(lds + 11 * MB);
    LAS float* AAB = (LAS float*)(lds + 12 * MB); LAS float* GC = AAB;
    LAS float* INVS = (LAS float*)(lds + 12 * MB + 16640);
    LAS float* LWf = (LAS float*)(lds + 8 * MB); LAS float* LAf = (LAS float*)(lds + 10 * MB); LAS float* TF = (LAS float*)(lds + 8 * MB);
    LAS bf16* TW = (LAS bf16*)(lds + 0); LAS bf16* AD = (LAS bf16*)(lds + 5120); LAS bf16* SG = (LAS bf16*)(lds + 10240);
    const int lane = tid & 63, wid = tid >> 6, i = tid >> 3, sub = tid & 7, r16 = lane & 15, q4 = lane >> 4;
    const int R = row_of(b, dir, ci, i), seg_lo = b * SEGT + (ci < 4 ? 0 : CTX), seg_hi = b * SEGT + (ci < 4 ? CTX : SEGT);
    const bool hasp = R - 1 >= seg_lo, hasn = R + 1 < seg_hi;
    const bf16* pr = P + (size_t)R * PC + C_RW;
    float rv[8], kv[8], vv[8];
#pragma unroll
    for (int w = 0; w < 3; ++w) { const int col = w * 512 + h * 64 + sub * 8; float cur[8], prv[8], nxt[8];
        unpack8(*(const u32x4*)(pr + col), cur);
        if (hasp) unpack8(*(const u32x4*)(pr - PC + col), prv); else {
#pragma unroll
            for (int e = 0; e < 8; ++e) prv[e] = 0.f; }
        if (hasn) unpack8(*(const u32x4*)(pr + PC + col), nxt); else {
#pragma unroll
            for (int e = 0; e < 8; ++e) nxt[e] = 0.f; }
        const f32x4 m0 = *(const f32x4*)(sw.mu + col), m1 = *(const f32x4*)(sw.mu + col + 4);
#pragma unroll
        for (int e = 0; e < 8; ++e) { const float x = cur[e] + (0.5f * (prv[e] + nxt[e]) - cur[e]) * (e < 4 ? m0[e] : m1[e - 4]); if (w == 0) rv[e] = x; else if (w == 1) kv[e] = x; else vv[e] = x; } }
#pragma unroll
    for (int w = 0; w < 2; ++w) { const int col = (w ? RW_AD : RW_WD) + dir * 32 + sub * 4;
        const u32x2 c2 = *(const u32x2*)(pr + col); u32x2 p2 = (u32x2){0u, 0u}, n2 = (u32x2){0u, 0u};
        if (hasp) p2 = *(const u32x2*)(pr - PC + col); if (hasn) n2 = *(const u32x2*)(pr + PC + col);
        const f32x4 m = *(const f32x4*)(sw.mu + col);
        const float cur[4] = {bflo(c2.x), bfhi(c2.x), bflo(c2.y), bfhi(c2.y)}, prv[4] = {bflo(p2.x), bfhi(p2.x), bflo(p2.y), bfhi(p2.y)}, nxt[4] = {bflo(n2.x), bfhi(n2.x), bflo(n2.y), bfhi(n2.y)};
        float x[4];
#pragma unroll
        for (int e = 0; e < 4; ++e) { x[e] = cur[e] + (0.5f * (prv[e] + nxt[e]) - cur[e]) * m[e]; if (w == 0) x[e] = tanhf(x[e]); }
        u32x2 o; o.x = pk2(x[0], x[1]); o.y = pk2(x[2], x[3]);
        *(LAS u32x2*)((w ? AD : TW) + i * 40 + sub * 4) = o; }
    if (dir == 0) {
#pragma unroll
        for (int j = 0; j < 3; ++j) { const int col = RW_GD + sub * 12 + j * 4;
            const u32x2 c2 = *(const u32x2*)(pr + col); u32x2 p2 = (u32x2){0u, 0u}, n2 = (u32x2){0u, 0u};
            if (hasp) p2 = *(const u32x2*)(pr - PC + col); if (hasn) n2 = *(const u32x2*)(pr + PC + col);
            const f32x4 m = *(const f32x4*)(sw.mu + col);
            const float cur[4] = {bflo(c2.x), bfhi(c2.x), bflo(c2.y), bfhi(c2.y)}, prv[4] = {bflo(p2.x), bfhi(p2.x), bflo(p2.y), bfhi(p2.y)}, nxt[4] = {bflo(n2.x), bfhi(n2.x), bflo(n2.y), bfhi(n2.y)};
            float x[4];
#pragma unroll
            for (int e = 0; e < 4; ++e) x[e] = sigmoidf_(cur[e] + (0.5f * (prv[e] + nxt[e]) - cur[e]) * m[e]);
            u32x2 o; o.x = pk2(x[0], x[1]); o.y = pk2(x[2], x[3]);
            *(LAS u32x2*)(SG + i * 104 + sub * 12 + j * 4) = o; }
    }
    LDS_BARRIER();
    { const int which = wid >> 2, tm = wid & 3;
      const bf16x8 a = *(const LAS bf16x8*)((which ? AD : TW) + (16 * tm + r16) * 40 + q4 * 8);
      const bf16* wt = (which ? sw.A2T : sw.W2T) + ((size_t)dir * 512 + h * 64) * 32;
#pragma unroll
      for (int tn = 0; tn < 4; ++tn) { const bf16x8 bb = *(const bf16x8*)(wt + (16 * tn + r16) * 32 + q4 * 8);
          const f32x4 acc = MFMA16(a, bb, ((f32x4){0.f, 0.f, 0.f, 0.f}));
#pragma unroll
          for (int e = 0; e < 4; ++e) (which ? LAf : LWf)[(16 * tm + 4 * q4 + e) * 65 + 16 * tn + r16] = acc[e]; } }
    if (dir == 0) { const int tm = wid >> 1;
#pragma unroll
        for (int j = 0; j < 2; ++j) { const int tn = (wid & 1) * 2 + j; f32x4 acc = (f32x4){0.f, 0.f, 0.f, 0.f};
#pragma unroll
            for (int k0 = 0; k0 < 96; k0 += 32) { const bf16x8 a = *(const LAS bf16x8*)(SG + (16 * tm + r16) * 104 + k0 + q4 * 8);
                const bf16x8 bb = *(const bf16x8*)(sw.G2T + (size_t)(h * 64 + 16 * tn + r16) * 96 + k0 + q4 * 8); acc = MFMA16(a, bb, acc); }
#pragma unroll
            for (int e = 0; e < 4; ++e) GATE[(size_t)row_of(b, 0, ci, 16 * tm + 4 * q4 + e) * 512 + h * 64 + 16 * tn + r16] = acc[e]; } }
    LDS_BARRIER();
    float av[8], bv[8], kd[8], lw[8];
#ifdef S1DBG
    float dbgv[8];
#endif
    { const int hc = h * 64 + sub * 8; float ss = 0.f, bon = 0.f, kk[8], al[8];
#pragma unroll
      for (int e = 0; e < 8; ++e) { const int c = sub * 8 + e;
          const float wl = -softplusf_(-(sw.w0[dir * 512 + hc + e] + LWf[i * 65 + c])) - 0.5f; lw[e] = -__expf(wl);
          al[e] = sigmoidf_(sw.a0[dir * 512 + hc + e] + LAf[i * 65 + c]);
          kk[e] = kv[e] * sw.k_k[hc + e]; ss += kk[e] * kk[e]; }
      ss += sx<1>(ss); ss += sx<2>(ss); ss += sx<4>(ss);
      const float rn = rsqrtf(ss + 1e-12f);
#pragma unroll
      for (int e = 0; e < 8; ++e) { kk[e] *= rn; kd[e] = kv[e] * (1.f + (al[e] - 1.f) * sw.k_a[hc + e]); av[e] = -kk[e]; bv[e] = kk[e] * al[e]; bon += rv[e] * kd[e] * sw.r_k[hc + e];
#ifdef S1DBG
          dbgv[e] = (S1DBG == 1) ? al[e] : kk[e];
#endif
      }
      bon += sx<1>(bon); bon += sx<2>(bon); bon += sx<4>(bon);
      if (sub == 0) BONUSd[(size_t)R * 8 + h] = bon;
#pragma unroll
      for (int e = 0; e < 8; ++e) GC[i * 64 + sub * 8 + e] = lw[e]; }
    LDS_BARRIER();
    if (wid == 0) { float run = 0.f;
#pragma unroll 8
        for (int t = 0; t < 64; ++t) { run += GC[t * 64 + lane]; GC[t * 64 + lane] = run; } }
    LDS_BARRIER();
    { float at[8], bt[8], kt[8], qt[8], bh[8], kh[8];
#pragma unroll
      for (int e = 0; e < 8; ++e) { const int c = sub * 8 + e; const float Gi = GC[i * 64 + c], Gm = (i > 0) ? GC[(i - 1) * 64 + c] : 0.f, GL = GC[63 * 64 + c];
          const float eG = __expf(Gi), eGm = __expf(Gm), enG = __expf(-Gi), eLG = __expf(GL - Gi);
          at[e] = av[e] * eGm; bt[e] = bv[e] * enG; kt[e] = kd[e] * enG; qt[e] = rv[e] * eG;
#ifdef S1DBG
          qt[e] = dbgv[e];
#endif
          bh[e] = bv[e] * eLG; kh[e] = kd[e] * eLG;
          if (i == 63) ((float*)(task + 57344))[c] = eG; }
      *(LAS u32x4*)(AT + i * 72 + sub * 8) = pack8f(at); *(LAS u32x4*)(BT + i * 72 + sub * 8) = pack8f(bt); *(LAS u32x4*)(KT + i * 72 + sub * 8) = pack8f(kt); *(LAS u32x4*)(QT + i * 72 + sub * 8) = pack8f(qt);
#pragma unroll
      for (int e = 0; e < 8; ++e) { const int c = sub * 8 + e; ATT[c * 72 + i] = f2bf(at[e]); VT[c * 72 + i] = f2bf(vv[e]); KHT[c * 72 + i] = f2bf(kh[e]); BHT[c * 72 + i] = f2bf(bh[e]); } }
    LDS_BARRIER();
    { const int mat = wid >> 1;
      const LAS bf16* Am = (mat < 2) ? AT : QT; const LAS bf16* Bm = (mat == 0 || mat == 2) ? BT : KT;
#pragma unroll 1
      for (int j = 0; j < 8; ++j) { const int idx = (wid & 1) * 8 + j, tm = idx >> 2, tn = idx & 3;
          f32x4 acc = (f32x4){0.f, 0.f, 0.f, 0.f};
          if (tm >= tn) acc = mm_tile<64>(Am, 72, Bm, 72, tm, tn, acc, lane);
#pragma unroll
          for (int e = 0; e < 4; ++e) { const int ti = 16 * tm + 4 * q4 + e, tj = 16 * tn + r16; const bool keep = (mat < 2) ? (ti > tj) : (ti >= tj); const float v = keep ? acc[e] : 0.f;
              if (mat == 0) AAB[ti * 65 + tj] = v; else if (mat == 1) AAK[ti * 72 + tj] = f2bf(v); else if (mat == 3) AQK[ti * 72 + tj] = f2bf(v); else ((bf16*)(task + 16384))[ti * 64 + tj] = f2bf(v); } } }
    LDS_BARRIER();
#pragma unroll 1
    for (int j = 0; j < 6; ++j) { const int idx = wid * 6 + j, mat = idx >> 4, tm = (idx >> 2) & 3, tn = idx & 3;
        const LAS bf16* Am = (mat == 0) ? AAK : (mat == 1) ? AQK : KHT;
        const f32x4 acc = mm_tile<64>(Am, 72, VT, 72, tm, tn, (f32x4){0.f, 0.f, 0.f, 0.f}, lane);
        if (mat == 0) { u32x2 o; o.x = pk2(acc[0], acc[1]); o.y = pk2(acc[2], acc[3]); *(LAS u32x2*)(XT + (16 * tn + r16) * 72 + 16 * tm + 4 * q4) = o; }
        else { bf16* dst = (bf16*)(task + (mat == 1 ? 40960 : 49152));
#pragma unroll
            for (int e = 0; e < 4; ++e) dst[(16 * tm + 4 * q4 + e) * 64 + 16 * tn + r16] = f2bf(acc[e]); } }
    *(u32x4*)(task + 8192 + (size_t)tid * 16) = *(const LAS u32x4*)(QT + (tid >> 3) * 72 + (tid & 7) * 8);
    *(u32x4*)(task + 24576 + (size_t)tid * 16) = *(const LAS u32x4*)(BHT + (tid >> 3) * 72 + (tid & 7) * 8);
    LDS_BARRIER();
    inv_blocked(AAB, TF, TT, INVS, wid, lane, tid);
    { const int mat = wid >> 2, tm = wid & 3; bf16* dst = (bf16*)(task + (mat ? 32768 : 0));
#pragma unroll 1
      for (int tn = 0; tn < 4; ++tn) { const f32x4 acc = mm_tile<64>(TT, 72, mat ? XT : ATT, 72, tm, tn, (f32x4){0.f, 0.f, 0.f, 0.f}, lane);
#pragma unroll
          for (int e = 0; e < 4; ++e) dst[(16 * tm + 4 * q4 + e) * 64 + 16 * tn + r16] = f2bf(acc[e]); } }
    LDS_BARRIER();
}

DI void s1_gdn(LAS uchar* lds, const bf16* P, const ScanW& sw, uchar* task, int b, int h, int dir, int ci, int tid) {
    using namespace cf;
    LAS bf16* KL = (LAS bf16*)(lds + 0); LAS bf16* QL = (LAS bf16*)(lds + 17408);
    LAS bf16* VT = (LAS bf16*)(lds + 34816); LAS bf16* KBT = (LAS bf16*)(lds + 53248); LAS bf16* BHT = (LAS bf16*)(lds + 71680);
    LAS bf16* TT = (LAS bf16*)(lds + 90112); LAS float* AAB = (LAS float*)(lds + 99328); LAS float* TF = (LAS float*)(lds + 115968);
    LAS float* INVS = (LAS float*)(lds + 132608); LAS float* gvec = (LAS float*)(lds + 136960);
    const int lane = tid & 63, wid = tid >> 6, i = tid >> 3, sub = tid & 7, r16 = lane & 15, q4 = lane >> 4;
    const int R = row_of(b, dir, ci, i), seg_lo = b * SEGT + (ci < 4 ? 0 : CTX), seg_hi = b * SEGT + (ci < 4 ? CTX : SEGT);
    const bf16* pr = P + (size_t)R * PC + C_GD;
    float qv[16], kv[16], vv[16];
#pragma unroll
    for (int w = 0; w < 3; ++w) { const int col = w * 512 + h * 128 + sub * 16; float acc[16];
#pragma unroll
        for (int e = 0; e < 16; ++e) acc[e] = 0.f;
#pragma unroll
        for (int j = 0; j < 5; ++j) { const int Rj = R + j - 2;
            if (Rj >= seg_lo && Rj < seg_hi) { float x[16]; float xa[8], xb[8];
                unpack8(*(const u32x4*)(pr + (ptrdiff_t)(j - 2) * PC + col), xa); unpack8(*(const u32x4*)(pr + (ptrdiff_t)(j - 2) * PC + col + 8), xb);
#pragma unroll
                for (int e = 0; e < 8; ++e) { x[e] = xa[e]; x[8 + e] = xb[e]; }
                const float* cw = sw.conv + (size_t)j * 1536 + col;
#pragma unroll
                for (int e4 = 0; e4 < 4; ++e4) { const f32x4 c4 = *(const f32x4*)(cw + 4 * e4);
#pragma unroll
                    for (int e = 0; e < 4; ++e) acc[4 * e4 + e] += c4[e] * x[4 * e4 + e]; } } }
#pragma unroll
        for (int e = 0; e < 16; ++e) { const float x = acc[e] * sigmoidf_(acc[e]); if (w == 0) qv[e] = x; else if (w == 1) kv[e] = x; else vv[e] = x; } }
    { float sq = 0.f, sk = 0.f;
#pragma unroll
      for (int e = 0; e < 16; ++e) { sq += qv[e] * qv[e]; sk += kv[e] * kv[e]; }
      sq += sx<1>(sq); sq += sx<2>(sq); sq += sx<4>(sq); sk += sx<1>(sk); sk += sx<2>(sk); sk += sx<4>(sk);
      const float rq = rsqrtf(sq + 1e-12f) * 0.08838834764831845f, rk = rsqrtf(sk + 1e-12f);
#pragma unroll
      for (int e = 0; e < 16; ++e) { qv[e] *= rq; kv[e] *= rk; } }
    if (sub == 0) { const float a_raw = bf2f(pr[GD_A + dir * 4 + h]), b_raw = bf2f(pr[GD_B + dir * 4 + h]);
        gvec[i] = -__expf(sw.a_log[dir * 4 + h]) * softplusf_(a_raw + sw.dt_bias[dir * 4 + h]); gvec[64 + i] = sigmoidf_(b_raw); }
    { float t0[8], t1[8];
#pragma unroll
      for (int e = 0; e < 8; ++e) { t0[e] = kv[e]; t1[e] = kv[8 + e]; }
      *(LAS u32x4*)(KL + i * 136 + sub * 16) = pack8f(t0); *(LAS u32x4*)(KL + i * 136 + sub * 16 + 8) = pack8f(t1);
#pragma unroll
      for (int e = 0; e < 8; ++e) { t0[e] = qv[e]; t1[e] = qv[8 + e]; }
      *(LAS u32x4*)(QL + i * 136 + sub * 16) = pack8f(t0); *(LAS u32x4*)(QL + i * 136 + sub * 16 + 8) = pack8f(t1); }
    LDS_BARRIER();
    if (wid == 0) { float g = 0.f;
#pragma unroll 8
        for (int t = 0; t < 64; ++t) { const float x = gvec[t]; g += (t <= lane) ? x : 0.f; }
        gvec[128 + lane] = g; }
    LDS_BARRIER();
    { const float Gi = gvec[128 + i], GL = gvec[128 + 63], be = gvec[64 + i], eG = __expf(Gi), eLG = __expf(GL - Gi), beG = be * eG;
      float t0[8], t1[8];
#pragma unroll
      for (int e = 0; e < 8; ++e) { t0[e] = qv[e] * eG; t1[e] = qv[8 + e] * eG; }
      *(u32x4*)(task + 16384 + ((size_t)i * 128 + sub * 16) * 2) = pack8f(t0); *(u32x4*)(task + 16384 + ((size_t)i * 128 + sub * 16 + 8) * 2) = pack8f(t1);
#pragma unroll
      for (int e = 0; e < 16; ++e) { const int c = sub * 16 + e; VT[c * 72 + i] = f2bf(be * vv[e]); KBT[c * 72 + i] = f2bf(beG * kv[e]); BHT[c * 72 + i] = f2bf(kv[e] * eLG); }
      if (tid < 128) ((float*)(task + 73728))[tid] = __expf(GL); }
#pragma unroll 1
    for (int j = 0; j < 4; ++j) { const int idx = wid * 4 + j, mat = idx >> 4, tm = (idx >> 2) & 3, tn = idx & 3;
        f32x4 acc = (f32x4){0.f, 0.f, 0.f, 0.f};
        if (tm >= tn) acc = mm_tile<128>(mat ? QL : KL, 136, KL, 136, tm, tn, acc, lane);
        const float Gj = gvec[128 + 16 * tn + r16];
#pragma unroll
        for (int e = 0; e < 4; ++e) { const int ti = 16 * tm + 4 * q4 + e, tj = 16 * tn + r16; const float dec = __expf(fminf(gvec[128 + ti] - Gj, 0.f));
            if (mat == 0) AAB[ti * 65 + tj] = (ti > tj) ? -gvec[64 + ti] * acc[e] * dec : 0.f;
            else ((bf16*)(task + 32768))[ti * 64 + tj] = f2bf((ti >= tj) ? acc[e] * dec : 0.f); } }
    LDS_BARRIER();
    inv_blocked(AAB, TF, TT, INVS, wid, lane, tid);
#pragma unroll 1
    for (int j = 0; j < 8; ++j) { const int idx = wid * 8 + j, mat = idx >> 5, tm = (idx >> 3) & 3, tn = idx & 7;
        const f32x4 acc = mm_tile<64>(TT, 72, mat ? KBT : VT, 72, tm, tn, (f32x4){0.f, 0.f, 0.f, 0.f}, lane);
        bf16* dst = (bf16*)(task + (mat ? 0 : 57344)); const float sgn = mat ? -1.f : 1.f;
#pragma unroll
        for (int e = 0; e < 4; ++e) dst[(16 * tm + 4 * q4 + e) * 128 + 16 * tn + r16] = f2bf(sgn * acc[e]); }
#pragma unroll
    for (int j = 0; j < 2; ++j) { const int ch = tid + 512 * j, row = ch >> 3, c8 = ch & 7; *(u32x4*)(task + 40960 + (size_t)ch * 16) = *(const LAS u32x4*)(BHT + row * 72 + c8 * 8); }
    LDS_BARRIER();
}

template <int NK, bool LOC> struct S2Frag { bf16x8 wt[NK / 32], qt[NK / 32], aqb[2], bht[2]; bf16 ul[2][4], yl[2][4], kl[NK / 32][4]; f32x4 gl; };
template <int NK, bool LOC>
DI void s2_load(S2Frag<NK, LOC>& f, const uchar* task, int o_wt, int o_qt, int o_aqb, int o_bht, int o_ul, int ldu, int ucol0, int o_yl, int o_kl, int o_gl, int tm, int tn0, int cm, int ctn0, int lane) {
    const int r16 = lane & 15, q4 = lane >> 4;
#pragma unroll
    for (int k = 0; k < NK / 32; ++k) { f.wt[k] = *(const bf16x8*)(task + o_wt + ((size_t)(16 * tm + r16) * NK + k * 32 + q4 * 8) * 2); f.qt[k] = *(const bf16x8*)(task + o_qt + ((size_t)(16 * tm + r16) * NK + k * 32 + q4 * 8) * 2); }
#pragma unroll
    for (int k = 0; k < 2; ++k) { f.aqb[k] = *(const bf16x8*)(task + o_aqb + ((size_t)(16 * tm + r16) * 64 + k * 32 + q4 * 8) * 2); f.bht[k] = *(const bf16x8*)(task + o_bht + ((size_t)(16 * cm + r16) * 64 + k * 32 + q4 * 8) * 2); }
#pragma unroll
    for (int j = 0; j < 2; ++j)
#pragma unroll
        for (int e = 0; e < 4; ++e) { f.ul[j][e] = *(const bf16*)(task + o_ul + ((size_t)(16 * tm + 4 * q4 + e) * ldu + ucol0 + 16 * (tn0 + j) + r16) * 2);
            if (LOC) f.yl[j][e] = *(const bf16*)(task + o_yl + ((size_t)(16 * tm + 4 * q4 + e) * 64 + 16 * (tn0 + j) + r16) * 2); }
    if (LOC) {
#pragma unroll
        for (int j = 0; j < NK / 32; ++j)
#pragma unroll
            for (int e = 0; e < 4; ++e) f.kl[j][e] = *(const bf16*)(task + o_kl + ((size_t)(16 * cm + 4 * q4 + e) * 64 + 16 * (ctn0 + j) + r16) * 2);
    }
    f.gl = *(const f32x4*)(task + o_gl + (size_t)(16 * cm + 4 * q4) * 4);
}
template <int NK, bool LOC>
DI void s2_scan(LAS uchar* lds, const uchar* task0, int task_bytes, int o_wt, int o_qt, int o_aqb, int o_bht, int o_ul, int ldu, int ucol0, int o_yl, int o_kl, int o_gl,
                float* Y, int ycol0, int b, int dir, int tid) {
    constexpr int NH = NK / 32, LDH = NK + 8;
    LAS bf16* HT = (LAS bf16*)lds;
    LAS bf16* UT = (LAS bf16*)(lds + 2 * 64 * LDH * 2);
    const int lane = tid & 63, wid = tid >> 6, r16 = lane & 15, q4 = lane >> 4;
    const int tm = wid >> 1, tn0 = (wid & 1) * 2;
    const int cm = (NK == 64) ? (wid >> 1) : wid, ctn0 = (NK == 64) ? (wid & 1) * 2 : 0;
    for (int i = tid; i < 64 * LDH * 2 / 16; i += 512) ((LAS u32x4*)HT)[i] = (u32x4){0u, 0u, 0u, 0u};
    f32x4 H[NH];
#pragma unroll
    for (int j = 0; j < NH; ++j) H[j] = (f32x4){0.f, 0.f, 0.f, 0.f};
    S2Frag<NK, LOC> cur;
    s2_load<NK, LOC>(cur, task0, o_wt, o_qt, o_aqb, o_bht, o_ul, ldu, ucol0, o_yl, o_kl, o_gl, tm, tn0, cm, ctn0, lane);
    LDS_BARRIER();
#pragma unroll 1
    for (int ci = 0; ci < cf::NCH; ++ci) {
        S2Frag<NK, LOC> nxt;
        { const int cn = (ci + 1 < cf::NCH) ? ci + 1 : ci;
          s2_load<NK, LOC>(nxt, task0 + (size_t)cn * task_bytes, o_wt, o_qt, o_aqb, o_bht, o_ul, ldu, ucol0, o_yl, o_kl, o_gl, tm, tn0, cm, ctn0, lane); }
        const LAS bf16* Hc = HT + (ci & 1) * 64 * LDH; LAS bf16* Hn = HT + ((ci + 1) & 1) * 64 * LDH;
        f32x4 U[2], Yv[2];
#pragma unroll
        for (int j = 0; j < 2; ++j) {
            U[j] = (f32x4){bf2f(cur.ul[j][0]), bf2f(cur.ul[j][1]), bf2f(cur.ul[j][2]), bf2f(cur.ul[j][3])};
            Yv[j] = LOC ? (f32x4){bf2f(cur.yl[j][0]), bf2f(cur.yl[j][1]), bf2f(cur.yl[j][2]), bf2f(cur.yl[j][3])} : (f32x4){0.f, 0.f, 0.f, 0.f};
#pragma unroll
            for (int k = 0; k < NK / 32; ++k) { const bf16x8 hb = *(const LAS bf16x8*)(Hc + (16 * (tn0 + j) + r16) * LDH + k * 32 + q4 * 8);
                U[j] = MFMA16(cur.wt[k], hb, U[j]); Yv[j] = MFMA16(cur.qt[k], hb, Yv[j]); }
            u32x2 o; o.x = pk2(U[j][0], U[j][1]); o.y = pk2(U[j][2], U[j][3]);
            *(LAS u32x2*)(UT + (16 * (tn0 + j) + r16) * 72 + 16 * tm + 4 * q4) = o;
        }
        LDS_BARRIER();
#pragma unroll
        for (int j = 0; j < 2; ++j) {
#pragma unroll
            for (int k = 0; k < 2; ++k) { const bf16x8 ub = *(const LAS bf16x8*)(UT + (16 * (tn0 + j) + r16) * 72 + k * 32 + q4 * 8); Yv[j] = MFMA16(cur.aqb[k], ub, Yv[j]); }
#pragma unroll
            for (int e = 0; e < 4; ++e) Y[(size_t)row_of(b, dir, ci, 16 * tm + 4 * q4 + e) * 512 + ycol0 + 16 * (tn0 + j) + r16] = Yv[j][e];
        }
#pragma unroll
        for (int j = 0; j < NH; ++j) {
            f32x4 h = H[j] * cur.gl;
            if (LOC) h += (f32x4){bf2f(cur.kl[j][0]), bf2f(cur.kl[j][1]), bf2f(cur.kl[j][2]), bf2f(cur.kl[j][3])};
#pragma unroll
            for (int k = 0; k < 2; ++k) { const bf16x8 ub = *(const LAS bf16x8*)(UT + (16 * (ctn0 + j) + r16) * 72 + k * 32 + q4 * 8); h = MFMA16(cur.bht[k], ub, h); }
            H[j] = h;
            u32x2 o; o.x = pk2(h[0], h[1]); o.y = pk2(h[2], h[3]);
            *(LAS u32x2*)(Hn + (16 * (ctn0 + j) + r16) * LDH + 16 * cm + 4 * q4) = o;
        }
        LDS_BARRIER();
        cur = nxt;
    }
}
namespace at {
constexpr int DQ = 192, DV = 128, NW = 8, QBLK = 32, KVBLK = 64;
constexpr float SCALE = 0.07216878364870322f;
constexpr float THR = 8.f;
constexpr int SHM_V = KVBLK * DV * 2, SHM_K = KVBLK * DQ * 2, SHM_Q = NW * 8 * 1024, SHM_ATTN = 2 * SHM_V + 2 * SHM_K + NW * 64 * 4 + SHM_Q;
#define KSWZ(row, colB) ((row) * 384 + ((colB) ^ (((row) & 7) << 4)))
#define SBAR() __builtin_amdgcn_sched_barrier(0)
DI int crow(int r, int hi) { return (r & 3) + 8 * (r >> 2) + 4 * hi; }
DI unsigned cvtpk(float lo, float hi) { const f32x2 v = {lo, hi}; return __builtin_bit_cast(unsigned, __builtin_convertvector(v, bf16x2_t)); }
DI void partialSM(f32x16& p0, f32x16& p1, float& m_reg, float& mn, float& alpha) {
  constexpr float C = SCALE * 1.4426950408889634f;
  float pmax = p0[0];
#pragma unroll
  for (int r = 1; r < 16; ++r) pmax = fmaxf(pmax, p0[r]);
#pragma unroll
  for (int r = 0; r < 16; ++r) pmax = fmaxf(pmax, p1[r]);
  { auto rr = __builtin_amdgcn_permlane32_swap(__float_as_uint(pmax), __float_as_uint(pmax), false, false);
    pmax = fmaxf(__uint_as_float(rr[0]), __uint_as_float(rr[1])); }
  if (__builtin_expect(__all(pmax - m_reg <= THR / SCALE), 1)) { mn = m_reg; alpha = 1.f; }
  else { mn = fmaxf(m_reg, pmax); alpha = __builtin_amdgcn_exp2f((m_reg - mn) * C); m_reg = mn; }
  float mnC = -mn * C;
#pragma unroll
  for (int r = 0; r < 16; ++r) p0[r] = fmaf(p0[r], C, mnC);
#pragma unroll
  for (int r = 0; r < 16; ++r) p1[r] = fmaf(p1[r], C, mnC);
#pragma unroll
  for (int r = 0; r < 16; ++r) p0[r] = __builtin_amdgcn_exp2f(p0[r]);
}
DI void finishSM(f32x16& p0, f32x16& p1, float alpha, float& l_reg, bf16x8& pa0, bf16x8& pa1, bf16x8& pa2, bf16x8& pa3) {
#pragma unroll
  for (int r = 0; r < 16; ++r) p1[r] = __builtin_amdgcn_exp2f(p1[r]);
  float ps = 0;
#pragma unroll
  for (int r = 0; r < 16; ++r) ps += p0[r];
#pragma unroll
  for (int r = 0; r < 16; ++r) ps += p1[r];
  { auto rr = __builtin_amdgcn_permlane32_swap(__float_as_uint(ps), __float_as_uint(ps), false, false);
    ps = __uint_as_float(rr[0]) + __uint_as_float(rr[1]); }
  l_reg = l_reg * alpha + ps;
#define PK4(P, BASE, OUT) do { unsigned a0 = cvtpk(P[BASE + 0], P[BASE + 1]), a1 = cvtpk(P[BASE + 2], P[BASE + 3]);   \
    unsigned b0 = cvtpk(P[BASE + 4], P[BASE + 5]), b1 = cvtpk(P[BASE + 6], P[BASE + 7]);                              \
    auto r0 = __builtin_amdgcn_permlane32_swap(a0, b0, false, false); auto r1 = __builtin_amdgcn_permlane32_swap(a1, b1, false, false); \
    u32x4 w = {r0[0], r1[0], r0[1], r1[1]}; OUT = *reinterpret_cast<bf16x8*>(&w); } while (0)
  PK4(p0, 0, pa0); PK4(p0, 8, pa1); PK4(p1, 0, pa2); PK4(p1, 8, pa3);
#undef PK4
}
constexpr int NQR = 4;
DI void qkt(f32x16& p0, f32x16& p1, const LAS char* Ks, const bf16x8* qr, const LAS char* qlds, int r32, int hi) {
  p0 = f32x16{}; p1 = f32x16{};
#pragma unroll
  for (int d0 = 0; d0 < 12; ++d0) { int cb = (d0 * 16 + hi * 8) * 2;
    const bf16x8 qf = (d0 < NQR) ? qr[d0] : *(const LAS bf16x8*)(qlds + (d0 - NQR) * 1024);
    bf16x8 b0 = *(const LAS bf16x8*)(Ks + KSWZ(r32, cb));
    bf16x8 b1 = *(const LAS bf16x8*)(Ks + KSWZ(32 + r32, cb));
    p0 = __builtin_amdgcn_mfma_f32_32x32x16_bf16(b0, qf, p0, 0, 0, 0);
    p1 = __builtin_amdgcn_mfma_f32_32x32x16_bf16(b1, qf, p1, 0, 0, 0); }
}
DI int v_st(int k, int c) { const int kk = (k & ~0xC) | ((k & 4) << 1) | ((k & 8) >> 1); return ((kk >> 3) * 4 + (c >> 5)) * 512 + ((kk & 7) * 32 + (c & 31)) * 2; }
DI int v_rd_base(int lane) { return ((lane & 3) << 3) | (((lane >> 2) & 3) << 6) | (((lane >> 4) & 1) << 5) | (((lane >> 5) & 1) << 8); }
constexpr int v_rd_off(int d0, int ks, int half) { return d0 * 512 + ks * 4096 + half * 2048; }
template <int OFF> DI s16x4 tr_read(int vb) { s16x4 r; asm volatile("ds_read_b64_tr_b16 %0, %1 offset:%2" : "=&v"(r) : "v"(vb), "i"(OFF) : "memory"); return r; }
template <int D0> DI void pv_one(f32x16& od, int vb, bf16x8 pa0, bf16x8 pa1, bf16x8 pa2, bf16x8 pa3) {
  const s16x4 l0 = tr_read<v_rd_off(D0, 0, 0)>(vb), h0 = tr_read<v_rd_off(D0, 0, 1)>(vb), l1 = tr_read<v_rd_off(D0, 1, 0)>(vb), h1 = tr_read<v_rd_off(D0, 1, 1)>(vb);
  const s16x4 l2 = tr_read<v_rd_off(D0, 2, 0)>(vb), h2 = tr_read<v_rd_off(D0, 2, 1)>(vb), l3 = tr_read<v_rd_off(D0, 3, 0)>(vb), h3 = tr_read<v_rd_off(D0, 3, 1)>(vb);
  asm volatile("s_waitcnt lgkmcnt(0)" ::: "memory"); SBAR();
#define PK(L, H) (bf16x8){L[0], L[1], L[2], L[3], H[0], H[1], H[2], H[3]}
  od = __builtin_amdgcn_mfma_f32_32x32x16_bf16(pa0, PK(l0, h0), od, 0, 0, 0);
  od = __builtin_amdgcn_mfma_f32_32x32x16_bf16(pa1, PK(l1, h1), od, 0, 0, 0);
  od = __builtin_amdgcn_mfma_f32_32x32x16_bf16(pa2, PK(l2, h2), od, 0, 0, 0);
  od = __builtin_amdgcn_mfma_f32_32x32x16_bf16(pa3, PK(l3, h3), od, 0, 0, 0);
#undef PK
}
DI void pv_d0(f32x16* o, int vb, bf16x8 pa0, bf16x8 pa1, bf16x8 pa2, bf16x8 pa3) {
  pv_one<0>(o[0], vb, pa0, pa1, pa2, pa3); pv_one<1>(o[1], vb, pa0, pa1, pa2, pa3); pv_one<2>(o[2], vb, pa0, pa1, pa2, pa3); pv_one<3>(o[3], vb, pa0, pa1, pa2, pa3);
}
DI void attn_unit(const bf16* __restrict__ Qb, const bf16* __restrict__ Kh, const bf16* __restrict__ Vh, bf16* __restrict__ Ob, int seq, const float* rope, int pos0, LAS char* lds, const int tid) {
  constexpr int LDQ = cf::QP, LDKK = cf::KP, LDVV = cf::VP, LDO = cf::D;
  const int wid = tid >> 6, lane = tid & 63, r32 = lane & 31, hi = lane >> 5;
  LAS char* V_lds = lds; LAS char* K_lds = lds + 2 * SHM_V;
  LAS float* ws = (LAS float*)(lds + 2 * SHM_V + 2 * SHM_K) + wid * 64; LAS float* li_l = ws; LAS float* al_l = ws + 32;
  LAS char* qlds = lds + 2 * SHM_V + 2 * SHM_K + NW * 64 * 4 + wid * (12 - NQR) * 1024 + lane * 16;
  float m_reg = -1e30f, l_reg = 0; f32x16 o[4] = {}; bf16x8 qr[12];
  const bf16* Qw = Qb + (long)(wid * QBLK + r32) * LDQ + hi * 8;
#pragma unroll
  for (int d0 = 0; d0 < 12; ++d0) qr[d0] = *reinterpret_cast<const bf16x8*>(Qw + d0 * 16);
  if (rope) { const int t = pos0 + wid * QBLK + r32;
#pragma unroll
    for (int ax = 0; ax < 2; ++ax) { const int pos = ax ? (t & 63) : (t >> 6);
      const f32x4 c0 = *(const f32x4*)(rope + pos * 16 + hi * 8), c1 = *(const f32x4*)(rope + pos * 16 + hi * 8 + 4), s0 = *(const f32x4*)(rope + 1024 + pos * 16 + hi * 8), s1 = *(const f32x4*)(rope + 1024 + pos * 16 + hi * 8 + 4);
      float x1[8], x2[8], o1[8], o2[8]; unpack8(__builtin_bit_cast(u32x4, qr[8 + 2 * ax]), x1); unpack8(__builtin_bit_cast(u32x4, qr[9 + 2 * ax]), x2);
#pragma unroll
      for (int e = 0; e < 8; ++e) { const float c = e < 4 ? c0[e] : c1[e - 4], s = e < 4 ? s0[e] : s1[e - 4]; o1[e] = x1[e] * c - x2[e] * s; o2[e] = x1[e] * s + x2[e] * c; }
      qr[8 + 2 * ax] = __builtin_bit_cast(bf16x8, pack8f(o1)); qr[9 + 2 * ax] = __builtin_bit_cast(bf16x8, pack8f(o2)); } }
#pragma unroll
  for (int d0 = NQR; d0 < 12; ++d0) *(LAS bf16x8*)(qlds + (d0 - NQR) * 1024) = qr[d0];
  const int sr = tid >> 4, sc = (tid & 15) * 8, vst0 = v_st(sr, sc), vst1 = v_st(32 + sr, sc);
  int kr_[3], kc_[3];
#pragma unroll
  for (int j = 0; j < 3; ++j) { const int q = tid + 512 * j; kr_[j] = q / 24; kc_[j] = (q % 24) * 8; }
  const int vb0 = (int)(uintptr_t)V_lds + v_rd_base(lane);
  bf16x8 vs0 = {}, vs1 = {}, ks0 = {}, ks1 = {}, ks2 = {};
#define SLOAD(k0) do { vs0 = *(const bf16x8*)(&Vh[(long)((k0) + sr) * LDVV + sc]); vs1 = *(const bf16x8*)(&Vh[(long)((k0) + 32 + sr) * LDVV + sc]); \
    ks0 = *(const bf16x8*)(&Kh[(long)((k0) + kr_[0]) * LDKK + kc_[0]]); ks1 = *(const bf16x8*)(&Kh[(long)((k0) + kr_[1]) * LDKK + kc_[1]]); ks2 = *(const bf16x8*)(&Kh[(long)((k0) + kr_[2]) * LDKK + kc_[2]]); } while (0)
#define SWRITE(b) do { *(LAS bf16x8*)(V_lds + (b) * SHM_V + vst0) = vs0; *(LAS bf16x8*)(V_lds + (b) * SHM_V + vst1) = vs1; \
    *(LAS bf16x8*)(K_lds + (b) * SHM_K + KSWZ(kr_[0], kc_[0] * 2)) = ks0; *(LAS bf16x8*)(K_lds + (b) * SHM_K + KSWZ(kr_[1], kc_[1] * 2)) = ks1; *(LAS bf16x8*)(K_lds + (b) * SHM_K + KSWZ(kr_[2], kc_[2] * 2)) = ks2; } while (0)
#define SWAIT() asm volatile("s_waitcnt vmcnt(0)" ::: "memory")
#define RESC(a) do { if (__any((a) < 1.f)) { if (hi == 0) al_l[r32] = (a); asm volatile("s_waitcnt lgkmcnt(0)" ::: "memory"); \
    _Pragma("unroll") for (int d = 0; d < 4; ++d) _Pragma("unroll") for (int r = 0; r < 16; ++r) o[d][r] *= al_l[crow(r, hi)]; } } while (0)
  f32x16 pA0 = {}, pA1 = {}, pB0 = {}, pB1 = {}; float mnA = 0.f, mnB = 0.f, alA = 1.f, alB = 1.f; bf16x8 pa0 = {}, pa1 = {}, pa2 = {}, pa3 = {}; const int NT = seq / KVBLK;
  SLOAD(0); SWAIT(); SWRITE(0); __syncthreads();
  qkt(pA0, pA1, K_lds, qr, qlds, r32, hi); partialSM(pA0, pA1, m_reg, mnA, alA);
  SLOAD(KVBLK);
  SWAIT(); SWRITE(1); __syncthreads();
  for (int j = 1; j + 1 < NT; j += 2) {
    SBAR(); qkt(pB0, pB1, K_lds + SHM_K, qr, qlds, r32, hi);
    finishSM(pA0, pA1, alA, l_reg, pa0, pa1, pa2, pa3); SBAR();
    SLOAD((j + 1) * KVBLK); SBAR();
    pv_d0(o, vb0, pa0, pa1, pa2, pa3); partialSM(pB0, pB1, m_reg, mnB, alB);
    __syncthreads(); SWAIT(); SWRITE(0);
    RESC(alB); __syncthreads();
    SBAR(); qkt(pA0, pA1, K_lds, qr, qlds, r32, hi);
    finishSM(pB0, pB1, alB, l_reg, pa0, pa1, pa2, pa3); SBAR();
    SLOAD((j + 2) * KVBLK); SBAR();
    pv_d0(o, vb0 + (int)SHM_V, pa0, pa1, pa2, pa3); partialSM(pA0, pA1, m_reg, mnA, alA);
    __syncthreads(); SWAIT(); SWRITE(1);
    RESC(alA); __syncthreads();
  }
  SBAR(); qkt(pB0, pB1, K_lds + SHM_K, qr, qlds, r32, hi);
  finishSM(pA0, pA1, alA, l_reg, pa0, pa1, pa2, pa3); SBAR();
  pv_d0(o, vb0, pa0, pa1, pa2, pa3); partialSM(pB0, pB1, m_reg, mnB, alB);
  __syncthreads(); RESC(alB);
  finishSM(pB0, pB1, alB, l_reg, pa0, pa1, pa2, pa3); SBAR();
  pv_d0(o, vb0 + (int)SHM_V, pa0, pa1, pa2, pa3);
  if (hi == 0) li_l[r32] = l_reg; asm volatile("s_waitcnt lgkmcnt(0)" ::: "memory");
  float rli[16];
#pragma unroll
  for (int r = 0; r < 16; ++r) rli[r] = __builtin_amdgcn_rcpf(li_l[crow(r, hi)]);
  bf16* Ow = Ob + (long)(wid * QBLK) * LDO;
#pragma unroll
  for (int r = 0; r < 16; ++r) { int orow = crow(r, hi);
#pragma unroll
    for (int d0 = 0; d0 < 4; ++d0) Ow[(long)orow * LDO + d0 * 32 + r32] = f2bf(o[d0][r] * rli[r]); }
  __syncthreads();
#undef SLOAD
#undef SWRITE
#undef SWAIT
#undef RESC
}
#undef KSWZ
}
#if defined(PROBE)
DI void fatomic_max(unsigned* p, float v) { atomicMax(p, __builtin_bit_cast(unsigned, fabsf(v))); }
DI float pshift(const bf16* P, int R, int lo, int hi, int col, const float* mu, int mucol) {
    const float c = bf2f(P[(size_t)R * cf::PC + col]), p = (R - 1 >= lo) ? bf2f(P[(size_t)(R - 1) * cf::PC + col]) : 0.f, n = (R + 1 < hi) ? bf2f(P[(size_t)(R + 1) * cf::PC + col]) : 0.f;
    return c + (0.5f * (p + n) - c) * mu[mucol];
}
__global__ void __launch_bounds__(256) probe(In in, uchar* ws, unsigned* res, float* scratch) {
    using namespace cf;
    __shared__ float sh[4352 + 1024];
    const int tid = threadIdx.x, bx = blockIdx.x;
    const bf16* P = (const bf16*)(ws + WS_P); const bf16* Qb = (const bf16*)(ws + WS_Q); const bf16* Kb = (const bf16*)(ws + WS_K); const bf16* Vb = (const bf16*)(ws + WS_V); const bf16* MIX = (const bf16*)(ws + WS_XM);
    const float* YR = (const float*)(ws + WS_YR); const float* YG = (const float*)(ws + WS_YG);
    if (bx < 8) {
        const int h = bx, b = 1;
        for (int which = 0; which < 4; ++which) {
            const bool isctx = which == 3; const int t = which == 0 ? 0 : which == 1 ? 1000 : which == 2 ? 4095 : 5;
            const int row = b * SEGT + (isctx ? t : CTX + t), nkeys = isctx ? CTX : SEGT;
            if (tid < 192) { float q = bf2f(Qb[(size_t)row * QP + h * 192 + tid]); sh[4352 + tid] = q; }
            __syncthreads();
            if (tid < 192 && tid >= 128 && !isctx) { const int j = tid - 128, ax = j >> 5, half = (j >> 4) & 1, f = j & 15; const float pos = ax ? (float)(t & 63) : (float)(t >> 6);
                const float ang = pos * powf(10000.f, -(float)f / 16.f), c = cosf(ang), s = sinf(ang);
                const float x1 = sh[4352 + 128 + ax * 32 + f], x2 = sh[4352 + 128 + ax * 32 + 16 + f];
                sh[4352 + 512 + j] = half ? (x1 * s + x2 * c) : (x1 * c - x2 * s); }
            __syncthreads();
            if (tid < 64 && !isctx) sh[4352 + 128 + tid] = sh[4352 + 512 + tid];
            __syncthreads();
            for (int kk = tid; kk < nkeys; kk += 256) { const int krow = b * SEGT + kk; const bool kctx = kk < CTX; const int kt = kk - CTX;
                float s = 0.f;
                for (int d = 0; d < 128; ++d) s += sh[4352 + d] * bf2f(Kb[(size_t)krow * KP + h * 192 + d]);
                for (int j = 0; j < 64; ++j) { const int ax = j >> 5, half = (j >> 4) & 1, f = j & 15;
                    float kv;
                    if (kctx) kv = bf2f(P[(size_t)krow * PC + C_KR + j]);
                    else { const float pos = ax ? (float)(kt & 63) : (float)(kt >> 6), ang = pos * powf(10000.f, -(float)f / 16.f), c = cosf(ang), sn = sinf(ang);
                        const float x1 = bf2f(P[(size_t)krow * PC + C_KR + ax * 32 + f]), x2 = bf2f(P[(size_t)krow * PC + C_KR + ax * 32 + 16 + f]);
                        kv = half ? (x1 * sn + x2 * c) : (x1 * c - x2 * sn); }
                    s += sh[4352 + 128 + j] * kv; }
                sh[kk] = s * 0.07216878364870322f; }
            __syncthreads();
            float mx = -1e30f; for (int kk = 0; kk < nkeys; ++kk) mx = fmaxf(mx, sh[kk]);
            float den = 0.f; for (int kk = 0; kk < nkeys; ++kk) den += __expf(sh[kk] - mx);
            if (tid < 128) { float o = 0.f; for (int kk = 0; kk < nkeys; ++kk) o += __expf(sh[kk] - mx) * bf2f(Vb[(size_t)(b * SEGT + kk) * VP + h * 128 + tid]);
                o /= den; const float got = bf2f(MIX[(size_t)row * D + h * 128 + tid]); fatomic_max(res + 0, got - o); fatomic_max(res + 16, o); }
            __syncthreads();
        }
    } else if (bx < 10) {
        if (tid >= 64) return;
        const int b = 1, h = 3, dir = bx - 8, lane = tid, hc = h * 64 + lane;
        const float* mu = in.p[11]; float S[64]; float cumw = 1.f;
        const uchar* task = ws + WS_RWT + (size_t)((((b * 8 + h) * 2 + dir) * NCH) + 0) * RW_TASK;
#pragma unroll
        for (int k = 0; k < 64; ++k) S[k] = 0.f;
        for (int step = 0; step < SEGT; ++step) {
            const int R = row_of(b, dir, step >> 6, step & 63), s = R % SEGT, lo = b * SEGT + (s < CTX ? 0 : CTX), hi = b * SEGT + (s < CTX ? CTX : SEGT);
            const float r = pshift(P, R, lo, hi, C_RW + hc, mu, hc), k = pshift(P, R, lo, hi, C_RW + 512 + hc, mu, 512 + hc), v = pshift(P, R, lo, hi, C_RW + 1024 + hc, mu, 1024 + hc);
            if (lane < 32) { sh[lane] = tanhf(pshift(P, R, lo, hi, C_RW + RW_WD + dir * 32 + lane, mu, RW_WD + dir * 32 + lane)); sh[32 + lane] = pshift(P, R, lo, hi, C_RW + RW_AD + dir * 32 + lane, mu, RW_AD + dir * 32 + lane); }
            __builtin_amdgcn_s_waitcnt(0); __builtin_amdgcn_wave_barrier();
            float lw = in.p[12][dir * 512 + hc], la = in.p[14][dir * 512 + hc];
            for (int rr = 0; rr < 32; ++rr) { lw += sh[rr] * in.p[13][((size_t)dir * 32 + rr) * 512 + hc]; la += sh[32 + rr] * in.p[15][((size_t)dir * 32 + rr) * 512 + hc]; }
            const float wlog = -log1pf(expf(-lw)) - 0.5f, w = expf(-expf(wlog)), alr = 1.f / (1.f + expf(-la));
            float kk = k * in.p[17][hc]; sh[400 + lane] = kk * kk; __builtin_amdgcn_s_waitcnt(0); __builtin_amdgcn_wave_barrier(); float nn = 0.f; for (int jj = 0; jj < 64; ++jj) nn += sh[400 + jj]; kk *= rsqrtf(nn + 1e-12f);
            const float kd = k * (1.f + (alr - 1.f) * in.p[18][hc]), a = -kk, bb = kk * alr;
            if (dir == 0 && step < 64) { cumw *= w;
#ifdef S1DBG
                const float qt = (S1DBG == 1) ? alr : kk,
#else
                const float qt = r * cumw,
#endif
                got = bf2f(((const bf16*)(task + 8192))[step * 64 + lane]); fatomic_max(res + 9, got - qt); fatomic_max(res + 25, qt);
                scratch[(size_t)8 * SEGT * 64 + step * 64 + lane] = bb; scratch[(size_t)8 * SEGT * 64 + 4096 + step * 64 + lane] = cumw;
                if (step == 63) { const float gl = ((const float*)(task + 57344))[lane]; fatomic_max(res + 8, gl - cumw); fatomic_max(res + 24, cumw);
                    for (int t2 = 0; t2 < 64; ++t2) { const float bh = scratch[(size_t)8 * SEGT * 64 + t2 * 64 + lane] * cumw / scratch[(size_t)8 * SEGT * 64 + 4096 + t2 * 64 + lane], gb = bf2f(((const bf16*)(task + 24576))[lane * 64 + t2]); fatomic_max(res + 10, gb - bh); fatomic_max(res + 26, bh); } } }
            sh[64 + lane] = a; sh[128 + lane] = bb; sh[192 + lane] = kd; sh[256 + lane] = w; sh[320 + lane] = r;
            __builtin_amdgcn_s_waitcnt(0); __builtin_amdgcn_wave_barrier();
            float sa = 0.f;
#pragma unroll
            for (int kx = 0; kx < 64; ++kx) sa += S[kx] * sh[64 + kx];
            float y = 0.f;
#pragma unroll
            for (int kx = 0; kx < 64; ++kx) { S[kx] = S[kx] * sh[256 + kx] + sa * sh[128 + kx] + v * sh[192 + kx]; y += S[kx] * sh[320 + kx]; }
            scratch[((size_t)dir * SEGT + (R - b * SEGT)) * 64 + lane] = y;
            __builtin_amdgcn_s_waitcnt(0); __builtin_amdgcn_wave_barrier();
        }
    } else if (bx < 12) {
        const int b = 2, h = 1, dir = bx - 10, c = tid & 127;
        float S[128];
#pragma unroll
        for (int k = 0; k < 128; ++k) S[k] = 0.f;
        const float A = expf(in.p[23][dir * 4 + h]), dtb = in.p[24][dir * 4 + h];
        for (int step = 0; step < SEGT; ++step) {
            const int R = row_of(b, dir, step >> 6, step & 63), s = R % SEGT, lo = b * SEGT + (s < CTX ? 0 : CTX), hi = b * SEGT + (s < CTX ? CTX : SEGT);
            float x[3];
            for (int w = 0; w < 3; ++w) { float acc = 0.f; const int col = w * 512 + h * 128 + c;
                for (int j = 0; j < 5; ++j) { const int Rj = R + j - 2; if (Rj >= lo && Rj < hi) acc += in.p[22][(size_t)j * 1536 + col] * bf2f(P[(size_t)Rj * PC + C_GD + col]); }
                x[w] = acc / (1.f + expf(-acc)); }
            if (tid < 128) { sh[tid] = x[0] * x[0]; sh[128 + tid] = x[1] * x[1]; }
            __syncthreads();
            float sq = 0.f, sk = 0.f; for (int j = 0; j < 128; ++j) { sq += sh[j]; sk += sh[128 + j]; }
            __syncthreads();
            const float q = x[0] * rsqrtf(sq + 1e-12f) * 0.08838834764831845f, k = x[1] * rsqrtf(sk + 1e-12f), v = x[2];
            const float a_raw = bf2f(P[(size_t)R * PC + C_GD + GD_A + dir * 4 + h]), b_raw = bf2f(P[(size_t)R * PC + C_GD + GD_B + dir * 4 + h]);
            const float z = a_raw + dtb, g = -A * (z > 20.f ? z : log1pf(expf(z))), eg = expf(g), beta = 1.f / (1.f + expf(-b_raw));
            if (tid < 128) { sh[256 + tid] = k; sh[384 + tid] = q; }
            __syncthreads();
            if (tid < 128) { float ks = 0.f;
#pragma unroll
                for (int kx = 0; kx < 128; ++kx) ks += sh[256 + kx] * S[kx];
                float o = 0.f;
#pragma unroll
                for (int kx = 0; kx < 128; ++kx) { S[kx] = eg * (S[kx] - beta * sh[256 + kx] * ks) + beta * sh[256 + kx] * v; o += sh[384 + kx] * S[kx]; }
                scratch[(size_t)2 * SEGT * 64 + ((size_t)dir * SEGT + (R - b * SEGT)) * 128 + c] = o; }
            __syncthreads();
        }
    }
}
__global__ void probe_cmp(uchar* ws, unsigned* res, const float* scratch) {
    using namespace cf;
    const float* YR = (const float*)(ws + WS_YR); const float* YG = (const float*)(ws + WS_YG);
    for (int i = blockIdx.x * blockDim.x + threadIdx.x; i < SEGT * 64; i += gridDim.x * blockDim.x) { const int s = i >> 6, v = i & 63, b = 1, h = 3; const size_t row = (size_t)b * SEGT + s;
        const float r0 = scratch[(size_t)s * 64 + v], r1 = scratch[((size_t)SEGT + s) * 64 + v], g0 = YR[row * 512 + h * 64 + v], g1 = YR[((size_t)M + row) * 512 + h * 64 + v];
        fatomic_max(res + 1, (g0 + g1) - (r0 + r1)); fatomic_max(res + 17, r0 + r1);
        fatomic_max(res + 3, g0 - r0); fatomic_max(res + 19, r0);
        fatomic_max(res + 4, g1 - r1); fatomic_max(res + 20, r1);
        if (s < 64) { fatomic_max(res + 5, g0 - r0); fatomic_max(res + 21, r0); }
        if (s >= 64 && s < 128) { fatomic_max(res + 6, g0 - r0); fatomic_max(res + 22, r0); }
        if (s >= 256 && s < 320) { fatomic_max(res + 7, g0 - r0); fatomic_max(res + 23, r0); }
    }
    for (int i = blockIdx.x * blockDim.x + threadIdx.x; i < SEGT * 128; i += gridDim.x * blockDim.x) { const int s = i >> 7, v = i & 127, b = 2, h = 1; const size_t row = (size_t)b * SEGT + s;
        const float* sg = scratch + (size_t)2 * SEGT * 64;
        const float ref = sg[(size_t)s * 128 + v] + sg[((size_t)SEGT + s) * 128 + v], got = YG[row * 512 + h * 128 + v] + YG[((size_t)M + row) * 512 + h * 128 + v];
        fatomic_max(res + 2, got - ref); fatomic_max(res + 18, ref); }
}
__global__ void probe_out(float* out, const unsigned* res, int selA, int selB) {
    if (blockIdx.x == 0 && threadIdx.x == 0) {
        out[0] = 1.0e5f * __builtin_bit_cast(float, res[selA]) / __builtin_bit_cast(float, res[16 + selA]);
        out[1] = 1.0e5f * __builtin_bit_cast(float, res[selB]) / __builtin_bit_cast(float, res[16 + selB]); }
}
#endif
constexpr int NWAVES = 8, NPH = 3 + 9 * cf::DEPTH;
struct Args { In in; float* out; uchar* ws; int g_lo, g_hi; };
static_assert(sizeof(Args) == 34 * 8 + 8 + 8 + 8, "Args has no padding");

__global__ void __launch_bounds__(NWAVES * 64, 2) fwd(Args args) {
    using namespace cf;
    extern __shared__ __attribute__((aligned(16))) unsigned char lds_raw[];
    LAS uchar* lds = (LAS uchar*)lds_raw;
    const int bx = blockIdx.x, G = gridDim.x, wv = __builtin_amdgcn_readfirstlane(threadIdx.x >> 6);
    auto lane_now = [&]() { unsigned ones = ~0u; asm volatile("" : "+s"(ones)); return (int)__builtin_amdgcn_mbcnt_hi(ones, __builtin_amdgcn_mbcnt_lo(ones, 0u)); };
#define TID() (wv * 64 + lane_now())
    const In& in = args.in;
    volatile LAS unsigned* MISC = (volatile LAS unsigned*)(lds + MISC_OFF);
    { const int tid = threadIdx.x; if (tid < 32) MISC[tid] = 0u; }
    __syncthreads();
    const int g_lo = args.g_lo, g_hi = args.g_hi;
    unsigned* barw = (unsigned*)(args.ws + WS_CTL) + CW_BAR;
    if (g_hi - g_lo > 1) (void)xcd_barrier_post(barw, MISC + 8);
#ifndef PH_MASK
#define PH_MASK 0xfff
#endif
#define PHK(g) ((g) < 3 ? (g) : 3 + ((g) - 3) % 9)
#define OPQ(v) asm volatile("" : "+v"(v))
#define IN(g) (((PH_MASK >> PHK(g)) & 1) && args.g_lo <= (g) && (g) < args.g_hi)
#define SEAM(g) do { if (args.g_lo <= (g) && (g) + 1 < args.g_hi) { XcdBarrier bar_; bar_.bar = (unsigned*)(args.ws + WS_CTL) + CW_BAR; bar_.x = xb_xcc_id(); bar_.st = (volatile LAS unsigned*)(lds + MISC_OFF) + 8; xcd_barrier(bar_); } } while (0)

#define OPQS(v) asm volatile("" : "+s"(v))
#define LOCALS int l = lq; OPQS(l); size_t zq_ = 0; OPQS(zq_); uchar* ws = args.ws + zq_; float* X = (float*)(ws + WS_X); bf16* XM = (bf16*)(ws + WS_XM); bf16* P = (bf16*)(ws + WS_P); \
    bf16* CQN = (bf16*)(ws + WS_CQN); bf16* CKVN = (bf16*)(ws + WS_CKVN); bf16* Qb = (bf16*)(ws + WS_Q); bf16* Kb = (bf16*)(ws + WS_K); bf16* Vb = (bf16*)(ws + WS_V); \
    bf16* HFF = (bf16*)(ws + WS_HFF); float* YR = (float*)(ws + WS_YR); float* YG = (float*)(ws + WS_YG); float* GATE = (float*)(ws + WS_GATE); float* BONUS = (float*)(ws + WS_BONUS); \
    const float* MODV = (const float*)(ws + WS_MODV); const float* ROPE = (const float*)(ws + WS_ROPE); const float* modl = MODV + (size_t)l * 5 * MODS; \
    (void)X; (void)XM; (void)P; (void)CQN; (void)CKVN; (void)Qb; (void)Kb; (void)Vb; (void)HFF; (void)YR; (void)YG; (void)GATE; (void)BONUS; (void)ROPE; (void)modl; int t_ = TID(); OPQ(t_);

    if (IN(0)) { const int lq = 0; LOCALS; phase_prologue(in, ws, lds, G, bx, t_); }
    SEAM(0);
    if (IN(1)) { const int lq = 0; LOCALS; phase_modreduce(in, ws, G, bx, t_); }
    SEAM(1);
    if (IN(2)) { const int lq = 0; LOCALS; phase_modulate(X, XM, MODV, 0, D, G, bx, t_); }
    SEAM(2);

#pragma unroll 1
    for (int lq = 0; lq < DEPTH; ++lq) {
        const int g0 = 3 + 9 * lq;
        if (IN(g0 + 0)) { LOCALS;
            pg8::Gemm g{XM, (const bf16*)(ws + WS_WIN) + (size_t)l * PC * D, M, PC, D}; pg8::StaticOrder S; S.init(M, PC, G, bx);
            pg8::EpiStore E{P, PC};
            pg8::gemm_phase<pg8::EpiStore, pg8::StaticOrder, true, true>(lds, g, S, E, t_);
        }
        SEAM(g0 + 0);
        if (IN(g0 + 1)) { LOCALS;
#ifndef NO_MLAPREP
            mla_prep_rows(P, CQN, CKVN, Kb, in.p[7] + l * 512, in.p[8] + l * 512, ROPE, G, bx, t_);
#endif
            ScanW sw; sw.mu = in.p[11] + l * RW_COLS; sw.w0 = in.p[12] + l * 1024; sw.a0 = in.p[14] + l * 1024; sw.k_k = in.p[17] + l * 512; sw.k_a = in.p[18] + l * 512; sw.r_k = in.p[19] + l * 512;
            sw.W2T = (const bf16*)(ws + WS_W2T) + (size_t)l * 2 * 512 * 32; sw.A2T = (const bf16*)(ws + WS_A2T) + (size_t)l * 2 * 512 * 32; sw.G2T = (const bf16*)(ws + WS_G2T) + (size_t)l * 512 * 96;
            sw.conv = in.p[22] + l * 5 * 1536; sw.a_log = in.p[23] + l * 8; sw.dt_bias = in.p[24] + l * 8;
#pragma unroll 1
            for (int tk = bx; tk < 4352 + 2176; tk += G) { int tt = TID(); OPQ(tt);
#ifndef NO_S1R
                if (tk < 4352) { const int ci = tk % NCH, t2 = tk / NCH, dir = t2 & 1, h = (t2 >> 1) & 7, b = t2 >> 4;
                    s1_rwkv(lds, P, sw, ws + WS_RWT + (size_t)tk * RW_TASK, GATE, BONUS + (size_t)dir * M * 8, b, h, dir, ci, tt); }
#endif
#ifndef NO_S1G
                if (tk >= 4352) { const int tg = tk - 4352, ci = tg % NCH, t2 = tg / NCH, dir = t2 & 1, h = (t2 >> 1) & 3, b = t2 >> 3;
                    s1_gdn(lds, P, sw, ws + WS_GDT + (size_t)tg * GD_TASK, b, h, dir, ci, tt); }
#endif
            }
        }
        SEAM(g0 + 1);
        if (IN(g0 + 2)) { LOCALS;
            const bool split = G >= 256;
#pragma unroll 1
            for (int s = bx; s < 128; s += (split ? 1 << 20 : G)) {
#ifndef NO_S2R
                if (s < 64) { const int b = s >> 4, h = (s >> 1) & 7, dir = s & 1;
                    s2_scan<64, true>(lds, ws + WS_RWT + (size_t)(((b * 8 + h) * 2 + dir) * NCH) * RW_TASK, RW_TASK, 0, 8192, 16384, 24576, 32768, 64, 0, 40960, 49152, 57344,
                                      YR + (size_t)dir * M * 512, h * 64, b, dir, t_); }
#endif
#ifndef NO_S2G
                if (s >= 64) { const int g = s - 64, vs = g & 1, dir = (g >> 1) & 1, h = (g >> 2) & 3, b = g >> 4;
                    s2_scan<128, false>(lds, ws + WS_GDT + (size_t)(((b * 4 + h) * 2 + dir) * NCH) * GD_TASK, GD_TASK, 0, 16384, 32768, 40960, 57344, 128, vs * 64, 0, 0, 73728,
                                        YG + (size_t)dir * M * 512, h * 128 + vs * 64, b, dir, t_); }
#endif
                __syncthreads();
            }
            OPQ(t_);
#ifndef NO_UPGEMM
            if (!split || bx >= 128) { const int Gg = split ? G - 128 : G, cg = split ? bx - 128 : bx;
                { pg8::Gemm g{CQN, (const bf16*)(ws + WS_WUQ) + (size_t)l * 1536 * 512, M, 1536, 512}; pg8::StaticOrder S; S.init(M, 1536, Gg, cg);
                  pg8::EpiStore E{Qb, QP}; pg8::gemm_phase<pg8::EpiStore, pg8::StaticOrder, true, true>(lds, g, S, E, t_); }
                __syncthreads(); OPQ(t_);
                { pg8::Gemm g{CKVN, (const bf16*)(ws + WS_WUKV) + (size_t)l * 2048 * 512, M, 2048, 512}; pg8::StaticOrder S; S.init(M, 2048, Gg, cg);
                  pg8::EpiKV E{Kb, Vb}; pg8::gemm_phase<pg8::EpiKV, pg8::StaticOrder, true, true>(lds, g, S, E, t_); }
            }
#endif
        }
        SEAM(g0 + 2);
        if (IN(g0 + 3)) { LOCALS;
#ifndef NO_MIXROWS
            mix_rows(P, YR, YG, GATE, BONUS, XM, in.p[11] + l * RW_COLS, in.p[20] + l * 512, in.p[21] + l * 512, in.p[25] + l * 128, G, bx, t_);
#endif
#ifndef NO_ATTN
            const int nunits = 512 + (l < DEPTH - 1 ? 32 : 0);
#pragma unroll 1
            for (int u = bx; u < nunits; u += G) { int tt = TID(); OPQ(tt);
                if (u < 512) { const int x = u & 7, j = u >> 3, bh = x + 8 * (j >> 4), qb = j & 15, b = bh >> 3, h = bh & 7;
                    const size_t qrow = (size_t)b * SEGT + CTX + qb * 256, krow = (size_t)b * SEGT;
                    at::attn_unit(Qb + qrow * QP + h * 192, Kb + krow * KP + h * 192, Vb + krow * VP + h * 128, XM + qrow * D + h * 128, SEGT, ROPE, qb * 256, (LAS char*)lds, tt); }
                else { const int bh = u - 512, b = bh >> 3, h = bh & 7; const size_t qrow = (size_t)b * SEGT;
                    at::attn_unit(Qb + qrow * QP + h * 192, Kb + qrow * KP + h * 192, Vb + qrow * VP + h * 128, XM + qrow * D + h * 128, CTX, nullptr, 0, (LAS char*)lds, tt); }
            }
#endif
        }
        SEAM(g0 + 3);
        if (IN(g0 + 4)) { LOCALS;
            pg8::Gemm g{XM, (const bf16*)(ws + WS_WOUT) + (size_t)l * D * D, M, D, D}; pg8::StaticOrder S; S.init(M, D, G, bx);
            float alpha_ = ALPHA; OPQ(alpha_); pg8::EpiRes E{X, modl + 2 * D, MODS, alpha_};
            pg8::gemm_phase<pg8::EpiRes, pg8::StaticOrder, true, true>(lds, g, S, E, t_);
        }
        SEAM(g0 + 4);
        if (IN(g0 + 5)) { LOCALS; phase_ln(X, in.p[27] + l * D, in.p[28] + l * D, XM, modl, 3 * D, 4 * D, nullptr, G, bx, t_); }
        SEAM(g0 + 5);
        if (IN(g0 + 6)) { LOCALS;
            pg8::Gemm g{XM, (const bf16*)(ws + WS_WGU) + (size_t)l * 2 * DFF * D, M, 2 * DFF, D}; pg8::StaticOrder S; S.init(M, 2 * DFF, G, bx);
            pg8::EpiSwiGLU E{HFF, DFF};
            pg8::gemm_phase<pg8::EpiSwiGLU, pg8::StaticOrder, true, true>(lds, g, S, E, t_);
        }
        SEAM(g0 + 6);
        if (IN(g0 + 7)) { LOCALS;
            pg8::Gemm g{HFF, (const bf16*)(ws + WS_WDN) + (size_t)l * D * DFF, M, D, DFF}; pg8::StaticOrder S; S.init(M, D, G, bx);
            float alpha_ = ALPHA; OPQ(alpha_); pg8::EpiRes E{X, modl + 5 * D, MODS, alpha_};
            pg8::gemm_phase<pg8::EpiRes, pg8::StaticOrder, true, true>(lds, g, S, E, t_);
        }
        SEAM(g0 + 7);
        if (IN(g0 + 8)) { LOCALS;
            if (l < DEPTH - 1) phase_ln(X, in.p[32] + l * D, in.p[33] + l * D, XM, modl + 5 * MODS, 0, D, nullptr, G, bx, t_);
            else phase_ln(X, in.p[32] + l * D, in.p[33] + l * D, XM, modl, 0, D, args.out, G, bx, t_);
        }
        SEAM(g0 + 8);
    }
#undef IN
#undef SEAM
}


#if defined(DBG_STOP)
__global__ void dbg_dump(float* out, const unsigned char* ws, int kind, size_t off, int pitch, size_t stride) {
    const size_t n = (size_t)cf::NB * cf::SEQ * cf::D;
    for (size_t i = (size_t)blockIdx.x * blockDim.x + threadIdx.x; i < n; i += (size_t)gridDim.x * blockDim.x) {
        const size_t rr = i / cf::D, c = i % cf::D, b = rr / cf::SEQ, t = rr % cf::SEQ, row = b * cf::SEGT + cf::CTX + t;
        float v;
        if (kind == 0) v = ((const float*)(ws + WS_X))[row * cf::D + c];
        else if (kind == 1) v = bf2f(((const bf16*)(ws + off))[row * (size_t)pitch + c]);
        else if (kind == 3) v = ((const float*)(ws + off))[(i * stride)];
        else if (kind == 4) v = ((const float*)(ws + off))[i % ((size_t)pitch * 1024)];
        else v = bf2f(((const bf16*)(ws + off))[i * stride]);
        if (!(fabsf(v) < 3.0e38f)) v = 1.0e30f;
        out[i] = v;
    }
}
#endif
#ifndef MK_MULTI
#define MK_MULTI 0
#endif
extern "C" void kernel_launch(void* const* d_in, const int* in_sizes, int n_in, void* d_out, int out_size, void* d_ws, size_t ws_size, hipStream_t stream) {
    static int grid = 0;
    if (grid == 0) {
        if (n_in != 34 || out_size != cf::NB * cf::SEQ * cf::D || ws_size < WS_END) { fprintf(stderr, "kernel_launch: shape mismatch (n_in %d out %d ws %zu)\n", n_in, out_size, ws_size); grid = -1; return; }
        int dev = 0, cus = 0;
        if (hipGetDevice(&dev) != hipSuccess || hipDeviceGetAttribute(&cus, hipDeviceAttributeMultiprocessorCount, dev) != hipSuccess) { grid = -1; return; }
        if (hipFuncSetAttribute((const void*)fwd, hipFuncAttributeMaxDynamicSharedMemorySize, LDS_BYTES) != hipSuccess) { fprintf(stderr, "kernel_launch: hipFuncSetAttribute failed\n"); grid = -1; return; }
        int per_cu = 0;
        if (hipOccupancyMaxActiveBlocksPerMultiprocessor(&per_cu, (const void*)fwd, NWAVES * 64, LDS_BYTES) != hipSuccess || per_cu < 1) fprintf(stderr, "kernel_launch: occupancy query says %d\n", per_cu);
        (void)hipGetLastError();
        grid = cus;
    }
    if (grid < 0) return;
    (void)hipMemsetAsync((char*)d_ws, 0, ZERO_BYTES, stream);
    Args a{};
    for (int i = 0; i < 34; ++i) a.in.p[i] = (const float*)d_in[i];
    a.out = (float*)d_out; a.ws = (uchar*)d_ws;
#if defined(PROBE)
    for (int g = 0; g < 7; ++g) { a.g_lo = g; a.g_hi = g + 1; hipLaunchKernelGGL(fwd, dim3(grid), dim3(NWAVES * 64), LDS_BYTES, stream, a); }
    { unsigned* res = (unsigned*)d_ws + 64; float* scratch = (float*)((char*)d_ws + WS_HFF + (400ull << 20));
      scratch = (float*)((char*)d_ws + WS_END);
      hipLaunchKernelGGL(probe, dim3(12), dim3(256), 0, stream, a.in, (uchar*)d_ws, res, scratch);
      hipLaunchKernelGGL(probe_cmp, dim3(256), dim3(256), 0, stream, (uchar*)d_ws, res, (const float*)scratch);
      for (int g = 7; g < NPH; ++g) { a.g_lo = g; a.g_hi = g + 1; hipLaunchKernelGGL(fwd, dim3(grid), dim3(NWAVES * 64), LDS_BYTES, stream, a); }
      hipLaunchKernelGGL(probe_out, dim3(1), dim3(64), 0, stream, (float*)d_out, (const unsigned*)res, PROBE_SELA, PROBE_SELB); }
#elif defined(DBG_STOP)
    for (int g = 0; g < DBG_STOP; ++g) { a.g_lo = g; a.g_hi = g + 1; hipLaunchKernelGGL(fwd, dim3(grid), dim3(NWAVES * 64), LDS_BYTES, stream, a); }
    hipLaunchKernelGGL(dbg_dump, dim3(2048), dim3(256), 0, stream, (float*)d_out, (const unsigned char*)d_ws, DBG_KIND, (size_t)DBG_OFF, DBG_PITCH, (size_t)DBG_STRIDE);
#elif MK_MULTI
    for (int g = 0; g < NPH; ++g) { a.g_lo = g; a.g_hi = g + 1; hipLaunchKernelGGL(fwd, dim3(grid), dim3(NWAVES * 64), LDS_BYTES, stream, a); }
#else
    a.g_lo = 0; a.g_hi = NPH;
    hipLaunchKernelGGL(fwd, dim3(grid), dim3(NWAVES * 64), LDS_BYTES, stream, a);
#endif
    const hipError_t le = hipPeekAtLastError();
    if (le != hipSuccess) fprintf(stderr, "kernel_launch: launch failed: %s\n", hipGetErrorName(le));
}
```

```cpp
#include <hip/hip_runtime.h>
#include <cstdio>
#include <cstdint>

#define DI __device__ __forceinline__
#define LAS __attribute__((address_space(3)))
#define GAS __attribute__((address_space(1)))
typedef unsigned short bf16;
typedef short bf16x8 __attribute__((ext_vector_type(8)));
typedef short s16x4 __attribute__((ext_vector_type(4)));
typedef float f32x4 __attribute__((ext_vector_type(4)));
typedef float f32x2 __attribute__((ext_vector_type(2)));
typedef float f32x16 __attribute__((ext_vector_type(16)));
typedef unsigned u32x4 __attribute__((ext_vector_type(4)));
typedef unsigned u32x2 __attribute__((ext_vector_type(2)));
typedef unsigned char uchar;
typedef __bf16 bf16x2_t __attribute__((ext_vector_type(2)));

namespace pg8 {
typedef unsigned short bf16_t;
#define PG8_LAS __attribute__((address_space(3)))
constexpr int BM = 256, BK = 64, HALF = 128, HTB = HALF * BK * 2  , STAGE_BYTES = 8 * HTB, NXCD = 8, WGM = 8;

__host__ __device__ __forceinline__ int lds_byte(int r, int c) { const int st = (r >> 4) * 2 + (c >> 5), rr = r & 15, cc = c & 31, ob = rr * 64 + cc * 2; return st * 1024 + (ob ^ (((ob >> 9) & 1) << 5)); }
__host__ __device__ __forceinline__ void stage_rc(int b, int& R, int& C) { const int st = b / 1024, sb = b % 1024, swz = sb ^ (((sb >> 9) & 1) << 5); R = (st >> 1) * 16 + swz / 64; C = (st & 1) * 32 + (swz % 64) / 2; }
__host__ __device__ __forceinline__ int perm32(int rho) { const int n = rho >> 4, i = rho & 15; return 8 * (i >> 2) + 4 * n + (i & 3); }

struct Unit { int pm, pn; };
struct Gemm { const bf16_t* A; const bf16_t* Bt; int M, N, K; };

struct StaticOrder {
    int nM, nN, nwg, G, c;
    __host__ __device__ void init(int M, int N, int G_, int c_) { nM = M / BM; nN = N / BM; nwg = nM * nN; G = G_; c = c_; }
    __host__ __device__ bool next(int i, Unit& u) const {
        const long L = (long)i * G + c; if (L >= nwg) return false;
        int wgid = (int)L; { const int q = nwg / NXCD, r = nwg % NXCD, xcd = wgid % NXCD, off = wgid / NXCD; wgid = (xcd < r ? xcd * (q + 1) : r * (q + 1) + (xcd - r) * q) + off; }
        const int nig = WGM * nN, gid = wgid / nig, fm = gid * WGM, gsz = (nM - fm) < WGM ? (nM - fm) : WGM;
        u.pm = fm + ((wgid % nig) % gsz); u.pn = (wgid % nig) / gsz; return true;
    }
    __device__ __forceinline__ void a_ready(const Unit&) const {}
    __device__ __forceinline__ void done(const Unit&) const {}
};

__device__ __forceinline__ unsigned cvt_pk_bf16(float lo, float hi) { const f32x2 v = {lo, hi}; return __builtin_bit_cast(unsigned, __builtin_convertvector(v, bf16x2_t)); }
__device__ __forceinline__ u32x4 pack8(f32x4 v0, f32x4 v1) { u32x4 w; w.x = cvt_pk_bf16(v0[0], v0[1]); w.y = cvt_pk_bf16(v0[2], v0[3]); w.z = cvt_pk_bf16(v1[0], v1[1]); w.w = cvt_pk_bf16(v1[2], v1[3]); return w; }

struct EpiStore {
    static constexpr bool PERM = true, AFTER_DRAIN = false;
    bf16_t* O; int ldc;
    __device__ __forceinline__ void operator()(const f32x4 (&acc)[2][2][4][2], const Unit& u, int wr, int wc, int fr, int fq) const {
        const int row0 = u.pm * BM + wr * 64 + fr, col0 = u.pn * BM + wc * 32 + 8 * fq;
#pragma unroll
        for (int ai = 0; ai < 2; ++ai)
#pragma unroll
            for (int m = 0; m < 4; ++m) { bf16_t* rowp = O + (size_t)(row0 + ai * HALF + m * 16) * ldc + col0;
#pragma unroll
                for (int bj = 0; bj < 2; ++bj) *(u32x4*)(rowp + bj * HALF) = pack8(acc[ai][bj][m][0], acc[ai][bj][m][1]); }
    }
};
struct EpiKV {
    static constexpr bool PERM = true, AFTER_DRAIN = false;
    bf16_t* Kb; bf16_t* Vb;
    __device__ __forceinline__ void operator()(const f32x4 (&acc)[2][2][4][2], const Unit& u, int wr, int wc, int fr, int fq) const {
        const int row0 = u.pm * BM + wr * 64 + fr, c0 = wc * 32 + 8 * fq;
#pragma unroll
        for (int ai = 0; ai < 2; ++ai)
#pragma unroll
            for (int m = 0; m < 4; ++m) { const size_t row = (size_t)(row0 + ai * HALF + m * 16);
                *(u32x4*)(Kb + row * 1536 + u.pn * 192 + c0) = pack8(acc[ai][0][m][0], acc[ai][0][m][1]);
                *(u32x4*)(Vb + row * 1024 + u.pn * 128 + c0) = pack8(acc[ai][1][m][0], acc[ai][1][m][1]); }
    }
};
struct EpiSwiGLU {
    static constexpr bool PERM = true, AFTER_DRAIN = false;
    bf16_t* Hb; int ldh;
    __device__ __forceinline__ void operator()(const f32x4 (&acc)[2][2][4][2], const Unit& u, int wr, int wc, int fr, int fq) const {
        const int row0 = u.pm * BM + wr * 64 + fr, col0 = u.pn * HALF + wc * 32 + 8 * fq;
#pragma unroll
        for (int ai = 0; ai < 2; ++ai)
#pragma unroll
            for (int m = 0; m < 4; ++m) { f32x4 o[2];
#pragma unroll
                for (int n = 0; n < 2; ++n) { const f32x4 g = acc[ai][0][m][n], up = acc[ai][1][m][n];
#pragma unroll
                    for (int e = 0; e < 4; ++e) o[n][e] = g[e] * __builtin_amdgcn_rcpf(1.f + __expf(-g[e])) * up[e]; }
                *(u32x4*)(Hb + (size_t)(row0 + ai * HALF + m * 16) * ldh + col0) = pack8(o[0], o[1]); }
    }
};
struct EpiRes {
    static constexpr bool PERM = true, AFTER_DRAIN = false;
    float* X; const float* gate; int gstride; float alpha;
    __device__ __forceinline__ void operator()(const f32x4 (&acc)[2][2][4][2], const Unit& u, int wr, int wc, int fr, int fq) const {
        const int row0 = u.pm * BM + wr * 64 + fr, col0 = u.pn * BM + wc * 32 + 8 * fq;
        const int vec = (u.pm % 17 == 0) ? 4 : (u.pm / 17);
        const float* gp = gate + (size_t)vec * gstride + col0;
        f32x4 gv[2][2];
#pragma unroll
        for (int bj = 0; bj < 2; ++bj)
#pragma unroll
            for (int n = 0; n < 2; ++n) gv[bj][n] = *(const f32x4*)(gp + bj * HALF + 4 * n);
#pragma unroll
        for (int ai = 0; ai < 2; ++ai)
#pragma unroll
            for (int m = 0; m < 4; ++m) { float* rowp = X + (size_t)(row0 + ai * HALF + m * 16) * 2048 + col0;
#pragma unroll
                for (int bj = 0; bj < 2; ++bj)
#pragma unroll
                    for (int n = 0; n < 2; ++n) { f32x4* p = (f32x4*)(rowp + bj * HALF + 4 * n); const f32x4 x = *p; *p = x * alpha + gv[bj][n] * acc[ai][bj][m][n]; } }
    }
};

template <class Epi, class Sched, bool ALIGN_EPI = false, bool SP2 = false>
__device__ __forceinline__ void gemm_phase(PG8_LAS unsigned char* lds, const Gemm g, const Sched& S, const Epi& E, const int tid) {
    const int wid = __builtin_amdgcn_readfirstlane(tid >> 6), lane = tid & 63, wr = wid >> 2, wc = wid & 3, fr = lane & 15, fq = lane >> 4;
    const int K = g.K, nt = K / BK;
    unsigned voffA[2], voffB[2];
#pragma unroll
    for (int i = 0; i < 2; ++i) { int R, C; stage_rc(tid * 16 + i * 8192, R, C); const int Rb = Epi::PERM ? ((R & ~31) + perm32(R & 31)) : R;
        voffA[i] = (unsigned)(R * K + C) * 2u; voffB[i] = (unsigned)(Rb * K + C) * 2u; }
    const size_t kstep = (size_t)(BK * 2);
    const size_t hstep = (size_t)HALF * K * 2;
    const size_t tstep = 2 * hstep;
    const unsigned ldsw = (unsigned)wid * 1024u;
    const int aoff = lds_byte(wr * 64 + fr, fq * 8), boff = lds_byte(wc * 32 + fr, fq * 8);
#define PG8_SA(b, h) (((b) * 2 + (h)) * HTB)
#define PG8_SB(b, h) ((4 + (b) * 2 + (h)) * HTB)
#define PG8_STAGE(bufoff, gbase, voff) do { _Pragma("unroll") for (int _i = 0; _i < 2; ++_i) \
        __builtin_amdgcn_global_load_lds((const unsigned*)((const char*)(gbase) + (voff)[_i]), (PG8_LAS unsigned*)(lds + (bufoff) + ldsw + _i * 8192), 16, 0, 0); } while (0)
#define PG8_LDA(dst, b, h) do { _Pragma("unroll") for (int m = 0; m < 4; ++m) _Pragma("unroll") for (int k = 0; k < 2; ++k) dst[m][k] = *(const PG8_LAS bf16x8*)(lds + PG8_SA(b, h) + aoff + m * 2048 + k * 1024); } while (0)
#define PG8_LDB(dst, b, h) do { _Pragma("unroll") for (int n = 0; n < 2; ++n) _Pragma("unroll") for (int k = 0; k < 2; ++k) dst[n][k] = *(const PG8_LAS bf16x8*)(lds + PG8_SB(b, h) + boff + n * 2048 + k * 1024); } while (0)
#define PG8_MMA(ai, bj, At, Bt) do { __builtin_amdgcn_s_setprio(1); _Pragma("unroll") for (int m = 0; m < 4; ++m) _Pragma("unroll") for (int n = 0; n < 2; ++n) _Pragma("unroll") for (int k = 0; k < 2; ++k) \
        acc[ai][bj][m][n] = __builtin_amdgcn_mfma_f32_16x16x32_bf16(Bt[n][k], At[m][k], acc[ai][bj][m][n], 0, 0, 0); __builtin_amdgcn_s_setprio(0); } while (0)
#define PG8_WAIT_V(n) asm volatile("s_waitcnt vmcnt(" #n ")" ::: "memory")
#define PG8_WAIT_L(n) asm volatile("s_waitcnt lgkmcnt(" #n ")" ::: "memory")
#define PG8_BAR __builtin_amdgcn_s_barrier()
#define PG8_SCHED __builtin_amdgcn_sched_barrier(0)
    Unit cur, nxt; int ui = 0;
    if (!S.next(0, cur)) return;
    f32x4 acc[2][2][4][2];
#pragma unroll
    for (int a = 0; a < 2; ++a)
#pragma unroll
        for (int b = 0; b < 2; ++b)
#pragma unroll
            for (int m = 0; m < 4; ++m)
#pragma unroll
                for (int n = 0; n < 2; ++n) acc[a][b][m][n] = (f32x4){0.f, 0.f, 0.f, 0.f};
    bf16x8 At[4][2], B0[2][2], B1[2][2];
    const char* cA = (const char*)g.A + (size_t)cur.pm * tstep; const char* cB = (const char*)g.Bt + (size_t)cur.pn * tstep;
    S.a_ready(cur);
    if constexpr (SP2) {
        PG8_STAGE(PG8_SB(0, 0), cB, voffB); PG8_STAGE(PG8_SB(0, 1), cB + hstep, voffB); PG8_STAGE(PG8_SA(0, 0), cA, voffA); PG8_STAGE(PG8_SA(0, 1), cA + hstep, voffA);
        if (wr == 1) PG8_BAR;
        PG8_WAIT_V(2); PG8_BAR;
        PG8_STAGE(PG8_SB(1, 0), cB + kstep, voffB); PG8_STAGE(PG8_SA(1, 0), cA + kstep, voffA); PG8_STAGE(PG8_SB(1, 1), cB + hstep + kstep, voffB);
        PG8_WAIT_V(6); PG8_BAR;
    } else {
        PG8_STAGE(PG8_SB(0, 0), cB, voffB); PG8_STAGE(PG8_SA(0, 0), cA, voffA); PG8_STAGE(PG8_SB(0, 1), cB + hstep, voffB); PG8_STAGE(PG8_SA(0, 1), cA + hstep, voffA);
        if (wr == 1) PG8_BAR;
        PG8_WAIT_V(4); PG8_BAR;
        PG8_STAGE(PG8_SB(1, 0), cB + kstep, voffB); PG8_STAGE(PG8_SA(1, 0), cA + kstep, voffA); PG8_STAGE(PG8_SB(1, 1), cB + hstep + kstep, voffB);
        PG8_WAIT_V(6); PG8_BAR;
    }
    for (;;) {
        const bool has_next = S.next(ui + 1, nxt);
        const char* nA = has_next ? (const char*)g.A + (size_t)nxt.pm * tstep : cA; const char* nB = has_next ? (const char*)g.Bt + (size_t)nxt.pn * tstep : cB;
        for (int t = 0; t < nt; t += 2) {
            const bool last = (t == nt - 2);
            const char* a1 = cA + (size_t)(t + 1) * kstep;
            const char* a2 = last ? nA : cA + (size_t)(t + 2) * kstep; const char* b2 = last ? nB : cB + (size_t)(t + 2) * kstep;
            const char* a3 = a2 + kstep; const char* b3 = b2 + kstep;
            if (last && has_next) S.a_ready(nxt);
            if constexpr (SP2) {
            PG8_LDB(B0, 0, 0); PG8_LDB(B1, 0, 1); PG8_SCHED; PG8_LDA(At, 0, 0); PG8_STAGE(PG8_SA(1, 1), a1 + hstep, voffA);
            PG8_WAIT_V(8); PG8_WAIT_L(0); PG8_BAR; PG8_MMA(0, 0, At, B0); PG8_MMA(0, 1, At, B1); PG8_BAR; PG8_SCHED;
            PG8_LDA(At, 0, 1); PG8_STAGE(PG8_SB(0, 0), b2, voffB); PG8_STAGE(PG8_SB(0, 1), b2 + hstep, voffB); PG8_STAGE(PG8_SA(0, 0), a2, voffA);
            PG8_WAIT_V(8); PG8_WAIT_L(0); PG8_BAR; PG8_MMA(1, 0, At, B0); PG8_MMA(1, 1, At, B1); PG8_BAR; PG8_SCHED;
            PG8_LDB(B0, 1, 0); PG8_LDB(B1, 1, 1); PG8_SCHED; PG8_LDA(At, 1, 0); PG8_STAGE(PG8_SA(0, 1), a2 + hstep, voffA);
            PG8_WAIT_V(8); PG8_WAIT_L(0); PG8_BAR; PG8_MMA(0, 0, At, B0); PG8_MMA(0, 1, At, B1); PG8_BAR; PG8_SCHED;
            PG8_LDA(At, 1, 1); PG8_STAGE(PG8_SB(1, 0), b3, voffB); PG8_STAGE(PG8_SB(1, 1), b3 + hstep, voffB); PG8_STAGE(PG8_SA(1, 0), a3, voffA);
            PG8_WAIT_V(8); PG8_WAIT_L(0); PG8_BAR; PG8_MMA(1, 0, At, B0); PG8_MMA(1, 1, At, B1); PG8_BAR; PG8_SCHED;
            } else {
            PG8_LDB(B0, 0, 0); PG8_SCHED; PG8_LDA(At, 0, 0); PG8_STAGE(PG8_SA(1, 1), a1 + hstep, voffA);
            PG8_WAIT_L(8); PG8_BAR; PG8_WAIT_L(0); PG8_MMA(0, 0, At, B0); PG8_BAR; PG8_SCHED;
            PG8_LDB(B1, 0, 1); PG8_STAGE(PG8_SB(0, 0), b2, voffB);
            PG8_BAR; PG8_WAIT_L(0); PG8_MMA(0, 1, At, B1); PG8_BAR;
            PG8_LDA(At, 0, 1); PG8_STAGE(PG8_SA(0, 0), a2, voffA);
            PG8_BAR; PG8_WAIT_L(0); PG8_MMA(1, 0, At, B0); PG8_BAR; PG8_SCHED;
            PG8_STAGE(PG8_SB(0, 1), b2 + hstep, voffB);
            PG8_WAIT_V(6); PG8_BAR; PG8_MMA(1, 1, At, B1); PG8_BAR;
            PG8_LDB(B0, 1, 0); PG8_SCHED; PG8_LDA(At, 1, 0); PG8_STAGE(PG8_SA(0, 1), a2 + hstep, voffA);
            PG8_WAIT_L(8); PG8_BAR; PG8_WAIT_L(0); PG8_MMA(0, 0, At, B0); PG8_BAR; PG8_SCHED;
            PG8_LDB(B1, 1, 1); PG8_STAGE(PG8_SB(1, 0), b3, voffB);
            PG8_BAR; PG8_WAIT_L(0); PG8_MMA(0, 1, At, B1); PG8_BAR;
            PG8_LDA(At, 1, 1); PG8_STAGE(PG8_SA(1, 0), a3, voffA);
            PG8_BAR; PG8_WAIT_L(0); PG8_MMA(1, 0, At, B0); PG8_BAR; PG8_SCHED;
            PG8_STAGE(PG8_SB(1, 1), b3 + hstep, voffB);
            PG8_WAIT_V(6); PG8_BAR; PG8_MMA(1, 1, At, B1); PG8_BAR;
            }
        }
        if constexpr (ALIGN_EPI) { if (wr == 0) PG8_BAR; }
        if constexpr (!Epi::AFTER_DRAIN) { E(acc, cur, wr, wc, fr, fq); S.done(cur); }
        if (!has_next) break;
#pragma unroll
        for (int a = 0; a < 2; ++a)
#pragma unroll
            for (int b = 0; b < 2; ++b)
#pragma unroll
                for (int m = 0; m < 4; ++m)
#pragma unroll
                    for (int n = 0; n < 2; ++n) acc[a][b][m][n] = (f32x4){0.f, 0.f, 0.f, 0.f};
        cur = nxt; cA = nA; cB = nB; ++ui;
        if constexpr (ALIGN_EPI) { if (wr == 1) PG8_BAR; }
    }
    PG8_WAIT_V(0);
    if constexpr (!ALIGN_EPI) { if (wr == 0) PG8_BAR; }
    PG8_BAR;
    if constexpr (Epi::AFTER_DRAIN) { E.fused(acc, cur, wr, wc, fr, fq, lds, wid, lane); S.done(cur); }
#undef PG8_SA
#undef PG8_SB
#undef PG8_STAGE
#undef PG8_LDA
#undef PG8_LDB
#undef PG8_MMA
#undef PG8_WAIT_V
#undef PG8_WAIT_L
#undef PG8_BAR
#undef PG8_SCHED
}
}
namespace cf {
constexpr int D = 2048, NB = 4, SEQ = 4096, CTX = 256, SEGT = 4352, M = 17408, DEPTH = 4;
constexpr int IN_COLS = 4912, PC = 5120;
constexpr int C_CQ = 0, C_CKV = 512, C_KR = 1024, C_RW = 1088, C_GD = 2848;
constexpr int RW_K = 512, RW_V = 1024, RW_WD = 1536, RW_AD = 1600, RW_GD = 1664, RW_COLS = 1760;
constexpr int GD_K = 512, GD_V = 1024, GD_Z = 1536, GD_A = 2048, GD_B = 2056;
constexpr int DFF = 5632, NCH = 68;
constexpr int QP = 1536, KP = 1536, VP = 1024;
constexpr int MODS = 6 * D;
constexpr float ALPHA = 1.681792830507429f;
constexpr int RW_TASK = 57600, GD_TASK = 74240;
}
constexpr size_t MiB = 1u << 20;
constexpr size_t WS_CTL = 0, WS_MODV = 1 * MiB, ZERO_BYTES = 2 * MiB;
constexpr size_t WS_ROPE = 2 * MiB, WS_W2T = 2 * MiB + 65536, WS_A2T = WS_W2T + 262144, WS_G2T = WS_A2T + 262144;
constexpr size_t WS_WIN = 4 * MiB, WS_WOUT = 84 * MiB, WS_WGU = 116 * MiB, WS_WDN = 292 * MiB, WS_WUQ = 380 * MiB, WS_WUKV = 386 * MiB;
constexpr size_t WS_X = 394 * MiB, WS_XM = 530 * MiB;
constexpr size_t WS_P = 598 * MiB, WS_CQN = 768 * MiB, WS_CKVN = 785 * MiB, WS_Q = 802 * MiB, WS_K = 853 * MiB, WS_V = 904 * MiB;
constexpr size_t WS_RWT = 938 * MiB, WS_GDT = 1178 * MiB, WS_YR = 1333 * MiB, WS_YG = 1401 * MiB, WS_GATE = 1469 * MiB, WS_BONUS = 1503 * MiB, WS_END = 1505 * MiB;
constexpr size_t WS_HFF = 598 * MiB;
static_assert(WS_RWT + (size_t)4352 * cf::RW_TASK <= WS_GDT && WS_GDT + (size_t)2176 * cf::GD_TASK <= WS_YR && WS_HFF + (size_t)cf::M * cf::DFF * 2 <= WS_CKVN, "ws map");
constexpr int CW_TMO = 0, CW_BAR = 4096;
constexpr int LDS_BYTES = 163840, MISC_OFF = LDS_BYTES - 128;

DI float bflo(unsigned w) { return __builtin_bit_cast(float, w << 16); }
DI float bfhi(unsigned w) { return __builtin_bit_cast(float, w & 0xffff0000u); }
DI float bf2f(bf16 h) { return __builtin_bit_cast(float, (unsigned)h << 16); }
DI bf16 f2bf(float f) { unsigned u = __builtin_bit_cast(unsigned, f); return (bf16)((u + 0x7fffu + ((u >> 16) & 1u)) >> 16); }
DI unsigned pk2(float lo, float hi) { const f32x2 v = {lo, hi}; return __builtin_bit_cast(unsigned, __builtin_convertvector(v, bf16x2_t)); }
DI void unpack8(u32x4 w, float (&f)[8]) { f[0] = bflo(w.x); f[1] = bfhi(w.x); f[2] = bflo(w.y); f[3] = bfhi(w.y); f[4] = bflo(w.z); f[5] = bfhi(w.z); f[6] = bflo(w.w); f[7] = bfhi(w.w); }
DI u32x4 pack8f(const float (&f)[8]) { u32x4 w; w.x = pk2(f[0], f[1]); w.y = pk2(f[2], f[3]); w.z = pk2(f[4], f[5]); w.w = pk2(f[6], f[7]); return w; }
template <int X> DI float sx(float v) { return __builtin_bit_cast(float, __builtin_amdgcn_ds_swizzle(__builtin_bit_cast(int, v), 0x1F | (X << 10))); }
DI float lx(float v, int lane, int X) { return __builtin_bit_cast(float, __builtin_amdgcn_ds_bpermute((lane ^ X) << 2, __builtin_bit_cast(int, v))); }
DI float wave_sum(float v, int lane) {
    v += sx<1>(v); v += sx<2>(v); v += sx<4>(v); v += lx(v, lane, 8); v += lx(v, lane, 16); v += lx(v, lane, 32);
    return v;
}
DI float sigmoidf_(float x) { return 1.f / (1.f + __expf(-x)); }
DI float softplusf_(float x) { const float e = __expf(x); return x > 20.f ? x : (x < -9.f ? e * (1.f - 0.5f * e) : __logf(1.f + e)); }
#define LDS_BARRIER() do { asm volatile("s_waitcnt lgkmcnt(0)" ::: "memory"); __builtin_amdgcn_s_barrier(); asm volatile("" ::: "memory"); } while (0)
#define LDS_WAIT() asm volatile("s_waitcnt lgkmcnt(0)" ::: "memory")
#define MFMA16(a, b, c) __builtin_amdgcn_mfma_f32_16x16x32_bf16((a), (b), (c), 0, 0, 0)

#define XB_TMO      128
#define XB_XCNT(j)  (256  + 64 * (j))
#define XB_XSUB(j)  (1280 + 64 * (j))
#define XB_XGEN(j)  (2304 + 64 * (j))
#define XB_TOP      3328
#define XB_TOPGEN   3392
#define XCD_BAR_WORDS 3456
#define XB_SPIN_CAP (1u << 22)
__device__ __forceinline__ unsigned xb_ld(unsigned* p)              { return __hip_atomic_load(p, __ATOMIC_RELAXED, __HIP_MEMORY_SCOPE_AGENT); }
__device__ __forceinline__ unsigned xb_add(unsigned* p, unsigned v) { return __hip_atomic_fetch_add(p, v, __ATOMIC_RELAXED, __HIP_MEMORY_SCOPE_AGENT); }
__device__ __forceinline__ unsigned xb_xcc_id() { return (unsigned)__builtin_amdgcn_s_getreg((3 << 11) | 20) & 0xFu; }
#define XB_SPIN(cond, bar) do { unsigned _sp = 0; while (cond) { __builtin_amdgcn_s_sleep(1); \
    if ((++_sp & 255u) == 0u) { if (xb_ld(&(bar)[XB_TMO])) break; if (_sp > XB_SPIN_CAP) { atomicAdd(&(bar)[XB_TMO], 1u); break; } } } } while (0)
struct XcdBarrier { unsigned* bar; unsigned x; volatile LAS unsigned* st; };
__device__ __forceinline__ XcdBarrier xcd_barrier_post(unsigned* bar, volatile LAS unsigned* st) {
    XcdBarrier b; b.bar = bar; b.x = xb_xcc_id(); b.st = st;
    if (threadIdx.x == 0) (void)xb_add(&bar[XB_XCNT(b.x)], 1u);
    return b;
}
__device__ __forceinline__ void xcd_barrier_complete(unsigned* bar, unsigned x, unsigned& nloc, unsigned& nx) {
    const unsigned G = gridDim.x * gridDim.y * gridDim.z;
    unsigned sum, cnt, mine, sp = 0u;
    for (;;) {
        sum = 0u; cnt = 0u; mine = 0u;
#pragma unroll
        for (unsigned j = 0; j < 16; ++j) { const unsigned c = xb_ld(&bar[XB_XCNT(j)]); sum += c; cnt += (c > 0u) ? 1u : 0u; mine = (j == x) ? c : mine; }
        if (sum == G) break;
        __builtin_amdgcn_s_sleep(1);
        if ((++sp & 255u) == 0u) { if (xb_ld(&bar[XB_TMO])) break; if (sp > XB_SPIN_CAP) { atomicAdd(&bar[XB_TMO], 1u); break; } }
    }
    nloc = mine > 0u ? mine : 1u; nx = cnt > 0u ? cnt : 1u;
}
__device__ __forceinline__ void xcd_barrier(const XcdBarrier& b) {
    asm volatile("s_waitcnt vmcnt(0)" ::: "memory");
    __syncthreads();
    if (threadIdx.x == 0) {
        unsigned* bar = b.bar;
        __builtin_amdgcn_s_waitcnt(0);
        unsigned nloc = b.st[0], nx = b.st[1];
        if (nloc == 0u) { xcd_barrier_complete(bar, b.x, nloc, nx); b.st[0] = nloc; b.st[1] = nx; }
        const unsigned old = xb_add(&bar[XB_XSUB(b.x)], 1u);
        const unsigned gen = old / nloc;
        if (old + 1u == (gen + 1u) * nloc) {
            __builtin_amdgcn_fence(__ATOMIC_RELEASE, "agent");
            asm volatile("s_waitcnt vmcnt(0)" ::: "memory");
            const unsigned og = xb_add(&bar[XB_TOP], 1u);
            const unsigned tg = og / nx;
            if (og + 1u == (tg + 1u) * nx) xb_add(&bar[XB_TOPGEN], 1u);
            else XB_SPIN(xb_ld(&bar[XB_TOPGEN]) == tg, bar);
            __builtin_amdgcn_fence(__ATOMIC_ACQUIRE, "agent");
            xb_add(&bar[XB_XGEN(b.x)], 1u);
            asm volatile("s_waitcnt vmcnt(0)" ::: "memory");
        } else {
            XB_SPIN(xb_ld(&bar[XB_XGEN(b.x)]) == gen, bar);
            __builtin_amdgcn_fence(__ATOMIC_ACQUIRE, "agent");
            asm volatile("s_waitcnt vmcnt(0)" ::: "memory");
        }
    }
    __syncthreads();
}

DI int row_of(int b, int dir, int ci, int i) {
    int s;
    if (dir == 0) s = ci * 64 + i;
    else s = (ci < 4) ? (3 - ci) * 64 + (63 - i) : 256 + (67 - ci) * 64 + (63 - i);
    return b * cf::SEGT + s;
}
DI void transpose_item(const float* W, int K, int N, bf16* WT, int out_row0, int k0, int n0, LAS float* scr, int lane) {
    const int n = n0 + (lane & 31); const bool ok = n < N;
#pragma unroll 8
    for (int i = 0; i < 32; ++i) { const int kk = 2 * i + (lane >> 5); scr[kk * 33 + (lane & 31)] = ok ? W[(size_t)(k0 + kk) * N + n] : 0.f; }
    LDS_WAIT();
    const int c = lane & 7;
#pragma unroll
    for (int j = 0; j < 4; ++j) { const int nn = (lane >> 3) + 8 * j; const LAS float* s = scr + (8 * c) * 33 + nn;
        u32x4 o; o.x = pk2(s[0 * 33], s[1 * 33]); o.y = pk2(s[2 * 33], s[3 * 33]); o.z = pk2(s[4 * 33], s[5 * 33]); o.w = pk2(s[6 * 33], s[7 * 33]);
        *(u32x4*)(WT + (size_t)(out_row0 + nn) * K + k0 + 8 * c) = o; }
    LDS_WAIT();
}

struct In { const float* p[34]; };

DI void phase_prologue(const In& in, uchar* ws, LAS uchar* lds, int G, int bx, int tid) {
    using namespace cf;
    const int lane = tid & 63, wid = tid >> 6, gw = bx * 8 + wid, NGW = G * 8;
    LAS float* scr = (LAS float*)(lds + wid * 16384);
    constexpr int I_IN = 32 * 160, I_OUT = 32 * 64, I_G = 32 * 176, I_DN = 88 * 64, I_UQ = 8 * 48, I_UKV = 8 * 64;
    constexpr int I_LAYER = I_IN + I_OUT + 2 * I_G + I_DN + I_UQ + I_UKV;
    for (int it = gw; it < DEPTH * I_LAYER; it += NGW) {
        const int l = it / I_LAYER; int r = it % I_LAYER;
        if (r < I_IN) { const int kb = r / 160, nb = r % 160; transpose_item(in.p[6] + (size_t)l * D * IN_COLS, D, IN_COLS, (bf16*)(ws + WS_WIN) + (size_t)l * PC * D, nb * 32, kb * 64, nb * 32, scr, lane); continue; } r -= I_IN;
        if (r < I_OUT) { const int kb = r / 64, nb = r % 64; transpose_item(in.p[26] + (size_t)l * D * D, D, D, (bf16*)(ws + WS_WOUT) + (size_t)l * D * D, nb * 32, kb * 64, nb * 32, scr, lane); continue; } r -= I_OUT;
        if (r < 2 * I_G) { const int up = r >= I_G; if (up) r -= I_G; const int kb = r / 176, nb = r % 176, n0 = nb * 32;
            transpose_item(in.p[up ? 30 : 29] + (size_t)l * D * DFF, D, DFF, (bf16*)(ws + WS_WGU) + (size_t)l * 2 * DFF * D, 256 * (n0 / 128) + (n0 % 128) + (up ? 128 : 0), kb * 64, n0, scr, lane); continue; } r -= 2 * I_G;
        if (r < I_DN) { const int kb = r / 64, nb = r % 64; transpose_item(in.p[31] + (size_t)l * DFF * D, DFF, D, (bf16*)(ws + WS_WDN) + (size_t)l * D * DFF, nb * 32, kb * 64, nb * 32, scr, lane); continue; } r -= I_DN;
        if (r < I_UQ) { const int kb = r / 48, nb = r % 48; transpose_item(in.p[9] + (size_t)l * 512 * 1536, 512, 1536, (bf16*)(ws + WS_WUQ) + (size_t)l * 1536 * 512, nb * 32, kb * 64, nb * 32, scr, lane); continue; } r -= I_UQ;
        { const int kb = r / 64, nb = r % 64; transpose_item(in.p[10] + (size_t)l * 512 * 2048, 512, 2048, (bf16*)(ws + WS_WUKV) + (size_t)l * 2048 * 512, nb * 32, kb * 64, nb * 32, scr, lane); }
    }
    float* X = (float*)(ws + WS_X);
    for (int r = gw; r < M; r += NGW) { const int b = r / SEGT, s = r % SEGT;
        const float* src = (s < CTX) ? in.p[2] + ((size_t)b * CTX + s) * D : in.p[0] + ((size_t)b * SEQ + (s - CTX)) * D;
        const f32x4* sp = (const f32x4*)src + lane; f32x4* dp = (f32x4*)(X + (size_t)r * D) + lane;
#pragma unroll
        for (int j = 0; j < 8; ++j) dp[64 * j] = sp[64 * j]; }
    const int gt = bx * 512 + tid, NGT = G * 512;
    float* rope = (float*)(ws + WS_ROPE);
    for (int i = gt; i < 1024; i += NGT) { const int pos = i >> 4, f = i & 15; const float inv = powf(10000.f, -(float)f / 16.f), ang = (float)pos * inv; rope[i] = cosf(ang); rope[1024 + i] = sinf(ang); }
    bf16* W2T = (bf16*)(ws + WS_W2T); bf16* A2T = (bf16*)(ws + WS_A2T); bf16* G2T = (bf16*)(ws + WS_G2T);
    for (int i = gt; i < DEPTH * 2 * 512 * 32; i += NGT) { const int r = i & 31, c = (i >> 5) & 511, ld = i >> 14;
        W2T[i] = f2bf(in.p[13][((size_t)ld * 32 + r) * 512 + c]); A2T[i] = f2bf(in.p[15][((size_t)ld * 32 + r) * 512 + c]); }
    for (int i = gt; i < DEPTH * 512 * 96; i += NGT) { const int k = i % 96, c = (i / 96) % 512, l = i / (96 * 512);
        G2T[i] = f2bf(in.p[16][((size_t)l * 96 + k) * 512 + c]); }
    LAS float* sv = scr;
    for (int it = gw; it < DEPTH * 48 * 16; it += NGW) {
        const int kp = it & 15, ng = (it >> 4) % 48, l = it / (16 * 48);
        for (int i = lane; i < 640; i += 64) { const int v = i >> 7, k = kp * 128 + (i & 127); const float x = (v < 4) ? in.p[1][v * D + k] : in.p[3][k]; sv[i] = x * sigmoidf_(x); }
        LDS_WAIT();
        const int n = ng * 256 + lane * 4;
        const float* wp = in.p[4] + ((size_t)l * D + (size_t)kp * 128) * MODS + n;
        f32x4 acc[5];
#pragma unroll
        for (int v = 0; v < 5; ++v) acc[v] = (f32x4){0.f, 0.f, 0.f, 0.f};
#pragma unroll 8
        for (int kk = 0; kk < 128; ++kk) { const f32x4 w = *(const f32x4*)(wp + (size_t)kk * MODS);
#pragma unroll
            for (int v = 0; v < 5; ++v) acc[v] += w * sv[v * 128 + kk]; }
        float* part = (float*)(ws + WS_P) + (size_t)kp * (DEPTH * 5 * MODS);
#pragma unroll
        for (int v = 0; v < 5; ++v) *(f32x4*)(part + ((size_t)l * 5 + v) * MODS + n) = acc[v];
        LDS_WAIT();
    }
}

DI void phase_modreduce(const In& in, uchar* ws, int G, int bx, int tid) {
    using namespace cf;
    float* modv = (float*)(ws + WS_MODV); const float* part = (const float*)(ws + WS_P);
    for (int i = bx * 512 + tid; i < DEPTH * 5 * MODS / 4; i += G * 512) { const int n4 = i % (MODS / 4), l = i / (5 * MODS / 4);
        f32x4 s = *(const f32x4*)(in.p[5] + (size_t)l * MODS + n4 * 4);
#pragma unroll
        for (int kp = 0; kp < 16; ++kp) s += *(const f32x4*)(part + (size_t)kp * (DEPTH * 5 * MODS) + (size_t)i * 4);
        *(f32x4*)(modv + (size_t)i * 4) = s; }
}

DI void phase_modulate(const float* X, bf16* XM, const float* modl  , int shift_off, int scale_off, int G, int bx, int tid) {
    using namespace cf;
    const int lane = tid & 63, gw = bx * 8 + (tid >> 6), NGW = G * 8;
    for (int r = gw; r < M; r += NGW) { const int b = r / SEGT, s = r % SEGT, vec = (s < CTX) ? 4 : b;
        const f32x4* xp = (const f32x4*)(X + (size_t)r * D) + lane; const f32x4* sh = (const f32x4*)(modl + (size_t)vec * MODS + shift_off) + lane; const f32x4* sc = (const f32x4*)(modl + (size_t)vec * MODS + scale_off) + lane;
        u32x2* op = (u32x2*)(XM + (size_t)r * D) + lane;
#pragma unroll
        for (int j = 0; j < 8; ++j) { const f32x4 v = xp[64 * j] * (sc[64 * j] + 1.f) + sh[64 * j]; u32x2 o; o.x = pk2(v.x, v.y); o.y = pk2(v.z, v.w); op[64 * j] = o; } }
}

DI void phase_ln(float* X, const float* g, const float* bb, bf16* XM, const float* modl, int shift_off, int scale_off, float* out, int G, int bx, int tid) {
    using namespace cf;
    const int lane = tid & 63, gw = bx * 8 + (tid >> 6), NGW = G * 8;
    for (int r = gw; r < M; r += NGW) { const int b = r / SEGT, s = r % SEGT, vec = (s < CTX) ? 4 : b;
        if (out && s < CTX) continue;
        f32x4* xp = (f32x4*)(X + (size_t)r * D) + lane;
        f32x4 v[8]; float sum = 0.f;
#pragma unroll
        for (int j = 0; j < 8; ++j) { v[j] = xp[64 * j]; sum += (v[j].x + v[j].y) + (v[j].z + v[j].w); }
        const float mean = wave_sum(sum, lane) * (1.f / D); float s2 = 0.f;
#pragma unroll
        for (int j = 0; j < 8; ++j) { v[j] = v[j] - mean; s2 += (v[j].x * v[j].x + v[j].y * v[j].y) + (v[j].z * v[j].z + v[j].w * v[j].w); }
        const float rstd = rsqrtf(wave_sum(s2, lane) * (1.f / D) + 1e-5f);
        const f32x4* gp = (const f32x4*)g + lane; const f32x4* bp = (const f32x4*)bb + lane;
#pragma unroll
        for (int j = 0; j < 8; ++j) v[j] = v[j] * rstd * gp[64 * j] + bp[64 * j];
        if (out) { f32x4* op = (f32x4*)(out + ((size_t)b * SEQ + (s - CTX)) * D) + lane;
#pragma unroll
            for (int j = 0; j < 8; ++j) op[64 * j] = v[j];
        } else {
            const f32x4* sh = (const f32x4*)(modl + (size_t)vec * MODS + shift_off) + lane; const f32x4* sc = (const f32x4*)(modl + (size_t)vec * MODS + scale_off) + lane;
            u32x2* op = (u32x2*)(XM + (size_t)r * D) + lane;
#pragma unroll
            for (int j = 0; j < 8; ++j) { xp[64 * j] = v[j]; const f32x4 m = v[j] * (sc[64 * j] + 1.f) + sh[64 * j]; u32x2 o; o.x = pk2(m.x, m.y); o.y = pk2(m.z, m.w); op[64 * j] = o; }
        }
    }
}

DI void mla_prep_rows(const bf16* P, bf16* CQN, bf16* CKVN, bf16* Kb, const float* qn, const float* kvn, const float* rope, int G, int bx, int tid) {
    using namespace cf;
    const int lane = tid & 63, gw = bx * 8 + (tid >> 6), NGW = G * 8;
    for (int r = gw; r < M; r += NGW) { const int s = r % SEGT; const bf16* pr = P + (size_t)r * PC;
#pragma unroll
        for (int part = 0; part < 2; ++part) {
            float x[8]; unpack8(*(const u32x4*)(pr + part * 512 + lane * 8), x);
            float ss = 0.f;
#pragma unroll
            for (int e = 0; e < 8; ++e) ss += x[e] * x[e];
            const float rs = rsqrtf(wave_sum(ss, lane) * (1.f / 512.f) + 1e-6f);
            const float* gp = (part ? kvn : qn) + lane * 8; const f32x4 g0 = *(const f32x4*)gp, g1 = *(const f32x4*)(gp + 4);
            float o[8];
#pragma unroll
            for (int e = 0; e < 8; ++e) o[e] = x[e] * rs * (e < 4 ? g0[e] : g1[e - 4]);
            *(u32x4*)((part ? CKVN : CQN) + (size_t)r * 512 + lane * 8) = pack8f(o);
        }
        float kr = bf2f(pr[C_KR + lane]);
        const float other = lx(kr, lane, 16);
        if (s >= CTX) { const int t = s - CTX, axis = lane >> 5, half = (lane >> 4) & 1, f = lane & 15, pos = axis ? (t & 63) : (t >> 6);
            const float c = rope[pos * 16 + f], sn = rope[1024 + pos * 16 + f];
            kr = half ? (other * sn + kr * c) : (kr * c - other * sn); }
        const bf16 kb = f2bf(kr);
#pragma unroll
        for (int h = 0; h < 8; ++h) Kb[(size_t)r * KP + h * 192 + 128 + lane] = kb;
    }
}

DI void mix_rows(const bf16* P, const float* YR, const float* YG, const float* GATE, const float* BONUS, bf16* MIX,
                 const float* mu, const float* gn_g, const float* gn_b, const float* gdn_norm, int G, int bx, int tid) {
    using namespace cf;
    const int lane = tid & 63, gw = bx * 8 + (tid >> 6), NGW = G * 8;
    for (int r = gw; r < M; r += NGW) { const int s = r % SEGT; const bf16* pr = P + (size_t)r * PC;
        const bool hasp = (s != 0) && (s != CTX), hasn = (s != CTX - 1) && (s != SEGT - 1);
        const int c0 = lane * 8;
        {
            float y[8], v[8];
            { const f32x4 a0 = *(const f32x4*)(YR + (size_t)r * 512 + c0), a1 = *(const f32x4*)(YR + (size_t)r * 512 + c0 + 4);
              const f32x4 b0 = *(const f32x4*)(YR + ((size_t)M + r) * 512 + c0), b1 = *(const f32x4*)(YR + ((size_t)M + r) * 512 + c0 + 4);
#pragma unroll
              for (int e = 0; e < 4; ++e) { y[e] = a0[e] + b0[e]; y[4 + e] = a1[e] + b1[e]; } }
            float sm = 0.f;
#pragma unroll
            for (int e = 0; e < 8; ++e) sm += y[e];
            sm += sx<1>(sm); sm += sx<2>(sm); sm += sx<4>(sm);
            const float mean = sm * (1.f / 64.f); float q = 0.f;
#pragma unroll
            for (int e = 0; e < 8; ++e) { y[e] -= mean; q += y[e] * y[e]; }
            q += sx<1>(q); q += sx<2>(q); q += sx<4>(q);
            const float rstd = rsqrtf(q * (1.f / 64.f) + 64e-5f);
            { float cur[8], prv[8], nxt[8]; const int col = C_RW + RW_V + c0;
              unpack8(*(const u32x4*)(pr + col), cur);
              if (hasp) unpack8(*(const u32x4*)(pr - PC + col), prv); else {
#pragma unroll
                  for (int e = 0; e < 8; ++e) prv[e] = 0.f; }
              if (hasn) unpack8(*(const u32x4*)(pr + PC + col), nxt); else {
#pragma unroll
                  for (int e = 0; e < 8; ++e) nxt[e] = 0.f; }
              const f32x4 m0 = *(const f32x4*)(mu + RW_V + c0), m1 = *(const f32x4*)(mu + RW_V + c0 + 4);
#pragma unroll
              for (int e = 0; e < 8; ++e) v[e] = cur[e] + (0.5f * (prv[e] + nxt[e]) - cur[e]) * (e < 4 ? m0[e] : m1[e - 4]); }
            const int h = lane >> 3;
            const float bonus = BONUS[(size_t)r * 8 + h] + BONUS[((size_t)M + r) * 8 + h];
            const f32x4 gg0 = *(const f32x4*)(gn_g + c0), gg1 = *(const f32x4*)(gn_g + c0 + 4), gb0 = *(const f32x4*)(gn_b + c0), gb1 = *(const f32x4*)(gn_b + c0 + 4);
            const f32x4 gt0 = *(const f32x4*)(GATE + (size_t)r * 512 + c0), gt1 = *(const f32x4*)(GATE + (size_t)r * 512 + c0 + 4);
            float o[8];
#pragma unroll
            for (int e = 0; e < 8; ++e) o[e] = (y[e] * rstd * (e < 4 ? gg0[e] : gg1[e - 4]) + (e < 4 ? gb0[e] : gb1[e - 4]) + bonus * v[e]) * (e < 4 ? gt0[e] : gt1[e - 4]);
            *(u32x4*)(MIX + (size_t)r * D + 1024 + c0) = pack8f(o);
        }
        {
            float y[8], z[8];
            { const f32x4 a0 = *(const f32x4*)(YG + (size_t)r * 512 + c0), a1 = *(const f32x4*)(YG + (size_t)r * 512 + c0 + 4);
              const f32x4 b0 = *(const f32x4*)(YG + ((size_t)M + r) * 512 + c0), b1 = *(const f32x4*)(YG + ((size_t)M + r) * 512 + c0 + 4);
#pragma unroll
              for (int e = 0; e < 4; ++e) { y[e] = a0[e] + b0[e]; y[4 + e] = a1[e] + b1[e]; } }
            float q = 0.f;
#pragma unroll
            for (int e = 0; e < 8; ++e) q += y[e] * y[e];
            q += sx<1>(q); q += sx<2>(q); q += sx<4>(q); q += lx(q, lane, 8);
            const float rs = rsqrtf(q * (1.f / 128.f) + 1e-6f);
            unpack8(*(const u32x4*)(pr + C_GD + GD_Z + c0), z);
            const int cn = c0 & 127; const f32x4 n0 = *(const f32x4*)(gdn_norm + cn), n1 = *(const f32x4*)(gdn_norm + cn + 4);
            float o[8];
#pragma unroll
            for (int e = 0; e < 8; ++e) o[e] = y[e] * rs * (e < 4 ? n0[e] : n1[e - 4]) * (z[e] * sigmoidf_(z[e]));
            *(u32x4*)(MIX + (size_t)r * D + 1536 + c0) = pack8f(o);
        }
    }
}
template <int K> DI f32x4 mm_tile(const LAS bf16* A, int lda, const LAS bf16* Bt, int ldb, int tm, int tn, f32x4 acc, int lane) {
    const int r = lane & 15, q = lane >> 4;
#pragma unroll
    for (int k0 = 0; k0 < K; k0 += 32) {
        const bf16x8 a = *(const LAS bf16x8*)(A + (16 * tm + r) * lda + k0 + q * 8);
        const bf16x8 b = *(const LAS bf16x8*)(Bt + (16 * tn + r) * ldb + k0 + q * 8);
        acc = MFMA16(a, b, acc);
    }
    return acc;
}
DI void inv_offblock(const LAS float* A, LAS float* TF, LAS bf16* TT, LAS float* scr, int i, int j, int lane) {
    const int r = lane & 15, q = lane >> 4;
    float p[4] = {0.f, 0.f, 0.f, 0.f};
    for (int kb = j; kb < i; ++kb) {
#pragma unroll
        for (int s = 0; s < 16; ++s) { const float a = A[(16 * i + r) * 65 + 16 * kb + s]; const LAS float* tp = TF + (16 * kb + s) * 65 + 16 * j + 4 * q;
#pragma unroll
            for (int e = 0; e < 4; ++e) p[e] += a * tp[e]; }
    }
#pragma unroll
    for (int e = 0; e < 4; ++e) scr[r * 17 + 4 * q + e] = p[e];
    LDS_WAIT();
    float o[4] = {0.f, 0.f, 0.f, 0.f};
#pragma unroll
    for (int s = 0; s < 16; ++s) { const float t = TF[(16 * i + r) * 65 + 16 * i + s];
#pragma unroll
        for (int e = 0; e < 4; ++e) o[e] += t * scr[s * 17 + 4 * q + e]; }
#pragma unroll
    for (int e = 0; e < 4; ++e) { TF[(16 * i + r) * 65 + 16 * j + 4 * q + e] = o[e]; TT[(16 * i + r) * 72 + 16 * j + 4 * q + e] = f2bf(o[e]); }
}
DI void inv_blocked(const LAS float* A, LAS float* TF, LAS bf16* TT, LAS float* scr_all, int wid, int lane, int tid) {
    for (int i = tid; i < 64 * 72 / 8; i += 512) ((LAS u32x4*)TT)[i] = (u32x4){0u, 0u, 0u, 0u};
    LDS_BARRIER();
    if (wid < 4 && lane < 16) { const int j = lane, base = 16 * wid; float tc[16];
#pragma unroll
        for (int t = 0; t < 16; ++t) { float acc = (t == j) ? 1.f : 0.f;
#pragma unroll
            for (int s = 0; s < t; ++s) acc += A[(base + t) * 65 + base + s] * tc[s];
            tc[t] = acc; }
#pragma unroll
        for (int t = 0; t < 16; ++t) { TF[(base + t) * 65 + base + j] = tc[t]; TT[(base + t) * 72 + base + j] = f2bf(tc[t]); }
    }
    LDS_BARRIER();
    LAS float* scr = scr_all + wid * 272;
    if (wid < 3) inv_offblock(A, TF, TT, scr, wid + 1, wid, lane);
    LDS_BARRIER();
    if (wid < 2) inv_offblock(A, TF, TT, scr, wid + 2, wid, lane);
    LDS_BARRIER();
    if (wid < 1) inv_offblock(A, TF, TT, scr, 3, 0, lane);
    LDS_BARRIER();
}

struct ScanW {
    const float *mu, *w0, *a0, *k_k, *k_a, *r_k;
    const bf16 *W2T, *A2T, *G2T;
    const float *conv, *a_log, *dt_bias;
};

DI void s1_rwkv(LAS uchar* lds, const bf16* P, const ScanW& sw, uchar* task, float* GATE, float* BONUSd, int b, int h, int dir, int ci, int tid) {
    using namespace cf;
    constexpr int MB = 9216;
    LAS bf16* AT = (LAS bf16*)(lds + 0 * MB); LAS bf16* BT = (LAS bf16*)(lds + 1 * MB); LAS bf16* KT = (LAS bf16*)(lds + 2 * MB); LAS bf16* QT = (LAS bf16*)(lds + 3 * MB);
    LAS bf16* ATT = (LAS bf16*)(lds + 4 * MB); LAS bf16* VT = (LAS bf16*)(lds + 5 * MB); LAS bf16* KHT = (LAS bf16*)(lds + 6 * MB); LAS bf16* BHT = (LAS bf16*)(lds + 7 * MB);
    LAS bf16* AAK = (LAS bf16*)(lds + 8 * MB); LAS bf16* AQK = (LAS bf16*)(lds + 9 * MB); LAS bf16* TT = (LAS bf16*)(lds + 10 * MB); LAS bf16* XT = (LAS bf16*)(lds + 11 * MB);
    LAS float* AAB = (LAS float*)(lds + 12 * MB); LAS float* GC = AAB;
    LAS float* INVS = (LAS float*)(lds + 12 * MB + 16640);
    LAS float* LWf = (LAS float*)(lds + 8 * MB); LAS float* LAf = (LAS float*)(lds + 10 * MB); LAS float* TF = (LAS float*)(lds + 8 * MB);
    LAS bf16* TW = (LAS bf16*)(lds + 0); LAS bf16* AD = (LAS bf16*)(lds + 5120); LAS bf16* SG = (LAS bf16*)(lds + 10240);
    const int lane = tid & 63, wid = tid >> 6, i = tid >> 3, sub = tid & 7, r16 = lane & 15, q4 = lane >> 4;
    const int R = row_of(b, dir, ci, i), seg_lo = b * SEGT + (ci < 4 ? 0 : CTX), seg_hi = b * SEGT + (ci < 4 ? CTX : SEGT);
    const bool hasp = R - 1 >= seg_lo, hasn = R + 1 < seg_hi;
    const bf16* pr = P + (size_t)R * PC + C_RW;
    float rv[8], kv[8], vv[8];
#pragma unroll
    for (int w = 0; w < 3; ++w) { const int col = w * 512 + h * 64 + sub * 8; float cur[8], prv[8], nxt[8];
        unpack8(*(const u32x4*)(pr + col), cur);
        if (hasp) unpack8(*(const u32x4*)(pr - PC + col), prv); else {
#pragma unroll
            for (int e = 0; e < 8; ++e) prv[e] = 0.f; }
        if (hasn) unpack8(*(const u32x4*)(pr + PC + col), nxt); else {
#pragma unroll
            for (int e = 0; e < 8; ++e) nxt[e] = 0.f; }
        const f32x4 m0 = *(const f32x4*)(sw.mu + col), m1 = *(const f32x4*)(sw.mu + col + 4);
#pragma unroll
        for (int e = 0; e < 8; ++e) { const float x = cur[e] + (0.5f * (prv[e] + nxt[e]) - cur[e]) * (e < 4 ? m0[e] : m1[e - 4]); if (w == 0) rv[e] = x; else if (w == 1) kv[e] = x; else vv[e] = x; } }
#pragma unroll
    for (int w = 0; w < 2; ++w) { const int col = (w ? RW_AD : RW_WD) + dir * 32 + sub * 4;
        const u32x2 c2 = *(const u32x2*)(pr + col); u32x2 p2 = (u32x2){0u, 0u}, n2 = (u32x2){0u, 0u};
        if (hasp) p2 = *(const u32x2*)(pr - PC + col); if (hasn) n2 = *(const u32x2*)(pr + PC + col);
        const f32x4 m = *(const f32x4*)(sw.mu + col);
        const float cur[4] = {bflo(c2.x), bfhi(c2.x), bflo(c2.y), bfhi(c2.y)}, prv[4] = {bflo(p2.x), bfhi(p2.x), bflo(p2.y), bfhi(p2.y)}, nxt[4] = {bflo(n2.x), bfhi(n2.x), bflo(n2.y), bfhi(n2.y)};
        float x[4];
#pragma unroll
        for (int e = 0; e < 4; ++e) { x[e] = cur[e] + (0.5f * (prv[e] + nxt[e]) - cur[e]) * m[e]; if (w == 0) x[e] = tanhf(x[e]); }
        u32x2 o; o.x = pk2(x[0], x[1]); o.y = pk2(x[2], x[3]);
        *(LAS u32x2*)((w ? AD : TW) + i * 40 + sub * 4) = o; }
    if (dir == 0) {
#pragma unroll
        for (int j = 0; j < 3; ++j) { const int col = RW_GD + sub * 12 + j * 4;
            const u32x2 c2 = *(const u32x2*)(pr + col); u32x2 p2 = (u32x2){0u, 0u}, n2 = (u32x2){0u, 0u};
            if (hasp) p2 = *(const u32x2*)(pr - PC + col); if (hasn) n2 = *(const u32x2*)(pr + PC + col);
            const f32x4 m = *(const f32x4*)(sw.mu + col);
            const float cur[4] = {bflo(c2.x), bfhi(c2.x), bflo(c2.y), bfhi(c2.y)}, prv[4] = {bflo(p2.x), bfhi(p2.x), bflo(p2.y), bfhi(p2.y)}, nxt[4] = {bflo(n2.x), bfhi(n2.x), bflo(n2.y), bfhi(n2.y)};
            float x[4];
#pragma unroll
            for (int e = 0; e < 4; ++e) x[e] = sigmoidf_(cur[e] + (0.5f * (prv[e] + nxt[e]) - cur[e]) * m[e]);
            u32x2 o; o.x = pk2(x[0], x[1]); o.y = pk2(x[2], x[3]);
            *(LAS u32x2*)(SG + i * 104 + sub * 12 + j * 4) = o; }
    }
    LDS_BARRIER();
    { const int which = wid >> 2, tm = wid & 3;
      const bf16x8 a = *(const LAS bf16x8*)((which ? AD : TW) + (16 * tm + r16) * 40 + q4 * 8);
      const bf16* wt = (which ? sw.A2T : sw.W2T) + ((size_t)dir * 512 + h * 64) * 32;
#pragma unroll
      for (int tn = 0; tn < 4; ++tn) { const bf16x8 bb = *(const bf16x8*)(wt + (16 * tn + r16) * 32 + q4 * 8);
          const f32x4 acc = MFMA16(a, bb, ((f32x4){0.f, 0.f, 0.f, 0.f}));
#pragma unroll
          for (int e = 0; e < 4; ++e) (which ? LAf : LWf)[(16 * tm + 4 * q4 + e) * 65 + 16 * tn + r16] = acc[e]; } }
    if (dir == 0) { const int tm = wid >> 1;
#pragma unroll
        for (int j = 0; j < 2; ++j) { const int tn = (wid & 1) * 2 + j; f32x4 acc = (f32x4){0.f, 0.f, 0.f, 0.f};
#pragma unroll
            for (int k0 = 0; k0 < 96; k0 += 32) { const bf16x8 a = *(const LAS bf16x8*)(SG + (16 * tm + r16) * 104 + k0 + q4 * 8);
                const bf16x8 bb = *(const bf16x8*)(sw.G2T + (size_t)(h * 64 + 16 * tn + r16) * 96 + k0 + q4 * 8); acc = MFMA16(a, bb, acc); }
#pragma unroll
            for (int e = 0; e < 4; ++e) GATE[(size_t)row_of(b, 0, ci, 16 * tm + 4 * q4 + e) * 512 + h * 64 + 16 * tn + r16] = acc[e]; } }
    LDS_BARRIER();
    float av[8], bv[8], kd[8], lw[8];
#ifdef S1DBG
    float dbgv[8];
#endif
    { const int hc = h * 64 + sub * 8; float ss = 0.f, bon = 0.f, kk[8], al[8];
#pragma unroll
      for (int e = 0; e < 8; ++e) { const int c = sub * 8 + e;
          const float wl = -softplusf_(-(sw.w0[dir * 512 + hc + e] + LWf[i * 65 + c])) - 0.5f; lw[e] = -__expf(wl);
          al[e] = sigmoidf_(sw.a0[dir * 512 + hc + e] + LAf[i * 65 + c]);
          kk[e] = kv[e] * sw.k_k[hc + e]; ss += kk[e] * kk[e]; }
      ss += sx<1>(ss); ss += sx<2>(ss); ss += sx<4>(ss);
      const float rn = rsqrtf(ss + 1e-12f);
#pragma unroll
      for (int e = 0; e < 8; ++e) { kk[e] *= rn; kd[e] = kv[e] * (1.f + (al[e] - 1.f) * sw.k_a[hc + e]); av[e] = -kk[e]; bv[e] = kk[e] * al[e]; bon += rv[e] * kd[e] * sw.r_k[hc + e];
#ifdef S1DBG
          dbgv[e] = (S1DBG == 1) ? al[e] : kk[e];
#endif
      }
      bon += sx<1>(bon); bon += sx<2>(bon); bon += sx<4>(bon);
      if (sub == 0) BONUSd[(size_t)R * 8 + h] = bon;
#pragma unroll
      for (int e = 0; e < 8; ++e) GC[i * 64 + sub * 8 + e] = lw[e]; }
    LDS_BARRIER();
    if (wid == 0) { float run = 0.f;
#pragma unroll 8
        for (int t = 0; t < 64; ++t) { run += GC[t * 64 + lane]; GC[t * 64 + lane] = run; } }
    LDS_BARRIER();
    { float at[8], bt[8], kt[8], qt[8], bh[8], kh[8];
#pragma unroll
      for (int e = 0; e < 8; ++e) { const int c = sub * 8 + e; const float Gi = GC[i * 64 + c], Gm = (i > 0) ? GC[(i - 1) * 64 + c] : 0.f, GL = GC[63 * 64 + c];
          const float eG = __expf(Gi), eGm = __expf(Gm), enG = __expf(-Gi), eLG = __expf(GL - Gi);
          at[e] = av[e] * eGm; bt[e] = bv[e] * enG; kt[e] = kd[e] * enG; qt[e] = rv[e] * eG;
#ifdef S1DBG
          qt[e] = dbgv[e];
#endif
          bh[e] = bv[e] * eLG; kh[e] = kd[e] * eLG;
          if (i == 63) ((float*)(task + 57344))[c] = eG; }
      *(LAS u32x4*)(AT + i * 72 + sub * 8) = pack8f(at); *(LAS u32x4*)(BT + i * 72 + sub * 8) = pack8f(bt); *(LAS u32x4*)(KT + i * 72 + sub * 8) = pack8f(kt); *(LAS u32x4*)(QT + i * 72 + sub * 8) = pack8f(qt);
#pragma unroll
      for (int e = 0; e < 8; ++e) { const int c = sub * 8 + e; ATT[c * 72 + i] = f2bf(at[e]); VT[c * 72 + i] = f2bf(vv[e]); KHT[c * 72 + i] = f2bf(kh[e]); BHT[c * 72 + i] = f2bf(bh[e]); } }
    LDS_BARRIER();
    { const int mat = wid >> 1;
      const LAS bf16* Am = (mat < 2) ? AT : QT; const LAS bf16* Bm = (mat == 0 || mat == 2) ? BT : KT;
#pragma unroll 1
      for (int j = 0; j < 8; ++j) { const int idx = (wid & 1) * 8 + j, tm = idx >> 2, tn = idx & 3;
          f32x4 acc = (f32x4){0.f, 0.f, 0.f, 0.f};
          if (tm >= tn) acc = mm_tile<64>(Am, 72, Bm, 72, tm, tn, acc, lane);
#pragma unroll
          for (int e = 0; e < 4; ++e) { const int ti = 16 * tm + 4 * q4 + e, tj = 16 * tn + r16; const bool keep = (mat < 2) ? (ti > tj) : (ti >= tj); const float v = keep ? acc[e] : 0.f;
              if (mat == 0) AAB[ti * 65 + tj] = v; else if (mat == 1) AAK[ti * 72 + tj] = f2bf(v); else if (mat == 3) AQK[ti * 72 + tj] = f2bf(v); else ((bf16*)(task + 16384))[ti * 64 + tj] = f2bf(v); } } }
    LDS_BARRIER();
#pragma unroll 1
    for (int j = 0; j < 6; ++j) { const int idx = wid * 6 + j, mat = idx >> 4, tm = (idx >> 2) & 3, tn = idx & 3;
        const LAS bf16* Am = (mat == 0) ? AAK : (mat == 1) ? AQK : KHT;
        const f32x4 acc = mm_tile<64>(Am, 72, VT, 72, tm, tn, (f32x4){0.f, 0.f, 0.f, 0.f}, lane);
        if (mat == 0) { u32x2 o; o.x = pk2(acc[0], acc[1]); o.y = pk2(acc[2], acc[3]); *(LAS u32x2*)(XT + (16 * tn + r16) * 72 + 16 * tm + 4 * q4) = o; }
        else { bf16* dst = (bf16*)(task + (mat == 1 ? 40960 : 49152));
#pragma unroll
            for (int e = 0; e < 4; ++e) dst[(16 * tm + 4 * q4 + e) * 64 + 16 * tn + r16] = f2bf(acc[e]); } }
    *(u32x4*)(task + 8192 + (size_t)tid * 16) = *(const LAS u32x4*)(QT + (tid >> 3) * 72 + (tid & 7) * 8);
    *(u32x4*)(task + 24576 + (size_t)tid * 16) = *(const LAS u32x4*)(BHT + (tid >> 3) * 72 + (tid & 7) * 8);
    LDS_BARRIER();
    inv_blocked(AAB, TF, TT, INVS, wid, lane, tid);
    { const int mat = wid >> 2, tm = wid & 3; bf16* dst = (bf16*)(task + (mat ? 32768 : 0));
#pragma unroll 1
      for (int tn = 0; tn < 4; ++tn) { const f32x4 acc = mm_tile<64>(TT, 72, mat ? XT : ATT, 72, tm, tn, (f32x4){0.f, 0.f, 0.f, 0.f}, lane);
#pragma unroll
          for (int e = 0; e < 4; ++e) dst[(16 * tm + 4 * q4 + e) * 64 + 16 * tn + r16] = f2bf(acc[e]); } }
    LDS_BARRIER();
}

DI void s1_gdn(LAS uchar* lds, const bf16* P, const ScanW& sw, uchar* task, int b, int h, int dir, int ci, int tid) {
    using namespace cf;
    LAS bf16* KL = (LAS bf16*)(lds + 0); LAS bf16* QL = (LAS bf16*)(lds + 17408);
    LAS bf16* VT = (LAS bf16*)(lds + 34816); LAS bf16* KBT = (LAS bf16*)(lds + 53248); LAS bf16* BHT = (LAS bf16*)(lds + 71680);
    LAS bf16* TT = (LAS bf16*)(lds + 90112); LAS float* AAB = (LAS float*)(lds + 99328); LAS float* TF = (LAS float*)(lds + 115968);
    LAS float* INVS = (LAS float*)(lds + 132608); LAS float* gvec = (LAS float*)(lds + 136960);
    const int lane = tid & 63, wid = tid >> 6, i = tid >> 3, sub = tid & 7, r16 = lane & 15, q4 = lane >> 4;
    const int R = row_of(b, dir, ci, i), seg_lo = b * SEGT + (ci < 4 ? 0 : CTX), seg_hi = b * SEGT + (ci < 4 ? CTX : SEGT);
    const bf16* pr = P + (size_t)R * PC + C_GD;
    float qv[16], kv[16], vv[16];
#pragma unroll
    for (int w = 0; w < 3; ++w) { const int col = w * 512 + h * 128 + sub * 16; float acc[16];
#pragma unroll
        for (int e = 0; e < 16; ++e) acc[e] = 0.f;
#pragma unroll
        for (int j = 0; j < 5; ++j) { const int Rj = R + j - 2;
            if (Rj >= seg_lo && Rj < seg_hi) { float x[16]; float xa[8], xb[8];
                unpack8(*(const u32x4*)(pr + (ptrdiff_t)(j - 2) * PC + col), xa); unpack8(*(const u32x4*)(pr + (ptrdiff_t)(j - 2) * PC + col + 8), xb);
#pragma unroll
                for (int e = 0; e < 8; ++e) { x[e] = xa[e]; x[8 + e] = xb[e]; }
                const float* cw = sw.conv + (size_t)j * 1536 + col;
#pragma unroll
                for (int e4 = 0; e4 < 4; ++e4) { const f32x4 c4 = *(const f32x4*)(cw + 4 * e4);
#pragma unroll
                    for (int e = 0; e < 4; ++e) acc[4 * e4 + e] += c4[e] * x[4 * e4 + e]; } } }
#pragma unroll
        for (int e = 0; e < 16; ++e) { const float x = acc[e] * sigmoidf_(acc[e]); if (w == 0) qv[e] = x; else if (w == 1) kv[e] = x; else vv[e] = x; } }
    { float sq = 0.f, sk = 0.f;
#pragma unroll
      for (int e = 0; e < 16; ++e) { sq += qv[e] * qv[e]; sk += kv[e] * kv[e]; }
      sq += sx<1>(sq); sq += sx<2>(sq); sq += sx<4>(sq); sk += sx<1>(sk); sk += sx<2>(sk); sk += sx<4>(sk);
      const float rq = rsqrtf(sq + 1e-12f) * 0.08838834764831845f, rk = rsqrtf(sk + 1e-12f);
#pragma unroll
      for (int e = 0; e < 16; ++e) { qv[e] *= rq; kv[e] *= rk; } }
    if (sub == 0) { const float a_raw = bf2f(pr[GD_A + dir * 4 + h]), b_raw = bf2f(pr[GD_B + dir * 4 + h]);
        gvec[i] = -__expf(sw.a_log[dir * 4 + h]) * softplusf_(a_raw + sw.dt_bias[dir * 4 + h]); gvec[64 + i] = sigmoidf_(b_raw); }
    { float t0[8], t1[8];
#pragma unroll
      for (int e = 0; e < 8; ++e) { t0[e] = kv[e]; t1[e] = kv[8 + e]; }
      *(LAS u32x4*)(KL + i * 136 + sub * 16) = pack8f(t0); *(LAS u32x4*)(KL + i * 136 + sub * 16 + 8) = pack8f(t1);
#pragma unroll
      for (int e = 0; e < 8; ++e) { t0[e] = qv[e]; t1[e] = qv[8 + e]; }
      *(LAS u32x4*)(QL + i * 136 + sub * 16) = pack8f(t0); *(LAS u32x4*)(QL + i * 136 + sub * 16 + 8) = pack8f(t1); }
    LDS_BARRIER();
    if (wid == 0) { float g = 0.f;
#pragma unroll 8
        for (int t = 0; t < 64; ++t) { const float x = gvec[t]; g += (t <= lane) ? x : 0.f; }
        gvec[128 + lane] = g; }
    LDS_BARRIER();
    { const float Gi = gvec[128 + i], GL = gvec[128 + 63], be = gvec[64 + i], eG = __expf(Gi), eLG = __expf(GL - Gi), beG = be * eG;
      float t0[8], t1[8];
#pragma unroll
      for (int e = 0; e < 8; ++e) { t0[e] = qv[e] * eG; t1[e] = qv[8 + e] * eG; }
      *(u32x4*)(task + 16384 + ((size_t)i * 128 + sub * 16) * 2) = pack8f(t0); *(u32x4*)(task + 16384 + ((size_t)i * 128 + sub * 16 + 8) * 2) = pack8f(t1);
#pragma unroll
      for (int e = 0; e < 16; ++e) { const int c = sub * 16 + e; VT[c * 72 + i] = f2bf(be * vv[e]); KBT[c * 72 + i] = f2bf(beG * kv[e]); BHT[c * 72 + i] = f2bf(kv[e] * eLG); }
      if (tid < 128) ((float*)(task + 73728))[tid] = __expf(GL); }
#pragma unroll 1
    for (int j = 0; j < 4; ++j) { const int idx = wid * 4 + j, mat = idx >> 4, tm = (idx >> 2) & 3, tn = idx & 3;
        f32x4 acc = (f32x4){0.f, 0.f, 0.f, 0.f};
        if (tm >= tn) acc = mm_tile<128>(mat ? QL : KL, 136, KL, 136, tm, tn, acc, lane);
        const float Gj = gvec[128 + 16 * tn + r16];
#pragma unroll
        for (int e = 0; e < 4; ++e) { const int ti = 16 * tm + 4 * q4 + e, tj = 16 * tn + r16; const float dec = __expf(fminf(gvec[128 + ti] - Gj, 0.f));
            if (mat == 0) AAB[ti * 65 + tj] = (ti > tj) ? -gvec[64 + ti] * acc[e] * dec : 0.f;
            else ((bf16*)(task + 32768))[ti * 64 + tj] = f2bf((ti >= tj) ? acc[e] * dec : 0.f); } }
    LDS_BARRIER();
    inv_blocked(AAB, TF, TT, INVS, wid, lane, tid);
#pragma unroll 1
    for (int j = 0; j < 8; ++j) { const int idx = wid * 8 + j, mat = idx >> 5, tm = (idx >> 3) & 3, tn = idx & 7;
        const f32x4 acc = mm_tile<64>(TT, 72, mat ? KBT : VT, 72, tm, tn, (f32x4){0.f, 0.f, 0.f, 0.f}, lane);
        bf16* dst = (bf16*)(task + (mat ? 0 : 57344)); const float sgn = mat ? -1.f : 1.f;
#pragma unroll
        for (int e = 0; e < 4; ++e) dst[(16 * tm + 4 * q4 + e) * 128 + 16 * tn + r16] = f2bf(sgn * acc[e]); }
#pragma unroll
    for (int j = 0; j < 2; ++j) { const int ch = tid + 512 * j, row = ch >> 3, c8 = ch & 7; *(u32x4*)(task + 40960 + (size_t)ch * 16) = *(const LAS u32x4*)(BHT + row * 72 + c8 * 8); }
    LDS_BARRIER();
}

template <int NK, bool LOC> struct S2Frag { bf16x8 wt[NK / 32], qt[NK / 32], aqb[2], bht[2]; bf16 ul[2][4], yl[2][4], kl[NK / 32][4]; f32x4 gl; };
template <int NK, bool LOC>
DI void s2_load(S2Frag<NK, LOC>& f, const uchar* task, int o_wt, int o_qt, int o_aqb, int o_bht, int o_ul, int ldu, int ucol0, int o_yl, int o_kl, int o_gl, int tm, int tn0, int cm, int ctn0, int lane) {
    const int r16 = lane & 15, q4 = lane >> 4;
#pragma unroll
    for (int k = 0; k < NK / 32; ++k) { f.wt[k] = *(const bf16x8*)(task + o_wt + ((size_t)(16 * tm + r16) * NK + k * 32 + q4 * 8) * 2); f.qt[k] = *(const bf16x8*)(task + o_qt + ((size_t)(16 * tm + r16) * NK + k * 32 + q4 * 8) * 2); }
#pragma unroll
    for (int k = 0; k < 2; ++k) { f.aqb[k] = *(const bf16x8*)(task + o_aqb + ((size_t)(16 * tm + r16) * 64 + k * 32 + q4 * 8) * 2); f.bht[k] = *(const bf16x8*)(task + o_bht + ((size_t)(16 * cm + r16) * 64 + k * 32 + q4 * 8) * 2); }
#pragma unroll
    for (int j = 0; j < 2; ++j)
#pragma unroll
        for (int e = 0; e < 4; ++e) { f.ul[j][e] = *(const bf16*)(task + o_ul + ((size_t)(16 * tm + 4 * q4 + e) * ldu + ucol0 + 16 * (tn0 + j) + r16) * 2);
            if (LOC) f.yl[j][e] = *(const bf16*)(task + o_yl + ((size_t)(16 * tm + 4 * q4 + e) * 64 + 16 * (tn0 + j) + r16) * 2); }
    if (LOC) {
#pragma unroll
        for (int j = 0; j < NK / 32; ++j)
#pragma unroll
            for (int e = 0; e < 4; ++e) f.kl[j][e] = *(const bf16*)(task + o_kl + ((size_t)(16 * cm + 4 * q4 + e) * 64 + 16 * (ctn0 + j) + r16) * 2);
    }
    f.gl = *(const f32x4*)(task + o_gl + (size_t)(16 * cm + 4 * q4) * 4);
}
template <int NK, bool LOC>
DI void s2_scan(LAS uchar* lds, const uchar* task0, int task_bytes, int o_wt, int o_qt, int o_aqb, int o_bht, int o_ul, int ldu, int ucol0, int o_yl, int o_kl, int o_gl,
                float* Y, int ycol0, int b, int dir, int tid) {
    constexpr int NH = NK / 32, LDH = NK + 8;
    LAS bf16* HT = (LAS bf16*)lds;
    LAS bf16* UT = (LAS bf16*)(lds + 2 * 64 * LDH * 2);
    const int lane = tid & 63, wid = tid >> 6, r16 = lane & 15, q4 = lane >> 4;
    const int tm = wid >> 1, tn0 = (wid & 1) * 2;
    const int cm = (NK == 64) ? (wid >> 1) : wid, ctn0 = (NK == 64) ? (wid & 1) * 2 : 0;
    for (int i = tid; i < 64 * LDH * 2 / 16; i += 512) ((LAS u32x4*)HT)[i] = (u32x4){0u, 0u, 0u, 0u};
    f32x4 H[NH];
#pragma unroll
    for (int j = 0; j < NH; ++j) H[j] = (f32x4){0.f, 0.f, 0.f, 0.f};
    S2Frag<NK, LOC> cur;
    s2_load<NK, LOC>(cur, task0, o_wt, o_qt, o_aqb, o_bht, o_ul, ldu, ucol0, o_yl, o_kl, o_gl, tm, tn0, cm, ctn0, lane);
    LDS_BARRIER();
#pragma unroll 1
    for (int ci = 0; ci < cf::NCH; ++ci) {
        S2Frag<NK, LOC> nxt;
        { const int cn = (ci + 1 < cf::NCH) ? ci + 1 : ci;
          s2_load<NK, LOC>(nxt, task0 + (size_t)cn * task_bytes, o_wt, o_qt, o_aqb, o_bht, o_ul, ldu, ucol0, o_yl, o_kl, o_gl, tm, tn0, cm, ctn0, lane); }
        const LAS bf16* Hc = HT + (ci & 1) * 64 * LDH; LAS bf16* Hn = HT + ((ci + 1) & 1) * 64 * LDH;
        f32x4 U[2], Yv[2];
#pragma unroll
        for (int j = 0; j < 2; ++j) {
            U[j] = (f32x4){bf2f(cur.ul[j][0]), bf2f(cur.ul[j][1]), bf2f(cur.ul[j][2]), bf2f(cur.ul[j][3])};
            Yv[j] = LOC ? (f32x4){bf2f(cur.yl[j][0]), bf2f(cur.yl[j][1]), bf2f(cur.yl[j][2]), bf2f(cur.yl[j][3])} : (f32x4){0.f, 0.f, 0.f, 0.f};
#pragma unroll
            for (int k = 0; k < NK / 32; ++k) { const bf16x8 hb = *(const LAS bf16x8*)(Hc + (16 * (tn0 + j) + r16) * LDH + k * 32 + q4 * 8);
                U[j] = MFMA16(cur.wt[k], hb, U[j]); Yv[j] = MFMA16(cur.qt[k], hb, Yv[j]); }
            u32x2 o; o.x = pk2(U[j][0], U[j][1]); o.y = pk2(U[j][2], U[j][3]);
            *(LAS u32x2*)(UT + (16 * (tn0 + j) + r16) * 72 + 16 * tm + 4 * q4) = o;
        }
        LDS_BARRIER();
#pragma unroll
        for (int j = 0; j < 2; ++j) {
#pragma unroll
            for (int k = 0; k < 2; ++k) { const bf16x8 ub = *(const LAS bf16x8*)(UT + (16 * (tn0 + j) + r16) * 72 + k * 32 + q4 * 8); Yv[j] = MFMA16(cur.aqb[k], ub, Yv[j]); }
#pragma unroll
            for (int e = 0; e < 4; ++e) Y[(size_t)row_of(b, dir, ci, 16 * tm + 4 * q4 + e) * 512 + ycol0 + 16 * (tn0 + j) + r16] = Yv[j][e];
        }
#pragma unroll
        for (int j = 0; j < NH; ++j) {
            f32x4 h = H[j] * cur.gl;
            if (LOC) h += (f32x4){bf2f(cur.kl[j][0]), bf2f(cur.kl[j][1]), bf2f(cur.kl[j][2]), bf2f(cur.kl[j][3])};
#pragma unroll
            for (int k = 0; k < 2; ++k) { const bf16x8 ub = *(const LAS bf16x8*)(UT + (16 * (ctn0 + j) + r16) * 72 + k * 32 + q4 * 8); h = MFMA16(cur.bht[k], ub, h); }
            H[j] = h;
            u32x2 o; o.x = pk2(h[0], h[1]); o.y = pk2(h[2], h[3]);
            *(LAS u32x2*)(Hn + (16 * (ctn0 + j) + r16) * LDH + 16 * cm + 4 * q4) = o;
        }
        LDS_BARRIER();
        cur = nxt;
    }
}
namespace at {
constexpr int DQ = 192, DV = 128, NW = 8, QBLK = 32, KVBLK = 64;
constexpr float SCALE = 0.07216878364870322f;
constexpr float THR = 8.f;
constexpr int SHM_V = KVBLK * DV * 2, SHM_K = KVBLK * DQ * 2, SHM_Q = NW * 8 * 1024, SHM_ATTN = 2 * SHM_V + 2 * SHM_K + NW * 64 * 4 + SHM_Q;
#define KSWZ(row, colB) ((row) * 384 + ((colB) ^ (((row) & 7) << 4)))
#define SBAR() __builtin_amdgcn_sched_barrier(0)
DI int crow(int r, int hi) { return (r & 3) + 8 * (r >> 2) + 4 * hi; }
DI unsigned cvtpk(float lo, float hi) { const f32x2 v = {lo, hi}; return __builtin_bit_cast(unsigned, __builtin_convertvector(v, bf16x2_t)); }
DI void partialSM(f32x16& p0, f32x16& p1, float& m_reg, float& mn, float& alpha) {
  constexpr float C = SCALE * 1.4426950408889634f;
  float pmax = p0[0];
#pragma unroll
  for (int r = 1; r < 16; ++r) pmax = fmaxf(pmax, p0[r]);
#pragma unroll
  for (int r = 0; r < 16; ++r) pmax = fmaxf(pmax, p1[r]);
  { auto rr = __builtin_amdgcn_permlane32_swap(__float_as_uint(pmax), __float_as_uint(pmax), false, false);
    pmax = fmaxf(__uint_as_float(rr[0]), __uint_as_float(rr[1])); }
  if (__builtin_expect(__all(pmax - m_reg <= THR / SCALE), 1)) { mn = m_reg; alpha = 1.f; }
  else { mn = fmaxf(m_reg, pmax); alpha = __builtin_amdgcn_exp2f((m_reg - mn) * C); m_reg = mn; }
  float mnC = -mn * C;
#pragma unroll
  for (int r = 0; r < 16; ++r) p0[r] = fmaf(p0[r], C, mnC);
#pragma unroll
  for (int r = 0; r < 16; ++r) p1[r] = fmaf(p1[r], C, mnC);
#pragma unroll
  for (int r = 0; r < 16; ++r) p0[r] = __builtin_amdgcn_exp2f(p0[r]);
}
DI void finishSM(f32x16& p0, f32x16& p1, float alpha, float& l_reg, bf16x8& pa0, bf16x8& pa1, bf16x8& pa2, bf16x8& pa3) {
#pragma unroll
  for (int r = 0; r < 16; ++r) p1[r] = __builtin_amdgcn_exp2f(p1[r]);
  float ps = 0;
#pragma unroll
  for (int r = 0; r < 16; ++r) ps += p0[r];
#pragma unroll
  for (int r = 0; r < 16; ++r) ps += p1[r];
  { auto rr = __builtin_amdgcn_permlane32_swap(__float_as_uint(ps), __float_as_uint(ps), false, false);
    ps = __uint_as_float(rr[0]) + __uint_as_float(rr[1]); }
  l_reg = l_reg * alpha + ps;
#define PK4(P, BASE, OUT) do { unsigned a0 = cvtpk(P[BASE + 0], P[BASE + 1]), a1 = cvtpk(P[BASE + 2], P[BASE + 3]);   \
    unsigned b0 = cvtpk(P[BASE + 4], P[BASE + 5]), b1 = cvtpk(P[BASE + 6], P[BASE + 7]);                              \
    auto r0 = __builtin_amdgcn_permlane32_swap(a0, b0, false, false); auto r1 = __builtin_amdgcn_permlane32_swap(a1, b1, false, false); \
    u32x4 w = {r0[0], r1[0], r0[1], r1[1]}; OUT = *reinterpret_cast<bf16x8*>(&w); } while (0)
  PK4(p0, 0, pa0); PK4(p0, 8, pa1); PK4(p1, 0, pa2); PK4(p1, 8, pa3);
#undef PK4
}
constexpr int NQR = 4;
DI void qkt(f32x16& p0, f32x16& p1, const LAS char* Ks, const bf16x8* qr, const LAS char* qlds, int r32, int hi) {
  p0 = f32x16{}; p1 = f32x16{};
#pragma unroll
  for (int d0 = 0; d0 < 12; ++d0) { int cb = (d0 * 16 + hi * 8) * 2;
    const bf16x8 qf = (d0 < NQR) ? qr[d0] : *(const LAS bf16x8*)(qlds + (d0 - NQR) * 1024);
    bf16x8 b0 = *(const LAS bf16x8*)(Ks + KSWZ(r32, cb));
    bf16x8 b1 = *(const LAS bf16x8*)(Ks + KSWZ(32 + r32, cb));
    p0 = __builtin_amdgcn_mfma_f32_32x32x16_bf16(b0, qf, p0, 0, 0, 0);
    p1 = __builtin_amdgcn_mfma_f32_32x32x16_bf16(b1, qf, p1, 0, 0, 0); }
}
DI int v_st(int k, int c) { const int kk = (k & ~0xC) | ((k & 4) << 1) | ((k & 8) >> 1); return ((kk >> 3) * 4 + (c >> 5)) * 512 + ((kk & 7) * 32 + (c & 31)) * 2; }
DI int v_rd_base(int lane) { return ((lane & 3) << 3) | (((lane >> 2) & 3) << 6) | (((lane >> 4) & 1) << 5) | (((lane >> 5) & 1) << 8); }
constexpr int v_rd_off(int d0, int ks, int half) { return d0 * 512 + ks * 4096 + half * 2048; }
template <int OFF> DI s16x4 tr_read(int vb) { s16x4 r; asm volatile("ds_read_b64_tr_b16 %0, %1 offset:%2" : "=&v"(r) : "v"(vb), "i"(OFF) : "memory"); return r; }
template <int D0> DI void pv_one(f32x16& od, int vb, bf16x8 pa0, bf16x8 pa1, bf16x8 pa2, bf16x8 pa3) {
  const s16x4 l0 = tr_read<v_rd_off(D0, 0, 0)>(vb), h0 = tr_read<v_rd_off(D0, 0, 1)>(vb), l1 = tr_read<v_rd_off(D0, 1, 0)>(vb), h1 = tr_read<v_rd_off(D0, 1, 1)>(vb);
  const s16x4 l2 = tr_read<v_rd_off(D0, 2, 0)>(vb), h2 = tr_read<v_rd_off(D0, 2, 1)>(vb), l3 = tr_read<v_rd_off(D0, 3, 0)>(vb), h3 = tr_read<v_rd_off(D0, 3, 1)>(vb);
  asm volatile("s_waitcnt lgkmcnt(0)" ::: "memory"); SBAR();
#define PK(L, H) (bf16x8){L[0], L[1], L[2], L[3], H[0], H[1], H[2], H[3]}
  od = __builtin_amdgcn_mfma_f32_32x32x16_bf16(pa0, PK(l0, h0), od, 0, 0, 0);
  od = __builtin_amdgcn_mfma_f32_32x32x16_bf16(pa1, PK(l1, h1), od, 0, 0, 0);
  od = __builtin_amdgcn_mfma_f32_32x32x16_bf16(pa2, PK(l2, h2), od, 0, 0, 0);
  od = __builtin_amdgcn_mfma_f32_32x32x16_bf16(pa3, PK(l3, h3), od, 0, 0, 0);
#undef PK
}
DI void pv_d0(f32x16* o, int vb, bf16x8 pa0, bf16x8 pa1, bf16x8 pa2, bf16x8 pa3) {
  pv_one<0>(o[0], vb, pa0, pa1, pa2, pa3); pv_one<1>(o[1], vb, pa0, pa1, pa2, pa3); pv_one<2>(o[2], vb, pa0, pa1, pa2, pa3); pv_one<3>(o[3], vb, pa0, pa1, pa2, pa3);
}
DI void attn_unit(const bf16* __restrict__ Qb, const bf16* __restrict__ Kh, const bf16* __restrict__ Vh, bf16* __restrict__ Ob, int seq, const float* rope, int pos0, LAS char* lds, const int tid) {
  constexpr int LDQ = cf::QP, LDKK = cf::KP, LDVV = cf::VP, LDO = cf::D;
  const int wid = tid >> 6, lane = tid & 63, r32 = lane & 31, hi = lane >> 5;
  LAS char* V_lds = lds; LAS char* K_lds = lds + 2 * SHM_V;
  LAS float* ws = (LAS float*)(lds + 2 * SHM_V + 2 * SHM_K) + wid * 64; LAS float* li_l = ws; LAS float* al_l = ws + 32;
  LAS char* qlds = lds + 2 * SHM_V + 2 * SHM_K + NW * 64 * 4 + wid * (12 - NQR) * 1024 + lane * 16;
  float m_reg = -1e30f, l_reg = 0; f32x16 o[4] = {}; bf16x8 qr[12];
  const bf16* Qw = Qb + (long)(wid * QBLK + r32) * LDQ + hi * 8;
#pragma unroll
  for (int d0 = 0; d0 < 12; ++d0) qr[d0] = *reinterpret_cast<const bf16x8*>(Qw + d0 * 16);
  if (rope) { const int t = pos0 + wid * QBLK + r32;
#pragma unroll
    for (int ax = 0; ax < 2; ++ax) { const int pos = ax ? (t & 63) : (t >> 6);
      const f32x4 c0 = *(const f32x4*)(rope + pos * 16 + hi * 8), c1 = *(const f32x4*)(rope + pos * 16 + hi * 8 + 4), s0 = *(const f32x4*)(rope + 1024 + pos * 16 + hi * 8), s1 = *(const f32x4*)(rope + 1024 + pos * 16 + hi * 8 + 4);
      float x1[8], x2[8], o1[8], o2[8]; unpack8(__builtin_bit_cast(u32x4, qr[8 + 2 * ax]), x1); unpack8(__builtin_bit_cast(u32x4, qr[9 + 2 * ax]), x2);
#pragma unroll
      for (int e = 0; e < 8; ++e) { const float c = e < 4 ? c0[e] : c1[e - 4], s = e < 4 ? s0[e] : s1[e - 4]; o1[e] = x1[e] * c - x2[e] * s; o2[e] = x1[e] * s + x2[e] * c; }
      qr[8 + 2 * ax] = __builtin_bit_cast(bf16x8, pack8f(o1)); qr[9 + 2 * ax] = __builtin_bit_cast(bf16x8, pack8f(o2)); } }
#pragma unroll
  for (int d0 = NQR; d0 < 12; ++d0) *(LAS bf16x8*)(qlds + (d0 - NQR) * 1024) = qr[d0];
  const int sr = tid >> 4, sc = (tid & 15) * 8, vst0 = v_st(sr, sc), vst1 = v_st(32 + sr, sc);
  int kr_[3], kc_[3];
#pragma unroll
  for (int j = 0; j < 3; ++j) { const int q = tid + 512 * j; kr_[j] = q / 24; kc_[j] = (q % 24) * 8; }
  const int vb0 = (int)(uintptr_t)V_lds + v_rd_base(lane);
  bf16x8 vs0 = {}, vs1 = {}, ks0 = {}, ks1 = {}, ks2 = {};
#define SLOAD(k0) do { vs0 = *(const bf16x8*)(&Vh[(long)((k0) + sr) * LDVV + sc]); vs1 = *(const bf16x8*)(&Vh[(long)((k0) + 32 + sr) * LDVV + sc]); \
    ks0 = *(const bf16x8*)(&Kh[(long)((k0) + kr_[0]) * LDKK + kc_[0]]); ks1 = *(const bf16x8*)(&Kh[(long)((k0) + kr_[1]) * LDKK + kc_[1]]); ks2 = *(const bf16x8*)(&Kh[(long)((k0) + kr_[2]) * LDKK + kc_[2]]); } while (0)
#define SWRITE(b) do { *(LAS bf16x8*)(V_lds + (b) * SHM_V + vst0) = vs0; *(LAS bf16x8*)(V_lds + (b) * SHM_V + vst1) = vs1; \
    *(LAS bf16x8*)(K_lds + (b) * SHM_K + KSWZ(kr_[0], kc_[0] * 2)) = ks0; *(LAS bf16x8*)(K_lds + (b) * SHM_K + KSWZ(kr_[1], kc_[1] * 2)) = ks1; *(LAS bf16x8*)(K_lds + (b) * SHM_K + KSWZ(kr_[2], kc_[2] * 2)) = ks2; } while (0)
#define SWAIT() asm volatile("s_waitcnt vmcnt(0)" ::: "memory")
#define RESC(a) do { if (__any((a) < 1.f)) { if (hi == 0) al_l[r32] = (a); asm volatile("s_waitcnt lgkmcnt(0)" ::: "memory"); \
    _Pragma("unroll") for (int d = 0; d < 4; ++d) _Pragma("unroll") for (int r = 0; r < 16; ++r) o[d][r] *= al_l[crow(r, hi)]; } } while (0)
  f32x16 pA0 = {}, pA1 = {}, pB0 = {}, pB1 = {}; float mnA = 0.f, mnB = 0.f, alA = 1.f, alB = 1.f; bf16x8 pa0 = {}, pa1 = {}, pa2 = {}, pa3 = {}; const int NT = seq / KVBLK;
  SLOAD(0); SWAIT(); SWRITE(0); __syncthreads();
  qkt(pA0, pA1, K_lds, qr, qlds, r32, hi); partialSM(pA0, pA1, m_reg, mnA, alA);
  SLOAD(KVBLK);
  SWAIT(); SWRITE(1); __syncthreads();
  for (int j = 1; j + 1 < NT; j += 2) {
    SBAR(); qkt(pB0, pB1, K_lds + SHM_K, qr, qlds, r32, hi);
    finishSM(pA0, pA1, alA, l_reg, pa0, pa1, pa2, pa3); SBAR();
    SLOAD((j + 1) * KVBLK); SBAR();
    pv_d0(o, vb0, pa0, pa1, pa2, pa3); partialSM(pB0, pB1, m_reg, mnB, alB);
    __syncthreads(); SWAIT(); SWRITE(0);
    RESC(alB); __syncthreads();
    SBAR(); qkt(pA0, pA1, K_lds, qr, qlds, r32, hi);
    finishSM(pB0, pB1, alB, l_reg, pa0, pa1, pa2, pa3); SBAR();
    SLOAD((j + 2) * KVBLK); SBAR();
    pv_d0(o, vb0 + (int)SHM_V, pa0, pa1, pa2, pa3); partialSM(pA0, pA1, m_reg, mnA, alA);
    __syncthreads(); SWAIT(); SWRITE(1);
    RESC(alA); __syncthreads();
  }
  SBAR(); qkt(pB0, pB1, K_lds + SHM_K, qr, qlds, r32, hi);
  finishSM(pA0, pA1, alA, l_reg, pa0, pa1, pa2, pa3); SBAR();
  pv_d0(o, vb0, pa0, pa1, pa2, pa3); partialSM(pB0, pB1, m_reg, mnB, alB);
  __syncthreads(); RESC(alB);
  finishSM(pB0, pB1, alB, l_reg, pa0, pa1, pa2, pa3); SBAR();
  pv_d0(o, vb0 + (int)SHM_V, pa0, pa1, pa2, pa3);
  if (hi == 0) li_l[r32] = l_reg; asm volatile("s_waitcnt lgkmcnt(0)" ::: "memory");
  float rli[16];
#pragma unroll
  for (int r = 0; r < 16; ++r) rli[r] = __builtin_amdgcn_rcpf(li_l[crow(r, hi)]);
  bf16* Ow = Ob + (long)(wid * QBLK) * LDO;
#pragma unroll
  for (int r = 0; r < 16; ++r) { int orow = crow(r, hi);
#pragma unroll
    for (int d0 = 0; d0 < 4; ++d0) Ow[(long)orow * LDO + d0 * 32 + r32] = f2bf(o[d0][r] * rli[r]); }
  __syncthreads();
#undef SLOAD
#undef SWRITE
#undef SWAIT
#undef RESC
}
#undef KSWZ
}
#if defined(PROBE)
DI void fatomic_max(unsigned* p, float v) { atomicMax(p, __builtin_bit_cast(unsigned, fabsf(v))); }
DI float pshift(const bf16* P, int R, int lo, int hi, int col, const float* mu, int mucol) {
    const float c = bf2f(P[(size_t)R * cf::PC + col]), p = (R - 1 >= lo) ? bf2f(P[(size_t)(R - 1) * cf::PC + col]) : 0.f, n = (R + 1 < hi) ? bf2f(P[(size_t)(R + 1) * cf::PC + col]) : 0.f;
    return c + (0.5f * (p + n) - c) * mu[mucol];
}
__global__ void __launch_bounds__(256) probe(In in, uchar* ws, unsigned* res, float* scratch) {
    using namespace cf;
    __shared__ float sh[4352 + 1024];
    const int tid = threadIdx.x, bx = blockIdx.x;
    const bf16* P = (const bf16*)(ws + WS_P); const bf16* Qb = (const bf16*)(ws + WS_Q); const bf16* Kb = (const bf16*)(ws + WS_K); const bf16* Vb = (const bf16*)(ws + WS_V); const bf16* MIX = (const bf16*)(ws + WS_XM);
    const float* YR = (const float*)(ws + WS_YR); const float* YG = (const float*)(ws + WS_YG);
    if (bx < 8) {
        const int h = bx, b = 1;
        for (int which = 0; which < 4; ++which) {
            const bool isctx = which == 3; const int t = which == 0 ? 0 : which == 1 ? 1000 : which == 2 ? 4095 : 5;
            const int row = b * SEGT + (isctx ? t : CTX + t), nkeys = isctx ? CTX : SEGT;
            if (tid < 192) { float q = bf2f(Qb[(size_t)row * QP + h * 192 + tid]); sh[4352 + tid] = q; }
            __syncthreads();
            if (tid < 192 && tid >= 128 && !isctx) { const int j = tid - 128, ax = j >> 5, half = (j >> 4) & 1, f = j & 15; const float pos = ax ? (float)(t & 63) : (float)(t >> 6);
                const float ang = pos * powf(10000.f, -(float)f / 16.f), c = cosf(ang), s = sinf(ang);
                const float x1 = sh[4352 + 128 + ax * 32 + f], x2 = sh[4352 + 128 + ax * 32 + 16 + f];
                sh[4352 + 512 + j] = half ? (x1 * s + x2 * c) : (x1 * c - x2 * s); }
            __syncthreads();
            if (tid < 64 && !isctx) sh[4352 + 128 + tid] = sh[4352 + 512 + tid];
            __syncthreads();
            for (int kk = tid; kk < nkeys; kk += 256) { const int krow = b * SEGT + kk; const bool kctx = kk < CTX; const int kt = kk - CTX;
                float s = 0.f;
                for (int d = 0; d < 128; ++d) s += sh[4352 + d] * bf2f(Kb[(size_t)krow * KP + h * 192 + d]);
                for (int j = 0; j < 64; ++j) { const int ax = j >> 5, half = (j >> 4) & 1, f = j & 15;
                    float kv;
                    if (kctx) kv = bf2f(P[(size_t)krow * PC + C_KR + j]);
                    else { const float pos = ax ? (float)(kt & 63) : (float)(kt >> 6), ang = pos * powf(10000.f, -(float)f / 16.f), c = cosf(ang), sn = sinf(ang);
                        const float x1 = bf2f(P[(size_t)krow * PC + C_KR + ax * 32 + f]), x2 = bf2f(P[(size_t)krow * PC + C_KR + ax * 32 + 16 + f]);
                        kv = half ? (x1 * sn + x2 * c) : (x1 * c - x2 * sn); }
                    s += sh[4352 + 128 + j] * kv; }
                sh[kk] = s * 0.07216878364870322f; }
            __syncthreads();
            float mx = -1e30f; for (int kk = 0; kk < nkeys; ++kk) mx = fmaxf(mx, sh[kk]);
            float den = 0.f; for (int kk = 0; kk < nkeys; ++kk) den += __expf(sh[kk] - mx);
            if (tid < 128) { float o = 0.f; for (int kk = 0; kk < nkeys; ++kk) o += __expf(sh[kk] - mx) * bf2f(Vb[(size_t)(b * SEGT + kk) * VP + h * 128 + tid]);
                o /= den; const float got = bf2f(MIX[(size_t)row * D + h * 128 + tid]); fatomic_max(res + 0, got - o); fatomic_max(res + 16, o); }
            __syncthreads();
        }
    } else if (bx < 10) {
        if (tid >= 64) return;
        const int b = 1, h = 3, dir = bx - 8, lane = tid, hc = h * 64 + lane;
        const float* mu = in.p[11]; float S[64]; float cumw = 1.f;
        const uchar* task = ws + WS_RWT + (size_t)((((b * 8 + h) * 2 + dir) * NCH) + 0) * RW_TASK;
#pragma unroll
        for (int k = 0; k < 64; ++k) S[k] = 0.f;
        for (int step = 0; step < SEGT; ++step) {
            const int R = row_of(b, dir, step >> 6, step & 63), s = R % SEGT, lo = b * SEGT + (s < CTX ? 0 : CTX), hi = b * SEGT + (s < CTX ? CTX : SEGT);
            const float r = pshift(P, R, lo, hi, C_RW + hc, mu, hc), k = pshift(P, R, lo, hi, C_RW + 512 + hc, mu, 512 + hc), v = pshift(P, R, lo, hi, C_RW + 1024 + hc, mu, 1024 + hc);
            if (lane < 32) { sh[lane] = tanhf(pshift(P, R, lo, hi, C_RW + RW_WD + dir * 32 + lane, mu, RW_WD + dir * 32 + lane)); sh[32 + lane] = pshift(P, R, lo, hi, C_RW + RW_AD + dir * 32 + lane, mu, RW_AD + dir * 32 + lane); }
            __builtin_amdgcn_s_waitcnt(0); __builtin_amdgcn_wave_barrier();
            float lw = in.p[12][dir * 512 + hc], la = in.p[14][dir * 512 + hc];
            for (int rr = 0; rr < 32; ++rr) { lw += sh[rr] * in.p[13][((size_t)dir * 32 + rr) * 512 + hc]; la += sh[32 + rr] * in.p[15][((size_t)dir * 32 + rr) * 512 + hc]; }
            const float wlog = -log1pf(expf(-lw)) - 0.5f, w = expf(-expf(wlog)), alr = 1.f / (1.f + expf(-la));
            float kk = k * in.p[17][hc]; sh[400 + lane] = kk * kk; __builtin_amdgcn_s_waitcnt(0); __builtin_amdgcn_wave_barrier(); float nn = 0.f; for (int jj = 0; jj < 64; ++jj) nn += sh[400 + jj]; kk *= rsqrtf(nn + 1e-12f);
            const float kd = k * (1.f + (alr - 1.f) * in.p[18][hc]), a = -kk, bb = kk * alr;
            if (dir == 0 && step < 64) { cumw *= w;
#ifdef S1DBG
                const float qt = (S1DBG == 1) ? alr : kk,
#else
                const float qt = r * cumw,
#endif
                got = bf2f(((const bf16*)(task + 8192))[step * 64 + lane]); fatomic_max(res + 9, got - qt); fatomic_max(res + 25, qt);
                scratch[(size_t)8 * SEGT * 64 + step * 64 + lane] = bb; scratch[(size_t)8 * SEGT * 64 + 4096 + step * 64 + lane] = cumw;
                if (step == 63) { const float gl = ((const float*)(task + 57344))[lane]; fatomic_max(res + 8, gl - cumw); fatomic_max(res + 24, cumw);
                    for (int t2 = 0; t2 < 64; ++t2) { const float bh = scratch[(size_t)8 * SEGT * 64 + t2 * 64 + lane] * cumw / scratch[(size_t)8 * SEGT * 64 + 4096 + t2 * 64 + lane], gb = bf2f(((const bf16*)(task + 24576))[lane * 64 + t2]); fatomic_max(res + 10, gb - bh); fatomic_max(res + 26, bh); } } }
            sh[64 + lane] = a; sh[128 + lane] = bb; sh[192 + lane] = kd; sh[256 + lane] = w; sh[320 + lane] = r;
            __builtin_amdgcn_s_waitcnt(0); __builtin_amdgcn_wave_barrier();
            float sa = 0.f;
#pragma unroll
            for (int kx = 0; kx < 64; ++kx) sa += S[kx] * sh[64 + kx];
            float y = 0.f;
#pragma unroll
            for (int kx = 0; kx < 64; ++kx) { S[kx] = S[kx] * sh[256 + kx] + sa * sh[128 + kx] + v * sh[192 + kx]; y += S[kx] * sh[320 + kx]; }
            scratch[((size_t)dir * SEGT + (R - b * SEGT)) * 64 + lane] = y;
            __builtin_amdgcn_s_waitcnt(0); __builtin_amdgcn_wave_barrier();
        }
    } else if (bx < 12) {
        const int b = 2, h = 1, dir = bx - 10, c = tid & 127;
        float S[128];
#pragma unroll
        for (int k = 0; k < 128; ++k) S[k] = 0.f;
        const float A = expf(in.p[23][dir * 4 + h]), dtb = in.p[24][dir * 4 + h];
        for (int step = 0; step < SEGT; ++step) {
            const int R = row_of(b, dir, step >> 6, step & 63), s = R % SEGT, lo = b * SEGT + (s < CTX ? 0 : CTX), hi = b * SEGT + (s < CTX ? CTX : SEGT);
            float x[3];
            for (int w = 0; w < 3; ++w) { float acc = 0.f; const int col = w * 512 + h * 128 + c;
                for (int j = 0; j < 5; ++j) { const int Rj = R + j - 2; if (Rj >= lo && Rj < hi) acc += in.p[22][(size_t)j * 1536 + col] * bf2f(P[(size_t)Rj * PC + C_GD + col]); }
                x[w] = acc / (1.f + expf(-acc)); }
            if (tid < 128) { sh[tid] = x[0] * x[0]; sh[128 + tid] = x[1] * x[1]; }
            __syncthreads();
            float sq = 0.f, sk = 0.f; for (int j = 0; j < 128; ++j) { sq += sh[j]; sk += sh[128 + j]; }
            __syncthreads();
            const float q = x[0] * rsqrtf(sq + 1e-12f) * 0.08838834764831845f, k = x[1] * rsqrtf(sk + 1e-12f), v = x[2];
            const float a_raw = bf2f(P[(size_t)R * PC + C_GD + GD_A + dir * 4 + h]), b_raw = bf2f(P[(size_t)R * PC + C_GD + GD_B + dir * 4 + h]);
            const float z = a_raw + dtb, g = -A * (z > 20.f ? z : log1pf(expf(z))), eg = expf(g), beta = 1.f / (1.f + expf(-b_raw));
            if (tid < 128) { sh[256 + tid] = k; sh[384 + tid] = q; }
            __syncthreads();
            if (tid < 128) { float ks = 0.f;
#pragma unroll
                for (int kx = 0; kx < 128; ++kx) ks += sh[256 + kx] * S[kx];
                float o = 0.f;
#pragma unroll
                for (int kx = 0; kx < 128; ++kx) { S[kx] = eg * (S[kx] - beta * sh[256 + kx] * ks) + beta * sh[256 + kx] * v; o += sh[384 + kx] * S[kx]; }
                scratch[(size_t)2 * SEGT * 64 + ((size_t)dir * SEGT + (R - b * SEGT)) * 128 + c] = o; }
            __syncthreads();
        }
    }
}
__global__ void probe_cmp(uchar* ws, unsigned* res, const float* scratch) {
    using namespace cf;
    const float* YR = (const float*)(ws + WS_YR); const float* YG = (const float*)(ws + WS_YG);
    for (int i = blockIdx.x * blockDim.x + threadIdx.x; i < SEGT * 64; i += gridDim.x * blockDim.x) { const int s = i >> 6, v = i & 63, b = 1, h = 3; const size_t row = (size_t)b * SEGT + s;
        const float r0 = scratch[(size_t)s * 64 + v], r1 = scratch[((size_t)SEGT + s) * 64 + v], g0 = YR[row * 512 + h * 64 + v], g1 = YR[((size_t)M + row) * 512 + h * 64 + v];
        fatomic_max(res + 1, (g0 + g1) - (r0 + r1)); fatomic_max(res + 17, r0 + r1);
        fatomic_max(res + 3, g0 - r0); fatomic_max(res + 19, r0);
        fatomic_max(res + 4, g1 - r1); fatomic_max(res + 20, r1);
        if (s < 64) { fatomic_max(res + 5, g0 - r0); fatomic_max(res + 21, r0); }
        if (s >= 64 && s < 128) { fatomic_max(res + 6, g0 - r0); fatomic_max(res + 22, r0); }
        if (s >= 256 && s < 320) { fatomic_max(res + 7, g0 - r0); fatomic_max(res + 23, r0); }
    }
    for (int i = blockIdx.x * blockDim.x + threadIdx.x; i < SEGT * 128; i += gridDim.x * blockDim.x) { const int s = i >> 7, v = i & 127, b = 2, h = 1; const size_t row = (size_t)b * SEGT + s;
        const float* sg = scratch + (size_t)2 * SEGT * 64;
        const float ref = sg[(size_t)s * 128 + v] + sg[((size_t)SEGT + s) * 128 + v], got = YG[row * 512 + h * 128 + v] + YG[((size_t)M + row) * 512 + h * 128 + v];
        fatomic_max(res + 2, got - ref); fatomic_max(res + 18, ref); }
}
__global__ void probe_out(float* out, const unsigned* res, int selA, int selB) {
    if (blockIdx.x == 0 && threadIdx.x == 0) {
        out[0] = 1.0e5f * __builtin_bit_cast(float, res[selA]) / __builtin_bit_cast(float, res[16 + selA]);
        out[1] = 1.0e5f * __builtin_bit_cast(float, res[selB]) / __builtin_bit_cast(float, res[16 + selB]); }
}
#endif
constexpr int NWAVES = 8, NPH = 3 + 9 * cf::DEPTH;
struct Args { In in; float* out; uchar* ws; int g_lo, g_hi; };
static_assert(sizeof(Args) == 34 * 8 + 8 + 8 + 8, "Args has no padding");

__global__ void __launch_bounds__(NWAVES * 64, 2) fwd(Args args) {
    using namespace cf;
    extern __shared__ __attribute__((aligned(16))) unsigned char lds_raw[];
    LAS uchar* lds = (LAS uchar*)lds_raw;
    const int bx = blockIdx.x, G = gridDim.x, wv = __builtin_amdgcn_readfirstlane(threadIdx.x >> 6);
    auto lane_now = [&]() { unsigned ones = ~0u; asm volatile("" : "+s"(ones)); return (int)__builtin_amdgcn_mbcnt_hi(ones, __builtin_amdgcn_mbcnt_lo(ones, 0u)); };
#define TID() (wv * 64 + lane_now())
    const In& in = args.in;
    volatile LAS unsigned* MISC = (volatile LAS unsigned*)(lds + MISC_OFF);
    { const int tid = threadIdx.x; if (tid < 32) MISC[tid] = 0u; }
    __syncthreads();
    const int g_lo = args.g_lo, g_hi = args.g_hi;
    unsigned* barw = (unsigned*)(args.ws + WS_CTL) + CW_BAR;
    if (g_hi - g_lo > 1) (void)xcd_barrier_post(barw, MISC + 8);
#ifndef PH_MASK
#define PH_MASK 0xfff
#endif
#define PHK(g) ((g) < 3 ? (g) : 3 + ((g) - 3) % 9)
#define OPQ(v) asm volatile("" : "+v"(v))
#define IN(g) (((PH_MASK >> PHK(g)) & 1) && args.g_lo <= (g) && (g) < args.g_hi)
#define SEAM(g) do { if (args.g_lo <= (g) && (g) + 1 < args.g_hi) { XcdBarrier bar_; bar_.bar = (unsigned*)(args.ws + WS_CTL) + CW_BAR; bar_.x = xb_xcc_id(); bar_.st = (volatile LAS unsigned*)(lds + MISC_OFF) + 8; xcd_barrier(bar_); } } while (0)

#define OPQS(v) asm volatile("" : "+s"(v))
#define LOCALS int l = lq; OPQS(l); size_t zq_ = 0; OPQS(zq_); uchar* ws = args.ws + zq_; float* X = (float*)(ws + WS_X); bf16* XM = (bf16*)(ws + WS_XM); bf16* P = (bf16*)(ws + WS_P); \
    bf16* CQN = (bf16*)(ws + WS_CQN); bf16* CKVN = (bf16*)(ws + WS_CKVN); bf16* Qb = (bf16*)(ws + WS_Q); bf16* Kb = (bf16*)(ws + WS_K); bf16* Vb = (bf16*)(ws + WS_V); \
    bf16* HFF = (bf16*)(ws + WS_HFF); float* YR = (float*)(ws + WS_YR); float* YG = (float*)(ws + WS_YG); float* GATE = (float*)(ws + WS_GATE); float* BONUS = (float*)(ws + WS_BONUS); \
    const float* MODV = (const float*)(ws + WS_MODV); const float* ROPE = (const float*)(ws + WS_ROPE); const float* modl = MODV + (size_t)l * 5 * MODS; \
    (void)X; (void)XM; (void)P; (void)CQN; (void)CKVN; (void)Qb; (void)Kb; (void)Vb; (void)HFF; (void)YR; (void)YG; (void)GATE; (void)BONUS; (void)ROPE; (void)modl; int t_ = TID(); OPQ(t_);

    if (IN(0)) { const int lq = 0; LOCALS; phase_prologue(in, ws, lds, G, bx, t_); }
    SEAM(0);
    if (IN(1)) { const int lq = 0; LOCALS; phase_modreduce(in, ws, G, bx, t_); }
    SEAM(1);
    if (IN(2)) { const int lq = 0; LOCALS; phase_modulate(X, XM, MODV, 0, D, G, bx, t_); }
    SEAM(2);

#pragma unroll 1
    for (int lq = 0; lq < DEPTH; ++lq) {
        const int g0 = 3 + 9 * lq;
        if (IN(g0 + 0)) { LOCALS;
            pg8::Gemm g{XM, (const bf16*)(ws + WS_WIN) + (size_t)l * PC * D, M, PC, D}; pg8::StaticOrder S; S.init(M, PC, G, bx);
            pg8::EpiStore E{P, PC};
            pg8::gemm_phase<pg8::EpiStore, pg8::StaticOrder, true, true>(lds, g, S, E, t_);
        }
        SEAM(g0 + 0);
        if (IN(g0 + 1)) { LOCALS;
#ifndef NO_MLAPREP
            mla_prep_rows(P, CQN, CKVN, Kb, in.p[7] + l * 512, in.p[8] + l * 512, ROPE, G, bx, t_);
#endif
            ScanW sw; sw.mu = in.p[11] + l * RW_COLS; sw.w0 = in.p[12] + l * 1024; sw.a0 = in.p[14] + l * 1024; sw.k_k = in.p[17] + l * 512; sw.k_a = in.p[18] + l * 512; sw.r_k = in.p[19] + l * 512;
            sw.W2T = (const bf16*)(ws + WS_W2T) + (size_t)l * 2 * 512 * 32; sw.A2T = (const bf16*)(ws + WS_A2T) + (size_t)l * 2 * 512 * 32; sw.G2T = (const bf16*)(ws + WS_G2T) + (size_t)l * 512 * 96;
            sw.conv = in.p[22] + l * 5 * 1536; sw.a_log = in.p[23] + l * 8; sw.dt_bias = in.p[24] + l * 8;
#pragma unroll 1
            for (int tk = bx; tk < 4352 + 2176; tk += G) { int tt = TID(); OPQ(tt);
#ifndef NO_S1R
                if (tk < 4352) { const int ci = tk % NCH, t2 = tk / NCH, dir = t2 & 1, h = (t2 >> 1) & 7, b = t2 >> 4;
                    s1_rwkv(lds, P, sw, ws + WS_RWT + (size_t)tk * RW_TASK, GATE, BONUS + (size_t)dir * M * 8, b, h, dir, ci, tt); }
#endif
#ifndef NO_S1G
                if (tk >= 4352) { const int tg = tk - 4352, ci = tg % NCH, t2 = tg / NCH, dir = t2 & 1, h = (t2 >> 1) & 3, b = t2 >> 3;
                    s1_gdn(lds, P, sw, ws + WS_GDT + (size_t)tg * GD_TASK, b, h, dir, ci, tt); }
#endif
            }
        }
        SEAM(g0 + 1);
        if (IN(g0 + 2)) { LOCALS;
            const bool split = G >= 256;
#pragma unroll 1
            for (int s = bx; s < 128; s += (split ? 1 << 20 : G)) {
#ifndef NO_S2R
                if (s < 64) { const int b = s >> 4, h = (s >> 1) & 7, dir = s & 1;
                    s2_scan<64, true>(lds, ws + WS_RWT + (size_t)(((b * 8 + h) * 2 + dir) * NCH) * RW_TASK, RW_TASK, 0, 8192, 16384, 24576, 32768, 64, 0, 40960, 49152, 57344,
                                      YR + (size_t)dir * M * 512, h * 64, b, dir, t_); }
#endif
#ifndef NO_S2G
                if (s >= 64) { const int g = s - 64, vs = g & 1, dir = (g >> 1) & 1, h = (g >> 2) & 3, b = g >> 4;
                    s2_scan<128, false>(lds, ws + WS_GDT + (size_t)(((b * 4 + h) * 2 + dir) * NCH) * GD_TASK, GD_TASK, 0, 16384, 32768, 40960, 57344, 128, vs * 64, 0, 0, 73728,
                                        YG + (size_t)dir * M * 512, h * 128 + vs * 64, b, dir, t_); }
#endif
                __syncthreads();
            }
            OPQ(t_);
#ifndef NO_UPGEMM
            if (!split || bx >= 128) { const int Gg = split ? G - 128 : G, cg = split ? bx - 128 : bx;
                { pg8::Gemm g{CQN, (const bf16*)(ws + WS_WUQ) + (size_t)l * 1536 * 512, M, 1536, 512}; pg8::StaticOrder S; S.init(M, 1536, Gg, cg);
                  pg8::EpiStore E{Qb, QP}; pg8::gemm_phase<pg8::EpiStore, pg8::StaticOrder, true, true>(lds, g, S, E, t_); }
                __syncthreads(); OPQ(t_);
                { pg8::Gemm g{CKVN, (const bf16*)(ws + WS_WUKV) + (size_t)l * 2048 * 512, M, 2048, 512}; pg8::StaticOrder S; S.init(M, 2048, Gg, cg);
                  pg8::EpiKV E{Kb, Vb}; pg8::gemm_phase<pg8::EpiKV, pg8::StaticOrder, true, true>(lds, g, S, E, t_); }
            }
#endif
        }
        SEAM(g0 + 2);
        if (IN(g0 + 3)) { LOCALS;
#ifndef NO_MIXROWS
            mix_rows(P, YR, YG, GATE, BONUS, XM, in.p[11] + l * RW_COLS, in.p[20] + l * 512, in.p[21] + l * 512, in.p[25] + l * 128, G, bx, t_);
#endif
#ifndef NO_ATTN
            const int nunits = 512 + (l < DEPTH - 1 ? 32 : 0);
#pragma unroll 1
            for (int u = bx; u < nunits; u += G) { int tt = TID(); OPQ(tt);
                if (u < 512) { const int x = u & 7, j = u >> 3, bh = x + 8 * (j >> 4), qb = j & 15, b = bh >> 3, h = bh & 7;
                    const size_t qrow = (size_t)b * SEGT + CTX + qb * 256, krow = (size_t)b * SEGT;
                    at::attn_unit(Qb + qrow * QP + h * 192, Kb + krow * KP + h * 192, Vb + krow * VP + h * 128, XM + qrow * D + h * 128, SEGT, ROPE, qb * 256, (LAS char*)lds, tt); }
                else { const int bh = u - 512, b = bh >> 3, h = bh & 7; const size_t qrow = (size_t)b * SEGT;
                    at::attn_unit(Qb + qrow * QP + h * 192, Kb + qrow * KP + h * 192, Vb + qrow * VP + h * 128, XM + qrow * D + h * 128, CTX, nullptr, 0, (LAS char*)lds, tt); }
            }
#endif
        }
        SEAM(g0 + 3);
        if (IN(g0 + 4)) { LOCALS;
            pg8::Gemm g{XM, (const bf16*)(ws + WS_WOUT) + (size_t)l * D * D, M, D, D}; pg8::StaticOrder S; S.init(M, D, G, bx);
            float alpha_ = ALPHA; OPQ(alpha_); pg8::EpiRes E{X, modl + 2 * D, MODS, alpha_};
            pg8::gemm_phase<pg8::EpiRes, pg8::StaticOrder, true, true>(lds, g, S, E, t_);
        }
        SEAM(g0 + 4);
        if (IN(g0 + 5)) { LOCALS; phase_ln(X, in.p[27] + l * D, in.p[28] + l * D, XM, modl, 3 * D, 4 * D, nullptr, G, bx, t_); }
        SEAM(g0 + 5);
        if (IN(g0 + 6)) { LOCALS;
            pg8::Gemm g{XM, (const bf16*)(ws + WS_WGU) + (size_t)l * 2 * DFF * D, M, 2 * DFF, D}; pg8::StaticOrder S; S.init(M, 2 * DFF, G, bx);
            pg8::EpiSwiGLU E{HFF, DFF};
            pg8::gemm_phase<pg8::EpiSwiGLU, pg8::StaticOrder, true, true>(lds, g, S, E, t_);
        }
        SEAM(g0 + 6);
        if (IN(g0 + 7)) { LOCALS;
            pg8::Gemm g{HFF, (const bf16*)(ws + WS_WDN) + (size_t)l * D * DFF, M, D, DFF}; pg8::StaticOrder S; S.init(M, D, G, bx);
            float alpha_ = ALPHA; OPQ(alpha_); pg8::EpiRes E{X, modl + 5 * D, MODS, alpha_};
            pg8::gemm_phase<pg8::EpiRes, pg8::StaticOrder, true, true>(lds, g, S, E, t_);
        }
        SEAM(g0 + 7);
        if (IN(g0 + 8)) { LOCALS;
            if (l < DEPTH - 1) phase_ln(X, in.p[32] + l * D, in.p[33] + l * D, XM, modl + 5 * MODS, 0, D, nullptr, G, bx, t_);
            else phase_ln(X, in.p[32] + l * D, in.p[33] + l * D, XM, modl, 0, D, args.out, G, bx, t_);
        }
        SEAM(g0 + 8);
    }
#undef IN
#undef SEAM
}


#if defined(DBG_STOP)
__global__ void dbg_dump(float* out, const unsigned char* ws, int kind, size_t off, int pitch, size_t stride) {
    const size_t n = (size_t)cf::NB * cf::SEQ * cf::D;
    for (size_t i = (size_t)blockIdx.x * blockDim.x + threadIdx.x; i < n; i += (size_t)gridDim.x * blockDim.x) {
        const size_t rr = i / cf::D, c = i % cf::D, b = rr / cf::SEQ, t = rr % cf::SEQ, row = b * cf::SEGT + cf::CTX + t;
        float v;
        if (kind == 0) v = ((const float*)(ws + WS_X))[row * cf::D + c];
        else if (kind == 1) v = bf2f(((const bf16*)(ws + off))[row * (size_t)pitch + c]);
        else if (kind == 3) v = ((const float*)(ws + off))[(i * stride)];
        else if (kind == 4) v = ((const float*)(ws + off))[i % ((size_t)pitch * 1024)];
        else v = bf2f(((const bf16*)(ws + off))[i * stride]);
        if (!(fabsf(v) < 3.0e38f)) v = 1.0e30f;
        out[i] = v;
    }
}
#endif
#ifndef MK_MULTI
#define MK_MULTI 0
#endif
extern "C" void kernel_launch(void* const* d_in, const int* in_sizes, int n_in, void* d_out, int out_size, void* d_ws, size_t ws_size, hipStream_t stream) {
    static int grid = 0;
    if (grid == 0) {
        if (n_in != 34 || out_size != cf::NB * cf::SEQ * cf::D || ws_size < WS_END) { fprintf(stderr, "kernel_launch: shape mismatch (n_in %d out %d ws %zu)\n", n_in, out_size, ws_size); grid = -1; return; }
        int dev = 0, cus = 0;
        if (hipGetDevice(&dev) != hipSuccess || hipDeviceGetAttribute(&cus, hipDeviceAttributeMultiprocessorCount, dev) != hipSuccess) { grid = -1; return; }
        if (hipFuncSetAttribute((const void*)fwd, hipFuncAttributeMaxDynamicSharedMemorySize, LDS_BYTES) != hipSuccess) { fprintf(stderr, "kernel_launch: hipFuncSetAttribute failed\n"); grid = -1; return; }
        int per_cu = 0;
        if (hipOccupancyMaxActiveBlocksPerMultiprocessor(&per_cu, (const void*)fwd, NWAVES * 64, LDS_BYTES) != hipSuccess || per_cu < 1) fprintf(stderr, "kernel_launch: occupancy query says %d\n", per_cu);
        (void)hipGetLastError();
        grid = cus;
    }
    if (grid < 0) return;
    (void)hipMemsetAsync((char*)d_ws, 0, ZERO_BYTES, stream);
    Args a{};
    for (int i = 0; i < 34; ++i) a.in.p[i] = (const float*)d_in[i];
    a.out = (float*)d_out; a.ws = (uchar*)d_ws;
#if defined(PROBE)
    for (int g = 0; g < 7; ++g) { a.g_lo = g; a.g_hi = g + 1; hipLaunchKernelGGL(fwd, dim3(grid), dim3(NWAVES * 64), LDS_BYTES, stream, a); }
    { unsigned* res = (unsigned*)d_ws + 64; float* scratch = (float*)((char*)d_ws + WS_HFF + (400ull << 20));
      scratch = (float*)((char*)d_ws + WS_END);
      hipLaunchKernelGGL(probe, dim3(12), dim3(256), 0, stream, a.in, (uchar*)d_ws, res, scratch);
      hipLaunchKernelGGL(probe_cmp, dim3(256), dim3(256), 0, stream, (uchar*)d_ws, res, (const float*)scratch);
      for (int g = 7; g < NPH; ++g) { a.g_lo = g; a.g_hi = g + 1; hipLaunchKernelGGL(fwd, dim3(grid), dim3(NWAVES * 64), LDS_BYTES, stream, a); }
      hipLaunchKernelGGL(probe_out, dim3(1), dim3(64), 0, stream, (float*)d_out, (const unsigned*)res, PROBE_SELA, PROBE_SELB); }
#elif defined(DBG_STOP)
    for (int g = 0; g < DBG_STOP; ++g) { a.g_lo = g; a.g_hi = g + 1; hipLaunchKernelGGL(fwd, dim3(grid), dim3(NWAVES * 64), LDS_BYTES, stream, a); }
    hipLaunchKernelGGL(dbg_dump, dim3(2048), dim3(256), 0, stream, (float*)d_out, (const unsigned char*)d_ws, DBG_KIND, (size_t)DBG_OFF, DBG_PITCH, (size_t)DBG_STRIDE);
#elif MK_MULTI
    for (int g = 0; g < NPH; ++g) { a.g_lo = g; a.g_hi = g + 1; hipLaunchKernelGGL(fwd, dim3(grid), dim3(NWAVES * 64), LDS_BYTES, stream, a); }
#else
    a.g_lo = 0; a.g_hi = NPH;
    hipLaunchKernelGGL(fwd, dim3(grid), dim3(NWAVES * 64), LDS_BYTES, stream, a);
#endif
    const hipError_t le = hipPeekAtLastError();
    if (le != hipSuccess) fprintf(stderr, "kernel_launch: launch failed: %s\n", hipGetErrorName(le));
}
```

```cpp
#include <hip/hip_runtime.h>
#include <cstdio>
#include <cstdint>

#define DI __device__ __forceinline__
#define LAS __attribute__((address_space(3)))
#define GAS __attribute__((address_space(1)))
typedef unsigned short bf16;
typedef short bf16x8 __attribute__((ext_vector_type(8)));
typedef short s16x4 __attribute__((ext_vector_type(4)));
typedef float f32x4 __attribute__((ext_vector_type(4)));
typedef float f32x2 __attribute__((ext_vector_type(2)));
typedef float f32x16 __attribute__((ext_vector_type(16)));
typedef unsigned u32x4 __attribute__((ext_vector_type(4)));
typedef unsigned u32x2 __attribute__((ext_vector_type(2)));
typedef unsigned char uchar;
typedef __bf16 bf16x2_t __attribute__((ext_vector_type(2)));

namespace pg8 {
typedef unsigned short bf16_t;
#define PG8_LAS __attribute__((address_space(3)))
constexpr int BM = 256, BK = 64, HALF = 128, HTB = HALF * BK * 2  , STAGE_BYTES = 8 * HTB, NXCD = 8, WGM = 8;

__host__ __device__ __forceinline__ int lds_byte(int r, int c) { const int st = (r >> 4) * 2 + (c >> 5), rr = r & 15, cc = c & 31, ob = rr * 64 + cc * 2; return st * 1024 + (ob ^ (((ob >> 9) & 1) << 5)); }
__host__ __device__ __forceinline__ void stage_rc(int b, int& R, int& C) { const int st = b / 1024, sb = b % 1024, swz = sb ^ (((sb >> 9) & 1) << 5); R = (st >> 1) * 16 + swz / 64; C = (st & 1) * 32 + (swz % 64) / 2; }
__host__ __device__ __forceinline__ int perm32(int rho) { const int n = rho >> 4, i = rho & 15; return 8 * (i >> 2) + 4 * n + (i & 3); }

struct Unit { int pm, pn, ko, ks; };
struct Gemm { const bf16_t* A; const bf16_t* Bt; int M, N, K, ld; };

struct StaticOrder {
    int nM, nN, nwg, G, c;
    __host__ __device__ void init(int M, int N, int G_, int c_) { nM = M / BM; nN = N / BM; nwg = nM * nN; G = G_; c = c_; }
    __host__ __device__ bool next(int i, Unit& u) const {
        const long L = (long)i * G + c; if (L >= nwg) return false;
        int wgid = (int)L; { const int q = nwg / NXCD, r = nwg % NXCD, xcd = wgid % NXCD, off = wgid / NXCD; wgid = (xcd < r ? xcd * (q + 1) : r * (q + 1) + (xcd - r) * q) + off; }
        const int nig = WGM * nN, gid = wgid / nig, fm = gid * WGM, gsz = (nM - fm) < WGM ? (nM - fm) : WGM;
        u.pm = fm + ((wgid % nig) % gsz); u.pn = (wgid % nig) / gsz; u.ko = 0; u.ks = 0; return true;
    }
    __device__ __forceinline__ void a_ready(const Unit&) const {}
    __device__ __forceinline__ void done(const Unit&) const {}
};

struct LatOrder {
    StaticOrder S;
    __host__ __device__ void init(int N, int G_, int c_) { S.init(16384, N, G_, c_); }
    __host__ __device__ bool next(int i, Unit& u) const { if (!S.next(i, u)) return false; u.pm = (u.pm >> 4) * 17 + 1 + (u.pm & 15); return true; }
    __device__ __forceinline__ void a_ready(const Unit&) const {}
    __device__ __forceinline__ void done(const Unit&) const {}
};
struct CtxSplitOrder {
    int nN, KS, kbytes, G, c;
    __host__ __device__ void init(int N, int KS_, int Ksplit, int G_, int c_) { nN = N / BM; KS = KS_; kbytes = Ksplit * 2; G = G_; c = c_; }
    __host__ __device__ bool next(int i, Unit& u) const { const int j = i * G + c; if (j >= 4 * nN * KS) return false;
        const int ks = j % KS, cu = j / KS; u.pm = (cu / nN) * 17; u.pn = cu % nN; u.ks = ks; u.ko = ks * kbytes; return true; }
    __device__ __forceinline__ void a_ready(const Unit&) const {}
    __device__ __forceinline__ void done(const Unit&) const {}
};
__device__ __forceinline__ unsigned cvt_pk_bf16(float lo, float hi) { const f32x2 v = {lo, hi}; return __builtin_bit_cast(unsigned, __builtin_convertvector(v, bf16x2_t)); }
__device__ __forceinline__ u32x4 pack8(f32x4 v0, f32x4 v1) { u32x4 w; w.x = cvt_pk_bf16(v0[0], v0[1]); w.y = cvt_pk_bf16(v0[2], v0[3]); w.z = cvt_pk_bf16(v1[0], v1[1]); w.w = cvt_pk_bf16(v1[2], v1[3]); return w; }

struct EpiStore {
    static constexpr bool PERM = true, AFTER_DRAIN = false;
    bf16_t* O; int ldc;
    __device__ __forceinline__ void operator()(const f32x4 (&acc)[2][2][4][2], const Unit& u, int wr, int wc, int fr, int fq) const {
        const int row0 = u.pm * BM + wr * 64 + fr, col0 = u.pn * BM + wc * 32 + 8 * fq;
#pragma unroll
        for (int ai = 0; ai < 2; ++ai)
#pragma unroll
            for (int m = 0; m < 4; ++m) { bf16_t* rowp = O + (size_t)(row0 + ai * HALF + m * 16) * ldc + col0;
#pragma unroll
                for (int bj = 0; bj < 2; ++bj) *(u32x4*)(rowp + bj * HALF) = pack8(acc[ai][bj][m][0], acc[ai][bj][m][1]); }
    }
};
struct EpiKV {
    static constexpr bool PERM = true, AFTER_DRAIN = false;
    bf16_t* Kb; bf16_t* Vb;
    __device__ __forceinline__ void operator()(const f32x4 (&acc)[2][2][4][2], const Unit& u, int wr, int wc, int fr, int fq) const {
        const int row0 = u.pm * BM + wr * 64 + fr, c0 = wc * 32 + 8 * fq;
#pragma unroll
        for (int ai = 0; ai < 2; ++ai)
#pragma unroll
            for (int m = 0; m < 4; ++m) { const size_t row = (size_t)(row0 + ai * HALF + m * 16);
                *(u32x4*)(Kb + row * 1536 + u.pn * 192 + c0) = pack8(acc[ai][0][m][0], acc[ai][0][m][1]);
                *(u32x4*)(Vb + row * 1024 + u.pn * 128 + c0) = pack8(acc[ai][1][m][0], acc[ai][1][m][1]); }
    }
};
struct EpiSwiGLU {
    static constexpr bool PERM = true, AFTER_DRAIN = false;
    bf16_t* Hb; int ldh;
    __device__ __forceinline__ void operator()(const f32x4 (&acc)[2][2][4][2], const Unit& u, int wr, int wc, int fr, int fq) const {
        const int row0 = u.pm * BM + wr * 64 + fr, col0 = u.pn * HALF + wc * 32 + 8 * fq;
#pragma unroll
        for (int ai = 0; ai < 2; ++ai)
#pragma unroll
            for (int m = 0; m < 4; ++m) { f32x4 o[2];
#pragma unroll
                for (int n = 0; n < 2; ++n) { const f32x4 g = acc[ai][0][m][n], up = acc[ai][1][m][n];
#pragma unroll
                    for (int e = 0; e < 4; ++e) o[n][e] = g[e] * __builtin_amdgcn_rcpf(1.f + __expf(-g[e])) * up[e]; }
                *(u32x4*)(Hb + (size_t)(row0 + ai * HALF + m * 16) * ldh + col0) = pack8(o[0], o[1]); }
    }
};
struct EpiPart {
    static constexpr bool PERM = true, AFTER_DRAIN = false;
    float* part;
    __device__ __forceinline__ void operator()(const f32x4 (&acc)[2][2][4][2], const Unit& u, int wr, int wc, int fr, int fq) const {
        const int row0 = (u.pm / 17) * BM + wr * 64 + fr, col0 = u.pn * BM + wc * 32 + 8 * fq;
        float* base = part + (size_t)u.ks * 1024 * 2048;
#pragma unroll
        for (int ai = 0; ai < 2; ++ai)
#pragma unroll
            for (int m = 0; m < 4; ++m) { float* rowp = base + (size_t)(row0 + ai * HALF + m * 16) * 2048 + col0;
#pragma unroll
                for (int bj = 0; bj < 2; ++bj)
#pragma unroll
                    for (int n = 0; n < 2; ++n) *(f32x4*)(rowp + bj * HALF + 4 * n) = acc[ai][bj][m][n]; }
    }
};
struct EpiRes {
    static constexpr bool PERM = true, AFTER_DRAIN = false;
    float* X; const float* gate; int gstride; float alpha;
    __device__ __forceinline__ void operator()(const f32x4 (&acc)[2][2][4][2], const Unit& u, int wr, int wc, int fr, int fq) const {
        const int row0 = u.pm * BM + wr * 64 + fr, col0 = u.pn * BM + wc * 32 + 8 * fq;
        const int vec = (u.pm % 17 == 0) ? 4 : (u.pm / 17);
        const float* gp = gate + (size_t)vec * gstride + col0;
        f32x4 gv[2][2];
#pragma unroll
        for (int bj = 0; bj < 2; ++bj)
#pragma unroll
            for (int n = 0; n < 2; ++n) gv[bj][n] = *(const f32x4*)(gp + bj * HALF + 4 * n);
#pragma unroll
        for (int ai = 0; ai < 2; ++ai)
#pragma unroll
            for (int m = 0; m < 4; ++m) { float* rowp = X + (size_t)(row0 + ai * HALF + m * 16) * 2048 + col0;
#pragma unroll
                for (int bj = 0; bj < 2; ++bj)
#pragma unroll
                    for (int n = 0; n < 2; ++n) { f32x4* p = (f32x4*)(rowp + bj * HALF + 4 * n); const f32x4 x = *p; *p = x * alpha + gv[bj][n] * acc[ai][bj][m][n]; } }
    }
};

template <class Epi, class Sched, bool ALIGN_EPI = false, bool SP2 = false>
__device__ __forceinline__ void gemm_phase(PG8_LAS unsigned char* lds, const Gemm g, const Sched& S, const Epi& E, const int tid) {
    const int wid = __builtin_amdgcn_readfirstlane(tid >> 6), lane = tid & 63, wr = wid >> 2, wc = wid & 3, fr = lane & 15, fq = lane >> 4;
    const int K = g.ld, nt = g.K / BK;
    unsigned voffA[2], voffB[2];
#pragma unroll
    for (int i = 0; i < 2; ++i) { int R, C; stage_rc(tid * 16 + i * 8192, R, C); const int Rb = Epi::PERM ? ((R & ~31) + perm32(R & 31)) : R;
        voffA[i] = (unsigned)(R * K + C) * 2u; voffB[i] = (unsigned)(Rb * K + C) * 2u; }
    const size_t kstep = (size_t)(BK * 2);
    const size_t hstep = (size_t)HALF * K * 2;
    const size_t tstep = 2 * hstep;
    const unsigned ldsw = (unsigned)wid * 1024u;
    const int aoff = lds_byte(wr * 64 + fr, fq * 8), boff = lds_byte(wc * 32 + fr, fq * 8);
#define PG8_SA(b, h) (((b) * 2 + (h)) * HTB)
#define PG8_SB(b, h) ((4 + (b) * 2 + (h)) * HTB)
#define PG8_STAGE(bufoff, gbase, voff) do { _Pragma("unroll") for (int _i = 0; _i < 2; ++_i) \
        __builtin_amdgcn_global_load_lds((const unsigned*)((const char*)(gbase) + (voff)[_i]), (PG8_LAS unsigned*)(lds + (bufoff) + ldsw + _i * 8192), 16, 0, 0); } while (0)
#define PG8_LDA(dst, b, h) do { _Pragma("unroll") for (int m = 0; m < 4; ++m) _Pragma("unroll") for (int k = 0; k < 2; ++k) dst[m][k] = *(const PG8_LAS bf16x8*)(lds + PG8_SA(b, h) + aoff + m * 2048 + k * 1024); } while (0)
#define PG8_LDB(dst, b, h) do { _Pragma("unroll") for (int n = 0; n < 2; ++n) _Pragma("unroll") for (int k = 0; k < 2; ++k) dst[n][k] = *(const PG8_LAS bf16x8*)(lds + PG8_SB(b, h) + boff + n * 2048 + k * 1024); } while (0)
#define PG8_MMA(ai, bj, At, Bt) do { __builtin_amdgcn_s_setprio(1); _Pragma("unroll") for (int m = 0; m < 4; ++m) _Pragma("unroll") for (int n = 0; n < 2; ++n) _Pragma("unroll") for (int k = 0; k < 2; ++k) \
        acc[ai][bj][m][n] = __builtin_amdgcn_mfma_f32_16x16x32_bf16(Bt[n][k], At[m][k], acc[ai][bj][m][n], 0, 0, 0); __builtin_amdgcn_s_setprio(0); } while (0)
#define PG8_WAIT_V(n) asm volatile("s_waitcnt vmcnt(" #n ")" ::: "memory")
#define PG8_WAIT_L(n) asm volatile("s_waitcnt lgkmcnt(" #n ")" ::: "memory")
#define PG8_BAR __builtin_amdgcn_s_barrier()
#define PG8_SCHED __builtin_amdgcn_sched_barrier(0)
    Unit cur, nxt; int ui = 0;
    if (!S.next(0, cur)) return;
    f32x4 acc[2][2][4][2];
#pragma unroll
    for (int a = 0; a < 2; ++a)
#pragma unroll
        for (int b = 0; b < 2; ++b)
#pragma unroll
            for (int m = 0; m < 4; ++m)
#pragma unroll
                for (int n = 0; n < 2; ++n) acc[a][b][m][n] = (f32x4){0.f, 0.f, 0.f, 0.f};
    bf16x8 At[4][2], B0[2][2], B1[2][2];
    const char* cA = (const char*)g.A + (size_t)cur.pm * tstep + cur.ko; const char* cB = (const char*)g.Bt + (size_t)cur.pn * tstep + cur.ko;
    S.a_ready(cur);
    if constexpr (SP2) {
        PG8_STAGE(PG8_SB(0, 0), cB, voffB); PG8_STAGE(PG8_SB(0, 1), cB + hstep, voffB); PG8_STAGE(PG8_SA(0, 0), cA, voffA); PG8_STAGE(PG8_SA(0, 1), cA + hstep, voffA);
        if (wr == 1) PG8_BAR;
        PG8_WAIT_V(2); PG8_BAR;
        PG8_STAGE(PG8_SB(1, 0), cB + kstep, voffB); PG8_STAGE(PG8_SA(1, 0), cA + kstep, voffA); PG8_STAGE(PG8_SB(1, 1), cB + hstep + kstep, voffB);
        PG8_WAIT_V(6); PG8_BAR;
    } else {
        PG8_STAGE(PG8_SB(0, 0), cB, voffB); PG8_STAGE(PG8_SA(0, 0), cA, voffA); PG8_STAGE(PG8_SB(0, 1), cB + hstep, voffB); PG8_STAGE(PG8_SA(0, 1), cA + hstep, voffA);
        if (wr == 1) PG8_BAR;
        PG8_WAIT_V(4); PG8_BAR;
        PG8_STAGE(PG8_SB(1, 0), cB + kstep, voffB); PG8_STAGE(PG8_SA(1, 0), cA + kstep, voffA); PG8_STAGE(PG8_SB(1, 1), cB + hstep + kstep, voffB);
        PG8_WAIT_V(6); PG8_BAR;
    }
    for (;;) {
        const bool has_next = S.next(ui + 1, nxt);
        const char* nA = has_next ? (const char*)g.A + (size_t)nxt.pm * tstep + nxt.ko : cA; const char* nB = has_next ? (const char*)g.Bt + (size_t)nxt.pn * tstep + nxt.ko : cB;
        for (int t = 0; t < nt; t += 2) {
            const bool last = (t == nt - 2);
            const char* a1 = cA + (size_t)(t + 1) * kstep;
            const char* a2 = last ? nA : cA + (size_t)(t + 2) * kstep; const char* b2 = last ? nB : cB + (size_t)(t + 2) * kstep;
            const char* a3 = a2 + kstep; const char* b3 = b2 + kstep;
            if (last && has_next) S.a_ready(nxt);
            if constexpr (SP2) {
            PG8_LDB(B0, 0, 0); PG8_LDB(B1, 0, 1); PG8_SCHED; PG8_LDA(At, 0, 0); PG8_STAGE(PG8_SA(1, 1), a1 + hstep, voffA);
            PG8_WAIT_V(8); PG8_WAIT_L(0); PG8_BAR; PG8_MMA(0, 0, At, B0); PG8_MMA(0, 1, At, B1); PG8_BAR; PG8_SCHED;
            PG8_LDA(At, 0, 1); PG8_STAGE(PG8_SB(0, 0), b2, voffB); PG8_STAGE(PG8_SB(0, 1), b2 + hstep, voffB); PG8_STAGE(PG8_SA(0, 0), a2, voffA);
            PG8_WAIT_V(8); PG8_WAIT_L(0); PG8_BAR; PG8_MMA(1, 0, At, B0); PG8_MMA(1, 1, At, B1); PG8_BAR; PG8_SCHED;
            PG8_LDB(B0, 1, 0); PG8_LDB(B1, 1, 1); PG8_SCHED; PG8_LDA(At, 1, 0); PG8_STAGE(PG8_SA(0, 1), a2 + hstep, voffA);
            PG8_WAIT_V(8); PG8_WAIT_L(0); PG8_BAR; PG8_MMA(0, 0, At, B0); PG8_MMA(0, 1, At, B1); PG8_BAR; PG8_SCHED;
            PG8_LDA(At, 1, 1); PG8_STAGE(PG8_SB(1, 0), b3, voffB); PG8_STAGE(PG8_SB(1, 1), b3 + hstep, voffB); PG8_STAGE(PG8_SA(1, 0), a3, voffA);
            PG8_WAIT_V(8); PG8_WAIT_L(0); PG8_BAR; PG8_MMA(1, 0, At, B0); PG8_MMA(1, 1, At, B1); PG8_BAR; PG8_SCHED;
            } else {
            PG8_LDB(B0, 0, 0); PG8_SCHED; PG8_LDA(At, 0, 0); PG8_STAGE(PG8_SA(1, 1), a1 + hstep, voffA);
            PG8_WAIT_L(8); PG8_BAR; PG8_WAIT_L(0); PG8_MMA(0, 0, At, B0); PG8_BAR; PG8_SCHED;
            PG8_LDB(B1, 0, 1); PG8_STAGE(PG8_SB(0, 0), b2, voffB);
            PG8_BAR; PG8_WAIT_L(0); PG8_MMA(0, 1, At, B1); PG8_BAR;
            PG8_LDA(At, 0, 1); PG8_STAGE(PG8_SA(0, 0), a2, voffA);
            PG8_BAR; PG8_WAIT_L(0); PG8_MMA(1, 0, At, B0); PG8_BAR; PG8_SCHED;
            PG8_STAGE(PG8_SB(0, 1), b2 + hstep, voffB);
            PG8_WAIT_V(6); PG8_BAR; PG8_MMA(1, 1, At, B1); PG8_BAR;
            PG8_LDB(B0, 1, 0); PG8_SCHED; PG8_LDA(At, 1, 0); PG8_STAGE(PG8_SA(0, 1), a2 + hstep, voffA);
            PG8_WAIT_L(8); PG8_BAR; PG8_WAIT_L(0); PG8_MMA(0, 0, At, B0); PG8_BAR; PG8_SCHED;
            PG8_LDB(B1, 1, 1); PG8_STAGE(PG8_SB(1, 0), b3, voffB);
            PG8_BAR; PG8_WAIT_L(0); PG8_MMA(0, 1, At, B1); PG8_BAR;
            PG8_LDA(At, 1, 1); PG8_STAGE(PG8_SA(1, 0), a3, voffA);
            PG8_BAR; PG8_WAIT_L(0); PG8_MMA(1, 0, At, B0); PG8_BAR; PG8_SCHED;
            PG8_STAGE(PG8_SB(1, 1), b3 + hstep, voffB);
            PG8_WAIT_V(6); PG8_BAR; PG8_MMA(1, 1, At, B1); PG8_BAR;
            }
        }
        if constexpr (ALIGN_EPI) { if (wr == 0) PG8_BAR; }
        if constexpr (!Epi::AFTER_DRAIN) { E(acc, cur, wr, wc, fr, fq); S.done(cur); }
        if (!has_next) break;
#pragma unroll
        for (int a = 0; a < 2; ++a)
#pragma unroll
            for (int b = 0; b < 2; ++b)
#pragma unroll
                for (int m = 0; m < 4; ++m)
#pragma unroll
                    for (int n = 0; n < 2; ++n) acc[a][b][m][n] = (f32x4){0.f, 0.f, 0.f, 0.f};
        cur = nxt; cA = nA; cB = nB; ++ui;
        if constexpr (ALIGN_EPI) { if (wr == 1) PG8_BAR; }
    }
    PG8_WAIT_V(0);
    if constexpr (!ALIGN_EPI) { if (wr == 0) PG8_BAR; }
    PG8_BAR;
    if constexpr (Epi::AFTER_DRAIN) { E.fused(acc, cur, wr, wc, fr, fq, lds, wid, lane); S.done(cur); }
#undef PG8_SA
#undef PG8_SB
#undef PG8_STAGE
#undef PG8_LDA
#undef PG8_LDB
#undef PG8_MMA
#undef PG8_WAIT_V
#undef PG8_WAIT_L
#undef PG8_BAR
#undef PG8_SCHED
}
}
namespace cf {
constexpr int D = 2048, NB = 4, SEQ = 4096, CTX = 256, SEGT = 4352, M = 17408, DEPTH = 4;
constexpr int IN_COLS = 4912, PC = 5120;
constexpr int C_CQ = 0, C_CKV = 512, C_KR = 1024, C_RW = 1088, C_GD = 2848;
constexpr int RW_K = 512, RW_V = 1024, RW_WD = 1536, RW_AD = 1600, RW_GD = 1664, RW_COLS = 1760;
constexpr int GD_K = 512, GD_V = 1024, GD_Z = 1536, GD_A = 2048, GD_B = 2056;
constexpr int DFF = 5632, NCH = 68;
constexpr int QP = 1536, KP = 1536, VP = 1024;
constexpr int MODS = 6 * D;
constexpr float ALPHA = 1.681792830507429f;
constexpr int RW_TASK = 33024, GD_TASK = 98816;
}
constexpr size_t MiB = 1u << 20;
constexpr size_t WS_CTL = 0, WS_MODV = 1 * MiB, ZERO_BYTES = 2 * MiB;
constexpr size_t WS_ROPE = 2 * MiB, WS_W2T = 2 * MiB + 65536, WS_A2T = WS_W2T + 262144, WS_G2T = WS_A2T + 262144;
constexpr size_t WS_WIN = 4 * MiB, WS_WOUT = 84 * MiB, WS_WGU = 116 * MiB, WS_WDN = 292 * MiB, WS_WUQ = 380 * MiB, WS_WUKV = 386 * MiB;
constexpr size_t WS_X = 394 * MiB, WS_XM = 530 * MiB;
constexpr size_t WS_P = 598 * MiB, WS_CQN = 768 * MiB, WS_CKVN = 785 * MiB, WS_Q = 802 * MiB, WS_K = 853 * MiB, WS_V = 904 * MiB;
constexpr size_t WS_RWT = 938 * MiB, WS_GDT = 1076 * MiB, WS_YR = 1333 * MiB, WS_YG = 1401 * MiB, WS_GATE = 1469 * MiB, WS_BONUS = 1503 * MiB, WS_END = 1505 * MiB;
constexpr size_t WS_PART = 1076 * MiB;
constexpr size_t WS_HFF = 598 * MiB;
static_assert(WS_RWT + (size_t)4352 * cf::RW_TASK <= WS_GDT && WS_GDT + (size_t)2176 * cf::GD_TASK <= WS_YR && WS_HFF + (size_t)cf::M * cf::DFF * 2 <= WS_CKVN, "ws map");
constexpr int CW_TMO = 0, CW_BAR = 4096;
constexpr int LDS_BYTES = 163840, MISC_OFF = LDS_BYTES - 128;

DI float bflo(unsigned w) { return __builtin_bit_cast(float, w << 16); }
DI float bfhi(unsigned w) { return __builtin_bit_cast(float, w & 0xffff0000u); }
DI float bf2f(bf16 h) { return __builtin_bit_cast(float, (unsigned)h << 16); }
DI bf16 f2bf(float f) { unsigned u = __builtin_bit_cast(unsigned, f); return (bf16)((u + 0x7fffu + ((u >> 16) & 1u)) >> 16); }
DI unsigned pk2(float lo, float hi) { const f32x2 v = {lo, hi}; return __builtin_bit_cast(unsigned, __builtin_convertvector(v, bf16x2_t)); }
DI void unpack8(u32x4 w, float (&f)[8]) { f[0] = bflo(w.x); f[1] = bfhi(w.x); f[2] = bflo(w.y); f[3] = bfhi(w.y); f[4] = bflo(w.z); f[5] = bfhi(w.z); f[6] = bflo(w.w); f[7] = bfhi(w.w); }
DI u32x4 pack8f(const float (&f)[8]) { u32x4 w; w.x = pk2(f[0], f[1]); w.y = pk2(f[2], f[3]); w.z = pk2(f[4], f[5]); w.w = pk2(f[6], f[7]); return w; }
template <int X> DI float sx(float v) { return __builtin_bit_cast(float, __builtin_amdgcn_ds_swizzle(__builtin_bit_cast(int, v), 0x1F | (X << 10))); }
DI float lx(float v, int lane, int X) { return __builtin_bit_cast(float, __builtin_amdgcn_ds_bpermute((lane ^ X) << 2, __builtin_bit_cast(int, v))); }
DI float wave_sum(float v, int lane) {
    v += sx<1>(v); v += sx<2>(v); v += sx<4>(v); v += lx(v, lane, 8); v += lx(v, lane, 16); v += lx(v, lane, 32);
    return v;
}
DI float sigmoidf_(float x) { return __builtin_amdgcn_rcpf(1.f + __expf(-x)); }
DI float tanhf_(float x) { return 1.f - 2.f * __builtin_amdgcn_rcpf(1.f + __expf(2.f * x)); }
DI float softplusf_(float x) { const float e = __expf(x); return x > 20.f ? x : (x < -9.f ? e * (1.f - 0.5f * e) : __logf(1.f + e)); }
#define LDS_BARRIER() do { asm volatile("s_waitcnt lgkmcnt(0)" ::: "memory"); __builtin_amdgcn_s_barrier(); asm volatile("" ::: "memory"); } while (0)
#define LDS_WAIT() asm volatile("s_waitcnt lgkmcnt(0)" ::: "memory")
#define MFMA16(a, b, c) __builtin_amdgcn_mfma_f32_16x16x32_bf16((a), (b), (c), 0, 0, 0)

#define XB_TMO      128
#define XB_XCNT(j)  (256  + 64 * (j))
#define XB_XSUB(j)  (1280 + 64 * (j))
#define XB_XGEN(j)  (2304 + 64 * (j))
#define XB_TOP      3328
#define XB_TOPGEN   3392
#define XCD_BAR_WORDS 3456
#define XB_SPIN_CAP (1u << 22)
__device__ __forceinline__ unsigned xb_ld(unsigned* p)              { return __hip_atomic_load(p, __ATOMIC_RELAXED, __HIP_MEMORY_SCOPE_AGENT); }
__device__ __forceinline__ unsigned xb_add(unsigned* p, unsigned v) { return __hip_atomic_fetch_add(p, v, __ATOMIC_RELAXED, __HIP_MEMORY_SCOPE_AGENT); }
__device__ __forceinline__ unsigned xb_xcc_id() { return (unsigned)__builtin_amdgcn_s_getreg((3 << 11) | 20) & 0xFu; }
#define XB_SPIN(cond, bar) do { unsigned _sp = 0; while (cond) { __builtin_amdgcn_s_sleep(1); \
    if ((++_sp & 255u) == 0u) { if (xb_ld(&(bar)[XB_TMO])) break; if (_sp > XB_SPIN_CAP) { atomicAdd(&(bar)[XB_TMO], 1u); break; } } } } while (0)
struct XcdBarrier { unsigned* bar; unsigned x; volatile LAS unsigned* st; };
__device__ __forceinline__ XcdBarrier xcd_barrier_post(unsigned* bar, volatile LAS unsigned* st) {
    XcdBarrier b; b.bar = bar; b.x = xb_xcc_id(); b.st = st;
    if (threadIdx.x == 0) (void)xb_add(&bar[XB_XCNT(b.x)], 1u);
    return b;
}
__device__ __forceinline__ void xcd_barrier_complete(unsigned* bar, unsigned x, unsigned& nloc, unsigned& nx) {
    const unsigned G = gridDim.x * gridDim.y * gridDim.z;
    unsigned sum, cnt, mine, sp = 0u;
    for (;;) {
        sum = 0u; cnt = 0u; mine = 0u;
#pragma unroll
        for (unsigned j = 0; j < 16; ++j) { const unsigned c = xb_ld(&bar[XB_XCNT(j)]); sum += c; cnt += (c > 0u) ? 1u : 0u; mine = (j == x) ? c : mine; }
        if (sum == G) break;
        __builtin_amdgcn_s_sleep(1);
        if ((++sp & 255u) == 0u) { if (xb_ld(&bar[XB_TMO])) break; if (sp > XB_SPIN_CAP) { atomicAdd(&bar[XB_TMO], 1u); break; } }
    }
    nloc = mine > 0u ? mine : 1u; nx = cnt > 0u ? cnt : 1u;
}
__device__ __forceinline__ void xcd_barrier(const XcdBarrier& b) {
    asm volatile("s_waitcnt vmcnt(0)" ::: "memory");
    __syncthreads();
    if (threadIdx.x == 0) {
        unsigned* bar = b.bar;
        __builtin_amdgcn_s_waitcnt(0);
        unsigned nloc = b.st[0], nx = b.st[1];
        if (nloc == 0u) { xcd_barrier_complete(bar, b.x, nloc, nx); b.st[0] = nloc; b.st[1] = nx; }
        const unsigned old = xb_add(&bar[XB_XSUB(b.x)], 1u);
        const unsigned gen = old / nloc;
        if (old + 1u == (gen + 1u) * nloc) {
            __builtin_amdgcn_fence(__ATOMIC_RELEASE, "agent");
            asm volatile("s_waitcnt vmcnt(0)" ::: "memory");
            const unsigned og = xb_add(&bar[XB_TOP], 1u);
            const unsigned tg = og / nx;
            if (og + 1u == (tg + 1u) * nx) xb_add(&bar[XB_TOPGEN], 1u);
            else XB_SPIN(xb_ld(&bar[XB_TOPGEN]) == tg, bar);
            __builtin_amdgcn_fence(__ATOMIC_ACQUIRE, "agent");
            xb_add(&bar[XB_XGEN(b.x)], 1u);
            asm volatile("s_waitcnt vmcnt(0)" ::: "memory");
        } else {
            XB_SPIN(xb_ld(&bar[XB_XGEN(b.x)]) == gen, bar);
            __builtin_amdgcn_fence(__ATOMIC_ACQUIRE, "agent");
            asm volatile("s_waitcnt vmcnt(0)" ::: "memory");
        }
    }
    __syncthreads();
}

DI int row_of(int b, int dir, int ci, int i) {
    int s;
    if (dir == 0) s = ci * 64 + i;
    else s = (ci < 4) ? (3 - ci) * 64 + (63 - i) : 256 + (67 - ci) * 64 + (63 - i);
    return b * cf::SEGT + s;
}
DI void transpose_item(const float* W, int K, int N, bf16* WT, int out_row0, int k0, int n0, LAS float* scr, int lane) {
    const int n = n0 + (lane & 31); const bool ok = n < N;
#pragma unroll 8
    for (int i = 0; i < 32; ++i) { const int kk = 2 * i + (lane >> 5); scr[kk * 33 + (lane & 31)] = ok ? W[(size_t)(k0 + kk) * N + n] : 0.f; }
    LDS_WAIT();
    const int c = lane & 7;
#pragma unroll
    for (int j = 0; j < 4; ++j) { const int nn = (lane >> 3) + 8 * j; const LAS float* s = scr + (8 * c) * 33 + nn;
        u32x4 o; o.x = pk2(s[0 * 33], s[1 * 33]); o.y = pk2(s[2 * 33], s[3 * 33]); o.z = pk2(s[4 * 33], s[5 * 33]); o.w = pk2(s[6 * 33], s[7 * 33]);
        *(u32x4*)(WT + (size_t)(out_row0 + nn) * K + k0 + 8 * c) = o; }
    LDS_WAIT();
}

struct In { const float* p[34]; };

DI void phase_prologue(const In& in, uchar* ws, LAS uchar* lds, int G, int bx, int tid) {
    using namespace cf;
    const int lane = tid & 63, wid = __builtin_amdgcn_readfirstlane(tid >> 6), gw = bx * 8 + wid, NGW = G * 8;
    LAS float* scr = (LAS float*)(lds + wid * 16384);
    constexpr int I_IN = 32 * 160, I_OUT = 32 * 64, I_G = 32 * 176, I_DN = 88 * 64, I_UQ = 8 * 48, I_UKV = 8 * 64;
    constexpr int I_LAYER = I_IN + I_OUT + 2 * I_G + I_DN + I_UQ + I_UKV;
    for (int it = gw; it < DEPTH * I_LAYER; it += NGW) {
        const int l = it / I_LAYER; int r = it % I_LAYER;
        if (r < I_IN) { const int kb = r / 160, nb = r % 160; transpose_item(in.p[6] + (size_t)l * D * IN_COLS, D, IN_COLS, (bf16*)(ws + WS_WIN) + (size_t)l * PC * D, nb * 32, kb * 64, nb * 32, scr, lane); continue; } r -= I_IN;
        if (r < I_OUT) { const int kb = r / 64, nb = r % 64; transpose_item(in.p[26] + (size_t)l * D * D, D, D, (bf16*)(ws + WS_WOUT) + (size_t)l * D * D, nb * 32, kb * 64, nb * 32, scr, lane); continue; } r -= I_OUT;
        if (r < 2 * I_G) { const int up = r >= I_G; if (up) r -= I_G; const int kb = r / 176, nb = r % 176, n0 = nb * 32;
            transpose_item(in.p[up ? 30 : 29] + (size_t)l * D * DFF, D, DFF, (bf16*)(ws + WS_WGU) + (size_t)l * 2 * DFF * D, 256 * (n0 / 128) + (n0 % 128) + (up ? 128 : 0), kb * 64, n0, scr, lane); continue; } r -= 2 * I_G;
        if (r < I_DN) { const int kb = r / 64, nb = r % 64; transpose_item(in.p[31] + (size_t)l * DFF * D, DFF, D, (bf16*)(ws + WS_WDN) + (size_t)l * D * DFF, nb * 32, kb * 64, nb * 32, scr, lane); continue; } r -= I_DN;
        if (r < I_UQ) { const int kb = r / 48, nb = r % 48; transpose_item(in.p[9] + (size_t)l * 512 * 1536, 512, 1536, (bf16*)(ws + WS_WUQ) + (size_t)l * 1536 * 512, nb * 32, kb * 64, nb * 32, scr, lane); continue; } r -= I_UQ;
        { const int kb = r / 64, nb = r % 64; transpose_item(in.p[10] + (size_t)l * 512 * 2048, 512, 2048, (bf16*)(ws + WS_WUKV) + (size_t)l * 2048 * 512, nb * 32, kb * 64, nb * 32, scr, lane); }
    }
    float* X = (float*)(ws + WS_X);
    for (int r = gw; r < M; r += NGW) { const int b = r / SEGT, s = r % SEGT;
        const float* src = (s < CTX) ? in.p[2] + ((size_t)b * CTX + s) * D : in.p[0] + ((size_t)b * SEQ + (s - CTX)) * D;
        const f32x4* sp = (const f32x4*)src + lane; f32x4* dp = (f32x4*)(X + (size_t)r * D) + lane;
#pragma unroll
        for (int j = 0; j < 8; ++j) dp[64 * j] = sp[64 * j]; }
    const int gt = bx * 512 + tid, NGT = G * 512;
    float* rope = (float*)(ws + WS_ROPE);
    for (int i = gt; i < 1024; i += NGT) { const int pos = i >> 4, f = i & 15; const float inv = powf(10000.f, -(float)f / 16.f), ang = (float)pos * inv; rope[i] = cosf(ang); rope[1024 + i] = sinf(ang); }
    bf16* W2T = (bf16*)(ws + WS_W2T); bf16* A2T = (bf16*)(ws + WS_A2T); bf16* G2T = (bf16*)(ws + WS_G2T);
    for (int i = gt; i < DEPTH * 2 * 512 * 32; i += NGT) { const int r = i & 31, c = (i >> 5) & 511, ld = i >> 14;
        W2T[i] = f2bf(in.p[13][((size_t)ld * 32 + r) * 512 + c]); A2T[i] = f2bf(in.p[15][((size_t)ld * 32 + r) * 512 + c]); }
    for (int i = gt; i < DEPTH * 512 * 96; i += NGT) { const int k = i % 96, c = (i / 96) % 512, l = i / (96 * 512);
        G2T[i] = f2bf(in.p[16][((size_t)l * 96 + k) * 512 + c]); }
    LAS float* sv = scr;
    for (int it = gw; it < DEPTH * 48 * 16; it += NGW) {
        const int kp = it & 15, ng = (it >> 4) % 48, l = it / (16 * 48);
        for (int i = lane; i < 640; i += 64) { const int v = i >> 7, k = kp * 128 + (i & 127); const float x = (v < 4) ? in.p[1][v * D + k] : in.p[3][k]; sv[i] = x * sigmoidf_(x); }
        LDS_WAIT();
        const int n = ng * 256 + lane * 4;
        const float* wp = in.p[4] + ((size_t)l * D + (size_t)kp * 128) * MODS + n;
        f32x4 acc[5];
#pragma unroll
        for (int v = 0; v < 5; ++v) acc[v] = (f32x4){0.f, 0.f, 0.f, 0.f};
#pragma unroll 8
        for (int kk = 0; kk < 128; ++kk) { const f32x4 w = *(const f32x4*)(wp + (size_t)kk * MODS);
#pragma unroll
            for (int v = 0; v < 5; ++v) acc[v] += w * sv[v * 128 + kk]; }
        float* part = (float*)(ws + WS_P) + (size_t)kp * (DEPTH * 5 * MODS);
#pragma unroll
        for (int v = 0; v < 5; ++v) *(f32x4*)(part + ((size_t)l * 5 + v) * MODS + n) = acc[v];
        LDS_WAIT();
    }
}

DI void phase_modreduce(const In& in, uchar* ws, int G, int bx, int tid) {
    using namespace cf;
    float* modv = (float*)(ws + WS_MODV); const float* part = (const float*)(ws + WS_P);
    for (int i = bx * 512 + tid; i < DEPTH * 5 * MODS / 4; i += G * 512) { const int n4 = i % (MODS / 4), l = i / (5 * MODS / 4);
        f32x4 s = *(const f32x4*)(in.p[5] + (size_t)l * MODS + n4 * 4);
#pragma unroll
        for (int kp = 0; kp < 16; ++kp) s += *(const f32x4*)(part + (size_t)kp * (DEPTH * 5 * MODS) + (size_t)i * 4);
        *(f32x4*)(modv + (size_t)i * 4) = s; }
}

DI void phase_modulate(const float* X, bf16* XM, const float* modl  , int shift_off, int scale_off, int G, int bx, int tid) {
    using namespace cf;
    const int lane = tid & 63, gw = bx * 8 + __builtin_amdgcn_readfirstlane(tid >> 6), NGW = G * 8;
    for (int r = gw; r < M; r += NGW) { const int b = r / SEGT, s = r % SEGT, vec = (s < CTX) ? 4 : b;
        const f32x4* xp = (const f32x4*)(X + (size_t)r * D) + lane; const f32x4* sh = (const f32x4*)(modl + (size_t)vec * MODS + shift_off) + lane; const f32x4* sc = (const f32x4*)(modl + (size_t)vec * MODS + scale_off) + lane;
        u32x2* op = (u32x2*)(XM + (size_t)r * D) + lane;
#pragma unroll
        for (int j = 0; j < 8; ++j) { const f32x4 v = xp[64 * j] * (sc[64 * j] + 1.f) + sh[64 * j]; u32x2 o; o.x = pk2(v.x, v.y); o.y = pk2(v.z, v.w); op[64 * j] = o; } }
}

DI void ln_one_row(float* X, f32x4 (&v)[8], int r, const float* g, const float* bb, bf16* XM, const float* modl, int shift_off, int scale_off, float* out, const float* part, int nparts, const float* cgate, int lane) {
    using namespace cf;
    const int b = r / SEGT, s = r % SEGT, vec = (s < CTX) ? 4 : b;
    f32x4* xp = (f32x4*)(X + (size_t)r * D) + lane;
    float sum = 0.f;
    if (part && s < CTX) {
        const f32x4* gp4 = (const f32x4*)cgate + lane;
#pragma unroll
        for (int j = 0; j < 8; ++j) { f32x4 a = (f32x4){0.f, 0.f, 0.f, 0.f};
            for (int ks = 0; ks < nparts; ++ks) a += *((const f32x4*)(part + ((size_t)ks * 1024 + b * 256 + s) * D) + lane + 64 * j);
            v[j] = v[j] * ALPHA + gp4[64 * j] * a; } }
#pragma unroll
    for (int j = 0; j < 8; ++j) sum += (v[j].x + v[j].y) + (v[j].z + v[j].w);
    const float mean = wave_sum(sum, lane) * (1.f / D); float s2 = 0.f;
#pragma unroll
    for (int j = 0; j < 8; ++j) { v[j] = v[j] - mean; s2 += (v[j].x * v[j].x + v[j].y * v[j].y) + (v[j].z * v[j].z + v[j].w * v[j].w); }
    const float rstd = rsqrtf(wave_sum(s2, lane) * (1.f / D) + 1e-5f);
    const f32x4* gp = (const f32x4*)g + lane; const f32x4* bp = (const f32x4*)bb + lane;
#pragma unroll
    for (int j = 0; j < 8; ++j) v[j] = v[j] * rstd * gp[64 * j] + bp[64 * j];
    if (out) { f32x4* op = (f32x4*)(out + ((size_t)b * SEQ + (s - CTX)) * D) + lane;
#pragma unroll
        for (int j = 0; j < 8; ++j) op[64 * j] = v[j];
    } else {
        const f32x4* sh = (const f32x4*)(modl + (size_t)vec * MODS + shift_off) + lane; const f32x4* sc = (const f32x4*)(modl + (size_t)vec * MODS + scale_off) + lane;
        u32x2* op = (u32x2*)(XM + (size_t)r * D) + lane;
#pragma unroll
        for (int j = 0; j < 8; ++j) { xp[64 * j] = v[j]; const f32x4 m = v[j] * (sc[64 * j] + 1.f) + sh[64 * j]; u32x2 o; o.x = pk2(m.x, m.y); o.y = pk2(m.z, m.w); op[64 * j] = o; }
    }
}
DI void phase_ln(float* X, const float* g, const float* bb, bf16* XM, const float* modl, int shift_off, int scale_off, float* out, const float* part, int nparts, const float* cgate, bool skip_ctx, int G, int bx, int tid) {
    using namespace cf;
    const int lane = tid & 63, gw = bx * 8 + __builtin_amdgcn_readfirstlane(tid >> 6), NGW = G * 8;
    for (int r0 = gw; r0 < M; r0 += 2 * NGW) {
        const int r1 = r0 + NGW;
        const bool do0 = !(skip_ctx && (r0 % SEGT) < CTX), do1 = r1 < M && !(skip_ctx && (r1 % SEGT) < CTX);
        f32x4 va[8], vb[8];
        if (do0) { const f32x4* xp = (const f32x4*)(X + (size_t)r0 * D) + lane;
#pragma unroll
            for (int j = 0; j < 8; ++j) va[j] = xp[64 * j]; }
        if (do1) { const f32x4* xp = (const f32x4*)(X + (size_t)r1 * D) + lane;
#pragma unroll
            for (int j = 0; j < 8; ++j) vb[j] = xp[64 * j]; }
        if (do0) ln_one_row(X, va, r0, g, bb, XM, modl, shift_off, scale_off, out, part, nparts, cgate, lane);
        if (do1) ln_one_row(X, vb, r1, g, bb, XM, modl, shift_off, scale_off, out, part, nparts, cgate, lane);
    }
}

DI void mla_prep_rows(const bf16* P, bf16* CQN, bf16* CKVN, bf16* Kb, const float* qn, const float* kvn, const float* rope, int G, int bx, int tid) {
    using namespace cf;
    const int lane = tid & 63, gw = bx * 8 + __builtin_amdgcn_readfirstlane(tid >> 6), NGW = G * 8;
    const f32x4 gq0 = *(const f32x4*)(qn + lane * 8), gq1 = *(const f32x4*)(qn + lane * 8 + 4), gk0 = *(const f32x4*)(kvn + lane * 8), gk1 = *(const f32x4*)(kvn + lane * 8 + 4);
    const int axis = lane >> 5, half = (lane >> 4) & 1, f = lane & 15;
    for (int r0 = gw; r0 < M; r0 += 2 * NGW) {
        const int r1 = (r0 + NGW < M) ? r0 + NGW : r0;
        const bf16* pa = P + (size_t)r0 * PC; const bf16* pb = P + (size_t)r1 * PC;
        const u32x4 a0 = *(const u32x4*)(pa + lane * 8), a1 = *(const u32x4*)(pa + 512 + lane * 8), b0 = *(const u32x4*)(pb + lane * 8), b1 = *(const u32x4*)(pb + 512 + lane * 8);
        const bf16 ka = pa[C_KR + lane], kb = pb[C_KR + lane];
#pragma unroll
        for (int rr = 0; rr < 2; ++rr) { const int r = rr ? r1 : r0, s = r % SEGT;
#pragma unroll
            for (int part = 0; part < 2; ++part) {
                float x[8]; unpack8(rr ? (part ? b1 : b0) : (part ? a1 : a0), x);
                float ss = 0.f;
#pragma unroll
                for (int e = 0; e < 8; ++e) ss += x[e] * x[e];
                const float rs = rsqrtf(wave_sum(ss, lane) * (1.f / 512.f) + 1e-6f);
                const f32x4 g0 = part ? gk0 : gq0, g1 = part ? gk1 : gq1;
                float o[8];
#pragma unroll
                for (int e = 0; e < 8; ++e) o[e] = x[e] * rs * (e < 4 ? g0[e] : g1[e - 4]);
                *(u32x4*)((part ? CKVN : CQN) + (size_t)r * 512 + lane * 8) = pack8f(o);
            }
            float kr = bf2f(rr ? kb : ka);
            const float other = lx(kr, lane, 16);
            if (s >= CTX) { const int t = s - CTX, pos = axis ? (t & 63) : (t >> 6);
                const float c = rope[pos * 16 + f], sn = rope[1024 + pos * 16 + f];
                kr = half ? (other * sn + kr * c) : (kr * c - other * sn); }
            const bf16 kq = f2bf(kr);
#pragma unroll
            for (int h = 0; h < 8; ++h) Kb[(size_t)r * KP + h * 192 + 128 + lane] = kq;
        }
    }
}

DI void mix_rows(const bf16* P, const float* YR, const float* YG, const float* GATE, const float* BONUS, bf16* MIX,
                 const float* mu, const float* gn_g, const float* gn_b, const float* gdn_norm, int G, int bx, int tid) {
    using namespace cf;
    const int lane = tid & 63, gw = bx * 8 + __builtin_amdgcn_readfirstlane(tid >> 6), NGW = G * 8;
#pragma unroll 2
    for (int r = gw; r < M; r += NGW) { const int s = r % SEGT; const bf16* pr = P + (size_t)r * PC;
        const bool hasp = (s != 0) && (s != CTX), hasn = (s != CTX - 1) && (s != SEGT - 1);
        const int c0 = lane * 8;
        {
            float y[8], v[8];
            { const f32x4 a0 = *(const f32x4*)(YR + (size_t)r * 512 + c0), a1 = *(const f32x4*)(YR + (size_t)r * 512 + c0 + 4);
              const f32x4 b0 = *(const f32x4*)(YR + ((size_t)M + r) * 512 + c0), b1 = *(const f32x4*)(YR + ((size_t)M + r) * 512 + c0 + 4);
#pragma unroll
              for (int e = 0; e < 4; ++e) { y[e] = a0[e] + b0[e]; y[4 + e] = a1[e] + b1[e]; } }
            float sm = 0.f;
#pragma unroll
            for (int e = 0; e < 8; ++e) sm += y[e];
            sm += sx<1>(sm); sm += sx<2>(sm); sm += sx<4>(sm);
            const float mean = sm * (1.f / 64.f); float q = 0.f;
#pragma unroll
            for (int e = 0; e < 8; ++e) { y[e] -= mean; q += y[e] * y[e]; }
            q += sx<1>(q); q += sx<2>(q); q += sx<4>(q);
            const float rstd = rsqrtf(q * (1.f / 64.f) + 64e-5f);
            { float cur[8], prv[8], nxt[8]; const int col = C_RW + RW_V + c0;
              unpack8(*(const u32x4*)(pr + col), cur);
              if (hasp) unpack8(*(const u32x4*)(pr - PC + col), prv); else {
#pragma unroll
                  for (int e = 0; e < 8; ++e) prv[e] = 0.f; }
              if (hasn) unpack8(*(const u32x4*)(pr + PC + col), nxt); else {
#pragma unroll
                  for (int e = 0; e < 8; ++e) nxt[e] = 0.f; }
              const f32x4 m0 = *(const f32x4*)(mu + RW_V + c0), m1 = *(const f32x4*)(mu + RW_V + c0 + 4);
#pragma unroll
              for (int e = 0; e < 8; ++e) v[e] = cur[e] + (0.5f * (prv[e] + nxt[e]) - cur[e]) * (e < 4 ? m0[e] : m1[e - 4]); }
            const int h = lane >> 3;
            const float bonus = BONUS[(size_t)r * 8 + h] + BONUS[((size_t)M + r) * 8 + h];
            const f32x4 gg0 = *(const f32x4*)(gn_g + c0), gg1 = *(const f32x4*)(gn_g + c0 + 4), gb0 = *(const f32x4*)(gn_b + c0), gb1 = *(const f32x4*)(gn_b + c0 + 4);
            const f32x4 gt0 = *(const f32x4*)(GATE + (size_t)r * 512 + c0), gt1 = *(const f32x4*)(GATE + (size_t)r * 512 + c0 + 4);
            float o[8];
#pragma unroll
            for (int e = 0; e < 8; ++e) o[e] = (y[e] * rstd * (e < 4 ? gg0[e] : gg1[e - 4]) + (e < 4 ? gb0[e] : gb1[e - 4]) + bonus * v[e]) * (e < 4 ? gt0[e] : gt1[e - 4]);
            *(u32x4*)(MIX + (size_t)r * D + 1024 + c0) = pack8f(o);
        }
        {
            float y[8], z[8];
            { const f32x4 a0 = *(const f32x4*)(YG + (size_t)r * 512 + c0), a1 = *(const f32x4*)(YG + (size_t)r * 512 + c0 + 4);
              const f32x4 b0 = *(const f32x4*)(YG + ((size_t)M + r) * 512 + c0), b1 = *(const f32x4*)(YG + ((size_t)M + r) * 512 + c0 + 4);
#pragma unroll
              for (int e = 0; e < 4; ++e) { y[e] = a0[e] + b0[e]; y[4 + e] = a1[e] + b1[e]; } }
            float q = 0.f;
#pragma unroll
            for (int e = 0; e < 8; ++e) q += y[e] * y[e];
            q += sx<1>(q); q += sx<2>(q); q += sx<4>(q); q += lx(q, lane, 8);
            const float rs = rsqrtf(q * (1.f / 128.f) + 1e-6f);
            unpack8(*(const u32x4*)(pr + C_GD + GD_Z + c0), z);
            const int cn = c0 & 127; const f32x4 n0 = *(const f32x4*)(gdn_norm + cn), n1 = *(const f32x4*)(gdn_norm + cn + 4);
            float o[8];
#pragma unroll
            for (int e = 0; e < 8; ++e) o[e] = y[e] * rs * (e < 4 ? n0[e] : n1[e - 4]) * (z[e] * sigmoidf_(z[e]));
            *(u32x4*)(MIX + (size_t)r * D + 1536 + c0) = pack8f(o);
        }
    }
}
#define FRAGOFF(R, C, KS) ((((R) >> 4) * (KS) + ((C) >> 5)) * 1024 + ((((C) >> 3) & 3) * 16 + ((R) & 15)) * 16 + ((C) & 7) * 2)
template <int K> DI f32x4 mm_tile(const LAS bf16* A, int lda, const LAS bf16* Bt, int ldb, int tm, int tn, f32x4 acc, int lane) {
    const int r = lane & 15, q = lane >> 4;
#pragma unroll
    for (int k0 = 0; k0 < K; k0 += 32) {
        const bf16x8 a = *(const LAS bf16x8*)(A + (16 * tm + r) * lda + k0 + q * 8);
        const bf16x8 b = *(const LAS bf16x8*)(Bt + (16 * tn + r) * ldb + k0 + q * 8);
        acc = MFMA16(a, b, acc);
    }
    return acc;
}
template <int NCL>
DI void inv_offblock(const LAS float* A, LAS float* TF, LAS bf16* TT, LAS float* scr, int i, int j, int c0, int lane) {
    const int r = lane & 15, q = lane >> 4, cb = c0 + q * NCL;
    float p[NCL];
#pragma unroll
    for (int e = 0; e < NCL; ++e) p[e] = 0.f;
    for (int kb = j; kb < i; ++kb) {
#pragma unroll
        for (int s = 0; s < 16; ++s) { const float a = A[(16 * i + r) * 65 + 16 * kb + s]; const LAS float* tp = TF + (16 * kb + s) * 65 + 16 * j + cb;
#pragma unroll
            for (int e = 0; e < NCL; ++e) p[e] += a * tp[e]; }
    }
#pragma unroll
    for (int e = 0; e < NCL; ++e) scr[r * 17 + q * NCL + e] = p[e];
    LDS_WAIT();
    float o[NCL];
#pragma unroll
    for (int e = 0; e < NCL; ++e) o[e] = 0.f;
#pragma unroll
    for (int s = 0; s < 16; ++s) { const float t = TF[(16 * i + r) * 65 + 16 * i + s];
#pragma unroll
        for (int e = 0; e < NCL; ++e) o[e] += t * scr[s * 17 + q * NCL + e]; }
#pragma unroll
    for (int e = 0; e < NCL; ++e) { TF[(16 * i + r) * 65 + 16 * j + cb + e] = o[e]; TT[(16 * i + r) * 72 + 16 * j + cb + e] = f2bf(o[e]); }
}
template <class Side>
DI void inv_blocked(const LAS float* A, LAS float* TF, LAS bf16* TT, LAS float* scr_all, int wid, int lane, int tid, const Side& side) {
    if (wid < 4) { if (lane < 16) { const int j = lane, base = 16 * wid; float tc[16];
#pragma unroll
        for (int t = 0; t < 16; ++t) { float acc = (t == j) ? 1.f : 0.f;
#pragma unroll
            for (int s = 0; s < t; ++s) acc += A[(base + t) * 65 + base + s] * tc[s];
            tc[t] = acc; }
#pragma unroll
        for (int t = 0; t < 16; ++t) { TF[(base + t) * 65 + base + j] = tc[t]; TT[(base + t) * 72 + base + j] = f2bf(tc[t]); }
    } } else side(wid - 4);
    LDS_BARRIER();
    LAS float* scr = scr_all + wid * 272;
    if (wid < 6) inv_offblock<2>(A, TF, TT, scr, (wid >> 1) + 1, wid >> 1, (wid & 1) * 8, lane);
    LDS_BARRIER();
    inv_offblock<1>(A, TF, TT, scr, (wid >> 2) + 2, wid >> 2, (wid & 3) * 4, lane);
    LDS_BARRIER();
    if (wid < 4) inv_offblock<1>(A, TF, TT, scr, 3, 0, wid * 4, lane);
    LDS_BARRIER();
}

struct ScanW {
    const float *mu, *w0, *a0, *k_k, *k_a, *r_k;
    const bf16 *W2T, *A2T, *G2T;
    const float *conv, *a_log, *dt_bias;
};

constexpr int RWB = 136192, RWB_W2 = RWB + 2688, RWB_A2 = RWB_W2 + 5120, RWB_G2 = RWB_A2 + 5120;
constexpr int GDB = 143360;
DI void rw_stage_weights(LAS uchar* lds, const ScanW& sw, int h, int dir, int tid) {
    LAS float* WF = (LAS float*)(lds + RWB);
    for (int i = tid; i < 672; i += 512) { float v;
        if (i < 64) v = sw.w0[dir * 512 + h * 64 + i]; else if (i < 128) v = sw.a0[dir * 512 + h * 64 + i - 64]; else if (i < 192) v = sw.k_k[h * 64 + i - 128];
        else if (i < 256) v = sw.k_a[h * 64 + i - 192]; else if (i < 320) v = sw.r_k[h * 64 + i - 256];
        else if (i < 512) v = sw.mu[((i - 320) >> 6) * 512 + h * 64 + ((i - 320) & 63)];
        else if (i < 544) v = sw.mu[cf::RW_WD + dir * 32 + i - 512]; else if (i < 576) v = sw.mu[cf::RW_AD + dir * 32 + i - 544]; else v = sw.mu[cf::RW_GD + i - 576];
        WF[i] = v; }
    { const int which = tid >> 8, t = tid & 255, row = t >> 2, ch = t & 3;
      *(LAS u32x4*)(lds + (which ? RWB_A2 : RWB_W2) + (row * 40 + ch * 8) * 2) = *(const u32x4*)((which ? sw.A2T : sw.W2T) + ((size_t)dir * 512 + h * 64 + row) * 32 + ch * 8); }
    LDS_BARRIER();
}
DI void gd_stage_weights(LAS uchar* lds, const ScanW& sw, int h, int tid) {
    LAS float* CW = (LAS float*)(lds + GDB);
    for (int i = tid; i < 1920; i += 512) { const int jw = i >> 7, c = i & 127; CW[i] = sw.conv[(size_t)(jw / 3) * 1536 + (jw % 3) * 512 + h * 128 + c]; }
    LDS_BARRIER();
}

struct RwRaw { u32x4 c[3]; };
DI void rw_issue(RwRaw& q, const bf16* P, int b, int h, int dir, int ci, int tid) {
    using namespace cf;
    const int i = tid >> 3, sub = tid & 7;
    const int R = row_of(b, dir, ci, i), seg_lo = b * SEGT + (ci < 4 ? 0 : CTX), seg_hi = b * SEGT + (ci < 4 ? CTX : SEGT);
    const bf16* pr = P + (size_t)R * PC + C_RW; (void)seg_lo; (void)seg_hi;
#pragma unroll
    for (int w = 0; w < 3; ++w) { const int col = w * 512 + h * 64 + sub * 8;
        q.c[w] = *(const u32x4*)(pr + col); }
}

DI void s1_rwkv(LAS uchar* lds, const bf16* P, const ScanW& sw, uchar* task, float* GATE, float* BONUSd, int b, int h, int dir, int ci, int tid, unsigned& chk, int nb, int nci) {
    RwRaw raw;
    using namespace cf;
    constexpr int MB = 9216;
    LAS bf16* AT = (LAS bf16*)(lds + 0 * MB); LAS bf16* BT = (LAS bf16*)(lds + 1 * MB); LAS bf16* KT = (LAS bf16*)(lds + 2 * MB); LAS bf16* QT = (LAS bf16*)(lds + 3 * MB);
    LAS bf16* ATT = (LAS bf16*)(lds + 4 * MB); LAS bf16* VT = (LAS bf16*)(lds + 5 * MB); LAS bf16* KHT = (LAS bf16*)(lds + 6 * MB); LAS bf16* BHT = (LAS bf16*)(lds + 7 * MB);
    LAS bf16* AAK = (LAS bf16*)(lds + 8 * MB); LAS bf16* AQK = (LAS bf16*)(lds + 9 * MB); LAS bf16* TT = (LAS bf16*)(lds + 10 * MB); LAS bf16* XT = (LAS bf16*)(lds + 11 * MB);
    LAS float* AAB = (LAS float*)(lds + 12 * MB); LAS float* GC = AAB;
    LAS float* INVS = (LAS float*)(lds + 12 * MB + 16640);
    LAS float* LWf = (LAS float*)(lds + 8 * MB); LAS float* LAf = (LAS float*)(lds + 10 * MB); LAS float* TF = (LAS float*)(lds + 0);
    LAS bf16* WTT = (LAS bf16*)(lds + 0 * MB); LAS bf16* ULT = (LAS bf16*)(lds + 1 * MB); LAS bf16* AQBL = (LAS bf16*)(lds + RWB_G2);
    const LAS float* WF = (const LAS float*)(lds + RWB);
    LAS bf16* TW = (LAS bf16*)(lds + 0); LAS bf16* AD = (LAS bf16*)(lds + 5120); LAS bf16* SG = (LAS bf16*)(lds + 10240);
    const int lane = tid & 63, wid = __builtin_amdgcn_readfirstlane(tid >> 6), i = tid >> 3, sub = tid & 7, r16 = lane & 15, q4 = lane >> 4;
    const int R = row_of(b, dir, ci, i), seg_lo = b * SEGT + (ci < 4 ? 0 : CTX), seg_hi = b * SEGT + (ci < 4 ? CTX : SEGT);
    const bool hasp = R - 1 >= seg_lo, hasn = R + 1 < seg_hi;
    const bf16* pr = P + (size_t)R * PC + C_RW;
    float rv[8], kv[8], vv[8];
#ifndef RW_PREFETCH
    rw_issue(raw, P, b, h, dir, ci, tid);
#endif
#ifdef DUP_ST01
    for (int rp_ = 0; rp_ < 2; ++rp_) {
#endif
#pragma unroll
    for (int w = 0; w < 3; ++w) { const int col = w * 512 + h * 64 + sub * 8; float cur[8], prv[8], nxt[8];
        unpack8(raw.c[w], cur);
        if (hasp) unpack8(*(const u32x4*)(pr - PC + col), prv); else {
#pragma unroll
            for (int e = 0; e < 8; ++e) prv[e] = 0.f; }
        if (hasn) unpack8(*(const u32x4*)(pr + PC + col), nxt); else {
#pragma unroll
            for (int e = 0; e < 8; ++e) nxt[e] = 0.f; }
        const f32x4 m0 = *(const LAS f32x4*)(WF + 320 + w * 64 + sub * 8), m1 = *(const LAS f32x4*)(WF + 320 + w * 64 + sub * 8 + 4);
#pragma unroll
        for (int e = 0; e < 8; ++e) { const float x = cur[e] + (0.5f * (prv[e] + nxt[e]) - cur[e]) * (e < 4 ? m0[e] : m1[e - 4]); if (w == 0) rv[e] = x; else if (w == 1) kv[e] = x; else vv[e] = x; } }
#pragma unroll
    for (int w = 0; w < 2; ++w) { const int col = (w ? RW_AD : RW_WD) + dir * 32 + sub * 4;
        const u32x2 c2 = *(const u32x2*)(pr + col); u32x2 p2 = (u32x2){0u, 0u}, n2 = (u32x2){0u, 0u};
        if (hasp) p2 = *(const u32x2*)(pr - PC + col); if (hasn) n2 = *(const u32x2*)(pr + PC + col);
        const f32x4 m = *(const LAS f32x4*)(WF + 512 + w * 32 + sub * 4);
        const float cur[4] = {bflo(c2.x), bfhi(c2.x), bflo(c2.y), bfhi(c2.y)}, prv[4] = {bflo(p2.x), bfhi(p2.x), bflo(p2.y), bfhi(p2.y)}, nxt[4] = {bflo(n2.x), bfhi(n2.x), bflo(n2.y), bfhi(n2.y)};
        float x[4];
#pragma unroll
        for (int e = 0; e < 4; ++e) { x[e] = cur[e] + (0.5f * (prv[e] + nxt[e]) - cur[e]) * m[e]; if (w == 0) x[e] = tanhf_(x[e]); }
        u32x2 o; o.x = pk2(x[0], x[1]); o.y = pk2(x[2], x[3]);
        *(LAS u32x2*)((w ? AD : TW) + i * 40 + sub * 4) = o; }
    if (dir == 0) {
#pragma unroll
        for (int j = 0; j < 3; ++j) { const int col = RW_GD + sub * 12 + j * 4;
            const u32x2 c2 = *(const u32x2*)(pr + col); u32x2 p2 = (u32x2){0u, 0u}, n2 = (u32x2){0u, 0u};
            if (hasp) p2 = *(const u32x2*)(pr - PC + col); if (hasn) n2 = *(const u32x2*)(pr + PC + col);
            const f32x4 m = *(const LAS f32x4*)(WF + 576 + sub * 12 + j * 4);
            const float cur[4] = {bflo(c2.x), bfhi(c2.x), bflo(c2.y), bfhi(c2.y)}, prv[4] = {bflo(p2.x), bfhi(p2.x), bflo(p2.y), bfhi(p2.y)}, nxt[4] = {bflo(n2.x), bfhi(n2.x), bflo(n2.y), bfhi(n2.y)};
            float x[4];
#pragma unroll
            for (int e = 0; e < 4; ++e) x[e] = sigmoidf_(cur[e] + (0.5f * (prv[e] + nxt[e]) - cur[e]) * m[e]);
            u32x2 o; o.x = pk2(x[0], x[1]); o.y = pk2(x[2], x[3]);
            *(LAS u32x2*)(SG + i * 104 + sub * 12 + j * 4) = o; }
    }
    LDS_BARRIER();
    { const int which = wid >> 2, tm = wid & 3;
      const bf16x8 a = *(const LAS bf16x8*)((which ? AD : TW) + (16 * tm + r16) * 40 + q4 * 8);
      const LAS bf16* wt = (const LAS bf16*)(lds + (which ? RWB_A2 : RWB_W2));
#pragma unroll
      for (int tn = 0; tn < 4; ++tn) { const bf16x8 bb = *(const LAS bf16x8*)(wt + (16 * tn + r16) * 40 + q4 * 8);
          const f32x4 acc = MFMA16(a, bb, ((f32x4){0.f, 0.f, 0.f, 0.f}));
#pragma unroll
          for (int e = 0; e < 4; ++e) (which ? LAf : LWf)[(16 * tm + 4 * q4 + e) * 65 + 16 * tn + r16] = acc[e]; } }
    if (dir == 0) { const int tm = wid >> 1;
#pragma unroll
        for (int j = 0; j < 2; ++j) { const int tn = (wid & 1) * 2 + j; f32x4 acc = (f32x4){0.f, 0.f, 0.f, 0.f};
#pragma unroll
            for (int k0 = 0; k0 < 96; k0 += 32) { const bf16x8 a = *(const LAS bf16x8*)(SG + (16 * tm + r16) * 104 + k0 + q4 * 8);
                const bf16x8 bb = *(const bf16x8*)(sw.G2T + (size_t)(h * 64 + 16 * tn + r16) * 96 + k0 + q4 * 8); acc = MFMA16(a, bb, acc); }
#pragma unroll
            for (int e = 0; e < 4; ++e) GATE[(size_t)row_of(b, 0, ci, 16 * tm + 4 * q4 + e) * 512 + h * 64 + 16 * tn + r16] = acc[e]; } }
    LDS_BARRIER();
#ifdef DUP_ST01
    }
#endif
    float av[8], bv[8], kd[8], lw[8];
#ifdef S1DBG
    float dbgv[8];
#endif
#ifdef DUP_ST2A
    for (int rp_ = 0; rp_ < 2; ++rp_) {
#endif
    { const int hc = h * 64 + sub * 8; float ss = 0.f, bon = 0.f, kk[8], al[8];
#pragma unroll
      for (int e = 0; e < 8; ++e) { const int c = sub * 8 + e;
          const float wl = -softplusf_(-(WF[c] + LWf[i * 65 + c])) - 0.5f; lw[e] = -__expf(wl);
          al[e] = sigmoidf_(WF[64 + c] + LAf[i * 65 + c]);
          kk[e] = kv[e] * WF[128 + c]; ss += kk[e] * kk[e]; }
      ss += sx<1>(ss); ss += sx<2>(ss); ss += sx<4>(ss);
      const float rn = rsqrtf(ss + 1e-12f);
#pragma unroll
      for (int e = 0; e < 8; ++e) { kk[e] *= rn; kd[e] = kv[e] * (1.f + (al[e] - 1.f) * WF[192 + sub * 8 + e]); av[e] = -kk[e]; bv[e] = kk[e] * al[e]; bon += rv[e] * kd[e] * WF[256 + sub * 8 + e];
#ifdef S1DBG
          dbgv[e] = (S1DBG == 1) ? al[e] : kk[e];
#endif
      }
      bon += sx<1>(bon); bon += sx<2>(bon); bon += sx<4>(bon);
      if (sub == 0) BONUSd[(size_t)R * 8 + h] = bon;
#pragma unroll
      for (int e = 0; e < 8; ++e) GC[i * 64 + sub * 8 + e] = lw[e]; }
    LDS_BARRIER();
#ifdef DUP_ST2A
    }
#endif
    {
        LAS float* TOT = INVS;
        float g8[8]; float run = 0.f;
#pragma unroll
        for (int j = 0; j < 8; ++j) g8[j] = GC[(wid * 8 + j) * 64 + lane];
#pragma unroll
        for (int j = 0; j < 8; ++j) { run += g8[j]; g8[j] = run; }
        TOT[wid * 64 + lane] = run;
        LDS_BARRIER();
        float off = 0.f;
#pragma unroll
        for (int sgm = 0; sgm < 7; ++sgm) { const float tv = TOT[sgm * 64 + lane]; off += (sgm < wid) ? tv : 0.f; }
#pragma unroll
        for (int j = 0; j < 8; ++j) GC[(wid * 8 + j) * 64 + lane] = g8[j] + off;
    }
    LDS_BARRIER();
#ifdef DUP_ST2C
    for (int rp_ = 0; rp_ < 2; ++rp_) {
#endif
    { float at[8], bt[8], kt[8], qt[8], bh[8], kh[8];
#pragma unroll
      for (int e = 0; e < 8; ++e) { const int c = sub * 8 + e; const float Gi = GC[i * 64 + c], Gm = (i > 0) ? GC[(i - 1) * 64 + c] : 0.f, GL = GC[63 * 64 + c];
          const float eG = __expf(Gi), eGm = __expf(Gm), enG = __expf(-Gi), eLG = __expf(GL - Gi);
          at[e] = av[e] * eGm; bt[e] = bv[e] * enG; kt[e] = kd[e] * enG; qt[e] = rv[e] * eG;
#ifdef S1DBG
          qt[e] = dbgv[e];
#endif
          bh[e] = bv[e] * eLG; kh[e] = kd[e] * eLG;
          if (i == 63) ((float*)(task + 32768))[c] = eG; }
      *(LAS u32x4*)(AT + i * 72 + sub * 8) = pack8f(at); *(LAS u32x4*)(BT + i * 72 + sub * 8) = pack8f(bt); *(LAS u32x4*)(KT + i * 72 + sub * 8) = pack8f(kt); *(LAS u32x4*)(QT + i * 72 + sub * 8) = pack8f(qt);
#pragma unroll
      for (int e = 0; e < 8; ++e) { const int c = sub * 8 + e; ATT[c * 72 + i] = f2bf(at[e]); VT[c * 72 + i] = f2bf(vv[e]); KHT[c * 72 + i] = f2bf(kh[e]); BHT[c * 72 + i] = f2bf(bh[e]); } }
    LDS_BARRIER();
#ifdef DUP_ST2C
    }
#endif
#ifdef DUP_ST3
    for (int rp_ = 0; rp_ < 2; ++rp_) {
#endif
    RwRaw warm; rw_issue(warm, P, nb, h, dir, nci, tid);
    for (int z_ = tid; z_ < 64 * 72 / 8; z_ += 512) ((LAS u32x4*)TT)[z_] = (u32x4){0u, 0u, 0u, 0u};
    { const int mat = wid >> 1;
      const LAS bf16* Am = (mat < 2) ? AT : QT; const LAS bf16* Bm = (mat == 0 || mat == 2) ? BT : KT;
#pragma unroll 4
      for (int j = 0; j < 8; ++j) { const int idx = (wid & 1) * 8 + j, tm = idx >> 2, tn = idx & 3;
          f32x4 acc = (f32x4){0.f, 0.f, 0.f, 0.f};
          if (tm >= tn) acc = mm_tile<64>(Am, 72, Bm, 72, tm, tn, acc, lane);
#pragma unroll
          for (int e = 0; e < 4; ++e) { const int ti = 16 * tm + 4 * q4 + e, tj = 16 * tn + r16; const bool keep = (mat < 2) ? (ti > tj) : (ti >= tj); const float v = keep ? acc[e] : 0.f;
              if (mat == 0) AAB[ti * 65 + tj] = v; else if (mat == 1) AAK[ti * 72 + tj] = f2bf(v); else if (mat == 3) AQK[ti * 72 + tj] = f2bf(v); else AQBL[ti * 72 + tj] = f2bf(v); } } }
    LDS_BARRIER();
#ifdef DUP_ST3
    }
#endif
    inv_blocked(AAB, TF, TT, INVS, wid, lane, tid, [&](int sw_) {
#pragma unroll
        for (int j = 0; j < 4; ++j) { const int tm = sw_, tn = j;
            const f32x4 acc = mm_tile<64>(AAK, 72, VT, 72, tm, tn, (f32x4){0.f, 0.f, 0.f, 0.f}, lane);
            u32x2 o; o.x = pk2(acc[0], acc[1]); o.y = pk2(acc[2], acc[3]); *(LAS u32x2*)(XT + (16 * tn + r16) * 72 + 16 * tm + 4 * q4) = o; } });
#ifdef DUP_ST6
    for (int rp_ = 0; rp_ < 2; ++rp_) {
#endif
    { const int mat = wid >> 2, tm = wid & 3; LAS bf16* dst = mat ? ULT : WTT;
#pragma unroll 4
      for (int tn = 0; tn < 4; ++tn) { const f32x4 acc = mm_tile<64>(TT, 72, mat ? XT : ATT, 72, tm, tn, (f32x4){0.f, 0.f, 0.f, 0.f}, lane);
          u32x2 o; o.x = pk2(acc[0], acc[1]); o.y = pk2(acc[2], acc[3]); *(LAS u32x2*)(dst + (16 * tn + r16) * 72 + 16 * tm + 4 * q4) = o; } }
    LDS_BARRIER();
    {
#define FRAG(Mx, row, k) (*(const LAS bf16x8*)((Mx) + (row) * 72 + (k) * 32 + q4 * 8))
      const int tm = wid >> 1;
      const bf16x8 w0 = FRAG(WTT, 16 * tm + r16, 0), w1 = FRAG(WTT, 16 * tm + r16, 1), h0 = FRAG(BHT, 16 * tm + r16, 0), h1 = FRAG(BHT, 16 * tm + r16, 1);
      const bf16x8 k0 = FRAG(KHT, 16 * tm + r16, 0), k1 = FRAG(KHT, 16 * tm + r16, 1), a0 = FRAG(AQBL, 16 * tm + r16, 0), a1 = FRAG(AQBL, 16 * tm + r16, 1), g0 = FRAG(AQK, 16 * tm + r16, 0), g1 = FRAG(AQK, 16 * tm + r16, 1);
#pragma unroll
      for (int j = 0; j < 2; ++j) { const int tn = (wid & 1) * 2 + j; const f32x4 z = (f32x4){0.f, 0.f, 0.f, 0.f};
          { f32x4 acc = MFMA16(w0, FRAG(BHT, 16 * tn + r16, 0), z); acc = MFMA16(w1, FRAG(BHT, 16 * tn + r16, 1), acc);
            u32x2 o; o.x = pk2(acc[0], acc[1]); o.y = pk2(acc[2], acc[3]); *(u32x2*)(task + 0 + FRAGOFF(16 * tn + r16, 16 * tm + 4 * q4, 2)) = o; }
          { f32x4 acc = MFMA16(w0, FRAG(AQBL, 16 * tn + r16, 0), z); acc = MFMA16(w1, FRAG(AQBL, 16 * tn + r16, 1), acc);
            const u32x2 qq = *(const LAS u32x2*)(QT + (16 * tn + r16) * 72 + 16 * tm + 4 * q4);
            u32x2 o; o.x = pk2(acc[0] + bflo(qq.x), acc[1] + bfhi(qq.x)); o.y = pk2(acc[2] + bflo(qq.y), acc[3] + bfhi(qq.y)); *(u32x2*)(task + 8192 + FRAGOFF(16 * tn + r16, 16 * tm + 4 * q4, 2)) = o; }
          { f32x4 acc = MFMA16(h0, FRAG(ULT, 16 * tn + r16, 0), z); acc = MFMA16(h1, FRAG(ULT, 16 * tn + r16, 1), acc);
            acc = MFMA16(k0, FRAG(VT, 16 * tn + r16, 0), acc); acc = MFMA16(k1, FRAG(VT, 16 * tn + r16, 1), acc);
            u32x2 o; o.x = pk2(acc[0], acc[1]); o.y = pk2(acc[2], acc[3]); *(u32x2*)(task + 16384 + ((tm * 2 + (tn >> 1)) * 64 + lane) * 16 + (tn & 1) * 8) = o; }
          { f32x4 acc = MFMA16(a0, FRAG(ULT, 16 * tn + r16, 0), z); acc = MFMA16(a1, FRAG(ULT, 16 * tn + r16, 1), acc);
            acc = MFMA16(g0, FRAG(VT, 16 * tn + r16, 0), acc); acc = MFMA16(g1, FRAG(VT, 16 * tn + r16, 1), acc);
            u32x2 o; o.x = pk2(acc[0], acc[1]); o.y = pk2(acc[2], acc[3]); *(u32x2*)(task + 24576 + ((tm * 2 + (tn >> 1)) * 64 + lane) * 16 + (tn & 1) * 8) = o; } }
#undef FRAG
    }
    LDS_BARRIER();
    chk ^= warm.c[0].x ^ warm.c[1].x ^ warm.c[2].x;
#ifdef DUP_ST6
    }
#endif
}

DI void s1_gdn(LAS uchar* lds, const bf16* P, const ScanW& sw, uchar* task, int b, int h, int dir, int ci, int tid) {
    using namespace cf;
    LAS bf16* KL = (LAS bf16*)(lds + 0); LAS bf16* QL = (LAS bf16*)(lds + 17408);
    LAS bf16* VT = (LAS bf16*)(lds + 34816); LAS bf16* KBT = (LAS bf16*)(lds + 53248); LAS bf16* BHT = (LAS bf16*)(lds + 71680);
    LAS bf16* TT = (LAS bf16*)(lds + 90112); LAS float* AAB = (LAS float*)(lds + 99328); LAS float* TF = (LAS float*)(lds + 115968);
    LAS float* INVS = (LAS float*)(lds + 132608); LAS float* gvec = (LAS float*)(lds + 141312); LAS bf16* AQBL = (LAS bf16*)(lds + 151552);
    const int lane = tid & 63, wid = __builtin_amdgcn_readfirstlane(tid >> 6), i = tid >> 3, sub = tid & 7, r16 = lane & 15, q4 = lane >> 4;
    const int R = row_of(b, dir, ci, i), seg_lo = b * SEGT + (ci < 4 ? 0 : CTX), seg_hi = b * SEGT + (ci < 4 ? CTX : SEGT);
    const bf16* pr = P + (size_t)R * PC + C_GD;
    float qv[16], kv[16], vv[16];
#pragma unroll
    for (int w = 0; w < 3; ++w) { const int col = w * 512 + h * 128 + sub * 16; float acc[16];
#pragma unroll
        for (int e = 0; e < 16; ++e) acc[e] = 0.f;
#pragma unroll
        for (int j = 0; j < 5; ++j) { const int Rj = R + j - 2;
            if (Rj >= seg_lo && Rj < seg_hi) { float x[16]; float xa[8], xb[8];
                unpack8(*(const u32x4*)(pr + (ptrdiff_t)(j - 2) * PC + col), xa); unpack8(*(const u32x4*)(pr + (ptrdiff_t)(j - 2) * PC + col + 8), xb);
#pragma unroll
                for (int e = 0; e < 8; ++e) { x[e] = xa[e]; x[8 + e] = xb[e]; }
                const LAS float* cw = (const LAS float*)(lds + GDB) + (j * 3 + w) * 128 + sub * 16;
#pragma unroll
                for (int e4 = 0; e4 < 4; ++e4) { const f32x4 c4 = *(const LAS f32x4*)(cw + 4 * e4);
#pragma unroll
                    for (int e = 0; e < 4; ++e) acc[4 * e4 + e] += c4[e] * x[4 * e4 + e]; } } }
#pragma unroll
        for (int e = 0; e < 16; ++e) { const float x = acc[e] * sigmoidf_(acc[e]); if (w == 0) qv[e] = x; else if (w == 1) kv[e] = x; else vv[e] = x; } }
    { float sq = 0.f, sk = 0.f;
#pragma unroll
      for (int e = 0; e < 16; ++e) { sq += qv[e] * qv[e]; sk += kv[e] * kv[e]; }
      sq += sx<1>(sq); sq += sx<2>(sq); sq += sx<4>(sq); sk += sx<1>(sk); sk += sx<2>(sk); sk += sx<4>(sk);
      const float rq = rsqrtf(sq + 1e-12f) * 0.08838834764831845f, rk = rsqrtf(sk + 1e-12f);
#pragma unroll
      for (int e = 0; e < 16; ++e) { qv[e] *= rq; kv[e] *= rk; } }
    if (sub == 0) { const float a_raw = bf2f(pr[GD_A + dir * 4 + h]), b_raw = bf2f(pr[GD_B + dir * 4 + h]);
        gvec[i] = -__expf(sw.a_log[dir * 4 + h]) * softplusf_(a_raw + sw.dt_bias[dir * 4 + h]); gvec[64 + i] = sigmoidf_(b_raw); }
    { float t0[8], t1[8];
#pragma unroll
      for (int e = 0; e < 8; ++e) { t0[e] = kv[e]; t1[e] = kv[8 + e]; }
      *(LAS u32x4*)(KL + i * 136 + sub * 16) = pack8f(t0); *(LAS u32x4*)(KL + i * 136 + sub * 16 + 8) = pack8f(t1);
#pragma unroll
      for (int e = 0; e < 8; ++e) { t0[e] = qv[e]; t1[e] = qv[8 + e]; }
      *(LAS u32x4*)(QL + i * 136 + sub * 16) = pack8f(t0); *(LAS u32x4*)(QL + i * 136 + sub * 16 + 8) = pack8f(t1); }
    LDS_BARRIER();
    if (wid == 0) { float g = 0.f;
#pragma unroll 8
        for (int t = 0; t < 64; ++t) { const float x = gvec[t]; g += (t <= lane) ? x : 0.f; }
        gvec[128 + lane] = g; }
    LDS_BARRIER();
    for (int z_ = tid; z_ < 64 * 72 / 8; z_ += 512) ((LAS u32x4*)TT)[z_] = (u32x4){0u, 0u, 0u, 0u};
    { const float Gi = gvec[128 + i], GL = gvec[128 + 63], be = gvec[64 + i], eG = __expf(Gi), eLG = __expf(GL - Gi), beG = be * eG;
#pragma unroll
      for (int e = 0; e < 16; ++e) { const int c = sub * 16 + e; VT[c * 72 + i] = f2bf(be * vv[e]); KBT[c * 72 + i] = f2bf(beG * kv[e]); BHT[c * 72 + i] = f2bf(kv[e] * eLG); }
      if (tid < 128) ((float*)(task + 98304))[tid] = __expf(GL); }
#pragma unroll 4
    for (int j = 0; j < 4; ++j) { const int idx = wid * 4 + j, mat = idx >> 4, tm = (idx >> 2) & 3, tn = idx & 3;
        f32x4 acc = (f32x4){0.f, 0.f, 0.f, 0.f};
        if (tm >= tn) acc = mm_tile<128>(mat ? QL : KL, 136, KL, 136, tm, tn, acc, lane);
        const float Gj = gvec[128 + 16 * tn + r16];
#pragma unroll
        for (int e = 0; e < 4; ++e) { const int ti = 16 * tm + 4 * q4 + e, tj = 16 * tn + r16; const float dec = __expf(fminf(gvec[128 + ti] - Gj, 0.f));
            if (mat == 0) AAB[ti * 65 + tj] = (ti > tj) ? -gvec[64 + ti] * acc[e] * dec : 0.f;
            else AQBL[ti * 72 + tj] = f2bf((ti >= tj) ? acc[e] * dec : 0.f); } }
    LDS_BARRIER();
    inv_blocked(AAB, TF, TT, INVS, wid, lane, tid, [](int) {});
    { const int mat = wid >> 2, tm = wid & 3; f32x4 zt[8];
#pragma unroll
      for (int tn = 0; tn < 8; ++tn) zt[tn] = mm_tile<64>(TT, 72, mat ? KBT : VT, 72, tm, tn, (f32x4){0.f, 0.f, 0.f, 0.f}, lane);
      LDS_BARRIER();
      LAS bf16* dst = mat ? KBT : VT; const float sg = mat ? -1.f : 1.f;
#pragma unroll
      for (int tn = 0; tn < 8; ++tn) { u32x2 o; o.x = pk2(sg * zt[tn][0], sg * zt[tn][1]); o.y = pk2(sg * zt[tn][2], sg * zt[tn][3]); *(LAS u32x2*)(dst + (16 * tn + r16) * 72 + 16 * tm + 4 * q4) = o; } }
    LDS_BARRIER();
    { const LAS bf16* WTT = KBT; const LAS bf16* ULT = VT;
#define FRAG(Mx, row, k) (*(const LAS bf16x8*)((Mx) + (row) * 72 + (k) * 32 + q4 * 8))
      const bf16x8 w0 = FRAG(WTT, 16 * wid + r16, 0), w1 = FRAG(WTT, 16 * wid + r16, 1);
      const bf16x8 h0 = FRAG(BHT, 16 * wid + r16, 0), h1 = FRAG(BHT, 16 * wid + r16, 1);
#pragma unroll
      for (int tn = 0; tn < 8; ++tn) {
          f32x4 acc = MFMA16(w0, FRAG(BHT, 16 * tn + r16, 0), ((f32x4){0.f, 0.f, 0.f, 0.f})); acc = MFMA16(w1, FRAG(BHT, 16 * tn + r16, 1), acc);
          u32x2 o; o.x = pk2(acc[0], acc[1]); o.y = pk2(acc[2], acc[3]); *(u32x2*)(task + 0 + FRAGOFF(16 * tn + r16, 16 * wid + 4 * q4, 4)) = o; }
#pragma unroll
      for (int tn = 0; tn < 8; ++tn) {
          f32x4 acc = MFMA16(h0, FRAG(ULT, 16 * tn + r16, 0), ((f32x4){0.f, 0.f, 0.f, 0.f})); acc = MFMA16(h1, FRAG(ULT, 16 * tn + r16, 1), acc);
          u32x2 o; o.x = pk2(acc[0], acc[1]); o.y = pk2(acc[2], acc[3]); *(u32x2*)(task + 49152 + ((wid * 4 + (tn >> 1)) * 64 + lane) * 16 + (tn & 1) * 8) = o; }
#pragma unroll
      for (int tn = 0; tn < 4; ++tn) {
          f32x4 acc = MFMA16(w0, FRAG(AQBL, 16 * tn + r16, 0), ((f32x4){0.f, 0.f, 0.f, 0.f})); acc = MFMA16(w1, FRAG(AQBL, 16 * tn + r16, 1), acc);
          const int t = 16 * tn + r16; const float eG = __expf(gvec[128 + t]); const u32x2 qq = *(const LAS u32x2*)(QL + t * 136 + 16 * wid + 4 * q4);
          u32x2 o; o.x = pk2(acc[0] + eG * bflo(qq.x), acc[1] + eG * bfhi(qq.x)); o.y = pk2(acc[2] + eG * bflo(qq.y), acc[3] + eG * bfhi(qq.y)); *(u32x2*)(task + 32768 + FRAGOFF(t, 16 * wid + 4 * q4, 4)) = o; }
      { const int tm = wid >> 1; const bf16x8 a0 = FRAG(AQBL, 16 * tm + r16, 0), a1 = FRAG(AQBL, 16 * tm + r16, 1);
#pragma unroll
        for (int j = 0; j < 4; ++j) { const int tn = (wid & 1) * 4 + j;
            f32x4 acc = MFMA16(a0, FRAG(ULT, 16 * tn + r16, 0), ((f32x4){0.f, 0.f, 0.f, 0.f})); acc = MFMA16(a1, FRAG(ULT, 16 * tn + r16, 1), acc);
            u32x2 o; o.x = pk2(acc[0], acc[1]); o.y = pk2(acc[2], acc[3]); *(u32x2*)(task + 81920 + ((tm * 4 + (tn >> 1)) * 64 + lane) * 16 + (tn & 1) * 8) = o; } }
#undef FRAG
    }
    LDS_BARRIER();
}

template <int NK, bool LOC> struct S2FA { bf16x8 wt[NK / 32]; u32x4 ul; };
template <int NK, bool LOC> struct S2FB { bf16x8 qt[NK / 32], aqb[2], bht[2]; u32x4 yl, kl; f32x4 gl; float gls; };
template <int NK, bool LOC>
DI void s2_load_a(S2FA<NK, LOC>& f, const uchar* task, int o_wt, int o_ul, int ulh, int tm, int lane) {
    const int r16 = lane & 15, q4 = lane >> 4;
#pragma unroll
    for (int k = 0; k < NK / 32; ++k) f.wt[k] = *(const bf16x8*)(task + o_wt + ((size_t)(16 * tm + r16) * NK + k * 32 + q4 * 8) * 2);
    f.ul = *(const u32x4*)(task + o_ul + (size_t)(ulh * 64 + lane) * 16);
}
template <int NK, bool LOC>
DI void s2_load_b(S2FB<NK, LOC>& f, const uchar* task, int o_qt, int o_aqb, int o_bht, int o_yl, int ulh, int o_kl, int o_gl, int tm, int cm, int ch, int lane) {
    const int r16 = lane & 15, q4 = lane >> 4;
#pragma unroll
    for (int k = 0; k < NK / 32; ++k) f.qt[k] = *(const bf16x8*)(task + o_qt + ((size_t)(16 * tm + r16) * NK + k * 32 + q4 * 8) * 2);
    if (LOC) f.yl = *(const u32x4*)(task + o_yl + (size_t)(ulh * 64 + lane) * 16);
#pragma unroll
    for (int k = 0; k < 2; ++k) { f.aqb[k] = *(const bf16x8*)(task + o_aqb + ((size_t)(16 * tm + r16) * 64 + k * 32 + q4 * 8) * 2); f.bht[k] = *(const bf16x8*)(task + o_bht + ((size_t)(16 * cm + r16) * 64 + k * 32 + q4 * 8) * 2); }
    if (LOC) f.kl = *(const u32x4*)(task + o_kl + (size_t)((cm * 2 + ch) * 64 + lane) * 16);
    if (LOC) f.gl = *(const f32x4*)(task + o_gl + (size_t)(16 * cm + 4 * q4) * 4); else f.gls = *(const float*)(task + o_gl);
}
template <int NK, bool LOC>
DI void s2_step(const S2FA<NK, LOC>& fa, const S2FB<NK, LOC>& fb, f32x4 (&H)[NK / 32], const LAS bf16* Hc, LAS bf16* Hn, LAS bf16* UT, float* Y, int ycol0, int b, int dir, int ci, int tm, int tn0, int cm, int ctn0, int lane) {
    constexpr int NH = NK / 32, LDH = NK + 8;
    const int r16 = lane & 15, q4 = lane >> 4;
    f32x4 U[2], Yv[2];
    U[0] = (f32x4){bflo(fa.ul.x), bfhi(fa.ul.x), bflo(fa.ul.y), bfhi(fa.ul.y)}; U[1] = (f32x4){bflo(fa.ul.z), bfhi(fa.ul.z), bflo(fa.ul.w), bfhi(fa.ul.w)};
#pragma unroll
    for (int j = 0; j < 2; ++j) {
#pragma unroll
        for (int k = 0; k < NK / 32; ++k) { const bf16x8 hb = *(const LAS bf16x8*)(Hc + (16 * (tn0 + j) + r16) * LDH + k * 32 + q4 * 8); U[j] = MFMA16(fa.wt[k], hb, U[j]); }
        u32x2 o; o.x = pk2(U[j][0], U[j][1]); o.y = pk2(U[j][2], U[j][3]);
        *(LAS u32x2*)(UT + (16 * (tn0 + j) + r16) * 72 + 16 * tm + 4 * q4) = o;
    }
    LDS_BARRIER();
    if (LOC) { Yv[0] = (f32x4){bflo(fb.yl.x), bfhi(fb.yl.x), bflo(fb.yl.y), bfhi(fb.yl.y)}; Yv[1] = (f32x4){bflo(fb.yl.z), bfhi(fb.yl.z), bflo(fb.yl.w), bfhi(fb.yl.w)}; }
    else { Yv[0] = (f32x4){0.f, 0.f, 0.f, 0.f}; Yv[1] = Yv[0]; }
#pragma unroll
    for (int j = 0; j < 2; ++j) {
#pragma unroll
        for (int k = 0; k < NK / 32; ++k) { const bf16x8 hb = *(const LAS bf16x8*)(Hc + (16 * (tn0 + j) + r16) * LDH + k * 32 + q4 * 8); Yv[j] = MFMA16(fb.qt[k], hb, Yv[j]); }
#pragma unroll
        for (int k = 0; k < 2; ++k) { const bf16x8 ub = *(const LAS bf16x8*)(UT + (16 * (tn0 + j) + r16) * 72 + k * 32 + q4 * 8); Yv[j] = MFMA16(fb.aqb[k], ub, Yv[j]); }
#pragma unroll
        for (int e = 0; e < 4; ++e) Y[(size_t)row_of(b, dir, ci, 16 * tm + 4 * q4 + e) * 512 + ycol0 + 16 * (tn0 + j) + r16] = Yv[j][e];
    }
#pragma unroll
    for (int j = 0; j < NH; ++j) {
        f32x4 h = LOC ? H[j] * fb.gl : H[j] * fb.gls;
        if (LOC) { if (j == 0) h += (f32x4){bflo(fb.kl.x), bfhi(fb.kl.x), bflo(fb.kl.y), bfhi(fb.kl.y)}; else h += (f32x4){bflo(fb.kl.z), bfhi(fb.kl.z), bflo(fb.kl.w), bfhi(fb.kl.w)}; }
#pragma unroll
        for (int k = 0; k < 2; ++k) { const bf16x8 ub = *(const LAS bf16x8*)(UT + (16 * (ctn0 + j) + r16) * 72 + k * 32 + q4 * 8); h = MFMA16(fb.bht[k], ub, h); }
        H[j] = h;
        u32x2 o; o.x = pk2(h[0], h[1]); o.y = pk2(h[2], h[3]);
        *(LAS u32x2*)(Hn + (16 * (ctn0 + j) + r16) * LDH + 16 * cm + 4 * q4) = o;
    }
    LDS_BARRIER();
}
template <int NK, bool LOC>
DI void s2_scan(LAS uchar* lds, const uchar* task0, int task_bytes, int o_wt, int o_qt, int o_aqb, int o_bht, int o_ul, int ulq, int o_yl, int o_kl, int o_gl,
                float* Y, int ycol0, int b, int dir, int tid) {
    constexpr int NH = NK / 32, LDH = NK + 8;
    LAS bf16* HT = (LAS bf16*)lds;
    LAS bf16* UT = (LAS bf16*)(lds + 2 * 64 * LDH * 2);
    const int lane = tid & 63, wid = tid >> 6;
    const int tm = wid >> 1, tn0 = (wid & 1) * 2;
    const int cm = (NK == 64) ? (wid >> 1) : wid, ctn0 = (NK == 64) ? (wid & 1) * 2 : 0;
    const int ulh = tm * ulq + (wid & 1);
    for (int i = tid; i < 64 * LDH * 2 / 16; i += 512) ((LAS u32x4*)HT)[i] = (u32x4){0u, 0u, 0u, 0u};
    f32x4 H[NH];
#pragma unroll
    for (int j = 0; j < NH; ++j) H[j] = (f32x4){0.f, 0.f, 0.f, 0.f};
    S2FA<NK, LOC> a0, a1, a2; S2FB<NK, LOC> b0, b1, b2;
#define TASKP(c) (task0 + (size_t)((c) < cf::NCH ? (c) : cf::NCH - 1) * task_bytes)
#define LDA(f, c) s2_load_a<NK, LOC>(f, TASKP(c), o_wt, o_ul, ulh, tm, lane)
#define LDB(f, c) s2_load_b<NK, LOC>(f, TASKP(c), o_qt, o_aqb, o_bht, o_yl, ulh, o_kl, o_gl, tm, cm, (wid & 1), lane)
#define STP(fa, fb, c) s2_step<NK, LOC>(fa, fb, H, HT + ((c) & 1) * 64 * LDH, HT + (((c) + 1) & 1) * 64 * LDH, UT, Y, ycol0, b, dir, (c), tm, tn0, cm, ctn0, lane)
    LDA(a0, 0); LDB(b0, 0); LDA(a1, 1); LDB(b1, 1);
    LDS_BARRIER();
#pragma unroll 2
    for (int ci = 0; ci < cf::NCH; ++ci) {
        LDA(a2, ci + 2); LDB(b2, ci + 2); STP(a0, b0, ci);
        a0 = a1; a1 = a2; b0 = b1; b1 = b2;
    }
#undef TASKP
#undef LDA
#undef LDB
#undef STP
}

template <int NK, bool VECG> struct S2N { bf16x8 m[NK / 32], q[NK / 32]; u32x4 n[NK / 64], y; f32x4 gl; float gls; };
template <int NK, bool VECG>
DI void s2n_load(S2N<NK, VECG>& f, const uchar* task, int o_m, int o_q, int o_n, int o_y, int o_gl, int tm, int cm, int nh0, int yh, int lane) {
    const int r16 = lane & 15, q4 = lane >> 4;
#pragma unroll
    for (int k = 0; k < NK / 32; ++k) { f.m[k] = *(const bf16x8*)(task + o_m + (size_t)((cm * (NK / 32) + k) * 64 + lane) * 16); f.q[k] = *(const bf16x8*)(task + o_q + (size_t)((tm * (NK / 32) + k) * 64 + lane) * 16); }
#pragma unroll
    for (int j = 0; j < NK / 64; ++j) f.n[j] = *(const u32x4*)(task + o_n + (size_t)((nh0 + j) * 64 + lane) * 16);
    f.y = *(const u32x4*)(task + o_y + (size_t)(yh * 64 + lane) * 16);
    if (VECG) f.gl = *(const f32x4*)(task + o_gl + (size_t)(16 * cm + 4 * q4) * 4); else f.gls = *(const float*)(task + o_gl);
}
template <int NK, bool VECG>
DI void s2n_step(const S2N<NK, VECG>& f, f32x4 (&H)[NK / 32], const LAS bf16* Hc, LAS bf16* Hn, LAS float* YS, float* Y, int ycol0, int b, int dir, int ci, int tm, int tn0, int cm, int ctn0, int wid, int lane) {
    constexpr int NH = NK / 32, LDH = NK + 8;
    const int r16 = lane & 15, q4 = lane >> 4;
#pragma unroll
    for (int j = 0; j < NH; ++j) {
        const u32x4 nn = f.n[j >> 1];
        f32x4 h = VECG ? H[j] * f.gl : H[j] * f.gls;
        h += (j & 1) ? (f32x4){bflo(nn.z), bfhi(nn.z), bflo(nn.w), bfhi(nn.w)} : (f32x4){bflo(nn.x), bfhi(nn.x), bflo(nn.y), bfhi(nn.y)};
#pragma unroll
        for (int k = 0; k < NK / 32; ++k) { const bf16x8 hb = *(const LAS bf16x8*)(Hc + (16 * (ctn0 + j) + r16) * LDH + k * 32 + q4 * 8); h = MFMA16(f.m[k], hb, h); }
        H[j] = h;
        u32x2 o; o.x = pk2(h[0], h[1]); o.y = pk2(h[2], h[3]);
        *(LAS u32x2*)(Hn + (16 * (ctn0 + j) + r16) * LDH + 16 * cm + 4 * q4) = o;
    }
#pragma unroll
    for (int j = 0; j < 2; ++j) {
        f32x4 yv = j ? (f32x4){bflo(f.y.z), bfhi(f.y.z), bflo(f.y.w), bfhi(f.y.w)} : (f32x4){bflo(f.y.x), bfhi(f.y.x), bflo(f.y.y), bfhi(f.y.y)};
#pragma unroll
        for (int k = 0; k < NK / 32; ++k) { const bf16x8 hb = *(const LAS bf16x8*)(Hc + (16 * (tn0 + j) + r16) * LDH + k * 32 + q4 * 8); yv = MFMA16(f.q[k], hb, yv); }
#pragma unroll
        for (int e = 0; e < 4; ++e) YS[(16 * tm + 4 * q4 + e) * 65 + 16 * (tn0 + j) + r16] = yv[e];
    }
    LDS_BARRIER();
#pragma unroll
    for (int e = 0; e < 8; ++e) { const int t = 8 * wid + e;
        Y[(size_t)row_of(b, dir, ci, t) * 512 + ycol0 + lane] = YS[t * 65 + lane]; }
}
template <int NK, bool VECG>
DI void s2n_scan(LAS uchar* lds, const uchar* task0, int task_bytes, int o_m, int o_q, int o_n, int o_y, int o_gl, int nq, int vs, float* Y, int ycol0, int b, int dir, int tid) {
    constexpr int NH = NK / 32, LDH = NK + 8;
    LAS bf16* HT = (LAS bf16*)lds;
    LAS float* YSB = (LAS float*)(lds + 2 * 64 * LDH * 2);
    const int lane = tid & 63, wid = __builtin_amdgcn_readfirstlane(tid >> 6);
    const int tm = wid >> 1, tn0 = (wid & 1) * 2;
    const int cm = (NK == 64) ? (wid >> 1) : wid, ctn0 = (NK == 64) ? (wid & 1) * 2 : 0;
    const int nh0 = (NK == 64) ? (cm * nq + (wid & 1)) : (cm * nq + vs * 2), yh = tm * nq + vs * 2 + (wid & 1);
    for (int i = tid; i < 64 * LDH * 2 / 16; i += 512) ((LAS u32x4*)HT)[i] = (u32x4){0u, 0u, 0u, 0u};
    f32x4 H[NH];
#pragma unroll
    for (int j = 0; j < NH; ++j) H[j] = (f32x4){0.f, 0.f, 0.f, 0.f};
#define TP(c) (task0 + (size_t)((c) < cf::NCH ? (c) : cf::NCH - 1) * task_bytes)
#define LD(f, c) s2n_load<NK, VECG>(f, TP(c), o_m, o_q, o_n, o_y, o_gl, tm, cm, nh0, yh, lane)
#define ST(f, c) s2n_step<NK, VECG>(f, H, HT + ((c) & 1) * 64 * LDH, HT + (((c) + 1) & 1) * 64 * LDH, YSB + ((c) & 1) * 64 * 65, Y, ycol0, b, dir, (c), tm, tn0, cm, ctn0, wid, lane)
    if constexpr (NK == 64) {
        S2N<NK, VECG> f0, f1, f2, f3;
        LD(f0, 0); LD(f1, 1); LD(f2, 2);
        LDS_BARRIER();
#pragma unroll 1
        for (int ci = 0; ci < cf::NCH; ci += 4) {
            LD(f3, ci + 3); ST(f0, ci);
            LD(f0, ci + 4); ST(f1, ci + 1);
            LD(f1, ci + 5); ST(f2, ci + 2);
            LD(f2, ci + 6); ST(f3, ci + 3);
        }
    } else {
        S2N<NK, VECG> f0, f1, f2;
        LD(f0, 0); LD(f1, 1);
        LDS_BARRIER();
#pragma unroll 1
        for (int ci = 0; ci + 2 < cf::NCH; ci += 3) {
            LD(f2, ci + 2); ST(f0, ci);
            LD(f0, ci + 3); ST(f1, ci + 1);
            LD(f1, ci + 4); ST(f2, ci + 2);
        }
        ST(f0, cf::NCH - 2); ST(f1, cf::NCH - 1);
    }
#undef TP
#undef LD
#undef ST
}
namespace at {
constexpr int DQ = 192, DV = 128, NW = 8, QBLK = 32, KVBLK = 64;
constexpr float SCALE = 0.07216878364870322f;
constexpr float THR = 8.f;
constexpr int SHM_V = KVBLK * DV * 2, SHM_K = KVBLK * DQ * 2, SHM_Q = NW * 8 * 1024, SHM_ATTN = 2 * SHM_V + 2 * SHM_K + NW * 64 * 4 + SHM_Q;
#define KSWZ(row, colB) ((row) * 384 + ((colB) ^ (((row) & 7) << 4)))
#define SBAR() __builtin_amdgcn_sched_barrier(0)
DI int crow(int r, int hi) { return (r & 3) + 8 * (r >> 2) + 4 * hi; }
DI unsigned cvtpk(float lo, float hi) { const f32x2 v = {lo, hi}; return __builtin_bit_cast(unsigned, __builtin_convertvector(v, bf16x2_t)); }
DI void partialSM(f32x16& p0, f32x16& p1, float& m_reg, float& mn, float& alpha) {
  constexpr float C = SCALE * 1.4426950408889634f;
  float pmax = p0[0];
#pragma unroll
  for (int r = 1; r < 16; ++r) pmax = fmaxf(pmax, p0[r]);
#pragma unroll
  for (int r = 0; r < 16; ++r) pmax = fmaxf(pmax, p1[r]);
  { auto rr = __builtin_amdgcn_permlane32_swap(__float_as_uint(pmax), __float_as_uint(pmax), false, false);
    pmax = fmaxf(__uint_as_float(rr[0]), __uint_as_float(rr[1])); }
  if (__builtin_expect(__all(pmax - m_reg <= THR / SCALE), 1)) { mn = m_reg; alpha = 1.f; }
  else { mn = fmaxf(m_reg, pmax); alpha = __builtin_amdgcn_exp2f((m_reg - mn) * C); m_reg = mn; }
  float mnC = -mn * C;
#pragma unroll
  for (int r = 0; r < 16; ++r) p0[r] = fmaf(p0[r], C, mnC);
#pragma unroll
  for (int r = 0; r < 16; ++r) p1[r] = fmaf(p1[r], C, mnC);
#pragma unroll
  for (int r = 0; r < 16; ++r) p0[r] = __builtin_amdgcn_exp2f(p0[r]);
}
DI void finishSM(f32x16& p0, f32x16& p1, float alpha, float& l_reg, bf16x8& pa0, bf16x8& pa1, bf16x8& pa2, bf16x8& pa3) {
#pragma unroll
  for (int r = 0; r < 16; ++r) p1[r] = __builtin_amdgcn_exp2f(p1[r]);
  float ps = 0;
#pragma unroll
  for (int r = 0; r < 16; ++r) ps += p0[r];
#pragma unroll
  for (int r = 0; r < 16; ++r) ps += p1[r];
  { auto rr = __builtin_amdgcn_permlane32_swap(__float_as_uint(ps), __float_as_uint(ps), false, false);
    ps = __uint_as_float(rr[0]) + __uint_as_float(rr[1]); }
  l_reg = l_reg * alpha + ps;
#define PK4(P, BASE, OUT) do { unsigned a0 = cvtpk(P[BASE + 0], P[BASE + 1]), a1 = cvtpk(P[BASE + 2], P[BASE + 3]);   \
    unsigned b0 = cvtpk(P[BASE + 4], P[BASE + 5]), b1 = cvtpk(P[BASE + 6], P[BASE + 7]);                              \
    auto r0 = __builtin_amdgcn_permlane32_swap(a0, b0, false, false); auto r1 = __builtin_amdgcn_permlane32_swap(a1, b1, false, false); \
    u32x4 w = {r0[0], r1[0], r0[1], r1[1]}; OUT = *reinterpret_cast<bf16x8*>(&w); } while (0)
  PK4(p0, 0, pa0); PK4(p0, 8, pa1); PK4(p1, 0, pa2); PK4(p1, 8, pa3);
#undef PK4
}
constexpr int NQR = 5;
DI void qkt(f32x16& p0, f32x16& p1, const LAS char* Ks, const bf16x8* qr, const LAS char* qlds, int r32, int hi) {
  p0 = f32x16{}; p1 = f32x16{};
#pragma unroll
  for (int d0 = 0; d0 < 12; ++d0) { int cb = (d0 * 16 + hi * 8) * 2;
    const bf16x8 qf = (d0 < NQR) ? qr[d0] : *(const LAS bf16x8*)(qlds + (d0 - NQR) * 1024);
    bf16x8 b0 = *(const LAS bf16x8*)(Ks + KSWZ(r32, cb));
    bf16x8 b1 = *(const LAS bf16x8*)(Ks + KSWZ(32 + r32, cb));
    p0 = __builtin_amdgcn_mfma_f32_32x32x16_bf16(b0, qf, p0, 0, 0, 0);
    p1 = __builtin_amdgcn_mfma_f32_32x32x16_bf16(b1, qf, p1, 0, 0, 0); }
}
DI int v_st(int k, int c) { const int kk = (k & ~0xC) | ((k & 4) << 1) | ((k & 8) >> 1); return ((kk >> 3) * 4 + (c >> 5)) * 512 + ((kk & 7) * 32 + (c & 31)) * 2; }
DI int v_rd_base(int lane) { return ((lane & 3) << 3) | (((lane >> 2) & 3) << 6) | (((lane >> 4) & 1) << 5) | (((lane >> 5) & 1) << 8); }
constexpr int v_rd_off(int d0, int ks, int half) { return d0 * 512 + ks * 4096 + half * 2048; }
template <int OFF> DI s16x4 tr_read(int vb) { s16x4 r; asm volatile("ds_read_b64_tr_b16 %0, %1 offset:%2" : "=&v"(r) : "v"(vb), "i"(OFF) : "memory"); return r; }
template <int D0> DI void pv_one(f32x16& od, int vb, bf16x8 pa0, bf16x8 pa1, bf16x8 pa2, bf16x8 pa3) {
  const s16x4 l0 = tr_read<v_rd_off(D0, 0, 0)>(vb), h0 = tr_read<v_rd_off(D0, 0, 1)>(vb), l1 = tr_read<v_rd_off(D0, 1, 0)>(vb), h1 = tr_read<v_rd_off(D0, 1, 1)>(vb);
  const s16x4 l2 = tr_read<v_rd_off(D0, 2, 0)>(vb), h2 = tr_read<v_rd_off(D0, 2, 1)>(vb), l3 = tr_read<v_rd_off(D0, 3, 0)>(vb), h3 = tr_read<v_rd_off(D0, 3, 1)>(vb);
  asm volatile("s_waitcnt lgkmcnt(0)" ::: "memory"); SBAR();
#define PK(L, H) (bf16x8){L[0], L[1], L[2], L[3], H[0], H[1], H[2], H[3]}
  od = __builtin_amdgcn_mfma_f32_32x32x16_bf16(pa0, PK(l0, h0), od, 0, 0, 0);
  od = __builtin_amdgcn_mfma_f32_32x32x16_bf16(pa1, PK(l1, h1), od, 0, 0, 0);
  od = __builtin_amdgcn_mfma_f32_32x32x16_bf16(pa2, PK(l2, h2), od, 0, 0, 0);
  od = __builtin_amdgcn_mfma_f32_32x32x16_bf16(pa3, PK(l3, h3), od, 0, 0, 0);
#undef PK
}
DI void pv_d0(f32x16* o, int vb, bf16x8 pa0, bf16x8 pa1, bf16x8 pa2, bf16x8 pa3) {
  pv_one<0>(o[0], vb, pa0, pa1, pa2, pa3); pv_one<1>(o[1], vb, pa0, pa1, pa2, pa3); pv_one<2>(o[2], vb, pa0, pa1, pa2, pa3); pv_one<3>(o[3], vb, pa0, pa1, pa2, pa3);
}
DI void attn_unit(const bf16* __restrict__ Qb, const bf16* __restrict__ Kh, const bf16* __restrict__ Vh, bf16* __restrict__ Ob, int seq, const float* rope, int pos0, LAS char* lds, const int tid) {
  constexpr int LDQ = cf::QP, LDKK = cf::KP, LDVV = cf::VP, LDO = cf::D;
  const int wid = __builtin_amdgcn_readfirstlane(tid >> 6), lane = tid & 63, r32 = lane & 31, hi = lane >> 5;
  LAS char* V_lds = lds; LAS char* K_lds = lds + 2 * SHM_V;
  LAS float* ws = (LAS float*)(lds + 2 * SHM_V + 2 * SHM_K) + wid * 64; LAS float* li_l = ws; LAS float* al_l = ws + 32;
  LAS char* qlds = lds + 2 * SHM_V + 2 * SHM_K + NW * 64 * 4 + wid * (12 - NQR) * 1024 + lane * 16;
  float m_reg = -1e30f, l_reg = 0; f32x16 o[4] = {}; bf16x8 qr[12];
  const bf16* Qw = Qb + (long)(wid * QBLK + r32) * LDQ + hi * 8;
#pragma unroll
  for (int d0 = 0; d0 < 12; ++d0) qr[d0] = *reinterpret_cast<const bf16x8*>(Qw + d0 * 16);
  if (rope) { const int t = pos0 + wid * QBLK + r32;
#pragma unroll
    for (int ax = 0; ax < 2; ++ax) { const int pos = ax ? (t & 63) : (t >> 6);
      const f32x4 c0 = *(const f32x4*)(rope + pos * 16 + hi * 8), c1 = *(const f32x4*)(rope + pos * 16 + hi * 8 + 4), s0 = *(const f32x4*)(rope + 1024 + pos * 16 + hi * 8), s1 = *(const f32x4*)(rope + 1024 + pos * 16 + hi * 8 + 4);
      float x1[8], x2[8], o1[8], o2[8]; unpack8(__builtin_bit_cast(u32x4, qr[8 + 2 * ax]), x1); unpack8(__builtin_bit_cast(u32x4, qr[9 + 2 * ax]), x2);
#pragma unroll
      for (int e = 0; e < 8; ++e) { const float c = e < 4 ? c0[e] : c1[e - 4], s = e < 4 ? s0[e] : s1[e - 4]; o1[e] = x1[e] * c - x2[e] * s; o2[e] = x1[e] * s + x2[e] * c; }
      qr[8 + 2 * ax] = __builtin_bit_cast(bf16x8, pack8f(o1)); qr[9 + 2 * ax] = __builtin_bit_cast(bf16x8, pack8f(o2)); } }
#pragma unroll
  for (int d0 = NQR; d0 < 12; ++d0) *(LAS bf16x8*)(qlds + (d0 - NQR) * 1024) = qr[d0];
  const int sr = tid >> 4, sc = (tid & 15) * 8, vst0 = v_st(sr, sc), vst1 = v_st(32 + sr, sc);
  int kr_[3], kc_[3];
#pragma unroll
  for (int j = 0; j < 3; ++j) { const int q = tid + 512 * j; kr_[j] = q / 24; kc_[j] = (q % 24) * 8; }
  const int vb0 = (int)(uintptr_t)V_lds + v_rd_base(lane);
  bf16x8 vs0 = {}, vs1 = {}, ks0 = {}, ks1 = {}, ks2 = {};
#define SLOAD(k0) do { vs0 = *(const bf16x8*)(&Vh[(long)((k0) + sr) * LDVV + sc]); vs1 = *(const bf16x8*)(&Vh[(long)((k0) + 32 + sr) * LDVV + sc]); \
    ks0 = *(const bf16x8*)(&Kh[(long)((k0) + kr_[0]) * LDKK + kc_[0]]); ks1 = *(const bf16x8*)(&Kh[(long)((k0) + kr_[1]) * LDKK + kc_[1]]); ks2 = *(const bf16x8*)(&Kh[(long)((k0) + kr_[2]) * LDKK + kc_[2]]); } while (0)
#define SWRITE(b) do { *(LAS bf16x8*)(V_lds + (b) * SHM_V + vst0) = vs0; *(LAS bf16x8*)(V_lds + (b) * SHM_V + vst1) = vs1; \
    *(LAS bf16x8*)(K_lds + (b) * SHM_K + KSWZ(kr_[0], kc_[0] * 2)) = ks0; *(LAS bf16x8*)(K_lds + (b) * SHM_K + KSWZ(kr_[1], kc_[1] * 2)) = ks1; *(LAS bf16x8*)(K_lds + (b) * SHM_K + KSWZ(kr_[2], kc_[2] * 2)) = ks2; } while (0)
#define SWAIT() asm volatile("s_waitcnt vmcnt(0)" ::: "memory")
#define RESC(a) do { if (__any((a) < 1.f)) { if (hi == 0) al_l[r32] = (a); asm volatile("s_waitcnt lgkmcnt(0)" ::: "memory"); \
    _Pragma("unroll") for (int d = 0; d < 4; ++d) _Pragma("unroll") for (int r = 0; r < 16; ++r) o[d][r] *= al_l[crow(r, hi)]; } } while (0)
  f32x16 pA0 = {}, pA1 = {}, pB0 = {}, pB1 = {}; float mnA = 0.f, mnB = 0.f, alA = 1.f, alB = 1.f; bf16x8 pa0 = {}, pa1 = {}, pa2 = {}, pa3 = {}; const int NT = seq / KVBLK;
  SLOAD(0); SWAIT(); SWRITE(0); __syncthreads();
  qkt(pA0, pA1, K_lds, qr, qlds, r32, hi); partialSM(pA0, pA1, m_reg, mnA, alA);
  SLOAD(KVBLK);
  SWAIT(); SWRITE(1); __syncthreads();
  for (int j = 1; j + 1 < NT; j += 2) {
    SBAR(); qkt(pB0, pB1, K_lds + SHM_K, qr, qlds, r32, hi);
    finishSM(pA0, pA1, alA, l_reg, pa0, pa1, pa2, pa3); SBAR();
    SLOAD((j + 1) * KVBLK); SBAR();
    pv_d0(o, vb0, pa0, pa1, pa2, pa3); partialSM(pB0, pB1, m_reg, mnB, alB);
    __syncthreads(); SWAIT(); SWRITE(0);
    RESC(alB); __syncthreads();
    SBAR(); qkt(pA0, pA1, K_lds, qr, qlds, r32, hi);
    finishSM(pB0, pB1, alB, l_reg, pa0, pa1, pa2, pa3); SBAR();
    SLOAD((j + 2) * KVBLK); SBAR();
    pv_d0(o, vb0 + (int)SHM_V, pa0, pa1, pa2, pa3); partialSM(pA0, pA1, m_reg, mnA, alA);
    __syncthreads(); SWAIT(); SWRITE(1);
    RESC(alA); __syncthreads();
  }
  SBAR(); qkt(pB0, pB1, K_lds + SHM_K, qr, qlds, r32, hi);
  finishSM(pA0, pA1, alA, l_reg, pa0, pa1, pa2, pa3); SBAR();
  pv_d0(o, vb0, pa0, pa1, pa2, pa3); partialSM(pB0, pB1, m_reg, mnB, alB);
  __syncthreads(); RESC(alB);
  finishSM(pB0, pB1, alB, l_reg, pa0, pa1, pa2, pa3); SBAR();
  pv_d0(o, vb0 + (int)SHM_V, pa0, pa1, pa2, pa3);
  if (hi == 0) li_l[r32] = l_reg; asm volatile("s_waitcnt lgkmcnt(0)" ::: "memory");
  float rli[16];
#pragma unroll
  for (int r = 0; r < 16; ++r) rli[r] = __builtin_amdgcn_rcpf(li_l[crow(r, hi)]);
  bf16* Ow = Ob + (long)(wid * QBLK) * LDO;
#pragma unroll
  for (int r = 0; r < 16; ++r) { int orow = crow(r, hi);
#pragma unroll
    for (int d0 = 0; d0 < 4; ++d0) Ow[(long)orow * LDO + d0 * 32 + r32] = f2bf(o[d0][r] * rli[r]); }
  __syncthreads();
#undef SLOAD
#undef SWRITE
#undef SWAIT
#undef RESC
}
#undef KSWZ
}
#if defined(PROBE)
DI void fatomic_max(unsigned* p, float v) { atomicMax(p, __builtin_bit_cast(unsigned, fabsf(v))); }
DI float pshift(const bf16* P, int R, int lo, int hi, int col, const float* mu, int mucol) {
    const float c = bf2f(P[(size_t)R * cf::PC + col]), p = (R - 1 >= lo) ? bf2f(P[(size_t)(R - 1) * cf::PC + col]) : 0.f, n = (R + 1 < hi) ? bf2f(P[(size_t)(R + 1) * cf::PC + col]) : 0.f;
    return c + (0.5f * (p + n) - c) * mu[mucol];
}
__global__ void __launch_bounds__(256) probe(In in, uchar* ws, unsigned* res, float* scratch) {
    using namespace cf;
    __shared__ float sh[4352 + 1024];
    const int tid = threadIdx.x, bx = blockIdx.x;
    const bf16* P = (const bf16*)(ws + WS_P); const bf16* Qb = (const bf16*)(ws + WS_Q); const bf16* Kb = (const bf16*)(ws + WS_K); const bf16* Vb = (const bf16*)(ws + WS_V); const bf16* MIX = (const bf16*)(ws + WS_XM);
    const float* YR = (const float*)(ws + WS_YR); const float* YG = (const float*)(ws + WS_YG);
    if (bx < 8) {
        const int h = bx, b = 1;
        for (int which = 0; which < 4; ++which) {
            const bool isctx = which == 3; const int t = which == 0 ? 0 : which == 1 ? 1000 : which == 2 ? 4095 : 5;
            const int row = b * SEGT + (isctx ? t : CTX + t), nkeys = isctx ? CTX : SEGT;
            if (tid < 192) { float q = bf2f(Qb[(size_t)row * QP + h * 192 + tid]); sh[4352 + tid] = q; }
            __syncthreads();
            if (tid < 192 && tid >= 128 && !isctx) { const int j = tid - 128, ax = j >> 5, half = (j >> 4) & 1, f = j & 15; const float pos = ax ? (float)(t & 63) : (float)(t >> 6);
                const float ang = pos * powf(10000.f, -(float)f / 16.f), c = cosf(ang), s = sinf(ang);
                const float x1 = sh[4352 + 128 + ax * 32 + f], x2 = sh[4352 + 128 + ax * 32 + 16 + f];
                sh[4352 + 512 + j] = half ? (x1 * s + x2 * c) : (x1 * c - x2 * s); }
            __syncthreads();
            if (tid < 64 && !isctx) sh[4352 + 128 + tid] = sh[4352 + 512 + tid];
            __syncthreads();
            for (int kk = tid; kk < nkeys; kk += 256) { const int krow = b * SEGT + kk; const bool kctx = kk < CTX; const int kt = kk - CTX;
                float s = 0.f;
                for (int d = 0; d < 128; ++d) s += sh[4352 + d] * bf2f(Kb[(size_t)krow * KP + h * 192 + d]);
                for (int j = 0; j < 64; ++j) { const int ax = j >> 5, half = (j >> 4) & 1, f = j & 15;
                    float kv;
                    if (kctx) kv = bf2f(P[(size_t)krow * PC + C_KR + j]);
                    else { const float pos = ax ? (float)(kt & 63) : (float)(kt >> 6), ang = pos * powf(10000.f, -(float)f / 16.f), c = cosf(ang), sn = sinf(ang);
                        const float x1 = bf2f(P[(size_t)krow * PC + C_KR + ax * 32 + f]), x2 = bf2f(P[(size_t)krow * PC + C_KR + ax * 32 + 16 + f]);
                        kv = half ? (x1 * sn + x2 * c) : (x1 * c - x2 * sn); }
                    s += sh[4352 + 128 + j] * kv; }
                sh[kk] = s * 0.07216878364870322f; }
            __syncthreads();
            float mx = -1e30f; for (int kk = 0; kk < nkeys; ++kk) mx = fmaxf(mx, sh[kk]);
            float den = 0.f; for (int kk = 0; kk < nkeys; ++kk) den += __expf(sh[kk] - mx);
            if (tid < 128) { float o = 0.f; for (int kk = 0; kk < nkeys; ++kk) o += __expf(sh[kk] - mx) * bf2f(Vb[(size_t)(b * SEGT + kk) * VP + h * 128 + tid]);
                o /= den; const float got = bf2f(MIX[(size_t)row * D + h * 128 + tid]); fatomic_max(res + 0, got - o); fatomic_max(res + 16, o); }
            __syncthreads();
        }
    } else if (bx < 10) {
        if (tid >= 64) return;
        const int b = 1, h = 3, dir = bx - 8, lane = tid, hc = h * 64 + lane;
        const float* mu = in.p[11]; float S[64]; float cumw = 1.f;
        const uchar* task = ws + WS_RWT + (size_t)((((b * 8 + h) * 2 + dir) * NCH) + 0) * RW_TASK;
#pragma unroll
        for (int k = 0; k < 64; ++k) S[k] = 0.f;
        for (int step = 0; step < SEGT; ++step) {
            const int R = row_of(b, dir, step >> 6, step & 63), s = R % SEGT, lo = b * SEGT + (s < CTX ? 0 : CTX), hi = b * SEGT + (s < CTX ? CTX : SEGT);
            const float r = pshift(P, R, lo, hi, C_RW + hc, mu, hc), k = pshift(P, R, lo, hi, C_RW + 512 + hc, mu, 512 + hc), v = pshift(P, R, lo, hi, C_RW + 1024 + hc, mu, 1024 + hc);
            if (lane < 32) { sh[lane] = tanhf(pshift(P, R, lo, hi, C_RW + RW_WD + dir * 32 + lane, mu, RW_WD + dir * 32 + lane)); sh[32 + lane] = pshift(P, R, lo, hi, C_RW + RW_AD + dir * 32 + lane, mu, RW_AD + dir * 32 + lane); }
            __builtin_amdgcn_s_waitcnt(0); __builtin_amdgcn_wave_barrier();
            float lw = in.p[12][dir * 512 + hc], la = in.p[14][dir * 512 + hc];
            for (int rr = 0; rr < 32; ++rr) { lw += sh[rr] * in.p[13][((size_t)dir * 32 + rr) * 512 + hc]; la += sh[32 + rr] * in.p[15][((size_t)dir * 32 + rr) * 512 + hc]; }
            const float wlog = -log1pf(expf(-lw)) - 0.5f, w = expf(-expf(wlog)), alr = 1.f / (1.f + expf(-la));
            float kk = k * in.p[17][hc]; sh[400 + lane] = kk * kk; __builtin_amdgcn_s_waitcnt(0); __builtin_amdgcn_wave_barrier(); float nn = 0.f; for (int jj = 0; jj < 64; ++jj) nn += sh[400 + jj]; kk *= rsqrtf(nn + 1e-12f);
            const float kd = k * (1.f + (alr - 1.f) * in.p[18][hc]), a = -kk, bb = kk * alr;
            if (dir == 0 && step < 64) { cumw *= w;
#ifdef S1DBG
                const float qt = (S1DBG == 1) ? alr : kk,
#else
                const float qt = r * cumw,
#endif
                got = bf2f(((const bf16*)(task + 8192))[step * 64 + lane]); fatomic_max(res + 9, got - qt); fatomic_max(res + 25, qt);
                scratch[(size_t)8 * SEGT * 64 + step * 64 + lane] = bb; scratch[(size_t)8 * SEGT * 64 + 4096 + step * 64 + lane] = cumw;
                if (step == 63) { const float gl = ((const float*)(task + 57344))[lane]; fatomic_max(res + 8, gl - cumw); fatomic_max(res + 24, cumw);
                    for (int t2 = 0; t2 < 64; ++t2) { const float bh = scratch[(size_t)8 * SEGT * 64 + t2 * 64 + lane] * cumw / scratch[(size_t)8 * SEGT * 64 + 4096 + t2 * 64 + lane], gb = bf2f(((const bf16*)(task + 24576))[lane * 64 + t2]); fatomic_max(res + 10, gb - bh); fatomic_max(res + 26, bh); } } }
            sh[64 + lane] = a; sh[128 + lane] = bb; sh[192 + lane] = kd; sh[256 + lane] = w; sh[320 + lane] = r;
            __builtin_amdgcn_s_waitcnt(0); __builtin_amdgcn_wave_barrier();
            float sa = 0.f;
#pragma unroll
            for (int kx = 0; kx < 64; ++kx) sa += S[kx] * sh[64 + kx];
            float y = 0.f;
#pragma unroll
            for (int kx = 0; kx < 64; ++kx) { S[kx] = S[kx] * sh[256 + kx] + sa * sh[128 + kx] + v * sh[192 + kx]; y += S[kx] * sh[320 + kx]; }
            scratch[((size_t)dir * SEGT + (R - b * SEGT)) * 64 + lane] = y;
            __builtin_amdgcn_s_waitcnt(0); __builtin_amdgcn_wave_barrier();
        }
    } else if (bx < 12) {
        const int b = 2, h = 1, dir = bx - 10, c = tid & 127;
        float S[128];
#pragma unroll
        for (int k = 0; k < 128; ++k) S[k] = 0.f;
        const float A = expf(in.p[23][dir * 4 + h]), dtb = in.p[24][dir * 4 + h];
        for (int step = 0; step < SEGT; ++step) {
            const int R = row_of(b, dir, step >> 6, step & 63), s = R % SEGT, lo = b * SEGT + (s < CTX ? 0 : CTX), hi = b * SEGT + (s < CTX ? CTX : SEGT);
            float x[3];
            for (int w = 0; w < 3; ++w) { float acc = 0.f; const int col = w * 512 + h * 128 + c;
                for (int j = 0; j < 5; ++j) { const int Rj = R + j - 2; if (Rj >= lo && Rj < hi) acc += in.p[22][(size_t)j * 1536 + col] * bf2f(P[(size_t)Rj * PC + C_GD + col]); }
                x[w] = acc / (1.f + expf(-acc)); }
            if (tid < 128) { sh[tid] = x[0] * x[0]; sh[128 + tid] = x[1] * x[1]; }
            __syncthreads();
            float sq = 0.f, sk = 0.f; for (int j = 0; j < 128; ++j) { sq += sh[j]; sk += sh[128 + j]; }
            __syncthreads();
            const float q = x[0] * rsqrtf(sq + 1e-12f) * 0.08838834764831845f, k = x[1] * rsqrtf(sk + 1e-12f), v = x[2];
            const float a_raw = bf2f(P[(size_t)R * PC + C_GD + GD_A + dir * 4 + h]), b_raw = bf2f(P[(size_t)R * PC + C_GD + GD_B + dir * 4 + h]);
            const float z = a_raw + dtb, g = -A * (z > 20.f ? z : log1pf(expf(z))), eg = expf(g), beta = 1.f / (1.f + expf(-b_raw));
            if (tid < 128) { sh[256 + tid] = k; sh[384 + tid] = q; }
            __syncthreads();
            if (tid < 128) { float ks = 0.f;
#pragma unroll
                for (int kx = 0; kx < 128; ++kx) ks += sh[256 + kx] * S[kx];
                float o = 0.f;
#pragma unroll
                for (int kx = 0; kx < 128; ++kx) { S[kx] = eg * (S[kx] - beta * sh[256 + kx] * ks) + beta * sh[256 + kx] * v; o += sh[384 + kx] * S[kx]; }
                scratch[(size_t)2 * SEGT * 64 + ((size_t)dir * SEGT + (R - b * SEGT)) * 128 + c] = o; }
            __syncthreads();
        }
    }
}
__global__ void probe_cmp(uchar* ws, unsigned* res, const float* scratch) {
    using namespace cf;
    const float* YR = (const float*)(ws + WS_YR); const float* YG = (const float*)(ws + WS_YG);
    for (int i = blockIdx.x * blockDim.x + threadIdx.x; i < SEGT * 64; i += gridDim.x * blockDim.x) { const int s = i >> 6, v = i & 63, b = 1, h = 3; const size_t row = (size_t)b * SEGT + s;
        const float r0 = scratch[(size_t)s * 64 + v], r1 = scratch[((size_t)SEGT + s) * 64 + v], g0 = YR[row * 512 + h * 64 + v], g1 = YR[((size_t)M + row) * 512 + h * 64 + v];
        fatomic_max(res + 1, (g0 + g1) - (r0 + r1)); fatomic_max(res + 17, r0 + r1);
        fatomic_max(res + 3, g0 - r0); fatomic_max(res + 19, r0);
        fatomic_max(res + 4, g1 - r1); fatomic_max(res + 20, r1);
        if (s < 64) { fatomic_max(res + 5, g0 - r0); fatomic_max(res + 21, r0); }
        if (s >= 64 && s < 128) { fatomic_max(res + 6, g0 - r0); fatomic_max(res + 22, r0); }
        if (s >= 256 && s < 320) { fatomic_max(res + 7, g0 - r0); fatomic_max(res + 23, r0); }
    }
    for (int i = blockIdx.x * blockDim.x + threadIdx.x; i < SEGT * 128; i += gridDim.x * blockDim.x) { const int s = i >> 7, v = i & 127, b = 2, h = 1; const size_t row = (size_t)b * SEGT + s;
        const float* sg = scratch + (size_t)2 * SEGT * 64;
        const float ref = sg[(size_t)s * 128 + v] + sg[((size_t)SEGT + s) * 128 + v], got = YG[row * 512 + h * 128 + v] + YG[((size_t)M + row) * 512 + h * 128 + v];
        fatomic_max(res + 2, got - ref); fatomic_max(res + 18, ref); }
}
__global__ void probe_out(float* out, const unsigned* res, int selA, int selB) {
    if (blockIdx.x == 0 && threadIdx.x == 0) {
        out[0] = 1.0e5f * __builtin_bit_cast(float, res[selA]) / __builtin_bit_cast(float, res[16 + selA]);
        out[1] = 1.0e5f * __builtin_bit_cast(float, res[selB]) / __builtin_bit_cast(float, res[16 + selB]); }
}
#endif
constexpr int NWAVES = 8, NPH = 3 + 9 * cf::DEPTH;
struct Args { In in; float* out; uchar* ws; int g_lo, g_hi; };
static_assert(sizeof(Args) == 34 * 8 + 8 + 8 + 8, "Args has no padding");

__global__ void __launch_bounds__(NWAVES * 64, 2) fwd(Args args) {
    using namespace cf;
    extern __shared__ __attribute__((aligned(16))) unsigned char lds_raw[];
    LAS uchar* lds = (LAS uchar*)lds_raw;
    const int bx = blockIdx.x, G = gridDim.x, wv = __builtin_amdgcn_readfirstlane(threadIdx.x >> 6);
    auto lane_now = [&]() { unsigned ones = ~0u; asm volatile("" : "+s"(ones)); return (int)__builtin_amdgcn_mbcnt_hi(ones, __builtin_amdgcn_mbcnt_lo(ones, 0u)); };
#define TID() (wv * 64 + lane_now())
    const In& in = args.in;
    volatile LAS unsigned* MISC = (volatile LAS unsigned*)(lds + MISC_OFF);
    { const int tid = threadIdx.x; if (tid < 32) MISC[tid] = 0u; }
    __syncthreads();
    const int g_lo = args.g_lo, g_hi = args.g_hi;
    unsigned* barw = (unsigned*)(args.ws + WS_CTL) + CW_BAR;
    if (g_hi - g_lo > 1) (void)xcd_barrier_post(barw, MISC + 8);
#ifndef PH_MASK
#define PH_MASK 0xfff
#endif
#define PHK(g) ((g) < 3 ? (g) : 3 + ((g) - 3) % 9)
#ifndef DUP_PHASE
#define DUP_PHASE -1
#endif
#define NREP(k) ((DUP_PHASE == (k)) ? 2 : 1)
#define OPQ(v) asm volatile("" : "+v"(v))
#define IN(g) (((PH_MASK >> PHK(g)) & 1) && args.g_lo <= (g) && (g) < args.g_hi)
#ifdef TIMING
#define STAMP(i) do { if (blockIdx.x == 0 && TID() == 0) ((unsigned long long*)(args.ws + 16384))[i] = __builtin_amdgcn_s_memrealtime(); } while (0)
#else
#define STAMP(i) do {} while (0)
#endif
#define SEAM(g) do { if (args.g_lo <= (g) && (g) + 1 < args.g_hi) { XcdBarrier bar_; bar_.bar = (unsigned*)(args.ws + WS_CTL) + CW_BAR; bar_.x = xb_xcc_id(); bar_.st = (volatile LAS unsigned*)(lds + MISC_OFF) + 8; xcd_barrier(bar_); } STAMP((g) + 1); } while (0)

#define OPQS(v) asm volatile("" : "+s"(v))
#define LOCALS int l = lq; OPQS(l); size_t zq_ = 0; OPQS(zq_); uchar* ws = args.ws + zq_; float* X = (float*)(ws + WS_X); bf16* XM = (bf16*)(ws + WS_XM); bf16* P = (bf16*)(ws + WS_P); \
    bf16* CQN = (bf16*)(ws + WS_CQN); bf16* CKVN = (bf16*)(ws + WS_CKVN); bf16* Qb = (bf16*)(ws + WS_Q); bf16* Kb = (bf16*)(ws + WS_K); bf16* Vb = (bf16*)(ws + WS_V); \
    bf16* HFF = (bf16*)(ws + WS_HFF); float* YR = (float*)(ws + WS_YR); float* YG = (float*)(ws + WS_YG); float* GATE = (float*)(ws + WS_GATE); float* BONUS = (float*)(ws + WS_BONUS); \
    const float* MODV = (const float*)(ws + WS_MODV); const float* ROPE = (const float*)(ws + WS_ROPE); const float* modl = MODV + (size_t)l * 5 * MODS; \
    (void)X; (void)XM; (void)P; (void)CQN; (void)CKVN; (void)Qb; (void)Kb; (void)Vb; (void)HFF; (void)YR; (void)YG; (void)GATE; (void)BONUS; (void)ROPE; (void)modl; int t_ = TID(); OPQ(t_);

    STAMP(0);
    if (IN(0)) { const int lq = 0; LOCALS; phase_prologue(in, ws, lds, G, bx, t_); }
#ifdef DUP_PRO
    { XcdBarrier bar_; bar_.bar = (unsigned*)(args.ws + WS_CTL) + CW_BAR; bar_.x = xb_xcc_id(); bar_.st = (volatile LAS unsigned*)(lds + MISC_OFF) + 8; xcd_barrier(bar_); }
    if (IN(0)) { const int lq = 0; LOCALS; phase_prologue(in, ws, lds, G, bx, t_); }
#endif
    SEAM(0);
#ifdef DUP_BAR
    for (int nb_ = 0; nb_ < DUP_BAR; ++nb_) { XcdBarrier bar_; bar_.bar = (unsigned*)(args.ws + WS_CTL) + CW_BAR; bar_.x = xb_xcc_id(); bar_.st = (volatile LAS unsigned*)(lds + MISC_OFF) + 8; xcd_barrier(bar_); }
#endif
    if (IN(1)) { const int lq = 0; LOCALS; phase_modreduce(in, ws, G, bx, t_); }
    SEAM(1);
    if (IN(2)) { const int lq = 0; LOCALS; phase_modulate(X, XM, MODV, 0, D, G, bx, t_); }
    SEAM(2);

#pragma unroll 1
    for (int lq = 0; lq < DEPTH; ++lq) {
        const int g0 = 3 + 9 * lq;
        if (IN(g0 + 0)) for (int rep_ = 0; rep_ < NREP(0); ++rep_) { if (rep_) { XcdBarrier bar_; bar_.bar = (unsigned*)(args.ws + WS_CTL) + CW_BAR; bar_.x = xb_xcc_id(); bar_.st = (volatile LAS unsigned*)(lds + MISC_OFF) + 8; xcd_barrier(bar_); } LOCALS;
            pg8::Gemm g{XM, (const bf16*)(ws + WS_WIN) + (size_t)l * PC * D, M, PC, D, D}; pg8::StaticOrder S; S.init(M, PC, G, bx);
            pg8::EpiStore E{P, PC};
            pg8::gemm_phase<pg8::EpiStore, pg8::StaticOrder, true, true>(lds, g, S, E, t_);
        }
        SEAM(g0 + 0);
        if (IN(g0 + 1)) for (int rep_ = 0; rep_ < NREP(1); ++rep_) { if (rep_) { XcdBarrier bar_; bar_.bar = (unsigned*)(args.ws + WS_CTL) + CW_BAR; bar_.x = xb_xcc_id(); bar_.st = (volatile LAS unsigned*)(lds + MISC_OFF) + 8; xcd_barrier(bar_); } LOCALS;
#ifndef NO_MLAPREP
            mla_prep_rows(P, CQN, CKVN, Kb, in.p[7] + l * 512, in.p[8] + l * 512, ROPE, G, bx, t_);
#endif
            ScanW sw; sw.mu = in.p[11] + l * RW_COLS; sw.w0 = in.p[12] + l * 1024; sw.a0 = in.p[14] + l * 1024; sw.k_k = in.p[17] + l * 512; sw.k_a = in.p[18] + l * 512; sw.r_k = in.p[19] + l * 512;
            sw.W2T = (const bf16*)(ws + WS_W2T) + (size_t)l * 2 * 512 * 32; sw.A2T = (const bf16*)(ws + WS_A2T) + (size_t)l * 2 * 512 * 32; sw.G2T = (const bf16*)(ws + WS_G2T) + (size_t)l * 512 * 96;
            sw.conv = in.p[22] + l * 5 * 1536; sw.a_log = in.p[23] + l * 8; sw.dt_bias = in.p[24] + l * 8;
            {
                const int combo = bx & 15, h = combo >> 1, dir = combo & 1, nbl = (G >> 4) > 0 ? (G >> 4) : 1;
                int j = bx >> 4; unsigned chk = 0u;
                { int tw = TID(); OPQ(tw); rw_stage_weights(lds, sw, h, dir, tw); }

#pragma unroll 1
                for (; j < 272; j += nbl) { int tt = TID(); OPQ(tt);
#ifndef NO_S1R
                    const int jr = 271 - j;
                    const int b = jr / NCH, ci = jr % NCH, jn = (j + nbl < 272) ? j + nbl : j, tk = ((b * 8 + h) * 2 + dir) * NCH + ci;
                    s1_rwkv(lds, P, sw, ws + WS_RWT + (size_t)tk * RW_TASK, GATE, BONUS + (size_t)dir * M * 8, b, h, dir, ci, tt, chk, (271 - jn) / NCH, (271 - jn) % NCH);
#ifdef DUP_S1R
                    OPQ(tt); s1_rwkv(lds, P, sw, ws + WS_RWT + (size_t)tk * RW_TASK, GATE, BONUS + (size_t)dir * M * 8, b, h, dir, ci, tt, chk, (271 - jn) / NCH, (271 - jn) % NCH);
#endif
#endif
                }
                if (chk == 0x9e3779b9u) ((unsigned*)(ws + WS_CTL))[32] = chk;
            }
            {
                const int combo = bx & 7, h = combo >> 1, dir = combo & 1, nbl = (G >> 3) > 0 ? (G >> 3) : 1;
                __syncthreads();
                { int tw = TID(); OPQ(tw); gd_stage_weights(lds, sw, h, tw); }
#pragma unroll 1
                for (int j = bx >> 3; j < 272; j += nbl) { int tt = TID(); OPQ(tt);
#ifndef NO_S1G
                    const int jr = 271 - j, b = jr / NCH, ci = jr % NCH, tg = ((b * 4 + h) * 2 + dir) * NCH + ci;
                    s1_gdn(lds, P, sw, ws + WS_GDT + (size_t)tg * GD_TASK, b, h, dir, ci, tt);
#ifdef DUP_S1G
                    OPQ(tt); s1_gdn(lds, P, sw, ws + WS_GDT + (size_t)tg * GD_TASK, b, h, dir, ci, tt);
#endif
#endif
                }
            }
        }
        SEAM(g0 + 1);
        if (IN(g0 + 2)) for (int rep_ = 0; rep_ < NREP(2); ++rep_) { if (rep_) { XcdBarrier bar_; bar_.bar = (unsigned*)(args.ws + WS_CTL) + CW_BAR; bar_.x = xb_xcc_id(); bar_.st = (volatile LAS unsigned*)(lds + MISC_OFF) + 8; xcd_barrier(bar_); } LOCALS;
            const bool split = G >= 256;
#pragma unroll 1
#ifdef DUP_S2
            for (int rs_ = 0; rs_ < 2; ++rs_)
#endif
            for (int s = bx; s < 128; s += (split ? 1 << 20 : G)) {
#ifndef NO_S2R
                if (s < 64) { const int b = s >> 4, h = (s >> 1) & 7, dir = s & 1;
                    s2n_scan<64, true>(lds, ws + WS_RWT + (size_t)(((b * 8 + h) * 2 + dir) * NCH) * RW_TASK, RW_TASK, 0, 8192, 16384, 24576, 32768, 2, 0,
                                      YR + (size_t)dir * M * 512, h * 64, b, dir, t_); }
#endif
#ifndef NO_S2G
                if (s >= 64) { const int g = s - 64, vs = g & 1, dir = (g >> 1) & 1, h = (g >> 2) & 3, b = g >> 4;
                    s2n_scan<128, false>(lds, ws + WS_GDT + (size_t)(((b * 4 + h) * 2 + dir) * NCH) * GD_TASK, GD_TASK, 0, 32768, 49152, 81920, 98304, 4, vs,
                                        YG + (size_t)dir * M * 512, h * 128 + vs * 64, b, dir, t_); }
#endif
                __syncthreads();
            }
            OPQ(t_);
#ifndef NO_UPGEMM
            if (!split || bx >= 128) { const int Gg = split ? G - 128 : G, cg = split ? bx - 128 : bx;
#ifdef DUP_UPG
                for (int rg_ = 0; rg_ < 2; ++rg_) {
#endif
                { pg8::Gemm g{CQN, (const bf16*)(ws + WS_WUQ) + (size_t)l * 1536 * 512, M, 1536, 512, 512}; pg8::StaticOrder S; S.init(M, 1536, Gg, cg);
                  pg8::EpiStore E{Qb, QP}; pg8::gemm_phase<pg8::EpiStore, pg8::StaticOrder, true, true>(lds, g, S, E, t_); }
                __syncthreads(); OPQ(t_);
                { pg8::Gemm g{CKVN, (const bf16*)(ws + WS_WUKV) + (size_t)l * 2048 * 512, M, 2048, 512, 512}; pg8::StaticOrder S; S.init(M, 2048, Gg, cg);
                  pg8::EpiKV E{Kb, Vb}; pg8::gemm_phase<pg8::EpiKV, pg8::StaticOrder, true, true>(lds, g, S, E, t_); }
#ifdef DUP_UPG
                __syncthreads(); OPQ(t_); }
#endif
            }
#endif
        }
        SEAM(g0 + 2);
        if (IN(g0 + 3)) for (int rep_ = 0; rep_ < NREP(3); ++rep_) { if (rep_) { XcdBarrier bar_; bar_.bar = (unsigned*)(args.ws + WS_CTL) + CW_BAR; bar_.x = xb_xcc_id(); bar_.st = (volatile LAS unsigned*)(lds + MISC_OFF) + 8; xcd_barrier(bar_); } LOCALS;
#ifndef NO_MIXROWS
            mix_rows(P, YR, YG, GATE, BONUS, XM, in.p[11] + l * RW_COLS, in.p[20] + l * 512, in.p[21] + l * 512, in.p[25] + l * 128, G, bx, t_);
#endif
#ifndef NO_ATTN
            const int nunits = 512 + (l < DEPTH - 1 ? 32 : 0);
#pragma unroll 1
            for (int u = bx; u < nunits; u += G) { int tt = TID(); OPQ(tt);
                if (u < 512) { const int x = u & 7, j = u >> 3, bh = x + 8 * (j >> 4), qb = j & 15, b = bh >> 3, h = bh & 7;
                    const size_t qrow = (size_t)b * SEGT + CTX + qb * 256, krow = (size_t)b * SEGT;
                    at::attn_unit(Qb + qrow * QP + h * 192, Kb + krow * KP + h * 192, Vb + krow * VP + h * 128, XM + qrow * D + h * 128, SEGT, ROPE, qb * 256, (LAS char*)lds, tt); }
                else { const int bh = u - 512, b = bh >> 3, h = bh & 7; const size_t qrow = (size_t)b * SEGT;
                    at::attn_unit(Qb + qrow * QP + h * 192, Kb + qrow * KP + h * 192, Vb + qrow * VP + h * 128, XM + qrow * D + h * 128, CTX, nullptr, 0, (LAS char*)lds, tt); }
            }
#endif
        }
        SEAM(g0 + 3);
        if (IN(g0 + 4)) for (int rep_ = 0; rep_ < NREP(4); ++rep_) { if (rep_) { XcdBarrier bar_; bar_.bar = (unsigned*)(args.ws + WS_CTL) + CW_BAR; bar_.x = xb_xcc_id(); bar_.st = (volatile LAS unsigned*)(lds + MISC_OFF) + 8; xcd_barrier(bar_); } LOCALS;
            { pg8::Gemm g{XM, (const bf16*)(ws + WS_WOUT) + (size_t)l * D * D, M, D, D, D}; pg8::LatOrder S; S.init(D, G, bx);
              float alpha_ = ALPHA; OPQ(alpha_); pg8::EpiRes E{X, modl + 2 * D, MODS, alpha_};
              pg8::gemm_phase<pg8::EpiRes, pg8::LatOrder, true, true>(lds, g, S, E, t_);
#ifdef DUP_E
              __syncthreads(); OPQ(t_); { pg8::EpiStore E2{(bf16*)(ws + WS_HFF), D}; pg8::gemm_phase<pg8::EpiStore, pg8::LatOrder, true, true>(lds, g, S, E2, t_); }
#endif
            }
            if (l < DEPTH - 1) { __syncthreads(); OPQ(t_);
              pg8::Gemm g{XM, (const bf16*)(ws + WS_WOUT) + (size_t)l * D * D, M, D, D / 8, D}; pg8::CtxSplitOrder S; S.init(D, 8, D / 8, G, bx);
              pg8::EpiPart E{(float*)(ws + WS_PART)};
              pg8::gemm_phase<pg8::EpiPart, pg8::CtxSplitOrder, true, true>(lds, g, S, E, t_); }
        }
        SEAM(g0 + 4);
        if (IN(g0 + 5)) for (int rep_ = 0; rep_ < NREP(5); ++rep_) { if (rep_) { XcdBarrier bar_; bar_.bar = (unsigned*)(args.ws + WS_CTL) + CW_BAR; bar_.x = xb_xcc_id(); bar_.st = (volatile LAS unsigned*)(lds + MISC_OFF) + 8; xcd_barrier(bar_); } LOCALS; phase_ln(X, in.p[27] + l * D, in.p[28] + l * D, XM, modl, 3 * D, 4 * D, nullptr, (l < DEPTH - 1) ? (const float*)(ws + WS_PART) : nullptr, 8, modl + 4 * MODS + 2 * D, l == DEPTH - 1, G, bx, t_);
#ifdef DUP_LN
            { XcdBarrier bar_; bar_.bar = (unsigned*)(args.ws + WS_CTL) + CW_BAR; bar_.x = xb_xcc_id(); bar_.st = (volatile LAS unsigned*)(lds + MISC_OFF) + 8; xcd_barrier(bar_); }
            OPQ(t_); phase_ln(X, in.p[27] + l * D, in.p[28] + l * D, XM, modl, 3 * D, 4 * D, (float*)(ws + WS_Q), nullptr, 0, nullptr, true, G, bx, t_);
#endif
        }
        SEAM(g0 + 5);
        if (IN(g0 + 6)) for (int rep_ = 0; rep_ < NREP(6); ++rep_) { if (rep_) { XcdBarrier bar_; bar_.bar = (unsigned*)(args.ws + WS_CTL) + CW_BAR; bar_.x = xb_xcc_id(); bar_.st = (volatile LAS unsigned*)(lds + MISC_OFF) + 8; xcd_barrier(bar_); } LOCALS;
            pg8::Gemm g{XM, (const bf16*)(ws + WS_WGU) + (size_t)l * 2 * DFF * D, M, 2 * DFF, D, D}; pg8::EpiSwiGLU E{HFF, DFF};
            if (l < DEPTH - 1) { pg8::StaticOrder S; S.init(M, 2 * DFF, G, bx); pg8::gemm_phase<pg8::EpiSwiGLU, pg8::StaticOrder, true, true>(lds, g, S, E, t_); }
            else { pg8::LatOrder S; S.init(2 * DFF, G, bx); pg8::gemm_phase<pg8::EpiSwiGLU, pg8::LatOrder, true, true>(lds, g, S, E, t_); }
        }
        SEAM(g0 + 6);
        if (IN(g0 + 7)) for (int rep_ = 0; rep_ < NREP(7); ++rep_) { if (rep_) { XcdBarrier bar_; bar_.bar = (unsigned*)(args.ws + WS_CTL) + CW_BAR; bar_.x = xb_xcc_id(); bar_.st = (volatile LAS unsigned*)(lds + MISC_OFF) + 8; xcd_barrier(bar_); } LOCALS;
            { pg8::Gemm g{HFF, (const bf16*)(ws + WS_WDN) + (size_t)l * D * DFF, M, D, DFF, DFF}; pg8::LatOrder S; S.init(D, G, bx);
              float alpha_ = ALPHA; OPQ(alpha_); pg8::EpiRes E{X, modl + 5 * D, MODS, alpha_};
              pg8::gemm_phase<pg8::EpiRes, pg8::LatOrder, true, true>(lds, g, S, E, t_);
#ifdef DUP_H
              __syncthreads(); OPQ(t_); { pg8::EpiStore E2{(bf16*)(ws + WS_Q), D}; pg8::gemm_phase<pg8::EpiStore, pg8::LatOrder, true, true>(lds, g, S, E2, t_); }
#endif
            }
            if (l < DEPTH - 1) { __syncthreads(); OPQ(t_);
              pg8::Gemm g{HFF, (const bf16*)(ws + WS_WDN) + (size_t)l * D * DFF, M, D, DFF / 4, DFF}; pg8::CtxSplitOrder S; S.init(D, 4, DFF / 4, G, bx);
              pg8::EpiPart E{(float*)(ws + WS_PART)};
              pg8::gemm_phase<pg8::EpiPart, pg8::CtxSplitOrder, true, true>(lds, g, S, E, t_); }
        }
        SEAM(g0 + 7);
        if (IN(g0 + 8)) for (int rep_ = 0; rep_ < NREP(8); ++rep_) { if (rep_) { XcdBarrier bar_; bar_.bar = (unsigned*)(args.ws + WS_CTL) + CW_BAR; bar_.x = xb_xcc_id(); bar_.st = (volatile LAS unsigned*)(lds + MISC_OFF) + 8; xcd_barrier(bar_); } LOCALS;
            if (l < DEPTH - 1) phase_ln(X, in.p[32] + l * D, in.p[33] + l * D, XM, modl + 5 * MODS, 0, D, nullptr, (const float*)(ws + WS_PART), 4, modl + 4 * MODS + 5 * D, false, G, bx, t_);
            else phase_ln(X, in.p[32] + l * D, in.p[33] + l * D, XM, modl, 0, D, args.out, nullptr, 0, nullptr, true, G, bx, t_);
        }
        SEAM(g0 + 8);
    }
#ifdef TIMING
    __syncthreads();
    if (blockIdx.x == 0 && TID() == 0) { const unsigned long long* st = (const unsigned long long*)(args.ws + 16384); unsigned long long tot = 0;
        for (int g = 0; g < NPH; ++g) { const int cls = g < 3 ? 0 : 1 + (g - 3) % 9; if ((TIMING >> cls) & 1) tot += st[g + 1] - st[g]; }
        args.out[0] = (float)tot * 0.01f; }
#endif
#undef IN
#undef SEAM
}


#if defined(DBG_STOP)
__global__ void dbg_dump(float* out, const unsigned char* ws, int kind, size_t off, int pitch, size_t stride) {
    const size_t n = (size_t)cf::NB * cf::SEQ * cf::D;
    for (size_t i = (size_t)blockIdx.x * blockDim.x + threadIdx.x; i < n; i += (size_t)gridDim.x * blockDim.x) {
        const size_t rr = i / cf::D, c = i % cf::D, b = rr / cf::SEQ, t = rr % cf::SEQ, row = b * cf::SEGT + cf::CTX + t;
        float v;
        if (kind == 0) v = ((const float*)(ws + WS_X))[row * cf::D + c];
        else if (kind == 1) v = bf2f(((const bf16*)(ws + off))[row * (size_t)pitch + c]);
        else if (kind == 3) v = ((const float*)(ws + off))[(i * stride)];
        else if (kind == 4) v = ((const float*)(ws + off))[i % ((size_t)pitch * 1024)];
        else v = bf2f(((const bf16*)(ws + off))[i * stride]);
        if (!(fabsf(v) < 3.0e38f)) v = 1.0e30f;
        out[i] = v;
    }
}
#endif
#ifndef MK_MULTI
#define MK_MULTI 0
#endif
extern "C" void kernel_launch(void* const* d_in, const int* in_sizes, int n_in, void* d_out, int out_size, void* d_ws, size_t ws_size, hipStream_t stream) {
    static int grid = 0;
    if (grid == 0) {
        if (n_in != 34 || out_size != cf::NB * cf::SEQ * cf::D || ws_size < WS_END) { fprintf(stderr, "kernel_launch: shape mismatch (n_in %d out %d ws %zu)\n", n_in, out_size, ws_size); grid = -1; return; }
        int dev = 0, cus = 0;
        if (hipGetDevice(&dev) != hipSuccess || hipDeviceGetAttribute(&cus, hipDeviceAttributeMultiprocessorCount, dev) != hipSuccess) { grid = -1; return; }
        if (hipFuncSetAttribute((const void*)fwd, hipFuncAttributeMaxDynamicSharedMemorySize, LDS_BYTES) != hipSuccess) { fprintf(stderr, "kernel_launch: hipFuncSetAttribute failed\n"); grid = -1; return; }
        int per_cu = 0;
        if (hipOccupancyMaxActiveBlocksPerMultiprocessor(&per_cu, (const void*)fwd, NWAVES * 64, LDS_BYTES) != hipSuccess || per_cu < 1) fprintf(stderr, "kernel_launch: occupancy query says %d\n", per_cu);
        (void)hipGetLastError();
        grid = cus;
    }
    if (grid < 0) return;
    (void)hipMemsetAsync((char*)d_ws, 0, ZERO_BYTES, stream);
    Args a{};
    for (int i = 0; i < 34; ++i) a.in.p[i] = (const float*)d_in[i];
    a.out = (float*)d_out; a.ws = (uchar*)d_ws;
#if defined(PROBE)
    for (int g = 0; g < 7; ++g) { a.g_lo = g; a.g_hi = g + 1; hipLaunchKernelGGL(fwd, dim3(grid), dim3(NWAVES * 64), LDS_BYTES, stream, a); }
    { unsigned* res = (unsigned*)d_ws + 64; float* scratch = (float*)((char*)d_ws + WS_HFF + (400ull << 20));
      scratch = (float*)((char*)d_ws + WS_END);
      hipLaunchKernelGGL(probe, dim3(12), dim3(256), 0, stream, a.in, (uchar*)d_ws, res, scratch);
      hipLaunchKernelGGL(probe_cmp, dim3(256), dim3(256), 0, stream, (uchar*)d_ws, res, (const float*)scratch);
      for (int g = 7; g < NPH; ++g) { a.g_lo = g; a.g_hi = g + 1; hipLaunchKernelGGL(fwd, dim3(grid), dim3(NWAVES * 64), LDS_BYTES, stream, a); }
      hipLaunchKernelGGL(probe_out, dim3(1), dim3(64), 0, stream, (float*)d_out, (const unsigned*)res, PROBE_SELA, PROBE_SELB); }
#elif defined(DBG_STOP)
    for (int g = 0; g < DBG_STOP; ++g) { a.g_lo = g; a.g_hi = g + 1; hipLaunchKernelGGL(fwd, dim3(grid), dim3(NWAVES * 64), LDS_BYTES, stream, a); }
    hipLaunchKernelGGL(dbg_dump, dim3(2048), dim3(256), 0, stream, (float*)d_out, (const unsigned char*)d_ws, DBG_KIND, (size_t)DBG_OFF, DBG_PITCH, (size_t)DBG_STRIDE);
#elif MK_MULTI
    for (int g = 0; g < NPH; ++g) { a.g_lo = g; a.g_hi = g + 1; hipLaunchKernelGGL(fwd, dim3(grid), dim3(NWAVES * 64), LDS_BYTES, stream, a); }
#else
    a.g_lo = 0; a.g_hi = NPH;
    hipLaunchKernelGGL(fwd, dim3(grid), dim3(NWAVES * 64), LDS_BYTES, stream, a);
#endif
    const hipError_t le = hipPeekAtLastError();
    if (le != hipSuccess) fprintf(stderr, "kernel_launch: launch failed: %s\n", hipGetErrorName(le));
}
```

```cpp
#include <hip/hip_runtime.h>
#include <cstdio>
#include <cstdint>

#define DI __device__ __forceinline__
#define LAS __attribute__((address_space(3)))
#define GAS __attribute__((address_space(1)))
typedef unsigned short bf16;
typedef short bf16x8 __attribute__((ext_vector_type(8)));
typedef short s16x4 __attribute__((ext_vector_type(4)));
typedef float f32x4 __attribute__((ext_vector_type(4)));
typedef float f32x2 __attribute__((ext_vector_type(2)));
typedef float f32x16 __attribute__((ext_vector_type(16)));
typedef unsigned u32x4 __attribute__((ext_vector_type(4)));
typedef unsigned u32x2 __attribute__((ext_vector_type(2)));
typedef unsigned char uchar;
typedef __bf16 bf16x2_t __attribute__((ext_vector_type(2)));

namespace pg8 {
typedef unsigned short bf16_t;
#define PG8_LAS __attribute__((address_space(3)))
constexpr int BM = 256, BK = 64, HALF = 128, HTB = HALF * BK * 2  , STAGE_BYTES = 8 * HTB, NXCD = 8, WGM = 8;

__host__ __device__ __forceinline__ int lds_byte(int r, int c) { const int st = (r >> 4) * 2 + (c >> 5), rr = r & 15, cc = c & 31, ob = rr * 64 + cc * 2; return st * 1024 + (ob ^ (((ob >> 9) & 1) << 5)); }
__host__ __device__ __forceinline__ void stage_rc(int b, int& R, int& C) { const int st = b / 1024, sb = b % 1024, swz = sb ^ (((sb >> 9) & 1) << 5); R = (st >> 1) * 16 + swz / 64; C = (st & 1) * 32 + (swz % 64) / 2; }
__host__ __device__ __forceinline__ int perm32(int rho) { const int n = rho >> 4, i = rho & 15; return 8 * (i >> 2) + 4 * n + (i & 3); }

struct Unit { int pm, pn, ko, ks; };
struct Gemm { const bf16_t* A; const bf16_t* Bt; int M, N, K, ld; };

struct StaticOrder {
    int nM, nN, nwg, G, c;
    __host__ __device__ void init(int M, int N, int G_, int c_) { nM = M / BM; nN = N / BM; nwg = nM * nN; G = G_; c = c_; }
    __host__ __device__ bool next(int i, Unit& u) const {
        const long L = (long)i * G + c; if (L >= nwg) return false;
        int wgid = (int)L; { const int q = nwg / NXCD, r = nwg % NXCD, xcd = wgid % NXCD, off = wgid / NXCD; wgid = (xcd < r ? xcd * (q + 1) : r * (q + 1) + (xcd - r) * q) + off; }
        const int nig = WGM * nN, gid = wgid / nig, fm = gid * WGM, gsz = (nM - fm) < WGM ? (nM - fm) : WGM;
        u.pm = fm + ((wgid % nig) % gsz); u.pn = (wgid % nig) / gsz; u.ko = 0; u.ks = 0; return true;
    }
    __device__ __forceinline__ void a_ready(const Unit&) const {}
    __device__ __forceinline__ void done(const Unit&) const {}
};

struct LatOrder {
    StaticOrder S;
    __host__ __device__ void init(int N, int G_, int c_) { S.init(16384, N, G_, c_); }
    __host__ __device__ bool next(int i, Unit& u) const { if (!S.next(i, u)) return false; u.pm = (u.pm >> 4) * 17 + 1 + (u.pm & 15); return true; }
    __device__ __forceinline__ void a_ready(const Unit&) const {}
    __device__ __forceinline__ void done(const Unit&) const {}
};
struct CtxSplitOrder {
    int nN, KS, kbytes, G, c;
    __host__ __device__ void init(int N, int KS_, int Ksplit, int G_, int c_) { nN = N / BM; KS = KS_; kbytes = Ksplit * 2; G = G_; c = c_; }
    __host__ __device__ bool next(int i, Unit& u) const { const int j = i * G + c; if (j >= 4 * nN * KS) return false;
        const int ks = j % KS, cu = j / KS; u.pm = (cu / nN) * 17; u.pn = cu % nN; u.ks = ks; u.ko = ks * kbytes; return true; }
    __device__ __forceinline__ void a_ready(const Unit&) const {}
    __device__ __forceinline__ void done(const Unit&) const {}
};
__device__ __forceinline__ unsigned cvt_pk_bf16(float lo, float hi) { const f32x2 v = {lo, hi}; return __builtin_bit_cast(unsigned, __builtin_convertvector(v, bf16x2_t)); }
__device__ __forceinline__ u32x4 pack8(f32x4 v0, f32x4 v1) { u32x4 w; w.x = cvt_pk_bf16(v0[0], v0[1]); w.y = cvt_pk_bf16(v0[2], v0[3]); w.z = cvt_pk_bf16(v1[0], v1[1]); w.w = cvt_pk_bf16(v1[2], v1[3]); return w; }

struct EpiStore {
    static constexpr bool PERM = true, AFTER_DRAIN = false;
    bf16_t* O; int ldc;
    __device__ __forceinline__ void operator()(const f32x4 (&acc)[2][2][4][2], const Unit& u, int wr, int wc, int fr, int fq) const {
        const int row0 = u.pm * BM + wr * 64 + fr, col0 = u.pn * BM + wc * 32 + 8 * fq;
#pragma unroll
        for (int ai = 0; ai < 2; ++ai)
#pragma unroll
            for (int m = 0; m < 4; ++m) { bf16_t* rowp = O + (size_t)(row0 + ai * HALF + m * 16) * ldc + col0;
#pragma unroll
                for (int bj = 0; bj < 2; ++bj) *(u32x4*)(rowp + bj * HALF) = pack8(acc[ai][bj][m][0], acc[ai][bj][m][1]); }
    }
};
struct EpiKV {
    static constexpr bool PERM = true, AFTER_DRAIN = false;
    bf16_t* Kb; bf16_t* Vb;
    __device__ __forceinline__ void operator()(const f32x4 (&acc)[2][2][4][2], const Unit& u, int wr, int wc, int fr, int fq) const {
        const int row0 = u.pm * BM + wr * 64 + fr, c0 = wc * 32 + 8 * fq;
#pragma unroll
        for (int ai = 0; ai < 2; ++ai)
#pragma unroll
            for (int m = 0; m < 4; ++m) { const size_t row = (size_t)(row0 + ai * HALF + m * 16);
                *(u32x4*)(Kb + row * 1536 + u.pn * 192 + c0) = pack8(acc[ai][0][m][0], acc[ai][0][m][1]);
                *(u32x4*)(Vb + row * 1024 + u.pn * 128 + c0) = pack8(acc[ai][1][m][0], acc[ai][1][m][1]); }
    }
};
struct EpiSwiGLU {
    static constexpr bool PERM = true, AFTER_DRAIN = false;
    bf16_t* Hb; int ldh;
    __device__ __forceinline__ void operator()(const f32x4 (&acc)[2][2][4][2], const Unit& u, int wr, int wc, int fr, int fq) const {
        const int row0 = u.pm * BM + wr * 64 + fr, col0 = u.pn * HALF + wc * 32 + 8 * fq;
#pragma unroll
        for (int ai = 0; ai < 2; ++ai)
#pragma unroll
            for (int m = 0; m < 4; ++m) { f32x4 o[2];
#pragma unroll
                for (int n = 0; n < 2; ++n) { const f32x4 g = acc[ai][0][m][n], up = acc[ai][1][m][n];
#pragma unroll
                    for (int e = 0; e < 4; ++e) o[n][e] = g[e] * __builtin_amdgcn_rcpf(1.f + __expf(-g[e])) * up[e]; }
                *(u32x4*)(Hb + (size_t)(row0 + ai * HALF + m * 16) * ldh + col0) = pack8(o[0], o[1]); }
    }
};
struct EpiPart {
    static constexpr bool PERM = true, AFTER_DRAIN = false;
    float* part;
    __device__ __forceinline__ void operator()(const f32x4 (&acc)[2][2][4][2], const Unit& u, int wr, int wc, int fr, int fq) const {
        const int row0 = (u.pm / 17) * BM + wr * 64 + fr, col0 = u.pn * BM + wc * 32 + 8 * fq;
        float* base = part + (size_t)u.ks * 1024 * 2048;
#pragma unroll
        for (int ai = 0; ai < 2; ++ai)
#pragma unroll
            for (int m = 0; m < 4; ++m) { float* rowp = base + (size_t)(row0 + ai * HALF + m * 16) * 2048 + col0;
#pragma unroll
                for (int bj = 0; bj < 2; ++bj)
#pragma unroll
                    for (int n = 0; n < 2; ++n) *(f32x4*)(rowp + bj * HALF + 4 * n) = acc[ai][bj][m][n]; }
    }
};
struct EpiRes {
    static constexpr bool PERM = true, AFTER_DRAIN = false;
    float* X; const float* gate; int gstride; float alpha;
    __device__ __forceinline__ void operator()(const f32x4 (&acc)[2][2][4][2], const Unit& u, int wr, int wc, int fr, int fq) const {
        const int row0 = u.pm * BM + wr * 64 + fr, col0 = u.pn * BM + wc * 32 + 8 * fq;
        const int vec = (u.pm % 17 == 0) ? 4 : (u.pm / 17);
        const float* gp = gate + (size_t)vec * gstride + col0;
        f32x4 gv[2][2];
#pragma unroll
        for (int bj = 0; bj < 2; ++bj)
#pragma unroll
            for (int n = 0; n < 2; ++n) gv[bj][n] = *(const f32x4*)(gp + bj * HALF + 4 * n);
#pragma unroll
        for (int ai = 0; ai < 2; ++ai)
#pragma unroll
            for (int m = 0; m < 4; ++m) { float* rowp = X + (size_t)(row0 + ai * HALF + m * 16) * 2048 + col0;
#pragma unroll
                for (int bj = 0; bj < 2; ++bj)
#pragma unroll
                    for (int n = 0; n < 2; ++n) { f32x4* p = (f32x4*)(rowp + bj * HALF + 4 * n); const f32x4 x = *p; *p = x * alpha + gv[bj][n] * acc[ai][bj][m][n]; } }
    }
};

template <class Epi, class Sched, bool ALIGN_EPI = false, bool SP2 = false>
__device__ __forceinline__ void gemm_phase(PG8_LAS unsigned char* lds, const Gemm g, const Sched& S, const Epi& E, const int tid) {
    const int wid = __builtin_amdgcn_readfirstlane(tid >> 6), lane = tid & 63, wr = wid >> 2, wc = wid & 3, fr = lane & 15, fq = lane >> 4;
    const int K = g.ld, nt = g.K / BK;
    unsigned voffA[2], voffB[2];
#pragma unroll
    for (int i = 0; i < 2; ++i) { int R, C; stage_rc(tid * 16 + i * 8192, R, C); const int Rb = Epi::PERM ? ((R & ~31) + perm32(R & 31)) : R;
        voffA[i] = (unsigned)(R * K + C) * 2u; voffB[i] = (unsigned)(Rb * K + C) * 2u; }
    const size_t kstep = (size_t)(BK * 2);
    const size_t hstep = (size_t)HALF * K * 2;
    const size_t tstep = 2 * hstep;
    const unsigned ldsw = (unsigned)wid * 1024u;
    const int aoff = lds_byte(wr * 64 + fr, fq * 8), boff = lds_byte(wc * 32 + fr, fq * 8);
#define PG8_SA(b, h) (((b) * 2 + (h)) * HTB)
#define PG8_SB(b, h) ((4 + (b) * 2 + (h)) * HTB)
#define PG8_STAGE(bufoff, gbase, voff) do { _Pragma("unroll") for (int _i = 0; _i < 2; ++_i) \
        __builtin_amdgcn_global_load_lds((const unsigned*)((const char*)(gbase) + (voff)[_i]), (PG8_LAS unsigned*)(lds + (bufoff) + ldsw + _i * 8192), 16, 0, 0); } while (0)
#define PG8_LDA(dst, b, h) do { _Pragma("unroll") for (int m = 0; m < 4; ++m) _Pragma("unroll") for (int k = 0; k < 2; ++k) dst[m][k] = *(const PG8_LAS bf16x8*)(lds + PG8_SA(b, h) + aoff + m * 2048 + k * 1024); } while (0)
#define PG8_LDB(dst, b, h) do { _Pragma("unroll") for (int n = 0; n < 2; ++n) _Pragma("unroll") for (int k = 0; k < 2; ++k) dst[n][k] = *(const PG8_LAS bf16x8*)(lds + PG8_SB(b, h) + boff + n * 2048 + k * 1024); } while (0)
#define PG8_MMA(ai, bj, At, Bt) do { __builtin_amdgcn_s_setprio(1); _Pragma("unroll") for (int m = 0; m < 4; ++m) _Pragma("unroll") for (int n = 0; n < 2; ++n) _Pragma("unroll") for (int k = 0; k < 2; ++k) \
        acc[ai][bj][m][n] = __builtin_amdgcn_mfma_f32_16x16x32_bf16(Bt[n][k], At[m][k], acc[ai][bj][m][n], 0, 0, 0); __builtin_amdgcn_s_setprio(0); } while (0)
#define PG8_WAIT_V(n) asm volatile("s_waitcnt vmcnt(" #n ")" ::: "memory")
#define PG8_WAIT_L(n) asm volatile("s_waitcnt lgkmcnt(" #n ")" ::: "memory")
#define PG8_BAR __builtin_amdgcn_s_barrier()
#define PG8_SCHED __builtin_amdgcn_sched_barrier(0)
    Unit cur, nxt; int ui = 0;
    if (!S.next(0, cur)) return;
    f32x4 acc[2][2][4][2];
#pragma unroll
    for (int a = 0; a < 2; ++a)
#pragma unroll
        for (int b = 0; b < 2; ++b)
#pragma unroll
            for (int m = 0; m < 4; ++m)
#pragma unroll
                for (int n = 0; n < 2; ++n) acc[a][b][m][n] = (f32x4){0.f, 0.f, 0.f, 0.f};
    bf16x8 At[4][2], B0[2][2], B1[2][2];
    const char* cA = (const char*)g.A + (size_t)cur.pm * tstep + cur.ko; const char* cB = (const char*)g.Bt + (size_t)cur.pn * tstep + cur.ko;
    S.a_ready(cur);
    if constexpr (SP2) {
        PG8_STAGE(PG8_SB(0, 0), cB, voffB); PG8_STAGE(PG8_SB(0, 1), cB + hstep, voffB); PG8_STAGE(PG8_SA(0, 0), cA, voffA); PG8_STAGE(PG8_SA(0, 1), cA + hstep, voffA);
        if (wr == 1) PG8_BAR;
        PG8_WAIT_V(2); PG8_BAR;
        PG8_STAGE(PG8_SB(1, 0), cB + kstep, voffB); PG8_STAGE(PG8_SA(1, 0), cA + kstep, voffA); PG8_STAGE(PG8_SB(1, 1), cB + hstep + kstep, voffB);
        PG8_WAIT_V(6); PG8_BAR;
    } else {
        PG8_STAGE(PG8_SB(0, 0), cB, voffB); PG8_STAGE(PG8_SA(0, 0), cA, voffA); PG8_STAGE(PG8_SB(0, 1), cB + hstep, voffB); PG8_STAGE(PG8_SA(0, 1), cA + hstep, voffA);
        if (wr == 1) PG8_BAR;
        PG8_WAIT_V(4); PG8_BAR;
        PG8_STAGE(PG8_SB(1, 0), cB + kstep, voffB); PG8_STAGE(PG8_SA(1, 0), cA + kstep, voffA); PG8_STAGE(PG8_SB(1, 1), cB + hstep + kstep, voffB);
        PG8_WAIT_V(6); PG8_BAR;
    }
    for (;;) {
        const bool has_next = S.next(ui + 1, nxt);
        const char* nA = has_next ? (const char*)g.A + (size_t)nxt.pm * tstep + nxt.ko : cA; const char* nB = has_next ? (const char*)g.Bt + (size_t)nxt.pn * tstep + nxt.ko : cB;
        for (int t = 0; t < nt; t += 2) {
            const bool last = (t == nt - 2);
            const char* a1 = cA + (size_t)(t + 1) * kstep;
            const char* a2 = last ? nA : cA + (size_t)(t + 2) * kstep; const char* b2 = last ? nB : cB + (size_t)(t + 2) * kstep;
            const char* a3 = a2 + kstep; const char* b3 = b2 + kstep;
            if (last && has_next) S.a_ready(nxt);
            if constexpr (SP2) {
            PG8_LDB(B0, 0, 0); PG8_LDB(B1, 0, 1); PG8_SCHED; PG8_LDA(At, 0, 0); PG8_STAGE(PG8_SA(1, 1), a1 + hstep, voffA);
            PG8_WAIT_V(8); PG8_WAIT_L(0); PG8_BAR; PG8_MMA(0, 0, At, B0); PG8_MMA(0, 1, At, B1); PG8_BAR; PG8_SCHED;
            PG8_LDA(At, 0, 1); PG8_STAGE(PG8_SB(0, 0), b2, voffB); PG8_STAGE(PG8_SB(0, 1), b2 + hstep, voffB); PG8_STAGE(PG8_SA(0, 0), a2, voffA);
            PG8_WAIT_V(8); PG8_WAIT_L(0); PG8_BAR; PG8_MMA(1, 0, At, B0); PG8_MMA(1, 1, At, B1); PG8_BAR; PG8_SCHED;
            PG8_LDB(B0, 1, 0); PG8_LDB(B1, 1, 1); PG8_SCHED; PG8_LDA(At, 1, 0); PG8_STAGE(PG8_SA(0, 1), a2 + hstep, voffA);
            PG8_WAIT_V(8); PG8_WAIT_L(0); PG8_BAR; PG8_MMA(0, 0, At, B0); PG8_MMA(0, 1, At, B1); PG8_BAR; PG8_SCHED;
            PG8_LDA(At, 1, 1); PG8_STAGE(PG8_SB(1, 0), b3, voffB); PG8_STAGE(PG8_SB(1, 1), b3 + hstep, voffB); PG8_STAGE(PG8_SA(1, 0), a3, voffA);
            PG8_WAIT_V(8); PG8_WAIT_L(0); PG8_BAR; PG8_MMA(1, 0, At, B0); PG8_MMA(1, 1, At, B1); PG8_BAR; PG8_SCHED;
            } else {
            PG8_LDB(B0, 0, 0); PG8_SCHED; PG8_LDA(At, 0, 0); PG8_STAGE(PG8_SA(1, 1), a1 + hstep, voffA);
            PG8_WAIT_L(8); PG8_BAR; PG8_WAIT_L(0); PG8_MMA(0, 0, At, B0); PG8_BAR; PG8_SCHED;
            PG8_LDB(B1, 0, 1); PG8_STAGE(PG8_SB(0, 0), b2, voffB);
            PG8_BAR; PG8_WAIT_L(0); PG8_MMA(0, 1, At, B1); PG8_BAR;
            PG8_LDA(At, 0, 1); PG8_STAGE(PG8_SA(0, 0), a2, voffA);
            PG8_BAR; PG8_WAIT_L(0); PG8_MMA(1, 0, At, B0); PG8_BAR; PG8_SCHED;
            PG8_STAGE(PG8_SB(0, 1), b2 + hstep, voffB);
            PG8_WAIT_V(6); PG8_BAR; PG8_MMA(1, 1, At, B1); PG8_BAR;
            PG8_LDB(B0, 1, 0); PG8_SCHED; PG8_LDA(At, 1, 0); PG8_STAGE(PG8_SA(0, 1), a2 + hstep, voffA);
            PG8_WAIT_L(8); PG8_BAR; PG8_WAIT_L(0); PG8_MMA(0, 0, At, B0); PG8_BAR; PG8_SCHED;
            PG8_LDB(B1, 1, 1); PG8_STAGE(PG8_SB(1, 0), b3, voffB);
            PG8_BAR; PG8_WAIT_L(0); PG8_MMA(0, 1, At, B1); PG8_BAR;
            PG8_LDA(At, 1, 1); PG8_STAGE(PG8_SA(1, 0), a3, voffA);
            PG8_BAR; PG8_WAIT_L(0); PG8_MMA(1, 0, At, B0); PG8_BAR; PG8_SCHED;
            PG8_STAGE(PG8_SB(1, 1), b3 + hstep, voffB);
            PG8_WAIT_V(6); PG8_BAR; PG8_MMA(1, 1, At, B1); PG8_BAR;
            }
        }
        if constexpr (ALIGN_EPI) { if (wr == 0) PG8_BAR; }
        if constexpr (!Epi::AFTER_DRAIN) { E(acc, cur, wr, wc, fr, fq); S.done(cur); }
        if (!has_next) break;
#pragma unroll
        for (int a = 0; a < 2; ++a)
#pragma unroll
            for (int b = 0; b < 2; ++b)
#pragma unroll
                for (int m = 0; m < 4; ++m)
#pragma unroll
                    for (int n = 0; n < 2; ++n) acc[a][b][m][n] = (f32x4){0.f, 0.f, 0.f, 0.f};
        cur = nxt; cA = nA; cB = nB; ++ui;
        if constexpr (ALIGN_EPI) { if (wr == 1) PG8_BAR; }
    }
    PG8_WAIT_V(0);
    if constexpr (!ALIGN_EPI) { if (wr == 0) PG8_BAR; }
    PG8_BAR;
    if constexpr (Epi::AFTER_DRAIN) { E.fused(acc, cur, wr, wc, fr, fq, lds, wid, lane); S.done(cur); }
#undef PG8_SA
#undef PG8_SB
#undef PG8_STAGE
#undef PG8_LDA
#undef PG8_LDB
#undef PG8_MMA
#undef PG8_WAIT_V
#undef PG8_WAIT_L
#undef PG8_BAR
#undef PG8_SCHED
}
}
namespace cf {
constexpr int D = 2048, NB = 4, SEQ = 4096, CTX = 256, SEGT = 4352, M = 17408, DEPTH = 4;
constexpr int IN_COLS = 4912, PC = 5120;
constexpr int C_CQ = 0, C_CKV = 512, C_KR = 1024, C_RW = 1088, C_GD = 2848;
constexpr int RW_K = 512, RW_V = 1024, RW_WD = 1536, RW_AD = 1600, RW_GD = 1664, RW_COLS = 1760;
constexpr int GD_K = 512, GD_V = 1024, GD_Z = 1536, GD_A = 2048, GD_B = 2056;
constexpr int DFF = 5632, NCH = 68;
constexpr int QP = 1536, KP = 1536, VP = 1024;
constexpr int MODS = 6 * D;
constexpr float ALPHA = 1.681792830507429f;
constexpr int RW_TASK = 33024, GD_TASK = 98816;
}
constexpr size_t MiB = 1u << 20;
constexpr size_t WS_CTL = 0, WS_MODV = 1 * MiB, ZERO_BYTES = 2 * MiB;
constexpr size_t WS_ROPE = 2 * MiB, WS_W2T = 2 * MiB + 65536, WS_A2T = WS_W2T + 262144, WS_G2T = WS_A2T + 262144;
constexpr size_t WS_WIN = 4 * MiB, WS_WOUT = 84 * MiB, WS_WGU = 116 * MiB, WS_WDN = 292 * MiB, WS_WUQ = 380 * MiB, WS_WUKV = 386 * MiB;
constexpr size_t WS_X = 394 * MiB, WS_XM = 530 * MiB;
constexpr size_t WS_P = 598 * MiB, WS_CQN = 768 * MiB, WS_CKVN = 785 * MiB, WS_Q = 802 * MiB, WS_K = 853 * MiB, WS_V = 904 * MiB;
constexpr size_t WS_RWT = 938 * MiB, WS_GDT = 1076 * MiB, WS_YR = 1333 * MiB, WS_YG = 1401 * MiB, WS_GATE = 1469 * MiB, WS_BONUS = 1503 * MiB, WS_END = 1505 * MiB;
constexpr size_t WS_PART = 1076 * MiB;
constexpr size_t WS_HFF = 598 * MiB;
static_assert(WS_RWT + (size_t)4352 * cf::RW_TASK <= WS_GDT && WS_GDT + (size_t)2176 * cf::GD_TASK <= WS_YR && WS_HFF + (size_t)cf::M * cf::DFF * 2 <= WS_CKVN, "ws map");
constexpr int CW_TMO = 0, CW_BAR = 4096;
constexpr int LDS_BYTES = 163840, MISC_OFF = LDS_BYTES - 128;

DI float bflo(unsigned w) { return __builtin_bit_cast(float, w << 16); }
DI float bfhi(unsigned w) { return __builtin_bit_cast(float, w & 0xffff0000u); }
DI float bf2f(bf16 h) { return __builtin_bit_cast(float, (unsigned)h << 16); }
DI bf16 f2bf(float f) { unsigned u = __builtin_bit_cast(unsigned, f); return (bf16)((u + 0x7fffu + ((u >> 16) & 1u)) >> 16); }
DI unsigned pk2(float lo, float hi) { const f32x2 v = {lo, hi}; return __builtin_bit_cast(unsigned, __builtin_convertvector(v, bf16x2_t)); }
DI void unpack8(u32x4 w, float (&f)[8]) { f[0] = bflo(w.x); f[1] = bfhi(w.x); f[2] = bflo(w.y); f[3] = bfhi(w.y); f[4] = bflo(w.z); f[5] = bfhi(w.z); f[6] = bflo(w.w); f[7] = bfhi(w.w); }
DI u32x4 pack8f(const float (&f)[8]) { u32x4 w; w.x = pk2(f[0], f[1]); w.y = pk2(f[2], f[3]); w.z = pk2(f[4], f[5]); w.w = pk2(f[6], f[7]); return w; }
template <int X> DI float sx(float v) { return __builtin_bit_cast(float, __builtin_amdgcn_ds_swizzle(__builtin_bit_cast(int, v), 0x1F | (X << 10))); }
DI float lx(float v, int lane, int X) { return __builtin_bit_cast(float, __builtin_amdgcn_ds_bpermute((lane ^ X) << 2, __builtin_bit_cast(int, v))); }
DI float wave_sum(float v, int lane) {
    v += sx<1>(v); v += sx<2>(v); v += sx<4>(v); v += lx(v, lane, 8); v += lx(v, lane, 16); v += lx(v, lane, 32);
    return v;
}
DI float sigmoidf_(float x) { return __builtin_amdgcn_rcpf(1.f + __expf(-x)); }
DI float tanhf_(float x) { return 1.f - 2.f * __builtin_amdgcn_rcpf(1.f + __expf(2.f * x)); }
DI float softplusf_(float x) { const float e = __expf(x); return x > 20.f ? x : (x < -9.f ? e * (1.f - 0.5f * e) : __logf(1.f + e)); }
#define LDS_BARRIER() do { asm volatile("s_waitcnt lgkmcnt(0)" ::: "memory"); __builtin_amdgcn_s_barrier(); asm volatile("" ::: "memory"); } while (0)
#define LDS_WAIT() asm volatile("s_waitcnt lgkmcnt(0)" ::: "memory")
#define MFMA16(a, b, c) __builtin_amdgcn_mfma_f32_16x16x32_bf16((a), (b), (c), 0, 0, 0)

#define XB_TMO      128
#define XB_XCNT(j)  (256  + 64 * (j))
#define XB_XSUB(j)  (1280 + 64 * (j))
#define XB_XGEN(j)  (2304 + 64 * (j))
#define XB_TOP      3328
#define XB_TOPGEN   3392
#define XCD_BAR_WORDS 3456
#define XB_SPIN_CAP (1u << 22)
__device__ __forceinline__ unsigned xb_ld(unsigned* p)              { return __hip_atomic_load(p, __ATOMIC_RELAXED, __HIP_MEMORY_SCOPE_AGENT); }
__device__ __forceinline__ unsigned xb_add(unsigned* p, unsigned v) { return __hip_atomic_fetch_add(p, v, __ATOMIC_RELAXED, __HIP_MEMORY_SCOPE_AGENT); }
__device__ __forceinline__ unsigned xb_xcc_id() { return (unsigned)__builtin_amdgcn_s_getreg((3 << 11) | 20) & 0xFu; }
#define XB_SPIN(cond, bar) do { unsigned _sp = 0; while (cond) { __builtin_amdgcn_s_sleep(1); \
    if ((++_sp & 255u) == 0u) { if (xb_ld(&(bar)[XB_TMO])) break; if (_sp > XB_SPIN_CAP) { atomicAdd(&(bar)[XB_TMO], 1u); break; } } } } while (0)
struct XcdBarrier { unsigned* bar; unsigned x; volatile LAS unsigned* st; };
__device__ __forceinline__ XcdBarrier xcd_barrier_post(unsigned* bar, volatile LAS unsigned* st) {
    XcdBarrier b; b.bar = bar; b.x = xb_xcc_id(); b.st = st;
    if (threadIdx.x == 0) (void)xb_add(&bar[XB_XCNT(b.x)], 1u);
    return b;
}
__device__ __forceinline__ void xcd_barrier_complete(unsigned* bar, unsigned x, unsigned& nloc, unsigned& nx) {
    const unsigned G = gridDim.x * gridDim.y * gridDim.z;
    unsigned sum, cnt, mine, sp = 0u;
    for (;;) {
        sum = 0u; cnt = 0u; mine = 0u;
#pragma unroll
        for (unsigned j = 0; j < 16; ++j) { const unsigned c = xb_ld(&bar[XB_XCNT(j)]); sum += c; cnt += (c > 0u) ? 1u : 0u; mine = (j == x) ? c : mine; }
        if (sum == G) break;
        __builtin_amdgcn_s_sleep(1);
        if ((++sp & 255u) == 0u) { if (xb_ld(&bar[XB_TMO])) break; if (sp > XB_SPIN_CAP) { atomicAdd(&bar[XB_TMO], 1u); break; } }
    }
    nloc = mine > 0u ? mine : 1u; nx = cnt > 0u ? cnt : 1u;
}
__device__ __forceinline__ void xcd_barrier(const XcdBarrier& b) {
    asm volatile("s_waitcnt vmcnt(0)" ::: "memory");
    __syncthreads();
    if (threadIdx.x == 0) {
        unsigned* bar = b.bar;
        __builtin_amdgcn_s_waitcnt(0);
        unsigned nloc = b.st[0], nx = b.st[1];
        if (nloc == 0u) { xcd_barrier_complete(bar, b.x, nloc, nx); b.st[0] = nloc; b.st[1] = nx; }
        const unsigned old = xb_add(&bar[XB_XSUB(b.x)], 1u);
        const unsigned gen = old / nloc;
        if (old + 1u == (gen + 1u) * nloc) {
            __builtin_amdgcn_fence(__ATOMIC_RELEASE, "agent");
            asm volatile("s_waitcnt vmcnt(0)" ::: "memory");
            const unsigned og = xb_add(&bar[XB_TOP], 1u);
            const unsigned tg = og / nx;
            if (og + 1u == (tg + 1u) * nx) xb_add(&bar[XB_TOPGEN], 1u);
            else XB_SPIN(xb_ld(&bar[XB_TOPGEN]) == tg, bar);
            __builtin_amdgcn_fence(__ATOMIC_ACQUIRE, "agent");
            xb_add(&bar[XB_XGEN(b.x)], 1u);
            asm volatile("s_waitcnt vmcnt(0)" ::: "memory");
        } else {
            XB_SPIN(xb_ld(&bar[XB_XGEN(b.x)]) == gen, bar);
            __builtin_amdgcn_fence(__ATOMIC_ACQUIRE, "agent");
            asm volatile("s_waitcnt vmcnt(0)" ::: "memory");
        }
    }
    __syncthreads();
}

DI int row_of(int b, int dir, int ci, int i) {
    int s;
    if (dir == 0) s = ci * 64 + i;
    else s = (ci < 4) ? (3 - ci) * 64 + (63 - i) : 256 + (67 - ci) * 64 + (63 - i);
    return b * cf::SEGT + s;
}
DI void transpose_item(const float* W, int K, int N, bf16* WT, int out_row0, int k0, int n0, LAS float* scr, int lane) {
    const int n = n0 + (lane & 31); const bool ok = n < N;
#pragma unroll 8
    for (int i = 0; i < 32; ++i) { const int kk = 2 * i + (lane >> 5); scr[kk * 33 + (lane & 31)] = ok ? W[(size_t)(k0 + kk) * N + n] : 0.f; }
    LDS_WAIT();
    const int c = lane & 7;
#pragma unroll
    for (int j = 0; j < 4; ++j) { const int nn = (lane >> 3) + 8 * j; const LAS float* s = scr + (8 * c) * 33 + nn;
        u32x4 o; o.x = pk2(s[0 * 33], s[1 * 33]); o.y = pk2(s[2 * 33], s[3 * 33]); o.z = pk2(s[4 * 33], s[5 * 33]); o.w = pk2(s[6 * 33], s[7 * 33]);
        *(u32x4*)(WT + (size_t)(out_row0 + nn) * K + k0 + 8 * c) = o; }
    LDS_WAIT();
}

struct In { const float* p[34]; };

DI void phase_prologue(const In& in, uchar* ws, LAS uchar* lds, int G, int bx, int tid) {
    using namespace cf;
    const int lane = tid & 63, wid = __builtin_amdgcn_readfirstlane(tid >> 6), gw = bx * 8 + wid, NGW = G * 8;
    LAS float* scr = (LAS float*)(lds + wid * 16384);
    constexpr int I_IN = 32 * 160, I_OUT = 32 * 64, I_G = 32 * 176, I_DN = 88 * 64, I_UQ = 8 * 48, I_UKV = 8 * 64;
    constexpr int I_LAYER = I_IN + I_OUT + 2 * I_G + I_DN + I_UQ + I_UKV;
    for (int it = gw; it < DEPTH * I_LAYER; it += NGW) {
        const int l = it / I_LAYER; int r = it % I_LAYER;
        if (r < I_IN) { const int kb = r / 160, nb = r % 160; transpose_item(in.p[6] + (size_t)l * D * IN_COLS, D, IN_COLS, (bf16*)(ws + WS_WIN) + (size_t)l * PC * D, nb * 32, kb * 64, nb * 32, scr, lane); continue; } r -= I_IN;
        if (r < I_OUT) { const int kb = r / 64, nb = r % 64; transpose_item(in.p[26] + (size_t)l * D * D, D, D, (bf16*)(ws + WS_WOUT) + (size_t)l * D * D, nb * 32, kb * 64, nb * 32, scr, lane); continue; } r -= I_OUT;
        if (r < 2 * I_G) { const int up = r >= I_G; if (up) r -= I_G; const int kb = r / 176, nb = r % 176, n0 = nb * 32;
            transpose_item(in.p[up ? 30 : 29] + (size_t)l * D * DFF, D, DFF, (bf16*)(ws + WS_WGU) + (size_t)l * 2 * DFF * D, 256 * (n0 / 128) + (n0 % 128) + (up ? 128 : 0), kb * 64, n0, scr, lane); continue; } r -= 2 * I_G;
        if (r < I_DN) { const int kb = r / 64, nb = r % 64; transpose_item(in.p[31] + (size_t)l * DFF * D, DFF, D, (bf16*)(ws + WS_WDN) + (size_t)l * D * DFF, nb * 32, kb * 64, nb * 32, scr, lane); continue; } r -= I_DN;
        if (r < I_UQ) { const int kb = r / 48, nb = r % 48; transpose_item(in.p[9] + (size_t)l * 512 * 1536, 512, 1536, (bf16*)(ws + WS_WUQ) + (size_t)l * 1536 * 512, nb * 32, kb * 64, nb * 32, scr, lane); continue; } r -= I_UQ;
        { const int kb = r / 64, nb = r % 64; transpose_item(in.p[10] + (size_t)l * 512 * 2048, 512, 2048, (bf16*)(ws + WS_WUKV) + (size_t)l * 2048 * 512, nb * 32, kb * 64, nb * 32, scr, lane); }
    }
    float* X = (float*)(ws + WS_X);
    for (int r = gw; r < M; r += NGW) { const int b = r / SEGT, s = r % SEGT;
        const float* src = (s < CTX) ? in.p[2] + ((size_t)b * CTX + s) * D : in.p[0] + ((size_t)b * SEQ + (s - CTX)) * D;
        const f32x4* sp = (const f32x4*)src + lane; f32x4* dp = (f32x4*)(X + (size_t)r * D) + lane;
#pragma unroll
        for (int j = 0; j < 8; ++j) dp[64 * j] = sp[64 * j]; }
    const int gt = bx * 512 + tid, NGT = G * 512;
    float* rope = (float*)(ws + WS_ROPE);
    for (int i = gt; i < 1024; i += NGT) { const int pos = i >> 4, f = i & 15; const float inv = powf(10000.f, -(float)f / 16.f), ang = (float)pos * inv; rope[i] = cosf(ang); rope[1024 + i] = sinf(ang); }
    bf16* W2T = (bf16*)(ws + WS_W2T); bf16* A2T = (bf16*)(ws + WS_A2T); bf16* G2T = (bf16*)(ws + WS_G2T);
    for (int i = gt; i < DEPTH * 2 * 512 * 32; i += NGT) { const int r = i & 31, c = (i >> 5) & 511, ld = i >> 14;
        W2T[i] = f2bf(in.p[13][((size_t)ld * 32 + r) * 512 + c]); A2T[i] = f2bf(in.p[15][((size_t)ld * 32 + r) * 512 + c]); }
    for (int i = gt; i < DEPTH * 512 * 96; i += NGT) { const int k = i % 96, c = (i / 96) % 512, l = i / (96 * 512);
        G2T[i] = f2bf(in.p[16][((size_t)l * 96 + k) * 512 + c]); }
    LAS float* sv = scr;
    for (int it = gw; it < DEPTH * 48 * 16; it += NGW) {
        const int kp = it & 15, ng = (it >> 4) % 48, l = it / (16 * 48);
        for (int i = lane; i < 640; i += 64) { const int v = i >> 7, k = kp * 128 + (i & 127); const float x = (v < 4) ? in.p[1][v * D + k] : in.p[3][k]; sv[i] = x * sigmoidf_(x); }
        LDS_WAIT();
        const int n = ng * 256 + lane * 4;
        const float* wp = in.p[4] + ((size_t)l * D + (size_t)kp * 128) * MODS + n;
        f32x4 acc[5];
#pragma unroll
        for (int v = 0; v < 5; ++v) acc[v] = (f32x4){0.f, 0.f, 0.f, 0.f};
#pragma unroll 8
        for (int kk = 0; kk < 128; ++kk) { const f32x4 w = *(const f32x4*)(wp + (size_t)kk * MODS);
#pragma unroll
            for (int v = 0; v < 5; ++v) acc[v] += w * sv[v * 128 + kk]; }
        float* part = (float*)(ws + WS_P) + (size_t)kp * (DEPTH * 5 * MODS);
#pragma unroll
        for (int v = 0; v < 5; ++v) *(f32x4*)(part + ((size_t)l * 5 + v) * MODS + n) = acc[v];
        LDS_WAIT();
    }
}

DI void phase_modreduce(const In& in, uchar* ws, int G, int bx, int tid) {
    using namespace cf;
    float* modv = (float*)(ws + WS_MODV); const float* part = (const float*)(ws + WS_P);
    for (int i = bx * 512 + tid; i < DEPTH * 5 * MODS / 4; i += G * 512) { const int n4 = i % (MODS / 4), l = i / (5 * MODS / 4);
        f32x4 s = *(const f32x4*)(in.p[5] + (size_t)l * MODS + n4 * 4);
#pragma unroll
        for (int kp = 0; kp < 16; ++kp) s += *(const f32x4*)(part + (size_t)kp * (DEPTH * 5 * MODS) + (size_t)i * 4);
        *(f32x4*)(modv + (size_t)i * 4) = s; }
}

DI void phase_modulate(const float* X, bf16* XM, const float* modl  , int shift_off, int scale_off, int G, int bx, int tid) {
    using namespace cf;
    const int lane = tid & 63, gw = bx * 8 + __builtin_amdgcn_readfirstlane(tid >> 6), NGW = G * 8;
    for (int r = gw; r < M; r += NGW) { const int b = r / SEGT, s = r % SEGT, vec = (s < CTX) ? 4 : b;
        const f32x4* xp = (const f32x4*)(X + (size_t)r * D) + lane; const f32x4* sh = (const f32x4*)(modl + (size_t)vec * MODS + shift_off) + lane; const f32x4* sc = (const f32x4*)(modl + (size_t)vec * MODS + scale_off) + lane;
        u32x2* op = (u32x2*)(XM + (size_t)r * D) + lane;
#pragma unroll
        for (int j = 0; j < 8; ++j) { const f32x4 v = xp[64 * j] * (sc[64 * j] + 1.f) + sh[64 * j]; u32x2 o; o.x = pk2(v.x, v.y); o.y = pk2(v.z, v.w); op[64 * j] = o; } }
}

DI void ln_one_row(float* X, f32x4 (&v)[8], int r, const float* g, const float* bb, bf16* XM, const float* modl, int shift_off, int scale_off, float* out, const float* part, int nparts, const float* cgate, int lane) {
    using namespace cf;
    const int b = r / SEGT, s = r % SEGT, vec = (s < CTX) ? 4 : b;
    f32x4* xp = (f32x4*)(X + (size_t)r * D) + lane;
    float sum = 0.f;
    if (part && s < CTX) {
        const f32x4* gp4 = (const f32x4*)cgate + lane;
#pragma unroll
        for (int j = 0; j < 8; ++j) { f32x4 a = (f32x4){0.f, 0.f, 0.f, 0.f};
            for (int ks = 0; ks < nparts; ++ks) a += *((const f32x4*)(part + ((size_t)ks * 1024 + b * 256 + s) * D) + lane + 64 * j);
            v[j] = v[j] * ALPHA + gp4[64 * j] * a; } }
#pragma unroll
    for (int j = 0; j < 8; ++j) sum += (v[j].x + v[j].y) + (v[j].z + v[j].w);
    const float mean = wave_sum(sum, lane) * (1.f / D); float s2 = 0.f;
#pragma unroll
    for (int j = 0; j < 8; ++j) { v[j] = v[j] - mean; s2 += (v[j].x * v[j].x + v[j].y * v[j].y) + (v[j].z * v[j].z + v[j].w * v[j].w); }
    const float rstd = rsqrtf(wave_sum(s2, lane) * (1.f / D) + 1e-5f);
    const f32x4* gp = (const f32x4*)g + lane; const f32x4* bp = (const f32x4*)bb + lane;
#pragma unroll
    for (int j = 0; j < 8; ++j) v[j] = v[j] * rstd * gp[64 * j] + bp[64 * j];
    if (out) { f32x4* op = (f32x4*)(out + ((size_t)b * SEQ + (s - CTX)) * D) + lane;
#pragma unroll
        for (int j = 0; j < 8; ++j) op[64 * j] = v[j];
    } else {
        const f32x4* sh = (const f32x4*)(modl + (size_t)vec * MODS + shift_off) + lane; const f32x4* sc = (const f32x4*)(modl + (size_t)vec * MODS + scale_off) + lane;
        u32x2* op = (u32x2*)(XM + (size_t)r * D) + lane;
#pragma unroll
        for (int j = 0; j < 8; ++j) { xp[64 * j] = v[j]; const f32x4 m = v[j] * (sc[64 * j] + 1.f) + sh[64 * j]; u32x2 o; o.x = pk2(m.x, m.y); o.y = pk2(m.z, m.w); op[64 * j] = o; }
    }
}
DI void phase_ln(float* X, const float* g, const float* bb, bf16* XM, const float* modl, int shift_off, int scale_off, float* out, const float* part, int nparts, const float* cgate, bool skip_ctx, int G, int bx, int tid) {
    using namespace cf;
    const int lane = tid & 63, gw = bx * 8 + __builtin_amdgcn_readfirstlane(tid >> 6), NGW = G * 8;
    for (int r0 = gw; r0 < M; r0 += 2 * NGW) {
        const int r1 = r0 + NGW;
        const bool do0 = !(skip_ctx && (r0 % SEGT) < CTX), do1 = r1 < M && !(skip_ctx && (r1 % SEGT) < CTX);
        f32x4 va[8], vb[8];
        if (do0) { const f32x4* xp = (const f32x4*)(X + (size_t)r0 * D) + lane;
#pragma unroll
            for (int j = 0; j < 8; ++j) va[j] = xp[64 * j]; }
        if (do1) { const f32x4* xp = (const f32x4*)(X + (size_t)r1 * D) + lane;
#pragma unroll
            for (int j = 0; j < 8; ++j) vb[j] = xp[64 * j]; }
        if (do0) ln_one_row(X, va, r0, g, bb, XM, modl, shift_off, scale_off, out, part, nparts, cgate, lane);
        if (do1) ln_one_row(X, vb, r1, g, bb, XM, modl, shift_off, scale_off, out, part, nparts, cgate, lane);
    }
}

DI void mla_prep_rows(const bf16* P, bf16* CQN, bf16* CKVN, bf16* Kb, const float* qn, const float* kvn, const float* rope, int G, int bx, int tid) {
    using namespace cf;
    const int lane = tid & 63, gw = bx * 8 + __builtin_amdgcn_readfirstlane(tid >> 6), NGW = G * 8;
    const f32x4 gq0 = *(const f32x4*)(qn + lane * 8), gq1 = *(const f32x4*)(qn + lane * 8 + 4), gk0 = *(const f32x4*)(kvn + lane * 8), gk1 = *(const f32x4*)(kvn + lane * 8 + 4);
    const int axis = lane >> 5, half = (lane >> 4) & 1, f = lane & 15;
    for (int r0 = gw; r0 < M; r0 += 2 * NGW) {
        const int r1 = (r0 + NGW < M) ? r0 + NGW : r0;
        const bf16* pa = P + (size_t)r0 * PC; const bf16* pb = P + (size_t)r1 * PC;
        const u32x4 a0 = *(const u32x4*)(pa + lane * 8), a1 = *(const u32x4*)(pa + 512 + lane * 8), b0 = *(const u32x4*)(pb + lane * 8), b1 = *(const u32x4*)(pb + 512 + lane * 8);
        const bf16 ka = pa[C_KR + lane], kb = pb[C_KR + lane];
#pragma unroll
        for (int rr = 0; rr < 2; ++rr) { const int r = rr ? r1 : r0, s = r % SEGT;
#pragma unroll
            for (int part = 0; part < 2; ++part) {
                float x[8]; unpack8(rr ? (part ? b1 : b0) : (part ? a1 : a0), x);
                float ss = 0.f;
#pragma unroll
                for (int e = 0; e < 8; ++e) ss += x[e] * x[e];
                const float rs = rsqrtf(wave_sum(ss, lane) * (1.f / 512.f) + 1e-6f);
                const f32x4 g0 = part ? gk0 : gq0, g1 = part ? gk1 : gq1;
                float o[8];
#pragma unroll
                for (int e = 0; e < 8; ++e) o[e] = x[e] * rs * (e < 4 ? g0[e] : g1[e - 4]);
                *(u32x4*)((part ? CKVN : CQN) + (size_t)r * 512 + lane * 8) = pack8f(o);
            }
            float kr = bf2f(rr ? kb : ka);
            const float other = lx(kr, lane, 16);
            if (s >= CTX) { const int t = s - CTX, pos = axis ? (t & 63) : (t >> 6);
                const float c = rope[pos * 16 + f], sn = rope[1024 + pos * 16 + f];
                kr = half ? (other * sn + kr * c) : (kr * c - other * sn); }
            const bf16 kq = f2bf(kr);
#pragma unroll
            for (int h = 0; h < 8; ++h) Kb[(size_t)r * KP + h * 192 + 128 + lane] = kq;
        }
    }
}

DI void mix_rows(const bf16* P, const float* YR, const float* YG, const float* GATE, const float* BONUS, bf16* MIX,
                 const float* mu, const float* gn_g, const float* gn_b, const float* gdn_norm, int G, int bx, int tid) {
    using namespace cf;
    const int lane = tid & 63, gw = bx * 8 + __builtin_amdgcn_readfirstlane(tid >> 6), NGW = G * 8;
#pragma unroll 2
    for (int r = gw; r < M; r += NGW) { const int s = r % SEGT; const bf16* pr = P + (size_t)r * PC;
        const bool hasp = (s != 0) && (s != CTX), hasn = (s != CTX - 1) && (s != SEGT - 1);
        const int c0 = lane * 8;
        {
            float y[8], v[8];
            { const f32x4 a0 = *(const f32x4*)(YR + (size_t)r * 512 + c0), a1 = *(const f32x4*)(YR + (size_t)r * 512 + c0 + 4);
              const f32x4 b0 = *(const f32x4*)(YR + ((size_t)M + r) * 512 + c0), b1 = *(const f32x4*)(YR + ((size_t)M + r) * 512 + c0 + 4);
#pragma unroll
              for (int e = 0; e < 4; ++e) { y[e] = a0[e] + b0[e]; y[4 + e] = a1[e] + b1[e]; } }
            float sm = 0.f;
#pragma unroll
            for (int e = 0; e < 8; ++e) sm += y[e];
            sm += sx<1>(sm); sm += sx<2>(sm); sm += sx<4>(sm);
            const float mean = sm * (1.f / 64.f); float q = 0.f;
#pragma unroll
            for (int e = 0; e < 8; ++e) { y[e] -= mean; q += y[e] * y[e]; }
            q += sx<1>(q); q += sx<2>(q); q += sx<4>(q);
            const float rstd = rsqrtf(q * (1.f / 64.f) + 64e-5f);
            { float cur[8], prv[8], nxt[8]; const int col = C_RW + RW_V + c0;
              unpack8(*(const u32x4*)(pr + col), cur);
              if (hasp) unpack8(*(const u32x4*)(pr - PC + col), prv); else {
#pragma unroll
                  for (int e = 0; e < 8; ++e) prv[e] = 0.f; }
              if (hasn) unpack8(*(const u32x4*)(pr + PC + col), nxt); else {
#pragma unroll
                  for (int e = 0; e < 8; ++e) nxt[e] = 0.f; }
              const f32x4 m0 = *(const f32x4*)(mu + RW_V + c0), m1 = *(const f32x4*)(mu + RW_V + c0 + 4);
#pragma unroll
              for (int e = 0; e < 8; ++e) v[e] = cur[e] + (0.5f * (prv[e] + nxt[e]) - cur[e]) * (e < 4 ? m0[e] : m1[e - 4]); }
            const int h = lane >> 3;
            const float bonus = BONUS[(size_t)r * 8 + h] + BONUS[((size_t)M + r) * 8 + h];
            const f32x4 gg0 = *(const f32x4*)(gn_g + c0), gg1 = *(const f32x4*)(gn_g + c0 + 4), gb0 = *(const f32x4*)(gn_b + c0), gb1 = *(const f32x4*)(gn_b + c0 + 4);
            const f32x4 gt0 = *(const f32x4*)(GATE + (size_t)r * 512 + c0), gt1 = *(const f32x4*)(GATE + (size_t)r * 512 + c0 + 4);
            float o[8];
#pragma unroll
            for (int e = 0; e < 8; ++e) o[e] = (y[e] * rstd * (e < 4 ? gg0[e] : gg1[e - 4]) + (e < 4 ? gb0[e] : gb1[e - 4]) + bonus * v[e]) * (e < 4 ? gt0[e] : gt1[e - 4]);
            *(u32x4*)(MIX + (size_t)r * D + 1024 + c0) = pack8f(o);
        }
        {
            float y[8], z[8];
            { const f32x4 a0 = *(const f32x4*)(YG + (size_t)r * 512 + c0), a1 = *(const f32x4*)(YG + (size_t)r * 512 + c0 + 4);
              const f32x4 b0 = *(const f32x4*)(YG + ((size_t)M + r) * 512 + c0), b1 = *(const f32x4*)(YG + ((size_t)M + r) * 512 + c0 + 4);
#pragma unroll
              for (int e = 0; e < 4; ++e) { y[e] = a0[e] + b0[e]; y[4 + e] = a1[e] + b1[e]; } }
            float q = 0.f;
#pragma unroll
            for (int e = 0; e < 8; ++e) q += y[e] * y[e];
            q += sx<1>(q); q += sx<2>(q); q += sx<4>(q); q += lx(q, lane, 8);
            const float rs = rsqrtf(q * (1.f / 128.f) + 1e-6f);
            unpack8(*(const u32x4*)(pr + C_GD + GD_Z + c0), z);
            const int cn = c0 & 127; const f32x4 n0 = *(const f32x4*)(gdn_norm + cn), n1 = *(const f32x4*)(gdn_norm + cn + 4);
            float o[8];
#pragma unroll
            for (int e = 0; e < 8; ++e) o[e] = y[e] * rs * (e < 4 ? n0[e] : n1[e - 4]) * (z[e] * sigmoidf_(z[e]));
            *(u32x4*)(MIX + (size_t)r * D + 1536 + c0) = pack8f(o);
        }
    }
}
#define FRAGOFF(R, C, KS) ((((R) >> 4) * (KS) + ((C) >> 5)) * 1024 + ((((C) >> 3) & 3) * 16 + ((R) & 15)) * 16 + ((C) & 7) * 2)
template <int K> DI f32x4 mm_tile(const LAS bf16* A, int lda, const LAS bf16* Bt, int ldb, int tm, int tn, f32x4 acc, int lane) {
    const int r = lane & 15, q = lane >> 4;
#pragma unroll
    for (int k0 = 0; k0 < K; k0 += 32) {
        const bf16x8 a = *(const LAS bf16x8*)(A + (16 * tm + r) * lda + k0 + q * 8);
        const bf16x8 b = *(const LAS bf16x8*)(Bt + (16 * tn + r) * ldb + k0 + q * 8);
        acc = MFMA16(a, b, acc);
    }
    return acc;
}
template <int NCL>
DI void inv_offblock(const LAS float* A, LAS float* TF, LAS bf16* TT, LAS float* scr, int i, int j, int c0, int lane) {
    const int r = lane & 15, q = lane >> 4, cb = c0 + q * NCL;
    float p[NCL];
#pragma unroll
    for (int e = 0; e < NCL; ++e) p[e] = 0.f;
    for (int kb = j; kb < i; ++kb) {
#pragma unroll
        for (int s = 0; s < 16; ++s) { const float a = A[(16 * i + r) * 65 + 16 * kb + s]; const LAS float* tp = TF + (16 * kb + s) * 65 + 16 * j + cb;
#pragma unroll
            for (int e = 0; e < NCL; ++e) p[e] += a * tp[e]; }
    }
#pragma unroll
    for (int e = 0; e < NCL; ++e) scr[r * 17 + q * NCL + e] = p[e];
    LDS_WAIT();
    float o[NCL];
#pragma unroll
    for (int e = 0; e < NCL; ++e) o[e] = 0.f;
#pragma unroll
    for (int s = 0; s < 16; ++s) { const float t = TF[(16 * i + r) * 65 + 16 * i + s];
#pragma unroll
        for (int e = 0; e < NCL; ++e) o[e] += t * scr[s * 17 + q * NCL + e]; }
#pragma unroll
    for (int e = 0; e < NCL; ++e) { TF[(16 * i + r) * 65 + 16 * j + cb + e] = o[e]; TT[(16 * i + r) * 72 + 16 * j + cb + e] = f2bf(o[e]); }
}
template <class Side>
DI void inv_blocked(const LAS float* A, LAS float* TF, LAS bf16* TT, LAS float* scr_all, int wid, int lane, int tid, const Side& side) {
    if (wid < 4) { if (lane < 16) { const int j = lane, base = 16 * wid; float tc[16];
#pragma unroll
        for (int t = 0; t < 16; ++t) { float acc = (t == j) ? 1.f : 0.f;
#pragma unroll
            for (int s = 0; s < t; ++s) acc += A[(base + t) * 65 + base + s] * tc[s];
            tc[t] = acc; }
#pragma unroll
        for (int t = 0; t < 16; ++t) { TF[(base + t) * 65 + base + j] = tc[t]; TT[(base + t) * 72 + base + j] = f2bf(tc[t]); }
    } } else side(wid - 4);
    LDS_BARRIER();
    LAS float* scr = scr_all + wid * 272;
    if (wid < 6) inv_offblock<2>(A, TF, TT, scr, (wid >> 1) + 1, wid >> 1, (wid & 1) * 8, lane);
    LDS_BARRIER();
    inv_offblock<1>(A, TF, TT, scr, (wid >> 2) + 2, wid >> 2, (wid & 3) * 4, lane);
    LDS_BARRIER();
    if (wid < 4) inv_offblock<1>(A, TF, TT, scr, 3, 0, wid * 4, lane);
    LDS_BARRIER();
}

struct ScanW {
    const float *mu, *w0, *a0, *k_k, *k_a, *r_k;
    const bf16 *W2T, *A2T, *G2T;
    const float *conv, *a_log, *dt_bias;
};

constexpr int RWB = 136192, RWB_W2 = RWB + 2688, RWB_A2 = RWB_W2 + 5120, RWB_G2 = RWB_A2 + 5120;
constexpr int GDB = 143360;
DI void rw_stage_weights(LAS uchar* lds, const ScanW& sw, int h, int dir, int tid) {
    LAS float* WF = (LAS float*)(lds + RWB);
    for (int i = tid; i < 672; i += 512) { float v;
        if (i < 64) v = sw.w0[dir * 512 + h * 64 + i]; else if (i < 128) v = sw.a0[dir * 512 + h * 64 + i - 64]; else if (i < 192) v = sw.k_k[h * 64 + i - 128];
        else if (i < 256) v = sw.k_a[h * 64 + i - 192]; else if (i < 320) v = sw.r_k[h * 64 + i - 256];
        else if (i < 512) v = sw.mu[((i - 320) >> 6) * 512 + h * 64 + ((i - 320) & 63)];
        else if (i < 544) v = sw.mu[cf::RW_WD + dir * 32 + i - 512]; else if (i < 576) v = sw.mu[cf::RW_AD + dir * 32 + i - 544]; else v = sw.mu[cf::RW_GD + i - 576];
        WF[i] = v; }
    { const int which = tid >> 8, t = tid & 255, row = t >> 2, ch = t & 3;
      *(LAS u32x4*)(lds + (which ? RWB_A2 : RWB_W2) + (row * 40 + ch * 8) * 2) = *(const u32x4*)((which ? sw.A2T : sw.W2T) + ((size_t)dir * 512 + h * 64 + row) * 32 + ch * 8); }
    LDS_BARRIER();
}
DI void gd_stage_weights(LAS uchar* lds, const ScanW& sw, int h, int tid) {
    LAS float* CW = (LAS float*)(lds + GDB);
    for (int i = tid; i < 1920; i += 512) { const int jw = i >> 7, c = i & 127; CW[i] = sw.conv[(size_t)(jw / 3) * 1536 + (jw % 3) * 512 + h * 128 + c]; }
    LDS_BARRIER();
}

struct RwRaw { u32x4 c[3]; };
DI void rw_issue(RwRaw& q, const bf16* P, int b, int h, int dir, int ci, int tid) {
    using namespace cf;
    const int i = tid >> 3, sub = tid & 7;
    const int R = row_of(b, dir, ci, i), seg_lo = b * SEGT + (ci < 4 ? 0 : CTX), seg_hi = b * SEGT + (ci < 4 ? CTX : SEGT);
    const bf16* pr = P + (size_t)R * PC + C_RW; (void)seg_lo; (void)seg_hi;
#pragma unroll
    for (int w = 0; w < 3; ++w) { const int col = w * 512 + h * 64 + sub * 8;
        q.c[w] = *(const u32x4*)(pr + col); }
}

DI void s1_rwkv(LAS uchar* lds, const bf16* P, const ScanW& sw, uchar* task, float* GATE, float* BONUSd, int b, int h, int dir, int ci, int tid, unsigned& chk, int nb, int nci) {
    RwRaw raw;
    using namespace cf;
    constexpr int MB = 9216;
    LAS bf16* AT = (LAS bf16*)(lds + 0 * MB); LAS bf16* BT = (LAS bf16*)(lds + 1 * MB); LAS bf16* KT = (LAS bf16*)(lds + 2 * MB); LAS bf16* QT = (LAS bf16*)(lds + 3 * MB);
    LAS bf16* ATT = (LAS bf16*)(lds + 4 * MB); LAS bf16* VT = (LAS bf16*)(lds + 5 * MB); LAS bf16* KHT = (LAS bf16*)(lds + 6 * MB); LAS bf16* BHT = (LAS bf16*)(lds + 7 * MB);
    LAS bf16* AAK = (LAS bf16*)(lds + 8 * MB); LAS bf16* AQK = (LAS bf16*)(lds + 9 * MB); LAS bf16* TT = (LAS bf16*)(lds + 10 * MB); LAS bf16* XT = (LAS bf16*)(lds + 11 * MB);
    LAS float* AAB = (LAS float*)(lds + 12 * MB); LAS float* GC = AAB;
    LAS float* INVS = (LAS float*)(lds + 12 * MB + 16640);
    LAS float* LWf = (LAS float*)(lds + 8 * MB); LAS float* LAf = (LAS float*)(lds + 10 * MB); LAS float* TF = (LAS float*)(lds + 0);
    LAS bf16* WTT = (LAS bf16*)(lds + 0 * MB); LAS bf16* ULT = (LAS bf16*)(lds + 1 * MB); LAS bf16* AQBL = (LAS bf16*)(lds + RWB_G2);
    const LAS float* WF = (const LAS float*)(lds + RWB);
    LAS bf16* TW = (LAS bf16*)(lds + 0); LAS bf16* AD = (LAS bf16*)(lds + 5120); LAS bf16* SG = (LAS bf16*)(lds + 10240);
    const int lane = tid & 63, wid = __builtin_amdgcn_readfirstlane(tid >> 6), i = tid >> 3, sub = tid & 7, r16 = lane & 15, q4 = lane >> 4;
    const int R = row_of(b, dir, ci, i), seg_lo = b * SEGT + (ci < 4 ? 0 : CTX), seg_hi = b * SEGT + (ci < 4 ? CTX : SEGT);
    const bool hasp = R - 1 >= seg_lo, hasn = R + 1 < seg_hi;
    const bf16* pr = P + (size_t)R * PC + C_RW;
    float rv[8], kv[8], vv[8];
#ifndef RW_PREFETCH
    rw_issue(raw, P, b, h, dir, ci, tid);
#endif
#ifdef DUP_ST01
    for (int rp_ = 0; rp_ < 2; ++rp_) {
#endif
#pragma unroll
    for (int w = 0; w < 3; ++w) { const int col = w * 512 + h * 64 + sub * 8; float cur[8], prv[8], nxt[8];
        unpack8(raw.c[w], cur);
        if (hasp) unpack8(*(const u32x4*)(pr - PC + col), prv); else {
#pragma unroll
            for (int e = 0; e < 8; ++e) prv[e] = 0.f; }
        if (hasn) unpack8(*(const u32x4*)(pr + PC + col), nxt); else {
#pragma unroll
            for (int e = 0; e < 8; ++e) nxt[e] = 0.f; }
        const f32x4 m0 = *(const LAS f32x4*)(WF + 320 + w * 64 + sub * 8), m1 = *(const LAS f32x4*)(WF + 320 + w * 64 + sub * 8 + 4);
#pragma unroll
        for (int e = 0; e < 8; ++e) { const float x = cur[e] + (0.5f * (prv[e] + nxt[e]) - cur[e]) * (e < 4 ? m0[e] : m1[e - 4]); if (w == 0) rv[e] = x; else if (w == 1) kv[e] = x; else vv[e] = x; } }
#pragma unroll
    for (int w = 0; w < 2; ++w) { const int col = (w ? RW_AD : RW_WD) + dir * 32 + sub * 4;
        const u32x2 c2 = *(const u32x2*)(pr + col); u32x2 p2 = (u32x2){0u, 0u}, n2 = (u32x2){0u, 0u};
        if (hasp) p2 = *(const u32x2*)(pr - PC + col); if (hasn) n2 = *(const u32x2*)(pr + PC + col);
        const f32x4 m = *(const LAS f32x4*)(WF + 512 + w * 32 + sub * 4);
        const float cur[4] = {bflo(c2.x), bfhi(c2.x), bflo(c2.y), bfhi(c2.y)}, prv[4] = {bflo(p2.x), bfhi(p2.x), bflo(p2.y), bfhi(p2.y)}, nxt[4] = {bflo(n2.x), bfhi(n2.x), bflo(n2.y), bfhi(n2.y)};
        float x[4];
#pragma unroll
        for (int e = 0; e < 4; ++e) { x[e] = cur[e] + (0.5f * (prv[e] + nxt[e]) - cur[e]) * m[e]; if (w == 0) x[e] = tanhf_(x[e]); }
        u32x2 o; o.x = pk2(x[0], x[1]); o.y = pk2(x[2], x[3]);
        *(LAS u32x2*)((w ? AD : TW) + i * 40 + sub * 4) = o; }
    if (dir == 0) {
#pragma unroll
        for (int j = 0; j < 3; ++j) { const int col = RW_GD + sub * 12 + j * 4;
            const u32x2 c2 = *(const u32x2*)(pr + col); u32x2 p2 = (u32x2){0u, 0u}, n2 = (u32x2){0u, 0u};
            if (hasp) p2 = *(const u32x2*)(pr - PC + col); if (hasn) n2 = *(const u32x2*)(pr + PC + col);
            const f32x4 m = *(const LAS f32x4*)(WF + 576 + sub * 12 + j * 4);
            const float cur[4] = {bflo(c2.x), bfhi(c2.x), bflo(c2.y), bfhi(c2.y)}, prv[4] = {bflo(p2.x), bfhi(p2.x), bflo(p2.y), bfhi(p2.y)}, nxt[4] = {bflo(n2.x), bfhi(n2.x), bflo(n2.y), bfhi(n2.y)};
            float x[4];
#pragma unroll
            for (int e = 0; e < 4; ++e) x[e] = sigmoidf_(cur[e] + (0.5f * (prv[e] + nxt[e]) - cur[e]) * m[e]);
            u32x2 o; o.x = pk2(x[0], x[1]); o.y = pk2(x[2], x[3]);
            *(LAS u32x2*)(SG + i * 104 + sub * 12 + j * 4) = o; }
    }
    LDS_BARRIER();
    { const int which = wid >> 2, tm = wid & 3;
      const bf16x8 a = *(const LAS bf16x8*)((which ? AD : TW) + (16 * tm + r16) * 40 + q4 * 8);
      const LAS bf16* wt = (const LAS bf16*)(lds + (which ? RWB_A2 : RWB_W2));
#pragma unroll
      for (int tn = 0; tn < 4; ++tn) { const bf16x8 bb = *(const LAS bf16x8*)(wt + (16 * tn + r16) * 40 + q4 * 8);
          const f32x4 acc = MFMA16(a, bb, ((f32x4){0.f, 0.f, 0.f, 0.f}));
#pragma unroll
          for (int e = 0; e < 4; ++e) (which ? LAf : LWf)[(16 * tm + 4 * q4 + e) * 65 + 16 * tn + r16] = acc[e]; } }
    if (dir == 0) { const int tm = wid >> 1;
#pragma unroll
        for (int j = 0; j < 2; ++j) { const int tn = (wid & 1) * 2 + j; f32x4 acc = (f32x4){0.f, 0.f, 0.f, 0.f};
#pragma unroll
            for (int k0 = 0; k0 < 96; k0 += 32) { const bf16x8 a = *(const LAS bf16x8*)(SG + (16 * tm + r16) * 104 + k0 + q4 * 8);
                const bf16x8 bb = *(const bf16x8*)(sw.G2T + (size_t)(h * 64 + 16 * tn + r16) * 96 + k0 + q4 * 8); acc = MFMA16(a, bb, acc); }
#pragma unroll
            for (int e = 0; e < 4; ++e) GATE[(size_t)row_of(b, 0, ci, 16 * tm + 4 * q4 + e) * 512 + h * 64 + 16 * tn + r16] = acc[e]; } }
    LDS_BARRIER();
#ifdef DUP_ST01
    }
#endif
    float av[8], bv[8], kd[8], lw[8];
#ifdef S1DBG
    float dbgv[8];
#endif
#ifdef DUP_ST2A
    for (int rp_ = 0; rp_ < 2; ++rp_) {
#endif
    { const int hc = h * 64 + sub * 8; float ss = 0.f, bon = 0.f, kk[8], al[8];
#pragma unroll
      for (int e = 0; e < 8; ++e) { const int c = sub * 8 + e;
          const float wl = -softplusf_(-(WF[c] + LWf[i * 65 + c])) - 0.5f; lw[e] = -__expf(wl);
          al[e] = sigmoidf_(WF[64 + c] + LAf[i * 65 + c]);
          kk[e] = kv[e] * WF[128 + c]; ss += kk[e] * kk[e]; }
      ss += sx<1>(ss); ss += sx<2>(ss); ss += sx<4>(ss);
      const float rn = rsqrtf(ss + 1e-12f);
#pragma unroll
      for (int e = 0; e < 8; ++e) { kk[e] *= rn; kd[e] = kv[e] * (1.f + (al[e] - 1.f) * WF[192 + sub * 8 + e]); av[e] = -kk[e]; bv[e] = kk[e] * al[e]; bon += rv[e] * kd[e] * WF[256 + sub * 8 + e];
#ifdef S1DBG
          dbgv[e] = (S1DBG == 1) ? al[e] : kk[e];
#endif
      }
      bon += sx<1>(bon); bon += sx<2>(bon); bon += sx<4>(bon);
      if (sub == 0) BONUSd[(size_t)R * 8 + h] = bon;
#pragma unroll
      for (int e = 0; e < 8; ++e) GC[i * 64 + sub * 8 + e] = lw[e]; }
    LDS_BARRIER();
#ifdef DUP_ST2A
    }
#endif
    {
        LAS float* TOT = INVS;
        float g8[8]; float run = 0.f;
#pragma unroll
        for (int j = 0; j < 8; ++j) g8[j] = GC[(wid * 8 + j) * 64 + lane];
#pragma unroll
        for (int j = 0; j < 8; ++j) { run += g8[j]; g8[j] = run; }
        TOT[wid * 64 + lane] = run;
        LDS_BARRIER();
        float off = 0.f;
#pragma unroll
        for (int sgm = 0; sgm < 7; ++sgm) { const float tv = TOT[sgm * 64 + lane]; off += (sgm < wid) ? tv : 0.f; }
#pragma unroll
        for (int j = 0; j < 8; ++j) GC[(wid * 8 + j) * 64 + lane] = g8[j] + off;
    }
    LDS_BARRIER();
#ifdef DUP_ST2C
    for (int rp_ = 0; rp_ < 2; ++rp_) {
#endif
    { float at[8], bt[8], kt[8], qt[8], bh[8], kh[8];
#pragma unroll
      for (int e = 0; e < 8; ++e) { const int c = sub * 8 + e; const float Gi = GC[i * 64 + c], Gm = (i > 0) ? GC[(i - 1) * 64 + c] : 0.f, GL = GC[63 * 64 + c];
          const float eG = __expf(Gi), eGm = __expf(Gm), enG = __expf(-Gi), eLG = __expf(GL - Gi);
          at[e] = av[e] * eGm; bt[e] = bv[e] * enG; kt[e] = kd[e] * enG; qt[e] = rv[e] * eG;
#ifdef S1DBG
          qt[e] = dbgv[e];
#endif
          bh[e] = bv[e] * eLG; kh[e] = kd[e] * eLG;
          if (i == 63) ((float*)(task + 32768))[c] = eG; }
      *(LAS u32x4*)(AT + i * 72 + sub * 8) = pack8f(at); *(LAS u32x4*)(BT + i * 72 + sub * 8) = pack8f(bt); *(LAS u32x4*)(KT + i * 72 + sub * 8) = pack8f(kt); *(LAS u32x4*)(QT + i * 72 + sub * 8) = pack8f(qt);
#pragma unroll
      for (int e = 0; e < 8; ++e) { const int c = sub * 8 + e; ATT[c * 72 + i] = f2bf(at[e]); VT[c * 72 + i] = f2bf(vv[e]); KHT[c * 72 + i] = f2bf(kh[e]); BHT[c * 72 + i] = f2bf(bh[e]); } }
    LDS_BARRIER();
#ifdef DUP_ST2C
    }
#endif
#ifdef DUP_ST3
    for (int rp_ = 0; rp_ < 2; ++rp_) {
#endif
    RwRaw warm; rw_issue(warm, P, nb, h, dir, nci, tid);
    for (int z_ = tid; z_ < 64 * 72 / 8; z_ += 512) ((LAS u32x4*)TT)[z_] = (u32x4){0u, 0u, 0u, 0u};
    {
#define FRAG(Mx, row, k) (*(const LAS bf16x8*)((Mx) + (row) * 72 + (k) * 32 + q4 * 8))
      const int tm = wid >> 1;
      const bf16x8 a0 = FRAG(AT, 16 * tm + r16, 0), a1 = FRAG(AT, 16 * tm + r16, 1), q0 = FRAG(QT, 16 * tm + r16, 0), q1 = FRAG(QT, 16 * tm + r16, 1);
#pragma unroll
      for (int j = 0; j < 2; ++j) { const int tn = (wid & 1) * 2 + j; const f32x4 z = (f32x4){0.f, 0.f, 0.f, 0.f};
          f32x4 cab = z, cak = z, cqb = z, cqk = z;
          if (tm >= tn) { const bf16x8 b0 = FRAG(BT, 16 * tn + r16, 0), b1 = FRAG(BT, 16 * tn + r16, 1), k0 = FRAG(KT, 16 * tn + r16, 0), k1 = FRAG(KT, 16 * tn + r16, 1);
              cab = MFMA16(a0, b0, z); cab = MFMA16(a1, b1, cab); cak = MFMA16(a0, k0, z); cak = MFMA16(a1, k1, cak);
              cqb = MFMA16(q0, b0, z); cqb = MFMA16(q1, b1, cqb); cqk = MFMA16(q0, k0, z); cqk = MFMA16(q1, k1, cqk); }
#pragma unroll
          for (int e = 0; e < 4; ++e) { const int ti = 16 * tm + 4 * q4 + e, tj = 16 * tn + r16; const bool lo = ti > tj, le = ti >= tj;
              AAB[ti * 65 + tj] = lo ? cab[e] : 0.f; AAK[ti * 72 + tj] = f2bf(lo ? cak[e] : 0.f); AQBL[ti * 72 + tj] = f2bf(le ? cqb[e] : 0.f); AQK[ti * 72 + tj] = f2bf(le ? cqk[e] : 0.f); } }
#undef FRAG
    }
    LDS_BARRIER();
#ifdef DUP_ST3
    }
#endif
    inv_blocked(AAB, TF, TT, INVS, wid, lane, tid, [&](int sw_) {
#pragma unroll
        for (int j = 0; j < 4; ++j) { const int tm = sw_, tn = j;
            f32x4 acc = MFMA16(*(const LAS bf16x8*)(AAK + (16 * tm + r16) * 72 + q4 * 8), *(const LAS bf16x8*)(VT + (16 * tn + r16) * 72 + q4 * 8), ((f32x4){0.f, 0.f, 0.f, 0.f}));
            acc = MFMA16(*(const LAS bf16x8*)(AAK + (16 * tm + r16) * 72 + 32 + q4 * 8), *(const LAS bf16x8*)(VT + (16 * tn + r16) * 72 + 32 + q4 * 8), acc);
            u32x2 o; o.x = pk2(acc[0], acc[1]); o.y = pk2(acc[2], acc[3]); *(LAS u32x2*)(XT + (16 * tn + r16) * 72 + 16 * tm + 4 * q4) = o; } });
#ifdef DUP_ST6
    for (int rp_ = 0; rp_ < 2; ++rp_) {
#endif
    { const int mat = wid >> 2, tm = wid & 3; LAS bf16* dst = mat ? ULT : WTT; const LAS bf16* Bm = mat ? XT : ATT;
#define FRAG(Mx, row, k) (*(const LAS bf16x8*)((Mx) + (row) * 72 + (k) * 32 + q4 * 8))
      const bf16x8 t0 = FRAG(TT, 16 * tm + r16, 0), t1 = FRAG(TT, 16 * tm + r16, 1);
#pragma unroll
      for (int tn = 0; tn < 4; ++tn) { f32x4 acc = MFMA16(t0, FRAG(Bm, 16 * tn + r16, 0), ((f32x4){0.f, 0.f, 0.f, 0.f})); acc = MFMA16(t1, FRAG(Bm, 16 * tn + r16, 1), acc);
          u32x2 o; o.x = pk2(acc[0], acc[1]); o.y = pk2(acc[2], acc[3]); *(LAS u32x2*)(dst + (16 * tn + r16) * 72 + 16 * tm + 4 * q4) = o; }
#undef FRAG
    }
    LDS_BARRIER();
    {
#define FRAG(Mx, row, k) (*(const LAS bf16x8*)((Mx) + (row) * 72 + (k) * 32 + q4 * 8))
      const int tm = wid >> 1;
      const bf16x8 w0 = FRAG(WTT, 16 * tm + r16, 0), w1 = FRAG(WTT, 16 * tm + r16, 1), h0 = FRAG(BHT, 16 * tm + r16, 0), h1 = FRAG(BHT, 16 * tm + r16, 1);
      const bf16x8 k0 = FRAG(KHT, 16 * tm + r16, 0), k1 = FRAG(KHT, 16 * tm + r16, 1), a0 = FRAG(AQBL, 16 * tm + r16, 0), a1 = FRAG(AQBL, 16 * tm + r16, 1), g0 = FRAG(AQK, 16 * tm + r16, 0), g1 = FRAG(AQK, 16 * tm + r16, 1);
#pragma unroll
      for (int j = 0; j < 2; ++j) { const int tn = (wid & 1) * 2 + j; const f32x4 z = (f32x4){0.f, 0.f, 0.f, 0.f};
          { f32x4 acc = MFMA16(w0, FRAG(BHT, 16 * tn + r16, 0), z); acc = MFMA16(w1, FRAG(BHT, 16 * tn + r16, 1), acc);
            u32x2 o; o.x = pk2(acc[0], acc[1]); o.y = pk2(acc[2], acc[3]); *(u32x2*)(task + 0 + FRAGOFF(16 * tn + r16, 16 * tm + 4 * q4, 2)) = o; }
          { f32x4 acc = MFMA16(w0, FRAG(AQBL, 16 * tn + r16, 0), z); acc = MFMA16(w1, FRAG(AQBL, 16 * tn + r16, 1), acc);
            const u32x2 qq = *(const LAS u32x2*)(QT + (16 * tn + r16) * 72 + 16 * tm + 4 * q4);
            u32x2 o; o.x = pk2(acc[0] + bflo(qq.x), acc[1] + bfhi(qq.x)); o.y = pk2(acc[2] + bflo(qq.y), acc[3] + bfhi(qq.y)); *(u32x2*)(task + 8192 + FRAGOFF(16 * tn + r16, 16 * tm + 4 * q4, 2)) = o; }
          { f32x4 acc = MFMA16(h0, FRAG(ULT, 16 * tn + r16, 0), z); acc = MFMA16(h1, FRAG(ULT, 16 * tn + r16, 1), acc);
            acc = MFMA16(k0, FRAG(VT, 16 * tn + r16, 0), acc); acc = MFMA16(k1, FRAG(VT, 16 * tn + r16, 1), acc);
            u32x2 o; o.x = pk2(acc[0], acc[1]); o.y = pk2(acc[2], acc[3]); *(u32x2*)(task + 16384 + ((tm * 2 + (tn >> 1)) * 64 + lane) * 16 + (tn & 1) * 8) = o; }
          { f32x4 acc = MFMA16(a0, FRAG(ULT, 16 * tn + r16, 0), z); acc = MFMA16(a1, FRAG(ULT, 16 * tn + r16, 1), acc);
            acc = MFMA16(g0, FRAG(VT, 16 * tn + r16, 0), acc); acc = MFMA16(g1, FRAG(VT, 16 * tn + r16, 1), acc);
            u32x2 o; o.x = pk2(acc[0], acc[1]); o.y = pk2(acc[2], acc[3]); *(u32x2*)(task + 24576 + ((tm * 2 + (tn >> 1)) * 64 + lane) * 16 + (tn & 1) * 8) = o; } }
#undef FRAG
    }
    LDS_BARRIER();
    chk ^= warm.c[0].x ^ warm.c[1].x ^ warm.c[2].x;
#ifdef DUP_ST6
    }
#endif
}

DI void s1_gdn(LAS uchar* lds, const bf16* P, const ScanW& sw, uchar* task, int b, int h, int dir, int ci, int tid) {
    using namespace cf;
    LAS bf16* KL = (LAS bf16*)(lds + 0); LAS bf16* QL = (LAS bf16*)(lds + 17408);
    LAS bf16* VT = (LAS bf16*)(lds + 34816); LAS bf16* KBT = (LAS bf16*)(lds + 53248); LAS bf16* BHT = (LAS bf16*)(lds + 71680);
    LAS bf16* TT = (LAS bf16*)(lds + 90112); LAS float* AAB = (LAS float*)(lds + 99328); LAS float* TF = (LAS float*)(lds + 115968);
    LAS float* INVS = (LAS float*)(lds + 132608); LAS float* gvec = (LAS float*)(lds + 141312); LAS bf16* AQBL = (LAS bf16*)(lds + 151552);
    const int lane = tid & 63, wid = __builtin_amdgcn_readfirstlane(tid >> 6), i = tid >> 3, sub = tid & 7, r16 = lane & 15, q4 = lane >> 4;
    const int R = row_of(b, dir, ci, i), seg_lo = b * SEGT + (ci < 4 ? 0 : CTX), seg_hi = b * SEGT + (ci < 4 ? CTX : SEGT);
    const bf16* pr = P + (size_t)R * PC + C_GD;
    float qv[16], kv[16], vv[16];
#pragma unroll
    for (int w = 0; w < 3; ++w) { const int col = w * 512 + h * 128 + sub * 16; float acc[16];
#pragma unroll
        for (int e = 0; e < 16; ++e) acc[e] = 0.f;
#pragma unroll
        for (int j = 0; j < 5; ++j) { const int Rj = R + j - 2;
            if (Rj >= seg_lo && Rj < seg_hi) { float x[16]; float xa[8], xb[8];
                unpack8(*(const u32x4*)(pr + (ptrdiff_t)(j - 2) * PC + col), xa); unpack8(*(const u32x4*)(pr + (ptrdiff_t)(j - 2) * PC + col + 8), xb);
#pragma unroll
                for (int e = 0; e < 8; ++e) { x[e] = xa[e]; x[8 + e] = xb[e]; }
                const LAS float* cw = (const LAS float*)(lds + GDB) + (j * 3 + w) * 128 + sub * 16;
#pragma unroll
                for (int e4 = 0; e4 < 4; ++e4) { const f32x4 c4 = *(const LAS f32x4*)(cw + 4 * e4);
#pragma unroll
                    for (int e = 0; e < 4; ++e) acc[4 * e4 + e] += c4[e] * x[4 * e4 + e]; } } }
#pragma unroll
        for (int e = 0; e < 16; ++e) { const float x = acc[e] * sigmoidf_(acc[e]); if (w == 0) qv[e] = x; else if (w == 1) kv[e] = x; else vv[e] = x; } }
    { float sq = 0.f, sk = 0.f;
#pragma unroll
      for (int e = 0; e < 16; ++e) { sq += qv[e] * qv[e]; sk += kv[e] * kv[e]; }
      sq += sx<1>(sq); sq += sx<2>(sq); sq += sx<4>(sq); sk += sx<1>(sk); sk += sx<2>(sk); sk += sx<4>(sk);
      const float rq = rsqrtf(sq + 1e-12f) * 0.08838834764831845f, rk = rsqrtf(sk + 1e-12f);
#pragma unroll
      for (int e = 0; e < 16; ++e) { qv[e] *= rq; kv[e] *= rk; } }
    if (sub == 0) { const float a_raw = bf2f(pr[GD_A + dir * 4 + h]), b_raw = bf2f(pr[GD_B + dir * 4 + h]);
        gvec[i] = -__expf(sw.a_log[dir * 4 + h]) * softplusf_(a_raw + sw.dt_bias[dir * 4 + h]); gvec[64 + i] = sigmoidf_(b_raw); }
    { float t0[8], t1[8];
#pragma unroll
      for (int e = 0; e < 8; ++e) { t0[e] = kv[e]; t1[e] = kv[8 + e]; }
      *(LAS u32x4*)(KL + i * 136 + sub * 16) = pack8f(t0); *(LAS u32x4*)(KL + i * 136 + sub * 16 + 8) = pack8f(t1);
#pragma unroll
      for (int e = 0; e < 8; ++e) { t0[e] = qv[e]; t1[e] = qv[8 + e]; }
      *(LAS u32x4*)(QL + i * 136 + sub * 16) = pack8f(t0); *(LAS u32x4*)(QL + i * 136 + sub * 16 + 8) = pack8f(t1); }
    LDS_BARRIER();
    if (wid == 0) { float g = 0.f;
#pragma unroll 8
        for (int t = 0; t < 64; ++t) { const float x = gvec[t]; g += (t <= lane) ? x : 0.f; }
        gvec[128 + lane] = g; }
    LDS_BARRIER();
    for (int z_ = tid; z_ < 64 * 72 / 8; z_ += 512) ((LAS u32x4*)TT)[z_] = (u32x4){0u, 0u, 0u, 0u};
    { const float Gi = gvec[128 + i], GL = gvec[128 + 63], be = gvec[64 + i], eG = __expf(Gi), eLG = __expf(GL - Gi), beG = be * eG;
#pragma unroll
      for (int e = 0; e < 16; ++e) { const int c = sub * 16 + e; VT[c * 72 + i] = f2bf(be * vv[e]); KBT[c * 72 + i] = f2bf(beG * kv[e]); BHT[c * 72 + i] = f2bf(kv[e] * eLG); }
      if (tid < 128) ((float*)(task + 98304))[tid] = __expf(GL); }
    { const int mat = wid >> 2, tm = wid & 3;
      const LAS bf16* Am = mat ? QL : KL;
      bf16x8 af[4];
#pragma unroll
      for (int k = 0; k < 4; ++k) af[k] = *(const LAS bf16x8*)(Am + (16 * tm + r16) * 136 + k * 32 + q4 * 8);
#pragma unroll
      for (int tn = 0; tn < 4; ++tn) { f32x4 acc = (f32x4){0.f, 0.f, 0.f, 0.f};
          if (tm >= tn) {
#pragma unroll
              for (int k = 0; k < 4; ++k) acc = MFMA16(af[k], *(const LAS bf16x8*)(KL + (16 * tn + r16) * 136 + k * 32 + q4 * 8), acc); }
          const float Gj = gvec[128 + 16 * tn + r16];
#pragma unroll
          for (int e = 0; e < 4; ++e) { const int ti = 16 * tm + 4 * q4 + e, tj = 16 * tn + r16; const float dec = __expf(fminf(gvec[128 + ti] - Gj, 0.f));
              if (mat == 0) AAB[ti * 65 + tj] = (ti > tj) ? -gvec[64 + ti] * acc[e] * dec : 0.f;
              else AQBL[ti * 72 + tj] = f2bf((ti >= tj) ? acc[e] * dec : 0.f); } } }
    LDS_BARRIER();
    inv_blocked(AAB, TF, TT, INVS, wid, lane, tid, [](int) {});
    { const int mat = wid >> 2, tm = wid & 3; f32x4 zt[8];
      { const bf16x8 t0 = *(const LAS bf16x8*)(TT + (16 * tm + r16) * 72 + q4 * 8), t1 = *(const LAS bf16x8*)(TT + (16 * tm + r16) * 72 + 32 + q4 * 8); const LAS bf16* Bm = mat ? KBT : VT;
#pragma unroll
        for (int tn = 0; tn < 8; ++tn) { zt[tn] = MFMA16(t0, *(const LAS bf16x8*)(Bm + (16 * tn + r16) * 72 + q4 * 8), ((f32x4){0.f, 0.f, 0.f, 0.f})); zt[tn] = MFMA16(t1, *(const LAS bf16x8*)(Bm + (16 * tn + r16) * 72 + 32 + q4 * 8), zt[tn]); } }
      LDS_BARRIER();
      LAS bf16* dst = mat ? KBT : VT; const float sg = mat ? -1.f : 1.f;
#pragma unroll
      for (int tn = 0; tn < 8; ++tn) { u32x2 o; o.x = pk2(sg * zt[tn][0], sg * zt[tn][1]); o.y = pk2(sg * zt[tn][2], sg * zt[tn][3]); *(LAS u32x2*)(dst + (16 * tn + r16) * 72 + 16 * tm + 4 * q4) = o; } }
    LDS_BARRIER();
    { const LAS bf16* WTT = KBT; const LAS bf16* ULT = VT;
#define FRAG(Mx, row, k) (*(const LAS bf16x8*)((Mx) + (row) * 72 + (k) * 32 + q4 * 8))
      const bf16x8 w0 = FRAG(WTT, 16 * wid + r16, 0), w1 = FRAG(WTT, 16 * wid + r16, 1);
      const bf16x8 h0 = FRAG(BHT, 16 * wid + r16, 0), h1 = FRAG(BHT, 16 * wid + r16, 1);
#pragma unroll
      for (int tn = 0; tn < 8; ++tn) {
          f32x4 acc = MFMA16(w0, FRAG(BHT, 16 * tn + r16, 0), ((f32x4){0.f, 0.f, 0.f, 0.f})); acc = MFMA16(w1, FRAG(BHT, 16 * tn + r16, 1), acc);
          u32x2 o; o.x = pk2(acc[0], acc[1]); o.y = pk2(acc[2], acc[3]); *(u32x2*)(task + 0 + FRAGOFF(16 * tn + r16, 16 * wid + 4 * q4, 4)) = o; }
#pragma unroll
      for (int tn = 0; tn < 8; ++tn) {
          f32x4 acc = MFMA16(h0, FRAG(ULT, 16 * tn + r16, 0), ((f32x4){0.f, 0.f, 0.f, 0.f})); acc = MFMA16(h1, FRAG(ULT, 16 * tn + r16, 1), acc);
          u32x2 o; o.x = pk2(acc[0], acc[1]); o.y = pk2(acc[2], acc[3]); *(u32x2*)(task + 49152 + ((wid * 4 + (tn >> 1)) * 64 + lane) * 16 + (tn & 1) * 8) = o; }
#pragma unroll
      for (int tn = 0; tn < 4; ++tn) {
          f32x4 acc = MFMA16(w0, FRAG(AQBL, 16 * tn + r16, 0), ((f32x4){0.f, 0.f, 0.f, 0.f})); acc = MFMA16(w1, FRAG(AQBL, 16 * tn + r16, 1), acc);
          const int t = 16 * tn + r16; const float eG = __expf(gvec[128 + t]); const u32x2 qq = *(const LAS u32x2*)(QL + t * 136 + 16 * wid + 4 * q4);
          u32x2 o; o.x = pk2(acc[0] + eG * bflo(qq.x), acc[1] + eG * bfhi(qq.x)); o.y = pk2(acc[2] + eG * bflo(qq.y), acc[3] + eG * bfhi(qq.y)); *(u32x2*)(task + 32768 + FRAGOFF(t, 16 * wid + 4 * q4, 4)) = o; }
      { const int tm = wid >> 1; const bf16x8 a0 = FRAG(AQBL, 16 * tm + r16, 0), a1 = FRAG(AQBL, 16 * tm + r16, 1);
#pragma unroll
        for (int j = 0; j < 4; ++j) { const int tn = (wid & 1) * 4 + j;
            f32x4 acc = MFMA16(a0, FRAG(ULT, 16 * tn + r16, 0), ((f32x4){0.f, 0.f, 0.f, 0.f})); acc = MFMA16(a1, FRAG(ULT, 16 * tn + r16, 1), acc);
            u32x2 o; o.x = pk2(acc[0], acc[1]); o.y = pk2(acc[2], acc[3]); *(u32x2*)(task + 81920 + ((tm * 4 + (tn >> 1)) * 64 + lane) * 16 + (tn & 1) * 8) = o; } }
#undef FRAG
    }
    LDS_BARRIER();
}

template <int NK, bool LOC> struct S2FA { bf16x8 wt[NK / 32]; u32x4 ul; };
template <int NK, bool LOC> struct S2FB { bf16x8 qt[NK / 32], aqb[2], bht[2]; u32x4 yl, kl; f32x4 gl; float gls; };
template <int NK, bool LOC>
DI void s2_load_a(S2FA<NK, LOC>& f, const uchar* task, int o_wt, int o_ul, int ulh, int tm, int lane) {
    const int r16 = lane & 15, q4 = lane >> 4;
#pragma unroll
    for (int k = 0; k < NK / 32; ++k) f.wt[k] = *(const bf16x8*)(task + o_wt + ((size_t)(16 * tm + r16) * NK + k * 32 + q4 * 8) * 2);
    f.ul = *(const u32x4*)(task + o_ul + (size_t)(ulh * 64 + lane) * 16);
}
template <int NK, bool LOC>
DI void s2_load_b(S2FB<NK, LOC>& f, const uchar* task, int o_qt, int o_aqb, int o_bht, int o_yl, int ulh, int o_kl, int o_gl, int tm, int cm, int ch, int lane) {
    const int r16 = lane & 15, q4 = lane >> 4;
#pragma unroll
    for (int k = 0; k < NK / 32; ++k) f.qt[k] = *(const bf16x8*)(task + o_qt + ((size_t)(16 * tm + r16) * NK + k * 32 + q4 * 8) * 2);
    if (LOC) f.yl = *(const u32x4*)(task + o_yl + (size_t)(ulh * 64 + lane) * 16);
#pragma unroll
    for (int k = 0; k < 2; ++k) { f.aqb[k] = *(const bf16x8*)(task + o_aqb + ((size_t)(16 * tm + r16) * 64 + k * 32 + q4 * 8) * 2); f.bht[k] = *(const bf16x8*)(task + o_bht + ((size_t)(16 * cm + r16) * 64 + k * 32 + q4 * 8) * 2); }
    if (LOC) f.kl = *(const u32x4*)(task + o_kl + (size_t)((cm * 2 + ch) * 64 + lane) * 16);
    if (LOC) f.gl = *(const f32x4*)(task + o_gl + (size_t)(16 * cm + 4 * q4) * 4); else f.gls = *(const float*)(task + o_gl);
}
template <int NK, bool LOC>
DI void s2_step(const S2FA<NK, LOC>& fa, const S2FB<NK, LOC>& fb, f32x4 (&H)[NK / 32], const LAS bf16* Hc, LAS bf16* Hn, LAS bf16* UT, float* Y, int ycol0, int b, int dir, int ci, int tm, int tn0, int cm, int ctn0, int lane) {
    constexpr int NH = NK / 32, LDH = NK + 8;
    const int r16 = lane & 15, q4 = lane >> 4;
    f32x4 U[2], Yv[2];
    U[0] = (f32x4){bflo(fa.ul.x), bfhi(fa.ul.x), bflo(fa.ul.y), bfhi(fa.ul.y)}; U[1] = (f32x4){bflo(fa.ul.z), bfhi(fa.ul.z), bflo(fa.ul.w), bfhi(fa.ul.w)};
#pragma unroll
    for (int j = 0; j < 2; ++j) {
#pragma unroll
        for (int k = 0; k < NK / 32; ++k) { const bf16x8 hb = *(const LAS bf16x8*)(Hc + (16 * (tn0 + j) + r16) * LDH + k * 32 + q4 * 8); U[j] = MFMA16(fa.wt[k], hb, U[j]); }
        u32x2 o; o.x = pk2(U[j][0], U[j][1]); o.y = pk2(U[j][2], U[j][3]);
        *(LAS u32x2*)(UT + (16 * (tn0 + j) + r16) * 72 + 16 * tm + 4 * q4) = o;
    }
    LDS_BARRIER();
    if (LOC) { Yv[0] = (f32x4){bflo(fb.yl.x), bfhi(fb.yl.x), bflo(fb.yl.y), bfhi(fb.yl.y)}; Yv[1] = (f32x4){bflo(fb.yl.z), bfhi(fb.yl.z), bflo(fb.yl.w), bfhi(fb.yl.w)}; }
    else { Yv[0] = (f32x4){0.f, 0.f, 0.f, 0.f}; Yv[1] = Yv[0]; }
#pragma unroll
    for (int j = 0; j < 2; ++j) {
#pragma unroll
        for (int k = 0; k < NK / 32; ++k) { const bf16x8 hb = *(const LAS bf16x8*)(Hc + (16 * (tn0 + j) + r16) * LDH + k * 32 + q4 * 8); Yv[j] = MFMA16(fb.qt[k], hb, Yv[j]); }
#pragma unroll
        for (int k = 0; k < 2; ++k) { const bf16x8 ub = *(const LAS bf16x8*)(UT + (16 * (tn0 + j) + r16) * 72 + k * 32 + q4 * 8); Yv[j] = MFMA16(fb.aqb[k], ub, Yv[j]); }
#pragma unroll
        for (int e = 0; e < 4; ++e) Y[(size_t)row_of(b, dir, ci, 16 * tm + 4 * q4 + e) * 512 + ycol0 + 16 * (tn0 + j) + r16] = Yv[j][e];
    }
#pragma unroll
    for (int j = 0; j < NH; ++j) {
        f32x4 h = LOC ? H[j] * fb.gl : H[j] * fb.gls;
        if (LOC) { if (j == 0) h += (f32x4){bflo(fb.kl.x), bfhi(fb.kl.x), bflo(fb.kl.y), bfhi(fb.kl.y)}; else h += (f32x4){bflo(fb.kl.z), bfhi(fb.kl.z), bflo(fb.kl.w), bfhi(fb.kl.w)}; }
#pragma unroll
        for (int k = 0; k < 2; ++k) { const bf16x8 ub = *(const LAS bf16x8*)(UT + (16 * (ctn0 + j) + r16) * 72 + k * 32 + q4 * 8); h = MFMA16(fb.bht[k], ub, h); }
        H[j] = h;
        u32x2 o; o.x = pk2(h[0], h[1]); o.y = pk2(h[2], h[3]);
        *(LAS u32x2*)(Hn + (16 * (ctn0 + j) + r16) * LDH + 16 * cm + 4 * q4) = o;
    }
    LDS_BARRIER();
}
template <int NK, bool LOC>
DI void s2_scan(LAS uchar* lds, const uchar* task0, int task_bytes, int o_wt, int o_qt, int o_aqb, int o_bht, int o_ul, int ulq, int o_yl, int o_kl, int o_gl,
                float* Y, int ycol0, int b, int dir, int tid) {
    constexpr int NH = NK / 32, LDH = NK + 8;
    LAS bf16* HT = (LAS bf16*)lds;
    LAS bf16* UT = (LAS bf16*)(lds + 2 * 64 * LDH * 2);
    const int lane = tid & 63, wid = tid >> 6;
    const int tm = wid >> 1, tn0 = (wid & 1) * 2;
    const int cm = (NK == 64) ? (wid >> 1) : wid, ctn0 = (NK == 64) ? (wid & 1) * 2 : 0;
    const int ulh = tm * ulq + (wid & 1);
    for (int i = tid; i < 64 * LDH * 2 / 16; i += 512) ((LAS u32x4*)HT)[i] = (u32x4){0u, 0u, 0u, 0u};
    f32x4 H[NH];
#pragma unroll
    for (int j = 0; j < NH; ++j) H[j] = (f32x4){0.f, 0.f, 0.f, 0.f};
    S2FA<NK, LOC> a0, a1, a2; S2FB<NK, LOC> b0, b1, b2;
#define TASKP(c) (task0 + (size_t)((c) < cf::NCH ? (c) : cf::NCH - 1) * task_bytes)
#define LDA(f, c) s2_load_a<NK, LOC>(f, TASKP(c), o_wt, o_ul, ulh, tm, lane)
#define LDB(f, c) s2_load_b<NK, LOC>(f, TASKP(c), o_qt, o_aqb, o_bht, o_yl, ulh, o_kl, o_gl, tm, cm, (wid & 1), lane)
#define STP(fa, fb, c) s2_step<NK, LOC>(fa, fb, H, HT + ((c) & 1) * 64 * LDH, HT + (((c) + 1) & 1) * 64 * LDH, UT, Y, ycol0, b, dir, (c), tm, tn0, cm, ctn0, lane)
    LDA(a0, 0); LDB(b0, 0); LDA(a1, 1); LDB(b1, 1);
    LDS_BARRIER();
#pragma unroll 2
    for (int ci = 0; ci < cf::NCH; ++ci) {
        LDA(a2, ci + 2); LDB(b2, ci + 2); STP(a0, b0, ci);
        a0 = a1; a1 = a2; b0 = b1; b1 = b2;
    }
#undef TASKP
#undef LDA
#undef LDB
#undef STP
}

template <int NK, bool VECG> struct S2N { bf16x8 m[NK / 32], q[NK / 32]; u32x4 n[NK / 64], y; f32x4 gl; float gls; };
template <int NK, bool VECG>
DI void s2n_load(S2N<NK, VECG>& f, const uchar* task, int o_m, int o_q, int o_n, int o_y, int o_gl, int tm, int cm, int nh0, int yh, int lane) {
    const int r16 = lane & 15, q4 = lane >> 4;
#pragma unroll
    for (int k = 0; k < NK / 32; ++k) { f.m[k] = *(const bf16x8*)(task + o_m + (size_t)((cm * (NK / 32) + k) * 64 + lane) * 16); f.q[k] = *(const bf16x8*)(task + o_q + (size_t)((tm * (NK / 32) + k) * 64 + lane) * 16); }
#pragma unroll
    for (int j = 0; j < NK / 64; ++j) f.n[j] = *(const u32x4*)(task + o_n + (size_t)((nh0 + j) * 64 + lane) * 16);
    f.y = *(const u32x4*)(task + o_y + (size_t)(yh * 64 + lane) * 16);
    if (VECG) f.gl = *(const f32x4*)(task + o_gl + (size_t)(16 * cm + 4 * q4) * 4); else f.gls = *(const float*)(task + o_gl);
}
template <int NK, bool VECG>
DI void s2n_step(const S2N<NK, VECG>& f, f32x4 (&H)[NK / 32], const LAS bf16* Hc, LAS bf16* Hn, LAS float* YS, float* Y, int ycol0, int b, int dir, int ci, int tm, int tn0, int cm, int ctn0, int wid, int lane) {
    constexpr int NH = NK / 32, LDH = NK + 8;
    const int r16 = lane & 15, q4 = lane >> 4;
#pragma unroll
    for (int j = 0; j < NH; ++j) {
        const u32x4 nn = f.n[j >> 1];
        f32x4 h = VECG ? H[j] * f.gl : H[j] * f.gls;
        h += (j & 1) ? (f32x4){bflo(nn.z), bfhi(nn.z), bflo(nn.w), bfhi(nn.w)} : (f32x4){bflo(nn.x), bfhi(nn.x), bflo(nn.y), bfhi(nn.y)};
#pragma unroll
        for (int k = 0; k < NK / 32; ++k) { const bf16x8 hb = *(const LAS bf16x8*)(Hc + (16 * (ctn0 + j) + r16) * LDH + k * 32 + q4 * 8); h = MFMA16(f.m[k], hb, h); }
        H[j] = h;
        u32x2 o; o.x = pk2(h[0], h[1]); o.y = pk2(h[2], h[3]);
        *(LAS u32x2*)(Hn + (16 * (ctn0 + j) + r16) * LDH + 16 * cm + 4 * q4) = o;
    }
#pragma unroll
    for (int j = 0; j < 2; ++j) {
        f32x4 yv = j ? (f32x4){bflo(f.y.z), bfhi(f.y.z), bflo(f.y.w), bfhi(f.y.w)} : (f32x4){bflo(f.y.x), bfhi(f.y.x), bflo(f.y.y), bfhi(f.y.y)};
#pragma unroll
        for (int k = 0; k < NK / 32; ++k) { const bf16x8 hb = *(const LAS bf16x8*)(Hc + (16 * (tn0 + j) + r16) * LDH + k * 32 + q4 * 8); yv = MFMA16(f.q[k], hb, yv); }
#pragma unroll
        for (int e = 0; e < 4; ++e) YS[(16 * tm + 4 * q4 + e) * 65 + 16 * (tn0 + j) + r16] = yv[e];
    }
    LDS_BARRIER();
#pragma unroll
    for (int e = 0; e < 8; ++e) { const int t = 8 * wid + e;
        Y[(size_t)row_of(b, dir, ci, t) * 512 + ycol0 + lane] = YS[t * 65 + lane]; }
}
template <int NK, bool VECG>
DI void s2n_scan(LAS uchar* lds, const uchar* task0, int task_bytes, int o_m, int o_q, int o_n, int o_y, int o_gl, int nq, int vs, float* Y, int ycol0, int b, int dir, int tid) {
    constexpr int NH = NK / 32, LDH = NK + 8;
    LAS bf16* HT = (LAS bf16*)lds;
    LAS float* YSB = (LAS float*)(lds + 2 * 64 * LDH * 2);
    const int lane = tid & 63, wid = __builtin_amdgcn_readfirstlane(tid >> 6);
    const int tm = wid >> 1, tn0 = (wid & 1) * 2;
    const int cm = (NK == 64) ? (wid >> 1) : wid, ctn0 = (NK == 64) ? (wid & 1) * 2 : 0;
    const int nh0 = (NK == 64) ? (cm * nq + (wid & 1)) : (cm * nq + vs * 2), yh = tm * nq + vs * 2 + (wid & 1);
    for (int i = tid; i < 64 * LDH * 2 / 16; i += 512) ((LAS u32x4*)HT)[i] = (u32x4){0u, 0u, 0u, 0u};
    f32x4 H[NH];
#pragma unroll
    for (int j = 0; j < NH; ++j) H[j] = (f32x4){0.f, 0.f, 0.f, 0.f};
#define TP(c) (task0 + (size_t)((c) < cf::NCH ? (c) : cf::NCH - 1) * task_bytes)
#define LD(f, c) s2n_load<NK, VECG>(f, TP(c), o_m, o_q, o_n, o_y, o_gl, tm, cm, nh0, yh, lane)
#define ST(f, c) s2n_step<NK, VECG>(f, H, HT + ((c) & 1) * 64 * LDH, HT + (((c) + 1) & 1) * 64 * LDH, YSB + ((c) & 1) * 64 * 65, Y, ycol0, b, dir, (c), tm, tn0, cm, ctn0, wid, lane)
    if constexpr (NK == 64) {
        S2N<NK, VECG> f0, f1, f2, f3;
        LD(f0, 0); LD(f1, 1); LD(f2, 2);
        LDS_BARRIER();
#pragma unroll 1
        for (int ci = 0; ci < cf::NCH; ci += 4) {
            LD(f3, ci + 3); ST(f0, ci);
            LD(f0, ci + 4); ST(f1, ci + 1);
            LD(f1, ci + 5); ST(f2, ci + 2);
            LD(f2, ci + 6); ST(f3, ci + 3);
        }
    } else {
        S2N<NK, VECG> f0, f1, f2;
        LD(f0, 0); LD(f1, 1);
        LDS_BARRIER();
#pragma unroll 1
        for (int ci = 0; ci + 2 < cf::NCH; ci += 3) {
            LD(f2, ci + 2); ST(f0, ci);
            LD(f0, ci + 3); ST(f1, ci + 1);
            LD(f1, ci + 4); ST(f2, ci + 2);
        }
        ST(f0, cf::NCH - 2); ST(f1, cf::NCH - 1);
    }
#undef TP
#undef LD
#undef ST
}
namespace at {
constexpr int DQ = 192, DV = 128, NW = 8, QBLK = 32, KVBLK = 64;
constexpr float SCALE = 0.07216878364870322f;
constexpr float THR = 8.f;
constexpr int SHM_V = KVBLK * DV * 2, SHM_K = KVBLK * DQ * 2, SHM_Q = NW * 8 * 1024, SHM_ATTN = 2 * SHM_V + 2 * SHM_K + NW * 64 * 4 + SHM_Q;
#define KSWZ(row, colB) ((row) * 384 + ((colB) ^ (((row) & 7) << 4)))
#define SBAR() __builtin_amdgcn_sched_barrier(0)
DI int crow(int r, int hi) { return (r & 3) + 8 * (r >> 2) + 4 * hi; }
DI unsigned cvtpk(float lo, float hi) { const f32x2 v = {lo, hi}; return __builtin_bit_cast(unsigned, __builtin_convertvector(v, bf16x2_t)); }
DI void partialSM(f32x16& p0, f32x16& p1, float& m_reg, float& mn, float& alpha) {
  constexpr float C = SCALE * 1.4426950408889634f;
  float pmax = p0[0];
#pragma unroll
  for (int r = 1; r < 16; ++r) pmax = fmaxf(pmax, p0[r]);
#pragma unroll
  for (int r = 0; r < 16; ++r) pmax = fmaxf(pmax, p1[r]);
  { auto rr = __builtin_amdgcn_permlane32_swap(__float_as_uint(pmax), __float_as_uint(pmax), false, false);
    pmax = fmaxf(__uint_as_float(rr[0]), __uint_as_float(rr[1])); }
  if (__builtin_expect(__all(pmax - m_reg <= THR / SCALE), 1)) { mn = m_reg; alpha = 1.f; }
  else { mn = fmaxf(m_reg, pmax); alpha = __builtin_amdgcn_exp2f((m_reg - mn) * C); m_reg = mn; }
  float mnC = -mn * C;
#pragma unroll
  for (int r = 0; r < 16; ++r) p0[r] = fmaf(p0[r], C, mnC);
#pragma unroll
  for (int r = 0; r < 16; ++r) p1[r] = fmaf(p1[r], C, mnC);
#pragma unroll
  for (int r = 0; r < 16; ++r) p0[r] = __builtin_amdgcn_exp2f(p0[r]);
}
DI void finishSM(f32x16& p0, f32x16& p1, float alpha, float& l_reg, bf16x8& pa0, bf16x8& pa1, bf16x8& pa2, bf16x8& pa3) {
#pragma unroll
  for (int r = 0; r < 16; ++r) p1[r] = __builtin_amdgcn_exp2f(p1[r]);
  float ps = 0;
#pragma unroll
  for (int r = 0; r < 16; ++r) ps += p0[r];
#pragma unroll
  for (int r = 0; r < 16; ++r) ps += p1[r];
  { auto rr = __builtin_amdgcn_permlane32_swap(__float_as_uint(ps), __float_as_uint(ps), false, false);
    ps = __uint_as_float(rr[0]) + __uint_as_float(rr[1]); }
  l_reg = l_reg * alpha + ps;
#define PK4(P, BASE, OUT) do { unsigned a0 = cvtpk(P[BASE + 0], P[BASE + 1]), a1 = cvtpk(P[BASE + 2], P[BASE + 3]);   \
    unsigned b0 = cvtpk(P[BASE + 4], P[BASE + 5]), b1 = cvtpk(P[BASE + 6], P[BASE + 7]);                              \
    auto r0 = __builtin_amdgcn_permlane32_swap(a0, b0, false, false); auto r1 = __builtin_amdgcn_permlane32_swap(a1, b1, false, false); \
    u32x4 w = {r0[0], r1[0], r0[1], r1[1]}; OUT = *reinterpret_cast<bf16x8*>(&w); } while (0)
  PK4(p0, 0, pa0); PK4(p0, 8, pa1); PK4(p1, 0, pa2); PK4(p1, 8, pa3);
#undef PK4
}
constexpr int NQR = 5;
DI void qkt(f32x16& p0, f32x16& p1, const LAS char* Ks, const bf16x8* qr, const LAS char* qlds, int r32, int hi) {
  p0 = f32x16{}; p1 = f32x16{};
#pragma unroll
  for (int d0 = 0; d0 < 12; ++d0) { int cb = (d0 * 16 + hi * 8) * 2;
    const bf16x8 qf = (d0 < NQR) ? qr[d0] : *(const LAS bf16x8*)(qlds + (d0 - NQR) * 1024);
    bf16x8 b0 = *(const LAS bf16x8*)(Ks + KSWZ(r32, cb));
    bf16x8 b1 = *(const LAS bf16x8*)(Ks + KSWZ(32 + r32, cb));
    p0 = __builtin_amdgcn_mfma_f32_32x32x16_bf16(b0, qf, p0, 0, 0, 0);
    p1 = __builtin_amdgcn_mfma_f32_32x32x16_bf16(b1, qf, p1, 0, 0, 0); }
}
DI int v_st(int k, int c) { const int kk = (k & ~0xC) | ((k & 4) << 1) | ((k & 8) >> 1); return ((kk >> 3) * 4 + (c >> 5)) * 512 + ((kk & 7) * 32 + (c & 31)) * 2; }
DI int v_rd_base(int lane) { return ((lane & 3) << 3) | (((lane >> 2) & 3) << 6) | (((lane >> 4) & 1) << 5) | (((lane >> 5) & 1) << 8); }
constexpr int v_rd_off(int d0, int ks, int half) { return d0 * 512 + ks * 4096 + half * 2048; }
template <int OFF> DI s16x4 tr_read(int vb) { s16x4 r; asm volatile("ds_read_b64_tr_b16 %0, %1 offset:%2" : "=&v"(r) : "v"(vb), "i"(OFF) : "memory"); return r; }
template <int D0> DI void pv_one(f32x16& od, int vb, bf16x8 pa0, bf16x8 pa1, bf16x8 pa2, bf16x8 pa3) {
  const s16x4 l0 = tr_read<v_rd_off(D0, 0, 0)>(vb), h0 = tr_read<v_rd_off(D0, 0, 1)>(vb), l1 = tr_read<v_rd_off(D0, 1, 0)>(vb), h1 = tr_read<v_rd_off(D0, 1, 1)>(vb);
  const s16x4 l2 = tr_read<v_rd_off(D0, 2, 0)>(vb), h2 = tr_read<v_rd_off(D0, 2, 1)>(vb), l3 = tr_read<v_rd_off(D0, 3, 0)>(vb), h3 = tr_read<v_rd_off(D0, 3, 1)>(vb);
  asm volatile("s_waitcnt lgkmcnt(0)" ::: "memory"); SBAR();
#define PK(L, H) (bf16x8){L[0], L[1], L[2], L[3], H[0], H[1], H[2], H[3]}
  od = __builtin_amdgcn_mfma_f32_32x32x16_bf16(pa0, PK(l0, h0), od, 0, 0, 0);
  od = __builtin_amdgcn_mfma_f32_32x32x16_bf16(pa1, PK(l1, h1), od, 0, 0, 0);
  od = __builtin_amdgcn_mfma_f32_32x32x16_bf16(pa2, PK(l2, h2), od, 0, 0, 0);
  od = __builtin_amdgcn_mfma_f32_32x32x16_bf16(pa3, PK(l3, h3), od, 0, 0, 0);
#undef PK
}
DI void pv_d0(f32x16* o, int vb, bf16x8 pa0, bf16x8 pa1, bf16x8 pa2, bf16x8 pa3) {
  pv_one<0>(o[0], vb, pa0, pa1, pa2, pa3); pv_one<1>(o[1], vb, pa0, pa1, pa2, pa3); pv_one<2>(o[2], vb, pa0, pa1, pa2, pa3); pv_one<3>(o[3], vb, pa0, pa1, pa2, pa3);
}
DI void attn_unit(const bf16* __restrict__ Qb, const bf16* __restrict__ Kh, const bf16* __restrict__ Vh, bf16* __restrict__ Ob, int seq, const float* rope, int pos0, LAS char* lds, const int tid) {
  constexpr int LDQ = cf::QP, LDKK = cf::KP, LDVV = cf::VP, LDO = cf::D;
  const int wid = __builtin_amdgcn_readfirstlane(tid >> 6), lane = tid & 63, r32 = lane & 31, hi = lane >> 5;
  LAS char* V_lds = lds; LAS char* K_lds = lds + 2 * SHM_V;
  LAS float* ws = (LAS float*)(lds + 2 * SHM_V + 2 * SHM_K) + wid * 64; LAS float* li_l = ws; LAS float* al_l = ws + 32;
  LAS char* qlds = lds + 2 * SHM_V + 2 * SHM_K + NW * 64 * 4 + wid * (12 - NQR) * 1024 + lane * 16;
  float m_reg = -1e30f, l_reg = 0; f32x16 o[4] = {}; bf16x8 qr[12];
  const bf16* Qw = Qb + (long)(wid * QBLK + r32) * LDQ + hi * 8;
#pragma unroll
  for (int d0 = 0; d0 < 12; ++d0) qr[d0] = *reinterpret_cast<const bf16x8*>(Qw + d0 * 16);
  if (rope) { const int t = pos0 + wid * QBLK + r32;
#pragma unroll
    for (int ax = 0; ax < 2; ++ax) { const int pos = ax ? (t & 63) : (t >> 6);
      const f32x4 c0 = *(const f32x4*)(rope + pos * 16 + hi * 8), c1 = *(const f32x4*)(rope + pos * 16 + hi * 8 + 4), s0 = *(const f32x4*)(rope + 1024 + pos * 16 + hi * 8), s1 = *(const f32x4*)(rope + 1024 + pos * 16 + hi * 8 + 4);
      float x1[8], x2[8], o1[8], o2[8]; unpack8(__builtin_bit_cast(u32x4, qr[8 + 2 * ax]), x1); unpack8(__builtin_bit_cast(u32x4, qr[9 + 2 * ax]), x2);
#pragma unroll
      for (int e = 0; e < 8; ++e) { const float c = e < 4 ? c0[e] : c1[e - 4], s = e < 4 ? s0[e] : s1[e - 4]; o1[e] = x1[e] * c - x2[e] * s; o2[e] = x1[e] * s + x2[e] * c; }
      qr[8 + 2 * ax] = __builtin_bit_cast(bf16x8, pack8f(o1)); qr[9 + 2 * ax] = __builtin_bit_cast(bf16x8, pack8f(o2)); } }
#pragma unroll
  for (int d0 = NQR; d0 < 12; ++d0) *(LAS bf16x8*)(qlds + (d0 - NQR) * 1024) = qr[d0];
  const int sr = tid >> 4, sc = (tid & 15) * 8, vst0 = v_st(sr, sc), vst1 = v_st(32 + sr, sc);
  int kr_[3], kc_[3];
#pragma unroll
  for (int j = 0; j < 3; ++j) { const int q = tid + 512 * j; kr_[j] = q / 24; kc_[j] = (q % 24) * 8; }
  const int vb0 = (int)(uintptr_t)V_lds + v_rd_base(lane);
  bf16x8 vs0 = {}, vs1 = {}, ks0 = {}, ks1 = {}, ks2 = {};
#define SLOAD(k0) do { vs0 = *(const bf16x8*)(&Vh[(long)((k0) + sr) * LDVV + sc]); vs1 = *(const bf16x8*)(&Vh[(long)((k0) + 32 + sr) * LDVV + sc]); \
    ks0 = *(const bf16x8*)(&Kh[(long)((k0) + kr_[0]) * LDKK + kc_[0]]); ks1 = *(const bf16x8*)(&Kh[(long)((k0) + kr_[1]) * LDKK + kc_[1]]); ks2 = *(const bf16x8*)(&Kh[(long)((k0) + kr_[2]) * LDKK + kc_[2]]); } while (0)
#define SWRITE(b) do { *(LAS bf16x8*)(V_lds + (b) * SHM_V + vst0) = vs0; *(LAS bf16x8*)(V_lds + (b) * SHM_V + vst1) = vs1; \
    *(LAS bf16x8*)(K_lds + (b) * SHM_K + KSWZ(kr_[0], kc_[0] * 2)) = ks0; *(LAS bf16x8*)(K_lds + (b) * SHM_K + KSWZ(kr_[1], kc_[1] * 2)) = ks1; *(LAS bf16x8*)(K_lds + (b) * SHM_K + KSWZ(kr_[2], kc_[2] * 2)) = ks2; } while (0)
#define SWAIT() asm volatile("s_waitcnt vmcnt(0)" ::: "memory")
#define RESC(a) do { if (__any((a) < 1.f)) { if (hi == 0) al_l[r32] = (a); asm volatile("s_waitcnt lgkmcnt(0)" ::: "memory"); \
    _Pragma("unroll") for (int d = 0; d < 4; ++d) _Pragma("unroll") for (int r = 0; r < 16; ++r) o[d][r] *= al_l[crow(r, hi)]; } } while (0)
  f32x16 pA0 = {}, pA1 = {}, pB0 = {}, pB1 = {}; float mnA = 0.f, mnB = 0.f, alA = 1.f, alB = 1.f; bf16x8 pa0 = {}, pa1 = {}, pa2 = {}, pa3 = {}; const int NT = seq / KVBLK;
  SLOAD(0); SWAIT(); SWRITE(0); __syncthreads();
  qkt(pA0, pA1, K_lds, qr, qlds, r32, hi); partialSM(pA0, pA1, m_reg, mnA, alA);
  SLOAD(KVBLK);
  SWAIT(); SWRITE(1); __syncthreads();
  for (int j = 1; j + 1 < NT; j += 2) {
    SBAR(); qkt(pB0, pB1, K_lds + SHM_K, qr, qlds, r32, hi);
    finishSM(pA0, pA1, alA, l_reg, pa0, pa1, pa2, pa3); SBAR();
    SLOAD((j + 1) * KVBLK); SBAR();
    pv_d0(o, vb0, pa0, pa1, pa2, pa3); partialSM(pB0, pB1, m_reg, mnB, alB);
    __syncthreads(); SWAIT(); SWRITE(0);
    RESC(alB); __syncthreads();
    SBAR(); qkt(pA0, pA1, K_lds, qr, qlds, r32, hi);
    finishSM(pB0, pB1, alB, l_reg, pa0, pa1, pa2, pa3); SBAR();
    SLOAD((j + 2) * KVBLK); SBAR();
    pv_d0(o, vb0 + (int)SHM_V, pa0, pa1, pa2, pa3); partialSM(pA0, pA1, m_reg, mnA, alA);
    __syncthreads(); SWAIT(); SWRITE(1);
    RESC(alA); __syncthreads();
  }
  SBAR(); qkt(pB0, pB1, K_lds + SHM_K, qr, qlds, r32, hi);
  finishSM(pA0, pA1, alA, l_reg, pa0, pa1, pa2, pa3); SBAR();
  pv_d0(o, vb0, pa0, pa1, pa2, pa3); partialSM(pB0, pB1, m_reg, mnB, alB);
  __syncthreads(); RESC(alB);
  finishSM(pB0, pB1, alB, l_reg, pa0, pa1, pa2, pa3); SBAR();
  pv_d0(o, vb0 + (int)SHM_V, pa0, pa1, pa2, pa3);
  if (hi == 0) li_l[r32] = l_reg; asm volatile("s_waitcnt lgkmcnt(0)" ::: "memory");
  float rli[16];
#pragma unroll
  for (int r = 0; r < 16; ++r) rli[r] = __builtin_amdgcn_rcpf(li_l[crow(r, hi)]);
  bf16* Ow = Ob + (long)(wid * QBLK) * LDO;
#pragma unroll
  for (int r = 0; r < 16; ++r) { int orow = crow(r, hi);
#pragma unroll
    for (int d0 = 0; d0 < 4; ++d0) Ow[(long)orow * LDO + d0 * 32 + r32] = f2bf(o[d0][r] * rli[r]); }
  __syncthreads();
#undef SLOAD
#undef SWRITE
#undef SWAIT
#undef RESC
}
#undef KSWZ
}
#if defined(PROBE)
DI void fatomic_max(unsigned* p, float v) { atomicMax(p, __builtin_bit_cast(unsigned, fabsf(v))); }
DI float pshift(const bf16* P, int R, int lo, int hi, int col, const float* mu, int mucol) {
    const float c = bf2f(P[(size_t)R * cf::PC + col]), p = (R - 1 >= lo) ? bf2f(P[(size_t)(R - 1) * cf::PC + col]) : 0.f, n = (R + 1 < hi) ? bf2f(P[(size_t)(R + 1) * cf::PC + col]) : 0.f;
    return c + (0.5f * (p + n) - c) * mu[mucol];
}
__global__ void __launch_bounds__(256) probe(In in, uchar* ws, unsigned* res, float* scratch) {
    using namespace cf;
    __shared__ float sh[4352 + 1024];
    const int tid = threadIdx.x, bx = blockIdx.x;
    const bf16* P = (const bf16*)(ws + WS_P); const bf16* Qb = (const bf16*)(ws + WS_Q); const bf16* Kb = (const bf16*)(ws + WS_K); const bf16* Vb = (const bf16*)(ws + WS_V); const bf16* MIX = (const bf16*)(ws + WS_XM);
    const float* YR = (const float*)(ws + WS_YR); const float* YG = (const float*)(ws + WS_YG);
    if (bx < 8) {
        const int h = bx, b = 1;
        for (int which = 0; which < 4; ++which) {
            const bool isctx = which == 3; const int t = which == 0 ? 0 : which == 1 ? 1000 : which == 2 ? 4095 : 5;
            const int row = b * SEGT + (isctx ? t : CTX + t), nkeys = isctx ? CTX : SEGT;
            if (tid < 192) { float q = bf2f(Qb[(size_t)row * QP + h * 192 + tid]); sh[4352 + tid] = q; }
            __syncthreads();
            if (tid < 192 && tid >= 128 && !isctx) { const int j = tid - 128, ax = j >> 5, half = (j >> 4) & 1, f = j & 15; const float pos = ax ? (float)(t & 63) : (float)(t >> 6);
                const float ang = pos * powf(10000.f, -(float)f / 16.f), c = cosf(ang), s = sinf(ang);
                const float x1 = sh[4352 + 128 + ax * 32 + f], x2 = sh[4352 + 128 + ax * 32 + 16 + f];
                sh[4352 + 512 + j] = half ? (x1 * s + x2 * c) : (x1 * c - x2 * s); }
            __syncthreads();
            if (tid < 64 && !isctx) sh[4352 + 128 + tid] = sh[4352 + 512 + tid];
            __syncthreads();
            for (int kk = tid; kk < nkeys; kk += 256) { const int krow = b * SEGT + kk; const bool kctx = kk < CTX; const int kt = kk - CTX;
                float s = 0.f;
                for (int d = 0; d < 128; ++d) s += sh[4352 + d] * bf2f(Kb[(size_t)krow * KP + h * 192 + d]);
                for (int j = 0; j < 64; ++j) { const int ax = j >> 5, half = (j >> 4) & 1, f = j & 15;
                    float kv;
                    if (kctx) kv = bf2f(P[(size_t)krow * PC + C_KR + j]);
                    else { const float pos = ax ? (float)(kt & 63) : (float)(kt >> 6), ang = pos * powf(10000.f, -(float)f / 16.f), c = cosf(ang), sn = sinf(ang);
                        const float x1 = bf2f(P[(size_t)krow * PC + C_KR + ax * 32 + f]), x2 = bf2f(P[(size_t)krow * PC + C_KR + ax * 32 + 16 + f]);
                        kv = half ? (x1 * sn + x2 * c) : (x1 * c - x2 * sn); }
                    s += sh[4352 + 128 + j] * kv; }
                sh[kk] = s * 0.07216878364870322f; }
            __syncthreads();
            float mx = -1e30f; for (int kk = 0; kk < nkeys; ++kk) mx = fmaxf(mx, sh[kk]);
            float den = 0.f; for (int kk = 0; kk < nkeys; ++kk) den += __expf(sh[kk] - mx);
            if (tid < 128) { float o = 0.f; for (int kk = 0; kk < nkeys; ++kk) o += __expf(sh[kk] - mx) * bf2f(Vb[(size_t)(b * SEGT + kk) * VP + h * 128 + tid]);
                o /= den; const float got = bf2f(MIX[(size_t)row * D + h * 128 + tid]); fatomic_max(res + 0, got - o); fatomic_max(res + 16, o); }
            __syncthreads();
        }
    } else if (bx < 10) {
        if (tid >= 64) return;
        const int b = 1, h = 3, dir = bx - 8, lane = tid, hc = h * 64 + lane;
        const float* mu = in.p[11]; float S[64]; float cumw = 1.f;
        const uchar* task = ws + WS_RWT + (size_t)((((b * 8 + h) * 2 + dir) * NCH) + 0) * RW_TASK;
#pragma unroll
        for (int k = 0; k < 64; ++k) S[k] = 0.f;
        for (int step = 0; step < SEGT; ++step) {
            const int R = row_of(b, dir, step >> 6, step & 63), s = R % SEGT, lo = b * SEGT + (s < CTX ? 0 : CTX), hi = b * SEGT + (s < CTX ? CTX : SEGT);
            const float r = pshift(P, R, lo, hi, C_RW + hc, mu, hc), k = pshift(P, R, lo, hi, C_RW + 512 + hc, mu, 512 + hc), v = pshift(P, R, lo, hi, C_RW + 1024 + hc, mu, 1024 + hc);
            if (lane < 32) { sh[lane] = tanhf(pshift(P, R, lo, hi, C_RW + RW_WD + dir * 32 + lane, mu, RW_WD + dir * 32 + lane)); sh[32 + lane] = pshift(P, R, lo, hi, C_RW + RW_AD + dir * 32 + lane, mu, RW_AD + dir * 32 + lane); }
            __builtin_amdgcn_s_waitcnt(0); __builtin_amdgcn_wave_barrier();
            float lw = in.p[12][dir * 512 + hc], la = in.p[14][dir * 512 + hc];
            for (int rr = 0; rr < 32; ++rr) { lw += sh[rr] * in.p[13][((size_t)dir * 32 + rr) * 512 + hc]; la += sh[32 + rr] * in.p[15][((size_t)dir * 32 + rr) * 512 + hc]; }
            const float wlog = -log1pf(expf(-lw)) - 0.5f, w = expf(-expf(wlog)), alr = 1.f / (1.f + expf(-la));
            float kk = k * in.p[17][hc]; sh[400 + lane] = kk * kk; __builtin_amdgcn_s_waitcnt(0); __builtin_amdgcn_wave_barrier(); float nn = 0.f; for (int jj = 0; jj < 64; ++jj) nn += sh[400 + jj]; kk *= rsqrtf(nn + 1e-12f);
            const float kd = k * (1.f + (alr - 1.f) * in.p[18][hc]), a = -kk, bb = kk * alr;
            if (dir == 0 && step < 64) { cumw *= w;
#ifdef S1DBG
                const float qt = (S1DBG == 1) ? alr : kk,
#else
                const float qt = r * cumw,
#endif
                got = bf2f(((const bf16*)(task + 8192))[step * 64 + lane]); fatomic_max(res + 9, got - qt); fatomic_max(res + 25, qt);
                scratch[(size_t)8 * SEGT * 64 + step * 64 + lane] = bb; scratch[(size_t)8 * SEGT * 64 + 4096 + step * 64 + lane] = cumw;
                if (step == 63) { const float gl = ((const float*)(task + 57344))[lane]; fatomic_max(res + 8, gl - cumw); fatomic_max(res + 24, cumw);
                    for (int t2 = 0; t2 < 64; ++t2) { const float bh = scratch[(size_t)8 * SEGT * 64 + t2 * 64 + lane] * cumw / scratch[(size_t)8 * SEGT * 64 + 4096 + t2 * 64 + lane], gb = bf2f(((const bf16*)(task + 24576))[lane * 64 + t2]); fatomic_max(res + 10, gb - bh); fatomic_max(res + 26, bh); } } }
            sh[64 + lane] = a; sh[128 + lane] = bb; sh[192 + lane] = kd; sh[256 + lane] = w; sh[320 + lane] = r;
            __builtin_amdgcn_s_waitcnt(0); __builtin_amdgcn_wave_barrier();
            float sa = 0.f;
#pragma unroll
            for (int kx = 0; kx < 64; ++kx) sa += S[kx] * sh[64 + kx];
            float y = 0.f;
#pragma unroll
            for (int kx = 0; kx < 64; ++kx) { S[kx] = S[kx] * sh[256 + kx] + sa * sh[128 + kx] + v * sh[192 + kx]; y += S[kx] * sh[320 + kx]; }
            scratch[((size_t)dir * SEGT + (R - b * SEGT)) * 64 + lane] = y;
            __builtin_amdgcn_s_waitcnt(0); __builtin_amdgcn_wave_barrier();
        }
    } else if (bx < 12) {
        const int b = 2, h = 1, dir = bx - 10, c = tid & 127;
        float S[128];
#pragma unroll
        for (int k = 0; k < 128; ++k) S[k] = 0.f;
        const float A = expf(in.p[23][dir * 4 + h]), dtb = in.p[24][dir * 4 + h];
        for (int step = 0; step < SEGT; ++step) {
            const int R = row_of(b, dir, step >> 6, step & 63), s = R % SEGT, lo = b * SEGT + (s < CTX ? 0 : CTX), hi = b * SEGT + (s < CTX ? CTX : SEGT);
            float x[3];
            for (int w = 0; w < 3; ++w) { float acc = 0.f; const int col = w * 512 + h * 128 + c;
                for (int j = 0; j < 5; ++j) { const int Rj = R + j - 2; if (Rj >= lo && Rj < hi) acc += in.p[22][(size_t)j * 1536 + col] * bf2f(P[(size_t)Rj * PC + C_GD + col]); }
                x[w] = acc / (1.f + expf(-acc)); }
            if (tid < 128) { sh[tid] = x[0] * x[0]; sh[128 + tid] = x[1] * x[1]; }
            __syncthreads();
            float sq = 0.f, sk = 0.f; for (int j = 0; j < 128; ++j) { sq += sh[j]; sk += sh[128 + j]; }
            __syncthreads();
            const float q = x[0] * rsqrtf(sq + 1e-12f) * 0.08838834764831845f, k = x[1] * rsqrtf(sk + 1e-12f), v = x[2];
            const float a_raw = bf2f(P[(size_t)R * PC + C_GD + GD_A + dir * 4 + h]), b_raw = bf2f(P[(size_t)R * PC + C_GD + GD_B + dir * 4 + h]);
            const float z = a_raw + dtb, g = -A * (z > 20.f ? z : log1pf(expf(z))), eg = expf(g), beta = 1.f / (1.f + expf(-b_raw));
            if (tid < 128) { sh[256 + tid] = k; sh[384 + tid] = q; }
            __syncthreads();
            if (tid < 128) { float ks = 0.f;
#pragma unroll
                for (int kx = 0; kx < 128; ++kx) ks += sh[256 + kx] * S[kx];
                float o = 0.f;
#pragma unroll
                for (int kx = 0; kx < 128; ++kx) { S[kx] = eg * (S[kx] - beta * sh[256 + kx] * ks) + beta * sh[256 + kx] * v; o += sh[384 + kx] * S[kx]; }
                scratch[(size_t)2 * SEGT * 64 + ((size_t)dir * SEGT + (R - b * SEGT)) * 128 + c] = o; }
            __syncthreads();
        }
    }
}
__global__ void probe_cmp(uchar* ws, unsigned* res, const float* scratch) {
    using namespace cf;
    const float* YR = (const float*)(ws + WS_YR); const float* YG = (const float*)(ws + WS_YG);
    for (int i = blockIdx.x * blockDim.x + threadIdx.x; i < SEGT * 64; i += gridDim.x * blockDim.x) { const int s = i >> 6, v = i & 63, b = 1, h = 3; const size_t row = (size_t)b * SEGT + s;
        const float r0 = scratch[(size_t)s * 64 + v], r1 = scratch[((size_t)SEGT + s) * 64 + v], g0 = YR[row * 512 + h * 64 + v], g1 = YR[((size_t)M + row) * 512 + h * 64 + v];
        fatomic_max(res + 1, (g0 + g1) - (r0 + r1)); fatomic_max(res + 17, r0 + r1);
        fatomic_max(res + 3, g0 - r0); fatomic_max(res + 19, r0);
        fatomic_max(res + 4, g1 - r1); fatomic_max(res + 20, r1);
        if (s < 64) { fatomic_max(res + 5, g0 - r0); fatomic_max(res + 21, r0); }
        if (s >= 64 && s < 128) { fatomic_max(res + 6, g0 - r0); fatomic_max(res + 22, r0); }
        if (s >= 256 && s < 320) { fatomic_max(res + 7, g0 - r0); fatomic_max(res + 23, r0); }
    }
    for (int i = blockIdx.x * blockDim.x + threadIdx.x; i < SEGT * 128; i += gridDim.x * blockDim.x) { const int s = i >> 7, v = i & 127, b = 2, h = 1; const size_t row = (size_t)b * SEGT + s;
        const float* sg = scratch + (size_t)2 * SEGT * 64;
        const float ref = sg[(size_t)s * 128 + v] + sg[((size_t)SEGT + s) * 128 + v], got = YG[row * 512 + h * 128 + v] + YG[((size_t)M + row) * 512 + h * 128 + v];
        fatomic_max(res + 2, got - ref); fatomic_max(res + 18, ref); }
}
__global__ void probe_out(float* out, const unsigned* res, int selA, int selB) {
    if (blockIdx.x == 0 && threadIdx.x == 0) {
        out[0] = 1.0e5f * __builtin_bit_cast(float, res[selA]) / __builtin_bit_cast(float, res[16 + selA]);
        out[1] = 1.0e5f * __builtin_bit_cast(float, res[selB]) / __builtin_bit_cast(float, res[16 + selB]); }
}
#endif
constexpr int NWAVES = 8, NPH = 3 + 9 * cf::DEPTH;
struct Args { In in; float* out; uchar* ws; int g_lo, g_hi; };
static_assert(sizeof(Args) == 34 * 8 + 8 + 8 + 8, "Args has no padding");

__global__ void __launch_bounds__(NWAVES * 64, 2) fwd(Args args) {
    using namespace cf;
    extern __shared__ __attribute__((aligned(16))) unsigned char lds_raw[];
    LAS uchar* lds = (LAS uchar*)lds_raw;
    const int bx = blockIdx.x, G = gridDim.x, wv = __builtin_amdgcn_readfirstlane(threadIdx.x >> 6);
    auto lane_now = [&]() { unsigned ones = ~0u; asm volatile("" : "+s"(ones)); return (int)__builtin_amdgcn_mbcnt_hi(ones, __builtin_amdgcn_mbcnt_lo(ones, 0u)); };
#define TID() (wv * 64 + lane_now())
    const In& in = args.in;
    volatile LAS unsigned* MISC = (volatile LAS unsigned*)(lds + MISC_OFF);
    { const int tid = threadIdx.x; if (tid < 32) MISC[tid] = 0u; }
    __syncthreads();
    const int g_lo = args.g_lo, g_hi = args.g_hi;
    unsigned* barw = (unsigned*)(args.ws + WS_CTL) + CW_BAR;
    if (g_hi - g_lo > 1) (void)xcd_barrier_post(barw, MISC + 8);
#ifndef PH_MASK
#define PH_MASK 0xfff
#endif
#define PHK(g) ((g) < 3 ? (g) : 3 + ((g) - 3) % 9)
#ifndef DUP_PHASE
#define DUP_PHASE -1
#endif
#define NREP(k) ((DUP_PHASE == (k)) ? 2 : 1)
#define OPQ(v) asm volatile("" : "+v"(v))
#define IN(g) (((PH_MASK >> PHK(g)) & 1) && args.g_lo <= (g) && (g) < args.g_hi)
#ifdef TIMING
#define STAMP(i) do { if (blockIdx.x == 0 && TID() == 0) ((unsigned long long*)(args.ws + 16384))[i] = __builtin_amdgcn_s_memrealtime(); } while (0)
#else
#define STAMP(i) do {} while (0)
#endif
#define SEAM(g) do { if (args.g_lo <= (g) && (g) + 1 < args.g_hi) { XcdBarrier bar_; bar_.bar = (unsigned*)(args.ws + WS_CTL) + CW_BAR; bar_.x = xb_xcc_id(); bar_.st = (volatile LAS unsigned*)(lds + MISC_OFF) + 8; xcd_barrier(bar_); } STAMP((g) + 1); } while (0)

#define OPQS(v) asm volatile("" : "+s"(v))
#define LOCALS int l = lq; OPQS(l); size_t zq_ = 0; OPQS(zq_); uchar* ws = args.ws + zq_; float* X = (float*)(ws + WS_X); bf16* XM = (bf16*)(ws + WS_XM); bf16* P = (bf16*)(ws + WS_P); \
    bf16* CQN = (bf16*)(ws + WS_CQN); bf16* CKVN = (bf16*)(ws + WS_CKVN); bf16* Qb = (bf16*)(ws + WS_Q); bf16* Kb = (bf16*)(ws + WS_K); bf16* Vb = (bf16*)(ws + WS_V); \
    bf16* HFF = (bf16*)(ws + WS_HFF); float* YR = (float*)(ws + WS_YR); float* YG = (float*)(ws + WS_YG); float* GATE = (float*)(ws + WS_GATE); float* BONUS = (float*)(ws + WS_BONUS); \
    const float* MODV = (const float*)(ws + WS_MODV); const float* ROPE = (const float*)(ws + WS_ROPE); const float* modl = MODV + (size_t)l * 5 * MODS; \
    (void)X; (void)XM; (void)P; (void)CQN; (void)CKVN; (void)Qb; (void)Kb; (void)Vb; (void)HFF; (void)YR; (void)YG; (void)GATE; (void)BONUS; (void)ROPE; (void)modl; int t_ = TID(); OPQ(t_);

    STAMP(0);
    if (IN(0)) { const int lq = 0; LOCALS; phase_prologue(in, ws, lds, G, bx, t_); }
#ifdef DUP_PRO
    { XcdBarrier bar_; bar_.bar = (unsigned*)(args.ws + WS_CTL) + CW_BAR; bar_.x = xb_xcc_id(); bar_.st = (volatile LAS unsigned*)(lds + MISC_OFF) + 8; xcd_barrier(bar_); }
    if (IN(0)) { const int lq = 0; LOCALS; phase_prologue(in, ws, lds, G, bx, t_); }
#endif
    SEAM(0);
#ifdef DUP_BAR
    for (int nb_ = 0; nb_ < DUP_BAR; ++nb_) { XcdBarrier bar_; bar_.bar = (unsigned*)(args.ws + WS_CTL) + CW_BAR; bar_.x = xb_xcc_id(); bar_.st = (volatile LAS unsigned*)(lds + MISC_OFF) + 8; xcd_barrier(bar_); }
#endif
    if (IN(1)) { const int lq = 0; LOCALS; phase_modreduce(in, ws, G, bx, t_); }
    SEAM(1);
    if (IN(2)) { const int lq = 0; LOCALS; phase_modulate(X, XM, MODV, 0, D, G, bx, t_); }
    SEAM(2);

#pragma unroll 1
    for (int lq = 0; lq < DEPTH; ++lq) {
        const int g0 = 3 + 9 * lq;
        if (IN(g0 + 0)) for (int rep_ = 0; rep_ < NREP(0); ++rep_) { if (rep_) { XcdBarrier bar_; bar_.bar = (unsigned*)(args.ws + WS_CTL) + CW_BAR; bar_.x = xb_xcc_id(); bar_.st = (volatile LAS unsigned*)(lds + MISC_OFF) + 8; xcd_barrier(bar_); } LOCALS;
            pg8::Gemm g{XM, (const bf16*)(ws + WS_WIN) + (size_t)l * PC * D, M, PC, D, D}; pg8::StaticOrder S; S.init(M, PC, G, bx);
            pg8::EpiStore E{P, PC};
            pg8::gemm_phase<pg8::EpiStore, pg8::StaticOrder, true, true>(lds, g, S, E, t_);
        }
        SEAM(g0 + 0);
        if (IN(g0 + 1)) for (int rep_ = 0; rep_ < NREP(1); ++rep_) { if (rep_) { XcdBarrier bar_; bar_.bar = (unsigned*)(args.ws + WS_CTL) + CW_BAR; bar_.x = xb_xcc_id(); bar_.st = (volatile LAS unsigned*)(lds + MISC_OFF) + 8; xcd_barrier(bar_); } LOCALS;
#ifndef NO_MLAPREP
            mla_prep_rows(P, CQN, CKVN, Kb, in.p[7] + l * 512, in.p[8] + l * 512, ROPE, G, bx, t_);
#endif
            ScanW sw; sw.mu = in.p[11] + l * RW_COLS; sw.w0 = in.p[12] + l * 1024; sw.a0 = in.p[14] + l * 1024; sw.k_k = in.p[17] + l * 512; sw.k_a = in.p[18] + l * 512; sw.r_k = in.p[19] + l * 512;
            sw.W2T = (const bf16*)(ws + WS_W2T) + (size_t)l * 2 * 512 * 32; sw.A2T = (const bf16*)(ws + WS_A2T) + (size_t)l * 2 * 512 * 32; sw.G2T = (const bf16*)(ws + WS_G2T) + (size_t)l * 512 * 96;
            sw.conv = in.p[22] + l * 5 * 1536; sw.a_log = in.p[23] + l * 8; sw.dt_bias = in.p[24] + l * 8;
            {
                const int combo = bx & 15, h = combo >> 1, dir = combo & 1, nbl = (G >> 4) > 0 ? (G >> 4) : 1;
                int j = bx >> 4; unsigned chk = 0u;
                { int tw = TID(); OPQ(tw); rw_stage_weights(lds, sw, h, dir, tw); }

#pragma unroll 1
                for (; j < 272; j += nbl) { int tt = TID(); OPQ(tt);
#ifndef NO_S1R
                    const int jr = 271 - j;
                    const int b = jr / NCH, ci = jr % NCH, jn = (j + nbl < 272) ? j + nbl : j, tk = ((b * 8 + h) * 2 + dir) * NCH + ci;
                    s1_rwkv(lds, P, sw, ws + WS_RWT + (size_t)tk * RW_TASK, GATE, BONUS + (size_t)dir * M * 8, b, h, dir, ci, tt, chk, (271 - jn) / NCH, (271 - jn) % NCH);
#ifdef DUP_S1R
                    OPQ(tt); s1_rwkv(lds, P, sw, ws + WS_RWT + (size_t)tk * RW_TASK, GATE, BONUS + (size_t)dir * M * 8, b, h, dir, ci, tt, chk, (271 - jn) / NCH, (271 - jn) % NCH);
#endif
#endif
                }
                if (chk == 0x9e3779b9u) ((unsigned*)(ws + WS_CTL))[32] = chk;
            }
            {
                const int combo = bx & 7, h = combo >> 1, dir = combo & 1, nbl = (G >> 3) > 0 ? (G >> 3) : 1;
                __syncthreads();
                { int tw = TID(); OPQ(tw); gd_stage_weights(lds, sw, h, tw); }
#pragma unroll 1
                for (int j = bx >> 3; j < 272; j += nbl) { int tt = TID(); OPQ(tt);
#ifndef NO_S1G
                    const int jr = 271 - j, b = jr / NCH, ci = jr % NCH, tg = ((b * 4 + h) * 2 + dir) * NCH + ci;
                    s1_gdn(lds, P, sw, ws + WS_GDT + (size_t)tg * GD_TASK, b, h, dir, ci, tt);
#ifdef DUP_S1G
                    OPQ(tt); s1_gdn(lds, P, sw, ws + WS_GDT + (size_t)tg * GD_TASK, b, h, dir, ci, tt);
#endif
#endif
                }
            }
        }
        SEAM(g0 + 1);
        if (IN(g0 + 2)) for (int rep_ = 0; rep_ < NREP(2); ++rep_) { if (rep_) { XcdBarrier bar_; bar_.bar = (unsigned*)(args.ws + WS_CTL) + CW_BAR; bar_.x = xb_xcc_id(); bar_.st = (volatile LAS unsigned*)(lds + MISC_OFF) + 8; xcd_barrier(bar_); } LOCALS;
            const bool split = G >= 256;
#pragma unroll 1
#ifdef DUP_S2
            for (int rs_ = 0; rs_ < 2; ++rs_)
#endif
            for (int s = bx; s < 128; s += (split ? 1 << 20 : G)) {
#ifndef NO_S2R
                if (s < 64) { const int b = s >> 4, h = (s >> 1) & 7, dir = s & 1;
                    s2n_scan<64, true>(lds, ws + WS_RWT + (size_t)(((b * 8 + h) * 2 + dir) * NCH) * RW_TASK, RW_TASK, 0, 8192, 16384, 24576, 32768, 2, 0,
                                      YR + (size_t)dir * M * 512, h * 64, b, dir, t_); }
#endif
#ifndef NO_S2G
                if (s >= 64) { const int g = s - 64, vs = g & 1, dir = (g >> 1) & 1, h = (g >> 2) & 3, b = g >> 4;
                    s2n_scan<128, false>(lds, ws + WS_GDT + (size_t)(((b * 4 + h) * 2 + dir) * NCH) * GD_TASK, GD_TASK, 0, 32768, 49152, 81920, 98304, 4, vs,
                                        YG + (size_t)dir * M * 512, h * 128 + vs * 64, b, dir, t_); }
#endif
                __syncthreads();
            }
            OPQ(t_);
#ifndef NO_UPGEMM
            if (!split || bx >= 128) { const int Gg = split ? G - 128 : G, cg = split ? bx - 128 : bx;
#ifdef DUP_UPG
                for (int rg_ = 0; rg_ < 2; ++rg_) {
#endif
                { pg8::Gemm g{CQN, (const bf16*)(ws + WS_WUQ) + (size_t)l * 1536 * 512, M, 1536, 512, 512}; pg8::StaticOrder S; S.init(M, 1536, Gg, cg);
                  pg8::EpiStore E{Qb, QP}; pg8::gemm_phase<pg8::EpiStore, pg8::StaticOrder, true, true>(lds, g, S, E, t_); }
                __syncthreads(); OPQ(t_);
                { pg8::Gemm g{CKVN, (const bf16*)(ws + WS_WUKV) + (size_t)l * 2048 * 512, M, 2048, 512, 512}; pg8::StaticOrder S; S.init(M, 2048, Gg, cg);
                  pg8::EpiKV E{Kb, Vb}; pg8::gemm_phase<pg8::EpiKV, pg8::StaticOrder, true, true>(lds, g, S, E, t_); }
#ifdef DUP_UPG
                __syncthreads(); OPQ(t_); }
#endif
            }
#endif
        }
        SEAM(g0 + 2);
        if (IN(g0 + 3)) for (int rep_ = 0; rep_ < NREP(3); ++rep_) { if (rep_) { XcdBarrier bar_; bar_.bar = (unsigned*)(args.ws + WS_CTL) + CW_BAR; bar_.x = xb_xcc_id(); bar_.st = (volatile LAS unsigned*)(lds + MISC_OFF) + 8; xcd_barrier(bar_); } LOCALS;
#ifndef NO_MIXROWS
            mix_rows(P, YR, YG, GATE, BONUS, XM, in.p[11] + l * RW_COLS, in.p[20] + l * 512, in.p[21] + l * 512, in.p[25] + l * 128, G, bx, t_);
#endif
#ifndef NO_ATTN
            const int nunits = 512 + (l < DEPTH - 1 ? 32 : 0);
#pragma unroll 1
            for (int u = bx; u < nunits; u += G) { int tt = TID(); OPQ(tt);
                if (u < 512) { const int x = u & 7, j = u >> 3, bh = x + 8 * (j >> 4), qb = j & 15, b = bh >> 3, h = bh & 7;
                    const size_t qrow = (size_t)b * SEGT + CTX + qb * 256, krow = (size_t)b * SEGT;
                    at::attn_unit(Qb + qrow * QP + h * 192, Kb + krow * KP + h * 192, Vb + krow * VP + h * 128, XM + qrow * D + h * 128, SEGT, ROPE, qb * 256, (LAS char*)lds, tt); }
                else { const int bh = u - 512, b = bh >> 3, h = bh & 7; const size_t qrow = (size_t)b * SEGT;
                    at::attn_unit(Qb + qrow * QP + h * 192, Kb + qrow * KP + h * 192, Vb + qrow * VP + h * 128, XM + qrow * D + h * 128, CTX, nullptr, 0, (LAS char*)lds, tt); }
            }
#endif
        }
        SEAM(g0 + 3);
        if (IN(g0 + 4)) for (int rep_ = 0; rep_ < NREP(4); ++rep_) { if (rep_) { XcdBarrier bar_; bar_.bar = (unsigned*)(args.ws + WS_CTL) + CW_BAR; bar_.x = xb_xcc_id(); bar_.st = (volatile LAS unsigned*)(lds + MISC_OFF) + 8; xcd_barrier(bar_); } LOCALS;
            { pg8::Gemm g{XM, (const bf16*)(ws + WS_WOUT) + (size_t)l * D * D, M, D, D, D}; pg8::LatOrder S; S.init(D, G, bx);
              float alpha_ = ALPHA; OPQ(alpha_); pg8::EpiRes E{X, modl + 2 * D, MODS, alpha_};
              pg8::gemm_phase<pg8::EpiRes, pg8::LatOrder, true, true>(lds, g, S, E, t_);
#ifdef DUP_E
              __syncthreads(); OPQ(t_); { pg8::EpiStore E2{(bf16*)(ws + WS_HFF), D}; pg8::gemm_phase<pg8::EpiStore, pg8::LatOrder, true, true>(lds, g, S, E2, t_); }
#endif
            }
            if (l < DEPTH - 1) { __syncthreads(); OPQ(t_);
              pg8::Gemm g{XM, (const bf16*)(ws + WS_WOUT) + (size_t)l * D * D, M, D, D / 8, D}; pg8::CtxSplitOrder S; S.init(D, 8, D / 8, G, bx);
              pg8::EpiPart E{(float*)(ws + WS_PART)};
              pg8::gemm_phase<pg8::EpiPart, pg8::CtxSplitOrder, true, true>(lds, g, S, E, t_); }
        }
        SEAM(g0 + 4);
        if (IN(g0 + 5)) for (int rep_ = 0; rep_ < NREP(5); ++rep_) { if (rep_) { XcdBarrier bar_; bar_.bar = (unsigned*)(args.ws + WS_CTL) + CW_BAR; bar_.x = xb_xcc_id(); bar_.st = (volatile LAS unsigned*)(lds + MISC_OFF) + 8; xcd_barrier(bar_); } LOCALS; phase_ln(X, in.p[27] + l * D, in.p[28] + l * D, XM, modl, 3 * D, 4 * D, nullptr, (l < DEPTH - 1) ? (const float*)(ws + WS_PART) : nullptr, 8, modl + 4 * MODS + 2 * D, l == DEPTH - 1, G, bx, t_);
#ifdef DUP_LN
            { XcdBarrier bar_; bar_.bar = (unsigned*)(args.ws + WS_CTL) + CW_BAR; bar_.x = xb_xcc_id(); bar_.st = (volatile LAS unsigned*)(lds + MISC_OFF) + 8; xcd_barrier(bar_); }
            OPQ(t_); phase_ln(X, in.p[27] + l * D, in.p[28] + l * D, XM, modl, 3 * D, 4 * D, (float*)(ws + WS_Q), nullptr, 0, nullptr, true, G, bx, t_);
#endif
        }
        SEAM(g0 + 5);
        if (IN(g0 + 6)) for (int rep_ = 0; rep_ < NREP(6); ++rep_) { if (rep_) { XcdBarrier bar_; bar_.bar = (unsigned*)(args.ws + WS_CTL) + CW_BAR; bar_.x = xb_xcc_id(); bar_.st = (volatile LAS unsigned*)(lds + MISC_OFF) + 8; xcd_barrier(bar_); } LOCALS;
            pg8::Gemm g{XM, (const bf16*)(ws + WS_WGU) + (size_t)l * 2 * DFF * D, M, 2 * DFF, D, D}; pg8::EpiSwiGLU E{HFF, DFF};
            if (l < DEPTH - 1) { pg8::StaticOrder S; S.init(M, 2 * DFF, G, bx); pg8::gemm_phase<pg8::EpiSwiGLU, pg8::StaticOrder, true, true>(lds, g, S, E, t_); }
            else { pg8::LatOrder S; S.init(2 * DFF, G, bx); pg8::gemm_phase<pg8::EpiSwiGLU, pg8::LatOrder, true, true>(lds, g, S, E, t_); }
        }
        SEAM(g0 + 6);
        if (IN(g0 + 7)) for (int rep_ = 0; rep_ < NREP(7); ++rep_) { if (rep_) { XcdBarrier bar_; bar_.bar = (unsigned*)(args.ws + WS_CTL) + CW_BAR; bar_.x = xb_xcc_id(); bar_.st = (volatile LAS unsigned*)(lds + MISC_OFF) + 8; xcd_barrier(bar_); } LOCALS;
            { pg8::Gemm g{HFF, (const bf16*)(ws + WS_WDN) + (size_t)l * D * DFF, M, D, DFF, DFF}; pg8::LatOrder S; S.init(D, G, bx);
              float alpha_ = ALPHA; OPQ(alpha_); pg8::EpiRes E{X, modl + 5 * D, MODS, alpha_};
              pg8::gemm_phase<pg8::EpiRes, pg8::LatOrder, true, true>(lds, g, S, E, t_);
#ifdef DUP_H
              __syncthreads(); OPQ(t_); { pg8::EpiStore E2{(bf16*)(ws + WS_Q), D}; pg8::gemm_phase<pg8::EpiStore, pg8::LatOrder, true, true>(lds, g, S, E2, t_); }
#endif
            }
            if (l < DEPTH - 1) { __syncthreads(); OPQ(t_);
              pg8::Gemm g{HFF, (const bf16*)(ws + WS_WDN) + (size_t)l * D * DFF, M, D, DFF / 4, DFF}; pg8::CtxSplitOrder S; S.init(D, 4, DFF / 4, G, bx);
              pg8::EpiPart E{(float*)(ws + WS_PART)};
              pg8::gemm_phase<pg8::EpiPart, pg8::CtxSplitOrder, true, true>(lds, g, S, E, t_); }
        }
        SEAM(g0 + 7);
        if (IN(g0 + 8)) for (int rep_ = 0; rep_ < NREP(8); ++rep_) { if (rep_) { XcdBarrier bar_; bar_.bar = (unsigned*)(args.ws + WS_CTL) + CW_BAR; bar_.x = xb_xcc_id(); bar_.st = (volatile LAS unsigned*)(lds + MISC_OFF) + 8; xcd_barrier(bar_); } LOCALS;
            if (l < DEPTH - 1) phase_ln(X, in.p[32] + l * D, in.p[33] + l * D, XM, modl + 5 * MODS, 0, D, nullptr, (const float*)(ws + WS_PART), 4, modl + 4 * MODS + 5 * D, false, G, bx, t_);
            else phase_ln(X, in.p[32] + l * D, in.p[33] + l * D, XM, modl, 0, D, args.out, nullptr, 0, nullptr, true, G, bx, t_);
        }
        SEAM(g0 + 8);
    }
#ifdef TIMING
    __syncthreads();
    if (blockIdx.x == 0 && TID() == 0) { const unsigned long long* st = (const unsigned long long*)(args.ws + 16384); unsigned long long tot = 0;
        for (int g = 0; g < NPH; ++g) { const int cls = g < 3 ? 0 : 1 + (g - 3) % 9; if ((TIMING >> cls) & 1) tot += st[g + 1] - st[g]; }
        args.out[0] = (float)tot * 0.01f; }
#endif
#undef IN
#undef SEAM
}


#if defined(DBG_STOP)
__global__ void dbg_dump(float* out, const unsigned char* ws, int kind, size_t off, int pitch, size_t stride) {
    const size_t n = (size_t)cf::NB * cf::SEQ * cf::D;
    for (size_t i = (size_t)blockIdx.x * blockDim.x + threadIdx.x; i < n; i += (size_t)gridDim.x * blockDim.x) {
        const size_t rr = i / cf::D, c = i % cf::D, b = rr / cf::SEQ, t = rr % cf::SEQ, row = b * cf::SEGT + cf::CTX + t;
        float v;
        if (kind == 0) v = ((const float*)(ws + WS_X))[row * cf::D + c];
        else if (kind == 1) v = bf2f(((const bf16*)(ws + off))[row * (size_t)pitch + c]);
        else if (kind == 3) v = ((const float*)(ws + off))[(i * stride)];
        else if (kind == 4) v = ((const float*)(ws + off))[i % ((size_t)pitch * 1024)];
        else v = bf2f(((const bf16*)(ws + off))[i * stride]);
        if (!(fabsf(v) < 3.0e38f)) v = 1.0e30f;
        out[i] = v;
    }
}
#endif
#ifndef MK_MULTI
#define MK_MULTI 0
#endif
extern "C" void kernel_launch(void* const* d_in, const int* in_sizes, int n_in, void* d_out, int out_size, void* d_ws, size_t ws_size, hipStream_t stream) {
    static int grid = 0;
    if (grid == 0) {
        if (n_in != 34 || out_size != cf::NB * cf::SEQ * cf::D || ws_size < WS_END) { fprintf(stderr, "kernel_launch: shape mismatch (n_in %d out %d ws %zu)\n", n_in, out_size, ws_size); grid = -1; return; }
        int dev = 0, cus = 0;
        if (hipGetDevice(&dev) != hipSuccess || hipDeviceGetAttribute(&cus, hipDeviceAttributeMultiprocessorCount, dev) != hipSuccess) { grid = -1; return; }
        if (hipFuncSetAttribute((const void*)fwd, hipFuncAttributeMaxDynamicSharedMemorySize, LDS_BYTES) != hipSuccess) { fprintf(stderr, "kernel_launch: hipFuncSetAttribute failed\n"); grid = -1; return; }
        int per_cu = 0;
        if (hipOccupancyMaxActiveBlocksPerMultiprocessor(&per_cu, (const void*)fwd, NWAVES * 64, LDS_BYTES) != hipSuccess || per_cu < 1) fprintf(stderr, "kernel_launch: occupancy query says %d\n", per_cu);
        (void)hipGetLastError();
        grid = cus;
    }
    if (grid < 0) return;
    (void)hipMemsetAsync((char*)d_ws, 0, ZERO_BYTES, stream);
    Args a{};
    for (int i = 0; i < 34; ++i) a.in.p[i] = (const float*)d_in[i];
    a.out = (float*)d_out; a.ws = (uchar*)d_ws;
#if defined(PROBE)
    for (int g = 0; g < 7; ++g) { a.g_lo = g; a.g_hi = g + 1; hipLaunchKernelGGL(fwd, dim3(grid), dim3(NWAVES * 64), LDS_BYTES, stream, a); }
    { unsigned* res = (unsigned*)d_ws + 64; float* scratch = (float*)((char*)d_ws + WS_HFF + (400ull << 20));
      scratch = (float*)((char*)d_ws + WS_END);
      hipLaunchKernelGGL(probe, dim3(12), dim3(256), 0, stream, a.in, (uchar*)d_ws, res, scratch);
      hipLaunchKernelGGL(probe_cmp, dim3(256), dim3(256), 0, stream, (uchar*)d_ws, res, (const float*)scratch);
      for (int g = 7; g < NPH; ++g) { a.g_lo = g; a.g_hi = g + 1; hipLaunchKernelGGL(fwd, dim3(grid), dim3(NWAVES * 64), LDS_BYTES, stream, a); }
      hipLaunchKernelGGL(probe_out, dim3(1), dim3(64), 0, stream, (float*)d_out, (const unsigned*)res, PROBE_SELA, PROBE_SELB); }
#elif defined(DBG_STOP)
    for (int g = 0; g < DBG_STOP; ++g) { a.g_lo = g; a.g_hi = g + 1; hipLaunchKernelGGL(fwd, dim3(grid), dim3(NWAVES * 64), LDS_BYTES, stream, a); }
    hipLaunchKernelGGL(dbg_dump, dim3(2048), dim3(256), 0, stream, (float*)d_out, (const unsigned char*)d_ws, DBG_KIND, (size_t)DBG_OFF, DBG_PITCH, (size_t)DBG_STRIDE);
#elif MK_MULTI
    for (int g = 0; g < NPH; ++g) { a.g_lo = g; a.g_hi = g + 1; hipLaunchKernelGGL(fwd, dim3(grid), dim3(NWAVES * 64), LDS_BYTES, stream, a); }
#else
    a.g_lo = 0; a.g_hi = NPH;
    hipLaunchKernelGGL(fwd, dim3(grid), dim3(NWAVES * 64), LDS_BYTES, stream, a);
#endif
    const hipError_t le = hipPeekAtLastError();
    if (le != hipSuccess) fprintf(stderr, "kernel_launch: launch failed: %s\n", hipGetErrorName(le));
}
```

```cpp
#include <hip/hip_runtime.h>
#include <cstdio>
#include <cstdint>

#define DI __device__ __forceinline__
#define LAS __attribute__((address_space(3)))
#define GAS __attribute__((address_space(1)))
typedef unsigned short bf16;
typedef short bf16x8 __attribute__((ext_vector_type(8)));
typedef short s16x4 __attribute__((ext_vector_type(4)));
typedef float f32x4 __attribute__((ext_vector_type(4)));
typedef float f32x2 __attribute__((ext_vector_type(2)));
typedef float f32x16 __attribute__((ext_vector_type(16)));
typedef unsigned u32x4 __attribute__((ext_vector_type(4)));
typedef unsigned u32x2 __attribute__((ext_vector_type(2)));
typedef unsigned char uchar;
typedef __bf16 bf16x2_t __attribute__((ext_vector_type(2)));

namespace pg8 {
typedef unsigned short bf16_t;
#define PG8_LAS __attribute__((address_space(3)))
constexpr int BM = 256, BK = 64, HALF = 128, HTB = HALF * BK * 2  , STAGE_BYTES = 8 * HTB, NXCD = 8, WGM = 8;

__host__ __device__ __forceinline__ int lds_byte(int r, int c) { const int st = (r >> 4) * 2 + (c >> 5), rr = r & 15, cc = c & 31, ob = rr * 64 + cc * 2; return st * 1024 + (ob ^ (((ob >> 9) & 1) << 5)); }
__host__ __device__ __forceinline__ void stage_rc(int b, int& R, int& C) { const int st = b / 1024, sb = b % 1024, swz = sb ^ (((sb >> 9) & 1) << 5); R = (st >> 1) * 16 + swz / 64; C = (st & 1) * 32 + (swz % 64) / 2; }
__host__ __device__ __forceinline__ int perm32(int rho) { const int n = rho >> 4, i = rho & 15; return 8 * (i >> 2) + 4 * n + (i & 3); }

struct Unit { int pm, pn, ko, ks; };
struct Gemm { const bf16_t* A; const bf16_t* Bt; int M, N, K, ld; };

struct StaticOrder {
    int nM, nN, nwg, G, c;
    __host__ __device__ void init(int M, int N, int G_, int c_) { nM = M / BM; nN = N / BM; nwg = nM * nN; G = G_; c = c_; }
    __host__ __device__ bool next(int i, Unit& u) const {
        const long L = (long)i * G + c; if (L >= nwg) return false;
        int wgid = (int)L; { const int q = nwg / NXCD, r = nwg % NXCD, xcd = wgid % NXCD, off = wgid / NXCD; wgid = (xcd < r ? xcd * (q + 1) : r * (q + 1) + (xcd - r) * q) + off; }
        const int nig = WGM * nN, gid = wgid / nig, fm = gid * WGM, gsz = (nM - fm) < WGM ? (nM - fm) : WGM;
        u.pm = fm + ((wgid % nig) % gsz); u.pn = (wgid % nig) / gsz; u.ko = 0; u.ks = 0; return true;
    }
    __device__ __forceinline__ void a_ready(const Unit&) const {}
    __device__ __forceinline__ void done(const Unit&) const {}
};

struct LatOrder {
    StaticOrder S;
    __host__ __device__ void init(int N, int G_, int c_) { S.init(16384, N, G_, c_); }
    __host__ __device__ bool next(int i, Unit& u) const { if (!S.next(i, u)) return false; u.pm = (u.pm >> 4) * 17 + 1 + (u.pm & 15); return true; }
    __device__ __forceinline__ void a_ready(const Unit&) const {}
    __device__ __forceinline__ void done(const Unit&) const {}
};
struct CtxSplitOrder {
    int nN, KS, kbytes, G, c;
    __host__ __device__ void init(int N, int KS_, int Ksplit, int G_, int c_) { nN = N / BM; KS = KS_; kbytes = Ksplit * 2; G = G_; c = c_; }
    __host__ __device__ bool next(int i, Unit& u) const { const int j = i * G + c; if (j >= 4 * nN * KS) return false;
        const int ks = j % KS, cu = j / KS; u.pm = (cu / nN) * 17; u.pn = cu % nN; u.ks = ks; u.ko = ks * kbytes; return true; }
    __device__ __forceinline__ void a_ready(const Unit&) const {}
    __device__ __forceinline__ void done(const Unit&) const {}
};
__device__ __forceinline__ unsigned cvt_pk_bf16(float lo, float hi) { const f32x2 v = {lo, hi}; return __builtin_bit_cast(unsigned, __builtin_convertvector(v, bf16x2_t)); }
__device__ __forceinline__ u32x4 pack8(f32x4 v0, f32x4 v1) { u32x4 w; w.x = cvt_pk_bf16(v0[0], v0[1]); w.y = cvt_pk_bf16(v0[2], v0[3]); w.z = cvt_pk_bf16(v1[0], v1[1]); w.w = cvt_pk_bf16(v1[2], v1[3]); return w; }

struct EpiStore {
    static constexpr bool PERM = true, AFTER_DRAIN = false;
    bf16_t* O; int ldc;
    __device__ __forceinline__ void operator()(const f32x4 (&acc)[2][2][4][2], const Unit& u, int wr, int wc, int fr, int fq) const {
        const int row0 = u.pm * BM + wr * 64 + fr, col0 = u.pn * BM + wc * 32 + 8 * fq;
#pragma unroll
        for (int ai = 0; ai < 2; ++ai)
#pragma unroll
            for (int m = 0; m < 4; ++m) { bf16_t* rowp = O + (size_t)(row0 + ai * HALF + m * 16) * ldc + col0;
#pragma unroll
                for (int bj = 0; bj < 2; ++bj) *(u32x4*)(rowp + bj * HALF) = pack8(acc[ai][bj][m][0], acc[ai][bj][m][1]); }
    }
};
struct EpiKV {
    static constexpr bool PERM = true, AFTER_DRAIN = false;
    bf16_t* Kb; bf16_t* Vb;
    __device__ __forceinline__ void operator()(const f32x4 (&acc)[2][2][4][2], const Unit& u, int wr, int wc, int fr, int fq) const {
        const int row0 = u.pm * BM + wr * 64 + fr, c0 = wc * 32 + 8 * fq;
#pragma unroll
        for (int ai = 0; ai < 2; ++ai)
#pragma unroll
            for (int m = 0; m < 4; ++m) { const size_t row = (size_t)(row0 + ai * HALF + m * 16);
                *(u32x4*)(Kb + row * 1536 + u.pn * 192 + c0) = pack8(acc[ai][0][m][0], acc[ai][0][m][1]);
                *(u32x4*)(Vb + row * 1024 + u.pn * 128 + c0) = pack8(acc[ai][1][m][0], acc[ai][1][m][1]); }
    }
};
struct EpiSwiGLU {
    static constexpr bool PERM = true, AFTER_DRAIN = false;
    bf16_t* Hb; int ldh;
    __device__ __forceinline__ void operator()(const f32x4 (&acc)[2][2][4][2], const Unit& u, int wr, int wc, int fr, int fq) const {
        const int row0 = u.pm * BM + wr * 64 + fr, col0 = u.pn * HALF + wc * 32 + 8 * fq;
#pragma unroll
        for (int ai = 0; ai < 2; ++ai)
#pragma unroll
            for (int m = 0; m < 4; ++m) { f32x4 o[2];
#pragma unroll
                for (int n = 0; n < 2; ++n) { const f32x4 g = acc[ai][0][m][n], up = acc[ai][1][m][n];
#pragma unroll
                    for (int e = 0; e < 4; ++e) o[n][e] = g[e] * __builtin_amdgcn_rcpf(1.f + __expf(-g[e])) * up[e]; }
                *(u32x4*)(Hb + (size_t)(row0 + ai * HALF + m * 16) * ldh + col0) = pack8(o[0], o[1]); }
    }
};
struct EpiPart {
    static constexpr bool PERM = true, AFTER_DRAIN = false;
    float* part;
    __device__ __forceinline__ void operator()(const f32x4 (&acc)[2][2][4][2], const Unit& u, int wr, int wc, int fr, int fq) const {
        const int row0 = (u.pm / 17) * BM + wr * 64 + fr, col0 = u.pn * BM + wc * 32 + 8 * fq;
        float* base = part + (size_t)u.ks * 1024 * 2048;
#pragma unroll
        for (int ai = 0; ai < 2; ++ai)
#pragma unroll
            for (int m = 0; m < 4; ++m) { float* rowp = base + (size_t)(row0 + ai * HALF + m * 16) * 2048 + col0;
#pragma unroll
                for (int bj = 0; bj < 2; ++bj)
#pragma unroll
                    for (int n = 0; n < 2; ++n) *(f32x4*)(rowp + bj * HALF + 4 * n) = acc[ai][bj][m][n]; }
    }
};
struct EpiRes {
    static constexpr bool PERM = true, AFTER_DRAIN = false;
    float* X; const float* gate; int gstride; float alpha;
    __device__ __forceinline__ void operator()(const f32x4 (&acc)[2][2][4][2], const Unit& u, int wr, int wc, int fr, int fq) const {
        const int row0 = u.pm * BM + wr * 64 + fr, col0 = u.pn * BM + wc * 32 + 8 * fq;
        const int vec = (u.pm % 17 == 0) ? 4 : (u.pm / 17);
        const float* gp = gate + (size_t)vec * gstride + col0;
        f32x4 gv[2][2];
#pragma unroll
        for (int bj = 0; bj < 2; ++bj)
#pragma unroll
            for (int n = 0; n < 2; ++n) gv[bj][n] = *(const f32x4*)(gp + bj * HALF + 4 * n);
#pragma unroll
        for (int ai = 0; ai < 2; ++ai)
#pragma unroll
            for (int m = 0; m < 4; ++m) { float* rowp = X + (size_t)(row0 + ai * HALF + m * 16) * 2048 + col0;
#pragma unroll
                for (int bj = 0; bj < 2; ++bj)
#pragma unroll
                    for (int n = 0; n < 2; ++n) { f32x4* p = (f32x4*)(rowp + bj * HALF + 4 * n); const f32x4 x = *p; *p = x * alpha + gv[bj][n] * acc[ai][bj][m][n]; } }
    }
};

template <class Epi, class Sched, bool ALIGN_EPI = false, bool SP2 = false>
__device__ __forceinline__ void gemm_phase(PG8_LAS unsigned char* lds, const Gemm g, const Sched& S, const Epi& E, const int tid) {
    const int wid = __builtin_amdgcn_readfirstlane(tid >> 6), lane = tid & 63, wr = wid >> 2, wc = wid & 3, fr = lane & 15, fq = lane >> 4;
    const int K = g.ld, nt = g.K / BK;
    unsigned voffA[2], voffB[2];
#pragma unroll
    for (int i = 0; i < 2; ++i) { int R, C; stage_rc(tid * 16 + i * 8192, R, C); const int Rb = Epi::PERM ? ((R & ~31) + perm32(R & 31)) : R;
        voffA[i] = (unsigned)(R * K + C) * 2u; voffB[i] = (unsigned)(Rb * K + C) * 2u; }
    const size_t kstep = (size_t)(BK * 2);
    const size_t hstep = (size_t)HALF * K * 2;
    const size_t tstep = 2 * hstep;
    const unsigned ldsw = (unsigned)wid * 1024u;
    const int aoff = lds_byte(wr * 64 + fr, fq * 8), boff = lds_byte(wc * 32 + fr, fq * 8);
#define PG8_SA(b, h) (((b) * 2 + (h)) * HTB)
#define PG8_SB(b, h) ((4 + (b) * 2 + (h)) * HTB)
#define PG8_STAGE(bufoff, gbase, voff) do { _Pragma("unroll") for (int _i = 0; _i < 2; ++_i) \
        __builtin_amdgcn_global_load_lds((const unsigned*)((const char*)(gbase) + (voff)[_i]), (PG8_LAS unsigned*)(lds + (bufoff) + ldsw + _i * 8192), 16, 0, 0); } while (0)
#define PG8_LDA(dst, b, h) do { _Pragma("unroll") for (int m = 0; m < 4; ++m) _Pragma("unroll") for (int k = 0; k < 2; ++k) dst[m][k] = *(const PG8_LAS bf16x8*)(lds + PG8_SA(b, h) + aoff + m * 2048 + k * 1024); } while (0)
#define PG8_LDB(dst, b, h) do { _Pragma("unroll") for (int n = 0; n < 2; ++n) _Pragma("unroll") for (int k = 0; k < 2; ++k) dst[n][k] = *(const PG8_LAS bf16x8*)(lds + PG8_SB(b, h) + boff + n * 2048 + k * 1024); } while (0)
#define PG8_MMA(ai, bj, At, Bt) do { __builtin_amdgcn_s_setprio(1); _Pragma("unroll") for (int m = 0; m < 4; ++m) _Pragma("unroll") for (int n = 0; n < 2; ++n) _Pragma("unroll") for (int k = 0; k < 2; ++k) \
        acc[ai][bj][m][n] = __builtin_amdgcn_mfma_f32_16x16x32_bf16(Bt[n][k], At[m][k], acc[ai][bj][m][n], 0, 0, 0); __builtin_amdgcn_s_setprio(0); } while (0)
#define PG8_WAIT_V(n) asm volatile("s_waitcnt vmcnt(" #n ")" ::: "memory")
#define PG8_WAIT_L(n) asm volatile("s_waitcnt lgkmcnt(" #n ")" ::: "memory")
#define PG8_BAR __builtin_amdgcn_s_barrier()
#define PG8_SCHED __builtin_amdgcn_sched_barrier(0)
    Unit cur, nxt; int ui = 0;
    if (!S.next(0, cur)) return;
    f32x4 acc[2][2][4][2];
#pragma unroll
    for (int a = 0; a < 2; ++a)
#pragma unroll
        for (int b = 0; b < 2; ++b)
#pragma unroll
            for (int m = 0; m < 4; ++m)
#pragma unroll
                for (int n = 0; n < 2; ++n) acc[a][b][m][n] = (f32x4){0.f, 0.f, 0.f, 0.f};
    bf16x8 At[4][2], B0[2][2], B1[2][2];
    const char* cA = (const char*)g.A + (size_t)cur.pm * tstep + cur.ko; const char* cB = (const char*)g.Bt + (size_t)cur.pn * tstep + cur.ko;
    S.a_ready(cur);
    if constexpr (SP2) {
        PG8_STAGE(PG8_SB(0, 0), cB, voffB); PG8_STAGE(PG8_SB(0, 1), cB + hstep, voffB); PG8_STAGE(PG8_SA(0, 0), cA, voffA); PG8_STAGE(PG8_SA(0, 1), cA + hstep, voffA);
        if (wr == 1) PG8_BAR;
        PG8_WAIT_V(2); PG8_BAR;
        PG8_STAGE(PG8_SB(1, 0), cB + kstep, voffB); PG8_STAGE(PG8_SA(1, 0), cA + kstep, voffA); PG8_STAGE(PG8_SB(1, 1), cB + hstep + kstep, voffB);
        PG8_WAIT_V(6); PG8_BAR;
    } else {
        PG8_STAGE(PG8_SB(0, 0), cB, voffB); PG8_STAGE(PG8_SA(0, 0), cA, voffA); PG8_STAGE(PG8_SB(0, 1), cB + hstep, voffB); PG8_STAGE(PG8_SA(0, 1), cA + hstep, voffA);
        if (wr == 1) PG8_BAR;
        PG8_WAIT_V(4); PG8_BAR;
        PG8_STAGE(PG8_SB(1, 0), cB + kstep, voffB); PG8_STAGE(PG8_SA(1, 0), cA + kstep, voffA); PG8_STAGE(PG8_SB(1, 1), cB + hstep + kstep, voffB);
        PG8_WAIT_V(6); PG8_BAR;
    }
    for (;;) {
        const bool has_next = S.next(ui + 1, nxt);
        const char* nA = has_next ? (const char*)g.A + (size_t)nxt.pm * tstep + nxt.ko : cA; const char* nB = has_next ? (const char*)g.Bt + (size_t)nxt.pn * tstep + nxt.ko : cB;
        for (int t = 0; t < nt; t += 2) {
            const bool last = (t == nt - 2);
            const char* a1 = cA + (size_t)(t + 1) * kstep;
            const char* a2 = last ? nA : cA + (size_t)(t + 2) * kstep; const char* b2 = last ? nB : cB + (size_t)(t + 2) * kstep;
            const char* a3 = a2 + kstep; const char* b3 = b2 + kstep;
            if (last && has_next) S.a_ready(nxt);
            if constexpr (SP2) {
            PG8_LDB(B0, 0, 0); PG8_LDB(B1, 0, 1); PG8_SCHED; PG8_LDA(At, 0, 0); PG8_STAGE(PG8_SA(1, 1), a1 + hstep, voffA);
            PG8_WAIT_V(8); PG8_WAIT_L(0); PG8_BAR; PG8_MMA(0, 0, At, B0); PG8_MMA(0, 1, At, B1); PG8_BAR; PG8_SCHED;
            PG8_LDA(At, 0, 1); PG8_STAGE(PG8_SB(0, 0), b2, voffB); PG8_STAGE(PG8_SB(0, 1), b2 + hstep, voffB); PG8_STAGE(PG8_SA(0, 0), a2, voffA);
            PG8_WAIT_V(8); PG8_WAIT_L(0); PG8_BAR; PG8_MMA(1, 0, At, B0); PG8_MMA(1, 1, At, B1); PG8_BAR; PG8_SCHED;
            PG8_LDB(B0, 1, 0); PG8_LDB(B1, 1, 1); PG8_SCHED; PG8_LDA(At, 1, 0); PG8_STAGE(PG8_SA(0, 1), a2 + hstep, voffA);
            PG8_WAIT_V(8); PG8_WAIT_L(0); PG8_BAR; PG8_MMA(0, 0, At, B0); PG8_MMA(0, 1, At, B1); PG8_BAR; PG8_SCHED;
            PG8_LDA(At, 1, 1); PG8_STAGE(PG8_SB(1, 0), b3, voffB); PG8_STAGE(PG8_SB(1, 1), b3 + hstep, voffB); PG8_STAGE(PG8_SA(1, 0), a3, voffA);
            PG8_WAIT_V(8); PG8_WAIT_L(0); PG8_BAR; PG8_MMA(1, 0, At, B0); PG8_MMA(1, 1, At, B1); PG8_BAR; PG8_SCHED;
            } else {
            PG8_LDB(B0, 0, 0); PG8_SCHED; PG8_LDA(At, 0, 0); PG8_STAGE(PG8_SA(1, 1), a1 + hstep, voffA);
            PG8_WAIT_L(8); PG8_BAR; PG8_WAIT_L(0); PG8_MMA(0, 0, At, B0); PG8_BAR; PG8_SCHED;
            PG8_LDB(B1, 0, 1); PG8_STAGE(PG8_SB(0, 0), b2, voffB);
            PG8_BAR; PG8_WAIT_L(0); PG8_MMA(0, 1, At, B1); PG8_BAR;
            PG8_LDA(At, 0, 1); PG8_STAGE(PG8_SA(0, 0), a2, voffA);
            PG8_BAR; PG8_WAIT_L(0); PG8_MMA(1, 0, At, B0); PG8_BAR; PG8_SCHED;
            PG8_STAGE(PG8_SB(0, 1), b2 + hstep, voffB);
            PG8_WAIT_V(6); PG8_BAR; PG8_MMA(1, 1, At, B1); PG8_BAR;
            PG8_LDB(B0, 1, 0); PG8_SCHED; PG8_LDA(At, 1, 0); PG8_STAGE(PG8_SA(0, 1), a2 + hstep, voffA);
            PG8_WAIT_L(8); PG8_BAR; PG8_WAIT_L(0); PG8_MMA(0, 0, At, B0); PG8_BAR; PG8_SCHED;
            PG8_LDB(B1, 1, 1); PG8_STAGE(PG8_SB(1, 0), b3, voffB);
            PG8_BAR; PG8_WAIT_L(0); PG8_MMA(0, 1, At, B1); PG8_BAR;
            PG8_LDA(At, 1, 1); PG8_STAGE(PG8_SA(1, 0), a3, voffA);
            PG8_BAR; PG8_WAIT_L(0); PG8_MMA(1, 0, At, B0); PG8_BAR; PG8_SCHED;
            PG8_STAGE(PG8_SB(1, 1), b3 + hstep, voffB);
            PG8_WAIT_V(6); PG8_BAR; PG8_MMA(1, 1, At, B1); PG8_BAR;
            }
        }
        if constexpr (ALIGN_EPI) { if (wr == 0) PG8_BAR; }
        if constexpr (!Epi::AFTER_DRAIN) { E(acc, cur, wr, wc, fr, fq); S.done(cur); }
        if (!has_next) break;
#pragma unroll
        for (int a = 0; a < 2; ++a)
#pragma unroll
            for (int b = 0; b < 2; ++b)
#pragma unroll
                for (int m = 0; m < 4; ++m)
#pragma unroll
                    for (int n = 0; n < 2; ++n) acc[a][b][m][n] = (f32x4){0.f, 0.f, 0.f, 0.f};
        cur = nxt; cA = nA; cB = nB; ++ui;
        if constexpr (ALIGN_EPI) { if (wr == 1) PG8_BAR; }
    }
    PG8_WAIT_V(0);
    if constexpr (!ALIGN_EPI) { if (wr == 0) PG8_BAR; }
    PG8_BAR;
    if constexpr (Epi::AFTER_DRAIN) { E.fused(acc, cur, wr, wc, fr, fq, lds, wid, lane); S.done(cur); }
#undef PG8_SA
#undef PG8_SB
#undef PG8_STAGE
#undef PG8_LDA
#undef PG8_LDB
#undef PG8_MMA
#undef PG8_WAIT_V
#undef PG8_WAIT_L
#undef PG8_BAR
#undef PG8_SCHED
}
}
namespace cf {
constexpr int D = 2048, NB = 4, SEQ = 4096, CTX = 256, SEGT = 4352, M = 17408, DEPTH = 4;
constexpr int IN_COLS = 4912, PC = 5120;
constexpr int C_CQ = 0, C_CKV = 512, C_KR = 1024, C_RW = 1088, C_GD = 2848;
constexpr int RW_K = 512, RW_V = 1024, RW_WD = 1536, RW_AD = 1600, RW_GD = 1664, RW_COLS = 1760;
constexpr int GD_K = 512, GD_V = 1024, GD_Z = 1536, GD_A = 2048, GD_B = 2056;
constexpr int DFF = 5632, NCH = 68;
constexpr int QP = 1536, KP = 1536, VP = 1024;
constexpr int MODS = 6 * D;
constexpr float ALPHA = 1.681792830507429f;
constexpr int RW_TASK = 33024, GD_TASK = 98816;
}
constexpr size_t MiB = 1u << 20;
constexpr size_t WS_CTL = 0, WS_MODV = 1 * MiB, ZERO_BYTES = 2 * MiB;
constexpr size_t WS_ROPE = 2 * MiB, WS_W2T = 2 * MiB + 65536, WS_A2T = WS_W2T + 262144, WS_G2T = WS_A2T + 262144;
constexpr size_t WS_WIN = 4 * MiB, WS_WOUT = 84 * MiB, WS_WGU = 116 * MiB, WS_WDN = 292 * MiB, WS_WUQ = 380 * MiB, WS_WUKV = 386 * MiB;
constexpr size_t WS_X = 394 * MiB, WS_XM = 530 * MiB;
constexpr size_t WS_P = 598 * MiB, WS_CQN = 768 * MiB, WS_CKVN = 785 * MiB, WS_Q = 802 * MiB, WS_K = 853 * MiB, WS_V = 904 * MiB;
constexpr size_t WS_RWT = 938 * MiB, WS_GDT = 1076 * MiB, WS_YR = 1333 * MiB, WS_YG = 1401 * MiB, WS_GATE = 1469 * MiB, WS_BONUS = 1503 * MiB, WS_END = 1505 * MiB;
constexpr size_t WS_PART = 1076 * MiB;
constexpr size_t WS_HFF = 598 * MiB;
static_assert(WS_RWT + (size_t)4352 * cf::RW_TASK <= WS_GDT && WS_GDT + (size_t)2176 * cf::GD_TASK <= WS_YR && WS_HFF + (size_t)cf::M * cf::DFF * 2 <= WS_CKVN, "ws map");
constexpr int CW_TMO = 0, CW_BAR = 4096;
constexpr int LDS_BYTES = 163840, MISC_OFF = LDS_BYTES - 128;

DI float bflo(unsigned w) { return __builtin_bit_cast(float, w << 16); }
DI float bfhi(unsigned w) { return __builtin_bit_cast(float, w & 0xffff0000u); }
DI float bf2f(bf16 h) { return __builtin_bit_cast(float, (unsigned)h << 16); }
DI bf16 f2bf(float f) { unsigned u = __builtin_bit_cast(unsigned, f); return (bf16)((u + 0x7fffu + ((u >> 16) & 1u)) >> 16); }
DI unsigned pk2(float lo, float hi) { const f32x2 v = {lo, hi}; return __builtin_bit_cast(unsigned, __builtin_convertvector(v, bf16x2_t)); }
DI void unpack8(u32x4 w, float (&f)[8]) { f[0] = bflo(w.x); f[1] = bfhi(w.x); f[2] = bflo(w.y); f[3] = bfhi(w.y); f[4] = bflo(w.z); f[5] = bfhi(w.z); f[6] = bflo(w.w); f[7] = bfhi(w.w); }
DI u32x4 pack8f(const float (&f)[8]) { u32x4 w; w.x = pk2(f[0], f[1]); w.y = pk2(f[2], f[3]); w.z = pk2(f[4], f[5]); w.w = pk2(f[6], f[7]); return w; }
template <int X> DI float sx(float v) { return __builtin_bit_cast(float, __builtin_amdgcn_ds_swizzle(__builtin_bit_cast(int, v), 0x1F | (X << 10))); }
DI float lx(float v, int lane, int X) { return __builtin_bit_cast(float, __builtin_amdgcn_ds_bpermute((lane ^ X) << 2, __builtin_bit_cast(int, v))); }
DI float wave_sum(float v, int lane) {
    v += sx<1>(v); v += sx<2>(v); v += sx<4>(v); v += lx(v, lane, 8); v += lx(v, lane, 16); v += lx(v, lane, 32);
    return v;
}
DI float sigmoidf_(float x) { return __builtin_amdgcn_rcpf(1.f + __expf(-x)); }
DI float tanhf_(float x) { return 1.f - 2.f * __builtin_amdgcn_rcpf(1.f + __expf(2.f * x)); }
DI float softplusf_(float x) { const float e = __expf(x); return x > 20.f ? x : (x < -9.f ? e * (1.f - 0.5f * e) : __logf(1.f + e)); }
#define LDS_BARRIER() do { asm volatile("s_waitcnt lgkmcnt(0)" ::: "memory"); __builtin_amdgcn_s_barrier(); asm volatile("" ::: "memory"); } while (0)
#define LDS_WAIT() asm volatile("s_waitcnt lgkmcnt(0)" ::: "memory")
#define MFMA16(a, b, c) __builtin_amdgcn_mfma_f32_16x16x32_bf16((a), (b), (c), 0, 0, 0)

#define XB_TMO      128
#define XB_XCNT(j)  (256  + 64 * (j))
#define XB_XSUB(j)  (1280 + 64 * (j))
#define XB_XGEN(j)  (2304 + 64 * (j))
#define XB_TOP      3328
#define XB_TOPGEN   3392
#define XCD_BAR_WORDS 3456
#define XB_SPIN_CAP (1u << 22)
__device__ __forceinline__ unsigned xb_ld(unsigned* p)              { return __hip_atomic_load(p, __ATOMIC_RELAXED, __HIP_MEMORY_SCOPE_AGENT); }
__device__ __forceinline__ unsigned xb_add(unsigned* p, unsigned v) { return __hip_atomic_fetch_add(p, v, __ATOMIC_RELAXED, __HIP_MEMORY_SCOPE_AGENT); }
__device__ __forceinline__ unsigned xb_xcc_id() { return (unsigned)__builtin_amdgcn_s_getreg((3 << 11) | 20) & 0xFu; }
#define XB_SPIN(cond, bar) do { unsigned _sp = 0; while (cond) { __builtin_amdgcn_s_sleep(1); \
    if ((++_sp & 255u) == 0u) { if (xb_ld(&(bar)[XB_TMO])) break; if (_sp > XB_SPIN_CAP) { atomicAdd(&(bar)[XB_TMO], 1u); break; } } } } while (0)
struct XcdBarrier { unsigned* bar; unsigned x; volatile LAS unsigned* st; };
__device__ __forceinline__ XcdBarrier xcd_barrier_post(unsigned* bar, volatile LAS unsigned* st) {
    XcdBarrier b; b.bar = bar; b.x = xb_xcc_id(); b.st = st;
    if (threadIdx.x == 0) (void)xb_add(&bar[XB_XCNT(b.x)], 1u);
    return b;
}
__device__ __forceinline__ void xcd_barrier_complete(unsigned* bar, unsigned x, unsigned& nloc, unsigned& nx) {
    const unsigned G = gridDim.x * gridDim.y * gridDim.z;
    unsigned sum, cnt, mine, sp = 0u;
    for (;;) {
        sum = 0u; cnt = 0u; mine = 0u;
#pragma unroll
        for (unsigned j = 0; j < 16; ++j) { const unsigned c = xb_ld(&bar[XB_XCNT(j)]); sum += c; cnt += (c > 0u) ? 1u : 0u; mine = (j == x) ? c : mine; }
        if (sum == G) break;
        __builtin_amdgcn_s_sleep(1);
        if ((++sp & 255u) == 0u) { if (xb_ld(&bar[XB_TMO])) break; if (sp > XB_SPIN_CAP) { atomicAdd(&bar[XB_TMO], 1u); break; } }
    }
    nloc = mine > 0u ? mine : 1u; nx = cnt > 0u ? cnt : 1u;
}
__device__ __forceinline__ void xcd_barrier(const XcdBarrier& b) {
    asm volatile("s_waitcnt vmcnt(0)" ::: "memory");
    __syncthreads();
    if (threadIdx.x == 0) {
        unsigned* bar = b.bar;
        __builtin_amdgcn_s_waitcnt(0);
        unsigned nloc = b.st[0], nx = b.st[1];
        if (nloc == 0u) { xcd_barrier_complete(bar, b.x, nloc, nx); b.st[0] = nloc; b.st[1] = nx; }
        const unsigned old = xb_add(&bar[XB_XSUB(b.x)], 1u);
        const unsigned gen = old / nloc;
        if (old + 1u == (gen + 1u) * nloc) {
            __builtin_amdgcn_fence(__ATOMIC_RELEASE, "agent");
            asm volatile("s_waitcnt vmcnt(0)" ::: "memory");
            const unsigned og = xb_add(&bar[XB_TOP], 1u);
            const unsigned tg = og / nx;
            if (og + 1u == (tg + 1u) * nx) xb_add(&bar[XB_TOPGEN], 1u);
            else XB_SPIN(xb_ld(&bar[XB_TOPGEN]) == tg, bar);
            __builtin_amdgcn_fence(__ATOMIC_ACQUIRE, "agent");
            xb_add(&bar[XB_XGEN(b.x)], 1u);
            asm volatile("s_waitcnt vmcnt(0)" ::: "memory");
        } else {
            XB_SPIN(xb_ld(&bar[XB_XGEN(b.x)]) == gen, bar);
            __builtin_amdgcn_fence(__ATOMIC_ACQUIRE, "agent");
            asm volatile("s_waitcnt vmcnt(0)" ::: "memory");
        }
    }
    __syncthreads();
}

DI int row_of(int b, int dir, int ci, int i) {
    int s;
    if (dir == 0) s = ci * 64 + i;
    else s = (ci < 4) ? (3 - ci) * 64 + (63 - i) : 256 + (67 - ci) * 64 + (63 - i);
    return b * cf::SEGT + s;
}
DI void transpose_item(const float* W, int K, int N, bf16* WT, int out_row0, int k0, int n0, LAS float* scr, int lane) {
    const int n = n0 + (lane & 31); const bool ok = n < N;
#pragma unroll 8
    for (int i = 0; i < 32; ++i) { const int kk = 2 * i + (lane >> 5); scr[kk * 33 + (lane & 31)] = ok ? W[(size_t)(k0 + kk) * N + n] : 0.f; }
    LDS_WAIT();
    const int c = lane & 7;
#pragma unroll
    for (int j = 0; j < 4; ++j) { const int nn = (lane >> 3) + 8 * j; const LAS float* s = scr + (8 * c) * 33 + nn;
        u32x4 o; o.x = pk2(s[0 * 33], s[1 * 33]); o.y = pk2(s[2 * 33], s[3 * 33]); o.z = pk2(s[4 * 33], s[5 * 33]); o.w = pk2(s[6 * 33], s[7 * 33]);
        *(u32x4*)(WT + (size_t)(out_row0 + nn) * K + k0 + 8 * c) = o; }
    LDS_WAIT();
}

struct In { const float* p[34]; };

DI void phase_prologue(const In& in, uchar* ws, LAS uchar* lds, int G, int bx, int tid) {
    using namespace cf;
    const int lane = tid & 63, wid = __builtin_amdgcn_readfirstlane(tid >> 6), gw = bx * 8 + wid, NGW = G * 8;
    LAS float* scr = (LAS float*)(lds + wid * 16384);
    constexpr int I_IN = 32 * 160, I_OUT = 32 * 64, I_G = 32 * 176, I_DN = 88 * 64, I_UQ = 8 * 48, I_UKV = 8 * 64;
    constexpr int I_LAYER = I_IN + I_OUT + 2 * I_G + I_DN + I_UQ + I_UKV;
    for (int it = gw; it < DEPTH * I_LAYER; it += NGW) {
        const int l = it / I_LAYER; int r = it % I_LAYER;
        if (r < I_IN) { const int kb = r / 160, nb = r % 160; transpose_item(in.p[6] + (size_t)l * D * IN_COLS, D, IN_COLS, (bf16*)(ws + WS_WIN) + (size_t)l * PC * D, nb * 32, kb * 64, nb * 32, scr, lane); continue; } r -= I_IN;
        if (r < I_OUT) { const int kb = r / 64, nb = r % 64; transpose_item(in.p[26] + (size_t)l * D * D, D, D, (bf16*)(ws + WS_WOUT) + (size_t)l * D * D, nb * 32, kb * 64, nb * 32, scr, lane); continue; } r -= I_OUT;
        if (r < 2 * I_G) { const int up = r >= I_G; if (up) r -= I_G; const int kb = r / 176, nb = r % 176, n0 = nb * 32;
            transpose_item(in.p[up ? 30 : 29] + (size_t)l * D * DFF, D, DFF, (bf16*)(ws + WS_WGU) + (size_t)l * 2 * DFF * D, 256 * (n0 / 128) + (n0 % 128) + (up ? 128 : 0), kb * 64, n0, scr, lane); continue; } r -= 2 * I_G;
        if (r < I_DN) { const int kb = r / 64, nb = r % 64; transpose_item(in.p[31] + (size_t)l * DFF * D, DFF, D, (bf16*)(ws + WS_WDN) + (size_t)l * D * DFF, nb * 32, kb * 64, nb * 32, scr, lane); continue; } r -= I_DN;
        if (r < I_UQ) { const int kb = r / 48, nb = r % 48; transpose_item(in.p[9] + (size_t)l * 512 * 1536, 512, 1536, (bf16*)(ws + WS_WUQ) + (size_t)l * 1536 * 512, nb * 32, kb * 64, nb * 32, scr, lane); continue; } r -= I_UQ;
        { const int kb = r / 64, nb = r % 64; transpose_item(in.p[10] + (size_t)l * 512 * 2048, 512, 2048, (bf16*)(ws + WS_WUKV) + (size_t)l * 2048 * 512, nb * 32, kb * 64, nb * 32, scr, lane); }
    }
    float* X = (float*)(ws + WS_X);
    for (int r = gw; r < M; r += NGW) { const int b = r / SEGT, s = r % SEGT;
        const float* src = (s < CTX) ? in.p[2] + ((size_t)b * CTX + s) * D : in.p[0] + ((size_t)b * SEQ + (s - CTX)) * D;
        const f32x4* sp = (const f32x4*)src + lane; f32x4* dp = (f32x4*)(X + (size_t)r * D) + lane;
#pragma unroll
        for (int j = 0; j < 8; ++j) dp[64 * j] = sp[64 * j]; }
    const int gt = bx * 512 + tid, NGT = G * 512;
    float* rope = (float*)(ws + WS_ROPE);
    for (int i = gt; i < 1024; i += NGT) { const int pos = i >> 4, f = i & 15; const float inv = powf(10000.f, -(float)f / 16.f), ang = (float)pos * inv; rope[i] = cosf(ang); rope[1024 + i] = sinf(ang); }
    bf16* W2T = (bf16*)(ws + WS_W2T); bf16* A2T = (bf16*)(ws + WS_A2T); bf16* G2T = (bf16*)(ws + WS_G2T);
    for (int i = gt; i < DEPTH * 2 * 512 * 32; i += NGT) { const int r = i & 31, c = (i >> 5) & 511, ld = i >> 14;
        W2T[i] = f2bf(in.p[13][((size_t)ld * 32 + r) * 512 + c]); A2T[i] = f2bf(in.p[15][((size_t)ld * 32 + r) * 512 + c]); }
    for (int i = gt; i < DEPTH * 512 * 96; i += NGT) { const int k = i % 96, c = (i / 96) % 512, l = i / (96 * 512);
        G2T[i] = f2bf(in.p[16][((size_t)l * 96 + k) * 512 + c]); }
    LAS float* sv = scr;
    for (int it = gw; it < DEPTH * 48 * 16; it += NGW) {
        const int kp = it & 15, ng = (it >> 4) % 48, l = it / (16 * 48);
        for (int i = lane; i < 640; i += 64) { const int v = i >> 7, k = kp * 128 + (i & 127); const float x = (v < 4) ? in.p[1][v * D + k] : in.p[3][k]; sv[i] = x * sigmoidf_(x); }
        LDS_WAIT();
        const int n = ng * 256 + lane * 4;
        const float* wp = in.p[4] + ((size_t)l * D + (size_t)kp * 128) * MODS + n;
        f32x4 acc[5];
#pragma unroll
        for (int v = 0; v < 5; ++v) acc[v] = (f32x4){0.f, 0.f, 0.f, 0.f};
#pragma unroll 8
        for (int kk = 0; kk < 128; ++kk) { const f32x4 w = *(const f32x4*)(wp + (size_t)kk * MODS);
#pragma unroll
            for (int v = 0; v < 5; ++v) acc[v] += w * sv[v * 128 + kk]; }
        float* part = (float*)(ws + WS_P) + (size_t)kp * (DEPTH * 5 * MODS);
#pragma unroll
        for (int v = 0; v < 5; ++v) *(f32x4*)(part + ((size_t)l * 5 + v) * MODS + n) = acc[v];
        LDS_WAIT();
    }
}

DI void phase_modreduce(const In& in, uchar* ws, int G, int bx, int tid) {
    using namespace cf;
    float* modv = (float*)(ws + WS_MODV); const float* part = (const float*)(ws + WS_P);
    for (int i = bx * 512 + tid; i < DEPTH * 5 * MODS / 4; i += G * 512) { const int n4 = i % (MODS / 4), l = i / (5 * MODS / 4);
        f32x4 s = *(const f32x4*)(in.p[5] + (size_t)l * MODS + n4 * 4);
#pragma unroll
        for (int kp = 0; kp < 16; ++kp) s += *(const f32x4*)(part + (size_t)kp * (DEPTH * 5 * MODS) + (size_t)i * 4);
        *(f32x4*)(modv + (size_t)i * 4) = s; }
}

DI void phase_modulate(const float* X, bf16* XM, const float* modl  , int shift_off, int scale_off, int G, int bx, int tid) {
    using namespace cf;
    const int lane = tid & 63, gw = bx * 8 + __builtin_amdgcn_readfirstlane(tid >> 6), NGW = G * 8;
    for (int r = gw; r < M; r += NGW) { const int b = r / SEGT, s = r % SEGT, vec = (s < CTX) ? 4 : b;
        const f32x4* xp = (const f32x4*)(X + (size_t)r * D) + lane; const f32x4* sh = (const f32x4*)(modl + (size_t)vec * MODS + shift_off) + lane; const f32x4* sc = (const f32x4*)(modl + (size_t)vec * MODS + scale_off) + lane;
        u32x2* op = (u32x2*)(XM + (size_t)r * D) + lane;
#pragma unroll
        for (int j = 0; j < 8; ++j) { const f32x4 v = xp[64 * j] * (sc[64 * j] + 1.f) + sh[64 * j]; u32x2 o; o.x = pk2(v.x, v.y); o.y = pk2(v.z, v.w); op[64 * j] = o; } }
}

DI void ln_one_row(float* X, f32x4 (&v)[8], int r, const float* g, const float* bb, bf16* XM, const float* modl, int shift_off, int scale_off, float* out, const float* part, int nparts, const float* cgate, int lane) {
    using namespace cf;
    const int b = r / SEGT, s = r % SEGT, vec = (s < CTX) ? 4 : b;
    f32x4* xp = (f32x4*)(X + (size_t)r * D) + lane;
    float sum = 0.f;
    if (part && s < CTX) {
        const f32x4* gp4 = (const f32x4*)cgate + lane;
#pragma unroll
        for (int j = 0; j < 8; ++j) { f32x4 a = (f32x4){0.f, 0.f, 0.f, 0.f};
            for (int ks = 0; ks < nparts; ++ks) a += *((const f32x4*)(part + ((size_t)ks * 1024 + b * 256 + s) * D) + lane + 64 * j);
            v[j] = v[j] * ALPHA + gp4[64 * j] * a; } }
#pragma unroll
    for (int j = 0; j < 8; ++j) sum += (v[j].x + v[j].y) + (v[j].z + v[j].w);
    const float mean = wave_sum(sum, lane) * (1.f / D); float s2 = 0.f;
#pragma unroll
    for (int j = 0; j < 8; ++j) { v[j] = v[j] - mean; s2 += (v[j].x * v[j].x + v[j].y * v[j].y) + (v[j].z * v[j].z + v[j].w * v[j].w); }
    const float rstd = rsqrtf(wave_sum(s2, lane) * (1.f / D) + 1e-5f);
    const f32x4* gp = (const f32x4*)g + lane; const f32x4* bp = (const f32x4*)bb + lane;
#pragma unroll
    for (int j = 0; j < 8; ++j) v[j] = v[j] * rstd * gp[64 * j] + bp[64 * j];
    if (out) { f32x4* op = (f32x4*)(out + ((size_t)b * SEQ + (s - CTX)) * D) + lane;
#pragma unroll
        for (int j = 0; j < 8; ++j) op[64 * j] = v[j];
    } else {
        const f32x4* sh = (const f32x4*)(modl + (size_t)vec * MODS + shift_off) + lane; const f32x4* sc = (const f32x4*)(modl + (size_t)vec * MODS + scale_off) + lane;
        u32x2* op = (u32x2*)(XM + (size_t)r * D) + lane;
#pragma unroll
        for (int j = 0; j < 8; ++j) { xp[64 * j] = v[j]; const f32x4 m = v[j] * (sc[64 * j] + 1.f) + sh[64 * j]; u32x2 o; o.x = pk2(m.x, m.y); o.y = pk2(m.z, m.w); op[64 * j] = o; }
    }
}
DI void phase_ln(float* X, const float* g, const float* bb, bf16* XM, const float* modl, int shift_off, int scale_off, float* out, const float* part, int nparts, const float* cgate, bool skip_ctx, int G, int bx, int tid) {
    using namespace cf;
    const int lane = tid & 63, gw = bx * 8 + __builtin_amdgcn_readfirstlane(tid >> 6), NGW = G * 8;
    for (int r0 = gw; r0 < M; r0 += 2 * NGW) {
        const int r1 = r0 + NGW;
        const bool do0 = !(skip_ctx && (r0 % SEGT) < CTX), do1 = r1 < M && !(skip_ctx && (r1 % SEGT) < CTX);
        f32x4 va[8], vb[8];
        if (do0) { const f32x4* xp = (const f32x4*)(X + (size_t)r0 * D) + lane;
#pragma unroll
            for (int j = 0; j < 8; ++j) va[j] = xp[64 * j]; }
        if (do1) { const f32x4* xp = (const f32x4*)(X + (size_t)r1 * D) + lane;
#pragma unroll
            for (int j = 0; j < 8; ++j) vb[j] = xp[64 * j]; }
        if (do0) ln_one_row(X, va, r0, g, bb, XM, modl, shift_off, scale_off, out, part, nparts, cgate, lane);
        if (do1) ln_one_row(X, vb, r1, g, bb, XM, modl, shift_off, scale_off, out, part, nparts, cgate, lane);
    }
}

DI void mla_prep_rows(const bf16* P, bf16* CQN, bf16* CKVN, bf16* Kb, const float* qn, const float* kvn, const float* rope, int G, int bx, int tid) {
    using namespace cf;
    const int lane = tid & 63, gw = bx * 8 + __builtin_amdgcn_readfirstlane(tid >> 6), NGW = G * 8;
    const f32x4 gq0 = *(const f32x4*)(qn + lane * 8), gq1 = *(const f32x4*)(qn + lane * 8 + 4), gk0 = *(const f32x4*)(kvn + lane * 8), gk1 = *(const f32x4*)(kvn + lane * 8 + 4);
    const int axis = lane >> 5, half = (lane >> 4) & 1, f = lane & 15;
    for (int r0 = gw; r0 < M; r0 += 2 * NGW) {
        const int r1 = (r0 + NGW < M) ? r0 + NGW : r0;
        const bf16* pa = P + (size_t)r0 * PC; const bf16* pb = P + (size_t)r1 * PC;
        const u32x4 a0 = *(const u32x4*)(pa + lane * 8), a1 = *(const u32x4*)(pa + 512 + lane * 8), b0 = *(const u32x4*)(pb + lane * 8), b1 = *(const u32x4*)(pb + 512 + lane * 8);
        const bf16 ka = pa[C_KR + lane], kb = pb[C_KR + lane];
#pragma unroll
        for (int rr = 0; rr < 2; ++rr) { const int r = rr ? r1 : r0, s = r % SEGT;
#pragma unroll
            for (int part = 0; part < 2; ++part) {
                float x[8]; unpack8(rr ? (part ? b1 : b0) : (part ? a1 : a0), x);
                float ss = 0.f;
#pragma unroll
                for (int e = 0; e < 8; ++e) ss += x[e] * x[e];
                const float rs = rsqrtf(wave_sum(ss, lane) * (1.f / 512.f) + 1e-6f);
                const f32x4 g0 = part ? gk0 : gq0, g1 = part ? gk1 : gq1;
                float o[8];
#pragma unroll
                for (int e = 0; e < 8; ++e) o[e] = x[e] * rs * (e < 4 ? g0[e] : g1[e - 4]);
                *(u32x4*)((part ? CKVN : CQN) + (size_t)r * 512 + lane * 8) = pack8f(o);
            }
            float kr = bf2f(rr ? kb : ka);
            const float other = lx(kr, lane, 16);
            if (s >= CTX) { const int t = s - CTX, pos = axis ? (t & 63) : (t >> 6);
                const float c = rope[pos * 16 + f], sn = rope[1024 + pos * 16 + f];
                kr = half ? (other * sn + kr * c) : (kr * c - other * sn); }
            const bf16 kq = f2bf(kr);
#pragma unroll
            for (int h = 0; h < 8; ++h) Kb[(size_t)r * KP + h * 192 + 128 + lane] = kq;
        }
    }
}

DI void mix_rows(const bf16* P, const float* YR, const float* YG, const float* GATE, const float* BONUS, bf16* MIX,
                 const float* mu, const float* gn_g, const float* gn_b, const float* gdn_norm, int G, int bx, int tid) {
    using namespace cf;
    const int lane = tid & 63, gw = bx * 8 + __builtin_amdgcn_readfirstlane(tid >> 6), NGW = G * 8;
#pragma unroll 2
    for (int r = gw; r < M; r += NGW) { const int s = r % SEGT; const bf16* pr = P + (size_t)r * PC;
        const bool hasp = (s != 0) && (s != CTX), hasn = (s != CTX - 1) && (s != SEGT - 1);
        const int c0 = lane * 8;
        {
            float y[8], v[8];
            { const f32x4 a0 = *(const f32x4*)(YR + (size_t)r * 512 + c0), a1 = *(const f32x4*)(YR + (size_t)r * 512 + c0 + 4);
              const f32x4 b0 = *(const f32x4*)(YR + ((size_t)M + r) * 512 + c0), b1 = *(const f32x4*)(YR + ((size_t)M + r) * 512 + c0 + 4);
#pragma unroll
              for (int e = 0; e < 4; ++e) { y[e] = a0[e] + b0[e]; y[4 + e] = a1[e] + b1[e]; } }
            float sm = 0.f;
#pragma unroll
            for (int e = 0; e < 8; ++e) sm += y[e];
            sm += sx<1>(sm); sm += sx<2>(sm); sm += sx<4>(sm);
            const float mean = sm * (1.f / 64.f); float q = 0.f;
#pragma unroll
            for (int e = 0; e < 8; ++e) { y[e] -= mean; q += y[e] * y[e]; }
            q += sx<1>(q); q += sx<2>(q); q += sx<4>(q);
            const float rstd = rsqrtf(q * (1.f / 64.f) + 64e-5f);
            { float cur[8], prv[8], nxt[8]; const int col = C_RW + RW_V + c0;
              unpack8(*(const u32x4*)(pr + col), cur);
              if (hasp) unpack8(*(const u32x4*)(pr - PC + col), prv); else {
#pragma unroll
                  for (int e = 0; e < 8; ++e) prv[e] = 0.f; }
              if (hasn) unpack8(*(const u32x4*)(pr + PC + col), nxt); else {
#pragma unroll
                  for (int e = 0; e < 8; ++e) nxt[e] = 0.f; }
              const f32x4 m0 = *(const f32x4*)(mu + RW_V + c0), m1 = *(const f32x4*)(mu + RW_V + c0 + 4);
#pragma unroll
              for (int e = 0; e < 8; ++e) v[e] = cur[e] + (0.5f * (prv[e] + nxt[e]) - cur[e]) * (e < 4 ? m0[e] : m1[e - 4]); }
            const int h = lane >> 3;
            const float bonus = BONUS[(size_t)r * 8 + h] + BONUS[((size_t)M + r) * 8 + h];
            const f32x4 gg0 = *(const f32x4*)(gn_g + c0), gg1 = *(const f32x4*)(gn_g + c0 + 4), gb0 = *(const f32x4*)(gn_b + c0), gb1 = *(const f32x4*)(gn_b + c0 + 4);
            const f32x4 gt0 = *(const f32x4*)(GATE + (size_t)r * 512 + c0), gt1 = *(const f32x4*)(GATE + (size_t)r * 512 + c0 + 4);
            float o[8];
#pragma unroll
            for (int e = 0; e < 8; ++e) o[e] = (y[e] * rstd * (e < 4 ? gg0[e] : gg1[e - 4]) + (e < 4 ? gb0[e] : gb1[e - 4]) + bonus * v[e]) * (e < 4 ? gt0[e] : gt1[e - 4]);
            *(u32x4*)(MIX + (size_t)r * D + 1024 + c0) = pack8f(o);
        }
        {
            float y[8], z[8];
            { const f32x4 a0 = *(const f32x4*)(YG + (size_t)r * 512 + c0), a1 = *(const f32x4*)(YG + (size_t)r * 512 + c0 + 4);
              const f32x4 b0 = *(const f32x4*)(YG + ((size_t)M + r) * 512 + c0), b1 = *(const f32x4*)(YG + ((size_t)M + r) * 512 + c0 + 4);
#pragma unroll
              for (int e = 0; e < 4; ++e) { y[e] = a0[e] + b0[e]; y[4 + e] = a1[e] + b1[e]; } }
            float q = 0.f;
#pragma unroll
            for (int e = 0; e < 8; ++e) q += y[e] * y[e];
            q += sx<1>(q); q += sx<2>(q); q += sx<4>(q); q += lx(q, lane, 8);
            const float rs = rsqrtf(q * (1.f / 128.f) + 1e-6f);
            unpack8(*(const u32x4*)(pr + C_GD + GD_Z + c0), z);
            const int cn = c0 & 127; const f32x4 n0 = *(const f32x4*)(gdn_norm + cn), n1 = *(const f32x4*)(gdn_norm + cn + 4);
            float o[8];
#pragma unroll
            for (int e = 0; e < 8; ++e) o[e] = y[e] * rs * (e < 4 ? n0[e] : n1[e - 4]) * (z[e] * sigmoidf_(z[e]));
            *(u32x4*)(MIX + (size_t)r * D + 1536 + c0) = pack8f(o);
        }
    }
}
#define FRAGOFF(R, C, KS) ((((R) >> 4) * (KS) + ((C) >> 5)) * 1024 + ((((C) >> 3) & 3) * 16 + ((R) & 15)) * 16 + ((C) & 7) * 2)
#define SWZ(row, SH) ((((row) >> (SH)) & 7) << 3)
#define FRAGS(Mx, row, k, SH) (*(const LAS bf16x8*)((Mx) + (row) * 72 + (((k) * 32 + q4 * 8) ^ SWZ(row, SH))))
template <int K> DI f32x4 mm_tile(const LAS bf16* A, int lda, const LAS bf16* Bt, int ldb, int tm, int tn, f32x4 acc, int lane) {
    const int r = lane & 15, q = lane >> 4;
#pragma unroll
    for (int k0 = 0; k0 < K; k0 += 32) {
        const bf16x8 a = *(const LAS bf16x8*)(A + (16 * tm + r) * lda + k0 + q * 8);
        const bf16x8 b = *(const LAS bf16x8*)(Bt + (16 * tn + r) * ldb + k0 + q * 8);
        acc = MFMA16(a, b, acc);
    }
    return acc;
}
template <int NCL>
DI void inv_offblock(const LAS float* A, LAS float* TF, LAS bf16* TT, LAS float* scr, int i, int j, int c0, int lane) {
    const int r = lane & 15, q = lane >> 4, cb = c0 + q * NCL;
    float p[NCL];
#pragma unroll
    for (int e = 0; e < NCL; ++e) p[e] = 0.f;
    for (int kb = j; kb < i; ++kb) {
#pragma unroll
        for (int s = 0; s < 16; ++s) { const float a = A[(16 * i + r) * 65 + 16 * kb + s]; const LAS float* tp = TF + (16 * kb + s) * 65 + 16 * j + cb;
#pragma unroll
            for (int e = 0; e < NCL; ++e) p[e] += a * tp[e]; }
    }
#pragma unroll
    for (int e = 0; e < NCL; ++e) scr[r * 17 + q * NCL + e] = p[e];
    LDS_WAIT();
    float o[NCL];
#pragma unroll
    for (int e = 0; e < NCL; ++e) o[e] = 0.f;
#pragma unroll
    for (int s = 0; s < 16; ++s) { const float t = TF[(16 * i + r) * 65 + 16 * i + s];
#pragma unroll
        for (int e = 0; e < NCL; ++e) o[e] += t * scr[s * 17 + q * NCL + e]; }
#pragma unroll
    for (int e = 0; e < NCL; ++e) { TF[(16 * i + r) * 65 + 16 * j + cb + e] = o[e]; TT[(16 * i + r) * 72 + 16 * j + cb + e] = f2bf(o[e]); }
}
template <class Side>
DI void inv_blocked(const LAS float* A, LAS float* TF, LAS bf16* TT, LAS float* scr_all, int wid, int lane, int tid, const Side& side) {
    if (wid < 4) { if (lane < 16) { const int j = lane, base = 16 * wid; float tc[16];
#pragma unroll
        for (int t = 0; t < 16; ++t) { float acc = (t == j) ? 1.f : 0.f;
#pragma unroll
            for (int s = 0; s < t; ++s) acc += A[(base + t) * 65 + base + s] * tc[s];
            tc[t] = acc; }
#pragma unroll
        for (int t = 0; t < 16; ++t) { TF[(base + t) * 65 + base + j] = tc[t]; TT[(base + t) * 72 + base + j] = f2bf(tc[t]); }
    } } else side(wid - 4);
    LDS_BARRIER();
    LAS float* scr = scr_all + wid * 272;
    if (wid < 6) inv_offblock<2>(A, TF, TT, scr, (wid >> 1) + 1, wid >> 1, (wid & 1) * 8, lane);
    LDS_BARRIER();
    inv_offblock<1>(A, TF, TT, scr, (wid >> 2) + 2, wid >> 2, (wid & 3) * 4, lane);
    LDS_BARRIER();
    if (wid < 4) inv_offblock<1>(A, TF, TT, scr, 3, 0, wid * 4, lane);
    LDS_BARRIER();
}

struct ScanW {
    const float *mu, *w0, *a0, *k_k, *k_a, *r_k;
    const bf16 *W2T, *A2T, *G2T;
    const float *conv, *a_log, *dt_bias;
};

constexpr int RWB = 136192, RWB_W2 = RWB + 2688, RWB_A2 = RWB_W2 + 5120, RWB_G2 = RWB_A2 + 5120;
constexpr int GDB = 143360;
DI void rw_stage_weights(LAS uchar* lds, const ScanW& sw, int h, int dir, int tid) {
    LAS float* WF = (LAS float*)(lds + RWB);
    for (int i = tid; i < 672; i += 512) { float v;
        if (i < 64) v = sw.w0[dir * 512 + h * 64 + i]; else if (i < 128) v = sw.a0[dir * 512 + h * 64 + i - 64]; else if (i < 192) v = sw.k_k[h * 64 + i - 128];
        else if (i < 256) v = sw.k_a[h * 64 + i - 192]; else if (i < 320) v = sw.r_k[h * 64 + i - 256];
        else if (i < 512) v = sw.mu[((i - 320) >> 6) * 512 + h * 64 + ((i - 320) & 63)];
        else if (i < 544) v = sw.mu[cf::RW_WD + dir * 32 + i - 512]; else if (i < 576) v = sw.mu[cf::RW_AD + dir * 32 + i - 544]; else v = sw.mu[cf::RW_GD + i - 576];
        WF[i] = v; }
    { const int which = tid >> 8, t = tid & 255, row = t >> 2, ch = t & 3;
      *(LAS u32x4*)(lds + (which ? RWB_A2 : RWB_W2) + (row * 40 + ch * 8) * 2) = *(const u32x4*)((which ? sw.A2T : sw.W2T) + ((size_t)dir * 512 + h * 64 + row) * 32 + ch * 8); }
    LDS_BARRIER();
}
DI void gd_stage_weights(LAS uchar* lds, const ScanW& sw, int h, int tid) {
    LAS float* CW = (LAS float*)(lds + GDB);
    for (int i = tid; i < 1920; i += 512) { const int jw = i >> 7, c = i & 127; CW[i] = sw.conv[(size_t)(jw / 3) * 1536 + (jw % 3) * 512 + h * 128 + c]; }
    LDS_BARRIER();
}

struct RwRaw { u32x4 c[3]; };
DI void rw_issue(RwRaw& q, const bf16* P, int b, int h, int dir, int ci, int tid) {
    using namespace cf;
    const int i = tid >> 3, sub = tid & 7;
    const int R = row_of(b, dir, ci, i), seg_lo = b * SEGT + (ci < 4 ? 0 : CTX), seg_hi = b * SEGT + (ci < 4 ? CTX : SEGT);
    const bf16* pr = P + (size_t)R * PC + C_RW; (void)seg_lo; (void)seg_hi;
#pragma unroll
    for (int w = 0; w < 3; ++w) { const int col = w * 512 + h * 64 + sub * 8;
        q.c[w] = *(const u32x4*)(pr + col); }
}

DI void s1_rwkv(LAS uchar* lds, const bf16* P, const ScanW& sw, uchar* task, float* GATE, float* BONUSd, int b, int h, int dir, int ci, int tid, unsigned& chk, int nb, int nci) {
    RwRaw raw;
    using namespace cf;
    constexpr int MB = 9216;
    LAS bf16* AT = (LAS bf16*)(lds + 0 * MB); LAS bf16* BT = (LAS bf16*)(lds + 1 * MB); LAS bf16* KT = (LAS bf16*)(lds + 2 * MB); LAS bf16* QT = (LAS bf16*)(lds + 3 * MB);
    LAS bf16* ATT = (LAS bf16*)(lds + 4 * MB); LAS bf16* VT = (LAS bf16*)(lds + 5 * MB); LAS bf16* KHT = (LAS bf16*)(lds + 6 * MB); LAS bf16* BHT = (LAS bf16*)(lds + 7 * MB);
    LAS bf16* AAK = (LAS bf16*)(lds + 8 * MB); LAS bf16* AQK = (LAS bf16*)(lds + 9 * MB); LAS bf16* TT = (LAS bf16*)(lds + 10 * MB); LAS bf16* XT = (LAS bf16*)(lds + 11 * MB);
    LAS float* AAB = (LAS float*)(lds + 12 * MB); LAS float* GC = AAB;
    LAS float* INVS = (LAS float*)(lds + 12 * MB + 16640);
    LAS float* LWf = (LAS float*)(lds + 8 * MB); LAS float* LAf = (LAS float*)(lds + 10 * MB); LAS float* TF = (LAS float*)(lds + 0);
    LAS bf16* WTT = (LAS bf16*)(lds + 0 * MB); LAS bf16* ULT = (LAS bf16*)(lds + 1 * MB); LAS bf16* AQBL = (LAS bf16*)(lds + RWB_G2);
    const LAS float* WF = (const LAS float*)(lds + RWB);
    LAS bf16* TW = (LAS bf16*)(lds + 0); LAS bf16* AD = (LAS bf16*)(lds + 5120); LAS bf16* SG = (LAS bf16*)(lds + 10240);
    const int lane = tid & 63, wid = __builtin_amdgcn_readfirstlane(tid >> 6), i = tid >> 3, sub = tid & 7, r16 = lane & 15, q4 = lane >> 4;
    const int R = row_of(b, dir, ci, i), seg_lo = b * SEGT + (ci < 4 ? 0 : CTX), seg_hi = b * SEGT + (ci < 4 ? CTX : SEGT);
    const bool hasp = R - 1 >= seg_lo, hasn = R + 1 < seg_hi;
    const bf16* pr = P + (size_t)R * PC + C_RW;
    float rv[8], kv[8], vv[8];
#ifndef RW_PREFETCH
    rw_issue(raw, P, b, h, dir, ci, tid);
#endif
#ifdef DUP_ST01
    for (int rp_ = 0; rp_ < 2; ++rp_) {
#endif
#pragma unroll
    for (int w = 0; w < 3; ++w) { const int col = w * 512 + h * 64 + sub * 8; float cur[8], prv[8], nxt[8];
        unpack8(raw.c[w], cur);
        if (hasp) unpack8(*(const u32x4*)(pr - PC + col), prv); else {
#pragma unroll
            for (int e = 0; e < 8; ++e) prv[e] = 0.f; }
        if (hasn) unpack8(*(const u32x4*)(pr + PC + col), nxt); else {
#pragma unroll
            for (int e = 0; e < 8; ++e) nxt[e] = 0.f; }
        const f32x4 m0 = *(const LAS f32x4*)(WF + 320 + w * 64 + sub * 8), m1 = *(const LAS f32x4*)(WF + 320 + w * 64 + sub * 8 + 4);
#pragma unroll
        for (int e = 0; e < 8; ++e) { const float x = cur[e] + (0.5f * (prv[e] + nxt[e]) - cur[e]) * (e < 4 ? m0[e] : m1[e - 4]); if (w == 0) rv[e] = x; else if (w == 1) kv[e] = x; else vv[e] = x; } }
#pragma unroll
    for (int w = 0; w < 2; ++w) { const int col = (w ? RW_AD : RW_WD) + dir * 32 + sub * 4;
        const u32x2 c2 = *(const u32x2*)(pr + col); u32x2 p2 = (u32x2){0u, 0u}, n2 = (u32x2){0u, 0u};
        if (hasp) p2 = *(const u32x2*)(pr - PC + col); if (hasn) n2 = *(const u32x2*)(pr + PC + col);
        const f32x4 m = *(const LAS f32x4*)(WF + 512 + w * 32 + sub * 4);
        const float cur[4] = {bflo(c2.x), bfhi(c2.x), bflo(c2.y), bfhi(c2.y)}, prv[4] = {bflo(p2.x), bfhi(p2.x), bflo(p2.y), bfhi(p2.y)}, nxt[4] = {bflo(n2.x), bfhi(n2.x), bflo(n2.y), bfhi(n2.y)};
        float x[4];
#pragma unroll
        for (int e = 0; e < 4; ++e) { x[e] = cur[e] + (0.5f * (prv[e] + nxt[e]) - cur[e]) * m[e]; if (w == 0) x[e] = tanhf_(x[e]); }
        u32x2 o; o.x = pk2(x[0], x[1]); o.y = pk2(x[2], x[3]);
        *(LAS u32x2*)((w ? AD : TW) + i * 40 + sub * 4) = o; }
    if (dir == 0) {
#pragma unroll
        for (int j = 0; j < 3; ++j) { const int col = RW_GD + sub * 12 + j * 4;
            const u32x2 c2 = *(const u32x2*)(pr + col); u32x2 p2 = (u32x2){0u, 0u}, n2 = (u32x2){0u, 0u};
            if (hasp) p2 = *(const u32x2*)(pr - PC + col); if (hasn) n2 = *(const u32x2*)(pr + PC + col);
            const f32x4 m = *(const LAS f32x4*)(WF + 576 + sub * 12 + j * 4);
            const float cur[4] = {bflo(c2.x), bfhi(c2.x), bflo(c2.y), bfhi(c2.y)}, prv[4] = {bflo(p2.x), bfhi(p2.x), bflo(p2.y), bfhi(p2.y)}, nxt[4] = {bflo(n2.x), bfhi(n2.x), bflo(n2.y), bfhi(n2.y)};
            float x[4];
#pragma unroll
            for (int e = 0; e < 4; ++e) x[e] = sigmoidf_(cur[e] + (0.5f * (prv[e] + nxt[e]) - cur[e]) * m[e]);
            u32x2 o; o.x = pk2(x[0], x[1]); o.y = pk2(x[2], x[3]);
            *(LAS u32x2*)(SG + i * 104 + sub * 12 + j * 4) = o; }
    }
    LDS_BARRIER();
    { const int which = wid >> 2, tm = wid & 3;
      const bf16x8 a = *(const LAS bf16x8*)((which ? AD : TW) + (16 * tm + r16) * 40 + q4 * 8);
      const LAS bf16* wt = (const LAS bf16*)(lds + (which ? RWB_A2 : RWB_W2));
#pragma unroll
      for (int tn = 0; tn < 4; ++tn) { const bf16x8 bb = *(const LAS bf16x8*)(wt + (16 * tn + r16) * 40 + q4 * 8);
          const f32x4 acc = MFMA16(a, bb, ((f32x4){0.f, 0.f, 0.f, 0.f}));
#pragma unroll
          for (int e = 0; e < 4; ++e) (which ? LAf : LWf)[(16 * tm + 4 * q4 + e) * 65 + 16 * tn + r16] = acc[e]; } }
    if (dir == 0) { const int tm = wid >> 1;
#pragma unroll
        for (int j = 0; j < 2; ++j) { const int tn = (wid & 1) * 2 + j; f32x4 acc = (f32x4){0.f, 0.f, 0.f, 0.f};
#pragma unroll
            for (int k0 = 0; k0 < 96; k0 += 32) { const bf16x8 a = *(const LAS bf16x8*)(SG + (16 * tm + r16) * 104 + k0 + q4 * 8);
                const bf16x8 bb = *(const bf16x8*)(sw.G2T + (size_t)(h * 64 + 16 * tn + r16) * 96 + k0 + q4 * 8); acc = MFMA16(a, bb, acc); }
#pragma unroll
            for (int e = 0; e < 4; ++e) GATE[(size_t)row_of(b, 0, ci, 16 * tm + 4 * q4 + e) * 512 + h * 64 + 16 * tn + r16] = acc[e]; } }
    LDS_BARRIER();
#ifdef DUP_ST01
    }
#endif
    float av[8], bv[8], kd[8], lw[8];
#ifdef S1DBG
    float dbgv[8];
#endif
#ifdef DUP_ST2A
    for (int rp_ = 0; rp_ < 2; ++rp_) {
#endif
    { const int hc = h * 64 + sub * 8; float ss = 0.f, bon = 0.f, kk[8], al[8];
#pragma unroll
      for (int e = 0; e < 8; ++e) { const int c = sub * 8 + e;
          const float wl = -softplusf_(-(WF[c] + LWf[i * 65 + c])) - 0.5f; lw[e] = -__expf(wl);
          al[e] = sigmoidf_(WF[64 + c] + LAf[i * 65 + c]);
          kk[e] = kv[e] * WF[128 + c]; ss += kk[e] * kk[e]; }
      ss += sx<1>(ss); ss += sx<2>(ss); ss += sx<4>(ss);
      const float rn = rsqrtf(ss + 1e-12f);
#pragma unroll
      for (int e = 0; e < 8; ++e) { kk[e] *= rn; kd[e] = kv[e] * (1.f + (al[e] - 1.f) * WF[192 + sub * 8 + e]); av[e] = -kk[e]; bv[e] = kk[e] * al[e]; bon += rv[e] * kd[e] * WF[256 + sub * 8 + e];
#ifdef S1DBG
          dbgv[e] = (S1DBG == 1) ? al[e] : kk[e];
#endif
      }
      bon += sx<1>(bon); bon += sx<2>(bon); bon += sx<4>(bon);
      if (sub == 0) BONUSd[(size_t)R * 8 + h] = bon;
#pragma unroll
      for (int e = 0; e < 8; ++e) GC[i * 65 + sub * 8 + e] = lw[e]; }
    LDS_BARRIER();
#ifdef DUP_ST2A
    }
#endif
    {
        LAS float* TOT = INVS;
        float g8[8]; float run = 0.f;
#pragma unroll
        for (int j = 0; j < 8; ++j) g8[j] = GC[(wid * 8 + j) * 65 + lane];
#pragma unroll
        for (int j = 0; j < 8; ++j) { run += g8[j]; g8[j] = run; }
        TOT[wid * 64 + lane] = run;
        LDS_BARRIER();
        float off = 0.f;
#pragma unroll
        for (int sgm = 0; sgm < 7; ++sgm) { const float tv = TOT[sgm * 64 + lane]; off += (sgm < wid) ? tv : 0.f; }
#pragma unroll
        for (int j = 0; j < 8; ++j) GC[(wid * 8 + j) * 65 + lane] = g8[j] + off;
    }
    LDS_BARRIER();
#ifdef DUP_ST2C
    for (int rp_ = 0; rp_ < 2; ++rp_) {
#endif
    { float at[8], bt[8], kt[8], qt[8], bh[8], kh[8];
#pragma unroll
      for (int e = 0; e < 8; ++e) { const int c = sub * 8 + e; const float Gi = GC[i * 65 + c], Gm = (i > 0) ? GC[(i - 1) * 65 + c] : 0.f, GL = GC[63 * 65 + c];
          const float eG = __expf(Gi), eGm = __expf(Gm), enG = __expf(-Gi), eLG = __expf(GL - Gi);
          at[e] = av[e] * eGm; bt[e] = bv[e] * enG; kt[e] = kd[e] * enG; qt[e] = rv[e] * eG;
#ifdef S1DBG
          qt[e] = dbgv[e];
#endif
          bh[e] = bv[e] * eLG; kh[e] = kd[e] * eLG;
          if (i == 63) ((float*)(task + 32768))[c] = eG; }
      *(LAS u32x4*)(AT + i * 72 + sub * 8) = pack8f(at); *(LAS u32x4*)(BT + i * 72 + sub * 8) = pack8f(bt); *(LAS u32x4*)(KT + i * 72 + sub * 8) = pack8f(kt); *(LAS u32x4*)(QT + i * 72 + sub * 8) = pack8f(qt);
#pragma unroll
      for (int e = 0; e < 8; ++e) { const int c = sub * 8 + e, is = i ^ (sub << 3); ATT[c * 72 + is] = f2bf(at[e]); VT[c * 72 + is] = f2bf(vv[e]); KHT[c * 72 + is] = f2bf(kh[e]); BHT[c * 72 + is] = f2bf(bh[e]); } }
    LDS_BARRIER();
#ifdef DUP_ST2C
    }
#endif
#ifdef DUP_ST3
    for (int rp_ = 0; rp_ < 2; ++rp_) {
#endif
    RwRaw warm; rw_issue(warm, P, nb, h, dir, nci, tid);
    for (int z_ = tid; z_ < 64 * 72 / 8; z_ += 512) ((LAS u32x4*)TT)[z_] = (u32x4){0u, 0u, 0u, 0u};
    {
#define FRAG(Mx, row, k) (*(const LAS bf16x8*)((Mx) + (row) * 72 + (k) * 32 + q4 * 8))
      const int tm = wid >> 1;
      const bf16x8 a0 = FRAG(AT, 16 * tm + r16, 0), a1 = FRAG(AT, 16 * tm + r16, 1), q0 = FRAG(QT, 16 * tm + r16, 0), q1 = FRAG(QT, 16 * tm + r16, 1);
#pragma unroll
      for (int j = 0; j < 2; ++j) { const int tn = (wid & 1) * 2 + j; const f32x4 z = (f32x4){0.f, 0.f, 0.f, 0.f};
          f32x4 cab = z, cak = z, cqb = z, cqk = z;
          if (tm >= tn) { const bf16x8 b0 = FRAG(BT, 16 * tn + r16, 0), b1 = FRAG(BT, 16 * tn + r16, 1), k0 = FRAG(KT, 16 * tn + r16, 0), k1 = FRAG(KT, 16 * tn + r16, 1);
              cab = MFMA16(a0, b0, z); cab = MFMA16(a1, b1, cab); cak = MFMA16(a0, k0, z); cak = MFMA16(a1, k1, cak);
              cqb = MFMA16(q0, b0, z); cqb = MFMA16(q1, b1, cqb); cqk = MFMA16(q0, k0, z); cqk = MFMA16(q1, k1, cqk); }
#pragma unroll
          for (int e = 0; e < 4; ++e) { const int ti = 16 * tm + 4 * q4 + e, tj = 16 * tn + r16; const bool lo = ti > tj, le = ti >= tj;
              AAB[ti * 65 + tj] = lo ? cab[e] : 0.f; AAK[ti * 72 + tj] = f2bf(lo ? cak[e] : 0.f); AQBL[ti * 72 + tj] = f2bf(le ? cqb[e] : 0.f); AQK[ti * 72 + tj] = f2bf(le ? cqk[e] : 0.f); } }
#undef FRAG
    }
    LDS_BARRIER();
#ifdef DUP_ST3
    }
#endif
    inv_blocked(AAB, TF, TT, INVS, wid, lane, tid, [&](int sw_) {
#pragma unroll
        for (int j = 0; j < 4; ++j) { const int tm = sw_, tn = j;
            f32x4 acc = MFMA16(*(const LAS bf16x8*)(AAK + (16 * tm + r16) * 72 + q4 * 8), FRAGS(VT, 16 * tn + r16, 0, 3), ((f32x4){0.f, 0.f, 0.f, 0.f}));
            acc = MFMA16(*(const LAS bf16x8*)(AAK + (16 * tm + r16) * 72 + 32 + q4 * 8), FRAGS(VT, 16 * tn + r16, 1, 3), acc);
            u32x2 o; o.x = pk2(acc[0], acc[1]); o.y = pk2(acc[2], acc[3]); *(LAS u32x2*)(XT + (16 * tn + r16) * 72 + 16 * tm + 4 * q4) = o; } });
#ifdef DUP_ST6
    for (int rp_ = 0; rp_ < 2; ++rp_) {
#endif
    { const int mat = wid >> 2, tm = wid & 3; LAS bf16* dst = mat ? ULT : WTT; const LAS bf16* Bm = mat ? XT : ATT;
#define FRAG(Mx, row, k) (*(const LAS bf16x8*)((Mx) + (row) * 72 + (k) * 32 + q4 * 8))
      const bf16x8 t0 = FRAG(TT, 16 * tm + r16, 0), t1 = FRAG(TT, 16 * tm + r16, 1);
#pragma unroll
      for (int tn = 0; tn < 4; ++tn) { const int sz = mat ? 0 : SWZ(16 * tn + r16, 3);
          f32x4 acc = MFMA16(t0, *(const LAS bf16x8*)(Bm + (16 * tn + r16) * 72 + ((q4 * 8) ^ sz)), ((f32x4){0.f, 0.f, 0.f, 0.f})); acc = MFMA16(t1, *(const LAS bf16x8*)(Bm + (16 * tn + r16) * 72 + ((32 + q4 * 8) ^ sz)), acc);
          u32x2 o; o.x = pk2(acc[0], acc[1]); o.y = pk2(acc[2], acc[3]); *(LAS u32x2*)(dst + (16 * tn + r16) * 72 + 16 * tm + 4 * q4) = o; }
#undef FRAG
    }
    LDS_BARRIER();
    {
#define FRAG(Mx, row, k) (*(const LAS bf16x8*)((Mx) + (row) * 72 + (k) * 32 + q4 * 8))
      const int tm = wid >> 1;
      const bf16x8 w0 = FRAG(WTT, 16 * tm + r16, 0), w1 = FRAG(WTT, 16 * tm + r16, 1), h0 = FRAGS(BHT, 16 * tm + r16, 0, 3), h1 = FRAGS(BHT, 16 * tm + r16, 1, 3);
      const bf16x8 k0 = FRAGS(KHT, 16 * tm + r16, 0, 3), k1 = FRAGS(KHT, 16 * tm + r16, 1, 3), a0 = FRAG(AQBL, 16 * tm + r16, 0), a1 = FRAG(AQBL, 16 * tm + r16, 1), g0 = FRAG(AQK, 16 * tm + r16, 0), g1 = FRAG(AQK, 16 * tm + r16, 1);
#pragma unroll
      for (int j = 0; j < 2; ++j) { const int tn = (wid & 1) * 2 + j; const f32x4 z = (f32x4){0.f, 0.f, 0.f, 0.f};
          { f32x4 acc = MFMA16(w0, FRAGS(BHT, 16 * tn + r16, 0, 3), z); acc = MFMA16(w1, FRAGS(BHT, 16 * tn + r16, 1, 3), acc);
            u32x2 o; o.x = pk2(acc[0], acc[1]); o.y = pk2(acc[2], acc[3]); *(u32x2*)(task + 0 + FRAGOFF(16 * tn + r16, 16 * tm + 4 * q4, 2)) = o; }
          { f32x4 acc = MFMA16(w0, FRAG(AQBL, 16 * tn + r16, 0), z); acc = MFMA16(w1, FRAG(AQBL, 16 * tn + r16, 1), acc);
            const u32x2 qq = *(const LAS u32x2*)(QT + (16 * tn + r16) * 72 + 16 * tm + 4 * q4);
            u32x2 o; o.x = pk2(acc[0] + bflo(qq.x), acc[1] + bfhi(qq.x)); o.y = pk2(acc[2] + bflo(qq.y), acc[3] + bfhi(qq.y)); *(u32x2*)(task + 8192 + FRAGOFF(16 * tn + r16, 16 * tm + 4 * q4, 2)) = o; }
          { f32x4 acc = MFMA16(h0, FRAG(ULT, 16 * tn + r16, 0), z); acc = MFMA16(h1, FRAG(ULT, 16 * tn + r16, 1), acc);
            acc = MFMA16(k0, FRAGS(VT, 16 * tn + r16, 0, 3), acc); acc = MFMA16(k1, FRAGS(VT, 16 * tn + r16, 1, 3), acc);
            u32x2 o; o.x = pk2(acc[0], acc[1]); o.y = pk2(acc[2], acc[3]); *(u32x2*)(task + 16384 + ((tm * 2 + (tn >> 1)) * 64 + lane) * 16 + (tn & 1) * 8) = o; }
          { f32x4 acc = MFMA16(a0, FRAG(ULT, 16 * tn + r16, 0), z); acc = MFMA16(a1, FRAG(ULT, 16 * tn + r16, 1), acc);
            acc = MFMA16(g0, FRAGS(VT, 16 * tn + r16, 0, 3), acc); acc = MFMA16(g1, FRAGS(VT, 16 * tn + r16, 1, 3), acc);
            u32x2 o; o.x = pk2(acc[0], acc[1]); o.y = pk2(acc[2], acc[3]); *(u32x2*)(task + 24576 + ((tm * 2 + (tn >> 1)) * 64 + lane) * 16 + (tn & 1) * 8) = o; } }
#undef FRAG
    }
    LDS_BARRIER();
    chk ^= warm.c[0].x ^ warm.c[1].x ^ warm.c[2].x;
#ifdef DUP_ST6
    }
#endif
}

DI void s1_gdn(LAS uchar* lds, const bf16* P, const ScanW& sw, uchar* task, int b, int h, int dir, int ci, int tid) {
    using namespace cf;
    LAS bf16* KL = (LAS bf16*)(lds + 0); LAS bf16* QL = (LAS bf16*)(lds + 17408);
    LAS bf16* VT = (LAS bf16*)(lds + 34816); LAS bf16* KBT = (LAS bf16*)(lds + 53248); LAS bf16* BHT = (LAS bf16*)(lds + 71680);
    LAS bf16* TT = (LAS bf16*)(lds + 90112); LAS float* AAB = (LAS float*)(lds + 99328); LAS float* TF = (LAS float*)(lds + 115968);
    LAS float* INVS = (LAS float*)(lds + 132608); LAS float* gvec = (LAS float*)(lds + 141312); LAS bf16* AQBL = (LAS bf16*)(lds + 151552);
    const int lane = tid & 63, wid = __builtin_amdgcn_readfirstlane(tid >> 6), i = tid >> 3, sub = tid & 7, r16 = lane & 15, q4 = lane >> 4;
    const int R = row_of(b, dir, ci, i), seg_lo = b * SEGT + (ci < 4 ? 0 : CTX), seg_hi = b * SEGT + (ci < 4 ? CTX : SEGT);
    const bf16* pr = P + (size_t)R * PC + C_GD;
    float qv[16], kv[16], vv[16];
#pragma unroll
    for (int w = 0; w < 3; ++w) { const int col = w * 512 + h * 128 + sub * 16; float acc[16];
#pragma unroll
        for (int e = 0; e < 16; ++e) acc[e] = 0.f;
#pragma unroll
        for (int j = 0; j < 5; ++j) { const int Rj = R + j - 2;
            if (Rj >= seg_lo && Rj < seg_hi) { float x[16]; float xa[8], xb[8];
                unpack8(*(const u32x4*)(pr + (ptrdiff_t)(j - 2) * PC + col), xa); unpack8(*(const u32x4*)(pr + (ptrdiff_t)(j - 2) * PC + col + 8), xb);
#pragma unroll
                for (int e = 0; e < 8; ++e) { x[e] = xa[e]; x[8 + e] = xb[e]; }
                const LAS float* cw = (const LAS float*)(lds + GDB) + (j * 3 + w) * 128 + sub * 16;
#pragma unroll
                for (int e4 = 0; e4 < 4; ++e4) { const f32x4 c4 = *(const LAS f32x4*)(cw + 4 * e4);
#pragma unroll
                    for (int e = 0; e < 4; ++e) acc[4 * e4 + e] += c4[e] * x[4 * e4 + e]; } } }
#pragma unroll
        for (int e = 0; e < 16; ++e) { const float x = acc[e] * sigmoidf_(acc[e]); if (w == 0) qv[e] = x; else if (w == 1) kv[e] = x; else vv[e] = x; } }
    { float sq = 0.f, sk = 0.f;
#pragma unroll
      for (int e = 0; e < 16; ++e) { sq += qv[e] * qv[e]; sk += kv[e] * kv[e]; }
      sq += sx<1>(sq); sq += sx<2>(sq); sq += sx<4>(sq); sk += sx<1>(sk); sk += sx<2>(sk); sk += sx<4>(sk);
      const float rq = rsqrtf(sq + 1e-12f) * 0.08838834764831845f, rk = rsqrtf(sk + 1e-12f);
#pragma unroll
      for (int e = 0; e < 16; ++e) { qv[e] *= rq; kv[e] *= rk; } }
    if (sub == 0) { const float a_raw = bf2f(pr[GD_A + dir * 4 + h]), b_raw = bf2f(pr[GD_B + dir * 4 + h]);
        gvec[i] = -__expf(sw.a_log[dir * 4 + h]) * softplusf_(a_raw + sw.dt_bias[dir * 4 + h]); gvec[64 + i] = sigmoidf_(b_raw); }
    { float t0[8], t1[8];
#pragma unroll
      for (int e = 0; e < 8; ++e) { t0[e] = kv[e]; t1[e] = kv[8 + e]; }
      *(LAS u32x4*)(KL + i * 136 + sub * 16) = pack8f(t0); *(LAS u32x4*)(KL + i * 136 + sub * 16 + 8) = pack8f(t1);
#pragma unroll
      for (int e = 0; e < 8; ++e) { t0[e] = qv[e]; t1[e] = qv[8 + e]; }
      *(LAS u32x4*)(QL + i * 136 + sub * 16) = pack8f(t0); *(LAS u32x4*)(QL + i * 136 + sub * 16 + 8) = pack8f(t1); }
    LDS_BARRIER();
    if (wid == 0) { float g = 0.f;
#pragma unroll 8
        for (int t = 0; t < 64; ++t) { const float x = gvec[t]; g += (t <= lane) ? x : 0.f; }
        gvec[128 + lane] = g; }
    LDS_BARRIER();
    for (int z_ = tid; z_ < 64 * 72 / 8; z_ += 512) ((LAS u32x4*)TT)[z_] = (u32x4){0u, 0u, 0u, 0u};
    { const float Gi = gvec[128 + i], GL = gvec[128 + 63], be = gvec[64 + i], eG = __expf(Gi), eLG = __expf(GL - Gi), beG = be * eG;
#pragma unroll
      for (int e = 0; e < 16; ++e) { const int c = sub * 16 + e, is = i ^ (sub << 3); VT[c * 72 + is] = f2bf(be * vv[e]); KBT[c * 72 + is] = f2bf(beG * kv[e]); BHT[c * 72 + is] = f2bf(kv[e] * eLG); }
      if (tid < 128) ((float*)(task + 98304))[tid] = __expf(GL); }
    { const int mat = wid >> 2, tm = wid & 3;
      const LAS bf16* Am = mat ? QL : KL;
      bf16x8 af[4];
#pragma unroll
      for (int k = 0; k < 4; ++k) af[k] = *(const LAS bf16x8*)(Am + (16 * tm + r16) * 136 + k * 32 + q4 * 8);
#pragma unroll
      for (int tn = 0; tn < 4; ++tn) { f32x4 acc = (f32x4){0.f, 0.f, 0.f, 0.f};
          if (tm >= tn) {
#pragma unroll
              for (int k = 0; k < 4; ++k) acc = MFMA16(af[k], *(const LAS bf16x8*)(KL + (16 * tn + r16) * 136 + k * 32 + q4 * 8), acc); }
          const float Gj = gvec[128 + 16 * tn + r16];
#pragma unroll
          for (int e = 0; e < 4; ++e) { const int ti = 16 * tm + 4 * q4 + e, tj = 16 * tn + r16; const float dec = __expf(fminf(gvec[128 + ti] - Gj, 0.f));
              if (mat == 0) AAB[ti * 65 + tj] = (ti > tj) ? -gvec[64 + ti] * acc[e] * dec : 0.f;
              else AQBL[ti * 72 + tj] = f2bf((ti >= tj) ? acc[e] * dec : 0.f); } } }
    LDS_BARRIER();
    inv_blocked(AAB, TF, TT, INVS, wid, lane, tid, [](int) {});
    { const int mat = wid >> 2, tm = wid & 3; f32x4 zt[8];
      { const bf16x8 t0 = *(const LAS bf16x8*)(TT + (16 * tm + r16) * 72 + q4 * 8), t1 = *(const LAS bf16x8*)(TT + (16 * tm + r16) * 72 + 32 + q4 * 8); const LAS bf16* Bm = mat ? KBT : VT;
#pragma unroll
        for (int tn = 0; tn < 8; ++tn) { zt[tn] = MFMA16(t0, FRAGS(Bm, 16 * tn + r16, 0, 4), ((f32x4){0.f, 0.f, 0.f, 0.f})); zt[tn] = MFMA16(t1, FRAGS(Bm, 16 * tn + r16, 1, 4), zt[tn]); } }
      LDS_BARRIER();
      LAS bf16* dst = mat ? KBT : VT; const float sg = mat ? -1.f : 1.f;
#pragma unroll
      for (int tn = 0; tn < 8; ++tn) { u32x2 o; o.x = pk2(sg * zt[tn][0], sg * zt[tn][1]); o.y = pk2(sg * zt[tn][2], sg * zt[tn][3]); *(LAS u32x2*)(dst + (16 * tn + r16) * 72 + 16 * tm + 4 * q4) = o; } }
    LDS_BARRIER();
    { const LAS bf16* WTT = KBT; const LAS bf16* ULT = VT;
#define FRAG(Mx, row, k) (*(const LAS bf16x8*)((Mx) + (row) * 72 + (k) * 32 + q4 * 8))
      const bf16x8 w0 = FRAG(WTT, 16 * wid + r16, 0), w1 = FRAG(WTT, 16 * wid + r16, 1);
      const bf16x8 h0 = FRAGS(BHT, 16 * wid + r16, 0, 4), h1 = FRAGS(BHT, 16 * wid + r16, 1, 4);
#pragma unroll
      for (int tn = 0; tn < 8; ++tn) {
          f32x4 acc = MFMA16(w0, FRAGS(BHT, 16 * tn + r16, 0, 4), ((f32x4){0.f, 0.f, 0.f, 0.f})); acc = MFMA16(w1, FRAGS(BHT, 16 * tn + r16, 1, 4), acc);
          u32x2 o; o.x = pk2(acc[0], acc[1]); o.y = pk2(acc[2], acc[3]); *(u32x2*)(task + 0 + FRAGOFF(16 * tn + r16, 16 * wid + 4 * q4, 4)) = o; }
#pragma unroll
      for (int tn = 0; tn < 8; ++tn) {
          f32x4 acc = MFMA16(h0, FRAG(ULT, 16 * tn + r16, 0), ((f32x4){0.f, 0.f, 0.f, 0.f})); acc = MFMA16(h1, FRAG(ULT, 16 * tn + r16, 1), acc);
          u32x2 o; o.x = pk2(acc[0], acc[1]); o.y = pk2(acc[2], acc[3]); *(u32x2*)(task + 49152 + ((wid * 4 + (tn >> 1)) * 64 + lane) * 16 + (tn & 1) * 8) = o; }
#pragma unroll
      for (int tn = 0; tn < 4; ++tn) {
          f32x4 acc = MFMA16(w0, FRAG(AQBL, 16 * tn + r16, 0), ((f32x4){0.f, 0.f, 0.f, 0.f})); acc = MFMA16(w1, FRAG(AQBL, 16 * tn + r16, 1), acc);
          const int t = 16 * tn + r16; const float eG = __expf(gvec[128 + t]); const u32x2 qq = *(const LAS u32x2*)(QL + t * 136 + 16 * wid + 4 * q4);
          u32x2 o; o.x = pk2(acc[0] + eG * bflo(qq.x), acc[1] + eG * bfhi(qq.x)); o.y = pk2(acc[2] + eG * bflo(qq.y), acc[3] + eG * bfhi(qq.y)); *(u32x2*)(task + 32768 + FRAGOFF(t, 16 * wid + 4 * q4, 4)) = o; }
      { const int tm = wid >> 1; const bf16x8 a0 = FRAG(AQBL, 16 * tm + r16, 0), a1 = FRAG(AQBL, 16 * tm + r16, 1);
#pragma unroll
        for (int j = 0; j < 4; ++j) { const int tn = (wid & 1) * 4 + j;
            f32x4 acc = MFMA16(a0, FRAG(ULT, 16 * tn + r16, 0), ((f32x4){0.f, 0.f, 0.f, 0.f})); acc = MFMA16(a1, FRAG(ULT, 16 * tn + r16, 1), acc);
            u32x2 o; o.x = pk2(acc[0], acc[1]); o.y = pk2(acc[2], acc[3]); *(u32x2*)(task + 81920 + ((tm * 4 + (tn >> 1)) * 64 + lane) * 16 + (tn & 1) * 8) = o; } }
#undef FRAG
    }
    LDS_BARRIER();
}

template <int NK, bool LOC> struct S2FA { bf16x8 wt[NK / 32]; u32x4 ul; };
template <int NK, bool LOC> struct S2FB { bf16x8 qt[NK / 32], aqb[2], bht[2]; u32x4 yl, kl; f32x4 gl; float gls; };
template <int NK, bool LOC>
DI void s2_load_a(S2FA<NK, LOC>& f, const uchar* task, int o_wt, int o_ul, int ulh, int tm, int lane) {
    const int r16 = lane & 15, q4 = lane >> 4;
#pragma unroll
    for (int k = 0; k < NK / 32; ++k) f.wt[k] = *(const bf16x8*)(task + o_wt + ((size_t)(16 * tm + r16) * NK + k * 32 + q4 * 8) * 2);
    f.ul = *(const u32x4*)(task + o_ul + (size_t)(ulh * 64 + lane) * 16);
}
template <int NK, bool LOC>
DI void s2_load_b(S2FB<NK, LOC>& f, const uchar* task, int o_qt, int o_aqb, int o_bht, int o_yl, int ulh, int o_kl, int o_gl, int tm, int cm, int ch, int lane) {
    const int r16 = lane & 15, q4 = lane >> 4;
#pragma unroll
    for (int k = 0; k < NK / 32; ++k) f.qt[k] = *(const bf16x8*)(task + o_qt + ((size_t)(16 * tm + r16) * NK + k * 32 + q4 * 8) * 2);
    if (LOC) f.yl = *(const u32x4*)(task + o_yl + (size_t)(ulh * 64 + lane) * 16);
#pragma unroll
    for (int k = 0; k < 2; ++k) { f.aqb[k] = *(const bf16x8*)(task + o_aqb + ((size_t)(16 * tm + r16) * 64 + k * 32 + q4 * 8) * 2); f.bht[k] = *(const bf16x8*)(task + o_bht + ((size_t)(16 * cm + r16) * 64 + k * 32 + q4 * 8) * 2); }
    if (LOC) f.kl = *(const u32x4*)(task + o_kl + (size_t)((cm * 2 + ch) * 64 + lane) * 16);
    if (LOC) f.gl = *(const f32x4*)(task + o_gl + (size_t)(16 * cm + 4 * q4) * 4); else f.gls = *(const float*)(task + o_gl);
}
template <int NK, bool LOC>
DI void s2_step(const S2FA<NK, LOC>& fa, const S2FB<NK, LOC>& fb, f32x4 (&H)[NK / 32], const LAS bf16* Hc, LAS bf16* Hn, LAS bf16* UT, float* Y, int ycol0, int b, int dir, int ci, int tm, int tn0, int cm, int ctn0, int lane) {
    constexpr int NH = NK / 32, LDH = NK + 8;
    const int r16 = lane & 15, q4 = lane >> 4;
    f32x4 U[2], Yv[2];
    U[0] = (f32x4){bflo(fa.ul.x), bfhi(fa.ul.x), bflo(fa.ul.y), bfhi(fa.ul.y)}; U[1] = (f32x4){bflo(fa.ul.z), bfhi(fa.ul.z), bflo(fa.ul.w), bfhi(fa.ul.w)};
#pragma unroll
    for (int j = 0; j < 2; ++j) {
#pragma unroll
        for (int k = 0; k < NK / 32; ++k) { const bf16x8 hb = *(const LAS bf16x8*)(Hc + (16 * (tn0 + j) + r16) * LDH + k * 32 + q4 * 8); U[j] = MFMA16(fa.wt[k], hb, U[j]); }
        u32x2 o; o.x = pk2(U[j][0], U[j][1]); o.y = pk2(U[j][2], U[j][3]);
        *(LAS u32x2*)(UT + (16 * (tn0 + j) + r16) * 72 + 16 * tm + 4 * q4) = o;
    }
    LDS_BARRIER();
    if (LOC) { Yv[0] = (f32x4){bflo(fb.yl.x), bfhi(fb.yl.x), bflo(fb.yl.y), bfhi(fb.yl.y)}; Yv[1] = (f32x4){bflo(fb.yl.z), bfhi(fb.yl.z), bflo(fb.yl.w), bfhi(fb.yl.w)}; }
    else { Yv[0] = (f32x4){0.f, 0.f, 0.f, 0.f}; Yv[1] = Yv[0]; }
#pragma unroll
    for (int j = 0; j < 2; ++j) {
#pragma unroll
        for (int k = 0; k < NK / 32; ++k) { const bf16x8 hb = *(const LAS bf16x8*)(Hc + (16 * (tn0 + j) + r16) * LDH + k * 32 + q4 * 8); Yv[j] = MFMA16(fb.qt[k], hb, Yv[j]); }
#pragma unroll
        for (int k = 0; k < 2; ++k) { const bf16x8 ub = *(const LAS bf16x8*)(UT + (16 * (tn0 + j) + r16) * 72 + k * 32 + q4 * 8); Yv[j] = MFMA16(fb.aqb[k], ub, Yv[j]); }
#pragma unroll
        for (int e = 0; e < 4; ++e) Y[(size_t)row_of(b, dir, ci, 16 * tm + 4 * q4 + e) * 512 + ycol0 + 16 * (tn0 + j) + r16] = Yv[j][e];
    }
#pragma unroll
    for (int j = 0; j < NH; ++j) {
        f32x4 h = LOC ? H[j] * fb.gl : H[j] * fb.gls;
        if (LOC) { if (j == 0) h += (f32x4){bflo(fb.kl.x), bfhi(fb.kl.x), bflo(fb.kl.y), bfhi(fb.kl.y)}; else h += (f32x4){bflo(fb.kl.z), bfhi(fb.kl.z), bflo(fb.kl.w), bfhi(fb.kl.w)}; }
#pragma unroll
        for (int k = 0; k < 2; ++k) { const bf16x8 ub = *(const LAS bf16x8*)(UT + (16 * (ctn0 + j) + r16) * 72 + k * 32 + q4 * 8); h = MFMA16(fb.bht[k], ub, h); }
        H[j] = h;
        u32x2 o; o.x = pk2(h[0], h[1]); o.y = pk2(h[2], h[3]);
        *(LAS u32x2*)(Hn + (16 * (ctn0 + j) + r16) * LDH + 16 * cm + 4 * q4) = o;
    }
    LDS_BARRIER();
}
template <int NK, bool LOC>
DI void s2_scan(LAS uchar* lds, const uchar* task0, int task_bytes, int o_wt, int o_qt, int o_aqb, int o_bht, int o_ul, int ulq, int o_yl, int o_kl, int o_gl,
                float* Y, int ycol0, int b, int dir, int tid) {
    constexpr int NH = NK / 32, LDH = NK + 8;
    LAS bf16* HT = (LAS bf16*)lds;
    LAS bf16* UT = (LAS bf16*)(lds + 2 * 64 * LDH * 2);
    const int lane = tid & 63, wid = tid >> 6;
    const int tm = wid >> 1, tn0 = (wid & 1) * 2;
    const int cm = (NK == 64) ? (wid >> 1) : wid, ctn0 = (NK == 64) ? (wid & 1) * 2 : 0;
    const int ulh = tm * ulq + (wid & 1);
    for (int i = tid; i < 64 * LDH * 2 / 16; i += 512) ((LAS u32x4*)HT)[i] = (u32x4){0u, 0u, 0u, 0u};
    f32x4 H[NH];
#pragma unroll
    for (int j = 0; j < NH; ++j) H[j] = (f32x4){0.f, 0.f, 0.f, 0.f};
    S2FA<NK, LOC> a0, a1, a2; S2FB<NK, LOC> b0, b1, b2;
#define TASKP(c) (task0 + (size_t)((c) < cf::NCH ? (c) : cf::NCH - 1) * task_bytes)
#define LDA(f, c) s2_load_a<NK, LOC>(f, TASKP(c), o_wt, o_ul, ulh, tm, lane)
#define LDB(f, c) s2_load_b<NK, LOC>(f, TASKP(c), o_qt, o_aqb, o_bht, o_yl, ulh, o_kl, o_gl, tm, cm, (wid & 1), lane)
#define STP(fa, fb, c) s2_step<NK, LOC>(fa, fb, H, HT + ((c) & 1) * 64 * LDH, HT + (((c) + 1) & 1) * 64 * LDH, UT, Y, ycol0, b, dir, (c), tm, tn0, cm, ctn0, lane)
    LDA(a0, 0); LDB(b0, 0); LDA(a1, 1); LDB(b1, 1);
    LDS_BARRIER();
#pragma unroll 2
    for (int ci = 0; ci < cf::NCH; ++ci) {
        LDA(a2, ci + 2); LDB(b2, ci + 2); STP(a0, b0, ci);
        a0 = a1; a1 = a2; b0 = b1; b1 = b2;
    }
#undef TASKP
#undef LDA
#undef LDB
#undef STP
}

template <int NK, bool VECG> struct S2N { bf16x8 m[NK / 32], q[NK / 32]; u32x4 n[NK / 64], y; f32x4 gl; float gls; };
template <int NK, bool VECG>
DI void s2n_load(S2N<NK, VECG>& f, const uchar* task, int o_m, int o_q, int o_n, int o_y, int o_gl, int tm, int cm, int nh0, int yh, int lane) {
    const int r16 = lane & 15, q4 = lane >> 4;
#pragma unroll
    for (int k = 0; k < NK / 32; ++k) { f.m[k] = *(const bf16x8*)(task + o_m + (size_t)((cm * (NK / 32) + k) * 64 + lane) * 16); f.q[k] = *(const bf16x8*)(task + o_q + (size_t)((tm * (NK / 32) + k) * 64 + lane) * 16); }
#pragma unroll
    for (int j = 0; j < NK / 64; ++j) f.n[j] = *(const u32x4*)(task + o_n + (size_t)((nh0 + j) * 64 + lane) * 16);
    f.y = *(const u32x4*)(task + o_y + (size_t)(yh * 64 + lane) * 16);
    if (VECG) f.gl = *(const f32x4*)(task + o_gl + (size_t)(16 * cm + 4 * q4) * 4); else f.gls = *(const float*)(task + o_gl);
}
template <int NK, bool VECG>
DI void s2n_step(const S2N<NK, VECG>& f, f32x4 (&H)[NK / 32], const LAS bf16* Hc, LAS bf16* Hn, LAS float* YS, float* Y, int ycol0, int b, int dir, int ci, int tm, int tn0, int cm, int ctn0, int wid, int lane) {
    constexpr int NH = NK / 32, LDH = NK + 8;
    const int r16 = lane & 15, q4 = lane >> 4;
#pragma unroll
    for (int j = 0; j < NH; ++j) {
        const u32x4 nn = f.n[j >> 1];
        f32x4 h = VECG ? H[j] * f.gl : H[j] * f.gls;
        h += (j & 1) ? (f32x4){bflo(nn.z), bfhi(nn.z), bflo(nn.w), bfhi(nn.w)} : (f32x4){bflo(nn.x), bfhi(nn.x), bflo(nn.y), bfhi(nn.y)};
#pragma unroll
        for (int k = 0; k < NK / 32; ++k) { const bf16x8 hb = *(const LAS bf16x8*)(Hc + (16 * (ctn0 + j) + r16) * LDH + k * 32 + q4 * 8); h = MFMA16(f.m[k], hb, h); }
        H[j] = h;
        u32x2 o; o.x = pk2(h[0], h[1]); o.y = pk2(h[2], h[3]);
        *(LAS u32x2*)(Hn + (16 * (ctn0 + j) + r16) * LDH + 16 * cm + 4 * q4) = o;
    }
#pragma unroll
    for (int j = 0; j < 2; ++j) {
        f32x4 yv = j ? (f32x4){bflo(f.y.z), bfhi(f.y.z), bflo(f.y.w), bfhi(f.y.w)} : (f32x4){bflo(f.y.x), bfhi(f.y.x), bflo(f.y.y), bfhi(f.y.y)};
#pragma unroll
        for (int k = 0; k < NK / 32; ++k) { const bf16x8 hb = *(const LAS bf16x8*)(Hc + (16 * (tn0 + j) + r16) * LDH + k * 32 + q4 * 8); yv = MFMA16(f.q[k], hb, yv); }
#pragma unroll
        for (int e = 0; e < 4; ++e) YS[(16 * tm + 4 * q4 + e) * 65 + 16 * (tn0 + j) + r16] = yv[e];
    }
    LDS_BARRIER();
#pragma unroll
    for (int e = 0; e < 8; ++e) { const int t = 8 * wid + e;
        Y[(size_t)row_of(b, dir, ci, t) * 512 + ycol0 + lane] = YS[t * 65 + lane]; }
}
template <int NK, bool VECG>
DI void s2n_scan(LAS uchar* lds, const uchar* task0, int task_bytes, int o_m, int o_q, int o_n, int o_y, int o_gl, int nq, int vs, float* Y, int ycol0, int b, int dir, int tid) {
    constexpr int NH = NK / 32, LDH = NK + 8;
    LAS bf16* HT = (LAS bf16*)lds;
    LAS float* YSB = (LAS float*)(lds + 2 * 64 * LDH * 2);
    const int lane = tid & 63, wid = __builtin_amdgcn_readfirstlane(tid >> 6);
    const int tm = wid >> 1, tn0 = (wid & 1) * 2;
    const int cm = (NK == 64) ? (wid >> 1) : wid, ctn0 = (NK == 64) ? (wid & 1) * 2 : 0;
    const int nh0 = (NK == 64) ? (cm * nq + (wid & 1)) : (cm * nq + vs * 2), yh = tm * nq + vs * 2 + (wid & 1);
    for (int i = tid; i < 64 * LDH * 2 / 16; i += 512) ((LAS u32x4*)HT)[i] = (u32x4){0u, 0u, 0u, 0u};
    f32x4 H[NH];
#pragma unroll
    for (int j = 0; j < NH; ++j) H[j] = (f32x4){0.f, 0.f, 0.f, 0.f};
#define TP(c) (task0 + (size_t)((c) < cf::NCH ? (c) : cf::NCH - 1) * task_bytes)
#define LD(f, c) s2n_load<NK, VECG>(f, TP(c), o_m, o_q, o_n, o_y, o_gl, tm, cm, nh0, yh, lane)
#define ST(f, c) s2n_step<NK, VECG>(f, H, HT + ((c) & 1) * 64 * LDH, HT + (((c) + 1) & 1) * 64 * LDH, YSB + ((c) & 1) * 64 * 65, Y, ycol0, b, dir, (c), tm, tn0, cm, ctn0, wid, lane)
    if constexpr (NK == 64) {
        S2N<NK, VECG> f0, f1, f2, f3;
        LD(f0, 0); LD(f1, 1); LD(f2, 2);
        LDS_BARRIER();
#pragma unroll 1
        for (int ci = 0; ci < cf::NCH; ci += 4) {
            LD(f3, ci + 3); ST(f0, ci);
            LD(f0, ci + 4); ST(f1, ci + 1);
            LD(f1, ci + 5); ST(f2, ci + 2);
            LD(f2, ci + 6); ST(f3, ci + 3);
        }
    } else {
        S2N<NK, VECG> f0, f1, f2;
        LD(f0, 0); LD(f1, 1);
        LDS_BARRIER();
#pragma unroll 1
        for (int ci = 0; ci + 2 < cf::NCH; ci += 3) {
            LD(f2, ci + 2); ST(f0, ci);
            LD(f0, ci + 3); ST(f1, ci + 1);
            LD(f1, ci + 4); ST(f2, ci + 2);
        }
        ST(f0, cf::NCH - 2); ST(f1, cf::NCH - 1);
    }
#undef TP
#undef LD
#undef ST
}
namespace at {
constexpr int DQ = 192, DV = 128, NW = 8, QBLK = 32, KVBLK = 64;
constexpr float SCALE = 0.07216878364870322f;
constexpr float THR = 8.f;
constexpr int SHM_V = KVBLK * DV * 2, SHM_K = KVBLK * DQ * 2, SHM_Q = NW * 8 * 1024, SHM_ATTN = 2 * SHM_V + 2 * SHM_K + NW * 64 * 4 + SHM_Q;
#define KSWZ(row, colB) ((row) * 384 + ((colB) ^ (((row) & 7) << 4)))
#define SBAR() __builtin_amdgcn_sched_barrier(0)
DI int crow(int r, int hi) { return (r & 3) + 8 * (r >> 2) + 4 * hi; }
DI unsigned cvtpk(float lo, float hi) { const f32x2 v = {lo, hi}; return __builtin_bit_cast(unsigned, __builtin_convertvector(v, bf16x2_t)); }
DI void partialSM(f32x16& p0, f32x16& p1, float& m_reg, float& mn, float& alpha) {
  constexpr float C = SCALE * 1.4426950408889634f;
  float pmax = p0[0];
#pragma unroll
  for (int r = 1; r < 16; ++r) pmax = fmaxf(pmax, p0[r]);
#pragma unroll
  for (int r = 0; r < 16; ++r) pmax = fmaxf(pmax, p1[r]);
  { auto rr = __builtin_amdgcn_permlane32_swap(__float_as_uint(pmax), __float_as_uint(pmax), false, false);
    pmax = fmaxf(__uint_as_float(rr[0]), __uint_as_float(rr[1])); }
  if (__builtin_expect(__all(pmax - m_reg <= THR / SCALE), 1)) { mn = m_reg; alpha = 1.f; }
  else { mn = fmaxf(m_reg, pmax); alpha = __builtin_amdgcn_exp2f((m_reg - mn) * C); m_reg = mn; }
  float mnC = -mn * C;
#pragma unroll
  for (int r = 0; r < 16; ++r) p0[r] = fmaf(p0[r], C, mnC);
#pragma unroll
  for (int r = 0; r < 16; ++r) p1[r] = fmaf(p1[r], C, mnC);
#pragma unroll
  for (int r = 0; r < 16; ++r) p0[r] = __builtin_amdgcn_exp2f(p0[r]);
}
DI void finishSM(f32x16& p0, f32x16& p1, float alpha, float& l_reg, bf16x8& pa0, bf16x8& pa1, bf16x8& pa2, bf16x8& pa3) {
#pragma unroll
  for (int r = 0; r < 16; ++r) p1[r] = __builtin_amdgcn_exp2f(p1[r]);
  float ps = 0;
#pragma unroll
  for (int r = 0; r < 16; ++r) ps += p0[r];
#pragma unroll
  for (int r = 0; r < 16; ++r) ps += p1[r];
  { auto rr = __builtin_amdgcn_permlane32_swap(__float_as_uint(ps), __float_as_uint(ps), false, false);
    ps = __uint_as_float(rr[0]) + __uint_as_float(rr[1]); }
  l_reg = l_reg * alpha + ps;
#define PK4(P, BASE, OUT) do { unsigned a0 = cvtpk(P[BASE + 0], P[BASE + 1]), a1 = cvtpk(P[BASE + 2], P[BASE + 3]);   \
    unsigned b0 = cvtpk(P[BASE + 4], P[BASE + 5]), b1 = cvtpk(P[BASE + 6], P[BASE + 7]);                              \
    auto r0 = __builtin_amdgcn_permlane32_swap(a0, b0, false, false); auto r1 = __builtin_amdgcn_permlane32_swap(a1, b1, false, false); \
    u32x4 w = {r0[0], r1[0], r0[1], r1[1]}; OUT = *reinterpret_cast<bf16x8*>(&w); } while (0)
  PK4(p0, 0, pa0); PK4(p0, 8, pa1); PK4(p1, 0, pa2); PK4(p1, 8, pa3);
#undef PK4
}
constexpr int NQR = 5;
DI void qkt(f32x16& p0, f32x16& p1, const LAS char* Ks, const bf16x8* qr, const LAS char* qlds, int r32, int hi) {
  p0 = f32x16{}; p1 = f32x16{};
#pragma unroll
  for (int d0 = 0; d0 < 12; ++d0) { int cb = (d0 * 16 + hi * 8) * 2;
    const bf16x8 qf = (d0 < NQR) ? qr[d0] : *(const LAS bf16x8*)(qlds + (d0 - NQR) * 1024);
    bf16x8 b0 = *(const LAS bf16x8*)(Ks + KSWZ(r32, cb));
    bf16x8 b1 = *(const LAS bf16x8*)(Ks + KSWZ(32 + r32, cb));
    p0 = __builtin_amdgcn_mfma_f32_32x32x16_bf16(b0, qf, p0, 0, 0, 0);
    p1 = __builtin_amdgcn_mfma_f32_32x32x16_bf16(b1, qf, p1, 0, 0, 0); }
}
DI int v_st(int k, int c) { const int kk = (k & ~0xC) | ((k & 4) << 1) | ((k & 8) >> 1); return ((kk >> 3) * 4 + (c >> 5)) * 512 + ((kk & 7) * 32 + (c & 31)) * 2; }
DI int v_rd_base(int lane) { return ((lane & 3) << 3) | (((lane >> 2) & 3) << 6) | (((lane >> 4) & 1) << 5) | (((lane >> 5) & 1) << 8); }
constexpr int v_rd_off(int d0, int ks, int half) { return d0 * 512 + ks * 4096 + half * 2048; }
template <int OFF> DI s16x4 tr_read(int vb) { s16x4 r; asm volatile("ds_read_b64_tr_b16 %0, %1 offset:%2" : "=&v"(r) : "v"(vb), "i"(OFF) : "memory"); return r; }
template <int D0> DI void pv_one(f32x16& od, int vb, bf16x8 pa0, bf16x8 pa1, bf16x8 pa2, bf16x8 pa3) {
  const s16x4 l0 = tr_read<v_rd_off(D0, 0, 0)>(vb), h0 = tr_read<v_rd_off(D0, 0, 1)>(vb), l1 = tr_read<v_rd_off(D0, 1, 0)>(vb), h1 = tr_read<v_rd_off(D0, 1, 1)>(vb);
  const s16x4 l2 = tr_read<v_rd_off(D0, 2, 0)>(vb), h2 = tr_read<v_rd_off(D0, 2, 1)>(vb), l3 = tr_read<v_rd_off(D0, 3, 0)>(vb), h3 = tr_read<v_rd_off(D0, 3, 1)>(vb);
  asm volatile("s_waitcnt lgkmcnt(0)" ::: "memory"); SBAR();
#define PK(L, H) (bf16x8){L[0], L[1], L[2], L[3], H[0], H[1], H[2], H[3]}
  od = __builtin_amdgcn_mfma_f32_32x32x16_bf16(pa0, PK(l0, h0), od, 0, 0, 0);
  od = __builtin_amdgcn_mfma_f32_32x32x16_bf16(pa1, PK(l1, h1), od, 0, 0, 0);
  od = __builtin_amdgcn_mfma_f32_32x32x16_bf16(pa2, PK(l2, h2), od, 0, 0, 0);
  od = __builtin_amdgcn_mfma_f32_32x32x16_bf16(pa3, PK(l3, h3), od, 0, 0, 0);
#undef PK
}
DI void pv_d0(f32x16* o, int vb, bf16x8 pa0, bf16x8 pa1, bf16x8 pa2, bf16x8 pa3) {
  pv_one<0>(o[0], vb, pa0, pa1, pa2, pa3); pv_one<1>(o[1], vb, pa0, pa1, pa2, pa3); pv_one<2>(o[2], vb, pa0, pa1, pa2, pa3); pv_one<3>(o[3], vb, pa0, pa1, pa2, pa3);
}
DI void attn_unit(const bf16* __restrict__ Qb, const bf16* __restrict__ Kh, const bf16* __restrict__ Vh, bf16* __restrict__ Ob, int seq, const float* rope, int pos0, LAS char* lds, const int tid) {
  constexpr int LDQ = cf::QP, LDKK = cf::KP, LDVV = cf::VP, LDO = cf::D;
  const int wid = __builtin_amdgcn_readfirstlane(tid >> 6), lane = tid & 63, r32 = lane & 31, hi = lane >> 5;
  LAS char* V_lds = lds; LAS char* K_lds = lds + 2 * SHM_V;
  LAS float* ws = (LAS float*)(lds + 2 * SHM_V + 2 * SHM_K) + wid * 64; LAS float* li_l = ws; LAS float* al_l = ws + 32;
  LAS char* qlds = lds + 2 * SHM_V + 2 * SHM_K + NW * 64 * 4 + wid * (12 - NQR) * 1024 + lane * 16;
  float m_reg = -1e30f, l_reg = 0; f32x16 o[4] = {}; bf16x8 qr[12];
  const bf16* Qw = Qb + (long)(wid * QBLK + r32) * LDQ + hi * 8;
#pragma unroll
  for (int d0 = 0; d0 < 12; ++d0) qr[d0] = *reinterpret_cast<const bf16x8*>(Qw + d0 * 16);
  if (rope) { const int t = pos0 + wid * QBLK + r32;
#pragma unroll
    for (int ax = 0; ax < 2; ++ax) { const int pos = ax ? (t & 63) : (t >> 6);
      const f32x4 c0 = *(const f32x4*)(rope + pos * 16 + hi * 8), c1 = *(const f32x4*)(rope + pos * 16 + hi * 8 + 4), s0 = *(const f32x4*)(rope + 1024 + pos * 16 + hi * 8), s1 = *(const f32x4*)(rope + 1024 + pos * 16 + hi * 8 + 4);
      float x1[8], x2[8], o1[8], o2[8]; unpack8(__builtin_bit_cast(u32x4, qr[8 + 2 * ax]), x1); unpack8(__builtin_bit_cast(u32x4, qr[9 + 2 * ax]), x2);
#pragma unroll
      for (int e = 0; e < 8; ++e) { const float c = e < 4 ? c0[e] : c1[e - 4], s = e < 4 ? s0[e] : s1[e - 4]; o1[e] = x1[e] * c - x2[e] * s; o2[e] = x1[e] * s + x2[e] * c; }
      qr[8 + 2 * ax] = __builtin_bit_cast(bf16x8, pack8f(o1)); qr[9 + 2 * ax] = __builtin_bit_cast(bf16x8, pack8f(o2)); } }
#pragma unroll
  for (int d0 = NQR; d0 < 12; ++d0) *(LAS bf16x8*)(qlds + (d0 - NQR) * 1024) = qr[d0];
  const int sr = tid >> 4, sc = (tid & 15) * 8, vst0 = v_st(sr, sc), vst1 = v_st(32 + sr, sc);
  int kr_[3], kc_[3];
#pragma unroll
  for (int j = 0; j < 3; ++j) { const int q = tid + 512 * j; kr_[j] = q / 24; kc_[j] = (q % 24) * 8; }
  const int vb0 = (int)(uintptr_t)V_lds + v_rd_base(lane);
  bf16x8 vs0 = {}, vs1 = {}, ks0 = {}, ks1 = {}, ks2 = {};
#define SLOAD(k0) do { vs0 = *(const bf16x8*)(&Vh[(long)((k0) + sr) * LDVV + sc]); vs1 = *(const bf16x8*)(&Vh[(long)((k0) + 32 + sr) * LDVV + sc]); \
    ks0 = *(const bf16x8*)(&Kh[(long)((k0) + kr_[0]) * LDKK + kc_[0]]); ks1 = *(const bf16x8*)(&Kh[(long)((k0) + kr_[1]) * LDKK + kc_[1]]); ks2 = *(const bf16x8*)(&Kh[(long)((k0) + kr_[2]) * LDKK + kc_[2]]); } while (0)
#define SWRITE(b) do { *(LAS bf16x8*)(V_lds + (b) * SHM_V + vst0) = vs0; *(LAS bf16x8*)(V_lds + (b) * SHM_V + vst1) = vs1; \
    *(LAS bf16x8*)(K_lds + (b) * SHM_K + KSWZ(kr_[0], kc_[0] * 2)) = ks0; *(LAS bf16x8*)(K_lds + (b) * SHM_K + KSWZ(kr_[1], kc_[1] * 2)) = ks1; *(LAS bf16x8*)(K_lds + (b) * SHM_K + KSWZ(kr_[2], kc_[2] * 2)) = ks2; } while (0)
#define SWAIT() asm volatile("s_waitcnt vmcnt(0)" ::: "memory")
#define RESC(a) do { if (__any((a) < 1.f)) { if (hi == 0) al_l[r32] = (a); asm volatile("s_waitcnt lgkmcnt(0)" ::: "memory"); \
    _Pragma("unroll") for (int d = 0; d < 4; ++d) _Pragma("unroll") for (int r = 0; r < 16; ++r) o[d][r] *= al_l[crow(r, hi)]; } } while (0)
  f32x16 pA0 = {}, pA1 = {}, pB0 = {}, pB1 = {}; float mnA = 0.f, mnB = 0.f, alA = 1.f, alB = 1.f; bf16x8 pa0 = {}, pa1 = {}, pa2 = {}, pa3 = {}; const int NT = seq / KVBLK;
  SLOAD(0); SWAIT(); SWRITE(0); __syncthreads();
  qkt(pA0, pA1, K_lds, qr, qlds, r32, hi); partialSM(pA0, pA1, m_reg, mnA, alA);
  SLOAD(KVBLK);
  SWAIT(); SWRITE(1); __syncthreads();
  for (int j = 1; j + 1 < NT; j += 2) {
    SBAR(); qkt(pB0, pB1, K_lds + SHM_K, qr, qlds, r32, hi);
    finishSM(pA0, pA1, alA, l_reg, pa0, pa1, pa2, pa3); SBAR();
    SLOAD((j + 1) * KVBLK); SBAR();
    pv_d0(o, vb0, pa0, pa1, pa2, pa3); partialSM(pB0, pB1, m_reg, mnB, alB);
    __syncthreads(); SWAIT(); SWRITE(0);
    RESC(alB); __syncthreads();
    SBAR(); qkt(pA0, pA1, K_lds, qr, qlds, r32, hi);
    finishSM(pB0, pB1, alB, l_reg, pa0, pa1, pa2, pa3); SBAR();
    SLOAD((j + 2) * KVBLK); SBAR();
    pv_d0(o, vb0 + (int)SHM_V, pa0, pa1, pa2, pa3); partialSM(pA0, pA1, m_reg, mnA, alA);
    __syncthreads(); SWAIT(); SWRITE(1);
    RESC(alA); __syncthreads();
  }
  SBAR(); qkt(pB0, pB1, K_lds + SHM_K, qr, qlds, r32, hi);
  finishSM(pA0, pA1, alA, l_reg, pa0, pa1, pa2, pa3); SBAR();
  pv_d0(o, vb0, pa0, pa1, pa2, pa3); partialSM(pB0, pB1, m_reg, mnB, alB);
  __syncthreads(); RESC(alB);
  finishSM(pB0, pB1, alB, l_reg, pa0, pa1, pa2, pa3); SBAR();
  pv_d0(o, vb0 + (int)SHM_V, pa0, pa1, pa2, pa3);
  if (hi == 0) li_l[r32] = l_reg; asm volatile("s_waitcnt lgkmcnt(0)" ::: "memory");
  float rli[16];
#pragma unroll
  for (int r = 0; r < 16; ++r) rli[r] = __builtin_amdgcn_rcpf(li_l[crow(r, hi)]);
  bf16* Ow = Ob + (long)(wid * QBLK) * LDO;
#pragma unroll
  for (int r = 0; r < 16; ++r) { int orow = crow(r, hi);
#pragma unroll
    for (int d0 = 0; d0 < 4; ++d0) Ow[(long)orow * LDO + d0 * 32 + r32] = f2bf(o[d0][r] * rli[r]); }
  __syncthreads();
#undef SLOAD
#undef SWRITE
#undef SWAIT
#undef RESC
}
#undef KSWZ
}
#if defined(PROBE)
DI void fatomic_max(unsigned* p, float v) { atomicMax(p, __builtin_bit_cast(unsigned, fabsf(v))); }
DI float pshift(const bf16* P, int R, int lo, int hi, int col, const float* mu, int mucol) {
    const float c = bf2f(P[(size_t)R * cf::PC + col]), p = (R - 1 >= lo) ? bf2f(P[(size_t)(R - 1) * cf::PC + col]) : 0.f, n = (R + 1 < hi) ? bf2f(P[(size_t)(R + 1) * cf::PC + col]) : 0.f;
    return c + (0.5f * (p + n) - c) * mu[mucol];
}
__global__ void __launch_bounds__(256) probe(In in, uchar* ws, unsigned* res, float* scratch) {
    using namespace cf;
    __shared__ float sh[4352 + 1024];
    const int tid = threadIdx.x, bx = blockIdx.x;
    const bf16* P = (const bf16*)(ws + WS_P); const bf16* Qb = (const bf16*)(ws + WS_Q); const bf16* Kb = (const bf16*)(ws + WS_K); const bf16* Vb = (const bf16*)(ws + WS_V); const bf16* MIX = (const bf16*)(ws + WS_XM);
    const float* YR = (const float*)(ws + WS_YR); const float* YG = (const float*)(ws + WS_YG);
    if (bx < 8) {
        const int h = bx, b = 1;
        for (int which = 0; which < 4; ++which) {
            const bool isctx = which == 3; const int t = which == 0 ? 0 : which == 1 ? 1000 : which == 2 ? 4095 : 5;
            const int row = b * SEGT + (isctx ? t : CTX + t), nkeys = isctx ? CTX : SEGT;
            if (tid < 192) { float q = bf2f(Qb[(size_t)row * QP + h * 192 + tid]); sh[4352 + tid] = q; }
            __syncthreads();
            if (tid < 192 && tid >= 128 && !isctx) { const int j = tid - 128, ax = j >> 5, half = (j >> 4) & 1, f = j & 15; const float pos = ax ? (float)(t & 63) : (float)(t >> 6);
                const float ang = pos * powf(10000.f, -(float)f / 16.f), c = cosf(ang), s = sinf(ang);
                const float x1 = sh[4352 + 128 + ax * 32 + f], x2 = sh[4352 + 128 + ax * 32 + 16 + f];
                sh[4352 + 512 + j] = half ? (x1 * s + x2 * c) : (x1 * c - x2 * s); }
            __syncthreads();
            if (tid < 64 && !isctx) sh[4352 + 128 + tid] = sh[4352 + 512 + tid];
            __syncthreads();
            for (int kk = tid; kk < nkeys; kk += 256) { const int krow = b * SEGT + kk; const bool kctx = kk < CTX; const int kt = kk - CTX;
                float s = 0.f;
                for (int d = 0; d < 128; ++d) s += sh[4352 + d] * bf2f(Kb[(size_t)krow * KP + h * 192 + d]);
                for (int j = 0; j < 64; ++j) { const int ax = j >> 5, half = (j >> 4) & 1, f = j & 15;
                    float kv;
                    if (kctx) kv = bf2f(P[(size_t)krow * PC + C_KR + j]);
                    else { const float pos = ax ? (float)(kt & 63) : (float)(kt >> 6), ang = pos * powf(10000.f, -(float)f / 16.f), c = cosf(ang), sn = sinf(ang);
                        const float x1 = bf2f(P[(size_t)krow * PC + C_KR + ax * 32 + f]), x2 = bf2f(P[(size_t)krow * PC + C_KR + ax * 32 + 16 + f]);
                        kv = half ? (x1 * sn + x2 * c) : (x1 * c - x2 * sn); }
                    s += sh[4352 + 128 + j] * kv; }
                sh[kk] = s * 0.07216878364870322f; }
            __syncthreads();
            float mx = -1e30f; for (int kk = 0; kk < nkeys; ++kk) mx = fmaxf(mx, sh[kk]);
            float den = 0.f; for (int kk = 0; kk < nkeys; ++kk) den += __expf(sh[kk] - mx);
            if (tid < 128) { float o = 0.f; for (int kk = 0; kk < nkeys; ++kk) o += __expf(sh[kk] - mx) * bf2f(Vb[(size_t)(b * SEGT + kk) * VP + h * 128 + tid]);
                o /= den; const float got = bf2f(MIX[(size_t)row * D + h * 128 + tid]); fatomic_max(res + 0, got - o); fatomic_max(res + 16, o); }
            __syncthreads();
        }
    } else if (bx < 10) {
        if (tid >= 64) return;
        const int b = 1, h = 3, dir = bx - 8, lane = tid, hc = h * 64 + lane;
        const float* mu = in.p[11]; float S[64]; float cumw = 1.f;
        const uchar* task = ws + WS_RWT + (size_t)((((b * 8 + h) * 2 + dir) * NCH) + 0) * RW_TASK;
#pragma unroll
        for (int k = 0; k < 64; ++k) S[k] = 0.f;
        for (int step = 0; step < SEGT; ++step) {
            const int R = row_of(b, dir, step >> 6, step & 63), s = R % SEGT, lo = b * SEGT + (s < CTX ? 0 : CTX), hi = b * SEGT + (s < CTX ? CTX : SEGT);
            const float r = pshift(P, R, lo, hi, C_RW + hc, mu, hc), k = pshift(P, R, lo, hi, C_RW + 512 + hc, mu, 512 + hc), v = pshift(P, R, lo, hi, C_RW + 1024 + hc, mu, 1024 + hc);
            if (lane < 32) { sh[lane] = tanhf(pshift(P, R, lo, hi, C_RW + RW_WD + dir * 32 + lane, mu, RW_WD + dir * 32 + lane)); sh[32 + lane] = pshift(P, R, lo, hi, C_RW + RW_AD + dir * 32 + lane, mu, RW_AD + dir * 32 + lane); }
            __builtin_amdgcn_s_waitcnt(0); __builtin_amdgcn_wave_barrier();
            float lw = in.p[12][dir * 512 + hc], la = in.p[14][dir * 512 + hc];
            for (int rr = 0; rr < 32; ++rr) { lw += sh[rr] * in.p[13][((size_t)dir * 32 + rr) * 512 + hc]; la += sh[32 + rr] * in.p[15][((size_t)dir * 32 + rr) * 512 + hc]; }
            const float wlog = -log1pf(expf(-lw)) - 0.5f, w = expf(-expf(wlog)), alr = 1.f / (1.f + expf(-la));
            float kk = k * in.p[17][hc]; sh[400 + lane] = kk * kk; __builtin_amdgcn_s_waitcnt(0); __builtin_amdgcn_wave_barrier(); float nn = 0.f; for (int jj = 0; jj < 64; ++jj) nn += sh[400 + jj]; kk *= rsqrtf(nn + 1e-12f);
            const float kd = k * (1.f + (alr - 1.f) * in.p[18][hc]), a = -kk, bb = kk * alr;
            if (dir == 0 && step < 64) { cumw *= w;
#ifdef S1DBG
                const float qt = (S1DBG == 1) ? alr : kk,
#else
                const float qt = r * cumw,
#endif
                got = bf2f(((const bf16*)(task + 8192))[step * 64 + lane]); fatomic_max(res + 9, got - qt); fatomic_max(res + 25, qt);
                scratch[(size_t)8 * SEGT * 64 + step * 64 + lane] = bb; scratch[(size_t)8 * SEGT * 64 + 4096 + step * 64 + lane] = cumw;
                if (step == 63) { const float gl = ((const float*)(task + 57344))[lane]; fatomic_max(res + 8, gl - cumw); fatomic_max(res + 24, cumw);
                    for (int t2 = 0; t2 < 64; ++t2) { const float bh = scratch[(size_t)8 * SEGT * 64 + t2 * 64 + lane] * cumw / scratch[(size_t)8 * SEGT * 64 + 4096 + t2 * 64 + lane], gb = bf2f(((const bf16*)(task + 24576))[lane * 64 + t2]); fatomic_max(res + 10, gb - bh); fatomic_max(res + 26, bh); } } }
            sh[64 + lane] = a; sh[128 + lane] = bb; sh[192 + lane] = kd; sh[256 + lane] = w; sh[320 + lane] = r;
            __builtin_amdgcn_s_waitcnt(0); __builtin_amdgcn_wave_barrier();
            float sa = 0.f;
#pragma unroll
            for (int kx = 0; kx < 64; ++kx) sa += S[kx] * sh[64 + kx];
            float y = 0.f;
#pragma unroll
            for (int kx = 0; kx < 64; ++kx) { S[kx] = S[kx] * sh[256 + kx] + sa * sh[128 + kx] + v * sh[192 + kx]; y += S[kx] * sh[320 + kx]; }
            scratch[((size_t)dir * SEGT + (R - b * SEGT)) * 64 + lane] = y;
            __builtin_amdgcn_s_waitcnt(0); __builtin_amdgcn_wave_barrier();
        }
    } else if (bx < 12) {
        const int b = 2, h = 1, dir = bx - 10, c = tid & 127;
        float S[128];
#pragma unroll
        for (int k = 0; k < 128; ++k) S[k] = 0.f;
        const float A = expf(in.p[23][dir * 4 + h]), dtb = in.p[24][dir * 4 + h];
        for (int step = 0; step < SEGT; ++step) {
            const int R = row_of(b, dir, step >> 6, step & 63), s = R % SEGT, lo = b * SEGT + (s < CTX ? 0 : CTX), hi = b * SEGT + (s < CTX ? CTX : SEGT);
            float x[3];
            for (int w = 0; w < 3; ++w) { float acc = 0.f; const int col = w * 512 + h * 128 + c;
                for (int j = 0; j < 5; ++j) { const int Rj = R + j - 2; if (Rj >= lo && Rj < hi) acc += in.p[22][(size_t)j * 1536 + col] * bf2f(P[(size_t)Rj * PC + C_GD + col]); }
                x[w] = acc / (1.f + expf(-acc)); }
            if (tid < 128) { sh[tid] = x[0] * x[0]; sh[128 + tid] = x[1] * x[1]; }
            __syncthreads();
            float sq = 0.f, sk = 0.f; for (int j = 0; j < 128; ++j) { sq += sh[j]; sk += sh[128 + j]; }
            __syncthreads();
            const float q = x[0] * rsqrtf(sq + 1e-12f) * 0.08838834764831845f, k = x[1] * rsqrtf(sk + 1e-12f), v = x[2];
            const float a_raw = bf2f(P[(size_t)R * PC + C_GD + GD_A + dir * 4 + h]), b_raw = bf2f(P[(size_t)R * PC + C_GD + GD_B + dir * 4 + h]);
            const float z = a_raw + dtb, g = -A * (z > 20.f ? z : log1pf(expf(z))), eg = expf(g), beta = 1.f / (1.f + expf(-b_raw));
            if (tid < 128) { sh[256 + tid] = k; sh[384 + tid] = q; }
            __syncthreads();
            if (tid < 128) { float ks = 0.f;
#pragma unroll
                for (int kx = 0; kx < 128; ++kx) ks += sh[256 + kx] * S[kx];
                float o = 0.f;
#pragma unroll
                for (int kx = 0; kx < 128; ++kx) { S[kx] = eg * (S[kx] - beta * sh[256 + kx] * ks) + beta * sh[256 + kx] * v; o += sh[384 + kx] * S[kx]; }
                scratch[(size_t)2 * SEGT * 64 + ((size_t)dir * SEGT + (R - b * SEGT)) * 128 + c] = o; }
            __syncthreads();
        }
    }
}
__global__ void probe_cmp(uchar* ws, unsigned* res, const float* scratch) {
    using namespace cf;
    const float* YR = (const float*)(ws + WS_YR); const float* YG = (const float*)(ws + WS_YG);
    for (int i = blockIdx.x * blockDim.x + threadIdx.x; i < SEGT * 64; i += gridDim.x * blockDim.x) { const int s = i >> 6, v = i & 63, b = 1, h = 3; const size_t row = (size_t)b * SEGT + s;
        const float r0 = scratch[(size_t)s * 64 + v], r1 = scratch[((size_t)SEGT + s) * 64 + v], g0 = YR[row * 512 + h * 64 + v], g1 = YR[((size_t)M + row) * 512 + h * 64 + v];
        fatomic_max(res + 1, (g0 + g1) - (r0 + r1)); fatomic_max(res + 17, r0 + r1);
        fatomic_max(res + 3, g0 - r0); fatomic_max(res + 19, r0);
        fatomic_max(res + 4, g1 - r1); fatomic_max(res + 20, r1);
        if (s < 64) { fatomic_max(res + 5, g0 - r0); fatomic_max(res + 21, r0); }
        if (s >= 64 && s < 128) { fatomic_max(res + 6, g0 - r0); fatomic_max(res + 22, r0); }
        if (s >= 256 && s < 320) { fatomic_max(res + 7, g0 - r0); fatomic_max(res + 23, r0); }
    }
    for (int i = blockIdx.x * blockDim.x + threadIdx.x; i < SEGT * 128; i += gridDim.x * blockDim.x) { const int s = i >> 7, v = i & 127, b = 2, h = 1; const size_t row = (size_t)b * SEGT + s;
        const float* sg = scratch + (size_t)2 * SEGT * 64;
        const float ref = sg[(size_t)s * 128 + v] + sg[((size_t)SEGT + s) * 128 + v], got = YG[row * 512 + h * 128 + v] + YG[((size_t)M + row) * 512 + h * 128 + v];
        fatomic_max(res + 2, got - ref); fatomic_max(res + 18, ref); }
}
__global__ void probe_out(float* out, const unsigned* res, int selA, int selB) {
    if (blockIdx.x == 0 && threadIdx.x == 0) {
        out[0] = 1.0e5f * __builtin_bit_cast(float, res[selA]) / __builtin_bit_cast(float, res[16 + selA]);
        out[1] = 1.0e5f * __builtin_bit_cast(float, res[selB]) / __builtin_bit_cast(float, res[16 + selB]); }
}
#endif
constexpr int NWAVES = 8, NPH = 3 + 9 * cf::DEPTH;
struct Args { In in; float* out; uchar* ws; int g_lo, g_hi; };
static_assert(sizeof(Args) == 34 * 8 + 8 + 8 + 8, "Args has no padding");

__global__ void __launch_bounds__(NWAVES * 64, 2) fwd(Args args) {
    using namespace cf;
    extern __shared__ __attribute__((aligned(16))) unsigned char lds_raw[];
    LAS uchar* lds = (LAS uchar*)lds_raw;
    const int bx = blockIdx.x, G = gridDim.x, wv = __builtin_amdgcn_readfirstlane(threadIdx.x >> 6);
    auto lane_now = [&]() { unsigned ones = ~0u; asm volatile("" : "+s"(ones)); return (int)__builtin_amdgcn_mbcnt_hi(ones, __builtin_amdgcn_mbcnt_lo(ones, 0u)); };
#define TID() (wv * 64 + lane_now())
    const In& in = args.in;
    volatile LAS unsigned* MISC = (volatile LAS unsigned*)(lds + MISC_OFF);
    { const int tid = threadIdx.x; if (tid < 32) MISC[tid] = 0u; }
    __syncthreads();
    const int g_lo = args.g_lo, g_hi = args.g_hi;
    unsigned* barw = (unsigned*)(args.ws + WS_CTL) + CW_BAR;
    if (g_hi - g_lo > 1) (void)xcd_barrier_post(barw, MISC + 8);
#ifndef PH_MASK
#define PH_MASK 0xfff
#endif
#define PHK(g) ((g) < 3 ? (g) : 3 + ((g) - 3) % 9)
#ifndef DUP_PHASE
#define DUP_PHASE -1
#endif
#define NREP(k) ((DUP_PHASE == (k)) ? 2 : 1)
#define OPQ(v) asm volatile("" : "+v"(v))
#define IN(g) (((PH_MASK >> PHK(g)) & 1) && args.g_lo <= (g) && (g) < args.g_hi)
#ifdef TIMING
#define STAMP(i) do { if (blockIdx.x == 0 && TID() == 0) ((unsigned long long*)(args.ws + 16384))[i] = __builtin_amdgcn_s_memrealtime(); } while (0)
#else
#define STAMP(i) do {} while (0)
#endif
#define SEAM(g) do { if (args.g_lo <= (g) && (g) + 1 < args.g_hi) { XcdBarrier bar_; bar_.bar = (unsigned*)(args.ws + WS_CTL) + CW_BAR; bar_.x = xb_xcc_id(); bar_.st = (volatile LAS unsigned*)(lds + MISC_OFF) + 8; xcd_barrier(bar_); } STAMP((g) + 1); } while (0)

#define OPQS(v) asm volatile("" : "+s"(v))
#define LOCALS int l = lq; OPQS(l); size_t zq_ = 0; OPQS(zq_); uchar* ws = args.ws + zq_; float* X = (float*)(ws + WS_X); bf16* XM = (bf16*)(ws + WS_XM); bf16* P = (bf16*)(ws + WS_P); \
    bf16* CQN = (bf16*)(ws + WS_CQN); bf16* CKVN = (bf16*)(ws + WS_CKVN); bf16* Qb = (bf16*)(ws + WS_Q); bf16* Kb = (bf16*)(ws + WS_K); bf16* Vb = (bf16*)(ws + WS_V); \
    bf16* HFF = (bf16*)(ws + WS_HFF); float* YR = (float*)(ws + WS_YR); float* YG = (float*)(ws + WS_YG); float* GATE = (float*)(ws + WS_GATE); float* BONUS = (float*)(ws + WS_BONUS); \
    const float* MODV = (const float*)(ws + WS_MODV); const float* ROPE = (const float*)(ws + WS_ROPE); const float* modl = MODV + (size_t)l * 5 * MODS; \
    (void)X; (void)XM; (void)P; (void)CQN; (void)CKVN; (void)Qb; (void)Kb; (void)Vb; (void)HFF; (void)YR; (void)YG; (void)GATE; (void)BONUS; (void)ROPE; (void)modl; int t_ = TID(); OPQ(t_);

    STAMP(0);
    if (IN(0)) { const int lq = 0; LOCALS; phase_prologue(in, ws, lds, G, bx, t_); }
#ifdef DUP_PRO
    { XcdBarrier bar_; bar_.bar = (unsigned*)(args.ws + WS_CTL) + CW_BAR; bar_.x = xb_xcc_id(); bar_.st = (volatile LAS unsigned*)(lds + MISC_OFF) + 8; xcd_barrier(bar_); }
    if (IN(0)) { const int lq = 0; LOCALS; phase_prologue(in, ws, lds, G, bx, t_); }
#endif
    SEAM(0);
#ifdef DUP_BAR
    for (int nb_ = 0; nb_ < DUP_BAR; ++nb_) { XcdBarrier bar_; bar_.bar = (unsigned*)(args.ws + WS_CTL) + CW_BAR; bar_.x = xb_xcc_id(); bar_.st = (volatile LAS unsigned*)(lds + MISC_OFF) + 8; xcd_barrier(bar_); }
#endif
    if (IN(1)) { const int lq = 0; LOCALS; phase_modreduce(in, ws, G, bx, t_); }
    SEAM(1);
    if (IN(2)) { const int lq = 0; LOCALS; phase_modulate(X, XM, MODV, 0, D, G, bx, t_); }
    SEAM(2);

#pragma unroll 1
    for (int lq = 0; lq < DEPTH; ++lq) {
        const int g0 = 3 + 9 * lq;
        if (IN(g0 + 0)) for (int rep_ = 0; rep_ < NREP(0); ++rep_) { if (rep_) { XcdBarrier bar_; bar_.bar = (unsigned*)(args.ws + WS_CTL) + CW_BAR; bar_.x = xb_xcc_id(); bar_.st = (volatile LAS unsigned*)(lds + MISC_OFF) + 8; xcd_barrier(bar_); } LOCALS;
            pg8::Gemm g{XM, (const bf16*)(ws + WS_WIN) + (size_t)l * PC * D, M, PC, D, D}; pg8::StaticOrder S; S.init(M, PC, G, bx);
            pg8::EpiStore E{P, PC};
            pg8::gemm_phase<pg8::EpiStore, pg8::StaticOrder, true, true>(lds, g, S, E, t_);
        }
        SEAM(g0 + 0);
        if (IN(g0 + 1)) for (int rep_ = 0; rep_ < NREP(1); ++rep_) { if (rep_) { XcdBarrier bar_; bar_.bar = (unsigned*)(args.ws + WS_CTL) + CW_BAR; bar_.x = xb_xcc_id(); bar_.st = (volatile LAS unsigned*)(lds + MISC_OFF) + 8; xcd_barrier(bar_); } LOCALS;
#ifndef NO_MLAPREP
            mla_prep_rows(P, CQN, CKVN, Kb, in.p[7] + l * 512, in.p[8] + l * 512, ROPE, G, bx, t_);
#endif
            ScanW sw; sw.mu = in.p[11] + l * RW_COLS; sw.w0 = in.p[12] + l * 1024; sw.a0 = in.p[14] + l * 1024; sw.k_k = in.p[17] + l * 512; sw.k_a = in.p[18] + l * 512; sw.r_k = in.p[19] + l * 512;
            sw.W2T = (const bf16*)(ws + WS_W2T) + (size_t)l * 2 * 512 * 32; sw.A2T = (const bf16*)(ws + WS_A2T) + (size_t)l * 2 * 512 * 32; sw.G2T = (const bf16*)(ws + WS_G2T) + (size_t)l * 512 * 96;
            sw.conv = in.p[22] + l * 5 * 1536; sw.a_log = in.p[23] + l * 8; sw.dt_bias = in.p[24] + l * 8;
            {
                const int combo = bx & 15, h = combo >> 1, dir = combo & 1, nbl = (G >> 4) > 0 ? (G >> 4) : 1;
                int j = bx >> 4; unsigned chk = 0u;
                { int tw = TID(); OPQ(tw); rw_stage_weights(lds, sw, h, dir, tw); }

#pragma unroll 1
                for (; j < 272; j += nbl) { int tt = TID(); OPQ(tt);
#ifndef NO_S1R
                    const int jr = 271 - j;
                    const int b = jr / NCH, ci = jr % NCH, jn = (j + nbl < 272) ? j + nbl : j, tk = ((b * 8 + h) * 2 + dir) * NCH + ci;
                    s1_rwkv(lds, P, sw, ws + WS_RWT + (size_t)tk * RW_TASK, GATE, BONUS + (size_t)dir * M * 8, b, h, dir, ci, tt, chk, (271 - jn) / NCH, (271 - jn) % NCH);
#ifdef DUP_S1R
                    OPQ(tt); s1_rwkv(lds, P, sw, ws + WS_RWT + (size_t)tk * RW_TASK, GATE, BONUS + (size_t)dir * M * 8, b, h, dir, ci, tt, chk, (271 - jn) / NCH, (271 - jn) % NCH);
#endif
#endif
                }
                if (chk == 0x9e3779b9u) ((unsigned*)(ws + WS_CTL))[32] = chk;
            }
            {
                const int combo = bx & 7, h = combo >> 1, dir = combo & 1, nbl = (G >> 3) > 0 ? (G >> 3) : 1;
                __syncthreads();
                { int tw = TID(); OPQ(tw); gd_stage_weights(lds, sw, h, tw); }
#pragma unroll 1
                for (int j = bx >> 3; j < 272; j += nbl) { int tt = TID(); OPQ(tt);
#ifndef NO_S1G
                    const int jr = 271 - j, b = jr / NCH, ci = jr % NCH, tg = ((b * 4 + h) * 2 + dir) * NCH + ci;
                    s1_gdn(lds, P, sw, ws + WS_GDT + (size_t)tg * GD_TASK, b, h, dir, ci, tt);
#ifdef DUP_S1G
                    OPQ(tt); s1_gdn(lds, P, sw, ws + WS_GDT + (size_t)tg * GD_TASK, b, h, dir, ci, tt);
#endif
#endif
                }
            }
        }
        SEAM(g0 + 1);
        if (IN(g0 + 2)) for (int rep_ = 0; rep_ < NREP(2); ++rep_) { if (rep_) { XcdBarrier bar_; bar_.bar = (unsigned*)(args.ws + WS_CTL) + CW_BAR; bar_.x = xb_xcc_id(); bar_.st = (volatile LAS unsigned*)(lds + MISC_OFF) + 8; xcd_barrier(bar_); } LOCALS;
            const bool split = G >= 256;
#pragma unroll 1
#ifdef DUP_S2
            for (int rs_ = 0; rs_ < 2; ++rs_)
#endif
            for (int s = bx; s < 128; s += (split ? 1 << 20 : G)) {
#ifndef NO_S2R
                if (s < 64) { const int b = s >> 4, h = (s >> 1) & 7, dir = s & 1;
                    s2n_scan<64, true>(lds, ws + WS_RWT + (size_t)(((b * 8 + h) * 2 + dir) * NCH) * RW_TASK, RW_TASK, 0, 8192, 16384, 24576, 32768, 2, 0,
                                      YR + (size_t)dir * M * 512, h * 64, b, dir, t_); }
#endif
#ifndef NO_S2G
                if (s >= 64) { const int g = s - 64, vs = g & 1, dir = (g >> 1) & 1, h = (g >> 2) & 3, b = g >> 4;
                    s2n_scan<128, false>(lds, ws + WS_GDT + (size_t)(((b * 4 + h) * 2 + dir) * NCH) * GD_TASK, GD_TASK, 0, 32768, 49152, 81920, 98304, 4, vs,
                                        YG + (size_t)dir * M * 512, h * 128 + vs * 64, b, dir, t_); }
#endif
                __syncthreads();
            }
            OPQ(t_);
#ifndef NO_UPGEMM
            if (!split || bx >= 128) { const int Gg = split ? G - 128 : G, cg = split ? bx - 128 : bx;
#ifdef DUP_UPG
                for (int rg_ = 0; rg_ < 2; ++rg_) {
#endif
                { pg8::Gemm g{CQN, (const bf16*)(ws + WS_WUQ) + (size_t)l * 1536 * 512, M, 1536, 512, 512}; pg8::StaticOrder S; S.init(M, 1536, Gg, cg);
                  pg8::EpiStore E{Qb, QP}; pg8::gemm_phase<pg8::EpiStore, pg8::StaticOrder, true, true>(lds, g, S, E, t_); }
                __syncthreads(); OPQ(t_);
                { pg8::Gemm g{CKVN, (const bf16*)(ws + WS_WUKV) + (size_t)l * 2048 * 512, M, 2048, 512, 512}; pg8::StaticOrder S; S.init(M, 2048, Gg, cg);
                  pg8::EpiKV E{Kb, Vb}; pg8::gemm_phase<pg8::EpiKV, pg8::StaticOrder, true, true>(lds, g, S, E, t_); }
#ifdef DUP_UPG
                __syncthreads(); OPQ(t_); }
#endif
            }
#endif
        }
        SEAM(g0 + 2);
        if (IN(g0 + 3)) for (int rep_ = 0; rep_ < NREP(3); ++rep_) { if (rep_) { XcdBarrier bar_; bar_.bar = (unsigned*)(args.ws + WS_CTL) + CW_BAR; bar_.x = xb_xcc_id(); bar_.st = (volatile LAS unsigned*)(lds + MISC_OFF) + 8; xcd_barrier(bar_); } LOCALS;
#ifndef NO_MIXROWS
            mix_rows(P, YR, YG, GATE, BONUS, XM, in.p[11] + l * RW_COLS, in.p[20] + l * 512, in.p[21] + l * 512, in.p[25] + l * 128, G, bx, t_);
#endif
#ifndef NO_ATTN
            const int nunits = 512 + (l < DEPTH - 1 ? 32 : 0);
#pragma unroll 1
            for (int u = bx; u < nunits; u += G) { int tt = TID(); OPQ(tt);
                if (u < 512) { const int x = u & 7, j = u >> 3, bh = x + 8 * (j >> 4), qb = j & 15, b = bh >> 3, h = bh & 7;
                    const size_t qrow = (size_t)b * SEGT + CTX + qb * 256, krow = (size_t)b * SEGT;
                    at::attn_unit(Qb + qrow * QP + h * 192, Kb + krow * KP + h * 192, Vb + krow * VP + h * 128, XM + qrow * D + h * 128, SEGT, ROPE, qb * 256, (LAS char*)lds, tt); }
                else { const int bh = u - 512, b = bh >> 3, h = bh & 7; const size_t qrow = (size_t)b * SEGT;
                    at::attn_unit(Qb + qrow * QP + h * 192, Kb + qrow * KP + h * 192, Vb + qrow * VP + h * 128, XM + qrow * D + h * 128, CTX, nullptr, 0, (LAS char*)lds, tt); }
            }
#endif
        }
        SEAM(g0 + 3);
        if (IN(g0 + 4)) for (int rep_ = 0; rep_ < NREP(4); ++rep_) { if (rep_) { XcdBarrier bar_; bar_.bar = (unsigned*)(args.ws + WS_CTL) + CW_BAR; bar_.x = xb_xcc_id(); bar_.st = (volatile LAS unsigned*)(lds + MISC_OFF) + 8; xcd_barrier(bar_); } LOCALS;
            { pg8::Gemm g{XM, (const bf16*)(ws + WS_WOUT) + (size_t)l * D * D, M, D, D, D}; pg8::LatOrder S; S.init(D, G, bx);
              float alpha_ = ALPHA; OPQ(alpha_); pg8::EpiRes E{X, modl + 2 * D, MODS, alpha_};
              pg8::gemm_phase<pg8::EpiRes, pg8::LatOrder, true, true>(lds, g, S, E, t_);
#ifdef DUP_E
              __syncthreads(); OPQ(t_); { pg8::EpiStore E2{(bf16*)(ws + WS_HFF), D}; pg8::gemm_phase<pg8::EpiStore, pg8::LatOrder, true, true>(lds, g, S, E2, t_); }
#endif
            }
            if (l < DEPTH - 1) { __syncthreads(); OPQ(t_);
              pg8::Gemm g{XM, (const bf16*)(ws + WS_WOUT) + (size_t)l * D * D, M, D, D / 8, D}; pg8::CtxSplitOrder S; S.init(D, 8, D / 8, G, bx);
              pg8::EpiPart E{(float*)(ws + WS_PART)};
              pg8::gemm_phase<pg8::EpiPart, pg8::CtxSplitOrder, true, true>(lds, g, S, E, t_); }
        }
        SEAM(g0 + 4);
        if (IN(g0 + 5)) for (int rep_ = 0; rep_ < NREP(5); ++rep_) { if (rep_) { XcdBarrier bar_; bar_.bar = (unsigned*)(args.ws + WS_CTL) + CW_BAR; bar_.x = xb_xcc_id(); bar_.st = (volatile LAS unsigned*)(lds + MISC_OFF) + 8; xcd_barrier(bar_); } LOCALS; phase_ln(X, in.p[27] + l * D, in.p[28] + l * D, XM, modl, 3 * D, 4 * D, nullptr, (l < DEPTH - 1) ? (const float*)(ws + WS_PART) : nullptr, 8, modl + 4 * MODS + 2 * D, l == DEPTH - 1, G, bx, t_);
#ifdef DUP_LN
            { XcdBarrier bar_; bar_.bar = (unsigned*)(args.ws + WS_CTL) + CW_BAR; bar_.x = xb_xcc_id(); bar_.st = (volatile LAS unsigned*)(lds + MISC_OFF) + 8; xcd_barrier(bar_); }
            OPQ(t_); phase_ln(X, in.p[27] + l * D, in.p[28] + l * D, XM, modl, 3 * D, 4 * D, (float*)(ws + WS_Q), nullptr, 0, nullptr, true, G, bx, t_);
#endif
        }
        SEAM(g0 + 5);
        if (IN(g0 + 6)) for (int rep_ = 0; rep_ < NREP(6); ++rep_) { if (rep_) { XcdBarrier bar_; bar_.bar = (unsigned*)(args.ws + WS_CTL) + CW_BAR; bar_.x = xb_xcc_id(); bar_.st = (volatile LAS unsigned*)(lds + MISC_OFF) + 8; xcd_barrier(bar_); } LOCALS;
            pg8::Gemm g{XM, (const bf16*)(ws + WS_WGU) + (size_t)l * 2 * DFF * D, M, 2 * DFF, D, D}; pg8::EpiSwiGLU E{HFF, DFF};
            if (l < DEPTH - 1) { pg8::StaticOrder S; S.init(M, 2 * DFF, G, bx); pg8::gemm_phase<pg8::EpiSwiGLU, pg8::StaticOrder, true, true>(lds, g, S, E, t_); }
            else { pg8::LatOrder S; S.init(2 * DFF, G, bx); pg8::gemm_phase<pg8::EpiSwiGLU, pg8::LatOrder, true, true>(lds, g, S, E, t_); }
        }
        SEAM(g0 + 6);
        if (IN(g0 + 7)) for (int rep_ = 0; rep_ < NREP(7); ++rep_) { if (rep_) { XcdBarrier bar_; bar_.bar = (unsigned*)(args.ws + WS_CTL) + CW_BAR; bar_.x = xb_xcc_id(); bar_.st = (volatile LAS unsigned*)(lds + MISC_OFF) + 8; xcd_barrier(bar_); } LOCALS;
            { pg8::Gemm g{HFF, (const bf16*)(ws + WS_WDN) + (size_t)l * D * DFF, M, D, DFF, DFF}; pg8::LatOrder S; S.init(D, G, bx);
              float alpha_ = ALPHA; OPQ(alpha_); pg8::EpiRes E{X, modl + 5 * D, MODS, alpha_};
              pg8::gemm_phase<pg8::EpiRes, pg8::LatOrder, true, true>(lds, g, S, E, t_);
#ifdef DUP_H
              __syncthreads(); OPQ(t_); { pg8::EpiStore E2{(bf16*)(ws + WS_Q), D}; pg8::gemm_phase<pg8::EpiStore, pg8::LatOrder, true, true>(lds, g, S, E2, t_); }
#endif
            }
            if (l < DEPTH - 1) { __syncthreads(); OPQ(t_);
              pg8::Gemm g{HFF, (const bf16*)(ws + WS_WDN) + (size_t)l * D * DFF, M, D, DFF / 4, DFF}; pg8::CtxSplitOrder S; S.init(D, 4, DFF / 4, G, bx);
              pg8::EpiPart E{(float*)(ws + WS_PART)};
              pg8::gemm_phase<pg8::EpiPart, pg8::CtxSplitOrder, true, true>(lds, g, S, E, t_); }
        }
        SEAM(g0 + 7);
        if (IN(g0 + 8)) for (int rep_ = 0; rep_ < NREP(8); ++rep_) { if (rep_) { XcdBarrier bar_; bar_.bar = (unsigned*)(args.ws + WS_CTL) + CW_BAR; bar_.x = xb_xcc_id(); bar_.st = (volatile LAS unsigned*)(lds + MISC_OFF) + 8; xcd_barrier(bar_); } LOCALS;
            if (l < DEPTH - 1) phase_ln(X, in.p[32] + l * D, in.p[33] + l * D, XM, modl + 5 * MODS, 0, D, nullptr, (const float*)(ws + WS_PART), 4, modl + 4 * MODS + 5 * D, false, G, bx, t_);
            else phase_ln(X, in.p[32] + l * D, in.p[33] + l * D, XM, modl, 0, D, args.out, nullptr, 0, nullptr, true, G, bx, t_);
        }
        SEAM(g0 + 8);
    }
#ifdef TIMING
    __syncthreads();
    if (blockIdx.x == 0 && TID() == 0) { const unsigned long long* st = (const unsigned long long*)(args.ws + 16384); unsigned long long tot = 0;
        for (int g = 0; g < NPH; ++g) { const int cls = g < 3 ? 0 : 1 + (g - 3) % 9; if ((TIMING >> cls) & 1) tot += st[g + 1] - st[g]; }
        args.out[0] = (float)tot * 0.01f; }
#endif
#undef IN
#undef SEAM
}


#if defined(DBG_STOP)
__global__ void dbg_dump(float* out, const unsigned char* ws, int kind, size_t off, int pitch, size_t stride) {
    const size_t n = (size_t)cf::NB * cf::SEQ * cf::D;
    for (size_t i = (size_t)blockIdx.x * blockDim.x + threadIdx.x; i < n; i += (size_t)gridDim.x * blockDim.x) {
        const size_t rr = i / cf::D, c = i % cf::D, b = rr / cf::SEQ, t = rr % cf::SEQ, row = b * cf::SEGT + cf::CTX + t;
        float v;
        if (kind == 0) v = ((const float*)(ws + WS_X))[row * cf::D + c];
        else if (kind == 1) v = bf2f(((const bf16*)(ws + off))[row * (size_t)pitch + c]);
        else if (kind == 3) v = ((const float*)(ws + off))[(i * stride)];
        else if (kind == 4) v = ((const float*)(ws + off))[i % ((size_t)pitch * 1024)];
        else v = bf2f(((const bf16*)(ws + off))[i * stride]);
        if (!(fabsf(v) < 3.0e38f)) v = 1.0e30f;
        out[i] = v;
    }
}
#endif
#ifndef MK_MULTI
#define MK_MULTI 0
#endif
extern "C" void kernel_launch(void* const* d_in, const int* in_sizes, int n_in, void* d_out, int out_size, void* d_ws, size_t ws_size, hipStream_t stream) {
    static int grid = 0;
    if (grid == 0) {
        if (n_in != 34 || out_size != cf::NB * cf::SEQ * cf::D || ws_size < WS_END) { fprintf(stderr, "kernel_launch: shape mismatch (n_in %d out %d ws %zu)\n", n_in, out_size, ws_size); grid = -1; return; }
        int dev = 0, cus = 0;
        if (hipGetDevice(&dev) != hipSuccess || hipDeviceGetAttribute(&cus, hipDeviceAttributeMultiprocessorCount, dev) != hipSuccess) { grid = -1; return; }
        if (hipFuncSetAttribute((const void*)fwd, hipFuncAttributeMaxDynamicSharedMemorySize, LDS_BYTES) != hipSuccess) { fprintf(stderr, "kernel_launch: hipFuncSetAttribute failed\n"); grid = -1; return; }
        int per_cu = 0;
        if (hipOccupancyMaxActiveBlocksPerMultiprocessor(&per_cu, (const void*)fwd, NWAVES * 64, LDS_BYTES) != hipSuccess || per_cu < 1) fprintf(stderr, "kernel_launch: occupancy query says %d\n", per_cu);
        (void)hipGetLastError();
        grid = cus;
    }
    if (grid < 0) return;
    (void)hipMemsetAsync((char*)d_ws, 0, ZERO_BYTES, stream);
    Args a{};
    for (int i = 0; i < 34; ++i) a.in.p[i] = (const float*)d_in[i];
    a.out = (float*)d_out; a.ws = (uchar*)d_ws;
#if defined(PROBE)
    for (int g = 0; g < 7; ++g) { a.g_lo = g; a.g_hi = g + 1; hipLaunchKernelGGL(fwd, dim3(grid), dim3(NWAVES * 64), LDS_BYTES, stream, a); }
    { unsigned* res = (unsigned*)d_ws + 64; float* scratch = (float*)((char*)d_ws + WS_HFF + (400ull << 20));
      scratch = (float*)((char*)d_ws + WS_END);
      hipLaunchKernelGGL(probe, dim3(12), dim3(256), 0, stream, a.in, (uchar*)d_ws, res, scratch);
      hipLaunchKernelGGL(probe_cmp, dim3(256), dim3(256), 0, stream, (uchar*)d_ws, res, (const float*)scratch);
      for (int g = 7; g < NPH; ++g) { a.g_lo = g; a.g_hi = g + 1; hipLaunchKernelGGL(fwd, dim3(grid), dim3(NWAVES * 64), LDS_BYTES, stream, a); }
      hipLaunchKernelGGL(probe_out, dim3(1), dim3(64), 0, stream, (float*)d_out, (const unsigned*)res, PROBE_SELA, PROBE_SELB); }
#elif defined(DBG_STOP)
    for (int g = 0; g < DBG_STOP; ++g) { a.g_lo = g; a.g_hi = g + 1; hipLaunchKernelGGL(fwd, dim3(grid), dim3(NWAVES * 64), LDS_BYTES, stream, a); }
    hipLaunchKernelGGL(dbg_dump, dim3(2048), dim3(256), 0, stream, (float*)d_out, (const unsigned char*)d_ws, DBG_KIND, (size_t)DBG_OFF, DBG_PITCH, (size_t)DBG_STRIDE);
#elif MK_MULTI
    for (int g = 0; g < NPH; ++g) { a.g_lo = g; a.g_hi = g + 1; hipLaunchKernelGGL(fwd, dim3(grid), dim3(NWAVES * 64), LDS_BYTES, stream, a); }
#else
    a.g_lo = 0; a.g_hi = NPH;
    hipLaunchKernelGGL(fwd, dim3(grid), dim3(NWAVES * 64), LDS_BYTES, stream, a);
#endif
    const hipError_t le = hipPeekAtLastError();
    if (le != hipSuccess) fprintf(stderr, "kernel_launch: launch failed: %s\n", hipGetErrorName(le));
}
```

```cpp
#include <hip/hip_runtime.h>
#include <cstdio>
#include <cstdint>

#define DI __device__ __forceinline__
#define LAS __attribute__((address_space(3)))
#define GAS __attribute__((address_space(1)))
typedef unsigned short bf16;
typedef short bf16x8 __attribute__((ext_vector_type(8)));
typedef short s16x4 __attribute__((ext_vector_type(4)));
typedef float f32x4 __attribute__((ext_vector_type(4)));
typedef float f32x2 __attribute__((ext_vector_type(2)));
typedef float f32x16 __attribute__((ext_vector_type(16)));
typedef unsigned u32x4 __attribute__((ext_vector_type(4)));
typedef unsigned u32x2 __attribute__((ext_vector_type(2)));
typedef unsigned char uchar;
typedef __bf16 bf16x2_t __attribute__((ext_vector_type(2)));

namespace pg8 {
typedef unsigned short bf16_t;
#define PG8_LAS __attribute__((address_space(3)))
constexpr int BM = 256, BK = 64, HALF = 128, HTB = HALF * BK * 2  , STAGE_BYTES = 8 * HTB, NXCD = 8, WGM = 8;

__host__ __device__ __forceinline__ int lds_byte(int r, int c) { const int st = (r >> 4) * 2 + (c >> 5), rr = r & 15, cc = c & 31, ob = rr * 64 + cc * 2; return st * 1024 + (ob ^ (((ob >> 9) & 1) << 5)); }
__host__ __device__ __forceinline__ void stage_rc(int b, int& R, int& C) { const int st = b / 1024, sb = b % 1024, swz = sb ^ (((sb >> 9) & 1) << 5); R = (st >> 1) * 16 + swz / 64; C = (st & 1) * 32 + (swz % 64) / 2; }
__host__ __device__ __forceinline__ int perm32(int rho) { const int n = rho >> 4, i = rho & 15; return 8 * (i >> 2) + 4 * n + (i & 3); }

struct Unit { int pm, pn, ko, ks; };
struct Gemm { const bf16_t* A; const bf16_t* Bt; int M, N, K, ld; };

struct StaticOrder {
    int nM, nN, nwg, G, c;
    __host__ __device__ void init(int M, int N, int G_, int c_) { nM = M / BM; nN = N / BM; nwg = nM * nN; G = G_; c = c_; }
    __host__ __device__ bool next(int i, Unit& u) const {
        const long L = (long)i * G + c; if (L >= nwg) return false;
        int wgid = (int)L; { const int q = nwg / NXCD, r = nwg % NXCD, xcd = wgid % NXCD, off = wgid / NXCD; wgid = (xcd < r ? xcd * (q + 1) : r * (q + 1) + (xcd - r) * q) + off; }
        const int nig = WGM * nN, gid = wgid / nig, fm = gid * WGM, gsz = (nM - fm) < WGM ? (nM - fm) : WGM;
        u.pm = fm + ((wgid % nig) % gsz); u.pn = (wgid % nig) / gsz; u.ko = 0; u.ks = 0; return true;
    }
    __device__ __forceinline__ void a_ready(const Unit&) const {}
    __device__ __forceinline__ void done(const Unit&) const {}
};

struct LatOrder {
    StaticOrder S;
    __host__ __device__ void init(int N, int G_, int c_) { S.init(16384, N, G_, c_); }
    __host__ __device__ bool next(int i, Unit& u) const { if (!S.next(i, u)) return false; u.pm = (u.pm >> 4) * 17 + 1 + (u.pm & 15); return true; }
    __device__ __forceinline__ void a_ready(const Unit&) const {}
    __device__ __forceinline__ void done(const Unit&) const {}
};
struct CtxSplitOrder {
    int nN, KS, kbytes, G, c;
    __host__ __device__ void init(int N, int KS_, int Ksplit, int G_, int c_) { nN = N / BM; KS = KS_; kbytes = Ksplit * 2; G = G_; c = c_; }
    __host__ __device__ bool next(int i, Unit& u) const { const int j = i * G + c; if (j >= 4 * nN * KS) return false;
        const int ks = j % KS, cu = j / KS; u.pm = (cu / nN) * 17; u.pn = cu % nN; u.ks = ks; u.ko = ks * kbytes; return true; }
    __device__ __forceinline__ void a_ready(const Unit&) const {}
    __device__ __forceinline__ void done(const Unit&) const {}
};
__device__ __forceinline__ unsigned cvt_pk_bf16(float lo, float hi) { const f32x2 v = {lo, hi}; return __builtin_bit_cast(unsigned, __builtin_convertvector(v, bf16x2_t)); }
__device__ __forceinline__ u32x4 pack8(f32x4 v0, f32x4 v1) { u32x4 w; w.x = cvt_pk_bf16(v0[0], v0[1]); w.y = cvt_pk_bf16(v0[2], v0[3]); w.z = cvt_pk_bf16(v1[0], v1[1]); w.w = cvt_pk_bf16(v1[2], v1[3]); return w; }

struct EpiStore {
    static constexpr bool PERM = true, AFTER_DRAIN = false;
    bf16_t* O; int ldc;
    __device__ __forceinline__ void operator()(const f32x4 (&acc)[2][2][4][2], const Unit& u, int wr, int wc, int fr, int fq) const {
        const int row0 = u.pm * BM + wr * 64 + fr, col0 = u.pn * BM + wc * 32 + 8 * fq;
#pragma unroll
        for (int ai = 0; ai < 2; ++ai)
#pragma unroll
            for (int m = 0; m < 4; ++m) { bf16_t* rowp = O + (size_t)(row0 + ai * HALF + m * 16) * ldc + col0;
#pragma unroll
                for (int bj = 0; bj < 2; ++bj) *(u32x4*)(rowp + bj * HALF) = pack8(acc[ai][bj][m][0], acc[ai][bj][m][1]); }
    }
};
struct EpiKV {
    static constexpr bool PERM = true, AFTER_DRAIN = false;
    bf16_t* Kb; bf16_t* Vb;
    __device__ __forceinline__ void operator()(const f32x4 (&acc)[2][2][4][2], const Unit& u, int wr, int wc, int fr, int fq) const {
        const int row0 = u.pm * BM + wr * 64 + fr, c0 = wc * 32 + 8 * fq;
#pragma unroll
        for (int ai = 0; ai < 2; ++ai)
#pragma unroll
            for (int m = 0; m < 4; ++m) { const size_t row = (size_t)(row0 + ai * HALF + m * 16);
                *(u32x4*)(Kb + row * 1536 + u.pn * 192 + c0) = pack8(acc[ai][0][m][0], acc[ai][0][m][1]);
                *(u32x4*)(Vb + row * 1024 + u.pn * 128 + c0) = pack8(acc[ai][1][m][0], acc[ai][1][m][1]); }
    }
};
struct EpiSwiGLU {
    static constexpr bool PERM = true, AFTER_DRAIN = false;
    bf16_t* Hb; int ldh;
    __device__ __forceinline__ void operator()(const f32x4 (&acc)[2][2][4][2], const Unit& u, int wr, int wc, int fr, int fq) const {
        const int row0 = u.pm * BM + wr * 64 + fr, col0 = u.pn * HALF + wc * 32 + 8 * fq;
#pragma unroll
        for (int ai = 0; ai < 2; ++ai)
#pragma unroll
            for (int m = 0; m < 4; ++m) { f32x4 o[2];
#pragma unroll
                for (int n = 0; n < 2; ++n) { const f32x4 g = acc[ai][0][m][n], up = acc[ai][1][m][n];
#pragma unroll
                    for (int e = 0; e < 4; ++e) o[n][e] = g[e] * __builtin_amdgcn_rcpf(1.f + __expf(-g[e])) * up[e]; }
                *(u32x4*)(Hb + (size_t)(row0 + ai * HALF + m * 16) * ldh + col0) = pack8(o[0], o[1]); }
    }
};
struct EpiPart {
    static constexpr bool PERM = true, AFTER_DRAIN = false;
    float* part;
    __device__ __forceinline__ void operator()(const f32x4 (&acc)[2][2][4][2], const Unit& u, int wr, int wc, int fr, int fq) const {
        const int row0 = (u.pm / 17) * BM + wr * 64 + fr, col0 = u.pn * BM + wc * 32 + 8 * fq;
        float* base = part + (size_t)u.ks * 1024 * 2048;
#pragma unroll
        for (int ai = 0; ai < 2; ++ai)
#pragma unroll
            for (int m = 0; m < 4; ++m) { float* rowp = base + (size_t)(row0 + ai * HALF + m * 16) * 2048 + col0;
#pragma unroll
                for (int bj = 0; bj < 2; ++bj)
#pragma unroll
                    for (int n = 0; n < 2; ++n) *(f32x4*)(rowp + bj * HALF + 4 * n) = acc[ai][bj][m][n]; }
    }
};
struct EpiRes {
    static constexpr bool PERM = true, AFTER_DRAIN = false;
    float* X; const float* gate; int gstride; float alpha;
    __device__ __forceinline__ void operator()(const f32x4 (&acc)[2][2][4][2], const Unit& u, int wr, int wc, int fr, int fq) const {
        const int row0 = u.pm * BM + wr * 64 + fr, col0 = u.pn * BM + wc * 32 + 8 * fq;
        const int vec = (u.pm % 17 == 0) ? 4 : (u.pm / 17);
        const float* gp = gate + (size_t)vec * gstride + col0;
        f32x4 gv[2][2];
#pragma unroll
        for (int bj = 0; bj < 2; ++bj)
#pragma unroll
            for (int n = 0; n < 2; ++n) gv[bj][n] = *(const f32x4*)(gp + bj * HALF + 4 * n);
#pragma unroll
        for (int ai = 0; ai < 2; ++ai)
#pragma unroll
            for (int m = 0; m < 4; ++m) { float* rowp = X + (size_t)(row0 + ai * HALF + m * 16) * 2048 + col0;
#pragma unroll
                for (int bj = 0; bj < 2; ++bj)
#pragma unroll
                    for (int n = 0; n < 2; ++n) { f32x4* p = (f32x4*)(rowp + bj * HALF + 4 * n); const f32x4 x = *p; *p = x * alpha + gv[bj][n] * acc[ai][bj][m][n]; } }
    }
};

template <class Epi, class Sched, bool ALIGN_EPI = false, bool SP2 = false>
__device__ __forceinline__ void gemm_phase(PG8_LAS unsigned char* lds, const Gemm g, const Sched& S, const Epi& E, const int tid) {
    const int wid = __builtin_amdgcn_readfirstlane(tid >> 6), lane = tid & 63, wr = wid >> 2, wc = wid & 3, fr = lane & 15, fq = lane >> 4;
    const int K = g.ld, nt = g.K / BK;
    unsigned voffA[2], voffB[2];
#pragma unroll
    for (int i = 0; i < 2; ++i) { int R, C; stage_rc(tid * 16 + i * 8192, R, C); const int Rb = Epi::PERM ? ((R & ~31) + perm32(R & 31)) : R;
        voffA[i] = (unsigned)(R * K + C) * 2u; voffB[i] = (unsigned)(Rb * K + C) * 2u; }
    const size_t kstep = (size_t)(BK * 2);
    const size_t hstep = (size_t)HALF * K * 2;
    const size_t tstep = 2 * hstep;
    const unsigned ldsw = (unsigned)wid * 1024u;
    const int aoff = lds_byte(wr * 64 + fr, fq * 8), boff = lds_byte(wc * 32 + fr, fq * 8);
#define PG8_SA(b, h) (((b) * 2 + (h)) * HTB)
#define PG8_SB(b, h) ((4 + (b) * 2 + (h)) * HTB)
#define PG8_STAGE(bufoff, gbase, voff) do { _Pragma("unroll") for (int _i = 0; _i < 2; ++_i) \
        __builtin_amdgcn_global_load_lds((const unsigned*)((const char*)(gbase) + (voff)[_i]), (PG8_LAS unsigned*)(lds + (bufoff) + ldsw + _i * 8192), 16, 0, 0); } while (0)
#define PG8_LDA(dst, b, h) do { _Pragma("unroll") for (int m = 0; m < 4; ++m) _Pragma("unroll") for (int k = 0; k < 2; ++k) dst[m][k] = *(const PG8_LAS bf16x8*)(lds + PG8_SA(b, h) + aoff + m * 2048 + k * 1024); } while (0)
#define PG8_LDB(dst, b, h) do { _Pragma("unroll") for (int n = 0; n < 2; ++n) _Pragma("unroll") for (int k = 0; k < 2; ++k) dst[n][k] = *(const PG8_LAS bf16x8*)(lds + PG8_SB(b, h) + boff + n * 2048 + k * 1024); } while (0)
#define PG8_MMA(ai, bj, At, Bt) do { __builtin_amdgcn_s_setprio(1); _Pragma("unroll") for (int m = 0; m < 4; ++m) _Pragma("unroll") for (int n = 0; n < 2; ++n) _Pragma("unroll") for (int k = 0; k < 2; ++k) \
        acc[ai][bj][m][n] = __builtin_amdgcn_mfma_f32_16x16x32_bf16(Bt[n][k], At[m][k], acc[ai][bj][m][n], 0, 0, 0); __builtin_amdgcn_s_setprio(0); } while (0)
#define PG8_WAIT_V(n) asm volatile("s_waitcnt vmcnt(" #n ")" ::: "memory")
#define PG8_WAIT_L(n) asm volatile("s_waitcnt lgkmcnt(" #n ")" ::: "memory")
#define PG8_BAR __builtin_amdgcn_s_barrier()
#define PG8_SCHED __builtin_amdgcn_sched_barrier(0)
    Unit cur, nxt; int ui = 0;
    if (!S.next(0, cur)) return;
    f32x4 acc[2][2][4][2];
#pragma unroll
    for (int a = 0; a < 2; ++a)
#pragma unroll
        for (int b = 0; b < 2; ++b)
#pragma unroll
            for (int m = 0; m < 4; ++m)
#pragma unroll
                for (int n = 0; n < 2; ++n) acc[a][b][m][n] = (f32x4){0.f, 0.f, 0.f, 0.f};
    bf16x8 At[4][2], B0[2][2], B1[2][2];
    const char* cA = (const char*)g.A + (size_t)cur.pm * tstep + cur.ko; const char* cB = (const char*)g.Bt + (size_t)cur.pn * tstep + cur.ko;
    S.a_ready(cur);
    if constexpr (SP2) {
        PG8_STAGE(PG8_SB(0, 0), cB, voffB); PG8_STAGE(PG8_SB(0, 1), cB + hstep, voffB); PG8_STAGE(PG8_SA(0, 0), cA, voffA); PG8_STAGE(PG8_SA(0, 1), cA + hstep, voffA);
        if (wr == 1) PG8_BAR;
        PG8_WAIT_V(2); PG8_BAR;
        PG8_STAGE(PG8_SB(1, 0), cB + kstep, voffB); PG8_STAGE(PG8_SA(1, 0), cA + kstep, voffA); PG8_STAGE(PG8_SB(1, 1), cB + hstep + kstep, voffB);
        PG8_WAIT_V(6); PG8_BAR;
    } else {
        PG8_STAGE(PG8_SB(0, 0), cB, voffB); PG8_STAGE(PG8_SA(0, 0), cA, voffA); PG8_STAGE(PG8_SB(0, 1), cB + hstep, voffB); PG8_STAGE(PG8_SA(0, 1), cA + hstep, voffA);
        if (wr == 1) PG8_BAR;
        PG8_WAIT_V(4); PG8_BAR;
        PG8_STAGE(PG8_SB(1, 0), cB + kstep, voffB); PG8_STAGE(PG8_SA(1, 0), cA + kstep, voffA); PG8_STAGE(PG8_SB(1, 1), cB + hstep + kstep, voffB);
        PG8_WAIT_V(6); PG8_BAR;
    }
    for (;;) {
        const bool has_next = S.next(ui + 1, nxt);
        const char* nA = has_next ? (const char*)g.A + (size_t)nxt.pm * tstep + nxt.ko : cA; const char* nB = has_next ? (const char*)g.Bt + (size_t)nxt.pn * tstep + nxt.ko : cB;
        for (int t = 0; t < nt; t += 2) {
            const bool last = (t == nt - 2);
            const char* a1 = cA + (size_t)(t + 1) * kstep;
            const char* a2 = last ? nA : cA + (size_t)(t + 2) * kstep; const char* b2 = last ? nB : cB + (size_t)(t + 2) * kstep;
            const char* a3 = a2 + kstep; const char* b3 = b2 + kstep;
            if (last && has_next) S.a_ready(nxt);
            if constexpr (SP2) {
            PG8_LDB(B0, 0, 0); PG8_LDB(B1, 0, 1); PG8_SCHED; PG8_LDA(At, 0, 0); PG8_STAGE(PG8_SA(1, 1), a1 + hstep, voffA);
            PG8_WAIT_V(8); PG8_WAIT_L(0); PG8_BAR; PG8_MMA(0, 0, At, B0); PG8_MMA(0, 1, At, B1); PG8_BAR; PG8_SCHED;
            PG8_LDA(At, 0, 1); PG8_STAGE(PG8_SB(0, 0), b2, voffB); PG8_STAGE(PG8_SB(0, 1), b2 + hstep, voffB); PG8_STAGE(PG8_SA(0, 0), a2, voffA);
            PG8_WAIT_V(8); PG8_WAIT_L(0); PG8_BAR; PG8_MMA(1, 0, At, B0); PG8_MMA(1, 1, At, B1); PG8_BAR; PG8_SCHED;
            PG8_LDB(B0, 1, 0); PG8_LDB(B1, 1, 1); PG8_SCHED; PG8_LDA(At, 1, 0); PG8_STAGE(PG8_SA(0, 1), a2 + hstep, voffA);
            PG8_WAIT_V(8); PG8_WAIT_L(0); PG8_BAR; PG8_MMA(0, 0, At, B0); PG8_MMA(0, 1, At, B1); PG8_BAR; PG8_SCHED;
            PG8_LDA(At, 1, 1); PG8_STAGE(PG8_SB(1, 0), b3, voffB); PG8_STAGE(PG8_SB(1, 1), b3 + hstep, voffB); PG8_STAGE(PG8_SA(1, 0), a3, voffA);
            PG8_WAIT_V(8); PG8_WAIT_L(0); PG8_BAR; PG8_MMA(1, 0, At, B0); PG8_MMA(1, 1, At, B1); PG8_BAR; PG8_SCHED;
            } else {
            PG8_LDB(B0, 0, 0); PG8_SCHED; PG8_LDA(At, 0, 0); PG8_STAGE(PG8_SA(1, 1), a1 + hstep, voffA);
            PG8_WAIT_L(8); PG8_BAR; PG8_WAIT_L(0); PG8_MMA(0, 0, At, B0); PG8_BAR; PG8_SCHED;
            PG8_LDB(B1, 0, 1); PG8_STAGE(PG8_SB(0, 0), b2, voffB);
            PG8_BAR; PG8_WAIT_L(0); PG8_MMA(0, 1, At, B1); PG8_BAR;
            PG8_LDA(At, 0, 1); PG8_STAGE(PG8_SA(0, 0), a2, voffA);
            PG8_BAR; PG8_WAIT_L(0); PG8_MMA(1, 0, At, B0); PG8_BAR; PG8_SCHED;
            PG8_STAGE(PG8_SB(0, 1), b2 + hstep, voffB);
            PG8_WAIT_V(6); PG8_BAR; PG8_MMA(1, 1, At, B1); PG8_BAR;
            PG8_LDB(B0, 1, 0); PG8_SCHED; PG8_LDA(At, 1, 0); PG8_STAGE(PG8_SA(0, 1), a2 + hstep, voffA);
            PG8_WAIT_L(8); PG8_BAR; PG8_WAIT_L(0); PG8_MMA(0, 0, At, B0); PG8_BAR; PG8_SCHED;
            PG8_LDB(B1, 1, 1); PG8_STAGE(PG8_SB(1, 0), b3, voffB);
            PG8_BAR; PG8_WAIT_L(0); PG8_MMA(0, 1, At, B1); PG8_BAR;
            PG8_LDA(At, 1, 1); PG8_STAGE(PG8_SA(1, 0), a3, voffA);
            PG8_BAR; PG8_WAIT_L(0); PG8_MMA(1, 0, At, B0); PG8_BAR; PG8_SCHED;
            PG8_STAGE(PG8_SB(1, 1), b3 + hstep, voffB);
            PG8_WAIT_V(6); PG8_BAR; PG8_MMA(1, 1, At, B1); PG8_BAR;
            }
        }
        if constexpr (ALIGN_EPI) { if (wr == 0) PG8_BAR; }
        if constexpr (!Epi::AFTER_DRAIN) { E(acc, cur, wr, wc, fr, fq); S.done(cur); }
        if (!has_next) break;
#pragma unroll
        for (int a = 0; a < 2; ++a)
#pragma unroll
            for (int b = 0; b < 2; ++b)
#pragma unroll
                for (int m = 0; m < 4; ++m)
#pragma unroll
                    for (int n = 0; n < 2; ++n) acc[a][b][m][n] = (f32x4){0.f, 0.f, 0.f, 0.f};
        cur = nxt; cA = nA; cB = nB; ++ui;
        if constexpr (ALIGN_EPI) { if (wr == 1) PG8_BAR; }
    }
    PG8_WAIT_V(0);
    if constexpr (!ALIGN_EPI) { if (wr == 0) PG8_BAR; }
    PG8_BAR;
    if constexpr (Epi::AFTER_DRAIN) { E.fused(acc, cur, wr, wc, fr, fq, lds, wid, lane); S.done(cur); }
#undef PG8_SA
#undef PG8_SB
#undef PG8_STAGE
#undef PG8_LDA
#undef PG8_LDB
#undef PG8_MMA
#undef PG8_WAIT_V
#undef PG8_WAIT_L
#undef PG8_BAR
#undef PG8_SCHED
}
}
namespace cf {
constexpr int D = 2048, NB = 4, SEQ = 4096, CTX = 256, SEGT = 4352, M = 17408, DEPTH = 4;
constexpr int IN_COLS = 4912, PC = 5120;
constexpr int C_CQ = 0, C_CKV = 512, C_KR = 1024, C_RW = 1088, C_GD = 2848;
constexpr int RW_K = 512, RW_V = 1024, RW_WD = 1536, RW_AD = 1600, RW_GD = 1664, RW_COLS = 1760;
constexpr int GD_K = 512, GD_V = 1024, GD_Z = 1536, GD_A = 2048, GD_B = 2056;
constexpr int DFF = 5632, NCH = 68;
constexpr int QP = 1536, KP = 1536, VP = 1024;
constexpr int MODS = 6 * D;
constexpr float ALPHA = 1.681792830507429f;
constexpr int RW_TASK = 33024, GD_TASK = 98816;
}
constexpr size_t MiB = 1u << 20;
constexpr size_t WS_CTL = 0, WS_MODV = 1 * MiB, ZERO_BYTES = 2 * MiB;
constexpr size_t WS_ROPE = 2 * MiB, WS_W2T = 2 * MiB + 65536, WS_A2T = WS_W2T + 262144, WS_G2T = WS_A2T + 262144;
constexpr size_t WS_WIN = 4 * MiB, WS_WOUT = 84 * MiB, WS_WGU = 116 * MiB, WS_WDN = 292 * MiB, WS_WUQ = 380 * MiB, WS_WUKV = 386 * MiB;
constexpr size_t WS_X = 394 * MiB, WS_XM = 530 * MiB;
constexpr size_t WS_P = 598 * MiB, WS_CQN = 768 * MiB, WS_CKVN = 785 * MiB, WS_Q = 802 * MiB, WS_K = 853 * MiB, WS_V = 904 * MiB;
constexpr size_t WS_RWT = 938 * MiB, WS_GDT = 1076 * MiB, WS_YR = 1333 * MiB, WS_YG = 1401 * MiB, WS_GATE = 1469 * MiB, WS_BONUS = 1503 * MiB, WS_END = 1505 * MiB;
constexpr size_t WS_PART = 1076 * MiB;
constexpr size_t WS_HFF = 598 * MiB;
static_assert(WS_RWT + (size_t)4352 * cf::RW_TASK <= WS_GDT && WS_GDT + (size_t)2176 * cf::GD_TASK <= WS_YR && WS_HFF + (size_t)cf::M * cf::DFF * 2 <= WS_CKVN, "ws map");
constexpr int CW_TMO = 0, CW_BAR = 4096;
constexpr int LDS_BYTES = 163840, MISC_OFF = LDS_BYTES - 128;

DI float bflo(unsigned w) { return __builtin_bit_cast(float, w << 16); }
DI float bfhi(unsigned w) { return __builtin_bit_cast(float, w & 0xffff0000u); }
DI float bf2f(bf16 h) { return __builtin_bit_cast(float, (unsigned)h << 16); }
DI unsigned pk2(float lo, float hi) { const f32x2 v = {lo, hi}; return __builtin_bit_cast(unsigned, __builtin_convertvector(v, bf16x2_t)); }
DI bf16 f2bf(float f) { return (bf16)pk2(f, f); }
DI void unpack8(u32x4 w, float (&f)[8]) { f[0] = bflo(w.x); f[1] = bfhi(w.x); f[2] = bflo(w.y); f[3] = bfhi(w.y); f[4] = bflo(w.z); f[5] = bfhi(w.z); f[6] = bflo(w.w); f[7] = bfhi(w.w); }
DI u32x4 pack8f(const float (&f)[8]) { u32x4 w; w.x = pk2(f[0], f[1]); w.y = pk2(f[2], f[3]); w.z = pk2(f[4], f[5]); w.w = pk2(f[6], f[7]); return w; }
template <int X> DI float sx(float v) { return __builtin_bit_cast(float, __builtin_amdgcn_ds_swizzle(__builtin_bit_cast(int, v), 0x1F | (X << 10))); }
DI float lx(float v, int lane, int X) { return __builtin_bit_cast(float, __builtin_amdgcn_ds_bpermute((lane ^ X) << 2, __builtin_bit_cast(int, v))); }
DI float wave_sum(float v, int lane) {
    v += sx<1>(v); v += sx<2>(v); v += sx<4>(v); v += lx(v, lane, 8); v += lx(v, lane, 16); v += lx(v, lane, 32);
    return v;
}
DI float sigmoidf_(float x) { return __builtin_amdgcn_rcpf(1.f + __expf(-x)); }
DI float tanhf_(float x) { return 1.f - 2.f * __builtin_amdgcn_rcpf(1.f + __expf(2.f * x)); }
DI float softplusf_(float x) { const float e = __expf(x); return x > 20.f ? x : (x < -9.f ? e * (1.f - 0.5f * e) : __logf(1.f + e)); }
#define LDS_BARRIER() do { asm volatile("s_waitcnt lgkmcnt(0)" ::: "memory"); __builtin_amdgcn_s_barrier(); asm volatile("" ::: "memory"); } while (0)
#define LDS_WAIT() asm volatile("s_waitcnt lgkmcnt(0)" ::: "memory")
#define MFMA16(a, b, c) __builtin_amdgcn_mfma_f32_16x16x32_bf16((a), (b), (c), 0, 0, 0)

#define XB_TMO      128
#define XB_XCNT(j)  (256  + 64 * (j))
#define XB_XSUB(j)  (1280 + 64 * (j))
#define XB_XGEN(j)  (2304 + 64 * (j))
#define XB_TOP      3328
#define XB_TOPGEN   3392
#define XCD_BAR_WORDS 3456
#define XB_SPIN_CAP (1u << 22)
__device__ __forceinline__ unsigned xb_ld(unsigned* p)              { return __hip_atomic_load(p, __ATOMIC_RELAXED, __HIP_MEMORY_SCOPE_AGENT); }
__device__ __forceinline__ unsigned xb_add(unsigned* p, unsigned v) { return __hip_atomic_fetch_add(p, v, __ATOMIC_RELAXED, __HIP_MEMORY_SCOPE_AGENT); }
__device__ __forceinline__ unsigned xb_xcc_id() { return (unsigned)__builtin_amdgcn_s_getreg((3 << 11) | 20) & 0xFu; }
#define XB_SPIN(cond, bar) do { unsigned _sp = 0; while (cond) { __builtin_amdgcn_s_sleep(1); \
    if ((++_sp & 255u) == 0u) { if (xb_ld(&(bar)[XB_TMO])) break; if (_sp > XB_SPIN_CAP) { atomicAdd(&(bar)[XB_TMO], 1u); break; } } } } while (0)
struct XcdBarrier { unsigned* bar; unsigned x; volatile LAS unsigned* st; };
__device__ __forceinline__ XcdBarrier xcd_barrier_post(unsigned* bar, volatile LAS unsigned* st) {
    XcdBarrier b; b.bar = bar; b.x = xb_xcc_id(); b.st = st;
    if (threadIdx.x == 0) (void)xb_add(&bar[XB_XCNT(b.x)], 1u);
    return b;
}
__device__ __forceinline__ void xcd_barrier_complete(unsigned* bar, unsigned x, unsigned& nloc, unsigned& nx) {
    const unsigned G = gridDim.x * gridDim.y * gridDim.z;
    unsigned sum, cnt, mine, sp = 0u;
    for (;;) {
        sum = 0u; cnt = 0u; mine = 0u;
#pragma unroll
        for (unsigned j = 0; j < 16; ++j) { const unsigned c = xb_ld(&bar[XB_XCNT(j)]); sum += c; cnt += (c > 0u) ? 1u : 0u; mine = (j == x) ? c : mine; }
        if (sum == G) break;
        __builtin_amdgcn_s_sleep(1);
        if ((++sp & 255u) == 0u) { if (xb_ld(&bar[XB_TMO])) break; if (sp > XB_SPIN_CAP) { atomicAdd(&bar[XB_TMO], 1u); break; } }
    }
    nloc = mine > 0u ? mine : 1u; nx = cnt > 0u ? cnt : 1u;
}
__device__ __forceinline__ void xcd_barrier(const XcdBarrier& b) {
    asm volatile("s_waitcnt vmcnt(0)" ::: "memory");
    __syncthreads();
    if (threadIdx.x == 0) {
        unsigned* bar = b.bar;
        __builtin_amdgcn_s_waitcnt(0);
        unsigned nloc = b.st[0], nx = b.st[1];
        if (nloc == 0u) { xcd_barrier_complete(bar, b.x, nloc, nx); b.st[0] = nloc; b.st[1] = nx; }
        const unsigned old = xb_add(&bar[XB_XSUB(b.x)], 1u);
        const unsigned gen = old / nloc;
        if (old + 1u == (gen + 1u) * nloc) {
            __builtin_amdgcn_fence(__ATOMIC_RELEASE, "agent");
            asm volatile("s_waitcnt vmcnt(0)" ::: "memory");
            const unsigned og = xb_add(&bar[XB_TOP], 1u);
            const unsigned tg = og / nx;
            if (og + 1u == (tg + 1u) * nx) xb_add(&bar[XB_TOPGEN], 1u);
            else XB_SPIN(xb_ld(&bar[XB_TOPGEN]) == tg, bar);
            __builtin_amdgcn_fence(__ATOMIC_ACQUIRE, "agent");
            xb_add(&bar[XB_XGEN(b.x)], 1u);
            asm volatile("s_waitcnt vmcnt(0)" ::: "memory");
        } else {
            XB_SPIN(xb_ld(&bar[XB_XGEN(b.x)]) == gen, bar);
            __builtin_amdgcn_fence(__ATOMIC_ACQUIRE, "agent");
            asm volatile("s_waitcnt vmcnt(0)" ::: "memory");
        }
    }
    __syncthreads();
}

DI int row_of(int b, int dir, int ci, int i) {
    int s;
    if (dir == 0) s = ci * 64 + i;
    else s = (ci < 4) ? (3 - ci) * 64 + (63 - i) : 256 + (67 - ci) * 64 + (63 - i);
    return b * cf::SEGT + s;
}
DI void transpose_item(const float* W, int K, int N, bf16* WT, int out_row0, int k0, int n0, LAS float* scr, int lane) {
    const int n = n0 + (lane & 31); const bool ok = n < N;
#pragma unroll 8
    for (int i = 0; i < 32; ++i) { const int kk = 2 * i + (lane >> 5); scr[kk * 33 + (lane & 31)] = ok ? W[(size_t)(k0 + kk) * N + n] : 0.f; }
    LDS_WAIT();
    const int c = lane & 7;
#pragma unroll
    for (int j = 0; j < 4; ++j) { const int nn = (lane >> 3) + 8 * j; const LAS float* s = scr + (8 * c) * 33 + nn;
        u32x4 o; o.x = pk2(s[0 * 33], s[1 * 33]); o.y = pk2(s[2 * 33], s[3 * 33]); o.z = pk2(s[4 * 33], s[5 * 33]); o.w = pk2(s[6 * 33], s[7 * 33]);
        *(u32x4*)(WT + (size_t)(out_row0 + nn) * K + k0 + 8 * c) = o; }
    LDS_WAIT();
}

struct In { const float* p[34]; };

DI void phase_prologue(const In& in, uchar* ws, LAS uchar* lds, int G, int bx, int tid) {
    using namespace cf;
    const int lane = tid & 63, wid = __builtin_amdgcn_readfirstlane(tid >> 6), gw = bx * 8 + wid, NGW = G * 8;
    LAS float* scr = (LAS float*)(lds + wid * 16384);
    constexpr int I_IN = 32 * 160, I_OUT = 32 * 64, I_G = 32 * 176, I_DN = 88 * 64, I_UQ = 8 * 48, I_UKV = 8 * 64;
    constexpr int I_LAYER = I_IN + I_OUT + 2 * I_G + I_DN + I_UQ + I_UKV;
    for (int it = gw; it < DEPTH * I_LAYER; it += NGW) {
        const int l = it / I_LAYER; int r = it % I_LAYER;
        if (r < I_IN) { const int kb = r / 160, nb = r % 160; transpose_item(in.p[6] + (size_t)l * D * IN_COLS, D, IN_COLS, (bf16*)(ws + WS_WIN) + (size_t)l * PC * D, nb * 32, kb * 64, nb * 32, scr, lane); continue; } r -= I_IN;
        if (r < I_OUT) { const int kb = r / 64, nb = r % 64; transpose_item(in.p[26] + (size_t)l * D * D, D, D, (bf16*)(ws + WS_WOUT) + (size_t)l * D * D, nb * 32, kb * 64, nb * 32, scr, lane); continue; } r -= I_OUT;
        if (r < 2 * I_G) { const int up = r >= I_G; if (up) r -= I_G; const int kb = r / 176, nb = r % 176, n0 = nb * 32;
            transpose_item(in.p[up ? 30 : 29] + (size_t)l * D * DFF, D, DFF, (bf16*)(ws + WS_WGU) + (size_t)l * 2 * DFF * D, 256 * (n0 / 128) + (n0 % 128) + (up ? 128 : 0), kb * 64, n0, scr, lane); continue; } r -= 2 * I_G;
        if (r < I_DN) { const int kb = r / 64, nb = r % 64; transpose_item(in.p[31] + (size_t)l * DFF * D, DFF, D, (bf16*)(ws + WS_WDN) + (size_t)l * D * DFF, nb * 32, kb * 64, nb * 32, scr, lane); continue; } r -= I_DN;
        if (r < I_UQ) { const int kb = r / 48, nb = r % 48; transpose_item(in.p[9] + (size_t)l * 512 * 1536, 512, 1536, (bf16*)(ws + WS_WUQ) + (size_t)l * 1536 * 512, nb * 32, kb * 64, nb * 32, scr, lane); continue; } r -= I_UQ;
        { const int kb = r / 64, nb = r % 64; transpose_item(in.p[10] + (size_t)l * 512 * 2048, 512, 2048, (bf16*)(ws + WS_WUKV) + (size_t)l * 2048 * 512, nb * 32, kb * 64, nb * 32, scr, lane); }
    }
    float* X = (float*)(ws + WS_X);
    for (int r = gw; r < M; r += NGW) { const int b = r / SEGT, s = r % SEGT;
        const float* src = (s < CTX) ? in.p[2] + ((size_t)b * CTX + s) * D : in.p[0] + ((size_t)b * SEQ + (s - CTX)) * D;
        const f32x4* sp = (const f32x4*)src + lane; f32x4* dp = (f32x4*)(X + (size_t)r * D) + lane;
#pragma unroll
        for (int j = 0; j < 8; ++j) dp[64 * j] = sp[64 * j]; }
    const int gt = bx * 512 + tid, NGT = G * 512;
    float* rope = (float*)(ws + WS_ROPE);
    for (int i = gt; i < 1024; i += NGT) { const int pos = i >> 4, f = i & 15; const float inv = powf(10000.f, -(float)f / 16.f), ang = (float)pos * inv; rope[i] = cosf(ang); rope[1024 + i] = sinf(ang); }
    bf16* W2T = (bf16*)(ws + WS_W2T); bf16* A2T = (bf16*)(ws + WS_A2T); bf16* G2T = (bf16*)(ws + WS_G2T);
    for (int i = gt; i < DEPTH * 2 * 512 * 32; i += NGT) { const int r = i & 31, c = (i >> 5) & 511, ld = i >> 14;
        W2T[i] = f2bf(in.p[13][((size_t)ld * 32 + r) * 512 + c]); A2T[i] = f2bf(in.p[15][((size_t)ld * 32 + r) * 512 + c]); }
    for (int i = gt; i < DEPTH * 512 * 96; i += NGT) { const int k = i % 96, c = (i / 96) % 512, l = i / (96 * 512);
        G2T[i] = f2bf(in.p[16][((size_t)l * 96 + k) * 512 + c]); }
    LAS float* sv = scr;
    for (int it = gw; it < DEPTH * 48 * 16; it += NGW) {
        const int kp = it & 15, ng = (it >> 4) % 48, l = it / (16 * 48);
        for (int i = lane; i < 640; i += 64) { const int v = i >> 7, k = kp * 128 + (i & 127); const float x = (v < 4) ? in.p[1][v * D + k] : in.p[3][k]; sv[i] = x * sigmoidf_(x); }
        LDS_WAIT();
        const int n = ng * 256 + lane * 4;
        const float* wp = in.p[4] + ((size_t)l * D + (size_t)kp * 128) * MODS + n;
        f32x4 acc[5];
#pragma unroll
        for (int v = 0; v < 5; ++v) acc[v] = (f32x4){0.f, 0.f, 0.f, 0.f};
#pragma unroll 8
        for (int kk = 0; kk < 128; ++kk) { const f32x4 w = *(const f32x4*)(wp + (size_t)kk * MODS);
#pragma unroll
            for (int v = 0; v < 5; ++v) acc[v] += w * sv[v * 128 + kk]; }
        float* part = (float*)(ws + WS_P) + (size_t)kp * (DEPTH * 5 * MODS);
#pragma unroll
        for (int v = 0; v < 5; ++v) *(f32x4*)(part + ((size_t)l * 5 + v) * MODS + n) = acc[v];
        LDS_WAIT();
    }
}

DI void phase_modreduce(const In& in, uchar* ws, int G, int bx, int tid) {
    using namespace cf;
    float* modv = (float*)(ws + WS_MODV); const float* part = (const float*)(ws + WS_P);
    for (int i = bx * 512 + tid; i < DEPTH * 5 * MODS / 4; i += G * 512) { const int n4 = i % (MODS / 4), l = i / (5 * MODS / 4);
        f32x4 s = *(const f32x4*)(in.p[5] + (size_t)l * MODS + n4 * 4);
#pragma unroll
        for (int kp = 0; kp < 16; ++kp) s += *(const f32x4*)(part + (size_t)kp * (DEPTH * 5 * MODS) + (size_t)i * 4);
        *(f32x4*)(modv + (size_t)i * 4) = s; }
}

DI void phase_modulate(const float* X, bf16* XM, const float* modl  , int shift_off, int scale_off, int G, int bx, int tid) {
    using namespace cf;
    const int lane = tid & 63, gw = bx * 8 + __builtin_amdgcn_readfirstlane(tid >> 6), NGW = G * 8;
    for (int r = gw; r < M; r += NGW) { const int b = r / SEGT, s = r % SEGT, vec = (s < CTX) ? 4 : b;
        const f32x4* xp = (const f32x4*)(X + (size_t)r * D) + lane; const f32x4* sh = (const f32x4*)(modl + (size_t)vec * MODS + shift_off) + lane; const f32x4* sc = (const f32x4*)(modl + (size_t)vec * MODS + scale_off) + lane;
        u32x2* op = (u32x2*)(XM + (size_t)r * D) + lane;
#pragma unroll
        for (int j = 0; j < 8; ++j) { const f32x4 v = xp[64 * j] * (sc[64 * j] + 1.f) + sh[64 * j]; u32x2 o; o.x = pk2(v.x, v.y); o.y = pk2(v.z, v.w); op[64 * j] = o; } }
}

DI void ln_one_row(float* X, f32x4 (&v)[8], int r, const float* g, const float* bb, bf16* XM, const float* modl, int shift_off, int scale_off, float* out, const float* part, int nparts, const float* cgate, int lane) {
    using namespace cf;
    const int b = r / SEGT, s = r % SEGT, vec = (s < CTX) ? 4 : b;
    f32x4* xp = (f32x4*)(X + (size_t)r * D) + lane;
    float sum = 0.f;
    if (part && s < CTX) {
        const f32x4* gp4 = (const f32x4*)cgate + lane;
#pragma unroll
        for (int j = 0; j < 8; ++j) { f32x4 a = (f32x4){0.f, 0.f, 0.f, 0.f};
            for (int ks = 0; ks < nparts; ++ks) a += *((const f32x4*)(part + ((size_t)ks * 1024 + b * 256 + s) * D) + lane + 64 * j);
            v[j] = v[j] * ALPHA + gp4[64 * j] * a; } }
#pragma unroll
    for (int j = 0; j < 8; ++j) sum += (v[j].x + v[j].y) + (v[j].z + v[j].w);
    const float mean = wave_sum(sum, lane) * (1.f / D); float s2 = 0.f;
#pragma unroll
    for (int j = 0; j < 8; ++j) { v[j] = v[j] - mean; s2 += (v[j].x * v[j].x + v[j].y * v[j].y) + (v[j].z * v[j].z + v[j].w * v[j].w); }
    const float rstd = rsqrtf(wave_sum(s2, lane) * (1.f / D) + 1e-5f);
    const f32x4* gp = (const f32x4*)g + lane; const f32x4* bp = (const f32x4*)bb + lane;
#pragma unroll
    for (int j = 0; j < 8; ++j) v[j] = v[j] * rstd * gp[64 * j] + bp[64 * j];
    if (out) { f32x4* op = (f32x4*)(out + ((size_t)b * SEQ + (s - CTX)) * D) + lane;
#pragma unroll
        for (int j = 0; j < 8; ++j) op[64 * j] = v[j];
    } else {
        const f32x4* sh = (const f32x4*)(modl + (size_t)vec * MODS + shift_off) + lane; const f32x4* sc = (const f32x4*)(modl + (size_t)vec * MODS + scale_off) + lane;
        u32x2* op = (u32x2*)(XM + (size_t)r * D) + lane;
#pragma unroll
        for (int j = 0; j < 8; ++j) { xp[64 * j] = v[j]; const f32x4 m = v[j] * (sc[64 * j] + 1.f) + sh[64 * j]; u32x2 o; o.x = pk2(m.x, m.y); o.y = pk2(m.z, m.w); op[64 * j] = o; }
    }
}
DI void phase_ln(float* X, const float* g, const float* bb, bf16* XM, const float* modl, int shift_off, int scale_off, float* out, const float* part, int nparts, const float* cgate, bool skip_ctx, int G, int bx, int tid) {
    using namespace cf;
    const int lane = tid & 63, gw = bx * 8 + __builtin_amdgcn_readfirstlane(tid >> 6), NGW = G * 8;
    for (int r0 = gw; r0 < M; r0 += 2 * NGW) {
        const int r1 = r0 + NGW;
        const bool do0 = !(skip_ctx && (r0 % SEGT) < CTX), do1 = r1 < M && !(skip_ctx && (r1 % SEGT) < CTX);
        f32x4 va[8], vb[8];
        if (do0) { const f32x4* xp = (const f32x4*)(X + (size_t)r0 * D) + lane;
#pragma unroll
            for (int j = 0; j < 8; ++j) va[j] = xp[64 * j]; }
        if (do1) { const f32x4* xp = (const f32x4*)(X + (size_t)r1 * D) + lane;
#pragma unroll
            for (int j = 0; j < 8; ++j) vb[j] = xp[64 * j]; }
        if (do0) ln_one_row(X, va, r0, g, bb, XM, modl, shift_off, scale_off, out, part, nparts, cgate, lane);
        if (do1) ln_one_row(X, vb, r1, g, bb, XM, modl, shift_off, scale_off, out, part, nparts, cgate, lane);
    }
}

DI void mla_prep_rows(const bf16* P, bf16* CQN, bf16* CKVN, bf16* Kb, const float* qn, const float* kvn, const float* rope, int G, int bx, int tid) {
    using namespace cf;
    const int lane = tid & 63, gw = bx * 8 + __builtin_amdgcn_readfirstlane(tid >> 6), NGW = G * 8;
    const f32x4 gq0 = *(const f32x4*)(qn + lane * 8), gq1 = *(const f32x4*)(qn + lane * 8 + 4), gk0 = *(const f32x4*)(kvn + lane * 8), gk1 = *(const f32x4*)(kvn + lane * 8 + 4);
    const int axis = lane >> 5, half = (lane >> 4) & 1, f = lane & 15;
    for (int r0 = gw; r0 < M; r0 += 2 * NGW) {
        const int r1 = (r0 + NGW < M) ? r0 + NGW : r0;
        const bf16* pa = P + (size_t)r0 * PC; const bf16* pb = P + (size_t)r1 * PC;
        const u32x4 a0 = *(const u32x4*)(pa + lane * 8), a1 = *(const u32x4*)(pa + 512 + lane * 8), b0 = *(const u32x4*)(pb + lane * 8), b1 = *(const u32x4*)(pb + 512 + lane * 8);
        const bf16 ka = pa[C_KR + lane], kb = pb[C_KR + lane];
#pragma unroll
        for (int rr = 0; rr < 2; ++rr) { const int r = rr ? r1 : r0, s = r % SEGT;
#pragma unroll
            for (int part = 0; part < 2; ++part) {
                float x[8]; unpack8(rr ? (part ? b1 : b0) : (part ? a1 : a0), x);
                float ss = 0.f;
#pragma unroll
                for (int e = 0; e < 8; ++e) ss += x[e] * x[e];
                const float rs = rsqrtf(wave_sum(ss, lane) * (1.f / 512.f) + 1e-6f);
                const f32x4 g0 = part ? gk0 : gq0, g1 = part ? gk1 : gq1;
                float o[8];
#pragma unroll
                for (int e = 0; e < 8; ++e) o[e] = x[e] * rs * (e < 4 ? g0[e] : g1[e - 4]);
                *(u32x4*)((part ? CKVN : CQN) + (size_t)r * 512 + lane * 8) = pack8f(o);
            }
            float kr = bf2f(rr ? kb : ka);
            const float other = lx(kr, lane, 16);
            if (s >= CTX) { const int t = s - CTX, pos = axis ? (t & 63) : (t >> 6);
                const float c = rope[pos * 16 + f], sn = rope[1024 + pos * 16 + f];
                kr = half ? (other * sn + kr * c) : (kr * c - other * sn); }
            const bf16 kq = f2bf(kr);
#pragma unroll
            for (int h = 0; h < 8; ++h) Kb[(size_t)r * KP + h * 192 + 128 + lane] = kq;
        }
    }
}

DI void mix_rows(const bf16* P, const float* YR, const float* YG, const float* GATE, const float* BONUS, bf16* MIX,
                 const float* mu, const float* gn_g, const float* gn_b, const float* gdn_norm, int G, int bx, int tid) {
    using namespace cf;
    const int lane = tid & 63, gw = bx * 8 + __builtin_amdgcn_readfirstlane(tid >> 6), NGW = G * 8;
#pragma unroll 2
    for (int r = gw; r < M; r += NGW) { const int s = r % SEGT; const bf16* pr = P + (size_t)r * PC;
        const bool hasp = (s != 0) && (s != CTX), hasn = (s != CTX - 1) && (s != SEGT - 1);
        const int c0 = lane * 8;
        {
            float y[8], v[8];
            { const f32x4 a0 = *(const f32x4*)(YR + (size_t)r * 512 + c0), a1 = *(const f32x4*)(YR + (size_t)r * 512 + c0 + 4);
              const f32x4 b0 = *(const f32x4*)(YR + ((size_t)M + r) * 512 + c0), b1 = *(const f32x4*)(YR + ((size_t)M + r) * 512 + c0 + 4);
#pragma unroll
              for (int e = 0; e < 4; ++e) { y[e] = a0[e] + b0[e]; y[4 + e] = a1[e] + b1[e]; } }
            float sm = 0.f;
#pragma unroll
            for (int e = 0; e < 8; ++e) sm += y[e];
            sm += sx<1>(sm); sm += sx<2>(sm); sm += sx<4>(sm);
            const float mean = sm * (1.f / 64.f); float q = 0.f;
#pragma unroll
            for (int e = 0; e < 8; ++e) { y[e] -= mean; q += y[e] * y[e]; }
            q += sx<1>(q); q += sx<2>(q); q += sx<4>(q);
            const float rstd = rsqrtf(q * (1.f / 64.f) + 64e-5f);
            { float cur[8], prv[8], nxt[8]; const int col = C_RW + RW_V + c0;
              unpack8(*(const u32x4*)(pr + col), cur);
              if (hasp) unpack8(*(const u32x4*)(pr - PC + col), prv); else {
#pragma unroll
                  for (int e = 0; e < 8; ++e) prv[e] = 0.f; }
              if (hasn) unpack8(*(const u32x4*)(pr + PC + col), nxt); else {
#pragma unroll
                  for (int e = 0; e < 8; ++e) nxt[e] = 0.f; }
              const f32x4 m0 = *(const f32x4*)(mu + RW_V + c0), m1 = *(const f32x4*)(mu + RW_V + c0 + 4);
#pragma unroll
              for (int e = 0; e < 8; ++e) v[e] = cur[e] + (0.5f * (prv[e] + nxt[e]) - cur[e]) * (e < 4 ? m0[e] : m1[e - 4]); }
            const int h = lane >> 3;
            const float bonus = BONUS[(size_t)r * 8 + h] + BONUS[((size_t)M + r) * 8 + h];
            const f32x4 gg0 = *(const f32x4*)(gn_g + c0), gg1 = *(const f32x4*)(gn_g + c0 + 4), gb0 = *(const f32x4*)(gn_b + c0), gb1 = *(const f32x4*)(gn_b + c0 + 4);
            const f32x4 gt0 = *(const f32x4*)(GATE + (size_t)r * 512 + c0), gt1 = *(const f32x4*)(GATE + (size_t)r * 512 + c0 + 4);
            float o[8];
#pragma unroll
            for (int e = 0; e < 8; ++e) o[e] = (y[e] * rstd * (e < 4 ? gg0[e] : gg1[e - 4]) + (e < 4 ? gb0[e] : gb1[e - 4]) + bonus * v[e]) * (e < 4 ? gt0[e] : gt1[e - 4]);
            *(u32x4*)(MIX + (size_t)r * D + 1024 + c0) = pack8f(o);
        }
        {
            float y[8], z[8];
            { const f32x4 a0 = *(const f32x4*)(YG + (size_t)r * 512 + c0), a1 = *(const f32x4*)(YG + (size_t)r * 512 + c0 + 4);
              const f32x4 b0 = *(const f32x4*)(YG + ((size_t)M + r) * 512 + c0), b1 = *(const f32x4*)(YG + ((size_t)M + r) * 512 + c0 + 4);
#pragma unroll
              for (int e = 0; e < 4; ++e) { y[e] = a0[e] + b0[e]; y[4 + e] = a1[e] + b1[e]; } }
            float q = 0.f;
#pragma unroll
            for (int e = 0; e < 8; ++e) q += y[e] * y[e];
            q += sx<1>(q); q += sx<2>(q); q += sx<4>(q); q += lx(q, lane, 8);
            const float rs = rsqrtf(q * (1.f / 128.f) + 1e-6f);
            unpack8(*(const u32x4*)(pr + C_GD + GD_Z + c0), z);
            const int cn = c0 & 127; const f32x4 n0 = *(const f32x4*)(gdn_norm + cn), n1 = *(const f32x4*)(gdn_norm + cn + 4);
            float o[8];
#pragma unroll
            for (int e = 0; e < 8; ++e) o[e] = y[e] * rs * (e < 4 ? n0[e] : n1[e - 4]) * (z[e] * sigmoidf_(z[e]));
            *(u32x4*)(MIX + (size_t)r * D + 1536 + c0) = pack8f(o);
        }
    }
}
#define FRAGOFF(R, C, KS) ((((R) >> 4) * (KS) + ((C) >> 5)) * 1024 + ((((C) >> 3) & 3) * 16 + ((R) & 15)) * 16 + ((C) & 7) * 2)
#define SWZ(row, SH) ((((row) >> (SH)) & 7) << 3)
#define FRAGS(Mx, row, k, SH) (*(const LAS bf16x8*)((Mx) + (row) * 72 + (((k) * 32 + q4 * 8) ^ SWZ(row, SH))))
template <int K> DI f32x4 mm_tile(const LAS bf16* A, int lda, const LAS bf16* Bt, int ldb, int tm, int tn, f32x4 acc, int lane) {
    const int r = lane & 15, q = lane >> 4;
#pragma unroll
    for (int k0 = 0; k0 < K; k0 += 32) {
        const bf16x8 a = *(const LAS bf16x8*)(A + (16 * tm + r) * lda + k0 + q * 8);
        const bf16x8 b = *(const LAS bf16x8*)(Bt + (16 * tn + r) * ldb + k0 + q * 8);
        acc = MFMA16(a, b, acc);
    }
    return acc;
}
template <int NCL>
DI void inv_offblock(const LAS float* A, LAS float* TF, LAS bf16* TT, LAS float* scr, int i, int j, int c0, int lane) {
    const int r = lane & 15, q = lane >> 4, cb = c0 + q * NCL;
    float p[NCL];
#pragma unroll
    for (int e = 0; e < NCL; ++e) p[e] = 0.f;
    for (int kb = j; kb < i; ++kb) {
#pragma unroll
        for (int s = 0; s < 16; ++s) { const float a = A[(16 * i + r) * 65 + 16 * kb + s]; const LAS float* tp = TF + (16 * kb + s) * 65 + 16 * j + cb;
#pragma unroll
            for (int e = 0; e < NCL; ++e) p[e] += a * tp[e]; }
    }
#pragma unroll
    for (int e = 0; e < NCL; ++e) scr[r * 17 + q * NCL + e] = p[e];
    LDS_WAIT();
    float o[NCL];
#pragma unroll
    for (int e = 0; e < NCL; ++e) o[e] = 0.f;
#pragma unroll
    for (int s = 0; s < 16; ++s) { const float t = TF[(16 * i + r) * 65 + 16 * i + s];
#pragma unroll
        for (int e = 0; e < NCL; ++e) o[e] += t * scr[s * 17 + q * NCL + e]; }
#pragma unroll
    for (int e = 0; e < NCL; ++e) { TF[(16 * i + r) * 65 + 16 * j + cb + e] = o[e]; TT[(16 * i + r) * 72 + 16 * j + cb + e] = f2bf(o[e]); }
}
template <class Side>
DI void inv_blocked(const LAS float* A, LAS float* TF, LAS bf16* TT, LAS float* scr_all, int wid, int lane, int tid, const Side& side) {
    if (wid < 4) { if (lane < 16) { const int j = lane, base = 16 * wid; float tc[16];
#pragma unroll
        for (int t = 0; t < 16; ++t) { float acc = (t == j) ? 1.f : 0.f;
#pragma unroll
            for (int s = 0; s < t; ++s) acc += A[(base + t) * 65 + base + s] * tc[s];
            tc[t] = acc; }
#pragma unroll
        for (int t = 0; t < 16; ++t) { TF[(base + t) * 65 + base + j] = tc[t]; TT[(base + t) * 72 + base + j] = f2bf(tc[t]); }
    } } else side(wid - 4);
    LDS_BARRIER();
    LAS float* scr = scr_all + wid * 272;
    if (wid < 6) inv_offblock<2>(A, TF, TT, scr, (wid >> 1) + 1, wid >> 1, (wid & 1) * 8, lane);
    LDS_BARRIER();
    inv_offblock<1>(A, TF, TT, scr, (wid >> 2) + 2, wid >> 2, (wid & 3) * 4, lane);
    LDS_BARRIER();
    if (wid < 4) inv_offblock<1>(A, TF, TT, scr, 3, 0, wid * 4, lane);
    LDS_BARRIER();
}

struct ScanW {
    const float *mu, *w0, *a0, *k_k, *k_a, *r_k;
    const bf16 *W2T, *A2T, *G2T;
    const float *conv, *a_log, *dt_bias;
};

constexpr int RWB = 136192, RWB_W2 = RWB + 2688, RWB_A2 = RWB_W2 + 5120, RWB_G2 = RWB_A2 + 5120;
constexpr int GDB = 143360;
DI void rw_stage_weights(LAS uchar* lds, const ScanW& sw, int h, int dir, int tid) {
    LAS float* WF = (LAS float*)(lds + RWB);
    for (int i = tid; i < 672; i += 512) { float v;
        if (i < 64) v = sw.w0[dir * 512 + h * 64 + i]; else if (i < 128) v = sw.a0[dir * 512 + h * 64 + i - 64]; else if (i < 192) v = sw.k_k[h * 64 + i - 128];
        else if (i < 256) v = sw.k_a[h * 64 + i - 192]; else if (i < 320) v = sw.r_k[h * 64 + i - 256];
        else if (i < 512) v = sw.mu[((i - 320) >> 6) * 512 + h * 64 + ((i - 320) & 63)];
        else if (i < 544) v = sw.mu[cf::RW_WD + dir * 32 + i - 512]; else if (i < 576) v = sw.mu[cf::RW_AD + dir * 32 + i - 544]; else v = sw.mu[cf::RW_GD + i - 576];
        WF[i] = v; }
    { const int which = tid >> 8, t = tid & 255, row = t >> 2, ch = t & 3;
      *(LAS u32x4*)(lds + (which ? RWB_A2 : RWB_W2) + (row * 40 + ch * 8) * 2) = *(const u32x4*)((which ? sw.A2T : sw.W2T) + ((size_t)dir * 512 + h * 64 + row) * 32 + ch * 8); }
    LDS_BARRIER();
}
DI void gd_stage_weights(LAS uchar* lds, const ScanW& sw, int h, int tid) {
    LAS float* CW = (LAS float*)(lds + GDB);
    for (int i = tid; i < 1920; i += 512) { const int jw = i >> 7, c = i & 127; CW[i] = sw.conv[(size_t)(jw / 3) * 1536 + (jw % 3) * 512 + h * 128 + c]; }
    LDS_BARRIER();
}

struct RwRaw { u32x4 c[3]; };
DI void rw_issue(RwRaw& q, const bf16* P, int b, int h, int dir, int ci, int tid) {
    using namespace cf;
    const int i = tid >> 3, sub = tid & 7;
    const int R = row_of(b, dir, ci, i), seg_lo = b * SEGT + (ci < 4 ? 0 : CTX), seg_hi = b * SEGT + (ci < 4 ? CTX : SEGT);
    const bf16* pr = P + (size_t)R * PC + C_RW; (void)seg_lo; (void)seg_hi;
#pragma unroll
    for (int w = 0; w < 3; ++w) { const int col = w * 512 + h * 64 + sub * 8;
        q.c[w] = *(const u32x4*)(pr + col); }
}

DI void s1_rwkv(LAS uchar* lds, const bf16* P, const ScanW& sw, uchar* task, float* GATE, float* BONUSd, int b, int h, int dir, int ci, int tid, unsigned& chk, int nb, int nci) {
    RwRaw raw;
    using namespace cf;
    constexpr int MB = 9216;
    LAS bf16* AT = (LAS bf16*)(lds + 0 * MB); LAS bf16* BT = (LAS bf16*)(lds + 1 * MB); LAS bf16* KT = (LAS bf16*)(lds + 2 * MB); LAS bf16* QT = (LAS bf16*)(lds + 3 * MB);
    LAS bf16* ATT = (LAS bf16*)(lds + 4 * MB); LAS bf16* VT = (LAS bf16*)(lds + 5 * MB); LAS bf16* KHT = (LAS bf16*)(lds + 6 * MB); LAS bf16* BHT = (LAS bf16*)(lds + 7 * MB);
    LAS bf16* AAK = (LAS bf16*)(lds + 8 * MB); LAS bf16* AQK = (LAS bf16*)(lds + 9 * MB); LAS bf16* TT = (LAS bf16*)(lds + 10 * MB); LAS bf16* XT = (LAS bf16*)(lds + 11 * MB);
    LAS float* AAB = (LAS float*)(lds + 12 * MB); LAS float* GC = AAB;
    LAS float* INVS = (LAS float*)(lds + 12 * MB + 16640);
    LAS float* LWf = (LAS float*)(lds + 8 * MB); LAS float* LAf = (LAS float*)(lds + 10 * MB); LAS float* TF = (LAS float*)(lds + 0);
    LAS bf16* WTT = (LAS bf16*)(lds + 0 * MB); LAS bf16* ULT = (LAS bf16*)(lds + 1 * MB); LAS bf16* AQBL = (LAS bf16*)(lds + RWB_G2);
    const LAS float* WF = (const LAS float*)(lds + RWB);
    LAS bf16* TW = (LAS bf16*)(lds + 0); LAS bf16* AD = (LAS bf16*)(lds + 5120); LAS bf16* SG = (LAS bf16*)(lds + 10240);
    const int lane = tid & 63, wid = __builtin_amdgcn_readfirstlane(tid >> 6), i = tid >> 3, sub = tid & 7, r16 = lane & 15, q4 = lane >> 4;
    const int R = row_of(b, dir, ci, i), seg_lo = b * SEGT + (ci < 4 ? 0 : CTX), seg_hi = b * SEGT + (ci < 4 ? CTX : SEGT);
    const bool hasp = R - 1 >= seg_lo, hasn = R + 1 < seg_hi;
    const bf16* pr = P + (size_t)R * PC + C_RW;
    float rv[8], kv[8], vv[8];
#ifndef RW_PREFETCH
    rw_issue(raw, P, b, h, dir, ci, tid);
#endif
#ifdef DUP_ST01
    for (int rp_ = 0; rp_ < 2; ++rp_) {
#endif
#pragma unroll
    for (int w = 0; w < 3; ++w) { const int col = w * 512 + h * 64 + sub * 8; float cur[8], prv[8], nxt[8];
        unpack8(raw.c[w], cur);
        if (hasp) unpack8(*(const u32x4*)(pr - PC + col), prv); else {
#pragma unroll
            for (int e = 0; e < 8; ++e) prv[e] = 0.f; }
        if (hasn) unpack8(*(const u32x4*)(pr + PC + col), nxt); else {
#pragma unroll
            for (int e = 0; e < 8; ++e) nxt[e] = 0.f; }
        const f32x4 m0 = *(const LAS f32x4*)(WF + 320 + w * 64 + sub * 8), m1 = *(const LAS f32x4*)(WF + 320 + w * 64 + sub * 8 + 4);
#pragma unroll
        for (int e = 0; e < 8; ++e) { const float x = cur[e] + (0.5f * (prv[e] + nxt[e]) - cur[e]) * (e < 4 ? m0[e] : m1[e - 4]); if (w == 0) rv[e] = x; else if (w == 1) kv[e] = x; else vv[e] = x; } }
#pragma unroll
    for (int w = 0; w < 2; ++w) { const int col = (w ? RW_AD : RW_WD) + dir * 32 + sub * 4;
        const u32x2 c2 = *(const u32x2*)(pr + col); u32x2 p2 = (u32x2){0u, 0u}, n2 = (u32x2){0u, 0u};
        if (hasp) p2 = *(const u32x2*)(pr - PC + col); if (hasn) n2 = *(const u32x2*)(pr + PC + col);
        const f32x4 m = *(const LAS f32x4*)(WF + 512 + w * 32 + sub * 4);
        const float cur[4] = {bflo(c2.x), bfhi(c2.x), bflo(c2.y), bfhi(c2.y)}, prv[4] = {bflo(p2.x), bfhi(p2.x), bflo(p2.y), bfhi(p2.y)}, nxt[4] = {bflo(n2.x), bfhi(n2.x), bflo(n2.y), bfhi(n2.y)};
        float x[4];
#pragma unroll
        for (int e = 0; e < 4; ++e) { x[e] = cur[e] + (0.5f * (prv[e] + nxt[e]) - cur[e]) * m[e]; if (w == 0) x[e] = tanhf_(x[e]); }
        u32x2 o; o.x = pk2(x[0], x[1]); o.y = pk2(x[2], x[3]);
        *(LAS u32x2*)((w ? AD : TW) + i * 40 + sub * 4) = o; }
    if (dir == 0) {
#pragma unroll
        for (int j = 0; j < 3; ++j) { const int col = RW_GD + sub * 12 + j * 4;
            const u32x2 c2 = *(const u32x2*)(pr + col); u32x2 p2 = (u32x2){0u, 0u}, n2 = (u32x2){0u, 0u};
            if (hasp) p2 = *(const u32x2*)(pr - PC + col); if (hasn) n2 = *(const u32x2*)(pr + PC + col);
            const f32x4 m = *(const LAS f32x4*)(WF + 576 + sub * 12 + j * 4);
            const float cur[4] = {bflo(c2.x), bfhi(c2.x), bflo(c2.y), bfhi(c2.y)}, prv[4] = {bflo(p2.x), bfhi(p2.x), bflo(p2.y), bfhi(p2.y)}, nxt[4] = {bflo(n2.x), bfhi(n2.x), bflo(n2.y), bfhi(n2.y)};
            float x[4];
#pragma unroll
            for (int e = 0; e < 4; ++e) x[e] = sigmoidf_(cur[e] + (0.5f * (prv[e] + nxt[e]) - cur[e]) * m[e]);
            u32x2 o; o.x = pk2(x[0], x[1]); o.y = pk2(x[2], x[3]);
            *(LAS u32x2*)(SG + i * 104 + sub * 12 + j * 4) = o; }
    }
    LDS_BARRIER();
    { const int which = wid >> 2, tm = wid & 3;
      const bf16x8 a = *(const LAS bf16x8*)((which ? AD : TW) + (16 * tm + r16) * 40 + q4 * 8);
      const LAS bf16* wt = (const LAS bf16*)(lds + (which ? RWB_A2 : RWB_W2));
#pragma unroll
      for (int tn = 0; tn < 4; ++tn) { const bf16x8 bb = *(const LAS bf16x8*)(wt + (16 * tn + r16) * 40 + q4 * 8);
          const f32x4 acc = MFMA16(a, bb, ((f32x4){0.f, 0.f, 0.f, 0.f}));
#pragma unroll
          for (int e = 0; e < 4; ++e) (which ? LAf : LWf)[(16 * tm + 4 * q4 + e) * 65 + 16 * tn + r16] = acc[e]; } }
    if (dir == 0) { const int tm = wid >> 1;
#pragma unroll
        for (int j = 0; j < 2; ++j) { const int tn = (wid & 1) * 2 + j; f32x4 acc = (f32x4){0.f, 0.f, 0.f, 0.f};
#pragma unroll
            for (int k0 = 0; k0 < 96; k0 += 32) { const bf16x8 a = *(const LAS bf16x8*)(SG + (16 * tm + r16) * 104 + k0 + q4 * 8);
                const bf16x8 bb = *(const bf16x8*)(sw.G2T + (size_t)(h * 64 + 16 * tn + r16) * 96 + k0 + q4 * 8); acc = MFMA16(a, bb, acc); }
#pragma unroll
            for (int e = 0; e < 4; ++e) GATE[(size_t)row_of(b, 0, ci, 16 * tm + 4 * q4 + e) * 512 + h * 64 + 16 * tn + r16] = acc[e]; } }
    LDS_BARRIER();
#ifdef DUP_ST01
    }
#endif
    float av[8], bv[8], kd[8], lw[8];
#ifdef S1DBG
    float dbgv[8];
#endif
#ifdef DUP_ST2A
    for (int rp_ = 0; rp_ < 2; ++rp_) {
#endif
    { const int hc = h * 64 + sub * 8; float ss = 0.f, bon = 0.f, kk[8], al[8];
#pragma unroll
      for (int e = 0; e < 8; ++e) { const int c = sub * 8 + e;
          const float wl = -softplusf_(-(WF[c] + LWf[i * 65 + c])) - 0.5f; lw[e] = -__expf(wl);
          al[e] = sigmoidf_(WF[64 + c] + LAf[i * 65 + c]);
          kk[e] = kv[e] * WF[128 + c]; ss += kk[e] * kk[e]; }
      ss += sx<1>(ss); ss += sx<2>(ss); ss += sx<4>(ss);
      const float rn = rsqrtf(ss + 1e-12f);
#pragma unroll
      for (int e = 0; e < 8; ++e) { kk[e] *= rn; kd[e] = kv[e] * (1.f + (al[e] - 1.f) * WF[192 + sub * 8 + e]); av[e] = -kk[e]; bv[e] = kk[e] * al[e]; bon += rv[e] * kd[e] * WF[256 + sub * 8 + e];
#ifdef S1DBG
          dbgv[e] = (S1DBG == 1) ? al[e] : kk[e];
#endif
      }
      bon += sx<1>(bon); bon += sx<2>(bon); bon += sx<4>(bon);
      if (sub == 0) BONUSd[(size_t)R * 8 + h] = bon;
#pragma unroll
      for (int e = 0; e < 8; ++e) GC[i * 65 + sub * 8 + e] = lw[e]; }
    LDS_BARRIER();
#ifdef DUP_ST2A
    }
#endif
    {
        LAS float* TOT = INVS;
        float g8[8]; float run = 0.f;
#pragma unroll
        for (int j = 0; j < 8; ++j) g8[j] = GC[(wid * 8 + j) * 65 + lane];
#pragma unroll
        for (int j = 0; j < 8; ++j) { run += g8[j]; g8[j] = run; }
        TOT[wid * 64 + lane] = run;
        LDS_BARRIER();
        float off = 0.f;
#pragma unroll
        for (int sgm = 0; sgm < 7; ++sgm) { const float tv = TOT[sgm * 64 + lane]; off += (sgm < wid) ? tv : 0.f; }
#pragma unroll
        for (int j = 0; j < 8; ++j) GC[(wid * 8 + j) * 65 + lane] = g8[j] + off;
    }
    LDS_BARRIER();
#ifdef DUP_ST2C
    for (int rp_ = 0; rp_ < 2; ++rp_) {
#endif
    { float at[8], bt[8], kt[8], qt[8], bh[8], kh[8];
#pragma unroll
      for (int e = 0; e < 8; ++e) { const int c = sub * 8 + e; const float Gi = GC[i * 65 + c], Gm = (i > 0) ? GC[(i - 1) * 65 + c] : 0.f, GL = GC[63 * 65 + c];
          const float eG = __expf(Gi), eGm = __expf(Gm), enG = __expf(-Gi), eLG = __expf(GL - Gi);
          at[e] = av[e] * eGm; bt[e] = bv[e] * enG; kt[e] = kd[e] * enG; qt[e] = rv[e] * eG;
#ifdef S1DBG
          qt[e] = dbgv[e];
#endif
          bh[e] = bv[e] * eLG; kh[e] = kd[e] * eLG;
          if (i == 63) ((float*)(task + 32768))[c] = eG; }
      *(LAS u32x4*)(AT + i * 72 + sub * 8) = pack8f(at); *(LAS u32x4*)(BT + i * 72 + sub * 8) = pack8f(bt); *(LAS u32x4*)(KT + i * 72 + sub * 8) = pack8f(kt); *(LAS u32x4*)(QT + i * 72 + sub * 8) = pack8f(qt);
#pragma unroll
      for (int e = 0; e < 8; ++e) { const int c = sub * 8 + e, is = i ^ (sub << 3); ATT[c * 72 + is] = f2bf(at[e]); VT[c * 72 + is] = f2bf(vv[e]); KHT[c * 72 + is] = f2bf(kh[e]); BHT[c * 72 + is] = f2bf(bh[e]); } }
    LDS_BARRIER();
#ifdef DUP_ST2C
    }
#endif
#ifdef DUP_ST3
    for (int rp_ = 0; rp_ < 2; ++rp_) {
#endif
    RwRaw warm; rw_issue(warm, P, nb, h, dir, nci, tid);
    for (int z_ = tid; z_ < 64 * 72 / 8; z_ += 512) ((LAS u32x4*)TT)[z_] = (u32x4){0u, 0u, 0u, 0u};
    {
#define FRAG(Mx, row, k) (*(const LAS bf16x8*)((Mx) + (row) * 72 + (k) * 32 + q4 * 8))
      const int tm = wid >> 1;
      const bf16x8 a0 = FRAG(AT, 16 * tm + r16, 0), a1 = FRAG(AT, 16 * tm + r16, 1), q0 = FRAG(QT, 16 * tm + r16, 0), q1 = FRAG(QT, 16 * tm + r16, 1);
#pragma unroll
      for (int j = 0; j < 2; ++j) { const int tn = (wid & 1) * 2 + j; const f32x4 z = (f32x4){0.f, 0.f, 0.f, 0.f};
          f32x4 cab = z, cak = z, cqb = z, cqk = z;
          if (tm >= tn) { const bf16x8 b0 = FRAG(BT, 16 * tn + r16, 0), b1 = FRAG(BT, 16 * tn + r16, 1), k0 = FRAG(KT, 16 * tn + r16, 0), k1 = FRAG(KT, 16 * tn + r16, 1);
              cab = MFMA16(a0, b0, z); cab = MFMA16(a1, b1, cab); cak = MFMA16(a0, k0, z); cak = MFMA16(a1, k1, cak);
              cqb = MFMA16(q0, b0, z); cqb = MFMA16(q1, b1, cqb); cqk = MFMA16(q0, k0, z); cqk = MFMA16(q1, k1, cqk); }
#pragma unroll
          for (int e = 0; e < 4; ++e) { const int ti = 16 * tm + 4 * q4 + e, tj = 16 * tn + r16; const bool lo = ti > tj, le = ti >= tj;
              AAB[ti * 65 + tj] = lo ? cab[e] : 0.f; AAK[ti * 72 + tj] = f2bf(lo ? cak[e] : 0.f); AQBL[ti * 72 + tj] = f2bf(le ? cqb[e] : 0.f); AQK[ti * 72 + tj] = f2bf(le ? cqk[e] : 0.f); } }
#undef FRAG
    }
    LDS_BARRIER();
#ifdef DUP_ST3
    }
#endif
    inv_blocked(AAB, TF, TT, INVS, wid, lane, tid, [&](int sw_) {
#pragma unroll
        for (int j = 0; j < 4; ++j) { const int tm = sw_, tn = j;
            f32x4 acc = MFMA16(*(const LAS bf16x8*)(AAK + (16 * tm + r16) * 72 + q4 * 8), FRAGS(VT, 16 * tn + r16, 0, 3), ((f32x4){0.f, 0.f, 0.f, 0.f}));
            acc = MFMA16(*(const LAS bf16x8*)(AAK + (16 * tm + r16) * 72 + 32 + q4 * 8), FRAGS(VT, 16 * tn + r16, 1, 3), acc);
            u32x2 o; o.x = pk2(acc[0], acc[1]); o.y = pk2(acc[2], acc[3]); *(LAS u32x2*)(XT + (16 * tn + r16) * 72 + 16 * tm + 4 * q4) = o; } });
#ifdef DUP_ST6
    for (int rp_ = 0; rp_ < 2; ++rp_) {
#endif
    { const int mat = wid >> 2, tm = wid & 3; LAS bf16* dst = mat ? ULT : WTT; const LAS bf16* Bm = mat ? XT : ATT;
#define FRAG(Mx, row, k) (*(const LAS bf16x8*)((Mx) + (row) * 72 + (k) * 32 + q4 * 8))
      const bf16x8 t0 = FRAG(TT, 16 * tm + r16, 0), t1 = FRAG(TT, 16 * tm + r16, 1);
#pragma unroll
      for (int tn = 0; tn < 4; ++tn) { const int sz = mat ? 0 : SWZ(16 * tn + r16, 3);
          f32x4 acc = MFMA16(t0, *(const LAS bf16x8*)(Bm + (16 * tn + r16) * 72 + ((q4 * 8) ^ sz)), ((f32x4){0.f, 0.f, 0.f, 0.f})); acc = MFMA16(t1, *(const LAS bf16x8*)(Bm + (16 * tn + r16) * 72 + ((32 + q4 * 8) ^ sz)), acc);
          u32x2 o; o.x = pk2(acc[0], acc[1]); o.y = pk2(acc[2], acc[3]); *(LAS u32x2*)(dst + (16 * tn + r16) * 72 + 16 * tm + 4 * q4) = o; }
#undef FRAG
    }
    LDS_BARRIER();
    {
#define FRAG(Mx, row, k) (*(const LAS bf16x8*)((Mx) + (row) * 72 + (k) * 32 + q4 * 8))
      const int tm = wid >> 1;
      const bf16x8 w0 = FRAG(WTT, 16 * tm + r16, 0), w1 = FRAG(WTT, 16 * tm + r16, 1), h0 = FRAGS(BHT, 16 * tm + r16, 0, 3), h1 = FRAGS(BHT, 16 * tm + r16, 1, 3);
      const bf16x8 k0 = FRAGS(KHT, 16 * tm + r16, 0, 3), k1 = FRAGS(KHT, 16 * tm + r16, 1, 3), a0 = FRAG(AQBL, 16 * tm + r16, 0), a1 = FRAG(AQBL, 16 * tm + r16, 1), g0 = FRAG(AQK, 16 * tm + r16, 0), g1 = FRAG(AQK, 16 * tm + r16, 1);
#pragma unroll
      for (int j = 0; j < 2; ++j) { const int tn = (wid & 1) * 2 + j; const f32x4 z = (f32x4){0.f, 0.f, 0.f, 0.f};
          { f32x4 acc = MFMA16(w0, FRAGS(BHT, 16 * tn + r16, 0, 3), z); acc = MFMA16(w1, FRAGS(BHT, 16 * tn + r16, 1, 3), acc);
            u32x2 o; o.x = pk2(acc[0], acc[1]); o.y = pk2(acc[2], acc[3]); *(u32x2*)(task + 0 + FRAGOFF(16 * tn + r16, 16 * tm + 4 * q4, 2)) = o; }
          { f32x4 acc = MFMA16(w0, FRAG(AQBL, 16 * tn + r16, 0), z); acc = MFMA16(w1, FRAG(AQBL, 16 * tn + r16, 1), acc);
            const u32x2 qq = *(const LAS u32x2*)(QT + (16 * tn + r16) * 72 + 16 * tm + 4 * q4);
            u32x2 o; o.x = pk2(acc[0] + bflo(qq.x), acc[1] + bfhi(qq.x)); o.y = pk2(acc[2] + bflo(qq.y), acc[3] + bfhi(qq.y)); *(u32x2*)(task + 8192 + FRAGOFF(16 * tn + r16, 16 * tm + 4 * q4, 2)) = o; }
          { f32x4 acc = MFMA16(h0, FRAG(ULT, 16 * tn + r16, 0), z); acc = MFMA16(h1, FRAG(ULT, 16 * tn + r16, 1), acc);
            acc = MFMA16(k0, FRAGS(VT, 16 * tn + r16, 0, 3), acc); acc = MFMA16(k1, FRAGS(VT, 16 * tn + r16, 1, 3), acc);
            u32x2 o; o.x = pk2(acc[0], acc[1]); o.y = pk2(acc[2], acc[3]); *(u32x2*)(task + 16384 + ((tm * 2 + (tn >> 1)) * 64 + lane) * 16 + (tn & 1) * 8) = o; }
          { f32x4 acc = MFMA16(a0, FRAG(ULT, 16 * tn + r16, 0), z); acc = MFMA16(a1, FRAG(ULT, 16 * tn + r16, 1), acc);
            acc = MFMA16(g0, FRAGS(VT, 16 * tn + r16, 0, 3), acc); acc = MFMA16(g1, FRAGS(VT, 16 * tn + r16, 1, 3), acc);
            u32x2 o; o.x = pk2(acc[0], acc[1]); o.y = pk2(acc[2], acc[3]); *(u32x2*)(task + 24576 + ((tm * 2 + (tn >> 1)) * 64 + lane) * 16 + (tn & 1) * 8) = o; } }
#undef FRAG
    }
    LDS_BARRIER();
    chk ^= warm.c[0].x ^ warm.c[1].x ^ warm.c[2].x;
#ifdef DUP_ST6
    }
#endif
}

DI void s1_gdn(LAS uchar* lds, const bf16* P, const ScanW& sw, uchar* task, int b, int h, int dir, int ci, int tid) {
    using namespace cf;
    LAS bf16* KL = (LAS bf16*)(lds + 0); LAS bf16* QL = (LAS bf16*)(lds + 17408);
    LAS bf16* VT = (LAS bf16*)(lds + 34816); LAS bf16* KBT = (LAS bf16*)(lds + 53248); LAS bf16* BHT = (LAS bf16*)(lds + 71680);
    LAS bf16* TT = (LAS bf16*)(lds + 90112); LAS float* AAB = (LAS float*)(lds + 99328); LAS float* TF = (LAS float*)(lds + 115968);
    LAS float* INVS = (LAS float*)(lds + 132608); LAS float* gvec = (LAS float*)(lds + 141312); LAS bf16* AQBL = (LAS bf16*)(lds + 151552);
    const int lane = tid & 63, wid = __builtin_amdgcn_readfirstlane(tid >> 6), i = tid >> 3, sub = tid & 7, r16 = lane & 15, q4 = lane >> 4;
    const int R = row_of(b, dir, ci, i), seg_lo = b * SEGT + (ci < 4 ? 0 : CTX), seg_hi = b * SEGT + (ci < 4 ? CTX : SEGT);
    const bf16* pr = P + (size_t)R * PC + C_GD;
    float qv[16], kv[16], vv[16];
#pragma unroll
    for (int w = 0; w < 3; ++w) { const int col = w * 512 + h * 128 + sub * 16; float acc[16];
#pragma unroll
        for (int e = 0; e < 16; ++e) acc[e] = 0.f;
#pragma unroll
        for (int j = 0; j < 5; ++j) { const int Rj = R + j - 2;
            if (Rj >= seg_lo && Rj < seg_hi) { float x[16]; float xa[8], xb[8];
                unpack8(*(const u32x4*)(pr + (ptrdiff_t)(j - 2) * PC + col), xa); unpack8(*(const u32x4*)(pr + (ptrdiff_t)(j - 2) * PC + col + 8), xb);
#pragma unroll
                for (int e = 0; e < 8; ++e) { x[e] = xa[e]; x[8 + e] = xb[e]; }
                const LAS float* cw = (const LAS float*)(lds + GDB) + (j * 3 + w) * 128 + sub * 16;
#pragma unroll
                for (int e4 = 0; e4 < 4; ++e4) { const f32x4 c4 = *(const LAS f32x4*)(cw + 4 * e4);
#pragma unroll
                    for (int e = 0; e < 4; ++e) acc[4 * e4 + e] += c4[e] * x[4 * e4 + e]; } } }
#pragma unroll
        for (int e = 0; e < 16; ++e) { const float x = acc[e] * sigmoidf_(acc[e]); if (w == 0) qv[e] = x; else if (w == 1) kv[e] = x; else vv[e] = x; } }
    { float sq = 0.f, sk = 0.f;
#pragma unroll
      for (int e = 0; e < 16; ++e) { sq += qv[e] * qv[e]; sk += kv[e] * kv[e]; }
      sq += sx<1>(sq); sq += sx<2>(sq); sq += sx<4>(sq); sk += sx<1>(sk); sk += sx<2>(sk); sk += sx<4>(sk);
      const float rq = rsqrtf(sq + 1e-12f) * 0.08838834764831845f, rk = rsqrtf(sk + 1e-12f);
#pragma unroll
      for (int e = 0; e < 16; ++e) { qv[e] *= rq; kv[e] *= rk; } }
    if (sub == 0) { const float a_raw = bf2f(pr[GD_A + dir * 4 + h]), b_raw = bf2f(pr[GD_B + dir * 4 + h]);
        gvec[i] = -__expf(sw.a_log[dir * 4 + h]) * softplusf_(a_raw + sw.dt_bias[dir * 4 + h]); gvec[64 + i] = sigmoidf_(b_raw); }
    { float t0[8], t1[8];
#pragma unroll
      for (int e = 0; e < 8; ++e) { t0[e] = kv[e]; t1[e] = kv[8 + e]; }
      *(LAS u32x4*)(KL + i * 136 + sub * 16) = pack8f(t0); *(LAS u32x4*)(KL + i * 136 + sub * 16 + 8) = pack8f(t1);
#pragma unroll
      for (int e = 0; e < 8; ++e) { t0[e] = qv[e]; t1[e] = qv[8 + e]; }
      *(LAS u32x4*)(QL + i * 136 + sub * 16) = pack8f(t0); *(LAS u32x4*)(QL + i * 136 + sub * 16 + 8) = pack8f(t1); }
    LDS_BARRIER();
    if (wid == 0) { float g = 0.f;
#pragma unroll 8
        for (int t = 0; t < 64; ++t) { const float x = gvec[t]; g += (t <= lane) ? x : 0.f; }
        gvec[128 + lane] = g; }
    LDS_BARRIER();
    for (int z_ = tid; z_ < 64 * 72 / 8; z_ += 512) ((LAS u32x4*)TT)[z_] = (u32x4){0u, 0u, 0u, 0u};
    { const float Gi = gvec[128 + i], GL = gvec[128 + 63], be = gvec[64 + i], eG = __expf(Gi), eLG = __expf(GL - Gi), beG = be * eG;
#pragma unroll
      for (int e = 0; e < 16; ++e) { const int c = sub * 16 + e, is = i ^ (sub << 3); VT[c * 72 + is] = f2bf(be * vv[e]); KBT[c * 72 + is] = f2bf(beG * kv[e]); BHT[c * 72 + is] = f2bf(kv[e] * eLG); }
      if (tid < 128) ((float*)(task + 98304))[tid] = __expf(GL); }
    { const int mat = wid >> 2, tm = wid & 3;
      const LAS bf16* Am = mat ? QL : KL;
      bf16x8 af[4];
#pragma unroll
      for (int k = 0; k < 4; ++k) af[k] = *(const LAS bf16x8*)(Am + (16 * tm + r16) * 136 + k * 32 + q4 * 8);
#pragma unroll
      for (int tn = 0; tn < 4; ++tn) { f32x4 acc = (f32x4){0.f, 0.f, 0.f, 0.f};
          if (tm >= tn) {
#pragma unroll
              for (int k = 0; k < 4; ++k) acc = MFMA16(af[k], *(const LAS bf16x8*)(KL + (16 * tn + r16) * 136 + k * 32 + q4 * 8), acc); }
          const float Gj = gvec[128 + 16 * tn + r16];
#pragma unroll
          for (int e = 0; e < 4; ++e) { const int ti = 16 * tm + 4 * q4 + e, tj = 16 * tn + r16; const float dec = __expf(fminf(gvec[128 + ti] - Gj, 0.f));
              if (mat == 0) AAB[ti * 65 + tj] = (ti > tj) ? -gvec[64 + ti] * acc[e] * dec : 0.f;
              else AQBL[ti * 72 + tj] = f2bf((ti >= tj) ? acc[e] * dec : 0.f); } } }
    LDS_BARRIER();
    inv_blocked(AAB, TF, TT, INVS, wid, lane, tid, [](int) {});
    LAS bf16* WTT = (LAS bf16*)(lds + 99328); LAS bf16* ULT = (LAS bf16*)(lds + 99328 + 18432);
    { const int mat = wid >> 2, tm = wid & 3;
      const bf16x8 t0 = *(const LAS bf16x8*)(TT + (16 * tm + r16) * 72 + q4 * 8), t1 = *(const LAS bf16x8*)(TT + (16 * tm + r16) * 72 + 32 + q4 * 8); const LAS bf16* Bm = mat ? KBT : VT;
      LAS bf16* dst = mat ? WTT : ULT; const float sg = mat ? -1.f : 1.f;
#pragma unroll
      for (int tn = 0; tn < 8; ++tn) { f32x4 z = MFMA16(t0, FRAGS(Bm, 16 * tn + r16, 0, 4), ((f32x4){0.f, 0.f, 0.f, 0.f})); z = MFMA16(t1, FRAGS(Bm, 16 * tn + r16, 1, 4), z);
          u32x2 o; o.x = pk2(sg * z[0], sg * z[1]); o.y = pk2(sg * z[2], sg * z[3]); *(LAS u32x2*)(dst + (16 * tn + r16) * 72 + 16 * tm + 4 * q4) = o; } }
    LDS_BARRIER();
    {
#define FRAG(Mx, row, k) (*(const LAS bf16x8*)((Mx) + (row) * 72 + (k) * 32 + q4 * 8))
      const bf16x8 w0 = FRAG(WTT, 16 * wid + r16, 0), w1 = FRAG(WTT, 16 * wid + r16, 1);
      const bf16x8 h0 = FRAGS(BHT, 16 * wid + r16, 0, 4), h1 = FRAGS(BHT, 16 * wid + r16, 1, 4);
#pragma unroll
      for (int tn = 0; tn < 8; ++tn) {
          f32x4 acc = MFMA16(w0, FRAGS(BHT, 16 * tn + r16, 0, 4), ((f32x4){0.f, 0.f, 0.f, 0.f})); acc = MFMA16(w1, FRAGS(BHT, 16 * tn + r16, 1, 4), acc);
          u32x2 o; o.x = pk2(acc[0], acc[1]); o.y = pk2(acc[2], acc[3]); *(u32x2*)(task + 0 + FRAGOFF(16 * tn + r16, 16 * wid + 4 * q4, 4)) = o; }
#pragma unroll
      for (int tn = 0; tn < 8; ++tn) {
          f32x4 acc = MFMA16(h0, FRAG(ULT, 16 * tn + r16, 0), ((f32x4){0.f, 0.f, 0.f, 0.f})); acc = MFMA16(h1, FRAG(ULT, 16 * tn + r16, 1), acc);
          u32x2 o; o.x = pk2(acc[0], acc[1]); o.y = pk2(acc[2], acc[3]); *(u32x2*)(task + 49152 + ((wid * 4 + (tn >> 1)) * 64 + lane) * 16 + (tn & 1) * 8) = o; }
#pragma unroll
      for (int tn = 0; tn < 4; ++tn) {
          f32x4 acc = MFMA16(w0, FRAG(AQBL, 16 * tn + r16, 0), ((f32x4){0.f, 0.f, 0.f, 0.f})); acc = MFMA16(w1, FRAG(AQBL, 16 * tn + r16, 1), acc);
          const int t = 16 * tn + r16; const float eG = __expf(gvec[128 + t]); const u32x2 qq = *(const LAS u32x2*)(QL + t * 136 + 16 * wid + 4 * q4);
          u32x2 o; o.x = pk2(acc[0] + eG * bflo(qq.x), acc[1] + eG * bfhi(qq.x)); o.y = pk2(acc[2] + eG * bflo(qq.y), acc[3] + eG * bfhi(qq.y)); *(u32x2*)(task + 32768 + FRAGOFF(t, 16 * wid + 4 * q4, 4)) = o; }
      { const int tm = wid >> 1; const bf16x8 a0 = FRAG(AQBL, 16 * tm + r16, 0), a1 = FRAG(AQBL, 16 * tm + r16, 1);
#pragma unroll
        for (int j = 0; j < 4; ++j) { const int tn = (wid & 1) * 4 + j;
            f32x4 acc = MFMA16(a0, FRAG(ULT, 16 * tn + r16, 0), ((f32x4){0.f, 0.f, 0.f, 0.f})); acc = MFMA16(a1, FRAG(ULT, 16 * tn + r16, 1), acc);
            u32x2 o; o.x = pk2(acc[0], acc[1]); o.y = pk2(acc[2], acc[3]); *(u32x2*)(task + 81920 + ((tm * 4 + (tn >> 1)) * 64 + lane) * 16 + (tn & 1) * 8) = o; } }
#undef FRAG
    }
    LDS_BARRIER();
}

template <int NK, bool LOC> struct S2FA { bf16x8 wt[NK / 32]; u32x4 ul; };
template <int NK, bool LOC> struct S2FB { bf16x8 qt[NK / 32], aqb[2], bht[2]; u32x4 yl, kl; f32x4 gl; float gls; };
template <int NK, bool LOC>
DI void s2_load_a(S2FA<NK, LOC>& f, const uchar* task, int o_wt, int o_ul, int ulh, int tm, int lane) {
    const int r16 = lane & 15, q4 = lane >> 4;
#pragma unroll
    for (int k = 0; k < NK / 32; ++k) f.wt[k] = *(const bf16x8*)(task + o_wt + ((size_t)(16 * tm + r16) * NK + k * 32 + q4 * 8) * 2);
    f.ul = *(const u32x4*)(task + o_ul + (size_t)(ulh * 64 + lane) * 16);
}
template <int NK, bool LOC>
DI void s2_load_b(S2FB<NK, LOC>& f, const uchar* task, int o_qt, int o_aqb, int o_bht, int o_yl, int ulh, int o_kl, int o_gl, int tm, int cm, int ch, int lane) {
    const int r16 = lane & 15, q4 = lane >> 4;
#pragma unroll
    for (int k = 0; k < NK / 32; ++k) f.qt[k] = *(const bf16x8*)(task + o_qt + ((size_t)(16 * tm + r16) * NK + k * 32 + q4 * 8) * 2);
    if (LOC) f.yl = *(const u32x4*)(task + o_yl + (size_t)(ulh * 64 + lane) * 16);
#pragma unroll
    for (int k = 0; k < 2; ++k) { f.aqb[k] = *(const bf16x8*)(task + o_aqb + ((size_t)(16 * tm + r16) * 64 + k * 32 + q4 * 8) * 2); f.bht[k] = *(const bf16x8*)(task + o_bht + ((size_t)(16 * cm + r16) * 64 + k * 32 + q4 * 8) * 2); }
    if (LOC) f.kl = *(const u32x4*)(task + o_kl + (size_t)((cm * 2 + ch) * 64 + lane) * 16);
    if (LOC) f.gl = *(const f32x4*)(task + o_gl + (size_t)(16 * cm + 4 * q4) * 4); else f.gls = *(const float*)(task + o_gl);
}
template <int NK, bool LOC>
DI void s2_step(const S2FA<NK, LOC>& fa, const S2FB<NK, LOC>& fb, f32x4 (&H)[NK / 32], const LAS bf16* Hc, LAS bf16* Hn, LAS bf16* UT, float* Y, int ycol0, int b, int dir, int ci, int tm, int tn0, int cm, int ctn0, int lane) {
    constexpr int NH = NK / 32, LDH = NK + 8;
    const int r16 = lane & 15, q4 = lane >> 4;
    f32x4 U[2], Yv[2];
    U[0] = (f32x4){bflo(fa.ul.x), bfhi(fa.ul.x), bflo(fa.ul.y), bfhi(fa.ul.y)}; U[1] = (f32x4){bflo(fa.ul.z), bfhi(fa.ul.z), bflo(fa.ul.w), bfhi(fa.ul.w)};
#pragma unroll
    for (int j = 0; j < 2; ++j) {
#pragma unroll
        for (int k = 0; k < NK / 32; ++k) { const bf16x8 hb = *(const LAS bf16x8*)(Hc + (16 * (tn0 + j) + r16) * LDH + k * 32 + q4 * 8); U[j] = MFMA16(fa.wt[k], hb, U[j]); }
        u32x2 o; o.x = pk2(U[j][0], U[j][1]); o.y = pk2(U[j][2], U[j][3]);
        *(LAS u32x2*)(UT + (16 * (tn0 + j) + r16) * 72 + 16 * tm + 4 * q4) = o;
    }
    LDS_BARRIER();
    if (LOC) { Yv[0] = (f32x4){bflo(fb.yl.x), bfhi(fb.yl.x), bflo(fb.yl.y), bfhi(fb.yl.y)}; Yv[1] = (f32x4){bflo(fb.yl.z), bfhi(fb.yl.z), bflo(fb.yl.w), bfhi(fb.yl.w)}; }
    else { Yv[0] = (f32x4){0.f, 0.f, 0.f, 0.f}; Yv[1] = Yv[0]; }
#pragma unroll
    for (int j = 0; j < 2; ++j) {
#pragma unroll
        for (int k = 0; k < NK / 32; ++k) { const bf16x8 hb = *(const LAS bf16x8*)(Hc + (16 * (tn0 + j) + r16) * LDH + k * 32 + q4 * 8); Yv[j] = MFMA16(fb.qt[k], hb, Yv[j]); }
#pragma unroll
        for (int k = 0; k < 2; ++k) { const bf16x8 ub = *(const LAS bf16x8*)(UT + (16 * (tn0 + j) + r16) * 72 + k * 32 + q4 * 8); Yv[j] = MFMA16(fb.aqb[k], ub, Yv[j]); }
#pragma unroll
        for (int e = 0; e < 4; ++e) Y[(size_t)row_of(b, dir, ci, 16 * tm + 4 * q4 + e) * 512 + ycol0 + 16 * (tn0 + j) + r16] = Yv[j][e];
    }
#pragma unroll
    for (int j = 0; j < NH; ++j) {
        f32x4 h = LOC ? H[j] * fb.gl : H[j] * fb.gls;
        if (LOC) { if (j == 0) h += (f32x4){bflo(fb.kl.x), bfhi(fb.kl.x), bflo(fb.kl.y), bfhi(fb.kl.y)}; else h += (f32x4){bflo(fb.kl.z), bfhi(fb.kl.z), bflo(fb.kl.w), bfhi(fb.kl.w)}; }
#pragma unroll
        for (int k = 0; k < 2; ++k) { const bf16x8 ub = *(const LAS bf16x8*)(UT + (16 * (ctn0 + j) + r16) * 72 + k * 32 + q4 * 8); h = MFMA16(fb.bht[k], ub, h); }
        H[j] = h;
        u32x2 o; o.x = pk2(h[0], h[1]); o.y = pk2(h[2], h[3]);
        *(LAS u32x2*)(Hn + (16 * (ctn0 + j) + r16) * LDH + 16 * cm + 4 * q4) = o;
    }
    LDS_BARRIER();
}
template <int NK, bool LOC>
DI void s2_scan(LAS uchar* lds, const uchar* task0, int task_bytes, int o_wt, int o_qt, int o_aqb, int o_bht, int o_ul, int ulq, int o_yl, int o_kl, int o_gl,
                float* Y, int ycol0, int b, int dir, int tid) {
    constexpr int NH = NK / 32, LDH = NK + 8;
    LAS bf16* HT = (LAS bf16*)lds;
    LAS bf16* UT = (LAS bf16*)(lds + 2 * 64 * LDH * 2);
    const int lane = tid & 63, wid = tid >> 6;
    const int tm = wid >> 1, tn0 = (wid & 1) * 2;
    const int cm = (NK == 64) ? (wid >> 1) : wid, ctn0 = (NK == 64) ? (wid & 1) * 2 : 0;
    const int ulh = tm * ulq + (wid & 1);
    for (int i = tid; i < 64 * LDH * 2 / 16; i += 512) ((LAS u32x4*)HT)[i] = (u32x4){0u, 0u, 0u, 0u};
    f32x4 H[NH];
#pragma unroll
    for (int j = 0; j < NH; ++j) H[j] = (f32x4){0.f, 0.f, 0.f, 0.f};
    S2FA<NK, LOC> a0, a1, a2; S2FB<NK, LOC> b0, b1, b2;
#define TASKP(c) (task0 + (size_t)((c) < cf::NCH ? (c) : cf::NCH - 1) * task_bytes)
#define LDA(f, c) s2_load_a<NK, LOC>(f, TASKP(c), o_wt, o_ul, ulh, tm, lane)
#define LDB(f, c) s2_load_b<NK, LOC>(f, TASKP(c), o_qt, o_aqb, o_bht, o_yl, ulh, o_kl, o_gl, tm, cm, (wid & 1), lane)
#define STP(fa, fb, c) s2_step<NK, LOC>(fa, fb, H, HT + ((c) & 1) * 64 * LDH, HT + (((c) + 1) & 1) * 64 * LDH, UT, Y, ycol0, b, dir, (c), tm, tn0, cm, ctn0, lane)
    LDA(a0, 0); LDB(b0, 0); LDA(a1, 1); LDB(b1, 1);
    LDS_BARRIER();
#pragma unroll 2
    for (int ci = 0; ci < cf::NCH; ++ci) {
        LDA(a2, ci + 2); LDB(b2, ci + 2); STP(a0, b0, ci);
        a0 = a1; a1 = a2; b0 = b1; b1 = b2;
    }
#undef TASKP
#undef LDA
#undef LDB
#undef STP
}

template <int NK, bool VECG> struct S2N { bf16x8 m[NK / 32], q[NK / 32]; u32x4 n[NK / 64], y; f32x4 gl; float gls; };
template <int NK, bool VECG>
DI void s2n_load(S2N<NK, VECG>& f, const uchar* task, int o_m, int o_q, int o_n, int o_y, int o_gl, int tm, int cm, int nh0, int yh, int lane) {
    const int r16 = lane & 15, q4 = lane >> 4;
#pragma unroll
    for (int k = 0; k < NK / 32; ++k) { f.m[k] = *(const bf16x8*)(task + o_m + (size_t)((cm * (NK / 32) + k) * 64 + lane) * 16); f.q[k] = *(const bf16x8*)(task + o_q + (size_t)((tm * (NK / 32) + k) * 64 + lane) * 16); }
#pragma unroll
    for (int j = 0; j < NK / 64; ++j) f.n[j] = *(const u32x4*)(task + o_n + (size_t)((nh0 + j) * 64 + lane) * 16);
    f.y = *(const u32x4*)(task + o_y + (size_t)(yh * 64 + lane) * 16);
    if (VECG) f.gl = *(const f32x4*)(task + o_gl + (size_t)(16 * cm + 4 * q4) * 4); else f.gls = *(const float*)(task + o_gl);
}
template <int NK, bool VECG>
DI void s2n_step(const S2N<NK, VECG>& f, f32x4 (&H)[NK / 32], const LAS bf16* Hc, LAS bf16* Hn, LAS float* YS, float* Y, int ycol0, int b, int dir, int ci, int tm, int tn0, int cm, int ctn0, int wid, int lane) {
    constexpr int NH = NK / 32, LDH = NK + 8;
    const int r16 = lane & 15, q4 = lane >> 4;
#pragma unroll
    for (int j = 0; j < NH; ++j) {
        const u32x4 nn = f.n[j >> 1];
        f32x4 h = VECG ? H[j] * f.gl : H[j] * f.gls;
        h += (j & 1) ? (f32x4){bflo(nn.z), bfhi(nn.z), bflo(nn.w), bfhi(nn.w)} : (f32x4){bflo(nn.x), bfhi(nn.x), bflo(nn.y), bfhi(nn.y)};
#pragma unroll
        for (int k = 0; k < NK / 32; ++k) { const bf16x8 hb = *(const LAS bf16x8*)(Hc + (16 * (ctn0 + j) + r16) * LDH + k * 32 + q4 * 8); h = MFMA16(f.m[k], hb, h); }
        H[j] = h;
        u32x2 o; o.x = pk2(h[0], h[1]); o.y = pk2(h[2], h[3]);
        *(LAS u32x2*)(Hn + (16 * (ctn0 + j) + r16) * LDH + 16 * cm + 4 * q4) = o;
    }
#pragma unroll
    for (int j = 0; j < 2; ++j) {
        f32x4 yv = j ? (f32x4){bflo(f.y.z), bfhi(f.y.z), bflo(f.y.w), bfhi(f.y.w)} : (f32x4){bflo(f.y.x), bfhi(f.y.x), bflo(f.y.y), bfhi(f.y.y)};
#pragma unroll
        for (int k = 0; k < NK / 32; ++k) { const bf16x8 hb = *(const LAS bf16x8*)(Hc + (16 * (tn0 + j) + r16) * LDH + k * 32 + q4 * 8); yv = MFMA16(f.q[k], hb, yv); }
#pragma unroll
        for (int e = 0; e < 4; ++e) YS[(16 * tm + 4 * q4 + e) * 65 + 16 * (tn0 + j) + r16] = yv[e];
    }
    LDS_BARRIER();
#pragma unroll
    for (int e = 0; e < 8; ++e) { const int t = 8 * wid + e;
        Y[(size_t)row_of(b, dir, ci, t) * 512 + ycol0 + lane] = YS[t * 65 + lane]; }
}
template <int NK, bool VECG>
DI void s2n_scan(LAS uchar* lds, const uchar* task0, int task_bytes, int o_m, int o_q, int o_n, int o_y, int o_gl, int nq, int vs, float* Y, int ycol0, int b, int dir, int tid) {
    constexpr int NH = NK / 32, LDH = NK + 8;
    LAS bf16* HT = (LAS bf16*)lds;
    LAS float* YSB = (LAS float*)(lds + 2 * 64 * LDH * 2);
    const int lane = tid & 63, wid = __builtin_amdgcn_readfirstlane(tid >> 6);
    const int tm = wid >> 1, tn0 = (wid & 1) * 2;
    const int cm = (NK == 64) ? (wid >> 1) : wid, ctn0 = (NK == 64) ? (wid & 1) * 2 : 0;
    const int nh0 = (NK == 64) ? (cm * nq + (wid & 1)) : (cm * nq + vs * 2), yh = tm * nq + vs * 2 + (wid & 1);
    for (int i = tid; i < 64 * LDH * 2 / 16; i += 512) ((LAS u32x4*)HT)[i] = (u32x4){0u, 0u, 0u, 0u};
    f32x4 H[NH];
#pragma unroll
    for (int j = 0; j < NH; ++j) H[j] = (f32x4){0.f, 0.f, 0.f, 0.f};
#define TP(c) (task0 + (size_t)((c) < cf::NCH ? (c) : cf::NCH - 1) * task_bytes)
#define LD(f, c) s2n_load<NK, VECG>(f, TP(c), o_m, o_q, o_n, o_y, o_gl, tm, cm, nh0, yh, lane)
#define ST(f, c) s2n_step<NK, VECG>(f, H, HT + ((c) & 1) * 64 * LDH, HT + (((c) + 1) & 1) * 64 * LDH, YSB + ((c) & 1) * 64 * 65, Y, ycol0, b, dir, (c), tm, tn0, cm, ctn0, wid, lane)
    if constexpr (NK == 64) {
        S2N<NK, VECG> f0, f1, f2, f3;
        LD(f0, 0); LD(f1, 1); LD(f2, 2);
        LDS_BARRIER();
#pragma unroll 1
        for (int ci = 0; ci < cf::NCH; ci += 4) {
            LD(f3, ci + 3); ST(f0, ci);
            LD(f0, ci + 4); ST(f1, ci + 1);
            LD(f1, ci + 5); ST(f2, ci + 2);
            LD(f2, ci + 6); ST(f3, ci + 3);
        }
    } else {
        S2N<NK, VECG> f0, f1, f2;
        LD(f0, 0); LD(f1, 1);
        LDS_BARRIER();
#pragma unroll 1
        for (int ci = 0; ci + 2 < cf::NCH; ci += 3) {
            LD(f2, ci + 2); ST(f0, ci);
            LD(f0, ci + 3); ST(f1, ci + 1);
            LD(f1, ci + 4); ST(f2, ci + 2);
        }
        ST(f0, cf::NCH - 2); ST(f1, cf::NCH - 1);
    }
#undef TP
#undef LD
#undef ST
}
namespace at {
constexpr int DQ = 192, DV = 128, NW = 8, QBLK = 32, KVBLK = 64;
constexpr float SCALE = 0.07216878364870322f;
constexpr float THR = 8.f;
constexpr int SHM_V = KVBLK * DV * 2, SHM_K = KVBLK * DQ * 2, SHM_Q = NW * 8 * 1024, SHM_ATTN = 2 * SHM_V + 2 * SHM_K + NW * 64 * 4 + SHM_Q;
#define KSWZ(row, colB) ((row) * 384 + ((colB) ^ (((row) & 7) << 4)))
#define SBAR() __builtin_amdgcn_sched_barrier(0)
DI int crow(int r, int hi) { return (r & 3) + 8 * (r >> 2) + 4 * hi; }
DI unsigned cvtpk(float lo, float hi) { const f32x2 v = {lo, hi}; return __builtin_bit_cast(unsigned, __builtin_convertvector(v, bf16x2_t)); }
DI void partialSM(f32x16& p0, f32x16& p1, float& m_reg, float& mn, float& alpha) {
  constexpr float C = SCALE * 1.4426950408889634f;
  float pmax = p0[0];
#pragma unroll
  for (int r = 1; r < 16; ++r) pmax = fmaxf(pmax, p0[r]);
#pragma unroll
  for (int r = 0; r < 16; ++r) pmax = fmaxf(pmax, p1[r]);
  { auto rr = __builtin_amdgcn_permlane32_swap(__float_as_uint(pmax), __float_as_uint(pmax), false, false);
    pmax = fmaxf(__uint_as_float(rr[0]), __uint_as_float(rr[1])); }
  if (__builtin_expect(__all(pmax - m_reg <= THR / SCALE), 1)) { mn = m_reg; alpha = 1.f; }
  else { mn = fmaxf(m_reg, pmax); alpha = __builtin_amdgcn_exp2f((m_reg - mn) * C); m_reg = mn; }
  float mnC = -mn * C;
#pragma unroll
  for (int r = 0; r < 16; ++r) p0[r] = fmaf(p0[r], C, mnC);
#pragma unroll
  for (int r = 0; r < 16; ++r) p1[r] = fmaf(p1[r], C, mnC);
#pragma unroll
  for (int r = 0; r < 16; ++r) p0[r] = __builtin_amdgcn_exp2f(p0[r]);
}
DI void finishSM(f32x16& p0, f32x16& p1, float alpha, float& l_reg, bf16x8& pa0, bf16x8& pa1, bf16x8& pa2, bf16x8& pa3) {
#pragma unroll
  for (int r = 0; r < 16; ++r) p1[r] = __builtin_amdgcn_exp2f(p1[r]);
  float ps = 0;
#pragma unroll
  for (int r = 0; r < 16; ++r) ps += p0[r];
#pragma unroll
  for (int r = 0; r < 16; ++r) ps += p1[r];
  { auto rr = __builtin_amdgcn_permlane32_swap(__float_as_uint(ps), __float_as_uint(ps), false, false);
    ps = __uint_as_float(rr[0]) + __uint_as_float(rr[1]); }
  l_reg = l_reg * alpha + ps;
#define PK4(P, BASE, OUT) do { unsigned a0 = cvtpk(P[BASE + 0], P[BASE + 1]), a1 = cvtpk(P[BASE + 2], P[BASE + 3]);   \
    unsigned b0 = cvtpk(P[BASE + 4], P[BASE + 5]), b1 = cvtpk(P[BASE + 6], P[BASE + 7]);                              \
    auto r0 = __builtin_amdgcn_permlane32_swap(a0, b0, false, false); auto r1 = __builtin_amdgcn_permlane32_swap(a1, b1, false, false); \
    u32x4 w = {r0[0], r1[0], r0[1], r1[1]}; OUT = *reinterpret_cast<bf16x8*>(&w); } while (0)
  PK4(p0, 0, pa0); PK4(p0, 8, pa1); PK4(p1, 0, pa2); PK4(p1, 8, pa3);
#undef PK4
}
constexpr int NQR = 5;
DI void qkt(f32x16& p0, f32x16& p1, const LAS char* Ks, const bf16x8* qr, const LAS char* qlds, int r32, int hi) {
  p0 = f32x16{}; p1 = f32x16{};
#pragma unroll
  for (int d0 = 0; d0 < 12; ++d0) { int cb = (d0 * 16 + hi * 8) * 2;
    const bf16x8 qf = (d0 < NQR) ? qr[d0] : *(const LAS bf16x8*)(qlds + (d0 - NQR) * 1024);
    bf16x8 b0 = *(const LAS bf16x8*)(Ks + KSWZ(r32, cb));
    bf16x8 b1 = *(const LAS bf16x8*)(Ks + KSWZ(32 + r32, cb));
    p0 = __builtin_amdgcn_mfma_f32_32x32x16_bf16(b0, qf, p0, 0, 0, 0);
    p1 = __builtin_amdgcn_mfma_f32_32x32x16_bf16(b1, qf, p1, 0, 0, 0); }
}
DI int v_st(int k, int c) { const int kk = (k & ~0xC) | ((k & 4) << 1) | ((k & 8) >> 1); return ((kk >> 3) * 4 + (c >> 5)) * 512 + ((kk & 7) * 32 + (c & 31)) * 2; }
DI int v_rd_base(int lane) { return ((lane & 3) << 3) | (((lane >> 2) & 3) << 6) | (((lane >> 4) & 1) << 5) | (((lane >> 5) & 1) << 8); }
constexpr int v_rd_off(int d0, int ks, int half) { return d0 * 512 + ks * 4096 + half * 2048; }
template <int OFF> DI s16x4 tr_read(int vb) { s16x4 r; asm volatile("ds_read_b64_tr_b16 %0, %1 offset:%2" : "=&v"(r) : "v"(vb), "i"(OFF) : "memory"); return r; }
template <int D0> DI void pv_one(f32x16& od, int vb, bf16x8 pa0, bf16x8 pa1, bf16x8 pa2, bf16x8 pa3) {
  const s16x4 l0 = tr_read<v_rd_off(D0, 0, 0)>(vb), h0 = tr_read<v_rd_off(D0, 0, 1)>(vb), l1 = tr_read<v_rd_off(D0, 1, 0)>(vb), h1 = tr_read<v_rd_off(D0, 1, 1)>(vb);
  const s16x4 l2 = tr_read<v_rd_off(D0, 2, 0)>(vb), h2 = tr_read<v_rd_off(D0, 2, 1)>(vb), l3 = tr_read<v_rd_off(D0, 3, 0)>(vb), h3 = tr_read<v_rd_off(D0, 3, 1)>(vb);
  asm volatile("s_waitcnt lgkmcnt(0)" ::: "memory"); SBAR();
#define PK(L, H) (bf16x8){L[0], L[1], L[2], L[3], H[0], H[1], H[2], H[3]}
  od = __builtin_amdgcn_mfma_f32_32x32x16_bf16(pa0, PK(l0, h0), od, 0, 0, 0);
  od = __builtin_amdgcn_mfma_f32_32x32x16_bf16(pa1, PK(l1, h1), od, 0, 0, 0);
  od = __builtin_amdgcn_mfma_f32_32x32x16_bf16(pa2, PK(l2, h2), od, 0, 0, 0);
  od = __builtin_amdgcn_mfma_f32_32x32x16_bf16(pa3, PK(l3, h3), od, 0, 0, 0);
#undef PK
}
DI void pv_d0(f32x16* o, int vb, bf16x8 pa0, bf16x8 pa1, bf16x8 pa2, bf16x8 pa3) {
  pv_one<0>(o[0], vb, pa0, pa1, pa2, pa3); pv_one<1>(o[1], vb, pa0, pa1, pa2, pa3); pv_one<2>(o[2], vb, pa0, pa1, pa2, pa3); pv_one<3>(o[3], vb, pa0, pa1, pa2, pa3);
}
DI void attn_unit(const bf16* __restrict__ Qb, const bf16* __restrict__ Kh, const bf16* __restrict__ Vh, bf16* __restrict__ Ob, int seq, const float* rope, int pos0, LAS char* lds, const int tid) {
  constexpr int LDQ = cf::QP, LDKK = cf::KP, LDVV = cf::VP, LDO = cf::D;
  const int wid = __builtin_amdgcn_readfirstlane(tid >> 6), lane = tid & 63, r32 = lane & 31, hi = lane >> 5;
  LAS char* V_lds = lds; LAS char* K_lds = lds + 2 * SHM_V;
  LAS float* ws = (LAS float*)(lds + 2 * SHM_V + 2 * SHM_K) + wid * 64; LAS float* li_l = ws; LAS float* al_l = ws + 32;
  LAS char* qlds = lds + 2 * SHM_V + 2 * SHM_K + NW * 64 * 4 + wid * (12 - NQR) * 1024 + lane * 16;
  float m_reg = -1e30f, l_reg = 0; f32x16 o[4] = {}; bf16x8 qr[12];
  const bf16* Qw = Qb + (long)(wid * QBLK + r32) * LDQ + hi * 8;
#pragma unroll
  for (int d0 = 0; d0 < 12; ++d0) qr[d0] = *reinterpret_cast<const bf16x8*>(Qw + d0 * 16);
  if (rope) { const int t = pos0 + wid * QBLK + r32;
#pragma unroll
    for (int ax = 0; ax < 2; ++ax) { const int pos = ax ? (t & 63) : (t >> 6);
      const f32x4 c0 = *(const f32x4*)(rope + pos * 16 + hi * 8), c1 = *(const f32x4*)(rope + pos * 16 + hi * 8 + 4), s0 = *(const f32x4*)(rope + 1024 + pos * 16 + hi * 8), s1 = *(const f32x4*)(rope + 1024 + pos * 16 + hi * 8 + 4);
      float x1[8], x2[8], o1[8], o2[8]; unpack8(__builtin_bit_cast(u32x4, qr[8 + 2 * ax]), x1); unpack8(__builtin_bit_cast(u32x4, qr[9 + 2 * ax]), x2);
#pragma unroll
      for (int e = 0; e < 8; ++e) { const float c = e < 4 ? c0[e] : c1[e - 4], s = e < 4 ? s0[e] : s1[e - 4]; o1[e] = x1[e] * c - x2[e] * s; o2[e] = x1[e] * s + x2[e] * c; }
      qr[8 + 2 * ax] = __builtin_bit_cast(bf16x8, pack8f(o1)); qr[9 + 2 * ax] = __builtin_bit_cast(bf16x8, pack8f(o2)); } }
#pragma unroll
  for (int d0 = NQR; d0 < 12; ++d0) *(LAS bf16x8*)(qlds + (d0 - NQR) * 1024) = qr[d0];
  const int sr = tid >> 4, sc = (tid & 15) * 8, vst0 = v_st(sr, sc), vst1 = v_st(32 + sr, sc);
  int kr_[3], kc_[3];
#pragma unroll
  for (int j = 0; j < 3; ++j) { const int q = tid + 512 * j; kr_[j] = q / 24; kc_[j] = (q % 24) * 8; }
  const int vb0 = (int)(uintptr_t)V_lds + v_rd_base(lane);
  bf16x8 vs0 = {}, vs1 = {}, ks0 = {}, ks1 = {}, ks2 = {};
#define SLOAD(k0) do { vs0 = *(const bf16x8*)(&Vh[(long)((k0) + sr) * LDVV + sc]); vs1 = *(const bf16x8*)(&Vh[(long)((k0) + 32 + sr) * LDVV + sc]); \
    ks0 = *(const bf16x8*)(&Kh[(long)((k0) + kr_[0]) * LDKK + kc_[0]]); ks1 = *(const bf16x8*)(&Kh[(long)((k0) + kr_[1]) * LDKK + kc_[1]]); ks2 = *(const bf16x8*)(&Kh[(long)((k0) + kr_[2]) * LDKK + kc_[2]]); } while (0)
#define SWRITE(b) do { *(LAS bf16x8*)(V_lds + (b) * SHM_V + vst0) = vs0; *(LAS bf16x8*)(V_lds + (b) * SHM_V + vst1) = vs1; \
    *(LAS bf16x8*)(K_lds + (b) * SHM_K + KSWZ(kr_[0], kc_[0] * 2)) = ks0; *(LAS bf16x8*)(K_lds + (b) * SHM_K + KSWZ(kr_[1], kc_[1] * 2)) = ks1; *(LAS bf16x8*)(K_lds + (b) * SHM_K + KSWZ(kr_[2], kc_[2] * 2)) = ks2; } while (0)
#define SWAIT() asm volatile("s_waitcnt vmcnt(0)" ::: "memory")
#define RESC(a) do { if (__any((a) < 1.f)) { if (hi == 0) al_l[r32] = (a); asm volatile("s_waitcnt lgkmcnt(0)" ::: "memory"); \
    _Pragma("unroll") for (int d = 0; d < 4; ++d) _Pragma("unroll") for (int r = 0; r < 16; ++r) o[d][r] *= al_l[crow(r, hi)]; } } while (0)
  f32x16 pA0 = {}, pA1 = {}, pB0 = {}, pB1 = {}; float mnA = 0.f, mnB = 0.f, alA = 1.f, alB = 1.f; bf16x8 pa0 = {}, pa1 = {}, pa2 = {}, pa3 = {}; const int NT = seq / KVBLK;
  SLOAD(0); SWAIT(); SWRITE(0); __syncthreads();
  qkt(pA0, pA1, K_lds, qr, qlds, r32, hi); partialSM(pA0, pA1, m_reg, mnA, alA);
  SLOAD(KVBLK);
  SWAIT(); SWRITE(1); __syncthreads();
  for (int j = 1; j + 1 < NT; j += 2) {
    SBAR(); qkt(pB0, pB1, K_lds + SHM_K, qr, qlds, r32, hi);
    finishSM(pA0, pA1, alA, l_reg, pa0, pa1, pa2, pa3); SBAR();
    SLOAD((j + 1) * KVBLK); SBAR();
    pv_d0(o, vb0, pa0, pa1, pa2, pa3); partialSM(pB0, pB1, m_reg, mnB, alB);
    __syncthreads(); SWAIT(); SWRITE(0);
    RESC(alB); __syncthreads();
    SBAR(); qkt(pA0, pA1, K_lds, qr, qlds, r32, hi);
    finishSM(pB0, pB1, alB, l_reg, pa0, pa1, pa2, pa3); SBAR();
    SLOAD((j + 2) * KVBLK); SBAR();
    pv_d0(o, vb0 + (int)SHM_V, pa0, pa1, pa2, pa3); partialSM(pA0, pA1, m_reg, mnA, alA);
    __syncthreads(); SWAIT(); SWRITE(1);
    RESC(alA); __syncthreads();
  }
  SBAR(); qkt(pB0, pB1, K_lds + SHM_K, qr, qlds, r32, hi);
  finishSM(pA0, pA1, alA, l_reg, pa0, pa1, pa2, pa3); SBAR();
  pv_d0(o, vb0, pa0, pa1, pa2, pa3); partialSM(pB0, pB1, m_reg, mnB, alB);
  __syncthreads(); RESC(alB);
  finishSM(pB0, pB1, alB, l_reg, pa0, pa1, pa2, pa3); SBAR();
  pv_d0(o, vb0 + (int)SHM_V, pa0, pa1, pa2, pa3);
  if (hi == 0) li_l[r32] = l_reg; asm volatile("s_waitcnt lgkmcnt(0)" ::: "memory");
  float rli[16];
#pragma unroll
  for (int r = 0; r < 16; ++r) rli[r] = __builtin_amdgcn_rcpf(li_l[crow(r, hi)]);
  bf16* Ow = Ob + (long)(wid * QBLK) * LDO;
#pragma unroll
  for (int r = 0; r < 16; ++r) { int orow = crow(r, hi);
#pragma unroll
    for (int d0 = 0; d0 < 4; ++d0) Ow[(long)orow * LDO + d0 * 32 + r32] = f2bf(o[d0][r] * rli[r]); }
  __syncthreads();
#undef SLOAD
#undef SWRITE
#undef SWAIT
#undef RESC
}
#undef KSWZ
}
#if defined(PROBE)
DI void fatomic_max(unsigned* p, float v) { atomicMax(p, __builtin_bit_cast(unsigned, fabsf(v))); }
DI float pshift(const bf16* P, int R, int lo, int hi, int col, const float* mu, int mucol) {
    const float c = bf2f(P[(size_t)R * cf::PC + col]), p = (R - 1 >= lo) ? bf2f(P[(size_t)(R - 1) * cf::PC + col]) : 0.f, n = (R + 1 < hi) ? bf2f(P[(size_t)(R + 1) * cf::PC + col]) : 0.f;
    return c + (0.5f * (p + n) - c) * mu[mucol];
}
__global__ void __launch_bounds__(256) probe(In in, uchar* ws, unsigned* res, float* scratch) {
    using namespace cf;
    __shared__ float sh[4352 + 1024];
    const int tid = threadIdx.x, bx = blockIdx.x;
    const bf16* P = (const bf16*)(ws + WS_P); const bf16* Qb = (const bf16*)(ws + WS_Q); const bf16* Kb = (const bf16*)(ws + WS_K); const bf16* Vb = (const bf16*)(ws + WS_V); const bf16* MIX = (const bf16*)(ws + WS_XM);
    const float* YR = (const float*)(ws + WS_YR); const float* YG = (const float*)(ws + WS_YG);
    if (bx < 8) {
        const int h = bx, b = 1;
        for (int which = 0; which < 4; ++which) {
            const bool isctx = which == 3; const int t = which == 0 ? 0 : which == 1 ? 1000 : which == 2 ? 4095 : 5;
            const int row = b * SEGT + (isctx ? t : CTX + t), nkeys = isctx ? CTX : SEGT;
            if (tid < 192) { float q = bf2f(Qb[(size_t)row * QP + h * 192 + tid]); sh[4352 + tid] = q; }
            __syncthreads();
            if (tid < 192 && tid >= 128 && !isctx) { const int j = tid - 128, ax = j >> 5, half = (j >> 4) & 1, f = j & 15; const float pos = ax ? (float)(t & 63) : (float)(t >> 6);
                const float ang = pos * powf(10000.f, -(float)f / 16.f), c = cosf(ang), s = sinf(ang);
                const float x1 = sh[4352 + 128 + ax * 32 + f], x2 = sh[4352 + 128 + ax * 32 + 16 + f];
                sh[4352 + 512 + j] = half ? (x1 * s + x2 * c) : (x1 * c - x2 * s); }
            __syncthreads();
            if (tid < 64 && !isctx) sh[4352 + 128 + tid] = sh[4352 + 512 + tid];
            __syncthreads();
            for (int kk = tid; kk < nkeys; kk += 256) { const int krow = b * SEGT + kk; const bool kctx = kk < CTX; const int kt = kk - CTX;
                float s = 0.f;
                for (int d = 0; d < 128; ++d) s += sh[4352 + d] * bf2f(Kb[(size_t)krow * KP + h * 192 + d]);
                for (int j = 0; j < 64; ++j) { const int ax = j >> 5, half = (j >> 4) & 1, f = j & 15;
                    float kv;
                    if (kctx) kv = bf2f(P[(size_t)krow * PC + C_KR + j]);
                    else { const float pos = ax ? (float)(kt & 63) : (float)(kt >> 6), ang = pos * powf(10000.f, -(float)f / 16.f), c = cosf(ang), sn = sinf(ang);
                        const float x1 = bf2f(P[(size_t)krow * PC + C_KR + ax * 32 + f]), x2 = bf2f(P[(size_t)krow * PC + C_KR + ax * 32 + 16 + f]);
                        kv = half ? (x1 * sn + x2 * c) : (x1 * c - x2 * sn); }
                    s += sh[4352 + 128 + j] * kv; }
                sh[kk] = s * 0.07216878364870322f; }
            __syncthreads();
            float mx = -1e30f; for (int kk = 0; kk < nkeys; ++kk) mx = fmaxf(mx, sh[kk]);
            float den = 0.f; for (int kk = 0; kk < nkeys; ++kk) den += __expf(sh[kk] - mx);
            if (tid < 128) { float o = 0.f; for (int kk = 0; kk < nkeys; ++kk) o += __expf(sh[kk] - mx) * bf2f(Vb[(size_t)(b * SEGT + kk) * VP + h * 128 + tid]);
                o /= den; const float got = bf2f(MIX[(size_t)row * D + h * 128 + tid]); fatomic_max(res + 0, got - o); fatomic_max(res + 16, o); }
            __syncthreads();
        }
    } else if (bx < 10) {
        if (tid >= 64) return;
        const int b = 1, h = 3, dir = bx - 8, lane = tid, hc = h * 64 + lane;
        const float* mu = in.p[11]; float S[64]; float cumw = 1.f;
        const uchar* task = ws + WS_RWT + (size_t)((((b * 8 + h) * 2 + dir) * NCH) + 0) * RW_TASK;
#pragma unroll
        for (int k = 0; k < 64; ++k) S[k] = 0.f;
        for (int step = 0; step < SEGT; ++step) {
            const int R = row_of(b, dir, step >> 6, step & 63), s = R % SEGT, lo = b * SEGT + (s < CTX ? 0 : CTX), hi = b * SEGT + (s < CTX ? CTX : SEGT);
            const float r = pshift(P, R, lo, hi, C_RW + hc, mu, hc), k = pshift(P, R, lo, hi, C_RW + 512 + hc, mu, 512 + hc), v = pshift(P, R, lo, hi, C_RW + 1024 + hc, mu, 1024 + hc);
            if (lane < 32) { sh[lane] = tanhf(pshift(P, R, lo, hi, C_RW + RW_WD + dir * 32 + lane, mu, RW_WD + dir * 32 + lane)); sh[32 + lane] = pshift(P, R, lo, hi, C_RW + RW_AD + dir * 32 + lane, mu, RW_AD + dir * 32 + lane); }
            __builtin_amdgcn_s_waitcnt(0); __builtin_amdgcn_wave_barrier();
            float lw = in.p[12][dir * 512 + hc], la = in.p[14][dir * 512 + hc];
            for (int rr = 0; rr < 32; ++rr) { lw += sh[rr] * in.p[13][((size_t)dir * 32 + rr) * 512 + hc]; la += sh[32 + rr] * in.p[15][((size_t)dir * 32 + rr) * 512 + hc]; }
            const float wlog = -log1pf(expf(-lw)) - 0.5f, w = expf(-expf(wlog)), alr = 1.f / (1.f + expf(-la));
            float kk = k * in.p[17][hc]; sh[400 + lane] = kk * kk; __builtin_amdgcn_s_waitcnt(0); __builtin_amdgcn_wave_barrier(); float nn = 0.f; for (int jj = 0; jj < 64; ++jj) nn += sh[400 + jj]; kk *= rsqrtf(nn + 1e-12f);
            const float kd = k * (1.f + (alr - 1.f) * in.p[18][hc]), a = -kk, bb = kk * alr;
            if (dir == 0 && step < 64) { cumw *= w;
#ifdef S1DBG
                const float qt = (S1DBG == 1) ? alr : kk,
#else
                const float qt = r * cumw,
#endif
                got = bf2f(((const bf16*)(task + 8192))[step * 64 + lane]); fatomic_max(res + 9, got - qt); fatomic_max(res + 25, qt);
                scratch[(size_t)8 * SEGT * 64 + step * 64 + lane] = bb; scratch[(size_t)8 * SEGT * 64 + 4096 + step * 64 + lane] = cumw;
                if (step == 63) { const float gl = ((const float*)(task + 57344))[lane]; fatomic_max(res + 8, gl - cumw); fatomic_max(res + 24, cumw);
                    for (int t2 = 0; t2 < 64; ++t2) { const float bh = scratch[(size_t)8 * SEGT * 64 + t2 * 64 + lane] * cumw / scratch[(size_t)8 * SEGT * 64 + 4096 + t2 * 64 + lane], gb = bf2f(((const bf16*)(task + 24576))[lane * 64 + t2]); fatomic_max(res + 10, gb - bh); fatomic_max(res + 26, bh); } } }
            sh[64 + lane] = a; sh[128 + lane] = bb; sh[192 + lane] = kd; sh[256 + lane] = w; sh[320 + lane] = r;
            __builtin_amdgcn_s_waitcnt(0); __builtin_amdgcn_wave_barrier();
            float sa = 0.f;
#pragma unroll
            for (int kx = 0; kx < 64; ++kx) sa += S[kx] * sh[64 + kx];
            float y = 0.f;
#pragma unroll
            for (int kx = 0; kx < 64; ++kx) { S[kx] = S[kx] * sh[256 + kx] + sa * sh[128 + kx] + v * sh[192 + kx]; y += S[kx] * sh[320 + kx]; }
            scratch[((size_t)dir * SEGT + (R - b * SEGT)) * 64 + lane] = y;
            __builtin_amdgcn_s_waitcnt(0); __builtin_amdgcn_wave_barrier();
        }
    } else if (bx < 12) {
        const int b = 2, h = 1, dir = bx - 10, c = tid & 127;
        float S[128];
#pragma unroll
        for (int k = 0; k < 128; ++k) S[k] = 0.f;
        const float A = expf(in.p[23][dir * 4 + h]), dtb = in.p[24][dir * 4 + h];
        for (int step = 0; step < SEGT; ++step) {
            const int R = row_of(b, dir, step >> 6, step & 63), s = R % SEGT, lo = b * SEGT + (s < CTX ? 0 : CTX), hi = b * SEGT + (s < CTX ? CTX : SEGT);
            float x[3];
            for (int w = 0; w < 3; ++w) { float acc = 0.f; const int col = w * 512 + h * 128 + c;
                for (int j = 0; j < 5; ++j) { const int Rj = R + j - 2; if (Rj >= lo && Rj < hi) acc += in.p[22][(size_t)j * 1536 + col] * bf2f(P[(size_t)Rj * PC + C_GD + col]); }
                x[w] = acc / (1.f + expf(-acc)); }
            if (tid < 128) { sh[tid] = x[0] * x[0]; sh[128 + tid] = x[1] * x[1]; }
            __syncthreads();
            float sq = 0.f, sk = 0.f; for (int j = 0; j < 128; ++j) { sq += sh[j]; sk += sh[128 + j]; }
            __syncthreads();
            const float q = x[0] * rsqrtf(sq + 1e-12f) * 0.08838834764831845f, k = x[1] * rsqrtf(sk + 1e-12f), v = x[2];
            const float a_raw = bf2f(P[(size_t)R * PC + C_GD + GD_A + dir * 4 + h]), b_raw = bf2f(P[(size_t)R * PC + C_GD + GD_B + dir * 4 + h]);
            const float z = a_raw + dtb, g = -A * (z > 20.f ? z : log1pf(expf(z))), eg = expf(g), beta = 1.f / (1.f + expf(-b_raw));
            if (tid < 128) { sh[256 + tid] = k; sh[384 + tid] = q; }
            __syncthreads();
            if (tid < 128) { float ks = 0.f;
#pragma unroll
                for (int kx = 0; kx < 128; ++kx) ks += sh[256 + kx] * S[kx];
                float o = 0.f;
#pragma unroll
                for (int kx = 0; kx < 128; ++kx) { S[kx] = eg * (S[kx] - beta * sh[256 + kx] * ks) + beta * sh[256 + kx] * v; o += sh[384 + kx] * S[kx]; }
                scratch[(size_t)2 * SEGT * 64 + ((size_t)dir * SEGT + (R - b * SEGT)) * 128 + c] = o; }
            __syncthreads();
        }
    }
}
__global__ void probe_cmp(uchar* ws, unsigned* res, const float* scratch) {
    using namespace cf;
    const float* YR = (const float*)(ws + WS_YR); const float* YG = (const float*)(ws + WS_YG);
    for (int i = blockIdx.x * blockDim.x + threadIdx.x; i < SEGT * 64; i += gridDim.x * blockDim.x) { const int s = i >> 6, v = i & 63, b = 1, h = 3; const size_t row = (size_t)b * SEGT + s;
        const float r0 = scratch[(size_t)s * 64 + v], r1 = scratch[((size_t)SEGT + s) * 64 + v], g0 = YR[row * 512 + h * 64 + v], g1 = YR[((size_t)M + row) * 512 + h * 64 + v];
        fatomic_max(res + 1, (g0 + g1) - (r0 + r1)); fatomic_max(res + 17, r0 + r1);
        fatomic_max(res + 3, g0 - r0); fatomic_max(res + 19, r0);
        fatomic_max(res + 4, g1 - r1); fatomic_max(res + 20, r1);
        if (s < 64) { fatomic_max(res + 5, g0 - r0); fatomic_max(res + 21, r0); }
        if (s >= 64 && s < 128) { fatomic_max(res + 6, g0 - r0); fatomic_max(res + 22, r0); }
        if (s >= 256 && s < 320) { fatomic_max(res + 7, g0 - r0); fatomic_max(res + 23, r0); }
    }
    for (int i = blockIdx.x * blockDim.x + threadIdx.x; i < SEGT * 128; i += gridDim.x * blockDim.x) { const int s = i >> 7, v = i & 127, b = 2, h = 1; const size_t row = (size_t)b * SEGT + s;
        const float* sg = scratch + (size_t)2 * SEGT * 64;
        const float ref = sg[(size_t)s * 128 + v] + sg[((size_t)SEGT + s) * 128 + v], got = YG[row * 512 + h * 128 + v] + YG[((size_t)M + row) * 512 + h * 128 + v];
        fatomic_max(res + 2, got - ref); fatomic_max(res + 18, ref); }
}
__global__ void probe_out(float* out, const unsigned* res, int selA, int selB) {
    if (blockIdx.x == 0 && threadIdx.x == 0) {
        out[0] = 1.0e5f * __builtin_bit_cast(float, res[selA]) / __builtin_bit_cast(float, res[16 + selA]);
        out[1] = 1.0e5f * __builtin_bit_cast(float, res[selB]) / __builtin_bit_cast(float, res[16 + selB]); }
}
#endif
constexpr int NWAVES = 8, NPH = 3 + 9 * cf::DEPTH;
struct Args { In in; float* out; uchar* ws; int g_lo, g_hi; };
static_assert(sizeof(Args) == 34 * 8 + 8 + 8 + 8, "Args has no padding");

__global__ void __launch_bounds__(NWAVES * 64, 2) fwd(Args args) {
    using namespace cf;
    extern __shared__ __attribute__((aligned(16))) unsigned char lds_raw[];
    LAS uchar* lds = (LAS uchar*)lds_raw;
    const int bx = blockIdx.x, G = gridDim.x, wv = __builtin_amdgcn_readfirstlane(threadIdx.x >> 6);
    auto lane_now = [&]() { unsigned ones = ~0u; asm volatile("" : "+s"(ones)); return (int)__builtin_amdgcn_mbcnt_hi(ones, __builtin_amdgcn_mbcnt_lo(ones, 0u)); };
#define TID() (wv * 64 + lane_now())
    const In& in = args.in;
    volatile LAS unsigned* MISC = (volatile LAS unsigned*)(lds + MISC_OFF);
    { const int tid = threadIdx.x; if (tid < 32) MISC[tid] = 0u; }
    __syncthreads();
    const int g_lo = args.g_lo, g_hi = args.g_hi;
    unsigned* barw = (unsigned*)(args.ws + WS_CTL) + CW_BAR;
    if (g_hi - g_lo > 1) (void)xcd_barrier_post(barw, MISC + 8);
#ifndef PH_MASK
#define PH_MASK 0xfff
#endif
#define PHK(g) ((g) < 3 ? (g) : 3 + ((g) - 3) % 9)
#ifndef DUP_PHASE
#define DUP_PHASE -1
#endif
#define NREP(k) ((DUP_PHASE == (k)) ? 2 : 1)
#define OPQ(v) asm volatile("" : "+v"(v))
#define IN(g) (((PH_MASK >> PHK(g)) & 1) && args.g_lo <= (g) && (g) < args.g_hi)
#ifdef TIMING
#define STAMP(i) do { if (blockIdx.x == 0 && TID() == 0) ((unsigned long long*)(args.ws + 16384))[i] = __builtin_amdgcn_s_memrealtime(); } while (0)
#else
#define STAMP(i) do {} while (0)
#endif
#define SEAM(g) do { if (args.g_lo <= (g) && (g) + 1 < args.g_hi) { XcdBarrier bar_; bar_.bar = (unsigned*)(args.ws + WS_CTL) + CW_BAR; bar_.x = xb_xcc_id(); bar_.st = (volatile LAS unsigned*)(lds + MISC_OFF) + 8; xcd_barrier(bar_); } STAMP((g) + 1); } while (0)

#define OPQS(v) asm volatile("" : "+s"(v))
#define LOCALS int l = lq; OPQS(l); size_t zq_ = 0; OPQS(zq_); uchar* ws = args.ws + zq_; float* X = (float*)(ws + WS_X); bf16* XM = (bf16*)(ws + WS_XM); bf16* P = (bf16*)(ws + WS_P); \
    bf16* CQN = (bf16*)(ws + WS_CQN); bf16* CKVN = (bf16*)(ws + WS_CKVN); bf16* Qb = (bf16*)(ws + WS_Q); bf16* Kb = (bf16*)(ws + WS_K); bf16* Vb = (bf16*)(ws + WS_V); \
    bf16* HFF = (bf16*)(ws + WS_HFF); float* YR = (float*)(ws + WS_YR); float* YG = (float*)(ws + WS_YG); float* GATE = (float*)(ws + WS_GATE); float* BONUS = (float*)(ws + WS_BONUS); \
    const float* MODV = (const float*)(ws + WS_MODV); const float* ROPE = (const float*)(ws + WS_ROPE); const float* modl = MODV + (size_t)l * 5 * MODS; \
    (void)X; (void)XM; (void)P; (void)CQN; (void)CKVN; (void)Qb; (void)Kb; (void)Vb; (void)HFF; (void)YR; (void)YG; (void)GATE; (void)BONUS; (void)ROPE; (void)modl; int t_ = TID(); OPQ(t_);

    STAMP(0);
    if (IN(0)) { const int lq = 0; LOCALS; phase_prologue(in, ws, lds, G, bx, t_); }
#ifdef DUP_PRO
    { XcdBarrier bar_; bar_.bar = (unsigned*)(args.ws + WS_CTL) + CW_BAR; bar_.x = xb_xcc_id(); bar_.st = (volatile LAS unsigned*)(lds + MISC_OFF) + 8; xcd_barrier(bar_); }
    if (IN(0)) { const int lq = 0; LOCALS; phase_prologue(in, ws, lds, G, bx, t_); }
#endif
    SEAM(0);
#ifdef DUP_BAR
    for (int nb_ = 0; nb_ < DUP_BAR; ++nb_) { XcdBarrier bar_; bar_.bar = (unsigned*)(args.ws + WS_CTL) + CW_BAR; bar_.x = xb_xcc_id(); bar_.st = (volatile LAS unsigned*)(lds + MISC_OFF) + 8; xcd_barrier(bar_); }
#endif
    if (IN(1)) { const int lq = 0; LOCALS; phase_modreduce(in, ws, G, bx, t_); }
    SEAM(1);
    if (IN(2)) { const int lq = 0; LOCALS; phase_modulate(X, XM, MODV, 0, D, G, bx, t_); }
    SEAM(2);

#pragma unroll 1
    for (int lq = 0; lq < DEPTH; ++lq) {
        const int g0 = 3 + 9 * lq;
        if (IN(g0 + 0)) for (int rep_ = 0; rep_ < NREP(0); ++rep_) { if (rep_) { XcdBarrier bar_; bar_.bar = (unsigned*)(args.ws + WS_CTL) + CW_BAR; bar_.x = xb_xcc_id(); bar_.st = (volatile LAS unsigned*)(lds + MISC_OFF) + 8; xcd_barrier(bar_); } LOCALS;
            pg8::Gemm g{XM, (const bf16*)(ws + WS_WIN) + (size_t)l * PC * D, M, PC, D, D}; pg8::StaticOrder S; S.init(M, PC, G, bx);
            pg8::EpiStore E{P, PC};
            pg8::gemm_phase<pg8::EpiStore, pg8::StaticOrder, true, true>(lds, g, S, E, t_);
        }
        SEAM(g0 + 0);
        if (IN(g0 + 1)) for (int rep_ = 0; rep_ < NREP(1); ++rep_) { if (rep_) { XcdBarrier bar_; bar_.bar = (unsigned*)(args.ws + WS_CTL) + CW_BAR; bar_.x = xb_xcc_id(); bar_.st = (volatile LAS unsigned*)(lds + MISC_OFF) + 8; xcd_barrier(bar_); } LOCALS;
#ifndef NO_MLAPREP
            mla_prep_rows(P, CQN, CKVN, Kb, in.p[7] + l * 512, in.p[8] + l * 512, ROPE, G, bx, t_);
#endif
            ScanW sw; sw.mu = in.p[11] + l * RW_COLS; sw.w0 = in.p[12] + l * 1024; sw.a0 = in.p[14] + l * 1024; sw.k_k = in.p[17] + l * 512; sw.k_a = in.p[18] + l * 512; sw.r_k = in.p[19] + l * 512;
            sw.W2T = (const bf16*)(ws + WS_W2T) + (size_t)l * 2 * 512 * 32; sw.A2T = (const bf16*)(ws + WS_A2T) + (size_t)l * 2 * 512 * 32; sw.G2T = (const bf16*)(ws + WS_G2T) + (size_t)l * 512 * 96;
            sw.conv = in.p[22] + l * 5 * 1536; sw.a_log = in.p[23] + l * 8; sw.dt_bias = in.p[24] + l * 8;
            {
                const int combo = bx & 15, h = combo >> 1, dir = combo & 1, nbl = (G >> 4) > 0 ? (G >> 4) : 1;
                int j = bx >> 4; unsigned chk = 0u;
                { int tw = TID(); OPQ(tw); rw_stage_weights(lds, sw, h, dir, tw); }

#pragma unroll 1
                for (; j < 272; j += nbl) { int tt = TID(); OPQ(tt);
#ifndef NO_S1R
                    const int jr = 271 - j;
                    const int b = jr / NCH, ci = jr % NCH, jn = (j + nbl < 272) ? j + nbl : j, tk = ((b * 8 + h) * 2 + dir) * NCH + ci;
                    s1_rwkv(lds, P, sw, ws + WS_RWT + (size_t)tk * RW_TASK, GATE, BONUS + (size_t)dir * M * 8, b, h, dir, ci, tt, chk, (271 - jn) / NCH, (271 - jn) % NCH);
#ifdef DUP_S1R
                    OPQ(tt); s1_rwkv(lds, P, sw, ws + WS_RWT + (size_t)tk * RW_TASK, GATE, BONUS + (size_t)dir * M * 8, b, h, dir, ci, tt, chk, (271 - jn) / NCH, (271 - jn) % NCH);
#endif
#endif
                }
                if (chk == 0x9e3779b9u) ((unsigned*)(ws + WS_CTL))[32] = chk;
            }
            {
                const int combo = bx & 7, h = combo >> 1, dir = combo & 1, nbl = (G >> 3) > 0 ? (G >> 3) : 1;
                __syncthreads();
                { int tw = TID(); OPQ(tw); gd_stage_weights(lds, sw, h, tw); }
#pragma unroll 1
                for (int j = bx >> 3; j < 272; j += nbl) { int tt = TID(); OPQ(tt);
#ifndef NO_S1G
                    const int jr = 271 - j, b = jr / NCH, ci = jr % NCH, tg = ((b * 4 + h) * 2 + dir) * NCH + ci;
                    s1_gdn(lds, P, sw, ws + WS_GDT + (size_t)tg * GD_TASK, b, h, dir, ci, tt);
#ifdef DUP_S1G
                    OPQ(tt); s1_gdn(lds, P, sw, ws + WS_GDT + (size_t)tg * GD_TASK, b, h, dir, ci, tt);
#endif
#endif
                }
            }
        }
        SEAM(g0 + 1);
        if (IN(g0 + 2)) for (int rep_ = 0; rep_ < NREP(2); ++rep_) { if (rep_) { XcdBarrier bar_; bar_.bar = (unsigned*)(args.ws + WS_CTL) + CW_BAR; bar_.x = xb_xcc_id(); bar_.st = (volatile LAS unsigned*)(lds + MISC_OFF) + 8; xcd_barrier(bar_); } LOCALS;
            const bool split = G >= 256;
#pragma unroll 1
#ifdef DUP_S2
            for (int rs_ = 0; rs_ < 2; ++rs_)
#endif
            for (int s = bx; s < 128; s += (split ? 1 << 20 : G)) {
#ifndef NO_S2R
                if (s < 64) { const int b = s >> 4, h = (s >> 1) & 7, dir = s & 1;
                    s2n_scan<64, true>(lds, ws + WS_RWT + (size_t)(((b * 8 + h) * 2 + dir) * NCH) * RW_TASK, RW_TASK, 0, 8192, 16384, 24576, 32768, 2, 0,
                                      YR + (size_t)dir * M * 512, h * 64, b, dir, t_); }
#endif
#ifndef NO_S2G
                if (s >= 64) { const int g = s - 64, vs = g & 1, dir = (g >> 1) & 1, h = (g >> 2) & 3, b = g >> 4;
                    s2n_scan<128, false>(lds, ws + WS_GDT + (size_t)(((b * 4 + h) * 2 + dir) * NCH) * GD_TASK, GD_TASK, 0, 32768, 49152, 81920, 98304, 4, vs,
                                        YG + (size_t)dir * M * 512, h * 128 + vs * 64, b, dir, t_); }
#endif
                __syncthreads();
            }
            OPQ(t_);
#ifndef NO_UPGEMM
            if (!split || bx >= 128) { const int Gg = split ? G - 128 : G, cg = split ? bx - 128 : bx;
#ifdef DUP_UPG
                for (int rg_ = 0; rg_ < 2; ++rg_) {
#endif
                { pg8::Gemm g{CQN, (const bf16*)(ws + WS_WUQ) + (size_t)l * 1536 * 512, M, 1536, 512, 512}; pg8::StaticOrder S; S.init(M, 1536, Gg, cg);
                  pg8::EpiStore E{Qb, QP}; pg8::gemm_phase<pg8::EpiStore, pg8::StaticOrder, true, true>(lds, g, S, E, t_); }
                __syncthreads(); OPQ(t_);
                { pg8::Gemm g{CKVN, (const bf16*)(ws + WS_WUKV) + (size_t)l * 2048 * 512, M, 2048, 512, 512}; pg8::StaticOrder S; S.init(M, 2048, Gg, cg);
                  pg8::EpiKV E{Kb, Vb}; pg8::gemm_phase<pg8::EpiKV, pg8::StaticOrder, true, true>(lds, g, S, E, t_); }
#ifdef DUP_UPG
                __syncthreads(); OPQ(t_); }
#endif
            }
#endif
        }
        SEAM(g0 + 2);
        if (IN(g0 + 3)) for (int rep_ = 0; rep_ < NREP(3); ++rep_) { if (rep_) { XcdBarrier bar_; bar_.bar = (unsigned*)(args.ws + WS_CTL) + CW_BAR; bar_.x = xb_xcc_id(); bar_.st = (volatile LAS unsigned*)(lds + MISC_OFF) + 8; xcd_barrier(bar_); } LOCALS;
#ifndef NO_MIXROWS
            mix_rows(P, YR, YG, GATE, BONUS, XM, in.p[11] + l * RW_COLS, in.p[20] + l * 512, in.p[21] + l * 512, in.p[25] + l * 128, G, bx, t_);
#endif
#ifndef NO_ATTN
            const int nunits = 512 + (l < DEPTH - 1 ? 32 : 0);
#pragma unroll 1
            for (int u = bx; u < nunits; u += G) { int tt = TID(); OPQ(tt);
                if (u < 512) { const int x = u & 7, j = u >> 3, bh = x + 8 * (j >> 4), qb = j & 15, b = bh >> 3, h = bh & 7;
                    const size_t qrow = (size_t)b * SEGT + CTX + qb * 256, krow = (size_t)b * SEGT;
                    at::attn_unit(Qb + qrow * QP + h * 192, Kb + krow * KP + h * 192, Vb + krow * VP + h * 128, XM + qrow * D + h * 128, SEGT, ROPE, qb * 256, (LAS char*)lds, tt); }
                else { const int bh = u - 512, b = bh >> 3, h = bh & 7; const size_t qrow = (size_t)b * SEGT;
                    at::attn_unit(Qb + qrow * QP + h * 192, Kb + qrow * KP + h * 192, Vb + qrow * VP + h * 128, XM + qrow * D + h * 128, CTX, nullptr, 0, (LAS char*)lds, tt); }
            }
#endif
        }
        SEAM(g0 + 3);
        if (IN(g0 + 4)) for (int rep_ = 0; rep_ < NREP(4); ++rep_) { if (rep_) { XcdBarrier bar_; bar_.bar = (unsigned*)(args.ws + WS_CTL) + CW_BAR; bar_.x = xb_xcc_id(); bar_.st = (volatile LAS unsigned*)(lds + MISC_OFF) + 8; xcd_barrier(bar_); } LOCALS;
            { pg8::Gemm g{XM, (const bf16*)(ws + WS_WOUT) + (size_t)l * D * D, M, D, D, D}; pg8::LatOrder S; S.init(D, G, bx);
              float alpha_ = ALPHA; OPQ(alpha_); pg8::EpiRes E{X, modl + 2 * D, MODS, alpha_};
              pg8::gemm_phase<pg8::EpiRes, pg8::LatOrder, true, true>(lds, g, S, E, t_);
#ifdef DUP_E
              __syncthreads(); OPQ(t_); { pg8::EpiStore E2{(bf16*)(ws + WS_HFF), D}; pg8::gemm_phase<pg8::EpiStore, pg8::LatOrder, true, true>(lds, g, S, E2, t_); }
#endif
            }
            if (l < DEPTH - 1) { __syncthreads(); OPQ(t_);
              pg8::Gemm g{XM, (const bf16*)(ws + WS_WOUT) + (size_t)l * D * D, M, D, D / 8, D}; pg8::CtxSplitOrder S; S.init(D, 8, D / 8, G, bx);
              pg8::EpiPart E{(float*)(ws + WS_PART)};
              pg8::gemm_phase<pg8::EpiPart, pg8::CtxSplitOrder, true, true>(lds, g, S, E, t_); }
        }
        SEAM(g0 + 4);
        if (IN(g0 + 5)) for (int rep_ = 0; rep_ < NREP(5); ++rep_) { if (rep_) { XcdBarrier bar_; bar_.bar = (unsigned*)(args.ws + WS_CTL) + CW_BAR; bar_.x = xb_xcc_id(); bar_.st = (volatile LAS unsigned*)(lds + MISC_OFF) + 8; xcd_barrier(bar_); } LOCALS; phase_ln(X, in.p[27] + l * D, in.p[28] + l * D, XM, modl, 3 * D, 4 * D, nullptr, (l < DEPTH - 1) ? (const float*)(ws + WS_PART) : nullptr, 8, modl + 4 * MODS + 2 * D, l == DEPTH - 1, G, bx, t_);
#ifdef DUP_LN
            { XcdBarrier bar_; bar_.bar = (unsigned*)(args.ws + WS_CTL) + CW_BAR; bar_.x = xb_xcc_id(); bar_.st = (volatile LAS unsigned*)(lds + MISC_OFF) + 8; xcd_barrier(bar_); }
            OPQ(t_); phase_ln(X, in.p[27] + l * D, in.p[28] + l * D, XM, modl, 3 * D, 4 * D, (float*)(ws + WS_Q), nullptr, 0, nullptr, true, G, bx, t_);
#endif
        }
        SEAM(g0 + 5);
        if (IN(g0 + 6)) for (int rep_ = 0; rep_ < NREP(6); ++rep_) { if (rep_) { XcdBarrier bar_; bar_.bar = (unsigned*)(args.ws + WS_CTL) + CW_BAR; bar_.x = xb_xcc_id(); bar_.st = (volatile LAS unsigned*)(lds + MISC_OFF) + 8; xcd_barrier(bar_); } LOCALS;
            pg8::Gemm g{XM, (const bf16*)(ws + WS_WGU) + (size_t)l * 2 * DFF * D, M, 2 * DFF, D, D}; pg8::EpiSwiGLU E{HFF, DFF};
            if (l < DEPTH - 1) { pg8::StaticOrder S; S.init(M, 2 * DFF, G, bx); pg8::gemm_phase<pg8::EpiSwiGLU, pg8::StaticOrder, true, true>(lds, g, S, E, t_); }
            else { pg8::LatOrder S; S.init(2 * DFF, G, bx); pg8::gemm_phase<pg8::EpiSwiGLU, pg8::LatOrder, true, true>(lds, g, S, E, t_); }
        }
        SEAM(g0 + 6);
        if (IN(g0 + 7)) for (int rep_ = 0; rep_ < NREP(7); ++rep_) { if (rep_) { XcdBarrier bar_; bar_.bar = (unsigned*)(args.ws + WS_CTL) + CW_BAR; bar_.x = xb_xcc_id(); bar_.st = (volatile LAS unsigned*)(lds + MISC_OFF) + 8; xcd_barrier(bar_); } LOCALS;
            { pg8::Gemm g{HFF, (const bf16*)(ws + WS_WDN) + (size_t)l * D * DFF, M, D, DFF, DFF}; pg8::LatOrder S; S.init(D, G, bx);
              float alpha_ = ALPHA; OPQ(alpha_); pg8::EpiRes E{X, modl + 5 * D, MODS, alpha_};
              pg8::gemm_phase<pg8::EpiRes, pg8::LatOrder, true, true>(lds, g, S, E, t_);
#ifdef DUP_H
              __syncthreads(); OPQ(t_); { pg8::EpiStore E2{(bf16*)(ws + WS_Q), D}; pg8::gemm_phase<pg8::EpiStore, pg8::LatOrder, true, true>(lds, g, S, E2, t_); }
#endif
            }
            if (l < DEPTH - 1) { __syncthreads(); OPQ(t_);
              pg8::Gemm g{HFF, (const bf16*)(ws + WS_WDN) + (size_t)l * D * DFF, M, D, DFF / 4, DFF}; pg8::CtxSplitOrder S; S.init(D, 4, DFF / 4, G, bx);
              pg8::EpiPart E{(float*)(ws + WS_PART)};
              pg8::gemm_phase<pg8::EpiPart, pg8::CtxSplitOrder, true, true>(lds, g, S, E, t_); }
        }
        SEAM(g0 + 7);
        if (IN(g0 + 8)) for (int rep_ = 0; rep_ < NREP(8); ++rep_) { if (rep_) { XcdBarrier bar_; bar_.bar = (unsigned*)(args.ws + WS_CTL) + CW_BAR; bar_.x = xb_xcc_id(); bar_.st = (volatile LAS unsigned*)(lds + MISC_OFF) + 8; xcd_barrier(bar_); } LOCALS;
            if (l < DEPTH - 1) phase_ln(X, in.p[32] + l * D, in.p[33] + l * D, XM, modl + 5 * MODS, 0, D, nullptr, (const float*)(ws + WS_PART), 4, modl + 4 * MODS + 5 * D, false, G, bx, t_);
            else phase_ln(X, in.p[32] + l * D, in.p[33] + l * D, XM, modl, 0, D, args.out, nullptr, 0, nullptr, true, G, bx, t_);
        }
        SEAM(g0 + 8);
    }
#ifdef TIMING
    __syncthreads();
    if (blockIdx.x == 0 && TID() == 0) { const unsigned long long* st = (const unsigned long long*)(args.ws + 16384); unsigned long long tot = 0;
        for (int g = 0; g < NPH; ++g) { const int cls = g < 3 ? 0 : 1 + (g - 3) % 9; if ((TIMING >> cls) & 1) tot += st[g + 1] - st[g]; }
        args.out[0] = (float)tot * 0.01f; }
#endif
#undef IN
#undef SEAM
}


#if defined(DBG_STOP)
__global__ void dbg_dump(float* out, const unsigned char* ws, int kind, size_t off, int pitch, size_t stride) {
    const size_t n = (size_t)cf::NB * cf::SEQ * cf::D;
    for (size_t i = (size_t)blockIdx.x * blockDim.x + threadIdx.x; i < n; i += (size_t)gridDim.x * blockDim.x) {
        const size_t rr = i / cf::D, c = i % cf::D, b = rr / cf::SEQ, t = rr % cf::SEQ, row = b * cf::SEGT + cf::CTX + t;
        float v;
        if (kind == 0) v = ((const float*)(ws + WS_X))[row * cf::D + c];
        else if (kind == 1) v = bf2f(((const bf16*)(ws + off))[row * (size_t)pitch + c]);
        else if (kind == 3) v = ((const float*)(ws + off))[(i * stride)];
        else if (kind == 4) v = ((const float*)(ws + off))[i % ((size_t)pitch * 1024)];
        else v = bf2f(((const bf16*)(ws + off))[i * stride]);
        if (!(fabsf(v) < 3.0e38f)) v = 1.0e30f;
        out[i] = v;
    }
}
#endif
#ifndef MK_MULTI
#define MK_MULTI 0
#endif
extern "C" void kernel_launch(void* const* d_in, const int* in_sizes, int n_in, void* d_out, int out_size, void* d_ws, size_t ws_size, hipStream_t stream) {
    static int grid = 0;
    if (grid == 0) {
        if (n_in != 34 || out_size != cf::NB * cf::SEQ * cf::D || ws_size < WS_END) { fprintf(stderr, "kernel_launch: shape mismatch (n_in %d out %d ws %zu)\n", n_in, out_size, ws_size); grid = -1; return; }
        int dev = 0, cus = 0;
        if (hipGetDevice(&dev) != hipSuccess || hipDeviceGetAttribute(&cus, hipDeviceAttributeMultiprocessorCount, dev) != hipSuccess) { grid = -1; return; }
        if (hipFuncSetAttribute((const void*)fwd, hipFuncAttributeMaxDynamicSharedMemorySize, LDS_BYTES) != hipSuccess) { fprintf(stderr, "kernel_launch: hipFuncSetAttribute failed\n"); grid = -1; return; }
        int per_cu = 0;
        if (hipOccupancyMaxActiveBlocksPerMultiprocessor(&per_cu, (const void*)fwd, NWAVES * 64, LDS_BYTES) != hipSuccess || per_cu < 1) fprintf(stderr, "kernel_launch: occupancy query says %d\n", per_cu);
        (void)hipGetLastError();
        grid = cus;
    }
    if (grid < 0) return;
    (void)hipMemsetAsync((char*)d_ws, 0, ZERO_BYTES, stream);
    Args a{};
    for (int i = 0; i < 34; ++i) a.in.p[i] = (const float*)d_in[i];
    a.out = (float*)d_out; a.ws = (uchar*)d_ws;
#if defined(PROBE)
    for (int g = 0; g < 7; ++g) { a.g_lo = g; a.g_hi = g + 1; hipLaunchKernelGGL(fwd, dim3(grid), dim3(NWAVES * 64), LDS_BYTES, stream, a); }
    { unsigned* res = (unsigned*)d_ws + 64; float* scratch = (float*)((char*)d_ws + WS_HFF + (400ull << 20));
      scratch = (float*)((char*)d_ws + WS_END);
      hipLaunchKernelGGL(probe, dim3(12), dim3(256), 0, stream, a.in, (uchar*)d_ws, res, scratch);
      hipLaunchKernelGGL(probe_cmp, dim3(256), dim3(256), 0, stream, (uchar*)d_ws, res, (const float*)scratch);
      for (int g = 7; g < NPH; ++g) { a.g_lo = g; a.g_hi = g + 1; hipLaunchKernelGGL(fwd, dim3(grid), dim3(NWAVES * 64), LDS_BYTES, stream, a); }
      hipLaunchKernelGGL(probe_out, dim3(1), dim3(64), 0, stream, (float*)d_out, (const unsigned*)res, PROBE_SELA, PROBE_SELB); }
#elif defined(DBG_STOP)
    for (int g = 0; g < DBG_STOP; ++g) { a.g_lo = g; a.g_hi = g + 1; hipLaunchKernelGGL(fwd, dim3(grid), dim3(NWAVES * 64), LDS_BYTES, stream, a); }
    hipLaunchKernelGGL(dbg_dump, dim3(2048), dim3(256), 0, stream, (float*)d_out, (const unsigned char*)d_ws, DBG_KIND, (size_t)DBG_OFF, DBG_PITCH, (size_t)DBG_STRIDE);
#elif MK_MULTI
    for (int g = 0; g < NPH; ++g) { a.g_lo = g; a.g_hi = g + 1; hipLaunchKernelGGL(fwd, dim3(grid), dim3(NWAVES * 64), LDS_BYTES, stream, a); }
#else
    a.g_lo = 0; a.g_hi = NPH;
    hipLaunchKernelGGL(fwd, dim3(grid), dim3(NWAVES * 64), LDS_BYTES, stream, a);
#endif
    const hipError_t le = hipPeekAtLastError();
    if (le != hipSuccess) fprintf(stderr, "kernel_launch: launch failed: %s\n", hipGetErrorName(le));
}
```

```cpp
#include <hip/hip_runtime.h>
#include <cstdio>
#include <cstdint>

#define DI __device__ __forceinline__
#define LAS __attribute__((address_space(3)))
#define GAS __attribute__((address_space(1)))
typedef unsigned short bf16;
typedef short bf16x8 __attribute__((ext_vector_type(8)));
typedef short s16x4 __attribute__((ext_vector_type(4)));
typedef float f32x4 __attribute__((ext_vector_type(4)));
typedef float f32x2 __attribute__((ext_vector_type(2)));
typedef float f32x16 __attribute__((ext_vector_type(16)));
typedef unsigned u32x4 __attribute__((ext_vector_type(4)));
typedef unsigned u32x2 __attribute__((ext_vector_type(2)));
typedef unsigned char uchar;
typedef __bf16 bf16x2_t __attribute__((ext_vector_type(2)));

namespace pg8 {
typedef unsigned short bf16_t;
#define PG8_LAS __attribute__((address_space(3)))
constexpr int BM = 256, BK = 64, HALF = 128, HTB = HALF * BK * 2  , STAGE_BYTES = 8 * HTB, NXCD = 8, WGM = 8;

__host__ __device__ __forceinline__ int lds_byte(int r, int c) { const int st = (r >> 4) * 2 + (c >> 5), rr = r & 15, cc = c & 31, ob = rr * 64 + cc * 2; return st * 1024 + (ob ^ (((ob >> 9) & 1) << 5)); }
__host__ __device__ __forceinline__ void stage_rc(int b, int& R, int& C) { const int st = b / 1024, sb = b % 1024, swz = sb ^ (((sb >> 9) & 1) << 5); R = (st >> 1) * 16 + swz / 64; C = (st & 1) * 32 + (swz % 64) / 2; }
__host__ __device__ __forceinline__ int perm32(int rho) { const int n = rho >> 4, i = rho & 15; return 8 * (i >> 2) + 4 * n + (i & 3); }

struct Unit { int pm, pn, ko, ks; };
struct Gemm { const bf16_t* A; const bf16_t* Bt; int M, N, K, ld; };

struct StaticOrder {
    int nM, nN, nwg, G, c;
    __host__ __device__ void init(int M, int N, int G_, int c_) { nM = M / BM; nN = N / BM; nwg = nM * nN; G = G_; c = c_; }
    __host__ __device__ bool next(int i, Unit& u) const {
        const long L = (long)i * G + c; if (L >= nwg) return false;
        int wgid = (int)L; { const int q = nwg / NXCD, r = nwg % NXCD, xcd = wgid % NXCD, off = wgid / NXCD; wgid = (xcd < r ? xcd * (q + 1) : r * (q + 1) + (xcd - r) * q) + off; }
        const int nig = WGM * nN, gid = wgid / nig, fm = gid * WGM, gsz = (nM - fm) < WGM ? (nM - fm) : WGM;
        u.pm = fm + ((wgid % nig) % gsz); u.pn = (wgid % nig) / gsz; u.ko = 0; u.ks = 0; return true;
    }
    __device__ __forceinline__ void a_ready(const Unit&) const {}
    __device__ __forceinline__ void done(const Unit&) const {}
};

struct LatOrder {
    StaticOrder S;
    __host__ __device__ void init(int N, int G_, int c_) { S.init(16384, N, G_, c_); }
    __host__ __device__ bool next(int i, Unit& u) const { if (!S.next(i, u)) return false; u.pm = (u.pm >> 4) * 17 + 1 + (u.pm & 15); return true; }
    __device__ __forceinline__ void a_ready(const Unit&) const {}
    __device__ __forceinline__ void done(const Unit&) const {}
};
struct CtxSplitOrder {
    int nN, KS, kbytes, G, c;
    __host__ __device__ void init(int N, int KS_, int Ksplit, int G_, int c_) { nN = N / BM; KS = KS_; kbytes = Ksplit * 2; G = G_; c = c_; }
    __host__ __device__ bool next(int i, Unit& u) const { const int j = i * G + c; if (j >= 4 * nN * KS) return false;
        const int ks = j % KS, cu = j / KS; u.pm = (cu / nN) * 17; u.pn = cu % nN; u.ks = ks; u.ko = ks * kbytes; return true; }
    __device__ __forceinline__ void a_ready(const Unit&) const {}
    __device__ __forceinline__ void done(const Unit&) const {}
};
__device__ __forceinline__ unsigned cvt_pk_bf16(float lo, float hi) { const f32x2 v = {lo, hi}; return __builtin_bit_cast(unsigned, __builtin_convertvector(v, bf16x2_t)); }
__device__ __forceinline__ u32x4 pack8(f32x4 v0, f32x4 v1) { u32x4 w; w.x = cvt_pk_bf16(v0[0], v0[1]); w.y = cvt_pk_bf16(v0[2], v0[3]); w.z = cvt_pk_bf16(v1[0], v1[1]); w.w = cvt_pk_bf16(v1[2], v1[3]); return w; }

struct EpiStore {
    static constexpr bool PERM = true, AFTER_DRAIN = false;
    bf16_t* O; int ldc;
    __device__ __forceinline__ void operator()(const f32x4 (&acc)[2][2][4][2], const Unit& u, int wr, int wc, int fr, int fq) const {
        const int row0 = u.pm * BM + wr * 64 + fr, col0 = u.pn * BM + wc * 32 + 8 * fq;
#pragma unroll
        for (int ai = 0; ai < 2; ++ai)
#pragma unroll
            for (int m = 0; m < 4; ++m) { bf16_t* rowp = O + (size_t)(row0 + ai * HALF + m * 16) * ldc + col0;
#pragma unroll
                for (int bj = 0; bj < 2; ++bj) *(u32x4*)(rowp + bj * HALF) = pack8(acc[ai][bj][m][0], acc[ai][bj][m][1]); }
    }
};
struct EpiKV {
    static constexpr bool PERM = true, AFTER_DRAIN = false;
    bf16_t* Kb; bf16_t* Vb;
    __device__ __forceinline__ void operator()(const f32x4 (&acc)[2][2][4][2], const Unit& u, int wr, int wc, int fr, int fq) const {
        const int row0 = u.pm * BM + wr * 64 + fr, c0 = wc * 32 + 8 * fq;
#pragma unroll
        for (int ai = 0; ai < 2; ++ai)
#pragma unroll
            for (int m = 0; m < 4; ++m) { const size_t row = (size_t)(row0 + ai * HALF + m * 16);
                *(u32x4*)(Kb + row * 1536 + u.pn * 192 + c0) = pack8(acc[ai][0][m][0], acc[ai][0][m][1]);
                *(u32x4*)(Vb + row * 1024 + u.pn * 128 + c0) = pack8(acc[ai][1][m][0], acc[ai][1][m][1]); }
    }
};
struct EpiSwiGLU {
    static constexpr bool PERM = true, AFTER_DRAIN = false;
    bf16_t* Hb; int ldh;
    __device__ __forceinline__ void operator()(const f32x4 (&acc)[2][2][4][2], const Unit& u, int wr, int wc, int fr, int fq) const {
        const int row0 = u.pm * BM + wr * 64 + fr, col0 = u.pn * HALF + wc * 32 + 8 * fq;
#pragma unroll
        for (int ai = 0; ai < 2; ++ai)
#pragma unroll
            for (int m = 0; m < 4; ++m) { f32x4 o[2];
#pragma unroll
                for (int n = 0; n < 2; ++n) { const f32x4 g = acc[ai][0][m][n], up = acc[ai][1][m][n];
#pragma unroll
                    for (int e = 0; e < 4; ++e) o[n][e] = g[e] * __builtin_amdgcn_rcpf(1.f + __expf(-g[e])) * up[e]; }
                *(u32x4*)(Hb + (size_t)(row0 + ai * HALF + m * 16) * ldh + col0) = pack8(o[0], o[1]); }
    }
};
struct EpiPart {
    static constexpr bool PERM = true, AFTER_DRAIN = false;
    float* part;
    __device__ __forceinline__ void operator()(const f32x4 (&acc)[2][2][4][2], const Unit& u, int wr, int wc, int fr, int fq) const {
        const int row0 = (u.pm / 17) * BM + wr * 64 + fr, col0 = u.pn * BM + wc * 32 + 8 * fq;
        float* base = part + (size_t)u.ks * 1024 * 2048;
#pragma unroll
        for (int ai = 0; ai < 2; ++ai)
#pragma unroll
            for (int m = 0; m < 4; ++m) { float* rowp = base + (size_t)(row0 + ai * HALF + m * 16) * 2048 + col0;
#pragma unroll
                for (int bj = 0; bj < 2; ++bj)
#pragma unroll
                    for (int n = 0; n < 2; ++n) *(f32x4*)(rowp + bj * HALF + 4 * n) = acc[ai][bj][m][n]; }
    }
};
struct EpiRes {
    static constexpr bool PERM = true, AFTER_DRAIN = false;
    float* X; const float* gate; int gstride; float alpha;
    __device__ __forceinline__ void operator()(const f32x4 (&acc)[2][2][4][2], const Unit& u, int wr, int wc, int fr, int fq) const {
        const int row0 = u.pm * BM + wr * 64 + fr, col0 = u.pn * BM + wc * 32 + 8 * fq;
        const int vec = (u.pm % 17 == 0) ? 4 : (u.pm / 17);
        const float* gp = gate + (size_t)vec * gstride + col0;
        f32x4 gv[2][2];
#pragma unroll
        for (int bj = 0; bj < 2; ++bj)
#pragma unroll
            for (int n = 0; n < 2; ++n) gv[bj][n] = *(const f32x4*)(gp + bj * HALF + 4 * n);
#pragma unroll
        for (int ai = 0; ai < 2; ++ai)
#pragma unroll
            for (int m = 0; m < 4; ++m) { float* rowp = X + (size_t)(row0 + ai * HALF + m * 16) * 2048 + col0;
#pragma unroll
                for (int bj = 0; bj < 2; ++bj)
#pragma unroll
                    for (int n = 0; n < 2; ++n) { f32x4* p = (f32x4*)(rowp + bj * HALF + 4 * n); const f32x4 x = *p; *p = x * alpha + gv[bj][n] * acc[ai][bj][m][n]; } }
    }
};

template <class Epi, class Sched, bool ALIGN_EPI = false, bool SP2 = false>
__device__ __forceinline__ void gemm_phase(PG8_LAS unsigned char* lds, const Gemm g, const Sched& S, const Epi& E, const int tid) {
    const int wid = __builtin_amdgcn_readfirstlane(tid >> 6), lane = tid & 63, wr = wid >> 2, wc = wid & 3, fr = lane & 15, fq = lane >> 4;
    const int K = g.ld, nt = g.K / BK;
    unsigned voffA[2], voffB[2];
#pragma unroll
    for (int i = 0; i < 2; ++i) { int R, C; stage_rc(tid * 16 + i * 8192, R, C); const int Rb = Epi::PERM ? ((R & ~31) + perm32(R & 31)) : R;
        voffA[i] = (unsigned)(R * K + C) * 2u; voffB[i] = (unsigned)(Rb * K + C) * 2u; }
    const size_t kstep = (size_t)(BK * 2);
    const size_t hstep = (size_t)HALF * K * 2;
    const size_t tstep = 2 * hstep;
    const unsigned ldsw = (unsigned)wid * 1024u;
    const int aoff = lds_byte(wr * 64 + fr, fq * 8), boff = lds_byte(wc * 32 + fr, fq * 8);
#define PG8_SA(b, h) (((b) * 2 + (h)) * HTB)
#define PG8_SB(b, h) ((4 + (b) * 2 + (h)) * HTB)
#define PG8_STAGE(bufoff, gbase, voff) do { _Pragma("unroll") for (int _i = 0; _i < 2; ++_i) \
        __builtin_amdgcn_global_load_lds((const unsigned*)((const char*)(gbase) + (voff)[_i]), (PG8_LAS unsigned*)(lds + (bufoff) + ldsw + _i * 8192), 16, 0, 0); } while (0)
#define PG8_LDA(dst, b, h) do { _Pragma("unroll") for (int m = 0; m < 4; ++m) _Pragma("unroll") for (int k = 0; k < 2; ++k) dst[m][k] = *(const PG8_LAS bf16x8*)(lds + PG8_SA(b, h) + aoff + m * 2048 + k * 1024); } while (0)
#define PG8_LDB(dst, b, h) do { _Pragma("unroll") for (int n = 0; n < 2; ++n) _Pragma("unroll") for (int k = 0; k < 2; ++k) dst[n][k] = *(const PG8_LAS bf16x8*)(lds + PG8_SB(b, h) + boff + n * 2048 + k * 1024); } while (0)
#define PG8_MMA(ai, bj, At, Bt) do { __builtin_amdgcn_s_setprio(1); _Pragma("unroll") for (int m = 0; m < 4; ++m) _Pragma("unroll") for (int n = 0; n < 2; ++n) _Pragma("unroll") for (int k = 0; k < 2; ++k) \
        acc[ai][bj][m][n] = __builtin_amdgcn_mfma_f32_16x16x32_bf16(Bt[n][k], At[m][k], acc[ai][bj][m][n], 0, 0, 0); __builtin_amdgcn_s_setprio(0); } while (0)
#define PG8_WAIT_V(n) asm volatile("s_waitcnt vmcnt(" #n ")" ::: "memory")
#define PG8_WAIT_L(n) asm volatile("s_waitcnt lgkmcnt(" #n ")" ::: "memory")
#define PG8_BAR __builtin_amdgcn_s_barrier()
#define PG8_SCHED __builtin_amdgcn_sched_barrier(0)
    Unit cur, nxt; int ui = 0;
    if (!S.next(0, cur)) return;
    f32x4 acc[2][2][4][2];
#pragma unroll
    for (int a = 0; a < 2; ++a)
#pragma unroll
        for (int b = 0; b < 2; ++b)
#pragma unroll
            for (int m = 0; m < 4; ++m)
#pragma unroll
                for (int n = 0; n < 2; ++n) acc[a][b][m][n] = (f32x4){0.f, 0.f, 0.f, 0.f};
    bf16x8 At[4][2], B0[2][2], B1[2][2];
    const char* cA = (const char*)g.A + (size_t)cur.pm * tstep + cur.ko; const char* cB = (const char*)g.Bt + (size_t)cur.pn * tstep + cur.ko;
    S.a_ready(cur);
    if constexpr (SP2) {
        PG8_STAGE(PG8_SB(0, 0), cB, voffB); PG8_STAGE(PG8_SB(0, 1), cB + hstep, voffB); PG8_STAGE(PG8_SA(0, 0), cA, voffA); PG8_STAGE(PG8_SA(0, 1), cA + hstep, voffA);
        if (wr == 1) PG8_BAR;
        PG8_WAIT_V(2); PG8_BAR;
        PG8_STAGE(PG8_SB(1, 0), cB + kstep, voffB); PG8_STAGE(PG8_SA(1, 0), cA + kstep, voffA); PG8_STAGE(PG8_SB(1, 1), cB + hstep + kstep, voffB);
        PG8_WAIT_V(6); PG8_BAR;
    } else {
        PG8_STAGE(PG8_SB(0, 0), cB, voffB); PG8_STAGE(PG8_SA(0, 0), cA, voffA); PG8_STAGE(PG8_SB(0, 1), cB + hstep, voffB); PG8_STAGE(PG8_SA(0, 1), cA + hstep, voffA);
        if (wr == 1) PG8_BAR;
        PG8_WAIT_V(4); PG8_BAR;
        PG8_STAGE(PG8_SB(1, 0), cB + kstep, voffB); PG8_STAGE(PG8_SA(1, 0), cA + kstep, voffA); PG8_STAGE(PG8_SB(1, 1), cB + hstep + kstep, voffB);
        PG8_WAIT_V(6); PG8_BAR;
    }
    for (;;) {
        const bool has_next = S.next(ui + 1, nxt);
        const char* nA = has_next ? (const char*)g.A + (size_t)nxt.pm * tstep + nxt.ko : cA; const char* nB = has_next ? (const char*)g.Bt + (size_t)nxt.pn * tstep + nxt.ko : cB;
        for (int t = 0; t < nt; t += 2) {
            const bool last = (t == nt - 2);
            const char* a1 = cA + (size_t)(t + 1) * kstep;
            const char* a2 = last ? nA : cA + (size_t)(t + 2) * kstep; const char* b2 = last ? nB : cB + (size_t)(t + 2) * kstep;
            const char* a3 = a2 + kstep; const char* b3 = b2 + kstep;
            if (last && has_next) S.a_ready(nxt);
            if constexpr (SP2) {
            PG8_LDB(B0, 0, 0); PG8_LDB(B1, 0, 1); PG8_SCHED; PG8_LDA(At, 0, 0); PG8_STAGE(PG8_SA(1, 1), a1 + hstep, voffA);
            PG8_WAIT_V(8); PG8_WAIT_L(0); PG8_BAR; PG8_MMA(0, 0, At, B0); PG8_MMA(0, 1, At, B1); PG8_BAR; PG8_SCHED;
            PG8_LDA(At, 0, 1); PG8_STAGE(PG8_SB(0, 0), b2, voffB); PG8_STAGE(PG8_SB(0, 1), b2 + hstep, voffB); PG8_STAGE(PG8_SA(0, 0), a2, voffA);
            PG8_WAIT_V(8); PG8_WAIT_L(0); PG8_BAR; PG8_MMA(1, 0, At, B0); PG8_MMA(1, 1, At, B1); PG8_BAR; PG8_SCHED;
            PG8_LDB(B0, 1, 0); PG8_LDB(B1, 1, 1); PG8_SCHED; PG8_LDA(At, 1, 0); PG8_STAGE(PG8_SA(0, 1), a2 + hstep, voffA);
            PG8_WAIT_V(8); PG8_WAIT_L(0); PG8_BAR; PG8_MMA(0, 0, At, B0); PG8_MMA(0, 1, At, B1); PG8_BAR; PG8_SCHED;
            PG8_LDA(At, 1, 1); PG8_STAGE(PG8_SB(1, 0), b3, voffB); PG8_STAGE(PG8_SB(1, 1), b3 + hstep, voffB); PG8_STAGE(PG8_SA(1, 0), a3, voffA);
            PG8_WAIT_V(8); PG8_WAIT_L(0); PG8_BAR; PG8_MMA(1, 0, At, B0); PG8_MMA(1, 1, At, B1); PG8_BAR; PG8_SCHED;
            } else {
            PG8_LDB(B0, 0, 0); PG8_SCHED; PG8_LDA(At, 0, 0); PG8_STAGE(PG8_SA(1, 1), a1 + hstep, voffA);
            PG8_WAIT_L(8); PG8_BAR; PG8_WAIT_L(0); PG8_MMA(0, 0, At, B0); PG8_BAR; PG8_SCHED;
            PG8_LDB(B1, 0, 1); PG8_STAGE(PG8_SB(0, 0), b2, voffB);
            PG8_BAR; PG8_WAIT_L(0); PG8_MMA(0, 1, At, B1); PG8_BAR;
            PG8_LDA(At, 0, 1); PG8_STAGE(PG8_SA(0, 0), a2, voffA);
            PG8_BAR; PG8_WAIT_L(0); PG8_MMA(1, 0, At, B0); PG8_BAR; PG8_SCHED;
            PG8_STAGE(PG8_SB(0, 1), b2 + hstep, voffB);
            PG8_WAIT_V(6); PG8_BAR; PG8_MMA(1, 1, At, B1); PG8_BAR;
            PG8_LDB(B0, 1, 0); PG8_SCHED; PG8_LDA(At, 1, 0); PG8_STAGE(PG8_SA(0, 1), a2 + hstep, voffA);
            PG8_WAIT_L(8); PG8_BAR; PG8_WAIT_L(0); PG8_MMA(0, 0, At, B0); PG8_BAR; PG8_SCHED;
            PG8_LDB(B1, 1, 1); PG8_STAGE(PG8_SB(1, 0), b3, voffB);
            PG8_BAR; PG8_WAIT_L(0); PG8_MMA(0, 1, At, B1); PG8_BAR;
            PG8_LDA(At, 1, 1); PG8_STAGE(PG8_SA(1, 0), a3, voffA);
            PG8_BAR; PG8_WAIT_L(0); PG8_MMA(1, 0, At, B0); PG8_BAR; PG8_SCHED;
            PG8_STAGE(PG8_SB(1, 1), b3 + hstep, voffB);
            PG8_WAIT_V(6); PG8_BAR; PG8_MMA(1, 1, At, B1); PG8_BAR;
            }
        }
        if constexpr (ALIGN_EPI) { if (wr == 0) PG8_BAR; }
        if constexpr (!Epi::AFTER_DRAIN) { E(acc, cur, wr, wc, fr, fq); S.done(cur); }
        if (!has_next) break;
#pragma unroll
        for (int a = 0; a < 2; ++a)
#pragma unroll
            for (int b = 0; b < 2; ++b)
#pragma unroll
                for (int m = 0; m < 4; ++m)
#pragma unroll
                    for (int n = 0; n < 2; ++n) acc[a][b][m][n] = (f32x4){0.f, 0.f, 0.f, 0.f};
        cur = nxt; cA = nA; cB = nB; ++ui;
        if constexpr (ALIGN_EPI) { if (wr == 1) PG8_BAR; }
    }
    PG8_WAIT_V(0);
    if constexpr (!ALIGN_EPI) { if (wr == 0) PG8_BAR; }
    PG8_BAR;
    if constexpr (Epi::AFTER_DRAIN) { E.fused(acc, cur, wr, wc, fr, fq, lds, wid, lane); S.done(cur); }
#undef PG8_SA
#undef PG8_SB
#undef PG8_STAGE
#undef PG8_LDA
#undef PG8_LDB
#undef PG8_MMA
#undef PG8_WAIT_V
#undef PG8_WAIT_L
#undef PG8_BAR
#undef PG8_SCHED
}
}
namespace cf {
constexpr int D = 2048, NB = 4, SEQ = 4096, CTX = 256, SEGT = 4352, M = 17408, DEPTH = 4;
constexpr int IN_COLS = 4912, PC = 5120;
constexpr int C_CQ = 0, C_CKV = 512, C_KR = 1024, C_RW = 1088, C_GD = 2848;
constexpr int RW_K = 512, RW_V = 1024, RW_WD = 1536, RW_AD = 1600, RW_GD = 1664, RW_COLS = 1760;
constexpr int GD_K = 512, GD_V = 1024, GD_Z = 1536, GD_A = 2048, GD_B = 2056;
constexpr int DFF = 5632, NCH = 68;
constexpr int QP = 1536, KP = 1536, VP = 1024;
constexpr int MODS = 6 * D;
constexpr float ALPHA = 1.681792830507429f;
constexpr int RW_TASK = 33024, GD_TASK = 98816;
}
constexpr size_t MiB = 1u << 20;
constexpr size_t WS_CTL = 0, WS_MODV = 1 * MiB, ZERO_BYTES = 2 * MiB;
constexpr size_t WS_ROPE = 2 * MiB, WS_W2T = 2 * MiB + 65536, WS_A2T = WS_W2T + 262144, WS_G2T = WS_A2T + 262144;
constexpr size_t WS_WIN = 4 * MiB, WS_WOUT = 84 * MiB, WS_WGU = 116 * MiB, WS_WDN = 292 * MiB, WS_WUQ = 380 * MiB, WS_WUKV = 386 * MiB;
constexpr size_t WS_X = 394 * MiB, WS_XM = 530 * MiB;
constexpr size_t WS_P = 598 * MiB, WS_CQN = 768 * MiB, WS_CKVN = 785 * MiB, WS_Q = 802 * MiB, WS_K = 853 * MiB, WS_V = 904 * MiB;
constexpr size_t WS_RWT = 938 * MiB, WS_GDT = 1076 * MiB, WS_YR = 1333 * MiB, WS_YG = 1401 * MiB, WS_GATE = 1469 * MiB, WS_BONUS = 1503 * MiB, WS_END = 1505 * MiB;
constexpr size_t WS_PART = 1076 * MiB;
constexpr size_t WS_HFF = 598 * MiB;
static_assert(WS_RWT + (size_t)4352 * cf::RW_TASK <= WS_GDT && WS_GDT + (size_t)2176 * cf::GD_TASK <= WS_YR && WS_HFF + (size_t)cf::M * cf::DFF * 2 <= WS_CKVN, "ws map");
constexpr int CW_TMO = 0, CW_BAR = 4096;
constexpr int LDS_BYTES = 163840, MISC_OFF = LDS_BYTES - 128;

DI float bflo(unsigned w) { return __builtin_bit_cast(float, w << 16); }
DI float bfhi(unsigned w) { return __builtin_bit_cast(float, w & 0xffff0000u); }
DI float bf2f(bf16 h) { return __builtin_bit_cast(float, (unsigned)h << 16); }
DI unsigned pk2(float lo, float hi) { const f32x2 v = {lo, hi}; return __builtin_bit_cast(unsigned, __builtin_convertvector(v, bf16x2_t)); }
DI bf16 f2bf(float f) { return (bf16)pk2(f, f); }
DI void unpack8(u32x4 w, float (&f)[8]) { f[0] = bflo(w.x); f[1] = bfhi(w.x); f[2] = bflo(w.y); f[3] = bfhi(w.y); f[4] = bflo(w.z); f[5] = bfhi(w.z); f[6] = bflo(w.w); f[7] = bfhi(w.w); }
DI u32x4 pack8f(const float (&f)[8]) { u32x4 w; w.x = pk2(f[0], f[1]); w.y = pk2(f[2], f[3]); w.z = pk2(f[4], f[5]); w.w = pk2(f[6], f[7]); return w; }
template <int X> DI float sx(float v) { return __builtin_bit_cast(float, __builtin_amdgcn_ds_swizzle(__builtin_bit_cast(int, v), 0x1F | (X << 10))); }
DI float lx(float v, int lane, int X) { return __builtin_bit_cast(float, __builtin_amdgcn_ds_bpermute((lane ^ X) << 2, __builtin_bit_cast(int, v))); }
DI float wave_sum(float v, int lane) {
    v += sx<1>(v); v += sx<2>(v); v += sx<4>(v); v += lx(v, lane, 8); v += lx(v, lane, 16); v += lx(v, lane, 32);
    return v;
}
DI float sigmoidf_(float x) { return __builtin_amdgcn_rcpf(1.f + __expf(-x)); }
DI float tanhf_(float x) { return 1.f - 2.f * __builtin_amdgcn_rcpf(1.f + __expf(2.f * x)); }
DI float softplusf_(float x) { const float e = __expf(x); return x > 20.f ? x : (x < -9.f ? e * (1.f - 0.5f * e) : __logf(1.f + e)); }
#define LDS_BARRIER() do { asm volatile("s_waitcnt lgkmcnt(0)" ::: "memory"); __builtin_amdgcn_s_barrier(); asm volatile("" ::: "memory"); } while (0)
#define LDS_WAIT() asm volatile("s_waitcnt lgkmcnt(0)" ::: "memory")
#define MFMA16(a, b, c) __builtin_amdgcn_mfma_f32_16x16x32_bf16((a), (b), (c), 0, 0, 0)

#define XB_TMO      128
#define XB_XCNT(j)  (256  + 64 * (j))
#define XB_XSUB(j)  (1280 + 64 * (j))
#define XB_XGEN(j)  (2304 + 64 * (j))
#define XB_TOP      3328
#define XB_TOPGEN   3392
#define XCD_BAR_WORDS 3456
#define XB_SPIN_CAP (1u << 22)
__device__ __forceinline__ unsigned xb_ld(unsigned* p)              { return __hip_atomic_load(p, __ATOMIC_RELAXED, __HIP_MEMORY_SCOPE_AGENT); }
__device__ __forceinline__ unsigned xb_add(unsigned* p, unsigned v) { return __hip_atomic_fetch_add(p, v, __ATOMIC_RELAXED, __HIP_MEMORY_SCOPE_AGENT); }
__device__ __forceinline__ unsigned xb_xcc_id() { return (unsigned)__builtin_amdgcn_s_getreg((3 << 11) | 20) & 0xFu; }
#define XB_SPIN(cond, bar) do { unsigned _sp = 0; while (cond) { __builtin_amdgcn_s_sleep(1); \
    if ((++_sp & 255u) == 0u) { if (xb_ld(&(bar)[XB_TMO])) break; if (_sp > XB_SPIN_CAP) { atomicAdd(&(bar)[XB_TMO], 1u); break; } } } } while (0)
struct XcdBarrier { unsigned* bar; unsigned x; volatile LAS unsigned* st; };
__device__ __forceinline__ XcdBarrier xcd_barrier_post(unsigned* bar, volatile LAS unsigned* st) {
    XcdBarrier b; b.bar = bar; b.x = xb_xcc_id(); b.st = st;
    if (threadIdx.x == 0) (void)xb_add(&bar[XB_XCNT(b.x)], 1u);
    return b;
}
__device__ __forceinline__ void xcd_barrier_complete(unsigned* bar, unsigned x, unsigned& nloc, unsigned& nx) {
    const unsigned G = gridDim.x * gridDim.y * gridDim.z;
    unsigned sum, cnt, mine, sp = 0u;
    for (;;) {
        sum = 0u; cnt = 0u; mine = 0u;
#pragma unroll
        for (unsigned j = 0; j < 16; ++j) { const unsigned c = xb_ld(&bar[XB_XCNT(j)]); sum += c; cnt += (c > 0u) ? 1u : 0u; mine = (j == x) ? c : mine; }
        if (sum == G) break;
        __builtin_amdgcn_s_sleep(1);
        if ((++sp & 255u) == 0u) { if (xb_ld(&bar[XB_TMO])) break; if (sp > XB_SPIN_CAP) { atomicAdd(&bar[XB_TMO], 1u); break; } }
    }
    nloc = mine > 0u ? mine : 1u; nx = cnt > 0u ? cnt : 1u;
}
__device__ __forceinline__ void xcd_barrier(const XcdBarrier& b) {
    asm volatile("s_waitcnt vmcnt(0)" ::: "memory");
    __syncthreads();
    if (threadIdx.x == 0) {
        unsigned* bar = b.bar;
        __builtin_amdgcn_s_waitcnt(0);
        unsigned nloc = b.st[0], nx = b.st[1];
        if (nloc == 0u) { xcd_barrier_complete(bar, b.x, nloc, nx); b.st[0] = nloc; b.st[1] = nx; }
        const unsigned old = xb_add(&bar[XB_XSUB(b.x)], 1u);
        const unsigned gen = old / nloc;
        if (old + 1u == (gen + 1u) * nloc) {
            __builtin_amdgcn_fence(__ATOMIC_RELEASE, "agent");
            asm volatile("s_waitcnt vmcnt(0)" ::: "memory");
            const unsigned og = xb_add(&bar[XB_TOP], 1u);
            const unsigned tg = og / nx;
            if (og + 1u == (tg + 1u) * nx) xb_add(&bar[XB_TOPGEN], 1u);
            else XB_SPIN(xb_ld(&bar[XB_TOPGEN]) == tg, bar);
            __builtin_amdgcn_fence(__ATOMIC_ACQUIRE, "agent");
            xb_add(&bar[XB_XGEN(b.x)], 1u);
            asm volatile("s_waitcnt vmcnt(0)" ::: "memory");
        } else {
            XB_SPIN(xb_ld(&bar[XB_XGEN(b.x)]) == gen, bar);
            __builtin_amdgcn_fence(__ATOMIC_ACQUIRE, "agent");
            asm volatile("s_waitcnt vmcnt(0)" ::: "memory");
        }
    }
    __syncthreads();
}

DI int row_of(int b, int dir, int ci, int i) {
    int s;
    if (dir == 0) s = ci * 64 + i;
    else s = (ci < 4) ? (3 - ci) * 64 + (63 - i) : 256 + (67 - ci) * 64 + (63 - i);
    return b * cf::SEGT + s;
}
DI void transpose_item(const float* W, int K, int N, bf16* WT, int out_row0, int k0, int n0, LAS float* scr, int lane) {
    const int n = n0 + (lane & 31); const bool ok = n < N;
#pragma unroll 8
    for (int i = 0; i < 32; ++i) { const int kk = 2 * i + (lane >> 5); scr[kk * 33 + (lane & 31)] = ok ? W[(size_t)(k0 + kk) * N + n] : 0.f; }
    LDS_WAIT();
    const int c = lane & 7;
#pragma unroll
    for (int j = 0; j < 4; ++j) { const int nn = (lane >> 3) + 8 * j; const LAS float* s = scr + (8 * c) * 33 + nn;
        u32x4 o; o.x = pk2(s[0 * 33], s[1 * 33]); o.y = pk2(s[2 * 33], s[3 * 33]); o.z = pk2(s[4 * 33], s[5 * 33]); o.w = pk2(s[6 * 33], s[7 * 33]);
        *(u32x4*)(WT + (size_t)(out_row0 + nn) * K + k0 + 8 * c) = o; }
    LDS_WAIT();
}

struct In { const float* p[34]; };

DI void phase_prologue(const In& in, uchar* ws, LAS uchar* lds, int G, int bx, int tid) {
    using namespace cf;
    const int lane = tid & 63, wid = __builtin_amdgcn_readfirstlane(tid >> 6), gw = bx * 8 + wid, NGW = G * 8;
    LAS float* scr = (LAS float*)(lds + wid * 16384);
    constexpr int I_IN = 32 * 160, I_OUT = 32 * 64, I_G = 32 * 176, I_DN = 88 * 64, I_UQ = 8 * 48, I_UKV = 8 * 64;
    constexpr int I_LAYER = I_IN + I_OUT + 2 * I_G + I_DN + I_UQ + I_UKV;
    for (int it = gw; it < DEPTH * I_LAYER; it += NGW) {
        const int l = it / I_LAYER; int r = it % I_LAYER;
        if (r < I_IN) { const int kb = r / 160, nb = r % 160; transpose_item(in.p[6] + (size_t)l * D * IN_COLS, D, IN_COLS, (bf16*)(ws + WS_WIN) + (size_t)l * PC * D, nb * 32, kb * 64, nb * 32, scr, lane); continue; } r -= I_IN;
        if (r < I_OUT) { const int kb = r / 64, nb = r % 64; transpose_item(in.p[26] + (size_t)l * D * D, D, D, (bf16*)(ws + WS_WOUT) + (size_t)l * D * D, nb * 32, kb * 64, nb * 32, scr, lane); continue; } r -= I_OUT;
        if (r < 2 * I_G) { const int up = r >= I_G; if (up) r -= I_G; const int kb = r / 176, nb = r % 176, n0 = nb * 32;
            transpose_item(in.p[up ? 30 : 29] + (size_t)l * D * DFF, D, DFF, (bf16*)(ws + WS_WGU) + (size_t)l * 2 * DFF * D, 256 * (n0 / 128) + (n0 % 128) + (up ? 128 : 0), kb * 64, n0, scr, lane); continue; } r -= 2 * I_G;
        if (r < I_DN) { const int kb = r / 64, nb = r % 64; transpose_item(in.p[31] + (size_t)l * DFF * D, DFF, D, (bf16*)(ws + WS_WDN) + (size_t)l * D * DFF, nb * 32, kb * 64, nb * 32, scr, lane); continue; } r -= I_DN;
        if (r < I_UQ) { const int kb = r / 48, nb = r % 48; transpose_item(in.p[9] + (size_t)l * 512 * 1536, 512, 1536, (bf16*)(ws + WS_WUQ) + (size_t)l * 1536 * 512, nb * 32, kb * 64, nb * 32, scr, lane); continue; } r -= I_UQ;
        { const int kb = r / 64, nb = r % 64; transpose_item(in.p[10] + (size_t)l * 512 * 2048, 512, 2048, (bf16*)(ws + WS_WUKV) + (size_t)l * 2048 * 512, nb * 32, kb * 64, nb * 32, scr, lane); }
    }
    float* X = (float*)(ws + WS_X);
    for (int r = gw; r < M; r += NGW) { const int b = r / SEGT, s = r % SEGT;
        const float* src = (s < CTX) ? in.p[2] + ((size_t)b * CTX + s) * D : in.p[0] + ((size_t)b * SEQ + (s - CTX)) * D;
        const f32x4* sp = (const f32x4*)src + lane; f32x4* dp = (f32x4*)(X + (size_t)r * D) + lane;
#pragma unroll
        for (int j = 0; j < 8; ++j) dp[64 * j] = sp[64 * j]; }
    const int gt = bx * 512 + tid, NGT = G * 512;
    float* rope = (float*)(ws + WS_ROPE);
    for (int i = gt; i < 1024; i += NGT) { const int pos = i >> 4, f = i & 15; const float inv = powf(10000.f, -(float)f / 16.f), ang = (float)pos * inv; rope[i] = cosf(ang); rope[1024 + i] = sinf(ang); }
    bf16* W2T = (bf16*)(ws + WS_W2T); bf16* A2T = (bf16*)(ws + WS_A2T); bf16* G2T = (bf16*)(ws + WS_G2T);
    for (int i = gt; i < DEPTH * 2 * 512 * 32; i += NGT) { const int r = i & 31, c = (i >> 5) & 511, ld = i >> 14;
        W2T[i] = f2bf(in.p[13][((size_t)ld * 32 + r) * 512 + c]); A2T[i] = f2bf(in.p[15][((size_t)ld * 32 + r) * 512 + c]); }
    for (int i = gt; i < DEPTH * 512 * 96; i += NGT) { const int k = i % 96, c = (i / 96) % 512, l = i / (96 * 512);
        G2T[i] = f2bf(in.p[16][((size_t)l * 96 + k) * 512 + c]); }
    LAS float* sv = scr;
    for (int it = gw; it < DEPTH * 48 * 16; it += NGW) {
        const int kp = it & 15, ng = (it >> 4) % 48, l = it / (16 * 48);
        for (int i = lane; i < 640; i += 64) { const int v = i >> 7, k = kp * 128 + (i & 127); const float x = (v < 4) ? in.p[1][v * D + k] : in.p[3][k]; sv[i] = x * sigmoidf_(x); }
        LDS_WAIT();
        const int n = ng * 256 + lane * 4;
        const float* wp = in.p[4] + ((size_t)l * D + (size_t)kp * 128) * MODS + n;
        f32x4 acc[5];
#pragma unroll
        for (int v = 0; v < 5; ++v) acc[v] = (f32x4){0.f, 0.f, 0.f, 0.f};
#pragma unroll 8
        for (int kk = 0; kk < 128; ++kk) { const f32x4 w = *(const f32x4*)(wp + (size_t)kk * MODS);
#pragma unroll
            for (int v = 0; v < 5; ++v) acc[v] += w * sv[v * 128 + kk]; }
        float* part = (float*)(ws + WS_P) + (size_t)kp * (DEPTH * 5 * MODS);
#pragma unroll
        for (int v = 0; v < 5; ++v) *(f32x4*)(part + ((size_t)l * 5 + v) * MODS + n) = acc[v];
        LDS_WAIT();
    }
}

DI void phase_modreduce(const In& in, uchar* ws, int G, int bx, int tid) {
    using namespace cf;
    float* modv = (float*)(ws + WS_MODV); const float* part = (const float*)(ws + WS_P);
    for (int i = bx * 512 + tid; i < DEPTH * 5 * MODS / 4; i += G * 512) { const int n4 = i % (MODS / 4), l = i / (5 * MODS / 4);
        f32x4 s = *(const f32x4*)(in.p[5] + (size_t)l * MODS + n4 * 4);
#pragma unroll
        for (int kp = 0; kp < 16; ++kp) s += *(const f32x4*)(part + (size_t)kp * (DEPTH * 5 * MODS) + (size_t)i * 4);
        *(f32x4*)(modv + (size_t)i * 4) = s; }
}

DI void phase_modulate(const float* X, bf16* XM, const float* modl  , int shift_off, int scale_off, int G, int bx, int tid) {
    using namespace cf;
    const int lane = tid & 63, gw = bx * 8 + __builtin_amdgcn_readfirstlane(tid >> 6), NGW = G * 8;
    for (int r = gw; r < M; r += NGW) { const int b = r / SEGT, s = r % SEGT, vec = (s < CTX) ? 4 : b;
        const f32x4* xp = (const f32x4*)(X + (size_t)r * D) + lane; const f32x4* sh = (const f32x4*)(modl + (size_t)vec * MODS + shift_off) + lane; const f32x4* sc = (const f32x4*)(modl + (size_t)vec * MODS + scale_off) + lane;
        u32x2* op = (u32x2*)(XM + (size_t)r * D) + lane;
#pragma unroll
        for (int j = 0; j < 8; ++j) { const f32x4 v = xp[64 * j] * (sc[64 * j] + 1.f) + sh[64 * j]; u32x2 o; o.x = pk2(v.x, v.y); o.y = pk2(v.z, v.w); op[64 * j] = o; } }
}

DI void ln_one_row(float* X, f32x4 (&v)[8], int r, const float* g, const float* bb, bf16* XM, const float* modl, int shift_off, int scale_off, float* out, const float* part, int nparts, const float* cgate, int lane) {
    using namespace cf;
    const int b = r / SEGT, s = r % SEGT, vec = (s < CTX) ? 4 : b;
    f32x4* xp = (f32x4*)(X + (size_t)r * D) + lane;
    float sum = 0.f;
    if (part && s < CTX) {
        const f32x4* gp4 = (const f32x4*)cgate + lane;
#pragma unroll
        for (int j = 0; j < 8; ++j) { f32x4 a = (f32x4){0.f, 0.f, 0.f, 0.f};
            for (int ks = 0; ks < nparts; ++ks) a += *((const f32x4*)(part + ((size_t)ks * 1024 + b * 256 + s) * D) + lane + 64 * j);
            v[j] = v[j] * ALPHA + gp4[64 * j] * a; } }
#pragma unroll
    for (int j = 0; j < 8; ++j) sum += (v[j].x + v[j].y) + (v[j].z + v[j].w);
    const float mean = wave_sum(sum, lane) * (1.f / D); float s2 = 0.f;
#pragma unroll
    for (int j = 0; j < 8; ++j) { v[j] = v[j] - mean; s2 += (v[j].x * v[j].x + v[j].y * v[j].y) + (v[j].z * v[j].z + v[j].w * v[j].w); }
    const float rstd = rsqrtf(wave_sum(s2, lane) * (1.f / D) + 1e-5f);
    const f32x4* gp = (const f32x4*)g + lane; const f32x4* bp = (const f32x4*)bb + lane;
#pragma unroll
    for (int j = 0; j < 8; ++j) v[j] = v[j] * rstd * gp[64 * j] + bp[64 * j];
    if (out) { f32x4* op = (f32x4*)(out + ((size_t)b * SEQ + (s - CTX)) * D) + lane;
#pragma unroll
        for (int j = 0; j < 8; ++j) op[64 * j] = v[j];
    } else {
        const f32x4* sh = (const f32x4*)(modl + (size_t)vec * MODS + shift_off) + lane; const f32x4* sc = (const f32x4*)(modl + (size_t)vec * MODS + scale_off) + lane;
        u32x2* op = (u32x2*)(XM + (size_t)r * D) + lane;
#pragma unroll
        for (int j = 0; j < 8; ++j) { xp[64 * j] = v[j]; const f32x4 m = v[j] * (sc[64 * j] + 1.f) + sh[64 * j]; u32x2 o; o.x = pk2(m.x, m.y); o.y = pk2(m.z, m.w); op[64 * j] = o; }
    }
}
DI void phase_ln(float* X, const float* g, const float* bb, bf16* XM, const float* modl, int shift_off, int scale_off, float* out, const float* part, int nparts, const float* cgate, bool skip_ctx, int G, int bx, int tid) {
    using namespace cf;
    const int lane = tid & 63, gw = bx * 8 + __builtin_amdgcn_readfirstlane(tid >> 6), NGW = G * 8;
    for (int r0 = gw; r0 < M; r0 += 2 * NGW) {
        const int r1 = r0 + NGW;
        const bool do0 = !(skip_ctx && (r0 % SEGT) < CTX), do1 = r1 < M && !(skip_ctx && (r1 % SEGT) < CTX);
        f32x4 va[8], vb[8];
        if (do0) { const f32x4* xp = (const f32x4*)(X + (size_t)r0 * D) + lane;
#pragma unroll
            for (int j = 0; j < 8; ++j) va[j] = xp[64 * j]; }
        if (do1) { const f32x4* xp = (const f32x4*)(X + (size_t)r1 * D) + lane;
#pragma unroll
            for (int j = 0; j < 8; ++j) vb[j] = xp[64 * j]; }
        if (do0) ln_one_row(X, va, r0, g, bb, XM, modl, shift_off, scale_off, out, part, nparts, cgate, lane);
        if (do1) ln_one_row(X, vb, r1, g, bb, XM, modl, shift_off, scale_off, out, part, nparts, cgate, lane);
    }
}

DI void mla_prep_rows(const bf16* P, bf16* CQN, bf16* CKVN, bf16* Kb, const float* qn, const float* kvn, const float* rope, int G, int bx, int tid) {
    using namespace cf;
    const int lane = tid & 63, gw = bx * 8 + __builtin_amdgcn_readfirstlane(tid >> 6), NGW = G * 8;
    const f32x4 gq0 = *(const f32x4*)(qn + lane * 8), gq1 = *(const f32x4*)(qn + lane * 8 + 4), gk0 = *(const f32x4*)(kvn + lane * 8), gk1 = *(const f32x4*)(kvn + lane * 8 + 4);
    const int axis = lane >> 5, half = (lane >> 4) & 1, f = lane & 15;
    for (int r0 = gw; r0 < M; r0 += 2 * NGW) {
        const int r1 = (r0 + NGW < M) ? r0 + NGW : r0;
        const bf16* pa = P + (size_t)r0 * PC; const bf16* pb = P + (size_t)r1 * PC;
        const u32x4 a0 = *(const u32x4*)(pa + lane * 8), a1 = *(const u32x4*)(pa + 512 + lane * 8), b0 = *(const u32x4*)(pb + lane * 8), b1 = *(const u32x4*)(pb + 512 + lane * 8);
        const bf16 ka = pa[C_KR + lane], kb = pb[C_KR + lane];
#pragma unroll
        for (int rr = 0; rr < 2; ++rr) { const int r = rr ? r1 : r0, s = r % SEGT;
#pragma unroll
            for (int part = 0; part < 2; ++part) {
                float x[8]; unpack8(rr ? (part ? b1 : b0) : (part ? a1 : a0), x);
                float ss = 0.f;
#pragma unroll
                for (int e = 0; e < 8; ++e) ss += x[e] * x[e];
                const float rs = rsqrtf(wave_sum(ss, lane) * (1.f / 512.f) + 1e-6f);
                const f32x4 g0 = part ? gk0 : gq0, g1 = part ? gk1 : gq1;
                float o[8];
#pragma unroll
                for (int e = 0; e < 8; ++e) o[e] = x[e] * rs * (e < 4 ? g0[e] : g1[e - 4]);
                *(u32x4*)((part ? CKVN : CQN) + (size_t)r * 512 + lane * 8) = pack8f(o);
            }
            float kr = bf2f(rr ? kb : ka);
            const float other = lx(kr, lane, 16);
            if (s >= CTX) { const int t = s - CTX, pos = axis ? (t & 63) : (t >> 6);
                const float c = rope[pos * 16 + f], sn = rope[1024 + pos * 16 + f];
                kr = half ? (other * sn + kr * c) : (kr * c - other * sn); }
            const bf16 kq = f2bf(kr);
#pragma unroll
            for (int h = 0; h < 8; ++h) Kb[(size_t)r * KP + h * 192 + 128 + lane] = kq;
        }
    }
}

DI void mix_rows(const bf16* P, const float* YR, const float* YG, const float* GATE, const float* BONUS, bf16* MIX,
                 const float* mu, const float* gn_g, const float* gn_b, const float* gdn_norm, int G, int bx, int tid) {
    using namespace cf;
    const int lane = tid & 63, gw = bx * 8 + __builtin_amdgcn_readfirstlane(tid >> 6), NGW = G * 8;
#pragma unroll 2
    for (int r = gw; r < M; r += NGW) { const int s = r % SEGT; const bf16* pr = P + (size_t)r * PC;
        const bool hasp = (s != 0) && (s != CTX), hasn = (s != CTX - 1) && (s != SEGT - 1);
        const int c0 = lane * 8;
        {
            float y[8], v[8];
            { const f32x4 a0 = *(const f32x4*)(YR + (size_t)r * 512 + c0), a1 = *(const f32x4*)(YR + (size_t)r * 512 + c0 + 4);
              const f32x4 b0 = *(const f32x4*)(YR + ((size_t)M + r) * 512 + c0), b1 = *(const f32x4*)(YR + ((size_t)M + r) * 512 + c0 + 4);
#pragma unroll
              for (int e = 0; e < 4; ++e) { y[e] = a0[e] + b0[e]; y[4 + e] = a1[e] + b1[e]; } }
            float sm = 0.f;
#pragma unroll
            for (int e = 0; e < 8; ++e) sm += y[e];
            sm += sx<1>(sm); sm += sx<2>(sm); sm += sx<4>(sm);
            const float mean = sm * (1.f / 64.f); float q = 0.f;
#pragma unroll
            for (int e = 0; e < 8; ++e) { y[e] -= mean; q += y[e] * y[e]; }
            q += sx<1>(q); q += sx<2>(q); q += sx<4>(q);
            const float rstd = rsqrtf(q * (1.f / 64.f) + 64e-5f);
            { float cur[8], prv[8], nxt[8]; const int col = C_RW + RW_V + c0;
              unpack8(*(const u32x4*)(pr + col), cur);
              if (hasp) unpack8(*(const u32x4*)(pr - PC + col), prv); else {
#pragma unroll
                  for (int e = 0; e < 8; ++e) prv[e] = 0.f; }
              if (hasn) unpack8(*(const u32x4*)(pr + PC + col), nxt); else {
#pragma unroll
                  for (int e = 0; e < 8; ++e) nxt[e] = 0.f; }
              const f32x4 m0 = *(const f32x4*)(mu + RW_V + c0), m1 = *(const f32x4*)(mu + RW_V + c0 + 4);
#pragma unroll
              for (int e = 0; e < 8; ++e) v[e] = cur[e] + (0.5f * (prv[e] + nxt[e]) - cur[e]) * (e < 4 ? m0[e] : m1[e - 4]); }
            const int h = lane >> 3;
            const float bonus = BONUS[(size_t)r * 8 + h] + BONUS[((size_t)M + r) * 8 + h];
            const f32x4 gg0 = *(const f32x4*)(gn_g + c0), gg1 = *(const f32x4*)(gn_g + c0 + 4), gb0 = *(const f32x4*)(gn_b + c0), gb1 = *(const f32x4*)(gn_b + c0 + 4);
            const f32x4 gt0 = *(const f32x4*)(GATE + (size_t)r * 512 + c0), gt1 = *(const f32x4*)(GATE + (size_t)r * 512 + c0 + 4);
            float o[8];
#pragma unroll
            for (int e = 0; e < 8; ++e) o[e] = (y[e] * rstd * (e < 4 ? gg0[e] : gg1[e - 4]) + (e < 4 ? gb0[e] : gb1[e - 4]) + bonus * v[e]) * (e < 4 ? gt0[e] : gt1[e - 4]);
            *(u32x4*)(MIX + (size_t)r * D + 1024 + c0) = pack8f(o);
        }
        {
            float y[8], z[8];
            { const f32x4 a0 = *(const f32x4*)(YG + (size_t)r * 512 + c0), a1 = *(const f32x4*)(YG + (size_t)r * 512 + c0 + 4);
              const f32x4 b0 = *(const f32x4*)(YG + ((size_t)M + r) * 512 + c0), b1 = *(const f32x4*)(YG + ((size_t)M + r) * 512 + c0 + 4);
#pragma unroll
              for (int e = 0; e < 4; ++e) { y[e] = a0[e] + b0[e]; y[4 + e] = a1[e] + b1[e]; } }
            float q = 0.f;
#pragma unroll
            for (int e = 0; e < 8; ++e) q += y[e] * y[e];
            q += sx<1>(q); q += sx<2>(q); q += sx<4>(q); q += lx(q, lane, 8);
            const float rs = rsqrtf(q * (1.f / 128.f) + 1e-6f);
            unpack8(*(const u32x4*)(pr + C_GD + GD_Z + c0), z);
            const int cn = c0 & 127; const f32x4 n0 = *(const f32x4*)(gdn_norm + cn), n1 = *(const f32x4*)(gdn_norm + cn + 4);
            float o[8];
#pragma unroll
            for (int e = 0; e < 8; ++e) o[e] = y[e] * rs * (e < 4 ? n0[e] : n1[e - 4]) * (z[e] * sigmoidf_(z[e]));
            *(u32x4*)(MIX + (size_t)r * D + 1536 + c0) = pack8f(o);
        }
    }
}
#define FRAGOFF(R, C, KS) ((((R) >> 4) * (KS) + ((C) >> 5)) * 1024 + ((((C) >> 3) & 3) * 16 + ((R) & 15)) * 16 + ((C) & 7) * 2)
#define SWZ(row, SH) ((((row) >> (SH)) & 7) << 3)
#define FRAGS(Mx, row, k, SH) (*(const LAS bf16x8*)((Mx) + (row) * 72 + (((k) * 32 + q4 * 8) ^ SWZ(row, SH))))
template <int K> DI f32x4 mm_tile(const LAS bf16* A, int lda, const LAS bf16* Bt, int ldb, int tm, int tn, f32x4 acc, int lane) {
    const int r = lane & 15, q = lane >> 4;
#pragma unroll
    for (int k0 = 0; k0 < K; k0 += 32) {
        const bf16x8 a = *(const LAS bf16x8*)(A + (16 * tm + r) * lda + k0 + q * 8);
        const bf16x8 b = *(const LAS bf16x8*)(Bt + (16 * tn + r) * ldb + k0 + q * 8);
        acc = MFMA16(a, b, acc);
    }
    return acc;
}
template <int NCL>
DI void inv_offblock(const LAS float* A, LAS float* TF, LAS bf16* TT, LAS float* scr, int i, int j, int c0, int lane) {
    const int r = lane & 15, q = lane >> 4, cb = c0 + q * NCL;
    float p[NCL];
#pragma unroll
    for (int e = 0; e < NCL; ++e) p[e] = 0.f;
    for (int kb = j; kb < i; ++kb) {
#pragma unroll
        for (int s = 0; s < 16; ++s) { const float a = A[(16 * i + r) * 65 + 16 * kb + s]; const LAS float* tp = TF + (16 * kb + s) * 65 + 16 * j + cb;
#pragma unroll
            for (int e = 0; e < NCL; ++e) p[e] += a * tp[e]; }
    }
#pragma unroll
    for (int e = 0; e < NCL; ++e) scr[r * 17 + q * NCL + e] = p[e];
    LDS_WAIT();
    float o[NCL];
#pragma unroll
    for (int e = 0; e < NCL; ++e) o[e] = 0.f;
#pragma unroll
    for (int s = 0; s < 16; ++s) { const float t = TF[(16 * i + r) * 65 + 16 * i + s];
#pragma unroll
        for (int e = 0; e < NCL; ++e) o[e] += t * scr[s * 17 + q * NCL + e]; }
#pragma unroll
    for (int e = 0; e < NCL; ++e) { TF[(16 * i + r) * 65 + 16 * j + cb + e] = o[e]; TT[(16 * i + r) * 72 + 16 * j + cb + e] = f2bf(o[e]); }
}
template <class Side>
DI void inv_blocked(const LAS float* A, LAS float* TF, LAS bf16* TT, LAS float* scr_all, int wid, int lane, int tid, const Side& side) {
    if (wid < 4) { if (lane < 16) { const int j = lane, base = 16 * wid; float tc[16];
#pragma unroll
        for (int t = 0; t < 16; ++t) { float acc = (t == j) ? 1.f : 0.f;
#pragma unroll
            for (int s = 0; s < t; ++s) acc += A[(base + t) * 65 + base + s] * tc[s];
            tc[t] = acc; }
#pragma unroll
        for (int t = 0; t < 16; ++t) { TF[(base + t) * 65 + base + j] = tc[t]; TT[(base + t) * 72 + base + j] = f2bf(tc[t]); }
    } } else side(wid - 4);
    LDS_BARRIER();
    LAS float* scr = scr_all + wid * 272;
    if (wid < 6) inv_offblock<2>(A, TF, TT, scr, (wid >> 1) + 1, wid >> 1, (wid & 1) * 8, lane);
    LDS_BARRIER();
    inv_offblock<1>(A, TF, TT, scr, (wid >> 2) + 2, wid >> 2, (wid & 3) * 4, lane);
    LDS_BARRIER();
    if (wid < 4) inv_offblock<1>(A, TF, TT, scr, 3, 0, wid * 4, lane);
    LDS_BARRIER();
}

struct ScanW {
    const float *mu, *w0, *a0, *k_k, *k_a, *r_k;
    const bf16 *W2T, *A2T, *G2T;
    const float *conv, *a_log, *dt_bias;
};

constexpr int RWB = 136192, RWB_W2 = RWB + 2688, RWB_A2 = RWB_W2 + 5120, RWB_G2 = RWB_A2 + 5120;
constexpr int GDB = 143360;
DI void rw_stage_weights(LAS uchar* lds, const ScanW& sw, int h, int dir, int tid) {
    LAS float* WF = (LAS float*)(lds + RWB);
    for (int i = tid; i < 672; i += 512) { float v;
        if (i < 64) v = sw.w0[dir * 512 + h * 64 + i]; else if (i < 128) v = sw.a0[dir * 512 + h * 64 + i - 64]; else if (i < 192) v = sw.k_k[h * 64 + i - 128];
        else if (i < 256) v = sw.k_a[h * 64 + i - 192]; else if (i < 320) v = sw.r_k[h * 64 + i - 256];
        else if (i < 512) v = sw.mu[((i - 320) >> 6) * 512 + h * 64 + ((i - 320) & 63)];
        else if (i < 544) v = sw.mu[cf::RW_WD + dir * 32 + i - 512]; else if (i < 576) v = sw.mu[cf::RW_AD + dir * 32 + i - 544]; else v = sw.mu[cf::RW_GD + i - 576];
        WF[i] = v; }
    { const int which = tid >> 8, t = tid & 255, row = t >> 2, ch = t & 3;
      *(LAS u32x4*)(lds + (which ? RWB_A2 : RWB_W2) + (row * 40 + ch * 8) * 2) = *(const u32x4*)((which ? sw.A2T : sw.W2T) + ((size_t)dir * 512 + h * 64 + row) * 32 + ch * 8); }
    LDS_BARRIER();
}
DI void gd_stage_weights(LAS uchar* lds, const ScanW& sw, int h, int tid) {
    LAS float* CW = (LAS float*)(lds + GDB);
    for (int i = tid; i < 1920; i += 512) { const int jw = i >> 7, c = i & 127; CW[i] = sw.conv[(size_t)(jw / 3) * 1536 + (jw % 3) * 512 + h * 128 + c]; }
    LDS_BARRIER();
}

struct RwRaw { u32x4 c[3]; };
DI void rw_issue(RwRaw& q, const bf16* P, int b, int h, int dir, int ci, int tid) {
    using namespace cf;
    const int i = tid >> 3, sub = tid & 7;
    const int R = row_of(b, dir, ci, i), seg_lo = b * SEGT + (ci < 4 ? 0 : CTX), seg_hi = b * SEGT + (ci < 4 ? CTX : SEGT);
    const bf16* pr = P + (size_t)R * PC + C_RW; (void)seg_lo; (void)seg_hi;
#pragma unroll
    for (int w = 0; w < 3; ++w) { const int col = w * 512 + h * 64 + sub * 8;
        q.c[w] = *(const u32x4*)(pr + col); }
}

DI void s1_rwkv(LAS uchar* lds, const bf16* P, const ScanW& sw, uchar* task, float* GATE, float* BONUSd, int b, int h, int dir, int ci, int tid, unsigned& chk, int nb, int nci) {
    RwRaw raw;
    using namespace cf;
    constexpr int MB = 9216;
    LAS bf16* AT = (LAS bf16*)(lds + 0 * MB); LAS bf16* BT = (LAS bf16*)(lds + 1 * MB); LAS bf16* KT = (LAS bf16*)(lds + 2 * MB); LAS bf16* QT = (LAS bf16*)(lds + 3 * MB);
    LAS bf16* ATT = (LAS bf16*)(lds + 4 * MB); LAS bf16* VT = (LAS bf16*)(lds + 5 * MB); LAS bf16* KHT = (LAS bf16*)(lds + 6 * MB); LAS bf16* BHT = (LAS bf16*)(lds + 7 * MB);
    LAS bf16* AAK = (LAS bf16*)(lds + 8 * MB); LAS bf16* AQK = (LAS bf16*)(lds + 9 * MB); LAS bf16* TT = (LAS bf16*)(lds + 10 * MB); LAS bf16* XT = (LAS bf16*)(lds + 11 * MB);
    LAS float* AAB = (LAS float*)(lds + 12 * MB); LAS float* GC = AAB;
    LAS float* INVS = (LAS float*)(lds + 12 * MB + 16640);
    LAS float* LWf = (LAS float*)(lds + 8 * MB); LAS float* LAf = (LAS float*)(lds + 10 * MB); LAS float* TF = (LAS float*)(lds + 0);
    LAS bf16* WTT = (LAS bf16*)(lds + 0 * MB); LAS bf16* ULT = (LAS bf16*)(lds + 1 * MB); LAS bf16* AQBL = (LAS bf16*)(lds + RWB_G2);
    const LAS float* WF = (const LAS float*)(lds + RWB);
    LAS bf16* TW = (LAS bf16*)(lds + 0); LAS bf16* AD = (LAS bf16*)(lds + 5120); LAS bf16* SG = (LAS bf16*)(lds + 10240);
    const int lane = tid & 63, wid = __builtin_amdgcn_readfirstlane(tid >> 6), i = tid >> 3, sub = tid & 7, r16 = lane & 15, q4 = lane >> 4;
    const int R = row_of(b, dir, ci, i), seg_lo = b * SEGT + (ci < 4 ? 0 : CTX), seg_hi = b * SEGT + (ci < 4 ? CTX : SEGT);
    const bool hasp = R - 1 >= seg_lo, hasn = R + 1 < seg_hi;
    const bf16* pr = P + (size_t)R * PC + C_RW;
    float rv[8], kv[8], vv[8];
#ifndef RW_PREFETCH
    rw_issue(raw, P, b, h, dir, ci, tid);
#endif
#ifdef DUP_ST01
    for (int rp_ = 0; rp_ < 2; ++rp_) {
#endif
#pragma unroll
    for (int w = 0; w < 3; ++w) { const int col = w * 512 + h * 64 + sub * 8; float cur[8], prv[8], nxt[8];
        unpack8(raw.c[w], cur);
        if (hasp) unpack8(*(const u32x4*)(pr - PC + col), prv); else {
#pragma unroll
            for (int e = 0; e < 8; ++e) prv[e] = 0.f; }
        if (hasn) unpack8(*(const u32x4*)(pr + PC + col), nxt); else {
#pragma unroll
            for (int e = 0; e < 8; ++e) nxt[e] = 0.f; }
        const f32x4 m0 = *(const LAS f32x4*)(WF + 320 + w * 64 + sub * 8), m1 = *(const LAS f32x4*)(WF + 320 + w * 64 + sub * 8 + 4);
#pragma unroll
        for (int e = 0; e < 8; ++e) { const float x = cur[e] + (0.5f * (prv[e] + nxt[e]) - cur[e]) * (e < 4 ? m0[e] : m1[e - 4]); if (w == 0) rv[e] = x; else if (w == 1) kv[e] = x; else vv[e] = x; } }
#pragma unroll
    for (int w = 0; w < 2; ++w) { const int col = (w ? RW_AD : RW_WD) + dir * 32 + sub * 4;
        const u32x2 c2 = *(const u32x2*)(pr + col); u32x2 p2 = (u32x2){0u, 0u}, n2 = (u32x2){0u, 0u};
        if (hasp) p2 = *(const u32x2*)(pr - PC + col); if (hasn) n2 = *(const u32x2*)(pr + PC + col);
        const f32x4 m = *(const LAS f32x4*)(WF + 512 + w * 32 + sub * 4);
        const float cur[4] = {bflo(c2.x), bfhi(c2.x), bflo(c2.y), bfhi(c2.y)}, prv[4] = {bflo(p2.x), bfhi(p2.x), bflo(p2.y), bfhi(p2.y)}, nxt[4] = {bflo(n2.x), bfhi(n2.x), bflo(n2.y), bfhi(n2.y)};
        float x[4];
#pragma unroll
        for (int e = 0; e < 4; ++e) { x[e] = cur[e] + (0.5f * (prv[e] + nxt[e]) - cur[e]) * m[e]; if (w == 0) x[e] = tanhf_(x[e]); }
        u32x2 o; o.x = pk2(x[0], x[1]); o.y = pk2(x[2], x[3]);
        *(LAS u32x2*)((w ? AD : TW) + i * 40 + sub * 4) = o; }
    if (dir == 0) {
#pragma unroll
        for (int j = 0; j < 3; ++j) { const int col = RW_GD + sub * 12 + j * 4;
            const u32x2 c2 = *(const u32x2*)(pr + col); u32x2 p2 = (u32x2){0u, 0u}, n2 = (u32x2){0u, 0u};
            if (hasp) p2 = *(const u32x2*)(pr - PC + col); if (hasn) n2 = *(const u32x2*)(pr + PC + col);
            const f32x4 m = *(const LAS f32x4*)(WF + 576 + sub * 12 + j * 4);
            const float cur[4] = {bflo(c2.x), bfhi(c2.x), bflo(c2.y), bfhi(c2.y)}, prv[4] = {bflo(p2.x), bfhi(p2.x), bflo(p2.y), bfhi(p2.y)}, nxt[4] = {bflo(n2.x), bfhi(n2.x), bflo(n2.y), bfhi(n2.y)};
            float x[4];
#pragma unroll
            for (int e = 0; e < 4; ++e) x[e] = sigmoidf_(cur[e] + (0.5f * (prv[e] + nxt[e]) - cur[e]) * m[e]);
            u32x2 o; o.x = pk2(x[0], x[1]); o.y = pk2(x[2], x[3]);
            *(LAS u32x2*)(SG + i * 104 + sub * 12 + j * 4) = o; }
    }
    LDS_BARRIER();
    { const int which = wid >> 2, tm = wid & 3;
      const bf16x8 a = *(const LAS bf16x8*)((which ? AD : TW) + (16 * tm + r16) * 40 + q4 * 8);
      const LAS bf16* wt = (const LAS bf16*)(lds + (which ? RWB_A2 : RWB_W2));
#pragma unroll
      for (int tn = 0; tn < 4; ++tn) { const bf16x8 bb = *(const LAS bf16x8*)(wt + (16 * tn + r16) * 40 + q4 * 8);
          const f32x4 acc = MFMA16(a, bb, ((f32x4){0.f, 0.f, 0.f, 0.f}));
#pragma unroll
          for (int e = 0; e < 4; ++e) (which ? LAf : LWf)[(16 * tm + 4 * q4 + e) * 65 + 16 * tn + r16] = acc[e]; } }
    if (dir == 0) { const int tm = wid >> 1;
#pragma unroll
        for (int j = 0; j < 2; ++j) { const int tn = (wid & 1) * 2 + j; f32x4 acc = (f32x4){0.f, 0.f, 0.f, 0.f};
#pragma unroll
            for (int k0 = 0; k0 < 96; k0 += 32) { const bf16x8 a = *(const LAS bf16x8*)(SG + (16 * tm + r16) * 104 + k0 + q4 * 8);
                const bf16x8 bb = *(const bf16x8*)(sw.G2T + (size_t)(h * 64 + 16 * tn + r16) * 96 + k0 + q4 * 8); acc = MFMA16(a, bb, acc); }
#pragma unroll
            for (int e = 0; e < 4; ++e) GATE[(size_t)row_of(b, 0, ci, 16 * tm + 4 * q4 + e) * 512 + h * 64 + 16 * tn + r16] = acc[e]; } }
    LDS_BARRIER();
#ifdef DUP_ST01
    }
#endif
    float av[8], bv[8], kd[8], lw[8];
#ifdef S1DBG
    float dbgv[8];
#endif
#ifdef DUP_ST2A
    for (int rp_ = 0; rp_ < 2; ++rp_) {
#endif
    { const int hc = h * 64 + sub * 8; float ss = 0.f, bon = 0.f, kk[8], al[8];
#pragma unroll
      for (int e = 0; e < 8; ++e) { const int c = sub * 8 + e;
          lw[e] = -0.6065306597126334f * sigmoidf_(WF[c] + LWf[i * 65 + c]);
          al[e] = sigmoidf_(WF[64 + c] + LAf[i * 65 + c]);
          kk[e] = kv[e] * WF[128 + c]; ss += kk[e] * kk[e]; }
      ss += sx<1>(ss); ss += sx<2>(ss); ss += sx<4>(ss);
      const float rn = rsqrtf(ss + 1e-12f);
#pragma unroll
      for (int e = 0; e < 8; ++e) { kk[e] *= rn; kd[e] = kv[e] * (1.f + (al[e] - 1.f) * WF[192 + sub * 8 + e]); av[e] = -kk[e]; bv[e] = kk[e] * al[e]; bon += rv[e] * kd[e] * WF[256 + sub * 8 + e];
#ifdef S1DBG
          dbgv[e] = (S1DBG == 1) ? al[e] : kk[e];
#endif
      }
      bon += sx<1>(bon); bon += sx<2>(bon); bon += sx<4>(bon);
      if (sub == 0) BONUSd[(size_t)R * 8 + h] = bon;
#pragma unroll
      for (int e = 0; e < 8; ++e) GC[i * 65 + sub * 8 + e] = lw[e]; }
    LDS_BARRIER();
#ifdef DUP_ST2A
    }
#endif
    {
        LAS float* TOT = INVS;
        float g8[8]; float run = 0.f;
#pragma unroll
        for (int j = 0; j < 8; ++j) g8[j] = GC[(wid * 8 + j) * 65 + lane];
#pragma unroll
        for (int j = 0; j < 8; ++j) { run += g8[j]; g8[j] = run; }
        TOT[wid * 64 + lane] = run;
        LDS_BARRIER();
        float off = 0.f;
#pragma unroll
        for (int sgm = 0; sgm < 7; ++sgm) { const float tv = TOT[sgm * 64 + lane]; off += (sgm < wid) ? tv : 0.f; }
#pragma unroll
        for (int j = 0; j < 8; ++j) GC[(wid * 8 + j) * 65 + lane] = g8[j] + off;
    }
    LDS_BARRIER();
#ifdef DUP_ST2C
    for (int rp_ = 0; rp_ < 2; ++rp_) {
#endif
    { float at[8], bt[8], kt[8], qt[8], bh[8], kh[8];
#pragma unroll
      for (int e = 0; e < 8; ++e) { const int c = sub * 8 + e; const float Gi = GC[i * 65 + c], Gm = (i > 0) ? GC[(i - 1) * 65 + c] : 0.f, GL = GC[63 * 65 + c];
          const float eG = __expf(Gi), eGm = __expf(Gm), enG = __expf(-Gi), eLG = __expf(GL - Gi);
          at[e] = av[e] * eGm; bt[e] = bv[e] * enG; kt[e] = kd[e] * enG; qt[e] = rv[e] * eG;
#ifdef S1DBG
          qt[e] = dbgv[e];
#endif
          bh[e] = bv[e] * eLG; kh[e] = kd[e] * eLG;
          if (i == 63) ((float*)(task + 32768))[c] = eG; }
      *(LAS u32x4*)(AT + i * 72 + sub * 8) = pack8f(at); *(LAS u32x4*)(BT + i * 72 + sub * 8) = pack8f(bt); *(LAS u32x4*)(KT + i * 72 + sub * 8) = pack8f(kt); *(LAS u32x4*)(QT + i * 72 + sub * 8) = pack8f(qt);
#pragma unroll
      for (int e = 0; e < 8; e += 2) { const int c = sub * 8 + e, is = i ^ (sub << 3);
          const unsigned pa = pk2(at[e], at[e + 1]), pv = pk2(vv[e], vv[e + 1]), pk = pk2(kh[e], kh[e + 1]), pb = pk2(bh[e], bh[e + 1]);
          ATT[c * 72 + is] = (bf16)pa; ATT[(c + 1) * 72 + is] = (bf16)(pa >> 16); VT[c * 72 + is] = (bf16)pv; VT[(c + 1) * 72 + is] = (bf16)(pv >> 16);
          KHT[c * 72 + is] = (bf16)pk; KHT[(c + 1) * 72 + is] = (bf16)(pk >> 16); BHT[c * 72 + is] = (bf16)pb; BHT[(c + 1) * 72 + is] = (bf16)(pb >> 16); } }
    LDS_BARRIER();
#ifdef DUP_ST2C
    }
#endif
#ifdef DUP_ST3
    for (int rp_ = 0; rp_ < 2; ++rp_) {
#endif
    RwRaw warm; rw_issue(warm, P, nb, h, dir, nci, tid);
    for (int z_ = tid; z_ < 64 * 72 / 8; z_ += 512) ((LAS u32x4*)TT)[z_] = (u32x4){0u, 0u, 0u, 0u};
    {
#define FRAG(Mx, row, k) (*(const LAS bf16x8*)((Mx) + (row) * 72 + (k) * 32 + q4 * 8))
      const int tm = wid >> 1;
      const bf16x8 a0 = FRAG(AT, 16 * tm + r16, 0), a1 = FRAG(AT, 16 * tm + r16, 1), q0 = FRAG(QT, 16 * tm + r16, 0), q1 = FRAG(QT, 16 * tm + r16, 1);
#pragma unroll
      for (int j = 0; j < 2; ++j) { const int tn = (wid & 1) * 2 + j; const f32x4 z = (f32x4){0.f, 0.f, 0.f, 0.f};
          f32x4 cab = z, cak = z, cqb = z, cqk = z;
          if (tm >= tn) { const bf16x8 b0 = FRAG(BT, 16 * tn + r16, 0), b1 = FRAG(BT, 16 * tn + r16, 1), k0 = FRAG(KT, 16 * tn + r16, 0), k1 = FRAG(KT, 16 * tn + r16, 1);
              cab = MFMA16(a0, b0, z); cab = MFMA16(a1, b1, cab); cak = MFMA16(a0, k0, z); cak = MFMA16(a1, k1, cak);
              cqb = MFMA16(q0, b0, z); cqb = MFMA16(q1, b1, cqb); cqk = MFMA16(q0, k0, z); cqk = MFMA16(q1, k1, cqk); }
#pragma unroll
          for (int e = 0; e < 4; ++e) { const int ti = 16 * tm + 4 * q4 + e, tj = 16 * tn + r16; const bool lo = ti > tj, le = ti >= tj;
              AAB[ti * 65 + tj] = lo ? cab[e] : 0.f; AAK[ti * 72 + tj] = f2bf(lo ? cak[e] : 0.f); AQBL[ti * 72 + tj] = f2bf(le ? cqb[e] : 0.f); AQK[ti * 72 + tj] = f2bf(le ? cqk[e] : 0.f); } }
#undef FRAG
    }
    LDS_BARRIER();
#ifdef DUP_ST3
    }
#endif
    inv_blocked(AAB, TF, TT, INVS, wid, lane, tid, [&](int sw_) {
#pragma unroll
        for (int j = 0; j < 4; ++j) { const int tm = sw_, tn = j;
            f32x4 acc = MFMA16(*(const LAS bf16x8*)(AAK + (16 * tm + r16) * 72 + q4 * 8), FRAGS(VT, 16 * tn + r16, 0, 3), ((f32x4){0.f, 0.f, 0.f, 0.f}));
            acc = MFMA16(*(const LAS bf16x8*)(AAK + (16 * tm + r16) * 72 + 32 + q4 * 8), FRAGS(VT, 16 * tn + r16, 1, 3), acc);
            u32x2 o; o.x = pk2(acc[0], acc[1]); o.y = pk2(acc[2], acc[3]); *(LAS u32x2*)(XT + (16 * tn + r16) * 72 + 16 * tm + 4 * q4) = o; } });
#ifdef DUP_ST6
    for (int rp_ = 0; rp_ < 2; ++rp_) {
#endif
    { const int mat = wid >> 2, tm = wid & 3; LAS bf16* dst = mat ? ULT : WTT; const LAS bf16* Bm = mat ? XT : ATT;
#define FRAG(Mx, row, k) (*(const LAS bf16x8*)((Mx) + (row) * 72 + (k) * 32 + q4 * 8))
      const bf16x8 t0 = FRAG(TT, 16 * tm + r16, 0), t1 = FRAG(TT, 16 * tm + r16, 1);
#pragma unroll
      for (int tn = 0; tn < 4; ++tn) { const int sz = mat ? 0 : SWZ(16 * tn + r16, 3);
          f32x4 acc = MFMA16(t0, *(const LAS bf16x8*)(Bm + (16 * tn + r16) * 72 + ((q4 * 8) ^ sz)), ((f32x4){0.f, 0.f, 0.f, 0.f})); acc = MFMA16(t1, *(const LAS bf16x8*)(Bm + (16 * tn + r16) * 72 + ((32 + q4 * 8) ^ sz)), acc);
          u32x2 o; o.x = pk2(acc[0], acc[1]); o.y = pk2(acc[2], acc[3]); *(LAS u32x2*)(dst + (16 * tn + r16) * 72 + 16 * tm + 4 * q4) = o; }
#undef FRAG
    }
    LDS_BARRIER();
    {
#define FRAG(Mx, row, k) (*(const LAS bf16x8*)((Mx) + (row) * 72 + (k) * 32 + q4 * 8))
      const int tm = wid >> 1;
      const bf16x8 w0 = FRAG(WTT, 16 * tm + r16, 0), w1 = FRAG(WTT, 16 * tm + r16, 1), h0 = FRAGS(BHT, 16 * tm + r16, 0, 3), h1 = FRAGS(BHT, 16 * tm + r16, 1, 3);
      const bf16x8 k0 = FRAGS(KHT, 16 * tm + r16, 0, 3), k1 = FRAGS(KHT, 16 * tm + r16, 1, 3), a0 = FRAG(AQBL, 16 * tm + r16, 0), a1 = FRAG(AQBL, 16 * tm + r16, 1), g0 = FRAG(AQK, 16 * tm + r16, 0), g1 = FRAG(AQK, 16 * tm + r16, 1);
#pragma unroll
      for (int j = 0; j < 2; ++j) { const int tn = (wid & 1) * 2 + j; const f32x4 z = (f32x4){0.f, 0.f, 0.f, 0.f};
          { f32x4 acc = MFMA16(w0, FRAGS(BHT, 16 * tn + r16, 0, 3), z); acc = MFMA16(w1, FRAGS(BHT, 16 * tn + r16, 1, 3), acc);
            u32x2 o; o.x = pk2(acc[0], acc[1]); o.y = pk2(acc[2], acc[3]); *(u32x2*)(task + 0 + FRAGOFF(16 * tn + r16, 16 * tm + 4 * q4, 2)) = o; }
          { f32x4 acc = MFMA16(w0, FRAG(AQBL, 16 * tn + r16, 0), z); acc = MFMA16(w1, FRAG(AQBL, 16 * tn + r16, 1), acc);
            const u32x2 qq = *(const LAS u32x2*)(QT + (16 * tn + r16) * 72 + 16 * tm + 4 * q4);
            u32x2 o; o.x = pk2(acc[0] + bflo(qq.x), acc[1] + bfhi(qq.x)); o.y = pk2(acc[2] + bflo(qq.y), acc[3] + bfhi(qq.y)); *(u32x2*)(task + 8192 + FRAGOFF(16 * tn + r16, 16 * tm + 4 * q4, 2)) = o; }
          { f32x4 acc = MFMA16(h0, FRAG(ULT, 16 * tn + r16, 0), z); acc = MFMA16(h1, FRAG(ULT, 16 * tn + r16, 1), acc);
            acc = MFMA16(k0, FRAGS(VT, 16 * tn + r16, 0, 3), acc); acc = MFMA16(k1, FRAGS(VT, 16 * tn + r16, 1, 3), acc);
            u32x2 o; o.x = pk2(acc[0], acc[1]); o.y = pk2(acc[2], acc[3]); *(u32x2*)(task + 16384 + ((tm * 2 + (tn >> 1)) * 64 + lane) * 16 + (tn & 1) * 8) = o; }
          { f32x4 acc = MFMA16(a0, FRAG(ULT, 16 * tn + r16, 0), z); acc = MFMA16(a1, FRAG(ULT, 16 * tn + r16, 1), acc);
            acc = MFMA16(g0, FRAGS(VT, 16 * tn + r16, 0, 3), acc); acc = MFMA16(g1, FRAGS(VT, 16 * tn + r16, 1, 3), acc);
            u32x2 o; o.x = pk2(acc[0], acc[1]); o.y = pk2(acc[2], acc[3]); *(u32x2*)(task + 24576 + ((tm * 2 + (tn >> 1)) * 64 + lane) * 16 + (tn & 1) * 8) = o; } }
#undef FRAG
    }
    LDS_BARRIER();
    chk ^= warm.c[0].x ^ warm.c[1].x ^ warm.c[2].x;
#ifdef DUP_ST6
    }
#endif
}

DI void s1_gdn(LAS uchar* lds, const bf16* P, const ScanW& sw, uchar* task, int b, int h, int dir, int ci, int tid) {
    using namespace cf;
    LAS bf16* KL = (LAS bf16*)(lds + 0); LAS bf16* QL = (LAS bf16*)(lds + 17408);
    LAS bf16* VT = (LAS bf16*)(lds + 34816); LAS bf16* KBT = (LAS bf16*)(lds + 53248); LAS bf16* BHT = (LAS bf16*)(lds + 71680);
    LAS bf16* TT = (LAS bf16*)(lds + 90112); LAS float* AAB = (LAS float*)(lds + 99328); LAS float* TF = (LAS float*)(lds + 115968);
    LAS float* INVS = (LAS float*)(lds + 132608); LAS float* gvec = (LAS float*)(lds + 141312); LAS bf16* AQBL = (LAS bf16*)(lds + 151552);
    const int lane = tid & 63, wid = __builtin_amdgcn_readfirstlane(tid >> 6), i = tid >> 3, sub = tid & 7, r16 = lane & 15, q4 = lane >> 4;
    const int R = row_of(b, dir, ci, i), seg_lo = b * SEGT + (ci < 4 ? 0 : CTX), seg_hi = b * SEGT + (ci < 4 ? CTX : SEGT);
    const bf16* pr = P + (size_t)R * PC + C_GD;
    float qv[16], kv[16], vv[16];
#pragma unroll
    for (int w = 0; w < 3; ++w) { const int col = w * 512 + h * 128 + sub * 16; float acc[16];
#pragma unroll
        for (int e = 0; e < 16; ++e) acc[e] = 0.f;
#pragma unroll
        for (int j = 0; j < 5; ++j) { const int Rj = R + j - 2;
            if (Rj >= seg_lo && Rj < seg_hi) { float x[16]; float xa[8], xb[8];
                unpack8(*(const u32x4*)(pr + (ptrdiff_t)(j - 2) * PC + col), xa); unpack8(*(const u32x4*)(pr + (ptrdiff_t)(j - 2) * PC + col + 8), xb);
#pragma unroll
                for (int e = 0; e < 8; ++e) { x[e] = xa[e]; x[8 + e] = xb[e]; }
                const LAS float* cw = (const LAS float*)(lds + GDB) + (j * 3 + w) * 128 + sub * 16;
#pragma unroll
                for (int e4 = 0; e4 < 4; ++e4) { const f32x4 c4 = *(const LAS f32x4*)(cw + 4 * e4);
#pragma unroll
                    for (int e = 0; e < 4; ++e) acc[4 * e4 + e] += c4[e] * x[4 * e4 + e]; } } }
#pragma unroll
        for (int e = 0; e < 16; ++e) { const float x = acc[e] * sigmoidf_(acc[e]); if (w == 0) qv[e] = x; else if (w == 1) kv[e] = x; else vv[e] = x; } }
    { float sq = 0.f, sk = 0.f;
#pragma unroll
      for (int e = 0; e < 16; ++e) { sq += qv[e] * qv[e]; sk += kv[e] * kv[e]; }
      sq += sx<1>(sq); sq += sx<2>(sq); sq += sx<4>(sq); sk += sx<1>(sk); sk += sx<2>(sk); sk += sx<4>(sk);
      const float rq = rsqrtf(sq + 1e-12f) * 0.08838834764831845f, rk = rsqrtf(sk + 1e-12f);
#pragma unroll
      for (int e = 0; e < 16; ++e) { qv[e] *= rq; kv[e] *= rk; } }
    if (sub == 0) { const float a_raw = bf2f(pr[GD_A + dir * 4 + h]), b_raw = bf2f(pr[GD_B + dir * 4 + h]);
        gvec[i] = -__expf(sw.a_log[dir * 4 + h]) * softplusf_(a_raw + sw.dt_bias[dir * 4 + h]); gvec[64 + i] = sigmoidf_(b_raw); }
    { float t0[8], t1[8];
#pragma unroll
      for (int e = 0; e < 8; ++e) { t0[e] = kv[e]; t1[e] = kv[8 + e]; }
      *(LAS u32x4*)(KL + i * 136 + sub * 16) = pack8f(t0); *(LAS u32x4*)(KL + i * 136 + sub * 16 + 8) = pack8f(t1);
#pragma unroll
      for (int e = 0; e < 8; ++e) { t0[e] = qv[e]; t1[e] = qv[8 + e]; }
      *(LAS u32x4*)(QL + i * 136 + sub * 16) = pack8f(t0); *(LAS u32x4*)(QL + i * 136 + sub * 16 + 8) = pack8f(t1); }
    LDS_BARRIER();
    if (wid == 0) { float g = 0.f;
#pragma unroll 8
        for (int t = 0; t < 64; ++t) { const float x = gvec[t]; g += (t <= lane) ? x : 0.f; }
        gvec[128 + lane] = g; }
    LDS_BARRIER();
    for (int z_ = tid; z_ < 64 * 72 / 8; z_ += 512) ((LAS u32x4*)TT)[z_] = (u32x4){0u, 0u, 0u, 0u};
    { const float Gi = gvec[128 + i], GL = gvec[128 + 63], be = gvec[64 + i], eG = __expf(Gi), eLG = __expf(GL - Gi), beG = be * eG;
#pragma unroll
      for (int e = 0; e < 16; e += 2) { const int c = sub * 16 + e, is = i ^ (sub << 3);
          const unsigned pv = pk2(be * vv[e], be * vv[e + 1]), pk = pk2(beG * kv[e], beG * kv[e + 1]), pb = pk2(kv[e] * eLG, kv[e + 1] * eLG);
          VT[c * 72 + is] = (bf16)pv; VT[(c + 1) * 72 + is] = (bf16)(pv >> 16); KBT[c * 72 + is] = (bf16)pk; KBT[(c + 1) * 72 + is] = (bf16)(pk >> 16); BHT[c * 72 + is] = (bf16)pb; BHT[(c + 1) * 72 + is] = (bf16)(pb >> 16); }
      if (tid < 128) ((float*)(task + 98304))[tid] = __expf(GL); }
    { const int mat = wid >> 2, tm = wid & 3;
      const LAS bf16* Am = mat ? QL : KL;
      bf16x8 af[4];
#pragma unroll
      for (int k = 0; k < 4; ++k) af[k] = *(const LAS bf16x8*)(Am + (16 * tm + r16) * 136 + k * 32 + q4 * 8);
#pragma unroll
      for (int tn = 0; tn < 4; ++tn) { f32x4 acc = (f32x4){0.f, 0.f, 0.f, 0.f};
          if (tm >= tn) {
#pragma unroll
              for (int k = 0; k < 4; ++k) acc = MFMA16(af[k], *(const LAS bf16x8*)(KL + (16 * tn + r16) * 136 + k * 32 + q4 * 8), acc); }
          const float Gj = gvec[128 + 16 * tn + r16];
#pragma unroll
          for (int e = 0; e < 4; ++e) { const int ti = 16 * tm + 4 * q4 + e, tj = 16 * tn + r16; const float dec = __expf(fminf(gvec[128 + ti] - Gj, 0.f));
              if (mat == 0) AAB[ti * 65 + tj] = (ti > tj) ? -gvec[64 + ti] * acc[e] * dec : 0.f;
              else AQBL[ti * 72 + tj] = f2bf((ti >= tj) ? acc[e] * dec : 0.f); } } }
    LDS_BARRIER();
    inv_blocked(AAB, TF, TT, INVS, wid, lane, tid, [](int) {});
    LAS bf16* WTT = (LAS bf16*)(lds + 99328); LAS bf16* ULT = (LAS bf16*)(lds + 99328 + 18432);
    { const int mat = wid >> 2, tm = wid & 3;
      const bf16x8 t0 = *(const LAS bf16x8*)(TT + (16 * tm + r16) * 72 + q4 * 8), t1 = *(const LAS bf16x8*)(TT + (16 * tm + r16) * 72 + 32 + q4 * 8); const LAS bf16* Bm = mat ? KBT : VT;
      LAS bf16* dst = mat ? WTT : ULT; const float sg = mat ? -1.f : 1.f;
#pragma unroll
      for (int tn = 0; tn < 8; ++tn) { f32x4 z = MFMA16(t0, FRAGS(Bm, 16 * tn + r16, 0, 4), ((f32x4){0.f, 0.f, 0.f, 0.f})); z = MFMA16(t1, FRAGS(Bm, 16 * tn + r16, 1, 4), z);
          u32x2 o; o.x = pk2(sg * z[0], sg * z[1]); o.y = pk2(sg * z[2], sg * z[3]); *(LAS u32x2*)(dst + (16 * tn + r16) * 72 + 16 * tm + 4 * q4) = o; } }
    LDS_BARRIER();
    {
#define FRAG(Mx, row, k) (*(const LAS bf16x8*)((Mx) + (row) * 72 + (k) * 32 + q4 * 8))
      const bf16x8 w0 = FRAG(WTT, 16 * wid + r16, 0), w1 = FRAG(WTT, 16 * wid + r16, 1);
      const bf16x8 h0 = FRAGS(BHT, 16 * wid + r16, 0, 4), h1 = FRAGS(BHT, 16 * wid + r16, 1, 4);
#pragma unroll
      for (int tn = 0; tn < 8; ++tn) {
          f32x4 acc = MFMA16(w0, FRAGS(BHT, 16 * tn + r16, 0, 4), ((f32x4){0.f, 0.f, 0.f, 0.f})); acc = MFMA16(w1, FRAGS(BHT, 16 * tn + r16, 1, 4), acc);
          u32x2 o; o.x = pk2(acc[0], acc[1]); o.y = pk2(acc[2], acc[3]); *(u32x2*)(task + 0 + FRAGOFF(16 * tn + r16, 16 * wid + 4 * q4, 4)) = o; }
#pragma unroll
      for (int tn = 0; tn < 8; ++tn) {
          f32x4 acc = MFMA16(h0, FRAG(ULT, 16 * tn + r16, 0), ((f32x4){0.f, 0.f, 0.f, 0.f})); acc = MFMA16(h1, FRAG(ULT, 16 * tn + r16, 1), acc);
          u32x2 o; o.x = pk2(acc[0], acc[1]); o.y = pk2(acc[2], acc[3]); *(u32x2*)(task + 49152 + ((wid * 4 + (tn >> 1)) * 64 + lane) * 16 + (tn & 1) * 8) = o; }
#pragma unroll
      for (int tn = 0; tn < 4; ++tn) {
          f32x4 acc = MFMA16(w0, FRAG(AQBL, 16 * tn + r16, 0), ((f32x4){0.f, 0.f, 0.f, 0.f})); acc = MFMA16(w1, FRAG(AQBL, 16 * tn + r16, 1), acc);
          const int t = 16 * tn + r16; const float eG = __expf(gvec[128 + t]); const u32x2 qq = *(const LAS u32x2*)(QL + t * 136 + 16 * wid + 4 * q4);
          u32x2 o; o.x = pk2(acc[0] + eG * bflo(qq.x), acc[1] + eG * bfhi(qq.x)); o.y = pk2(acc[2] + eG * bflo(qq.y), acc[3] + eG * bfhi(qq.y)); *(u32x2*)(task + 32768 + FRAGOFF(t, 16 * wid + 4 * q4, 4)) = o; }
      { const int tm = wid >> 1; const bf16x8 a0 = FRAG(AQBL, 16 * tm + r16, 0), a1 = FRAG(AQBL, 16 * tm + r16, 1);
#pragma unroll
        for (int j = 0; j < 4; ++j) { const int tn = (wid & 1) * 4 + j;
            f32x4 acc = MFMA16(a0, FRAG(ULT, 16 * tn + r16, 0), ((f32x4){0.f, 0.f, 0.f, 0.f})); acc = MFMA16(a1, FRAG(ULT, 16 * tn + r16, 1), acc);
            u32x2 o; o.x = pk2(acc[0], acc[1]); o.y = pk2(acc[2], acc[3]); *(u32x2*)(task + 81920 + ((tm * 4 + (tn >> 1)) * 64 + lane) * 16 + (tn & 1) * 8) = o; } }
#undef FRAG
    }
    LDS_BARRIER();
}

template <int NK, bool LOC> struct S2FA { bf16x8 wt[NK / 32]; u32x4 ul; };
template <int NK, bool LOC> struct S2FB { bf16x8 qt[NK / 32], aqb[2], bht[2]; u32x4 yl, kl; f32x4 gl; float gls; };
template <int NK, bool LOC>
DI void s2_load_a(S2FA<NK, LOC>& f, const uchar* task, int o_wt, int o_ul, int ulh, int tm, int lane) {
    const int r16 = lane & 15, q4 = lane >> 4;
#pragma unroll
    for (int k = 0; k < NK / 32; ++k) f.wt[k] = *(const bf16x8*)(task + o_wt + ((size_t)(16 * tm + r16) * NK + k * 32 + q4 * 8) * 2);
    f.ul = *(const u32x4*)(task + o_ul + (size_t)(ulh * 64 + lane) * 16);
}
template <int NK, bool LOC>
DI void s2_load_b(S2FB<NK, LOC>& f, const uchar* task, int o_qt, int o_aqb, int o_bht, int o_yl, int ulh, int o_kl, int o_gl, int tm, int cm, int ch, int lane) {
    const int r16 = lane & 15, q4 = lane >> 4;
#pragma unroll
    for (int k = 0; k < NK / 32; ++k) f.qt[k] = *(const bf16x8*)(task + o_qt + ((size_t)(16 * tm + r16) * NK + k * 32 + q4 * 8) * 2);
    if (LOC) f.yl = *(const u32x4*)(task + o_yl + (size_t)(ulh * 64 + lane) * 16);
#pragma unroll
    for (int k = 0; k < 2; ++k) { f.aqb[k] = *(const bf16x8*)(task + o_aqb + ((size_t)(16 * tm + r16) * 64 + k * 32 + q4 * 8) * 2); f.bht[k] = *(const bf16x8*)(task + o_bht + ((size_t)(16 * cm + r16) * 64 + k * 32 + q4 * 8) * 2); }
    if (LOC) f.kl = *(const u32x4*)(task + o_kl + (size_t)((cm * 2 + ch) * 64 + lane) * 16);
    if (LOC) f.gl = *(const f32x4*)(task + o_gl + (size_t)(16 * cm + 4 * q4) * 4); else f.gls = *(const float*)(task + o_gl);
}
template <int NK, bool LOC>
DI void s2_step(const S2FA<NK, LOC>& fa, const S2FB<NK, LOC>& fb, f32x4 (&H)[NK / 32], const LAS bf16* Hc, LAS bf16* Hn, LAS bf16* UT, float* Y, int ycol0, int b, int dir, int ci, int tm, int tn0, int cm, int ctn0, int lane) {
    constexpr int NH = NK / 32, LDH = NK + 8;
    const int r16 = lane & 15, q4 = lane >> 4;
    f32x4 U[2], Yv[2];
    U[0] = (f32x4){bflo(fa.ul.x), bfhi(fa.ul.x), bflo(fa.ul.y), bfhi(fa.ul.y)}; U[1] = (f32x4){bflo(fa.ul.z), bfhi(fa.ul.z), bflo(fa.ul.w), bfhi(fa.ul.w)};
#pragma unroll
    for (int j = 0; j < 2; ++j) {
#pragma unroll
        for (int k = 0; k < NK / 32; ++k) { const bf16x8 hb = *(const LAS bf16x8*)(Hc + (16 * (tn0 + j) + r16) * LDH + k * 32 + q4 * 8); U[j] = MFMA16(fa.wt[k], hb, U[j]); }
        u32x2 o; o.x = pk2(U[j][0], U[j][1]); o.y = pk2(U[j][2], U[j][3]);
        *(LAS u32x2*)(UT + (16 * (tn0 + j) + r16) * 72 + 16 * tm + 4 * q4) = o;
    }
    LDS_BARRIER();
    if (LOC) { Yv[0] = (f32x4){bflo(fb.yl.x), bfhi(fb.yl.x), bflo(fb.yl.y), bfhi(fb.yl.y)}; Yv[1] = (f32x4){bflo(fb.yl.z), bfhi(fb.yl.z), bflo(fb.yl.w), bfhi(fb.yl.w)}; }
    else { Yv[0] = (f32x4){0.f, 0.f, 0.f, 0.f}; Yv[1] = Yv[0]; }
#pragma unroll
    for (int j = 0; j < 2; ++j) {
#pragma unroll
        for (int k = 0; k < NK / 32; ++k) { const bf16x8 hb = *(const LAS bf16x8*)(Hc + (16 * (tn0 + j) + r16) * LDH + k * 32 + q4 * 8); Yv[j] = MFMA16(fb.qt[k], hb, Yv[j]); }
#pragma unroll
        for (int k = 0; k < 2; ++k) { const bf16x8 ub = *(const LAS bf16x8*)(UT + (16 * (tn0 + j) + r16) * 72 + k * 32 + q4 * 8); Yv[j] = MFMA16(fb.aqb[k], ub, Yv[j]); }
#pragma unroll
        for (int e = 0; e < 4; ++e) Y[(size_t)row_of(b, dir, ci, 16 * tm + 4 * q4 + e) * 512 + ycol0 + 16 * (tn0 + j) + r16] = Yv[j][e];
    }
#pragma unroll
    for (int j = 0; j < NH; ++j) {
        f32x4 h = LOC ? H[j] * fb.gl : H[j] * fb.gls;
        if (LOC) { if (j == 0) h += (f32x4){bflo(fb.kl.x), bfhi(fb.kl.x), bflo(fb.kl.y), bfhi(fb.kl.y)}; else h += (f32x4){bflo(fb.kl.z), bfhi(fb.kl.z), bflo(fb.kl.w), bfhi(fb.kl.w)}; }
#pragma unroll
        for (int k = 0; k < 2; ++k) { const bf16x8 ub = *(const LAS bf16x8*)(UT + (16 * (ctn0 + j) + r16) * 72 + k * 32 + q4 * 8); h = MFMA16(fb.bht[k], ub, h); }
        H[j] = h;
        u32x2 o; o.x = pk2(h[0], h[1]); o.y = pk2(h[2], h[3]);
        *(LAS u32x2*)(Hn + (16 * (ctn0 + j) + r16) * LDH + 16 * cm + 4 * q4) = o;
    }
    LDS_BARRIER();
}
template <int NK, bool LOC>
DI void s2_scan(LAS uchar* lds, const uchar* task0, int task_bytes, int o_wt, int o_qt, int o_aqb, int o_bht, int o_ul, int ulq, int o_yl, int o_kl, int o_gl,
                float* Y, int ycol0, int b, int dir, int tid) {
    constexpr int NH = NK / 32, LDH = NK + 8;
    LAS bf16* HT = (LAS bf16*)lds;
    LAS bf16* UT = (LAS bf16*)(lds + 2 * 64 * LDH * 2);
    const int lane = tid & 63, wid = tid >> 6;
    const int tm = wid >> 1, tn0 = (wid & 1) * 2;
    const int cm = (NK == 64) ? (wid >> 1) : wid, ctn0 = (NK == 64) ? (wid & 1) * 2 : 0;
    const int ulh = tm * ulq + (wid & 1);
    for (int i = tid; i < 64 * LDH * 2 / 16; i += 512) ((LAS u32x4*)HT)[i] = (u32x4){0u, 0u, 0u, 0u};
    f32x4 H[NH];
#pragma unroll
    for (int j = 0; j < NH; ++j) H[j] = (f32x4){0.f, 0.f, 0.f, 0.f};
    S2FA<NK, LOC> a0, a1, a2; S2FB<NK, LOC> b0, b1, b2;
#define TASKP(c) (task0 + (size_t)((c) < cf::NCH ? (c) : cf::NCH - 1) * task_bytes)
#define LDA(f, c) s2_load_a<NK, LOC>(f, TASKP(c), o_wt, o_ul, ulh, tm, lane)
#define LDB(f, c) s2_load_b<NK, LOC>(f, TASKP(c), o_qt, o_aqb, o_bht, o_yl, ulh, o_kl, o_gl, tm, cm, (wid & 1), lane)
#define STP(fa, fb, c) s2_step<NK, LOC>(fa, fb, H, HT + ((c) & 1) * 64 * LDH, HT + (((c) + 1) & 1) * 64 * LDH, UT, Y, ycol0, b, dir, (c), tm, tn0, cm, ctn0, lane)
    LDA(a0, 0); LDB(b0, 0); LDA(a1, 1); LDB(b1, 1);
    LDS_BARRIER();
#pragma unroll 2
    for (int ci = 0; ci < cf::NCH; ++ci) {
        LDA(a2, ci + 2); LDB(b2, ci + 2); STP(a0, b0, ci);
        a0 = a1; a1 = a2; b0 = b1; b1 = b2;
    }
#undef TASKP
#undef LDA
#undef LDB
#undef STP
}

template <int NK, bool VECG> struct S2N { bf16x8 m[NK / 32], q[NK / 32]; u32x4 n[NK / 64], y; f32x4 gl; float gls; };
template <int NK, bool VECG>
DI void s2n_load(S2N<NK, VECG>& f, const uchar* task, int o_m, int o_q, int o_n, int o_y, int o_gl, int tm, int cm, int nh0, int yh, int lane) {
    const int r16 = lane & 15, q4 = lane >> 4;
#pragma unroll
    for (int k = 0; k < NK / 32; ++k) { f.m[k] = *(const bf16x8*)(task + o_m + (size_t)((cm * (NK / 32) + k) * 64 + lane) * 16); f.q[k] = *(const bf16x8*)(task + o_q + (size_t)((tm * (NK / 32) + k) * 64 + lane) * 16); }
#pragma unroll
    for (int j = 0; j < NK / 64; ++j) f.n[j] = *(const u32x4*)(task + o_n + (size_t)((nh0 + j) * 64 + lane) * 16);
    f.y = *(const u32x4*)(task + o_y + (size_t)(yh * 64 + lane) * 16);
    if (VECG) f.gl = *(const f32x4*)(task + o_gl + (size_t)(16 * cm + 4 * q4) * 4); else f.gls = *(const float*)(task + o_gl);
}
template <int NK, bool VECG>
DI void s2n_step(const S2N<NK, VECG>& f, f32x4 (&H)[NK / 32], const LAS bf16* Hc, LAS bf16* Hn, LAS float* YS, float* Y, int ycol0, int b, int dir, int ci, int tm, int tn0, int cm, int ctn0, int wid, int lane) {
    constexpr int NH = NK / 32, LDH = NK + 8;
    const int r16 = lane & 15, q4 = lane >> 4;
#pragma unroll
    for (int j = 0; j < NH; ++j) {
        const u32x4 nn = f.n[j >> 1];
        f32x4 h = VECG ? H[j] * f.gl : H[j] * f.gls;
        h += (j & 1) ? (f32x4){bflo(nn.z), bfhi(nn.z), bflo(nn.w), bfhi(nn.w)} : (f32x4){bflo(nn.x), bfhi(nn.x), bflo(nn.y), bfhi(nn.y)};
#pragma unroll
        for (int k = 0; k < NK / 32; ++k) { const bf16x8 hb = *(const LAS bf16x8*)(Hc + (16 * (ctn0 + j) + r16) * LDH + k * 32 + q4 * 8); h = MFMA16(f.m[k], hb, h); }
        H[j] = h;
        u32x2 o; o.x = pk2(h[0], h[1]); o.y = pk2(h[2], h[3]);
        *(LAS u32x2*)(Hn + (16 * (ctn0 + j) + r16) * LDH + 16 * cm + 4 * q4) = o;
    }
#pragma unroll
    for (int j = 0; j < 2; ++j) {
        f32x4 yv = j ? (f32x4){bflo(f.y.z), bfhi(f.y.z), bflo(f.y.w), bfhi(f.y.w)} : (f32x4){bflo(f.y.x), bfhi(f.y.x), bflo(f.y.y), bfhi(f.y.y)};
#pragma unroll
        for (int k = 0; k < NK / 32; ++k) { const bf16x8 hb = *(const LAS bf16x8*)(Hc + (16 * (tn0 + j) + r16) * LDH + k * 32 + q4 * 8); yv = MFMA16(f.q[k], hb, yv); }
#pragma unroll
        for (int e = 0; e < 4; ++e) YS[(16 * tm + 4 * q4 + e) * 65 + 16 * (tn0 + j) + r16] = yv[e];
    }
    LDS_BARRIER();
#pragma unroll
    for (int e = 0; e < 8; ++e) { const int t = 8 * wid + e;
        Y[(size_t)row_of(b, dir, ci, t) * 512 + ycol0 + lane] = YS[t * 65 + lane]; }
}
template <int NK, bool VECG>
DI void s2n_scan(LAS uchar* lds, const uchar* task0, int task_bytes, int o_m, int o_q, int o_n, int o_y, int o_gl, int nq, int vs, float* Y, int ycol0, int b, int dir, int tid) {
    constexpr int NH = NK / 32, LDH = NK + 8;
    LAS bf16* HT = (LAS bf16*)lds;
    LAS float* YSB = (LAS float*)(lds + 2 * 64 * LDH * 2);
    const int lane = tid & 63, wid = __builtin_amdgcn_readfirstlane(tid >> 6);
    const int tm = wid >> 1, tn0 = (wid & 1) * 2;
    const int cm = (NK == 64) ? (wid >> 1) : wid, ctn0 = (NK == 64) ? (wid & 1) * 2 : 0;
    const int nh0 = (NK == 64) ? (cm * nq + (wid & 1)) : (cm * nq + vs * 2), yh = tm * nq + vs * 2 + (wid & 1);
    for (int i = tid; i < 64 * LDH * 2 / 16; i += 512) ((LAS u32x4*)HT)[i] = (u32x4){0u, 0u, 0u, 0u};
    f32x4 H[NH];
#pragma unroll
    for (int j = 0; j < NH; ++j) H[j] = (f32x4){0.f, 0.f, 0.f, 0.f};
#define TP(c) (task0 + (size_t)((c) < cf::NCH ? (c) : cf::NCH - 1) * task_bytes)
#define LD(f, c) s2n_load<NK, VECG>(f, TP(c), o_m, o_q, o_n, o_y, o_gl, tm, cm, nh0, yh, lane)
#define ST(f, c) s2n_step<NK, VECG>(f, H, HT + ((c) & 1) * 64 * LDH, HT + (((c) + 1) & 1) * 64 * LDH, YSB + ((c) & 1) * 64 * 65, Y, ycol0, b, dir, (c), tm, tn0, cm, ctn0, wid, lane)
    if constexpr (NK == 64) {
        S2N<NK, VECG> f0, f1, f2, f3;
        LD(f0, 0); LD(f1, 1); LD(f2, 2);
        LDS_BARRIER();
#pragma unroll 1
        for (int ci = 0; ci < cf::NCH; ci += 4) {
            LD(f3, ci + 3); ST(f0, ci);
            LD(f0, ci + 4); ST(f1, ci + 1);
            LD(f1, ci + 5); ST(f2, ci + 2);
            LD(f2, ci + 6); ST(f3, ci + 3);
        }
    } else {
        S2N<NK, VECG> f0, f1, f2;
        LD(f0, 0); LD(f1, 1);
        LDS_BARRIER();
#pragma unroll 1
        for (int ci = 0; ci + 2 < cf::NCH; ci += 3) {
            LD(f2, ci + 2); ST(f0, ci);
            LD(f0, ci + 3); ST(f1, ci + 1);
            LD(f1, ci + 4); ST(f2, ci + 2);
        }
        ST(f0, cf::NCH - 2); ST(f1, cf::NCH - 1);
    }
#undef TP
#undef LD
#undef ST
}
namespace at {
constexpr int DQ = 192, DV = 128, NW = 8, QBLK = 32, KVBLK = 64;
constexpr float SCALE = 0.07216878364870322f;
constexpr float THR = 8.f;
constexpr int SHM_V = KVBLK * DV * 2, SHM_K = KVBLK * DQ * 2, SHM_Q = NW * 8 * 1024, SHM_ATTN = 2 * SHM_V + 2 * SHM_K + NW * 64 * 4 + SHM_Q;
#define KSWZ(row, colB) ((row) * 384 + ((colB) ^ (((row) & 7) << 4)))
#define SBAR() __builtin_amdgcn_sched_barrier(0)
DI int crow(int r, int hi) { return (r & 3) + 8 * (r >> 2) + 4 * hi; }
DI unsigned cvtpk(float lo, float hi) { const f32x2 v = {lo, hi}; return __builtin_bit_cast(unsigned, __builtin_convertvector(v, bf16x2_t)); }
DI void partialSM(f32x16& p0, f32x16& p1, float& m_reg, float& mn, float& alpha) {
  constexpr float C = SCALE * 1.4426950408889634f;
  float pmax = p0[0];
#pragma unroll
  for (int r = 1; r < 16; ++r) pmax = fmaxf(pmax, p0[r]);
#pragma unroll
  for (int r = 0; r < 16; ++r) pmax = fmaxf(pmax, p1[r]);
  { auto rr = __builtin_amdgcn_permlane32_swap(__float_as_uint(pmax), __float_as_uint(pmax), false, false);
    pmax = fmaxf(__uint_as_float(rr[0]), __uint_as_float(rr[1])); }
  if (__builtin_expect(__all(pmax - m_reg <= THR / SCALE), 1)) { mn = m_reg; alpha = 1.f; }
  else { mn = fmaxf(m_reg, pmax); alpha = __builtin_amdgcn_exp2f((m_reg - mn) * C); m_reg = mn; }
  float mnC = -mn * C;
#pragma unroll
  for (int r = 0; r < 16; ++r) p0[r] = fmaf(p0[r], C, mnC);
#pragma unroll
  for (int r = 0; r < 16; ++r) p1[r] = fmaf(p1[r], C, mnC);
#pragma unroll
  for (int r = 0; r < 16; ++r) p0[r] = __builtin_amdgcn_exp2f(p0[r]);
}
DI void finishSM(f32x16& p0, f32x16& p1, float alpha, float& l_reg, bf16x8& pa0, bf16x8& pa1, bf16x8& pa2, bf16x8& pa3) {
#pragma unroll
  for (int r = 0; r < 16; ++r) p1[r] = __builtin_amdgcn_exp2f(p1[r]);
  float ps = 0;
#pragma unroll
  for (int r = 0; r < 16; ++r) ps += p0[r];
#pragma unroll
  for (int r = 0; r < 16; ++r) ps += p1[r];
  { auto rr = __builtin_amdgcn_permlane32_swap(__float_as_uint(ps), __float_as_uint(ps), false, false);
    ps = __uint_as_float(rr[0]) + __uint_as_float(rr[1]); }
  l_reg = l_reg * alpha + ps;
#define PK4(P, BASE, OUT) do { unsigned a0 = cvtpk(P[BASE + 0], P[BASE + 1]), a1 = cvtpk(P[BASE + 2], P[BASE + 3]);   \
    unsigned b0 = cvtpk(P[BASE + 4], P[BASE + 5]), b1 = cvtpk(P[BASE + 6], P[BASE + 7]);                              \
    auto r0 = __builtin_amdgcn_permlane32_swap(a0, b0, false, false); auto r1 = __builtin_amdgcn_permlane32_swap(a1, b1, false, false); \
    u32x4 w = {r0[0], r1[0], r0[1], r1[1]}; OUT = *reinterpret_cast<bf16x8*>(&w); } while (0)
  PK4(p0, 0, pa0); PK4(p0, 8, pa1); PK4(p1, 0, pa2); PK4(p1, 8, pa3);
#undef PK4
}
constexpr int NQR = 4;
DI void qkt(f32x16& p0, f32x16& p1, const LAS char* Ks, const bf16x8* qr, const LAS char* qlds, int r32, int hi) {
  p0 = f32x16{}; p1 = f32x16{};
#pragma unroll
  for (int d0 = 0; d0 < 12; ++d0) { int cb = (d0 * 16 + hi * 8) * 2;
    const bf16x8 qf = (d0 < NQR) ? qr[d0] : *(const LAS bf16x8*)(qlds + (d0 - NQR) * 1024);
    bf16x8 b0 = *(const LAS bf16x8*)(Ks + KSWZ(r32, cb));
    bf16x8 b1 = *(const LAS bf16x8*)(Ks + KSWZ(32 + r32, cb));
    p0 = __builtin_amdgcn_mfma_f32_32x32x16_bf16(b0, qf, p0, 0, 0, 0);
    p1 = __builtin_amdgcn_mfma_f32_32x32x16_bf16(b1, qf, p1, 0, 0, 0); }
}
DI int v_st(int k, int c) { const int kk = (k & ~0xC) | ((k & 4) << 1) | ((k & 8) >> 1); return ((kk >> 3) * 4 + (c >> 5)) * 512 + ((kk & 7) * 32 + (c & 31)) * 2; }
DI int v_rd_base(int lane) { return ((lane & 3) << 3) | (((lane >> 2) & 3) << 6) | (((lane >> 4) & 1) << 5) | (((lane >> 5) & 1) << 8); }
constexpr int v_rd_off(int d0, int ks, int half) { return d0 * 512 + ks * 4096 + half * 2048; }
template <int OFF> DI s16x4 tr_read(int vb) { s16x4 r; asm volatile("ds_read_b64_tr_b16 %0, %1 offset:%2" : "=&v"(r) : "v"(vb), "i"(OFF) : "memory"); return r; }
template <int D0> DI void pv_one(f32x16& od, int vb, bf16x8 pa0, bf16x8 pa1, bf16x8 pa2, bf16x8 pa3) {
  const s16x4 l0 = tr_read<v_rd_off(D0, 0, 0)>(vb), h0 = tr_read<v_rd_off(D0, 0, 1)>(vb), l1 = tr_read<v_rd_off(D0, 1, 0)>(vb), h1 = tr_read<v_rd_off(D0, 1, 1)>(vb);
  const s16x4 l2 = tr_read<v_rd_off(D0, 2, 0)>(vb), h2 = tr_read<v_rd_off(D0, 2, 1)>(vb), l3 = tr_read<v_rd_off(D0, 3, 0)>(vb), h3 = tr_read<v_rd_off(D0, 3, 1)>(vb);
  asm volatile("s_waitcnt lgkmcnt(0)" ::: "memory"); SBAR();
#define PK(L, H) (bf16x8){L[0], L[1], L[2], L[3], H[0], H[1], H[2], H[3]}
  od = __builtin_amdgcn_mfma_f32_32x32x16_bf16(pa0, PK(l0, h0), od, 0, 0, 0);
  od = __builtin_amdgcn_mfma_f32_32x32x16_bf16(pa1, PK(l1, h1), od, 0, 0, 0);
  od = __builtin_amdgcn_mfma_f32_32x32x16_bf16(pa2, PK(l2, h2), od, 0, 0, 0);
  od = __builtin_amdgcn_mfma_f32_32x32x16_bf16(pa3, PK(l3, h3), od, 0, 0, 0);
#undef PK
}
DI void pv_d0(f32x16* o, int vb, bf16x8 pa0, bf16x8 pa1, bf16x8 pa2, bf16x8 pa3) {
  pv_one<0>(o[0], vb, pa0, pa1, pa2, pa3); pv_one<1>(o[1], vb, pa0, pa1, pa2, pa3); pv_one<2>(o[2], vb, pa0, pa1, pa2, pa3); pv_one<3>(o[3], vb, pa0, pa1, pa2, pa3);
}
DI void attn_unit(const bf16* __restrict__ Qb, const bf16* __restrict__ Kh, const bf16* __restrict__ Vh, bf16* __restrict__ Ob, int seq, const float* rope, int pos0, LAS char* lds, const int tid) {
  constexpr int LDQ = cf::QP, LDKK = cf::KP, LDVV = cf::VP, LDO = cf::D;
  const int wid = __builtin_amdgcn_readfirstlane(tid >> 6), lane = tid & 63, r32 = lane & 31, hi = lane >> 5;
  LAS char* V_lds = lds; LAS char* K_lds = lds + 2 * SHM_V;
  LAS float* ws = (LAS float*)(lds + 2 * SHM_V + 2 * SHM_K) + wid * 64; LAS float* li_l = ws; LAS float* al_l = ws + 32;
  LAS char* qlds = lds + 2 * SHM_V + 2 * SHM_K + NW * 64 * 4 + wid * (12 - NQR) * 1024 + lane * 16;
  float m_reg = -1e30f, l_reg = 0; f32x16 o[4] = {}; bf16x8 qr[12];
  const bf16* Qw = Qb + (long)(wid * QBLK + r32) * LDQ + hi * 8;
#pragma unroll
  for (int d0 = 0; d0 < 12; ++d0) qr[d0] = *reinterpret_cast<const bf16x8*>(Qw + d0 * 16);
  if (rope) { const int t = pos0 + wid * QBLK + r32;
#pragma unroll
    for (int ax = 0; ax < 2; ++ax) { const int pos = ax ? (t & 63) : (t >> 6);
      const f32x4 c0 = *(const f32x4*)(rope + pos * 16 + hi * 8), c1 = *(const f32x4*)(rope + pos * 16 + hi * 8 + 4), s0 = *(const f32x4*)(rope + 1024 + pos * 16 + hi * 8), s1 = *(const f32x4*)(rope + 1024 + pos * 16 + hi * 8 + 4);
      float x1[8], x2[8], o1[8], o2[8]; unpack8(__builtin_bit_cast(u32x4, qr[8 + 2 * ax]), x1); unpack8(__builtin_bit_cast(u32x4, qr[9 + 2 * ax]), x2);
#pragma unroll
      for (int e = 0; e < 8; ++e) { const float c = e < 4 ? c0[e] : c1[e - 4], s = e < 4 ? s0[e] : s1[e - 4]; o1[e] = x1[e] * c - x2[e] * s; o2[e] = x1[e] * s + x2[e] * c; }
      qr[8 + 2 * ax] = __builtin_bit_cast(bf16x8, pack8f(o1)); qr[9 + 2 * ax] = __builtin_bit_cast(bf16x8, pack8f(o2)); } }
#pragma unroll
  for (int d0 = NQR; d0 < 12; ++d0) *(LAS bf16x8*)(qlds + (d0 - NQR) * 1024) = qr[d0];
  const int sr = tid >> 4, sc = (tid & 15) * 8, vst0 = v_st(sr, sc), vst1 = v_st(32 + sr, sc);
  int kr_[3], kc_[3];
#pragma unroll
  for (int j = 0; j < 3; ++j) { const int q = tid + 512 * j; kr_[j] = q / 24; kc_[j] = (q % 24) * 8; }
  const int vb0 = (int)(uintptr_t)V_lds + v_rd_base(lane);
  bf16x8 vs0 = {}, vs1 = {}, ks0 = {}, ks1 = {}, ks2 = {};
#define SLOAD(k0) do { vs0 = *(const bf16x8*)(&Vh[(long)((k0) + sr) * LDVV + sc]); vs1 = *(const bf16x8*)(&Vh[(long)((k0) + 32 + sr) * LDVV + sc]); \
    ks0 = *(const bf16x8*)(&Kh[(long)((k0) + kr_[0]) * LDKK + kc_[0]]); ks1 = *(const bf16x8*)(&Kh[(long)((k0) + kr_[1]) * LDKK + kc_[1]]); ks2 = *(const bf16x8*)(&Kh[(long)((k0) + kr_[2]) * LDKK + kc_[2]]); } while (0)
#define SWRITE(b) do { *(LAS bf16x8*)(V_lds + (b) * SHM_V + vst0) = vs0; *(LAS bf16x8*)(V_lds + (b) * SHM_V + vst1) = vs1; \
    *(LAS bf16x8*)(K_lds + (b) * SHM_K + KSWZ(kr_[0], kc_[0] * 2)) = ks0; *(LAS bf16x8*)(K_lds + (b) * SHM_K + KSWZ(kr_[1], kc_[1] * 2)) = ks1; *(LAS bf16x8*)(K_lds + (b) * SHM_K + KSWZ(kr_[2], kc_[2] * 2)) = ks2; } while (0)
#define SWAIT() asm volatile("s_waitcnt vmcnt(0)" ::: "memory")
#define RESC(a) do { if (__any((a) < 1.f)) { if (hi == 0) al_l[r32] = (a); asm volatile("s_waitcnt lgkmcnt(0)" ::: "memory"); \
    _Pragma("unroll") for (int d = 0; d < 4; ++d) _Pragma("unroll") for (int r = 0; r < 16; ++r) o[d][r] *= al_l[crow(r, hi)]; } } while (0)
  f32x16 pA0 = {}, pA1 = {}, pB0 = {}, pB1 = {}; float mnA = 0.f, mnB = 0.f, alA = 1.f, alB = 1.f; bf16x8 pa0 = {}, pa1 = {}, pa2 = {}, pa3 = {}; const int NT = seq / KVBLK;
  SLOAD(0); SWAIT(); SWRITE(0); __syncthreads();
  qkt(pA0, pA1, K_lds, qr, qlds, r32, hi); partialSM(pA0, pA1, m_reg, mnA, alA);
  SLOAD(KVBLK);
  SWAIT(); SWRITE(1); __syncthreads();
  for (int j = 1; j + 1 < NT; j += 2) {
    SBAR(); qkt(pB0, pB1, K_lds + SHM_K, qr, qlds, r32, hi);
    finishSM(pA0, pA1, alA, l_reg, pa0, pa1, pa2, pa3); SBAR();
    SLOAD((j + 1) * KVBLK); SBAR();
    pv_d0(o, vb0, pa0, pa1, pa2, pa3); partialSM(pB0, pB1, m_reg, mnB, alB);
    __syncthreads(); SWAIT(); SWRITE(0);
    RESC(alB); __syncthreads();
    SBAR(); qkt(pA0, pA1, K_lds, qr, qlds, r32, hi);
    finishSM(pB0, pB1, alB, l_reg, pa0, pa1, pa2, pa3); SBAR();
    SLOAD((j + 2) * KVBLK); SBAR();
    pv_d0(o, vb0 + (int)SHM_V, pa0, pa1, pa2, pa3); partialSM(pA0, pA1, m_reg, mnA, alA);
    __syncthreads(); SWAIT(); SWRITE(1);
    RESC(alA); __syncthreads();
  }
  SBAR(); qkt(pB0, pB1, K_lds + SHM_K, qr, qlds, r32, hi);
  finishSM(pA0, pA1, alA, l_reg, pa0, pa1, pa2, pa3); SBAR();
  pv_d0(o, vb0, pa0, pa1, pa2, pa3); partialSM(pB0, pB1, m_reg, mnB, alB);
  __syncthreads(); RESC(alB);
  finishSM(pB0, pB1, alB, l_reg, pa0, pa1, pa2, pa3); SBAR();
  pv_d0(o, vb0 + (int)SHM_V, pa0, pa1, pa2, pa3);
  if (hi == 0) li_l[r32] = l_reg; asm volatile("s_waitcnt lgkmcnt(0)" ::: "memory");
  float rli[16];
#pragma unroll
  for (int r = 0; r < 16; ++r) rli[r] = __builtin_amdgcn_rcpf(li_l[crow(r, hi)]);
  bf16* Ow = Ob + (long)(wid * QBLK) * LDO;
#pragma unroll
  for (int r = 0; r < 16; ++r) { int orow = crow(r, hi);
#pragma unroll
    for (int d0 = 0; d0 < 4; ++d0) Ow[(long)orow * LDO + d0 * 32 + r32] = f2bf(o[d0][r] * rli[r]); }
  __syncthreads();
#undef SLOAD
#undef SWRITE
#undef SWAIT
#undef RESC
}
#undef KSWZ
}
#if defined(PROBE)
DI void fatomic_max(unsigned* p, float v) { atomicMax(p, __builtin_bit_cast(unsigned, fabsf(v))); }
DI float pshift(const bf16* P, int R, int lo, int hi, int col, const float* mu, int mucol) {
    const float c = bf2f(P[(size_t)R * cf::PC + col]), p = (R - 1 >= lo) ? bf2f(P[(size_t)(R - 1) * cf::PC + col]) : 0.f, n = (R + 1 < hi) ? bf2f(P[(size_t)(R + 1) * cf::PC + col]) : 0.f;
    return c + (0.5f * (p + n) - c) * mu[mucol];
}
__global__ void __launch_bounds__(256) probe(In in, uchar* ws, unsigned* res, float* scratch) {
    using namespace cf;
    __shared__ float sh[4352 + 1024];
    const int tid = threadIdx.x, bx = blockIdx.x;
    const bf16* P = (const bf16*)(ws + WS_P); const bf16* Qb = (const bf16*)(ws + WS_Q); const bf16* Kb = (const bf16*)(ws + WS_K); const bf16* Vb = (const bf16*)(ws + WS_V); const bf16* MIX = (const bf16*)(ws + WS_XM);
    const float* YR = (const float*)(ws + WS_YR); const float* YG = (const float*)(ws + WS_YG);
    if (bx < 8) {
        const int h = bx, b = 1;
        for (int which = 0; which < 4; ++which) {
            const bool isctx = which == 3; const int t = which == 0 ? 0 : which == 1 ? 1000 : which == 2 ? 4095 : 5;
            const int row = b * SEGT + (isctx ? t : CTX + t), nkeys = isctx ? CTX : SEGT;
            if (tid < 192) { float q = bf2f(Qb[(size_t)row * QP + h * 192 + tid]); sh[4352 + tid] = q; }
            __syncthreads();
            if (tid < 192 && tid >= 128 && !isctx) { const int j = tid - 128, ax = j >> 5, half = (j >> 4) & 1, f = j & 15; const float pos = ax ? (float)(t & 63) : (float)(t >> 6);
                const float ang = pos * powf(10000.f, -(float)f / 16.f), c = cosf(ang), s = sinf(ang);
                const float x1 = sh[4352 + 128 + ax * 32 + f], x2 = sh[4352 + 128 + ax * 32 + 16 + f];
                sh[4352 + 512 + j] = half ? (x1 * s + x2 * c) : (x1 * c - x2 * s); }
            __syncthreads();
            if (tid < 64 && !isctx) sh[4352 + 128 + tid] = sh[4352 + 512 + tid];
            __syncthreads();
            for (int kk = tid; kk < nkeys; kk += 256) { const int krow = b * SEGT + kk; const bool kctx = kk < CTX; const int kt = kk - CTX;
                float s = 0.f;
                for (int d = 0; d < 128; ++d) s += sh[4352 + d] * bf2f(Kb[(size_t)krow * KP + h * 192 + d]);
                for (int j = 0; j < 64; ++j) { const int ax = j >> 5, half = (j >> 4) & 1, f = j & 15;
                    float kv;
                    if (kctx) kv = bf2f(P[(size_t)krow * PC + C_KR + j]);
                    else { const float pos = ax ? (float)(kt & 63) : (float)(kt >> 6), ang = pos * powf(10000.f, -(float)f / 16.f), c = cosf(ang), sn = sinf(ang);
                        const float x1 = bf2f(P[(size_t)krow * PC + C_KR + ax * 32 + f]), x2 = bf2f(P[(size_t)krow * PC + C_KR + ax * 32 + 16 + f]);
                        kv = half ? (x1 * sn + x2 * c) : (x1 * c - x2 * sn); }
                    s += sh[4352 + 128 + j] * kv; }
                sh[kk] = s * 0.07216878364870322f; }
            __syncthreads();
            float mx = -1e30f; for (int kk = 0; kk < nkeys; ++kk) mx = fmaxf(mx, sh[kk]);
            float den = 0.f; for (int kk = 0; kk < nkeys; ++kk) den += __expf(sh[kk] - mx);
            if (tid < 128) { float o = 0.f; for (int kk = 0; kk < nkeys; ++kk) o += __expf(sh[kk] - mx) * bf2f(Vb[(size_t)(b * SEGT + kk) * VP + h * 128 + tid]);
                o /= den; const float got = bf2f(MIX[(size_t)row * D + h * 128 + tid]); fatomic_max(res + 0, got - o); fatomic_max(res + 16, o); }
            __syncthreads();
        }
    } else if (bx < 10) {
        if (tid >= 64) return;
        const int b = 1, h = 3, dir = bx - 8, lane = tid, hc = h * 64 + lane;
        const float* mu = in.p[11]; float S[64]; float cumw = 1.f;
        const uchar* task = ws + WS_RWT + (size_t)((((b * 8 + h) * 2 + dir) * NCH) + 0) * RW_TASK;
#pragma unroll
        for (int k = 0; k < 64; ++k) S[k] = 0.f;
        for (int step = 0; step < SEGT; ++step) {
            const int R = row_of(b, dir, step >> 6, step & 63), s = R % SEGT, lo = b * SEGT + (s < CTX ? 0 : CTX), hi = b * SEGT + (s < CTX ? CTX : SEGT);
            const float r = pshift(P, R, lo, hi, C_RW + hc, mu, hc), k = pshift(P, R, lo, hi, C_RW + 512 + hc, mu, 512 + hc), v = pshift(P, R, lo, hi, C_RW + 1024 + hc, mu, 1024 + hc);
            if (lane < 32) { sh[lane] = tanhf(pshift(P, R, lo, hi, C_RW + RW_WD + dir * 32 + lane, mu, RW_WD + dir * 32 + lane)); sh[32 + lane] = pshift(P, R, lo, hi, C_RW + RW_AD + dir * 32 + lane, mu, RW_AD + dir * 32 + lane); }
            __builtin_amdgcn_s_waitcnt(0); __builtin_amdgcn_wave_barrier();
            float lw = in.p[12][dir * 512 + hc], la = in.p[14][dir * 512 + hc];
            for (int rr = 0; rr < 32; ++rr) { lw += sh[rr] * in.p[13][((size_t)dir * 32 + rr) * 512 + hc]; la += sh[32 + rr] * in.p[15][((size_t)dir * 32 + rr) * 512 + hc]; }
            const float wlog = -log1pf(expf(-lw)) - 0.5f, w = expf(-expf(wlog)), alr = 1.f / (1.f + expf(-la));
            float kk = k * in.p[17][hc]; sh[400 + lane] = kk * kk; __builtin_amdgcn_s_waitcnt(0); __builtin_amdgcn_wave_barrier(); float nn = 0.f; for (int jj = 0; jj < 64; ++jj) nn += sh[400 + jj]; kk *= rsqrtf(nn + 1e-12f);
            const float kd = k * (1.f + (alr - 1.f) * in.p[18][hc]), a = -kk, bb = kk * alr;
            if (dir == 0 && step < 64) { cumw *= w;
#ifdef S1DBG
                const float qt = (S1DBG == 1) ? alr : kk,
#else
                const float qt = r * cumw,
#endif
                got = bf2f(((const bf16*)(task + 8192))[step * 64 + lane]); fatomic_max(res + 9, got - qt); fatomic_max(res + 25, qt);
                scratch[(size_t)8 * SEGT * 64 + step * 64 + lane] = bb; scratch[(size_t)8 * SEGT * 64 + 4096 + step * 64 + lane] = cumw;
                if (step == 63) { const float gl = ((const float*)(task + 57344))[lane]; fatomic_max(res + 8, gl - cumw); fatomic_max(res + 24, cumw);
                    for (int t2 = 0; t2 < 64; ++t2) { const float bh = scratch[(size_t)8 * SEGT * 64 + t2 * 64 + lane] * cumw / scratch[(size_t)8 * SEGT * 64 + 4096 + t2 * 64 + lane], gb = bf2f(((const bf16*)(task + 24576))[lane * 64 + t2]); fatomic_max(res + 10, gb - bh); fatomic_max(res + 26, bh); } } }
            sh[64 + lane] = a; sh[128 + lane] = bb; sh[192 + lane] = kd; sh[256 + lane] = w; sh[320 + lane] = r;
            __builtin_amdgcn_s_waitcnt(0); __builtin_amdgcn_wave_barrier();
            float sa = 0.f;
#pragma unroll
            for (int kx = 0; kx < 64; ++kx) sa += S[kx] * sh[64 + kx];
            float y = 0.f;
#pragma unroll
            for (int kx = 0; kx < 64; ++kx) { S[kx] = S[kx] * sh[256 + kx] + sa * sh[128 + kx] + v * sh[192 + kx]; y += S[kx] * sh[320 + kx]; }
            scratch[((size_t)dir * SEGT + (R - b * SEGT)) * 64 + lane] = y;
            __builtin_amdgcn_s_waitcnt(0); __builtin_amdgcn_wave_barrier();
        }
    } else if (bx < 12) {
        const int b = 2, h = 1, dir = bx - 10, c = tid & 127;
        float S[128];
#pragma unroll
        for (int k = 0; k < 128; ++k) S[k] = 0.f;
        const float A = expf(in.p[23][dir * 4 + h]), dtb = in.p[24][dir * 4 + h];
        for (int step = 0; step < SEGT; ++step) {
            const int R = row_of(b, dir, step >> 6, step & 63), s = R % SEGT, lo = b * SEGT + (s < CTX ? 0 : CTX), hi = b * SEGT + (s < CTX ? CTX : SEGT);
            float x[3];
            for (int w = 0; w < 3; ++w) { float acc = 0.f; const int col = w * 512 + h * 128 + c;
                for (int j = 0; j < 5; ++j) { const int Rj = R + j - 2; if (Rj >= lo && Rj < hi) acc += in.p[22][(size_t)j * 1536 + col] * bf2f(P[(size_t)Rj * PC + C_GD + col]); }
                x[w] = acc / (1.f + expf(-acc)); }
            if (tid < 128) { sh[tid] = x[0] * x[0]; sh[128 + tid] = x[1] * x[1]; }
            __syncthreads();
            float sq = 0.f, sk = 0.f; for (int j = 0; j < 128; ++j) { sq += sh[j]; sk += sh[128 + j]; }
            __syncthreads();
            const float q = x[0] * rsqrtf(sq + 1e-12f) * 0.08838834764831845f, k = x[1] * rsqrtf(sk + 1e-12f), v = x[2];
            const float a_raw = bf2f(P[(size_t)R * PC + C_GD + GD_A + dir * 4 + h]), b_raw = bf2f(P[(size_t)R * PC + C_GD + GD_B + dir * 4 + h]);
            const float z = a_raw + dtb, g = -A * (z > 20.f ? z : log1pf(expf(z))), eg = expf(g), beta = 1.f / (1.f + expf(-b_raw));
            if (tid < 128) { sh[256 + tid] = k; sh[384 + tid] = q; }
            __syncthreads();
            if (tid < 128) { float ks = 0.f;
#pragma unroll
                for (int kx = 0; kx < 128; ++kx) ks += sh[256 + kx] * S[kx];
                float o = 0.f;
#pragma unroll
                for (int kx = 0; kx < 128; ++kx) { S[kx] = eg * (S[kx] - beta * sh[256 + kx] * ks) + beta * sh[256 + kx] * v; o += sh[384 + kx] * S[kx]; }
                scratch[(size_t)2 * SEGT * 64 + ((size_t)dir * SEGT + (R - b * SEGT)) * 128 + c] = o; }
            __syncthreads();
        }
    }
}
__global__ void probe_cmp(uchar* ws, unsigned* res, const float* scratch) {
    using namespace cf;
    const float* YR = (const float*)(ws + WS_YR); const float* YG = (const float*)(ws + WS_YG);
    for (int i = blockIdx.x * blockDim.x + threadIdx.x; i < SEGT * 64; i += gridDim.x * blockDim.x) { const int s = i >> 6, v = i & 63, b = 1, h = 3; const size_t row = (size_t)b * SEGT + s;
        const float r0 = scratch[(size_t)s * 64 + v], r1 = scratch[((size_t)SEGT + s) * 64 + v], g0 = YR[row * 512 + h * 64 + v], g1 = YR[((size_t)M + row) * 512 + h * 64 + v];
        fatomic_max(res + 1, (g0 + g1) - (r0 + r1)); fatomic_max(res + 17, r0 + r1);
        fatomic_max(res + 3, g0 - r0); fatomic_max(res + 19, r0);
        fatomic_max(res + 4, g1 - r1); fatomic_max(res + 20, r1);
        if (s < 64) { fatomic_max(res + 5, g0 - r0); fatomic_max(res + 21, r0); }
        if (s >= 64 && s < 128) { fatomic_max(res + 6, g0 - r0); fatomic_max(res + 22, r0); }
        if (s >= 256 && s < 320) { fatomic_max(res + 7, g0 - r0); fatomic_max(res + 23, r0); }
    }
    for (int i = blockIdx.x * blockDim.x + threadIdx.x; i < SEGT * 128; i += gridDim.x * blockDim.x) { const int s = i >> 7, v = i & 127, b = 2, h = 1; const size_t row = (size_t)b * SEGT + s;
        const float* sg = scratch + (size_t)2 * SEGT * 64;
        const float ref = sg[(size_t)s * 128 + v] + sg[((size_t)SEGT + s) * 128 + v], got = YG[row * 512 + h * 128 + v] + YG[((size_t)M + row) * 512 + h * 128 + v];
        fatomic_max(res + 2, got - ref); fatomic_max(res + 18, ref); }
}
__global__ void probe_out(float* out, const unsigned* res, int selA, int selB) {
    if (blockIdx.x == 0 && threadIdx.x == 0) {
        out[0] = 1.0e5f * __builtin_bit_cast(float, res[selA]) / __builtin_bit_cast(float, res[16 + selA]);
        out[1] = 1.0e5f * __builtin_bit_cast(float, res[selB]) / __builtin_bit_cast(float, res[16 + selB]); }
}
#endif
constexpr int NWAVES = 8, NPH = 3 + 9 * cf::DEPTH;
struct Args { In in; float* out; uchar* ws; int g_lo, g_hi; };
static_assert(sizeof(Args) == 34 * 8 + 8 + 8 + 8, "Args has no padding");

__global__ void __launch_bounds__(NWAVES * 64, 2) fwd(Args args) {
    using namespace cf;
    extern __shared__ __attribute__((aligned(16))) unsigned char lds_raw[];
    LAS uchar* lds = (LAS uchar*)lds_raw;
    const int bx = blockIdx.x, G = gridDim.x, wv = __builtin_amdgcn_readfirstlane(threadIdx.x >> 6);
    auto lane_now = [&]() { unsigned ones = ~0u; asm volatile("" : "+s"(ones)); return (int)__builtin_amdgcn_mbcnt_hi(ones, __builtin_amdgcn_mbcnt_lo(ones, 0u)); };
#define TID() (wv * 64 + lane_now())
    const In& in = args.in;
    volatile LAS unsigned* MISC = (volatile LAS unsigned*)(lds + MISC_OFF);
    { const int tid = threadIdx.x; if (tid < 32) MISC[tid] = 0u; }
    __syncthreads();
    const int g_lo = args.g_lo, g_hi = args.g_hi;
    unsigned* barw = (unsigned*)(args.ws + WS_CTL) + CW_BAR;
    if (g_hi - g_lo > 1) (void)xcd_barrier_post(barw, MISC + 8);
#ifndef PH_MASK
#define PH_MASK 0xfff
#endif
#define PHK(g) ((g) < 3 ? (g) : 3 + ((g) - 3) % 9)
#ifndef DUP_PHASE
#define DUP_PHASE -1
#endif
#define NREP(k) ((DUP_PHASE == (k)) ? 2 : 1)
#define OPQ(v) asm volatile("" : "+v"(v))
#define IN(g) (((PH_MASK >> PHK(g)) & 1) && args.g_lo <= (g) && (g) < args.g_hi)
#ifdef TIMING
#define STAMP(i) do { if (blockIdx.x == 0 && TID() == 0) ((unsigned long long*)(args.ws + 16384))[i] = __builtin_amdgcn_s_memrealtime(); } while (0)
#else
#define STAMP(i) do {} while (0)
#endif
#define SEAM(g) do { if (args.g_lo <= (g) && (g) + 1 < args.g_hi) { XcdBarrier bar_; bar_.bar = (unsigned*)(args.ws + WS_CTL) + CW_BAR; bar_.x = xb_xcc_id(); bar_.st = (volatile LAS unsigned*)(lds + MISC_OFF) + 8; xcd_barrier(bar_); } STAMP((g) + 1); } while (0)

#define OPQS(v) asm volatile("" : "+s"(v))
#define LOCALS int l = lq; OPQS(l); size_t zq_ = 0; OPQS(zq_); uchar* ws = args.ws + zq_; float* X = (float*)(ws + WS_X); bf16* XM = (bf16*)(ws + WS_XM); bf16* P = (bf16*)(ws + WS_P); \
    bf16* CQN = (bf16*)(ws + WS_CQN); bf16* CKVN = (bf16*)(ws + WS_CKVN); bf16* Qb = (bf16*)(ws + WS_Q); bf16* Kb = (bf16*)(ws + WS_K); bf16* Vb = (bf16*)(ws + WS_V); \
    bf16* HFF = (bf16*)(ws + WS_HFF); float* YR = (float*)(ws + WS_YR); float* YG = (float*)(ws + WS_YG); float* GATE = (float*)(ws + WS_GATE); float* BONUS = (float*)(ws + WS_BONUS); \
    const float* MODV = (const float*)(ws + WS_MODV); const float* ROPE = (const float*)(ws + WS_ROPE); const float* modl = MODV + (size_t)l * 5 * MODS; \
    (void)X; (void)XM; (void)P; (void)CQN; (void)CKVN; (void)Qb; (void)Kb; (void)Vb; (void)HFF; (void)YR; (void)YG; (void)GATE; (void)BONUS; (void)ROPE; (void)modl; int t_ = TID(); OPQ(t_);

    STAMP(0);
    if (IN(0)) { const int lq = 0; LOCALS; phase_prologue(in, ws, lds, G, bx, t_); }
#ifdef DUP_PRO
    { XcdBarrier bar_; bar_.bar = (unsigned*)(args.ws + WS_CTL) + CW_BAR; bar_.x = xb_xcc_id(); bar_.st = (volatile LAS unsigned*)(lds + MISC_OFF) + 8; xcd_barrier(bar_); }
    if (IN(0)) { const int lq = 0; LOCALS; phase_prologue(in, ws, lds, G, bx, t_); }
#endif
    SEAM(0);
#ifdef DUP_BAR
    for (int nb_ = 0; nb_ < DUP_BAR; ++nb_) { XcdBarrier bar_; bar_.bar = (unsigned*)(args.ws + WS_CTL) + CW_BAR; bar_.x = xb_xcc_id(); bar_.st = (volatile LAS unsigned*)(lds + MISC_OFF) + 8; xcd_barrier(bar_); }
#endif
    if (IN(1)) { const int lq = 0; LOCALS; phase_modreduce(in, ws, G, bx, t_); }
    SEAM(1);
    if (IN(2)) { const int lq = 0; LOCALS; phase_modulate(X, XM, MODV, 0, D, G, bx, t_); }
    SEAM(2);

#pragma unroll 1
    for (int lq = 0; lq < DEPTH; ++lq) {
        const int g0 = 3 + 9 * lq;
        if (IN(g0 + 0)) for (int rep_ = 0; rep_ < NREP(0); ++rep_) { if (rep_) { XcdBarrier bar_; bar_.bar = (unsigned*)(args.ws + WS_CTL) + CW_BAR; bar_.x = xb_xcc_id(); bar_.st = (volatile LAS unsigned*)(lds + MISC_OFF) + 8; xcd_barrier(bar_); } LOCALS;
            pg8::Gemm g{XM, (const bf16*)(ws + WS_WIN) + (size_t)l * PC * D, M, PC, D, D}; pg8::StaticOrder S; S.init(M, PC, G, bx);
            pg8::EpiStore E{P, PC};
            pg8::gemm_phase<pg8::EpiStore, pg8::StaticOrder, true, true>(lds, g, S, E, t_);
        }
        SEAM(g0 + 0);
        if (IN(g0 + 1)) for (int rep_ = 0; rep_ < NREP(1); ++rep_) { if (rep_) { XcdBarrier bar_; bar_.bar = (unsigned*)(args.ws + WS_CTL) + CW_BAR; bar_.x = xb_xcc_id(); bar_.st = (volatile LAS unsigned*)(lds + MISC_OFF) + 8; xcd_barrier(bar_); } LOCALS;
#ifndef NO_MLAPREP
            mla_prep_rows(P, CQN, CKVN, Kb, in.p[7] + l * 512, in.p[8] + l * 512, ROPE, G, bx, t_);
#endif
            ScanW sw; sw.mu = in.p[11] + l * RW_COLS; sw.w0 = in.p[12] + l * 1024; sw.a0 = in.p[14] + l * 1024; sw.k_k = in.p[17] + l * 512; sw.k_a = in.p[18] + l * 512; sw.r_k = in.p[19] + l * 512;
            sw.W2T = (const bf16*)(ws + WS_W2T) + (size_t)l * 2 * 512 * 32; sw.A2T = (const bf16*)(ws + WS_A2T) + (size_t)l * 2 * 512 * 32; sw.G2T = (const bf16*)(ws + WS_G2T) + (size_t)l * 512 * 96;
            sw.conv = in.p[22] + l * 5 * 1536; sw.a_log = in.p[23] + l * 8; sw.dt_bias = in.p[24] + l * 8;
            {
                const int combo = bx & 15, h = combo >> 1, dir = combo & 1, nbl = (G >> 4) > 0 ? (G >> 4) : 1;
                int j = bx >> 4; unsigned chk = 0u;
                { int tw = TID(); OPQ(tw); rw_stage_weights(lds, sw, h, dir, tw); }

#pragma unroll 1
                for (; j < 272; j += nbl) { int tt = TID(); OPQ(tt);
#ifndef NO_S1R
                    const int jr = 271 - j;
                    const int b = jr / NCH, ci = jr % NCH, jn = (j + nbl < 272) ? j + nbl : j, tk = ((b * 8 + h) * 2 + dir) * NCH + ci;
                    s1_rwkv(lds, P, sw, ws + WS_RWT + (size_t)tk * RW_TASK, GATE, BONUS + (size_t)dir * M * 8, b, h, dir, ci, tt, chk, (271 - jn) / NCH, (271 - jn) % NCH);
#ifdef DUP_S1R
                    OPQ(tt); s1_rwkv(lds, P, sw, ws + WS_RWT + (size_t)tk * RW_TASK, GATE, BONUS + (size_t)dir * M * 8, b, h, dir, ci, tt, chk, (271 - jn) / NCH, (271 - jn) % NCH);
#endif
#endif
                }
                if (chk == 0x9e3779b9u) ((unsigned*)(ws + WS_CTL))[32] = chk;
            }
            {
                const int combo = bx & 7, h = combo >> 1, dir = combo & 1, nbl = (G >> 3) > 0 ? (G >> 3) : 1;
                __syncthreads();
                { int tw = TID(); OPQ(tw); gd_stage_weights(lds, sw, h, tw); }
#pragma unroll 1
                for (int j = bx >> 3; j < 272; j += nbl) { int tt = TID(); OPQ(tt);
#ifndef NO_S1G
                    const int jr = 271 - j, b = jr / NCH, ci = jr % NCH, tg = ((b * 4 + h) * 2 + dir) * NCH + ci;
                    s1_gdn(lds, P, sw, ws + WS_GDT + (size_t)tg * GD_TASK, b, h, dir, ci, tt);
#ifdef DUP_S1G
                    OPQ(tt); s1_gdn(lds, P, sw, ws + WS_GDT + (size_t)tg * GD_TASK, b, h, dir, ci, tt);
#endif
#endif
                }
            }
        }
        SEAM(g0 + 1);
        if (IN(g0 + 2)) for (int rep_ = 0; rep_ < NREP(2); ++rep_) { if (rep_) { XcdBarrier bar_; bar_.bar = (unsigned*)(args.ws + WS_CTL) + CW_BAR; bar_.x = xb_xcc_id(); bar_.st = (volatile LAS unsigned*)(lds + MISC_OFF) + 8; xcd_barrier(bar_); } LOCALS;
            const bool split = G >= 256;
#pragma unroll 1
#ifdef DUP_S2
            for (int rs_ = 0; rs_ < 2; ++rs_)
#endif
            for (int s = bx; s < 128; s += (split ? 1 << 20 : G)) {
#ifndef NO_S2R
                if (s < 64) { const int b = s >> 4, h = (s >> 1) & 7, dir = s & 1;
                    s2n_scan<64, true>(lds, ws + WS_RWT + (size_t)(((b * 8 + h) * 2 + dir) * NCH) * RW_TASK, RW_TASK, 0, 8192, 16384, 24576, 32768, 2, 0,
                                      YR + (size_t)dir * M * 512, h * 64, b, dir, t_); }
#endif
#ifndef NO_S2G
                if (s >= 64) { const int g = s - 64, vs = g & 1, dir = (g >> 1) & 1, h = (g >> 2) & 3, b = g >> 4;
                    s2n_scan<128, false>(lds, ws + WS_GDT + (size_t)(((b * 4 + h) * 2 + dir) * NCH) * GD_TASK, GD_TASK, 0, 32768, 49152, 81920, 98304, 4, vs,
                                        YG + (size_t)dir * M * 512, h * 128 + vs * 64, b, dir, t_); }
#endif
                __syncthreads();
            }
            OPQ(t_);
#ifndef NO_UPGEMM
            if (!split || bx >= 128) { const int Gg = split ? G - 128 : G, cg = split ? bx - 128 : bx;
#ifdef DUP_UPG
                for (int rg_ = 0; rg_ < 2; ++rg_) {
#endif
                { pg8::Gemm g{CQN, (const bf16*)(ws + WS_WUQ) + (size_t)l * 1536 * 512, M, 1536, 512, 512}; pg8::StaticOrder S; S.init(M, 1536, Gg, cg);
                  pg8::EpiStore E{Qb, QP}; pg8::gemm_phase<pg8::EpiStore, pg8::StaticOrder, true, true>(lds, g, S, E, t_); }
                __syncthreads(); OPQ(t_);
                { pg8::Gemm g{CKVN, (const bf16*)(ws + WS_WUKV) + (size_t)l * 2048 * 512, M, 2048, 512, 512}; pg8::StaticOrder S; S.init(M, 2048, Gg, cg);
                  pg8::EpiKV E{Kb, Vb}; pg8::gemm_phase<pg8::EpiKV, pg8::StaticOrder, true, true>(lds, g, S, E, t_); }
#ifdef DUP_UPG
                __syncthreads(); OPQ(t_); }
#endif
            }
#endif
        }
        SEAM(g0 + 2);
        if (IN(g0 + 3)) for (int rep_ = 0; rep_ < NREP(3); ++rep_) { if (rep_) { XcdBarrier bar_; bar_.bar = (unsigned*)(args.ws + WS_CTL) + CW_BAR; bar_.x = xb_xcc_id(); bar_.st = (volatile LAS unsigned*)(lds + MISC_OFF) + 8; xcd_barrier(bar_); } LOCALS;
#ifndef NO_MIXROWS
            mix_rows(P, YR, YG, GATE, BONUS, XM, in.p[11] + l * RW_COLS, in.p[20] + l * 512, in.p[21] + l * 512, in.p[25] + l * 128, G, bx, t_);
#endif
#ifndef NO_ATTN
            const int nunits = 512 + (l < DEPTH - 1 ? 32 : 0);
#pragma unroll 1
            for (int u = bx; u < nunits; u += G) { int tt = TID(); OPQ(tt);
                if (u < 512) { const int x = u & 7, j = u >> 3, bh = x + 8 * (j >> 4), qb = j & 15, b = bh >> 3, h = bh & 7;
                    const size_t qrow = (size_t)b * SEGT + CTX + qb * 256, krow = (size_t)b * SEGT;
                    at::attn_unit(Qb + qrow * QP + h * 192, Kb + krow * KP + h * 192, Vb + krow * VP + h * 128, XM + qrow * D + h * 128, SEGT, ROPE, qb * 256, (LAS char*)lds, tt); }
                else { const int bh = u - 512, b = bh >> 3, h = bh & 7; const size_t qrow = (size_t)b * SEGT;
                    at::attn_unit(Qb + qrow * QP + h * 192, Kb + qrow * KP + h * 192, Vb + qrow * VP + h * 128, XM + qrow * D + h * 128, CTX, nullptr, 0, (LAS char*)lds, tt); }
            }
#endif
        }
        SEAM(g0 + 3);
        if (IN(g0 + 4)) for (int rep_ = 0; rep_ < NREP(4); ++rep_) { if (rep_) { XcdBarrier bar_; bar_.bar = (unsigned*)(args.ws + WS_CTL) + CW_BAR; bar_.x = xb_xcc_id(); bar_.st = (volatile LAS unsigned*)(lds + MISC_OFF) + 8; xcd_barrier(bar_); } LOCALS;
            { pg8::Gemm g{XM, (const bf16*)(ws + WS_WOUT) + (size_t)l * D * D, M, D, D, D}; pg8::LatOrder S; S.init(D, G, bx);
              float alpha_ = ALPHA; OPQ(alpha_); pg8::EpiRes E{X, modl + 2 * D, MODS, alpha_};
              pg8::gemm_phase<pg8::EpiRes, pg8::LatOrder, true, true>(lds, g, S, E, t_);
#ifdef DUP_E
              __syncthreads(); OPQ(t_); { pg8::EpiStore E2{(bf16*)(ws + WS_HFF), D}; pg8::gemm_phase<pg8::EpiStore, pg8::LatOrder, true, true>(lds, g, S, E2, t_); }
#endif
            }
            if (l < DEPTH - 1) { __syncthreads(); OPQ(t_);
              pg8::Gemm g{XM, (const bf16*)(ws + WS_WOUT) + (size_t)l * D * D, M, D, D / 8, D}; pg8::CtxSplitOrder S; S.init(D, 8, D / 8, G, bx);
              pg8::EpiPart E{(float*)(ws + WS_PART)};
              pg8::gemm_phase<pg8::EpiPart, pg8::CtxSplitOrder, true, true>(lds, g, S, E, t_); }
        }
        SEAM(g0 + 4);
        if (IN(g0 + 5)) for (int rep_ = 0; rep_ < NREP(5); ++rep_) { if (rep_) { XcdBarrier bar_; bar_.bar = (unsigned*)(args.ws + WS_CTL) + CW_BAR; bar_.x = xb_xcc_id(); bar_.st = (volatile LAS unsigned*)(lds + MISC_OFF) + 8; xcd_barrier(bar_); } LOCALS; phase_ln(X, in.p[27] + l * D, in.p[28] + l * D, XM, modl, 3 * D, 4 * D, nullptr, (l < DEPTH - 1) ? (const float*)(ws + WS_PART) : nullptr, 8, modl + 4 * MODS + 2 * D, l == DEPTH - 1, G, bx, t_);
#ifdef DUP_LN
            { XcdBarrier bar_; bar_.bar = (unsigned*)(args.ws + WS_CTL) + CW_BAR; bar_.x = xb_xcc_id(); bar_.st = (volatile LAS unsigned*)(lds + MISC_OFF) + 8; xcd_barrier(bar_); }
            OPQ(t_); phase_ln(X, in.p[27] + l * D, in.p[28] + l * D, XM, modl, 3 * D, 4 * D, (float*)(ws + WS_Q), nullptr, 0, nullptr, true, G, bx, t_);
#endif
        }
        SEAM(g0 + 5);
        if (IN(g0 + 6)) for (int rep_ = 0; rep_ < NREP(6); ++rep_) { if (rep_) { XcdBarrier bar_; bar_.bar = (unsigned*)(args.ws + WS_CTL) + CW_BAR; bar_.x = xb_xcc_id(); bar_.st = (volatile LAS unsigned*)(lds + MISC_OFF) + 8; xcd_barrier(bar_); } LOCALS;
            pg8::Gemm g{XM, (const bf16*)(ws + WS_WGU) + (size_t)l * 2 * DFF * D, M, 2 * DFF, D, D}; pg8::EpiSwiGLU E{HFF, DFF};
            if (l < DEPTH - 1) { pg8::StaticOrder S; S.init(M, 2 * DFF, G, bx); pg8::gemm_phase<pg8::EpiSwiGLU, pg8::StaticOrder, true, true>(lds, g, S, E, t_); }
            else { pg8::LatOrder S; S.init(2 * DFF, G, bx); pg8::gemm_phase<pg8::EpiSwiGLU, pg8::LatOrder, true, true>(lds, g, S, E, t_); }
        }
        SEAM(g0 + 6);
        if (IN(g0 + 7)) for (int rep_ = 0; rep_ < NREP(7); ++rep_) { if (rep_) { XcdBarrier bar_; bar_.bar = (unsigned*)(args.ws + WS_CTL) + CW_BAR; bar_.x = xb_xcc_id(); bar_.st = (volatile LAS unsigned*)(lds + MISC_OFF) + 8; xcd_barrier(bar_); } LOCALS;
            { pg8::Gemm g{HFF, (const bf16*)(ws + WS_WDN) + (size_t)l * D * DFF, M, D, DFF, DFF}; pg8::LatOrder S; S.init(D, G, bx);
              float alpha_ = ALPHA; OPQ(alpha_); pg8::EpiRes E{X, modl + 5 * D, MODS, alpha_};
              pg8::gemm_phase<pg8::EpiRes, pg8::LatOrder, true, true>(lds, g, S, E, t_);
#ifdef DUP_H
              __syncthreads(); OPQ(t_); { pg8::EpiStore E2{(bf16*)(ws + WS_Q), D}; pg8::gemm_phase<pg8::EpiStore, pg8::LatOrder, true, true>(lds, g, S, E2, t_); }
#endif
            }
            if (l < DEPTH - 1) { __syncthreads(); OPQ(t_);
              pg8::Gemm g{HFF, (const bf16*)(ws + WS_WDN) + (size_t)l * D * DFF, M, D, DFF / 4, DFF}; pg8::CtxSplitOrder S; S.init(D, 4, DFF / 4, G, bx);
              pg8::EpiPart E{(float*)(ws + WS_PART)};
              pg8::gemm_phase<pg8::EpiPart, pg8::CtxSplitOrder, true, true>(lds, g, S, E, t_); }
        }
        SEAM(g0 + 7);
        if (IN(g0 + 8)) for (int rep_ = 0; rep_ < NREP(8); ++rep_) { if (rep_) { XcdBarrier bar_; bar_.bar = (unsigned*)(args.ws + WS_CTL) + CW_BAR; bar_.x = xb_xcc_id(); bar_.st = (volatile LAS unsigned*)(lds + MISC_OFF) + 8; xcd_barrier(bar_); } LOCALS;
            if (l < DEPTH - 1) phase_ln(X, in.p[32] + l * D, in.p[33] + l * D, XM, modl + 5 * MODS, 0, D, nullptr, (const float*)(ws + WS_PART), 4, modl + 4 * MODS + 5 * D, false, G, bx, t_);
            else phase_ln(X, in.p[32] + l * D, in.p[33] + l * D, XM, modl, 0, D, args.out, nullptr, 0, nullptr, true, G, bx, t_);
        }
        SEAM(g0 + 8);
    }
#ifdef TIMING
    __syncthreads();
    if (blockIdx.x == 0 && TID() == 0) { const unsigned long long* st = (const unsigned long long*)(args.ws + 16384); unsigned long long tot = 0;
        for (int g = 0; g < NPH; ++g) { const int cls = g < 3 ? 0 : 1 + (g - 3) % 9; if ((TIMING >> cls) & 1) tot += st[g + 1] - st[g]; }
        args.out[0] = (float)tot * 0.01f; }
#endif
#undef IN
#undef SEAM
}


#if defined(DBG_STOP)
__global__ void dbg_dump(float* out, const unsigned char* ws, int kind, size_t off, int pitch, size_t stride) {
    const size_t n = (size_t)cf::NB * cf::SEQ * cf::D;
    for (size_t i = (size_t)blockIdx.x * blockDim.x + threadIdx.x; i < n; i += (size_t)gridDim.x * blockDim.x) {
        const size_t rr = i / cf::D, c = i % cf::D, b = rr / cf::SEQ, t = rr % cf::SEQ, row = b * cf::SEGT + cf::CTX + t;
        float v;
        if (kind == 0) v = ((const float*)(ws + WS_X))[row * cf::D + c];
        else if (kind == 1) v = bf2f(((const bf16*)(ws + off))[row * (size_t)pitch + c]);
        else if (kind == 3) v = ((const float*)(ws + off))[(i * stride)];
        else if (kind == 4) v = ((const float*)(ws + off))[i % ((size_t)pitch * 1024)];
        else v = bf2f(((const bf16*)(ws + off))[i * stride]);
        if (!(fabsf(v) < 3.0e38f)) v = 1.0e30f;
        out[i] = v;
    }
}
#endif
#ifndef MK_MULTI
#define MK_MULTI 0
#endif
extern "C" void kernel_launch(void* const* d_in, const int* in_sizes, int n_in, void* d_out, int out_size, void* d_ws, size_t ws_size, hipStream_t stream) {
    static int grid = 0;
    if (grid == 0) {
        if (n_in != 34 || out_size != cf::NB * cf::SEQ * cf::D || ws_size < WS_END) { fprintf(stderr, "kernel_launch: shape mismatch (n_in %d out %d ws %zu)\n", n_in, out_size, ws_size); grid = -1; return; }
        int dev = 0, cus = 0;
        if (hipGetDevice(&dev) != hipSuccess || hipDeviceGetAttribute(&cus, hipDeviceAttributeMultiprocessorCount, dev) != hipSuccess) { grid = -1; return; }
        if (hipFuncSetAttribute((const void*)fwd, hipFuncAttributeMaxDynamicSharedMemorySize, LDS_BYTES) != hipSuccess) { fprintf(stderr, "kernel_launch: hipFuncSetAttribute failed\n"); grid = -1; return; }
        int per_cu = 0;
        if (hipOccupancyMaxActiveBlocksPerMultiprocessor(&per_cu, (const void*)fwd, NWAVES * 64, LDS_BYTES) != hipSuccess || per_cu < 1) fprintf(stderr, "kernel_launch: occupancy query says %d\n", per_cu);
        (void)hipGetLastError();
        grid = cus;
    }
    if (grid < 0) return;
    (void)hipMemsetAsync((char*)d_ws, 0, ZERO_BYTES, stream);
    Args a{};
    for (int i = 0; i < 34; ++i) a.in.p[i] = (const float*)d_in[i];
    a.out = (float*)d_out; a.ws = (uchar*)d_ws;
#if defined(PROBE)
    for (int g = 0; g < 7; ++g) { a.g_lo = g; a.g_hi = g + 1; hipLaunchKernelGGL(fwd, dim3(grid), dim3(NWAVES * 64), LDS_BYTES, stream, a); }
    { unsigned* res = (unsigned*)d_ws + 64; float* scratch = (float*)((char*)d_ws + WS_HFF + (400ull << 20));
      scratch = (float*)((char*)d_ws + WS_END);
      hipLaunchKernelGGL(probe, dim3(12), dim3(256), 0, stream, a.in, (uchar*)d_ws, res, scratch);
      hipLaunchKernelGGL(probe_cmp, dim3(256), dim3(256), 0, stream, (uchar*)d_ws, res, (const float*)scratch);
      for (int g = 7; g < NPH; ++g) { a.g_lo = g; a.g_hi = g + 1; hipLaunchKernelGGL(fwd, dim3(grid), dim3(NWAVES * 64), LDS_BYTES, stream, a); }
      hipLaunchKernelGGL(probe_out, dim3(1), dim3(64), 0, stream, (float*)d_out, (const unsigned*)res, PROBE_SELA, PROBE_SELB); }
#elif defined(DBG_STOP)
    for (int g = 0; g < DBG_STOP; ++g) { a.g_lo = g; a.g_hi = g + 1; hipLaunchKernelGGL(fwd, dim3(grid), dim3(NWAVES * 64), LDS_BYTES, stream, a); }
    hipLaunchKernelGGL(dbg_dump, dim3(2048), dim3(256), 0, stream, (float*)d_out, (const unsigned char*)d_ws, DBG_KIND, (size_t)DBG_OFF, DBG_PITCH, (size_t)DBG_STRIDE);
#elif MK_MULTI
    for (int g = 0; g < NPH; ++g) { a.g_lo = g; a.g_hi = g + 1; hipLaunchKernelGGL(fwd, dim3(grid), dim3(NWAVES * 64), LDS_BYTES, stream, a); }
#else
    a.g_lo = 0; a.g_hi = NPH;
    hipLaunchKernelGGL(fwd, dim3(grid), dim3(NWAVES * 64), LDS_BYTES, stream, a);
#endif
    const hipError_t le = hipPeekAtLastError();
    if (le != hipSuccess) fprintf(stderr, "kernel_launch: launch failed: %s\n", hipGetErrorName(le));
}
```

```cpp
#include <hip/hip_runtime.h>
#include <cstdio>
#include <cstdint>

#define DI __device__ __forceinline__
#define LAS __attribute__((address_space(3)))
#define GAS __attribute__((address_space(1)))
typedef unsigned short bf16;
typedef short bf16x8 __attribute__((ext_vector_type(8)));
typedef short s16x4 __attribute__((ext_vector_type(4)));
typedef float f32x4 __attribute__((ext_vector_type(4)));
typedef float f32x2 __attribute__((ext_vector_type(2)));
typedef float f32x16 __attribute__((ext_vector_type(16)));
typedef unsigned u32x4 __attribute__((ext_vector_type(4)));
typedef unsigned u32x2 __attribute__((ext_vector_type(2)));
typedef unsigned char uchar;
typedef __bf16 bf16x2_t __attribute__((ext_vector_type(2)));

namespace pg8 {
typedef unsigned short bf16_t;
#define PG8_LAS __attribute__((address_space(3)))
constexpr int BM = 256, BK = 64, HALF = 128, HTB = HALF * BK * 2  , STAGE_BYTES = 8 * HTB, NXCD = 8, WGM = 8;

__host__ __device__ __forceinline__ int lds_byte(int r, int c) { const int st = (r >> 4) * 2 + (c >> 5), rr = r & 15, cc = c & 31, ob = rr * 64 + cc * 2; return st * 1024 + (ob ^ (((ob >> 9) & 1) << 5)); }
__host__ __device__ __forceinline__ void stage_rc(int b, int& R, int& C) { const int st = b / 1024, sb = b % 1024, swz = sb ^ (((sb >> 9) & 1) << 5); R = (st >> 1) * 16 + swz / 64; C = (st & 1) * 32 + (swz % 64) / 2; }
__host__ __device__ __forceinline__ int perm32(int rho) { const int n = rho >> 4, i = rho & 15; return 8 * (i >> 2) + 4 * n + (i & 3); }

struct Unit { int pm, pn, ko, ks; };
struct Gemm { const bf16_t* A; const bf16_t* Bt; int M, N, K, ld; };

struct StaticOrder {
    int nM, nN, nwg, G, c;
    __host__ __device__ void init(int M, int N, int G_, int c_) { nM = M / BM; nN = N / BM; nwg = nM * nN; G = G_; c = c_; }
    __host__ __device__ bool next(int i, Unit& u) const {
        const long L = (long)i * G + c; if (L >= nwg) return false;
        int wgid = (int)L; { const int q = nwg / NXCD, r = nwg % NXCD, xcd = wgid % NXCD, off = wgid / NXCD; wgid = (xcd < r ? xcd * (q + 1) : r * (q + 1) + (xcd - r) * q) + off; }
        const int nig = WGM * nN, gid = wgid / nig, fm = gid * WGM, gsz = (nM - fm) < WGM ? (nM - fm) : WGM;
        u.pm = fm + ((wgid % nig) % gsz); u.pn = (wgid % nig) / gsz; u.ko = 0; u.ks = 0; return true;
    }
    __device__ __forceinline__ void a_ready(const Unit&) const {}
    __device__ __forceinline__ void done(const Unit&) const {}
};

struct LatOrder {
    StaticOrder S;
    __host__ __device__ void init(int N, int G_, int c_) { S.init(16384, N, G_, c_); }
    __host__ __device__ bool next(int i, Unit& u) const { if (!S.next(i, u)) return false; u.pm = (u.pm >> 4) * 17 + 1 + (u.pm & 15); return true; }
    __device__ __forceinline__ void a_ready(const Unit&) const {}
    __device__ __forceinline__ void done(const Unit&) const {}
};
struct CtxSplitOrder {
    int nN, KS, kbytes, G, c;
    __host__ __device__ void init(int N, int KS_, int Ksplit, int G_, int c_) { nN = N / BM; KS = KS_; kbytes = Ksplit * 2; G = G_; c = c_; }
    __host__ __device__ bool next(int i, Unit& u) const { const int j = i * G + c; if (j >= 4 * nN * KS) return false;
        const int ks = j % KS, cu = j / KS; u.pm = (cu / nN) * 17; u.pn = cu % nN; u.ks = ks; u.ko = ks * kbytes; return true; }
    __device__ __forceinline__ void a_ready(const Unit&) const {}
    __device__ __forceinline__ void done(const Unit&) const {}
};
__device__ __forceinline__ unsigned cvt_pk_bf16(float lo, float hi) { const f32x2 v = {lo, hi}; return __builtin_bit_cast(unsigned, __builtin_convertvector(v, bf16x2_t)); }
__device__ __forceinline__ u32x4 pack8(f32x4 v0, f32x4 v1) { u32x4 w; w.x = cvt_pk_bf16(v0[0], v0[1]); w.y = cvt_pk_bf16(v0[2], v0[3]); w.z = cvt_pk_bf16(v1[0], v1[1]); w.w = cvt_pk_bf16(v1[2], v1[3]); return w; }

struct EpiStore {
    static constexpr bool PERM = true, AFTER_DRAIN = false;
    bf16_t* O; int ldc;
    __device__ __forceinline__ void operator()(const f32x4 (&acc)[2][2][4][2], const Unit& u, int wr, int wc, int fr, int fq) const {
        const int row0 = u.pm * BM + wr * 64 + fr, col0 = u.pn * BM + wc * 32 + 8 * fq;
#pragma unroll
        for (int ai = 0; ai < 2; ++ai)
#pragma unroll
            for (int m = 0; m < 4; ++m) { bf16_t* rowp = O + (size_t)(row0 + ai * HALF + m * 16) * ldc + col0;
#pragma unroll
                for (int bj = 0; bj < 2; ++bj) *(u32x4*)(rowp + bj * HALF) = pack8(acc[ai][bj][m][0], acc[ai][bj][m][1]); }
    }
};
struct EpiKV {
    static constexpr bool PERM = true, AFTER_DRAIN = false;
    bf16_t* Kb; bf16_t* Vb;
    __device__ __forceinline__ void operator()(const f32x4 (&acc)[2][2][4][2], const Unit& u, int wr, int wc, int fr, int fq) const {
        const int row0 = u.pm * BM + wr * 64 + fr, c0 = wc * 32 + 8 * fq;
#pragma unroll
        for (int ai = 0; ai < 2; ++ai)
#pragma unroll
            for (int m = 0; m < 4; ++m) { const size_t row = (size_t)(row0 + ai * HALF + m * 16);
                *(u32x4*)(Kb + row * 1536 + u.pn * 192 + c0) = pack8(acc[ai][0][m][0], acc[ai][0][m][1]);
                *(u32x4*)(Vb + row * 1024 + u.pn * 128 + c0) = pack8(acc[ai][1][m][0], acc[ai][1][m][1]); }
    }
};
struct EpiSwiGLU {
    static constexpr bool PERM = true, AFTER_DRAIN = false;
    bf16_t* Hb; int ldh;
    __device__ __forceinline__ void operator()(const f32x4 (&acc)[2][2][4][2], const Unit& u, int wr, int wc, int fr, int fq) const {
        const int row0 = u.pm * BM + wr * 64 + fr, col0 = u.pn * HALF + wc * 32 + 8 * fq;
#pragma unroll
        for (int ai = 0; ai < 2; ++ai)
#pragma unroll
            for (int m = 0; m < 4; ++m) { f32x4 o[2];
#pragma unroll
                for (int n = 0; n < 2; ++n) { const f32x4 g = acc[ai][0][m][n], up = acc[ai][1][m][n];
#pragma unroll
                    for (int e = 0; e < 4; ++e) o[n][e] = g[e] * __builtin_amdgcn_rcpf(1.f + __expf(-g[e])) * up[e]; }
                *(u32x4*)(Hb + (size_t)(row0 + ai * HALF + m * 16) * ldh + col0) = pack8(o[0], o[1]); }
    }
};
struct EpiPart {
    static constexpr bool PERM = true, AFTER_DRAIN = false;
    float* part;
    __device__ __forceinline__ void operator()(const f32x4 (&acc)[2][2][4][2], const Unit& u, int wr, int wc, int fr, int fq) const {
        const int row0 = (u.pm / 17) * BM + wr * 64 + fr, col0 = u.pn * BM + wc * 32 + 8 * fq;
        float* base = part + (size_t)u.ks * 1024 * 2048;
#pragma unroll
        for (int ai = 0; ai < 2; ++ai)
#pragma unroll
            for (int m = 0; m < 4; ++m) { float* rowp = base + (size_t)(row0 + ai * HALF + m * 16) * 2048 + col0;
#pragma unroll
                for (int bj = 0; bj < 2; ++bj)
#pragma unroll
                    for (int n = 0; n < 2; ++n) *(f32x4*)(rowp + bj * HALF + 4 * n) = acc[ai][bj][m][n]; }
    }
};
struct EpiRes {
    static constexpr bool PERM = true, AFTER_DRAIN = false;
    float* X; const float* gate; int gstride; float alpha;
    __device__ __forceinline__ void operator()(const f32x4 (&acc)[2][2][4][2], const Unit& u, int wr, int wc, int fr, int fq) const {
        const int row0 = u.pm * BM + wr * 64 + fr, col0 = u.pn * BM + wc * 32 + 8 * fq;
        const int vec = (u.pm % 17 == 0) ? 4 : (u.pm / 17);
        const float* gp = gate + (size_t)vec * gstride + col0;
        f32x4 gv[2][2];
#pragma unroll
        for (int bj = 0; bj < 2; ++bj)
#pragma unroll
            for (int n = 0; n < 2; ++n) gv[bj][n] = *(const f32x4*)(gp + bj * HALF + 4 * n);
#pragma unroll
        for (int ai = 0; ai < 2; ++ai)
#pragma unroll
            for (int m = 0; m < 4; ++m) { float* rowp = X + (size_t)(row0 + ai * HALF + m * 16) * 2048 + col0;
#pragma unroll
                for (int bj = 0; bj < 2; ++bj)
#pragma unroll
                    for (int n = 0; n < 2; ++n) { f32x4* p = (f32x4*)(rowp + bj * HALF + 4 * n); const f32x4 x = *p; *p = x * alpha + gv[bj][n] * acc[ai][bj][m][n]; } }
    }
};

template <class Epi, class Sched, bool ALIGN_EPI = false, bool SP2 = false>
__device__ __forceinline__ void gemm_phase(PG8_LAS unsigned char* lds, const Gemm g, const Sched& S, const Epi& E, const int tid) {
    const int wid = __builtin_amdgcn_readfirstlane(tid >> 6), lane = tid & 63, wr = wid >> 2, wc = wid & 3, fr = lane & 15, fq = lane >> 4;
    const int K = g.ld, nt = g.K / BK;
    unsigned voffA[2], voffB[2];
#pragma unroll
    for (int i = 0; i < 2; ++i) { int R, C; stage_rc(tid * 16 + i * 8192, R, C); const int Rb = Epi::PERM ? ((R & ~31) + perm32(R & 31)) : R;
        voffA[i] = (unsigned)(R * K + C) * 2u; voffB[i] = (unsigned)(Rb * K + C) * 2u; }
    const size_t kstep = (size_t)(BK * 2);
    const size_t hstep = (size_t)HALF * K * 2;
    const size_t tstep = 2 * hstep;
    const unsigned ldsw = (unsigned)wid * 1024u;
    const int aoff = lds_byte(wr * 64 + fr, fq * 8), boff = lds_byte(wc * 32 + fr, fq * 8);
#define PG8_SA(b, h) (((b) * 2 + (h)) * HTB)
#define PG8_SB(b, h) ((4 + (b) * 2 + (h)) * HTB)
#define PG8_STAGE(bufoff, gbase, voff) do { _Pragma("unroll") for (int _i = 0; _i < 2; ++_i) \
        __builtin_amdgcn_global_load_lds((const unsigned*)((const char*)(gbase) + (voff)[_i]), (PG8_LAS unsigned*)(lds + (bufoff) + ldsw + _i * 8192), 16, 0, 0); } while (0)
#define PG8_LDA(dst, b, h) do { _Pragma("unroll") for (int m = 0; m < 4; ++m) _Pragma("unroll") for (int k = 0; k < 2; ++k) dst[m][k] = *(const PG8_LAS bf16x8*)(lds + PG8_SA(b, h) + aoff + m * 2048 + k * 1024); } while (0)
#define PG8_LDB(dst, b, h) do { _Pragma("unroll") for (int n = 0; n < 2; ++n) _Pragma("unroll") for (int k = 0; k < 2; ++k) dst[n][k] = *(const PG8_LAS bf16x8*)(lds + PG8_SB(b, h) + boff + n * 2048 + k * 1024); } while (0)
#define PG8_MMA(ai, bj, At, Bt) do { __builtin_amdgcn_s_setprio(1); _Pragma("unroll") for (int m = 0; m < 4; ++m) _Pragma("unroll") for (int n = 0; n < 2; ++n) _Pragma("unroll") for (int k = 0; k < 2; ++k) \
        acc[ai][bj][m][n] = __builtin_amdgcn_mfma_f32_16x16x32_bf16(Bt[n][k], At[m][k], acc[ai][bj][m][n], 0, 0, 0); __builtin_amdgcn_s_setprio(0); } while (0)
#define PG8_WAIT_V(n) asm volatile("s_waitcnt vmcnt(" #n ")" ::: "memory")
#define PG8_WAIT_L(n) asm volatile("s_waitcnt lgkmcnt(" #n ")" ::: "memory")
#define PG8_BAR __builtin_amdgcn_s_barrier()
#define PG8_SCHED __builtin_amdgcn_sched_barrier(0)
    Unit cur, nxt; int ui = 0;
    if (!S.next(0, cur)) return;
    f32x4 acc[2][2][4][2];
#pragma unroll
    for (int a = 0; a < 2; ++a)
#pragma unroll
        for (int b = 0; b < 2; ++b)
#pragma unroll
            for (int m = 0; m < 4; ++m)
#pragma unroll
                for (int n = 0; n < 2; ++n) acc[a][b][m][n] = (f32x4){0.f, 0.f, 0.f, 0.f};
    bf16x8 At[4][2], B0[2][2], B1[2][2];
    const char* cA = (const char*)g.A + (size_t)cur.pm * tstep + cur.ko; const char* cB = (const char*)g.Bt + (size_t)cur.pn * tstep + cur.ko;
    S.a_ready(cur);
    if constexpr (SP2) {
        PG8_STAGE(PG8_SB(0, 0), cB, voffB); PG8_STAGE(PG8_SB(0, 1), cB + hstep, voffB); PG8_STAGE(PG8_SA(0, 0), cA, voffA); PG8_STAGE(PG8_SA(0, 1), cA + hstep, voffA);
        if (wr == 1) PG8_BAR;
        PG8_WAIT_V(2); PG8_BAR;
        PG8_STAGE(PG8_SB(1, 0), cB + kstep, voffB); PG8_STAGE(PG8_SA(1, 0), cA + kstep, voffA); PG8_STAGE(PG8_SB(1, 1), cB + hstep + kstep, voffB);
        PG8_WAIT_V(6); PG8_BAR;
    } else {
        PG8_STAGE(PG8_SB(0, 0), cB, voffB); PG8_STAGE(PG8_SA(0, 0), cA, voffA); PG8_STAGE(PG8_SB(0, 1), cB + hstep, voffB); PG8_STAGE(PG8_SA(0, 1), cA + hstep, voffA);
        if (wr == 1) PG8_BAR;
        PG8_WAIT_V(4); PG8_BAR;
        PG8_STAGE(PG8_SB(1, 0), cB + kstep, voffB); PG8_STAGE(PG8_SA(1, 0), cA + kstep, voffA); PG8_STAGE(PG8_SB(1, 1), cB + hstep + kstep, voffB);
        PG8_WAIT_V(6); PG8_BAR;
    }
    for (;;) {
        const bool has_next = S.next(ui + 1, nxt);
        const char* nA = has_next ? (const char*)g.A + (size_t)nxt.pm * tstep + nxt.ko : cA; const char* nB = has_next ? (const char*)g.Bt + (size_t)nxt.pn * tstep + nxt.ko : cB;
        for (int t = 0; t < nt; t += 2) {
            const bool last = (t == nt - 2);
            const char* a1 = cA + (size_t)(t + 1) * kstep;
            const char* a2 = last ? nA : cA + (size_t)(t + 2) * kstep; const char* b2 = last ? nB : cB + (size_t)(t + 2) * kstep;
            const char* a3 = a2 + kstep; const char* b3 = b2 + kstep;
            if (last && has_next) S.a_ready(nxt);
            if constexpr (SP2) {
            PG8_LDB(B0, 0, 0); PG8_LDB(B1, 0, 1); PG8_SCHED; PG8_LDA(At, 0, 0); PG8_STAGE(PG8_SA(1, 1), a1 + hstep, voffA);
            PG8_WAIT_V(8); PG8_WAIT_L(0); PG8_BAR; PG8_MMA(0, 0, At, B0); PG8_MMA(0, 1, At, B1); PG8_BAR; PG8_SCHED;
            PG8_LDA(At, 0, 1); PG8_STAGE(PG8_SB(0, 0), b2, voffB); PG8_STAGE(PG8_SB(0, 1), b2 + hstep, voffB); PG8_STAGE(PG8_SA(0, 0), a2, voffA);
            PG8_WAIT_V(8); PG8_WAIT_L(0); PG8_BAR; PG8_MMA(1, 0, At, B0); PG8_MMA(1, 1, At, B1); PG8_BAR; PG8_SCHED;
            PG8_LDB(B0, 1, 0); PG8_LDB(B1, 1, 1); PG8_SCHED; PG8_LDA(At, 1, 0); PG8_STAGE(PG8_SA(0, 1), a2 + hstep, voffA);
            PG8_WAIT_V(8); PG8_WAIT_L(0); PG8_BAR; PG8_MMA(0, 0, At, B0); PG8_MMA(0, 1, At, B1); PG8_BAR; PG8_SCHED;
            PG8_LDA(At, 1, 1); PG8_STAGE(PG8_SB(1, 0), b3, voffB); PG8_STAGE(PG8_SB(1, 1), b3 + hstep, voffB); PG8_STAGE(PG8_SA(1, 0), a3, voffA);
            PG8_WAIT_V(8); PG8_WAIT_L(0); PG8_BAR; PG8_MMA(1, 0, At, B0); PG8_MMA(1, 1, At, B1); PG8_BAR; PG8_SCHED;
            } else {
            PG8_LDB(B0, 0, 0); PG8_SCHED; PG8_LDA(At, 0, 0); PG8_STAGE(PG8_SA(1, 1), a1 + hstep, voffA);
            PG8_WAIT_L(8); PG8_BAR; PG8_WAIT_L(0); PG8_MMA(0, 0, At, B0); PG8_BAR; PG8_SCHED;
            PG8_LDB(B1, 0, 1); PG8_STAGE(PG8_SB(0, 0), b2, voffB);
            PG8_BAR; PG8_WAIT_L(0); PG8_MMA(0, 1, At, B1); PG8_BAR;
            PG8_LDA(At, 0, 1); PG8_STAGE(PG8_SA(0, 0), a2, voffA);
            PG8_BAR; PG8_WAIT_L(0); PG8_MMA(1, 0, At, B0); PG8_BAR; PG8_SCHED;
            PG8_STAGE(PG8_SB(0, 1), b2 + hstep, voffB);
            PG8_WAIT_V(6); PG8_BAR; PG8_MMA(1, 1, At, B1); PG8_BAR;
            PG8_LDB(B0, 1, 0); PG8_SCHED; PG8_LDA(At, 1, 0); PG8_STAGE(PG8_SA(0, 1), a2 + hstep, voffA);
            PG8_WAIT_L(8); PG8_BAR; PG8_WAIT_L(0); PG8_MMA(0, 0, At, B0); PG8_BAR; PG8_SCHED;
            PG8_LDB(B1, 1, 1); PG8_STAGE(PG8_SB(1, 0), b3, voffB);
            PG8_BAR; PG8_WAIT_L(0); PG8_MMA(0, 1, At, B1); PG8_BAR;
            PG8_LDA(At, 1, 1); PG8_STAGE(PG8_SA(1, 0), a3, voffA);
            PG8_BAR; PG8_WAIT_L(0); PG8_MMA(1, 0, At, B0); PG8_BAR; PG8_SCHED;
            PG8_STAGE(PG8_SB(1, 1), b3 + hstep, voffB);
            PG8_WAIT_V(6); PG8_BAR; PG8_MMA(1, 1, At, B1); PG8_BAR;
            }
        }
        if constexpr (ALIGN_EPI) { if (wr == 0) PG8_BAR; }
        if constexpr (!Epi::AFTER_DRAIN) { E(acc, cur, wr, wc, fr, fq); S.done(cur); }
        if (!has_next) break;
#pragma unroll
        for (int a = 0; a < 2; ++a)
#pragma unroll
            for (int b = 0; b < 2; ++b)
#pragma unroll
                for (int m = 0; m < 4; ++m)
#pragma unroll
                    for (int n = 0; n < 2; ++n) acc[a][b][m][n] = (f32x4){0.f, 0.f, 0.f, 0.f};
        cur = nxt; cA = nA; cB = nB; ++ui;
        if constexpr (ALIGN_EPI) { if (wr == 1) PG8_BAR; }
    }
    PG8_WAIT_V(0);
    if constexpr (!ALIGN_EPI) { if (wr == 0) PG8_BAR; }
    PG8_BAR;
    if constexpr (Epi::AFTER_DRAIN) { E.fused(acc, cur, wr, wc, fr, fq, lds, wid, lane); S.done(cur); }
#undef PG8_SA
#undef PG8_SB
#undef PG8_STAGE
#undef PG8_LDA
#undef PG8_LDB
#undef PG8_MMA
#undef PG8_WAIT_V
#undef PG8_WAIT_L
#undef PG8_BAR
#undef PG8_SCHED
}
}
namespace cf {
constexpr int D = 2048, NB = 4, SEQ = 4096, CTX = 256, SEGT = 4352, M = 17408, DEPTH = 4;
constexpr int IN_COLS = 4912, PC = 5120;
constexpr int C_CQ = 0, C_CKV = 512, C_KR = 1024, C_RW = 1088, C_GD = 2848;
constexpr int RW_K = 512, RW_V = 1024, RW_WD = 1536, RW_AD = 1600, RW_GD = 1664, RW_COLS = 1760;
constexpr int GD_K = 512, GD_V = 1024, GD_Z = 1536, GD_A = 2048, GD_B = 2056;
constexpr int DFF = 5632, NCH = 68;
constexpr int QP = 1536, KP = 1536, VP = 1024;
constexpr int MODS = 6 * D;
constexpr float ALPHA = 1.681792830507429f;
constexpr int RW_TASK = 33024, GD_TASK = 98816;
}
constexpr size_t MiB = 1u << 20;
constexpr size_t WS_CTL = 0, WS_MODV = 1 * MiB, ZERO_BYTES = 2 * MiB;
constexpr size_t WS_ROPE = 2 * MiB, WS_W2T = 2 * MiB + 65536, WS_A2T = WS_W2T + 262144, WS_G2T = WS_A2T + 262144;
constexpr size_t WS_WIN = 4 * MiB, WS_WOUT = 84 * MiB, WS_WGU = 116 * MiB, WS_WDN = 292 * MiB, WS_WUQ = 380 * MiB, WS_WUKV = 386 * MiB;
constexpr size_t WS_X = 394 * MiB, WS_XM = 530 * MiB;
constexpr size_t WS_P = 598 * MiB, WS_CQN = 768 * MiB, WS_CKVN = 785 * MiB, WS_Q = 802 * MiB, WS_K = 853 * MiB, WS_V = 904 * MiB;
constexpr size_t WS_RWT = 938 * MiB, WS_GDT = 1076 * MiB, WS_YR = 1333 * MiB, WS_YG = 1401 * MiB, WS_GATE = 1469 * MiB, WS_BONUS = 1503 * MiB, WS_END = 1505 * MiB;
constexpr size_t WS_PART = 1076 * MiB;
constexpr size_t WS_HFF = 598 * MiB;
static_assert(WS_RWT + (size_t)4352 * cf::RW_TASK <= WS_GDT && WS_GDT + (size_t)2176 * cf::GD_TASK <= WS_YR && WS_HFF + (size_t)cf::M * cf::DFF * 2 <= WS_CKVN, "ws map");
constexpr int CW_TMO = 0, CW_BAR = 4096;
constexpr int LDS_BYTES = 163840, MISC_OFF = LDS_BYTES - 128;

DI float bflo(unsigned w) { return __builtin_bit_cast(float, w << 16); }
DI float bfhi(unsigned w) { return __builtin_bit_cast(float, w & 0xffff0000u); }
DI float bf2f(bf16 h) { return __builtin_bit_cast(float, (unsigned)h << 16); }
DI unsigned pk2(float lo, float hi) { const f32x2 v = {lo, hi}; return __builtin_bit_cast(unsigned, __builtin_convertvector(v, bf16x2_t)); }
DI bf16 f2bf(float f) { return (bf16)pk2(f, f); }
DI void unpack8(u32x4 w, float (&f)[8]) { f[0] = bflo(w.x); f[1] = bfhi(w.x); f[2] = bflo(w.y); f[3] = bfhi(w.y); f[4] = bflo(w.z); f[5] = bfhi(w.z); f[6] = bflo(w.w); f[7] = bfhi(w.w); }
DI u32x4 pack8f(const float (&f)[8]) { u32x4 w; w.x = pk2(f[0], f[1]); w.y = pk2(f[2], f[3]); w.z = pk2(f[4], f[5]); w.w = pk2(f[6], f[7]); return w; }
template <int X> DI float sx(float v) { return __builtin_bit_cast(float, __builtin_amdgcn_ds_swizzle(__builtin_bit_cast(int, v), 0x1F | (X << 10))); }
DI float lx(float v, int lane, int X) { return __builtin_bit_cast(float, __builtin_amdgcn_ds_bpermute((lane ^ X) << 2, __builtin_bit_cast(int, v))); }
DI float wave_sum(float v, int lane) {
    v += sx<1>(v); v += sx<2>(v); v += sx<4>(v); v += lx(v, lane, 8); v += lx(v, lane, 16); v += lx(v, lane, 32);
    return v;
}
DI float sigmoidf_(float x) { return __builtin_amdgcn_rcpf(1.f + __expf(-x)); }
DI float tanhf_(float x) { return 1.f - 2.f * __builtin_amdgcn_rcpf(1.f + __expf(2.f * x)); }
DI float softplusf_(float x) { const float e = __expf(x); return x > 20.f ? x : (x < -9.f ? e * (1.f - 0.5f * e) : __logf(1.f + e)); }
#define LDS_BARRIER() do { asm volatile("s_waitcnt lgkmcnt(0)" ::: "memory"); __builtin_amdgcn_s_barrier(); asm volatile("" ::: "memory"); } while (0)
#define LDS_WAIT() asm volatile("s_waitcnt lgkmcnt(0)" ::: "memory")
#define MFMA16(a, b, c) __builtin_amdgcn_mfma_f32_16x16x32_bf16((a), (b), (c), 0, 0, 0)

#define XB_TMO      128
#define XB_XCNT(j)  (256  + 64 * (j))
#define XB_XSUB(j)  (1280 + 64 * (j))
#define XB_XGEN(j)  (2304 + 64 * (j))
#define XB_TOP      3328
#define XB_TOPGEN   3392
#define XCD_BAR_WORDS 3456
#define XB_SPIN_CAP (1u << 22)
__device__ __forceinline__ unsigned xb_ld(unsigned* p)              { return __hip_atomic_load(p, __ATOMIC_RELAXED, __HIP_MEMORY_SCOPE_AGENT); }
__device__ __forceinline__ unsigned xb_add(unsigned* p, unsigned v) { return __hip_atomic_fetch_add(p, v, __ATOMIC_RELAXED, __HIP_MEMORY_SCOPE_AGENT); }
__device__ __forceinline__ unsigned xb_xcc_id() { return (unsigned)__builtin_amdgcn_s_getreg((3 << 11) | 20) & 0xFu; }
#define XB_SPIN(cond, bar) do { unsigned _sp = 0; while (cond) { __builtin_amdgcn_s_sleep(1); \
    if ((++_sp & 255u) == 0u) { if (xb_ld(&(bar)[XB_TMO])) break; if (_sp > XB_SPIN_CAP) { atomicAdd(&(bar)[XB_TMO], 1u); break; } } } } while (0)
struct XcdBarrier { unsigned* bar; unsigned x; volatile LAS unsigned* st; };
__device__ __forceinline__ XcdBarrier xcd_barrier_post(unsigned* bar, volatile LAS unsigned* st) {
    XcdBarrier b; b.bar = bar; b.x = xb_xcc_id(); b.st = st;
    if (threadIdx.x == 0) (void)xb_add(&bar[XB_XCNT(b.x)], 1u);
    return b;
}
__device__ __forceinline__ void xcd_barrier_complete(unsigned* bar, unsigned x, unsigned& nloc, unsigned& nx) {
    const unsigned G = gridDim.x * gridDim.y * gridDim.z;
    unsigned sum, cnt, mine, sp = 0u;
    for (;;) {
        sum = 0u; cnt = 0u; mine = 0u;
#pragma unroll
        for (unsigned j = 0; j < 16; ++j) { const unsigned c = xb_ld(&bar[XB_XCNT(j)]); sum += c; cnt += (c > 0u) ? 1u : 0u; mine = (j == x) ? c : mine; }
        if (sum == G) break;
        __builtin_amdgcn_s_sleep(1);
        if ((++sp & 255u) == 0u) { if (xb_ld(&bar[XB_TMO])) break; if (sp > XB_SPIN_CAP) { atomicAdd(&bar[XB_TMO], 1u); break; } }
    }
    nloc = mine > 0u ? mine : 1u; nx = cnt > 0u ? cnt : 1u;
}
__device__ __forceinline__ void xcd_barrier(const XcdBarrier& b) {
    asm volatile("s_waitcnt vmcnt(0)" ::: "memory");
    __syncthreads();
    if (threadIdx.x == 0) {
        unsigned* bar = b.bar;
        __builtin_amdgcn_s_waitcnt(0);
        unsigned nloc = b.st[0], nx = b.st[1];
        if (nloc == 0u) { xcd_barrier_complete(bar, b.x, nloc, nx); b.st[0] = nloc; b.st[1] = nx; }
        const unsigned old = xb_add(&bar[XB_XSUB(b.x)], 1u);
        const unsigned gen = old / nloc;
        if (old + 1u == (gen + 1u) * nloc) {
            __builtin_amdgcn_fence(__ATOMIC_RELEASE, "agent");
            asm volatile("s_waitcnt vmcnt(0)" ::: "memory");
            const unsigned og = xb_add(&bar[XB_TOP], 1u);
            const unsigned tg = og / nx;
            if (og + 1u == (tg + 1u) * nx) xb_add(&bar[XB_TOPGEN], 1u);
            else XB_SPIN(xb_ld(&bar[XB_TOPGEN]) == tg, bar);
            __builtin_amdgcn_fence(__ATOMIC_ACQUIRE, "agent");
            xb_add(&bar[XB_XGEN(b.x)], 1u);
            asm volatile("s_waitcnt vmcnt(0)" ::: "memory");
        } else {
            XB_SPIN(xb_ld(&bar[XB_XGEN(b.x)]) == gen, bar);
            __builtin_amdgcn_fence(__ATOMIC_ACQUIRE, "agent");
            asm volatile("s_waitcnt vmcnt(0)" ::: "memory");
        }
    }
    __syncthreads();
}

DI int row_of(int b, int dir, int ci, int i) {
    int s;
    if (dir == 0) s = ci * 64 + i;
    else s = (ci < 4) ? (3 - ci) * 64 + (63 - i) : 256 + (67 - ci) * 64 + (63 - i);
    return b * cf::SEGT + s;
}
DI void transpose_item(const float* W, int K, int N, bf16* WT, int out_row0, int k0, int n0, LAS float* scr, int lane) {
    const int n = n0 + (lane & 31); const bool ok = n < N;
#pragma unroll 8
    for (int i = 0; i < 32; ++i) { const int kk = 2 * i + (lane >> 5); scr[kk * 33 + (lane & 31)] = ok ? W[(size_t)(k0 + kk) * N + n] : 0.f; }
    LDS_WAIT();
    const int c = lane & 7;
#pragma unroll
    for (int j = 0; j < 4; ++j) { const int nn = (lane >> 3) + 8 * j; const LAS float* s = scr + (8 * c) * 33 + nn;
        u32x4 o; o.x = pk2(s[0 * 33], s[1 * 33]); o.y = pk2(s[2 * 33], s[3 * 33]); o.z = pk2(s[4 * 33], s[5 * 33]); o.w = pk2(s[6 * 33], s[7 * 33]);
        *(u32x4*)(WT + (size_t)(out_row0 + nn) * K + k0 + 8 * c) = o; }
    LDS_WAIT();
}

struct In { const float* p[34]; };

DI void phase_prologue(const In& in, uchar* ws, LAS uchar* lds, int G, int bx, int tid) {
    using namespace cf;
    const int lane = tid & 63, wid = __builtin_amdgcn_readfirstlane(tid >> 6), gw = bx * 8 + wid, NGW = G * 8;
    LAS float* scr = (LAS float*)(lds + wid * 16384);
    constexpr int I_IN = 32 * 160, I_OUT = 32 * 64, I_G = 32 * 176, I_DN = 88 * 64, I_UQ = 8 * 48, I_UKV = 8 * 64;
    constexpr int I_LAYER = I_IN + I_OUT + 2 * I_G + I_DN + I_UQ + I_UKV;
    for (int it = gw; it < DEPTH * I_LAYER; it += NGW) {
        const int l = it / I_LAYER; int r = it % I_LAYER;
        if (r < I_IN) { const int kb = r / 160, nb = r % 160; transpose_item(in.p[6] + (size_t)l * D * IN_COLS, D, IN_COLS, (bf16*)(ws + WS_WIN) + (size_t)l * PC * D, nb * 32, kb * 64, nb * 32, scr, lane); continue; } r -= I_IN;
        if (r < I_OUT) { const int kb = r / 64, nb = r % 64; transpose_item(in.p[26] + (size_t)l * D * D, D, D, (bf16*)(ws + WS_WOUT) + (size_t)l * D * D, nb * 32, kb * 64, nb * 32, scr, lane); continue; } r -= I_OUT;
        if (r < 2 * I_G) { const int up = r >= I_G; if (up) r -= I_G; const int kb = r / 176, nb = r % 176, n0 = nb * 32;
            transpose_item(in.p[up ? 30 : 29] + (size_t)l * D * DFF, D, DFF, (bf16*)(ws + WS_WGU) + (size_t)l * 2 * DFF * D, 256 * (n0 / 128) + (n0 % 128) + (up ? 128 : 0), kb * 64, n0, scr, lane); continue; } r -= 2 * I_G;
        if (r < I_DN) { const int kb = r / 64, nb = r % 64; transpose_item(in.p[31] + (size_t)l * DFF * D, DFF, D, (bf16*)(ws + WS_WDN) + (size_t)l * D * DFF, nb * 32, kb * 64, nb * 32, scr, lane); continue; } r -= I_DN;
        if (r < I_UQ) { const int kb = r / 48, nb = r % 48; transpose_item(in.p[9] + (size_t)l * 512 * 1536, 512, 1536, (bf16*)(ws + WS_WUQ) + (size_t)l * 1536 * 512, nb * 32, kb * 64, nb * 32, scr, lane); continue; } r -= I_UQ;
        { const int kb = r / 64, nb = r % 64; transpose_item(in.p[10] + (size_t)l * 512 * 2048, 512, 2048, (bf16*)(ws + WS_WUKV) + (size_t)l * 2048 * 512, nb * 32, kb * 64, nb * 32, scr, lane); }
    }
    float* X = (float*)(ws + WS_X);
    for (int r = gw; r < M; r += NGW) { const int b = r / SEGT, s = r % SEGT;
        const float* src = (s < CTX) ? in.p[2] + ((size_t)b * CTX + s) * D : in.p[0] + ((size_t)b * SEQ + (s - CTX)) * D;
        const f32x4* sp = (const f32x4*)src + lane; f32x4* dp = (f32x4*)(X + (size_t)r * D) + lane;
#pragma unroll
        for (int j = 0; j < 8; ++j) dp[64 * j] = sp[64 * j]; }
    const int gt = bx * 512 + tid, NGT = G * 512;
    float* rope = (float*)(ws + WS_ROPE);
    for (int i = gt; i < 1024; i += NGT) { const int pos = i >> 4, f = i & 15; const float inv = powf(10000.f, -(float)f / 16.f), ang = (float)pos * inv; rope[i] = cosf(ang); rope[1024 + i] = sinf(ang); }
    bf16* W2T = (bf16*)(ws + WS_W2T); bf16* A2T = (bf16*)(ws + WS_A2T); bf16* G2T = (bf16*)(ws + WS_G2T);
    for (int i = gt; i < DEPTH * 2 * 512 * 32; i += NGT) { const int r = i & 31, c = (i >> 5) & 511, ld = i >> 14;
        W2T[i] = f2bf(in.p[13][((size_t)ld * 32 + r) * 512 + c]); A2T[i] = f2bf(in.p[15][((size_t)ld * 32 + r) * 512 + c]); }
    for (int i = gt; i < DEPTH * 512 * 96; i += NGT) { const int k = i % 96, c = (i / 96) % 512, l = i / (96 * 512);
        G2T[i] = f2bf(in.p[16][((size_t)l * 96 + k) * 512 + c]); }
    LAS float* sv = scr;
    for (int it = gw; it < DEPTH * 48 * 16; it += NGW) {
        const int kp = it & 15, ng = (it >> 4) % 48, l = it / (16 * 48);
        for (int i = lane; i < 640; i += 64) { const int v = i >> 7, k = kp * 128 + (i & 127); const float x = (v < 4) ? in.p[1][v * D + k] : in.p[3][k]; sv[i] = x * sigmoidf_(x); }
        LDS_WAIT();
        const int n = ng * 256 + lane * 4;
        const float* wp = in.p[4] + ((size_t)l * D + (size_t)kp * 128) * MODS + n;
        f32x4 acc[5];
#pragma unroll
        for (int v = 0; v < 5; ++v) acc[v] = (f32x4){0.f, 0.f, 0.f, 0.f};
#pragma unroll 8
        for (int kk = 0; kk < 128; ++kk) { const f32x4 w = *(const f32x4*)(wp + (size_t)kk * MODS);
#pragma unroll
            for (int v = 0; v < 5; ++v) acc[v] += w * sv[v * 128 + kk]; }
        float* part = (float*)(ws + WS_P) + (size_t)kp * (DEPTH * 5 * MODS);
#pragma unroll
        for (int v = 0; v < 5; ++v) *(f32x4*)(part + ((size_t)l * 5 + v) * MODS + n) = acc[v];
        LDS_WAIT();
    }
}

DI void phase_modreduce(const In& in, uchar* ws, int G, int bx, int tid) {
    using namespace cf;
    float* modv = (float*)(ws + WS_MODV); const float* part = (const float*)(ws + WS_P);
    for (int i = bx * 512 + tid; i < DEPTH * 5 * MODS / 4; i += G * 512) { const int n4 = i % (MODS / 4), l = i / (5 * MODS / 4);
        f32x4 s = *(const f32x4*)(in.p[5] + (size_t)l * MODS + n4 * 4);
#pragma unroll
        for (int kp = 0; kp < 16; ++kp) s += *(const f32x4*)(part + (size_t)kp * (DEPTH * 5 * MODS) + (size_t)i * 4);
        *(f32x4*)(modv + (size_t)i * 4) = s; }
}

DI void phase_modulate(const float* X, bf16* XM, const float* modl  , int shift_off, int scale_off, int G, int bx, int tid) {
    using namespace cf;
    const int lane = tid & 63, gw = bx * 8 + __builtin_amdgcn_readfirstlane(tid >> 6), NGW = G * 8;
    for (int r = gw; r < M; r += NGW) { const int b = r / SEGT, s = r % SEGT, vec = (s < CTX) ? 4 : b;
        const f32x4* xp = (const f32x4*)(X + (size_t)r * D) + lane; const f32x4* sh = (const f32x4*)(modl + (size_t)vec * MODS + shift_off) + lane; const f32x4* sc = (const f32x4*)(modl + (size_t)vec * MODS + scale_off) + lane;
        u32x2* op = (u32x2*)(XM + (size_t)r * D) + lane;
#pragma unroll
        for (int j = 0; j < 8; ++j) { const f32x4 v = xp[64 * j] * (sc[64 * j] + 1.f) + sh[64 * j]; u32x2 o; o.x = pk2(v.x, v.y); o.y = pk2(v.z, v.w); op[64 * j] = o; } }
}

DI void ln_one_row(float* X, f32x4 (&v)[8], int r, const float* g, const float* bb, bf16* XM, const float* modl, int shift_off, int scale_off, float* out, const float* part, int nparts, const float* cgate, int lane) {
    using namespace cf;
    const int b = r / SEGT, s = r % SEGT, vec = (s < CTX) ? 4 : b;
    f32x4* xp = (f32x4*)(X + (size_t)r * D) + lane;
    float sum = 0.f;
    if (part && s < CTX) {
        const f32x4* gp4 = (const f32x4*)cgate + lane;
#pragma unroll
        for (int j = 0; j < 8; ++j) { f32x4 a = (f32x4){0.f, 0.f, 0.f, 0.f};
            for (int ks = 0; ks < nparts; ++ks) a += *((const f32x4*)(part + ((size_t)ks * 1024 + b * 256 + s) * D) + lane + 64 * j);
            v[j] = v[j] * ALPHA + gp4[64 * j] * a; } }
#pragma unroll
    for (int j = 0; j < 8; ++j) sum += (v[j].x + v[j].y) + (v[j].z + v[j].w);
    const float mean = wave_sum(sum, lane) * (1.f / D); float s2 = 0.f;
#pragma unroll
    for (int j = 0; j < 8; ++j) { v[j] = v[j] - mean; s2 += (v[j].x * v[j].x + v[j].y * v[j].y) + (v[j].z * v[j].z + v[j].w * v[j].w); }
    const float rstd = rsqrtf(wave_sum(s2, lane) * (1.f / D) + 1e-5f);
    const f32x4* gp = (const f32x4*)g + lane; const f32x4* bp = (const f32x4*)bb + lane;
#pragma unroll
    for (int j = 0; j < 8; ++j) v[j] = v[j] * rstd * gp[64 * j] + bp[64 * j];
    if (out) { f32x4* op = (f32x4*)(out + ((size_t)b * SEQ + (s - CTX)) * D) + lane;
#pragma unroll
        for (int j = 0; j < 8; ++j) op[64 * j] = v[j];
    } else {
        const f32x4* sh = (const f32x4*)(modl + (size_t)vec * MODS + shift_off) + lane; const f32x4* sc = (const f32x4*)(modl + (size_t)vec * MODS + scale_off) + lane;
        u32x2* op = (u32x2*)(XM + (size_t)r * D) + lane;
#pragma unroll
        for (int j = 0; j < 8; ++j) { xp[64 * j] = v[j]; const f32x4 m = v[j] * (sc[64 * j] + 1.f) + sh[64 * j]; u32x2 o; o.x = pk2(m.x, m.y); o.y = pk2(m.z, m.w); op[64 * j] = o; }
    }
}
DI void phase_ln(float* X, const float* g, const float* bb, bf16* XM, const float* modl, int shift_off, int scale_off, float* out, const float* part, int nparts, const float* cgate, bool skip_ctx, int G, int bx, int tid) {
    using namespace cf;
    const int lane = tid & 63, gw = bx * 8 + __builtin_amdgcn_readfirstlane(tid >> 6), NGW = G * 8;
    for (int r0 = gw; r0 < M; r0 += 2 * NGW) {
        const int r1 = r0 + NGW;
        const bool do0 = !(skip_ctx && (r0 % SEGT) < CTX), do1 = r1 < M && !(skip_ctx && (r1 % SEGT) < CTX);
        f32x4 va[8], vb[8];
        if (do0) { const f32x4* xp = (const f32x4*)(X + (size_t)r0 * D) + lane;
#pragma unroll
            for (int j = 0; j < 8; ++j) va[j] = xp[64 * j]; }
        if (do1) { const f32x4* xp = (const f32x4*)(X + (size_t)r1 * D) + lane;
#pragma unroll
            for (int j = 0; j < 8; ++j) vb[j] = xp[64 * j]; }
        if (do0) ln_one_row(X, va, r0, g, bb, XM, modl, shift_off, scale_off, out, part, nparts, cgate, lane);
        if (do1) ln_one_row(X, vb, r1, g, bb, XM, modl, shift_off, scale_off, out, part, nparts, cgate, lane);
    }
}

DI void mla_prep_rows(const bf16* P, bf16* CQN, bf16* CKVN, bf16* Kb, const float* qn, const float* kvn, const float* rope, int G, int bx, int tid) {
    using namespace cf;
    const int lane = tid & 63, gw = bx * 8 + __builtin_amdgcn_readfirstlane(tid >> 6), NGW = G * 8;
    const f32x4 gq0 = *(const f32x4*)(qn + lane * 8), gq1 = *(const f32x4*)(qn + lane * 8 + 4), gk0 = *(const f32x4*)(kvn + lane * 8), gk1 = *(const f32x4*)(kvn + lane * 8 + 4);
    const int axis = lane >> 5, half = (lane >> 4) & 1, f = lane & 15;
    for (int r0 = gw; r0 < M; r0 += 2 * NGW) {
        const int r1 = (r0 + NGW < M) ? r0 + NGW : r0;
        const bf16* pa = P + (size_t)r0 * PC; const bf16* pb = P + (size_t)r1 * PC;
        const u32x4 a0 = *(const u32x4*)(pa + lane * 8), a1 = *(const u32x4*)(pa + 512 + lane * 8), b0 = *(const u32x4*)(pb + lane * 8), b1 = *(const u32x4*)(pb + 512 + lane * 8);
        const bf16 ka = pa[C_KR + lane], kb = pb[C_KR + lane];
#pragma unroll
        for (int rr = 0; rr < 2; ++rr) { const int r = rr ? r1 : r0, s = r % SEGT;
#pragma unroll
            for (int part = 0; part < 2; ++part) {
                float x[8]; unpack8(rr ? (part ? b1 : b0) : (part ? a1 : a0), x);
                float ss = 0.f;
#pragma unroll
                for (int e = 0; e < 8; ++e) ss += x[e] * x[e];
                const float rs = rsqrtf(wave_sum(ss, lane) * (1.f / 512.f) + 1e-6f);
                const f32x4 g0 = part ? gk0 : gq0, g1 = part ? gk1 : gq1;
                float o[8];
#pragma unroll
                for (int e = 0; e < 8; ++e) o[e] = x[e] * rs * (e < 4 ? g0[e] : g1[e - 4]);
                *(u32x4*)((part ? CKVN : CQN) + (size_t)r * 512 + lane * 8) = pack8f(o);
            }
            float kr = bf2f(rr ? kb : ka);
            const float other = lx(kr, lane, 16);
            if (s >= CTX) { const int t = s - CTX, pos = axis ? (t & 63) : (t >> 6);
                const float c = rope[pos * 16 + f], sn = rope[1024 + pos * 16 + f];
                kr = half ? (other * sn + kr * c) : (kr * c - other * sn); }
            const bf16 kq = f2bf(kr);
#pragma unroll
            for (int h = 0; h < 8; ++h) Kb[(size_t)r * KP + h * 192 + 128 + lane] = kq;
        }
    }
}

DI void mix_rows(const bf16* P, const float* YR, const float* YG, const float* GATE, const float* BONUS, bf16* MIX,
                 const float* mu, const float* gn_g, const float* gn_b, const float* gdn_norm, int G, int bx, int tid) {
    using namespace cf;
    const int lane = tid & 63, gw = bx * 8 + __builtin_amdgcn_readfirstlane(tid >> 6), NGW = G * 8;
#pragma unroll 2
    for (int r = gw; r < M; r += NGW) { const int s = r % SEGT; const bf16* pr = P + (size_t)r * PC;
        const bool hasp = (s != 0) && (s != CTX), hasn = (s != CTX - 1) && (s != SEGT - 1);
        const int c0 = lane * 8;
        {
            float y[8], v[8];
            { const f32x4 a0 = *(const f32x4*)(YR + (size_t)r * 512 + c0), a1 = *(const f32x4*)(YR + (size_t)r * 512 + c0 + 4);
              const f32x4 b0 = *(const f32x4*)(YR + ((size_t)M + r) * 512 + c0), b1 = *(const f32x4*)(YR + ((size_t)M + r) * 512 + c0 + 4);
#pragma unroll
              for (int e = 0; e < 4; ++e) { y[e] = a0[e] + b0[e]; y[4 + e] = a1[e] + b1[e]; } }
            float sm = 0.f;
#pragma unroll
            for (int e = 0; e < 8; ++e) sm += y[e];
            sm += sx<1>(sm); sm += sx<2>(sm); sm += sx<4>(sm);
            const float mean = sm * (1.f / 64.f); float q = 0.f;
#pragma unroll
            for (int e = 0; e < 8; ++e) { y[e] -= mean; q += y[e] * y[e]; }
            q += sx<1>(q); q += sx<2>(q); q += sx<4>(q);
            const float rstd = rsqrtf(q * (1.f / 64.f) + 64e-5f);
            { float cur[8], prv[8], nxt[8]; const int col = C_RW + RW_V + c0;
              unpack8(*(const u32x4*)(pr + col), cur);
              if (hasp) unpack8(*(const u32x4*)(pr - PC + col), prv); else {
#pragma unroll
                  for (int e = 0; e < 8; ++e) prv[e] = 0.f; }
              if (hasn) unpack8(*(const u32x4*)(pr + PC + col), nxt); else {
#pragma unroll
                  for (int e = 0; e < 8; ++e) nxt[e] = 0.f; }
              const f32x4 m0 = *(const f32x4*)(mu + RW_V + c0), m1 = *(const f32x4*)(mu + RW_V + c0 + 4);
#pragma unroll
              for (int e = 0; e < 8; ++e) v[e] = cur[e] + (0.5f * (prv[e] + nxt[e]) - cur[e]) * (e < 4 ? m0[e] : m1[e - 4]); }
            const int h = lane >> 3;
            const float bonus = BONUS[(size_t)r * 8 + h] + BONUS[((size_t)M + r) * 8 + h];
            const f32x4 gg0 = *(const f32x4*)(gn_g + c0), gg1 = *(const f32x4*)(gn_g + c0 + 4), gb0 = *(const f32x4*)(gn_b + c0), gb1 = *(const f32x4*)(gn_b + c0 + 4);
            const f32x4 gt0 = *(const f32x4*)(GATE + (size_t)r * 512 + c0), gt1 = *(const f32x4*)(GATE + (size_t)r * 512 + c0 + 4);
            float o[8];
#pragma unroll
            for (int e = 0; e < 8; ++e) o[e] = (y[e] * rstd * (e < 4 ? gg0[e] : gg1[e - 4]) + (e < 4 ? gb0[e] : gb1[e - 4]) + bonus * v[e]) * (e < 4 ? gt0[e] : gt1[e - 4]);
            *(u32x4*)(MIX + (size_t)r * D + 1024 + c0) = pack8f(o);
        }
        {
            float y[8], z[8];
            { const f32x4 a0 = *(const f32x4*)(YG + (size_t)r * 512 + c0), a1 = *(const f32x4*)(YG + (size_t)r * 512 + c0 + 4);
              const f32x4 b0 = *(const f32x4*)(YG + ((size_t)M + r) * 512 + c0), b1 = *(const f32x4*)(YG + ((size_t)M + r) * 512 + c0 + 4);
#pragma unroll
              for (int e = 0; e < 4; ++e) { y[e] = a0[e] + b0[e]; y[4 + e] = a1[e] + b1[e]; } }
            float q = 0.f;
#pragma unroll
            for (int e = 0; e < 8; ++e) q += y[e] * y[e];
            q += sx<1>(q); q += sx<2>(q); q += sx<4>(q); q += lx(q, lane, 8);
            const float rs = rsqrtf(q * (1.f / 128.f) + 1e-6f);
            unpack8(*(const u32x4*)(pr + C_GD + GD_Z + c0), z);
            const int cn = c0 & 127; const f32x4 n0 = *(const f32x4*)(gdn_norm + cn), n1 = *(const f32x4*)(gdn_norm + cn + 4);
            float o[8];
#pragma unroll
            for (int e = 0; e < 8; ++e) o[e] = y[e] * rs * (e < 4 ? n0[e] : n1[e - 4]) * (z[e] * sigmoidf_(z[e]));
            *(u32x4*)(MIX + (size_t)r * D + 1536 + c0) = pack8f(o);
        }
    }
}
#define FRAGOFF(R, C, KS) ((((R) >> 4) * (KS) + ((C) >> 5)) * 1024 + ((((C) >> 3) & 3) * 16 + ((R) & 15)) * 16 + ((C) & 7) * 2)
#define SWZ(row, SH) ((((row) >> (SH)) & 7) << 3)
#define FRAGS(Mx, row, k, SH) (*(const LAS bf16x8*)((Mx) + (row) * 72 + (((k) * 32 + q4 * 8) ^ SWZ(row, SH))))
template <int K> DI f32x4 mm_tile(const LAS bf16* A, int lda, const LAS bf16* Bt, int ldb, int tm, int tn, f32x4 acc, int lane) {
    const int r = lane & 15, q = lane >> 4;
#pragma unroll
    for (int k0 = 0; k0 < K; k0 += 32) {
        const bf16x8 a = *(const LAS bf16x8*)(A + (16 * tm + r) * lda + k0 + q * 8);
        const bf16x8 b = *(const LAS bf16x8*)(Bt + (16 * tn + r) * ldb + k0 + q * 8);
        acc = MFMA16(a, b, acc);
    }
    return acc;
}
template <int NCL>
DI void inv_offblock(const LAS float* A, LAS float* TF, LAS bf16* TT, LAS float* scr, int i, int j, int c0, int lane) {
    const int r = lane & 15, q = lane >> 4, cb = c0 + q * NCL;
    float p[NCL];
#pragma unroll
    for (int e = 0; e < NCL; ++e) p[e] = 0.f;
    for (int kb = j; kb < i; ++kb) {
#pragma unroll
        for (int s = 0; s < 16; ++s) { const float a = A[(16 * i + r) * 65 + 16 * kb + s]; const LAS float* tp = TF + (16 * kb + s) * 65 + 16 * j + cb;
#pragma unroll
            for (int e = 0; e < NCL; ++e) p[e] += a * tp[e]; }
    }
#pragma unroll
    for (int e = 0; e < NCL; ++e) scr[r * 17 + q * NCL + e] = p[e];
    LDS_WAIT();
    float o[NCL];
#pragma unroll
    for (int e = 0; e < NCL; ++e) o[e] = 0.f;
#pragma unroll
    for (int s = 0; s < 16; ++s) { const float t = TF[(16 * i + r) * 65 + 16 * i + s];
#pragma unroll
        for (int e = 0; e < NCL; ++e) o[e] += t * scr[s * 17 + q * NCL + e]; }
#pragma unroll
    for (int e = 0; e < NCL; ++e) { TF[(16 * i + r) * 65 + 16 * j + cb + e] = o[e]; TT[(16 * i + r) * 72 + 16 * j + cb + e] = f2bf(o[e]); }
}
template <class Side>
DI void inv_blocked(const LAS float* A, LAS float* TF, LAS bf16* TT, LAS float* scr_all, int wid, int lane, int tid, const Side& side) {
    if (wid < 4) { if (lane < 16) { const int j = lane, base = 16 * wid; float tc[16];
#pragma unroll
        for (int t = 0; t < 16; ++t) { float acc = (t == j) ? 1.f : 0.f;
#pragma unroll
            for (int s = 0; s < t; ++s) acc += A[(base + t) * 65 + base + s] * tc[s];
            tc[t] = acc; }
#pragma unroll
        for (int t = 0; t < 16; ++t) { TF[(base + t) * 65 + base + j] = tc[t]; TT[(base + t) * 72 + base + j] = f2bf(tc[t]); }
    } } else side(wid - 4);
    LDS_BARRIER();
    LAS float* scr = scr_all + wid * 272;
    if (wid < 6) inv_offblock<2>(A, TF, TT, scr, (wid >> 1) + 1, wid >> 1, (wid & 1) * 8, lane);
    LDS_BARRIER();
    inv_offblock<1>(A, TF, TT, scr, (wid >> 2) + 2, wid >> 2, (wid & 3) * 4, lane);
    LDS_BARRIER();
    if (wid < 4) inv_offblock<1>(A, TF, TT, scr, 3, 0, wid * 4, lane);
    LDS_BARRIER();
}

struct ScanW {
    const float *mu, *w0, *a0, *k_k, *k_a, *r_k;
    const bf16 *W2T, *A2T, *G2T;
    const float *conv, *a_log, *dt_bias;
};

constexpr int RWB = 136192, RWB_W2 = RWB + 2688, RWB_A2 = RWB_W2 + 5120, RWB_G2 = RWB_A2 + 5120;
constexpr int GDB = 143360;
DI void rw_stage_weights(LAS uchar* lds, const ScanW& sw, int h, int dir, int tid) {
    LAS float* WF = (LAS float*)(lds + RWB);
    for (int i = tid; i < 672; i += 512) { float v;
        if (i < 64) v = sw.w0[dir * 512 + h * 64 + i]; else if (i < 128) v = sw.a0[dir * 512 + h * 64 + i - 64]; else if (i < 192) v = sw.k_k[h * 64 + i - 128];
        else if (i < 256) v = sw.k_a[h * 64 + i - 192]; else if (i < 320) v = sw.r_k[h * 64 + i - 256];
        else if (i < 512) v = sw.mu[((i - 320) >> 6) * 512 + h * 64 + ((i - 320) & 63)];
        else if (i < 544) v = sw.mu[cf::RW_WD + dir * 32 + i - 512]; else if (i < 576) v = sw.mu[cf::RW_AD + dir * 32 + i - 544]; else v = sw.mu[cf::RW_GD + i - 576];
        WF[i] = v; }
    { const int which = tid >> 8, t = tid & 255, row = t >> 2, ch = t & 3;
      *(LAS u32x4*)(lds + (which ? RWB_A2 : RWB_W2) + (row * 40 + ch * 8) * 2) = *(const u32x4*)((which ? sw.A2T : sw.W2T) + ((size_t)dir * 512 + h * 64 + row) * 32 + ch * 8); }
    LDS_BARRIER();
}
DI void gd_stage_weights(LAS uchar* lds, const ScanW& sw, int h, int tid) {
    LAS float* CW = (LAS float*)(lds + GDB);
    for (int i = tid; i < 1920; i += 512) { const int jw = i >> 7, c = i & 127; CW[i] = sw.conv[(size_t)(jw / 3) * 1536 + (jw % 3) * 512 + h * 128 + c]; }
    LDS_BARRIER();
}

struct RwRaw { u32x4 c[3]; };
DI void rw_issue(RwRaw& q, const bf16* P, int b, int h, int dir, int ci, int tid) {
    using namespace cf;
    const int i = tid >> 3, sub = tid & 7;
    const int R = row_of(b, dir, ci, i), seg_lo = b * SEGT + (ci < 4 ? 0 : CTX), seg_hi = b * SEGT + (ci < 4 ? CTX : SEGT);
    const bf16* pr = P + (size_t)R * PC + C_RW; (void)seg_lo; (void)seg_hi;
#pragma unroll
    for (int w = 0; w < 3; ++w) { const int col = w * 512 + h * 64 + sub * 8;
        q.c[w] = *(const u32x4*)(pr + col); }
}

DI void s1_rwkv(LAS uchar* lds, const bf16* P, const ScanW& sw, uchar* task, float* GATE, float* BONUSd, int b, int h, int dir, int ci, int tid, unsigned& chk, int nb, int nci) {
    RwRaw raw;
    using namespace cf;
    constexpr int MB = 9216;
    LAS bf16* AT = (LAS bf16*)(lds + 0 * MB); LAS bf16* BT = (LAS bf16*)(lds + 1 * MB); LAS bf16* KT = (LAS bf16*)(lds + 2 * MB); LAS bf16* QT = (LAS bf16*)(lds + 3 * MB);
    LAS bf16* ATT = (LAS bf16*)(lds + 4 * MB); LAS bf16* VT = (LAS bf16*)(lds + 5 * MB); LAS bf16* KHT = (LAS bf16*)(lds + 6 * MB); LAS bf16* BHT = (LAS bf16*)(lds + 7 * MB);
    LAS bf16* AAK = (LAS bf16*)(lds + 8 * MB); LAS bf16* AQK = (LAS bf16*)(lds + 9 * MB); LAS bf16* TT = (LAS bf16*)(lds + 10 * MB); LAS bf16* XT = (LAS bf16*)(lds + 11 * MB);
    LAS float* AAB = (LAS float*)(lds + 12 * MB); LAS float* GC = AAB;
    LAS float* INVS = (LAS float*)(lds + 12 * MB + 16640);
    LAS float* LWf = (LAS float*)(lds + 8 * MB); LAS float* LAf = (LAS float*)(lds + 10 * MB); LAS float* TF = (LAS float*)(lds + 0);
    LAS bf16* WTT = (LAS bf16*)(lds + 0 * MB); LAS bf16* ULT = (LAS bf16*)(lds + 1 * MB); LAS bf16* AQBL = (LAS bf16*)(lds + RWB_G2);
    const LAS float* WF = (const LAS float*)(lds + RWB);
    LAS bf16* TW = (LAS bf16*)(lds + 0); LAS bf16* AD = (LAS bf16*)(lds + 5120); LAS bf16* SG = (LAS bf16*)(lds + 10240);
    const int lane = tid & 63, wid = __builtin_amdgcn_readfirstlane(tid >> 6), i = tid >> 3, sub = tid & 7, r16 = lane & 15, q4 = lane >> 4;
    const int R = row_of(b, dir, ci, i), seg_lo = b * SEGT + (ci < 4 ? 0 : CTX), seg_hi = b * SEGT + (ci < 4 ? CTX : SEGT);
    const bool hasp = R - 1 >= seg_lo, hasn = R + 1 < seg_hi;
    const bf16* pr = P + (size_t)R * PC + C_RW;
    float rv[8], kv[8], vv[8];
#ifndef RW_PREFETCH
    rw_issue(raw, P, b, h, dir, ci, tid);
#endif
#ifdef DUP_ST01
    for (int rp_ = 0; rp_ < 2; ++rp_) {
#endif
#pragma unroll
    for (int w = 0; w < 3; ++w) { const int col = w * 512 + h * 64 + sub * 8; float cur[8], prv[8], nxt[8];
        unpack8(raw.c[w], cur);
        if (hasp) unpack8(*(const u32x4*)(pr - PC + col), prv); else {
#pragma unroll
            for (int e = 0; e < 8; ++e) prv[e] = 0.f; }
        if (hasn) unpack8(*(const u32x4*)(pr + PC + col), nxt); else {
#pragma unroll
            for (int e = 0; e < 8; ++e) nxt[e] = 0.f; }
        const f32x4 m0 = *(const LAS f32x4*)(WF + 320 + w * 64 + sub * 8), m1 = *(const LAS f32x4*)(WF + 320 + w * 64 + sub * 8 + 4);
#pragma unroll
        for (int e = 0; e < 8; ++e) { const float x = cur[e] + (0.5f * (prv[e] + nxt[e]) - cur[e]) * (e < 4 ? m0[e] : m1[e - 4]); if (w == 0) rv[e] = x; else if (w == 1) kv[e] = x; else vv[e] = x; } }
#pragma unroll
    for (int w = 0; w < 2; ++w) { const int col = (w ? RW_AD : RW_WD) + dir * 32 + sub * 4;
        const u32x2 c2 = *(const u32x2*)(pr + col); u32x2 p2 = (u32x2){0u, 0u}, n2 = (u32x2){0u, 0u};
        if (hasp) p2 = *(const u32x2*)(pr - PC + col); if (hasn) n2 = *(const u32x2*)(pr + PC + col);
        const f32x4 m = *(const LAS f32x4*)(WF + 512 + w * 32 + sub * 4);
        const float cur[4] = {bflo(c2.x), bfhi(c2.x), bflo(c2.y), bfhi(c2.y)}, prv[4] = {bflo(p2.x), bfhi(p2.x), bflo(p2.y), bfhi(p2.y)}, nxt[4] = {bflo(n2.x), bfhi(n2.x), bflo(n2.y), bfhi(n2.y)};
        float x[4];
#pragma unroll
        for (int e = 0; e < 4; ++e) { x[e] = cur[e] + (0.5f * (prv[e] + nxt[e]) - cur[e]) * m[e]; if (w == 0) x[e] = tanhf_(x[e]); }
        u32x2 o; o.x = pk2(x[0], x[1]); o.y = pk2(x[2], x[3]);
        *(LAS u32x2*)((w ? AD : TW) + i * 40 + sub * 4) = o; }
    if (dir == 0) {
#pragma unroll
        for (int j = 0; j < 3; ++j) { const int col = RW_GD + sub * 12 + j * 4;
            const u32x2 c2 = *(const u32x2*)(pr + col); u32x2 p2 = (u32x2){0u, 0u}, n2 = (u32x2){0u, 0u};
            if (hasp) p2 = *(const u32x2*)(pr - PC + col); if (hasn) n2 = *(const u32x2*)(pr + PC + col);
            const f32x4 m = *(const LAS f32x4*)(WF + 576 + sub * 12 + j * 4);
            const float cur[4] = {bflo(c2.x), bfhi(c2.x), bflo(c2.y), bfhi(c2.y)}, prv[4] = {bflo(p2.x), bfhi(p2.x), bflo(p2.y), bfhi(p2.y)}, nxt[4] = {bflo(n2.x), bfhi(n2.x), bflo(n2.y), bfhi(n2.y)};
            float x[4];
#pragma unroll
            for (int e = 0; e < 4; ++e) x[e] = sigmoidf_(cur[e] + (0.5f * (prv[e] + nxt[e]) - cur[e]) * m[e]);
            u32x2 o; o.x = pk2(x[0], x[1]); o.y = pk2(x[2], x[3]);
            *(LAS u32x2*)(SG + i * 104 + sub * 12 + j * 4) = o; }
    }
    LDS_BARRIER();
    { const int which = wid >> 2, tm = wid & 3;
      const bf16x8 a = *(const LAS bf16x8*)((which ? AD : TW) + (16 * tm + r16) * 40 + q4 * 8);
      const LAS bf16* wt = (const LAS bf16*)(lds + (which ? RWB_A2 : RWB_W2));
#pragma unroll
      for (int tn = 0; tn < 4; ++tn) { const bf16x8 bb = *(const LAS bf16x8*)(wt + (16 * tn + r16) * 40 + q4 * 8);
          const f32x4 acc = MFMA16(a, bb, ((f32x4){0.f, 0.f, 0.f, 0.f}));
#pragma unroll
          for (int e = 0; e < 4; ++e) (which ? LAf : LWf)[(16 * tm + 4 * q4 + e) * 65 + 16 * tn + r16] = acc[e]; } }
    if (dir == 0) { const int tm = wid >> 1;
#pragma unroll
        for (int j = 0; j < 2; ++j) { const int tn = (wid & 1) * 2 + j; f32x4 acc = (f32x4){0.f, 0.f, 0.f, 0.f};
#pragma unroll
            for (int k0 = 0; k0 < 96; k0 += 32) { const bf16x8 a = *(const LAS bf16x8*)(SG + (16 * tm + r16) * 104 + k0 + q4 * 8);
                const bf16x8 bb = *(const bf16x8*)(sw.G2T + (size_t)(h * 64 + 16 * tn + r16) * 96 + k0 + q4 * 8); acc = MFMA16(a, bb, acc); }
#pragma unroll
            for (int e = 0; e < 4; ++e) GATE[(size_t)row_of(b, 0, ci, 16 * tm + 4 * q4 + e) * 512 + h * 64 + 16 * tn + r16] = acc[e]; } }
    LDS_BARRIER();
#ifdef DUP_ST01
    }
#endif
    float av[8], bv[8], kd[8], lw[8];
#ifdef S1DBG
    float dbgv[8];
#endif
#ifdef DUP_ST2A
    for (int rp_ = 0; rp_ < 2; ++rp_) {
#endif
    { const int hc = h * 64 + sub * 8; float ss = 0.f, bon = 0.f, kk[8], al[8];
#pragma unroll
      for (int e = 0; e < 8; ++e) { const int c = sub * 8 + e;
          lw[e] = -0.6065306597126334f * sigmoidf_(WF[c] + LWf[i * 65 + c]);
          al[e] = sigmoidf_(WF[64 + c] + LAf[i * 65 + c]);
          kk[e] = kv[e] * WF[128 + c]; ss += kk[e] * kk[e]; }
      ss += sx<1>(ss); ss += sx<2>(ss); ss += sx<4>(ss);
      const float rn = rsqrtf(ss + 1e-12f);
#pragma unroll
      for (int e = 0; e < 8; ++e) { kk[e] *= rn; kd[e] = kv[e] * (1.f + (al[e] - 1.f) * WF[192 + sub * 8 + e]); av[e] = -kk[e]; bv[e] = kk[e] * al[e]; bon += rv[e] * kd[e] * WF[256 + sub * 8 + e];
#ifdef S1DBG
          dbgv[e] = (S1DBG == 1) ? al[e] : kk[e];
#endif
      }
      bon += sx<1>(bon); bon += sx<2>(bon); bon += sx<4>(bon);
      if (sub == 0) BONUSd[(size_t)R * 8 + h] = bon;
#pragma unroll
      for (int e = 0; e < 8; ++e) GC[i * 65 + sub * 8 + e] = lw[e]; }
    LDS_BARRIER();
#ifdef DUP_ST2A
    }
#endif
    {
        LAS float* TOT = INVS;
        float g8[8]; float run = 0.f;
#pragma unroll
        for (int j = 0; j < 8; ++j) g8[j] = GC[(wid * 8 + j) * 65 + lane];
#pragma unroll
        for (int j = 0; j < 8; ++j) { run += g8[j]; g8[j] = run; }
        TOT[wid * 64 + lane] = run;
        LDS_BARRIER();
        float off = 0.f;
#pragma unroll
        for (int sgm = 0; sgm < 7; ++sgm) { const float tv = TOT[sgm * 64 + lane]; off += (sgm < wid) ? tv : 0.f; }
#pragma unroll
        for (int j = 0; j < 8; ++j) GC[(wid * 8 + j) * 65 + lane] = g8[j] + off;
    }
    LDS_BARRIER();
#ifdef DUP_ST2C
    for (int rp_ = 0; rp_ < 2; ++rp_) {
#endif
    { float at[8], bt[8], kt[8], qt[8], bh[8], kh[8];
#pragma unroll
      for (int e = 0; e < 8; ++e) { const int c = sub * 8 + e; const float Gi = GC[i * 65 + c], Gm = (i > 0) ? GC[(i - 1) * 65 + c] : 0.f, GL = GC[63 * 65 + c];
          const float eG = __expf(Gi), eGm = __expf(Gm), enG = __expf(-Gi), eLG = __expf(GL - Gi);
          at[e] = av[e] * eGm; bt[e] = bv[e] * enG; kt[e] = kd[e] * enG; qt[e] = rv[e] * eG;
#ifdef S1DBG
          qt[e] = dbgv[e];
#endif
          bh[e] = bv[e] * eLG; kh[e] = kd[e] * eLG;
          if (i == 63) ((float*)(task + 32768))[c] = eG; }
      *(LAS u32x4*)(AT + i * 72 + sub * 8) = pack8f(at); *(LAS u32x4*)(BT + i * 72 + sub * 8) = pack8f(bt); *(LAS u32x4*)(KT + i * 72 + sub * 8) = pack8f(kt); *(LAS u32x4*)(QT + i * 72 + sub * 8) = pack8f(qt);
#pragma unroll
      for (int e = 0; e < 8; e += 2) { const int c = sub * 8 + e, is = i ^ (sub << 3);
          const unsigned pa = pk2(at[e], at[e + 1]), pv = pk2(vv[e], vv[e + 1]), pk = pk2(kh[e], kh[e + 1]), pb = pk2(bh[e], bh[e + 1]);
          ATT[c * 72 + is] = (bf16)pa; ATT[(c + 1) * 72 + is] = (bf16)(pa >> 16); VT[c * 72 + is] = (bf16)pv; VT[(c + 1) * 72 + is] = (bf16)(pv >> 16);
          KHT[c * 72 + is] = (bf16)pk; KHT[(c + 1) * 72 + is] = (bf16)(pk >> 16); BHT[c * 72 + is] = (bf16)pb; BHT[(c + 1) * 72 + is] = (bf16)(pb >> 16); } }
    LDS_BARRIER();
#ifdef DUP_ST2C
    }
#endif
#ifdef DUP_ST3
    for (int rp_ = 0; rp_ < 2; ++rp_) {
#endif
    RwRaw warm; rw_issue(warm, P, nb, h, dir, nci, tid);
    for (int z_ = tid; z_ < 64 * 72 / 8; z_ += 512) ((LAS u32x4*)TT)[z_] = (u32x4){0u, 0u, 0u, 0u};
    {
#define FRAG(Mx, row, k) (*(const LAS bf16x8*)((Mx) + (row) * 72 + (k) * 32 + q4 * 8))
      const int tm = wid >> 1;
      const bf16x8 a0 = FRAG(AT, 16 * tm + r16, 0), a1 = FRAG(AT, 16 * tm + r16, 1), q0 = FRAG(QT, 16 * tm + r16, 0), q1 = FRAG(QT, 16 * tm + r16, 1);
#pragma unroll
      for (int j = 0; j < 2; ++j) { const int tn = (wid & 1) * 2 + j; const f32x4 z = (f32x4){0.f, 0.f, 0.f, 0.f};
          f32x4 cab = z, cak = z, cqb = z, cqk = z;
          if (tm >= tn) { const bf16x8 b0 = FRAG(BT, 16 * tn + r16, 0), b1 = FRAG(BT, 16 * tn + r16, 1), k0 = FRAG(KT, 16 * tn + r16, 0), k1 = FRAG(KT, 16 * tn + r16, 1);
              cab = MFMA16(a0, b0, z); cab = MFMA16(a1, b1, cab); cak = MFMA16(a0, k0, z); cak = MFMA16(a1, k1, cak);
              cqb = MFMA16(q0, b0, z); cqb = MFMA16(q1, b1, cqb); cqk = MFMA16(q0, k0, z); cqk = MFMA16(q1, k1, cqk); }
#pragma unroll
          for (int e = 0; e < 4; ++e) { const int ti = 16 * tm + 4 * q4 + e, tj = 16 * tn + r16; const bool lo = ti > tj, le = ti >= tj;
              AAB[ti * 65 + tj] = lo ? cab[e] : 0.f; AAK[ti * 72 + tj] = f2bf(lo ? cak[e] : 0.f); AQBL[ti * 72 + tj] = f2bf(le ? cqb[e] : 0.f); AQK[ti * 72 + tj] = f2bf(le ? cqk[e] : 0.f); } }
#undef FRAG
    }
    LDS_BARRIER();
#ifdef DUP_ST3
    }
#endif
    inv_blocked(AAB, TF, TT, INVS, wid, lane, tid, [&](int sw_) {
#pragma unroll
        for (int j = 0; j < 4; ++j) { const int tm = sw_, tn = j;
            f32x4 acc = MFMA16(*(const LAS bf16x8*)(AAK + (16 * tm + r16) * 72 + q4 * 8), FRAGS(VT, 16 * tn + r16, 0, 3), ((f32x4){0.f, 0.f, 0.f, 0.f}));
            acc = MFMA16(*(const LAS bf16x8*)(AAK + (16 * tm + r16) * 72 + 32 + q4 * 8), FRAGS(VT, 16 * tn + r16, 1, 3), acc);
            u32x2 o; o.x = pk2(acc[0], acc[1]); o.y = pk2(acc[2], acc[3]); *(LAS u32x2*)(XT + (16 * tn + r16) * 72 + 16 * tm + 4 * q4) = o; } });
#ifdef DUP_ST6
    for (int rp_ = 0; rp_ < 2; ++rp_) {
#endif
    { const int mat = wid >> 2, tm = wid & 3; LAS bf16* dst = mat ? ULT : WTT; const LAS bf16* Bm = mat ? XT : ATT;
#define FRAG(Mx, row, k) (*(const LAS bf16x8*)((Mx) + (row) * 72 + (k) * 32 + q4 * 8))
      const bf16x8 t0 = FRAG(TT, 16 * tm + r16, 0), t1 = FRAG(TT, 16 * tm + r16, 1);
#pragma unroll
      for (int tn = 0; tn < 4; ++tn) { const int sz = mat ? 0 : SWZ(16 * tn + r16, 3);
          f32x4 acc = MFMA16(t0, *(const LAS bf16x8*)(Bm + (16 * tn + r16) * 72 + ((q4 * 8) ^ sz)), ((f32x4){0.f, 0.f, 0.f, 0.f})); acc = MFMA16(t1, *(const LAS bf16x8*)(Bm + (16 * tn + r16) * 72 + ((32 + q4 * 8) ^ sz)), acc);
          u32x2 o; o.x = pk2(acc[0], acc[1]); o.y = pk2(acc[2], acc[3]); *(LAS u32x2*)(dst + (16 * tn + r16) * 72 + 16 * tm + 4 * q4) = o; }
#undef FRAG
    }
    LDS_BARRIER();
    {
#define FRAG(Mx, row, k) (*(const LAS bf16x8*)((Mx) + (row) * 72 + (k) * 32 + q4 * 8))
      const int tm = wid >> 1;
      const bf16x8 w0 = FRAG(WTT, 16 * tm + r16, 0), w1 = FRAG(WTT, 16 * tm + r16, 1), h0 = FRAGS(BHT, 16 * tm + r16, 0, 3), h1 = FRAGS(BHT, 16 * tm + r16, 1, 3);
      const bf16x8 k0 = FRAGS(KHT, 16 * tm + r16, 0, 3), k1 = FRAGS(KHT, 16 * tm + r16, 1, 3), a0 = FRAG(AQBL, 16 * tm + r16, 0), a1 = FRAG(AQBL, 16 * tm + r16, 1), g0 = FRAG(AQK, 16 * tm + r16, 0), g1 = FRAG(AQK, 16 * tm + r16, 1);
#pragma unroll
      for (int j = 0; j < 2; ++j) { const int tn = (wid & 1) * 2 + j; const f32x4 z = (f32x4){0.f, 0.f, 0.f, 0.f};
          { f32x4 acc = MFMA16(w0, FRAGS(BHT, 16 * tn + r16, 0, 3), z); acc = MFMA16(w1, FRAGS(BHT, 16 * tn + r16, 1, 3), acc);
            u32x2 o; o.x = pk2(acc[0], acc[1]); o.y = pk2(acc[2], acc[3]); *(u32x2*)(task + 0 + FRAGOFF(16 * tn + r16, 16 * tm + 4 * q4, 2)) = o; }
          { f32x4 acc = MFMA16(w0, FRAG(AQBL, 16 * tn + r16, 0), z); acc = MFMA16(w1, FRAG(AQBL, 16 * tn + r16, 1), acc);
            const u32x2 qq = *(const LAS u32x2*)(QT + (16 * tn + r16) * 72 + 16 * tm + 4 * q4);
            u32x2 o; o.x = pk2(acc[0] + bflo(qq.x), acc[1] + bfhi(qq.x)); o.y = pk2(acc[2] + bflo(qq.y), acc[3] + bfhi(qq.y)); *(u32x2*)(task + 8192 + FRAGOFF(16 * tn + r16, 16 * tm + 4 * q4, 2)) = o; }
          { f32x4 acc = MFMA16(h0, FRAG(ULT, 16 * tn + r16, 0), z); acc = MFMA16(h1, FRAG(ULT, 16 * tn + r16, 1), acc);
            acc = MFMA16(k0, FRAGS(VT, 16 * tn + r16, 0, 3), acc); acc = MFMA16(k1, FRAGS(VT, 16 * tn + r16, 1, 3), acc);
            u32x2 o; o.x = pk2(acc[0], acc[1]); o.y = pk2(acc[2], acc[3]); *(u32x2*)(task + 16384 + ((tm * 2 + (tn >> 1)) * 64 + lane) * 16 + (tn & 1) * 8) = o; }
          { f32x4 acc = MFMA16(a0, FRAG(ULT, 16 * tn + r16, 0), z); acc = MFMA16(a1, FRAG(ULT, 16 * tn + r16, 1), acc);
            acc = MFMA16(g0, FRAGS(VT, 16 * tn + r16, 0, 3), acc); acc = MFMA16(g1, FRAGS(VT, 16 * tn + r16, 1, 3), acc);
            u32x2 o; o.x = pk2(acc[0], acc[1]); o.y = pk2(acc[2], acc[3]); *(u32x2*)(task + 24576 + ((tm * 2 + (tn >> 1)) * 64 + lane) * 16 + (tn & 1) * 8) = o; } }
#undef FRAG
    }
    LDS_BARRIER();
    chk ^= warm.c[0].x ^ warm.c[1].x ^ warm.c[2].x;
#ifdef DUP_ST6
    }
#endif
}

DI void s1_gdn(LAS uchar* lds, const bf16* P, const ScanW& sw, uchar* task, int b, int h, int dir, int ci, int tid) {
    using namespace cf;
    LAS bf16* KL = (LAS bf16*)(lds + 0); LAS bf16* QL = (LAS bf16*)(lds + 17408);
    LAS bf16* VT = (LAS bf16*)(lds + 34816); LAS bf16* KBT = (LAS bf16*)(lds + 53248); LAS bf16* BHT = (LAS bf16*)(lds + 71680);
    LAS bf16* TT = (LAS bf16*)(lds + 90112); LAS float* AAB = (LAS float*)(lds + 99328); LAS float* TF = (LAS float*)(lds + 115968);
    LAS float* INVS = (LAS float*)(lds + 132608); LAS float* gvec = (LAS float*)(lds + 141312); LAS bf16* AQBL = (LAS bf16*)(lds + 151552);
    const int lane = tid & 63, wid = __builtin_amdgcn_readfirstlane(tid >> 6), i = tid >> 3, sub = tid & 7, r16 = lane & 15, q4 = lane >> 4;
    const int R = row_of(b, dir, ci, i), seg_lo = b * SEGT + (ci < 4 ? 0 : CTX), seg_hi = b * SEGT + (ci < 4 ? CTX : SEGT);
    const bf16* pr = P + (size_t)R * PC + C_GD;
    float qv[16], kv[16], vv[16];
#pragma unroll
    for (int w = 0; w < 3; ++w) { const int col = w * 512 + h * 128 + sub * 16; float acc[16];
#pragma unroll
        for (int e = 0; e < 16; ++e) acc[e] = 0.f;
#pragma unroll
        for (int j = 0; j < 5; ++j) { const int Rj = R + j - 2;
            if (Rj >= seg_lo && Rj < seg_hi) { float x[16]; float xa[8], xb[8];
                unpack8(*(const u32x4*)(pr + (ptrdiff_t)(j - 2) * PC + col), xa); unpack8(*(const u32x4*)(pr + (ptrdiff_t)(j - 2) * PC + col + 8), xb);
#pragma unroll
                for (int e = 0; e < 8; ++e) { x[e] = xa[e]; x[8 + e] = xb[e]; }
                const LAS float* cw = (const LAS float*)(lds + GDB) + (j * 3 + w) * 128 + sub * 16;
#pragma unroll
                for (int e4 = 0; e4 < 4; ++e4) { const f32x4 c4 = *(const LAS f32x4*)(cw + 4 * e4);
#pragma unroll
                    for (int e = 0; e < 4; ++e) acc[4 * e4 + e] += c4[e] * x[4 * e4 + e]; } } }
#pragma unroll
        for (int e = 0; e < 16; ++e) { const float x = acc[e] * sigmoidf_(acc[e]); if (w == 0) qv[e] = x; else if (w == 1) kv[e] = x; else vv[e] = x; } }
    { float sq = 0.f, sk = 0.f;
#pragma unroll
      for (int e = 0; e < 16; ++e) { sq += qv[e] * qv[e]; sk += kv[e] * kv[e]; }
      sq += sx<1>(sq); sq += sx<2>(sq); sq += sx<4>(sq); sk += sx<1>(sk); sk += sx<2>(sk); sk += sx<4>(sk);
      const float rq = rsqrtf(sq + 1e-12f) * 0.08838834764831845f, rk = rsqrtf(sk + 1e-12f);
#pragma unroll
      for (int e = 0; e < 16; ++e) { qv[e] *= rq; kv[e] *= rk; } }
    if (sub == 0) { const float a_raw = bf2f(pr[GD_A + dir * 4 + h]), b_raw = bf2f(pr[GD_B + dir * 4 + h]);
        gvec[i] = -__expf(sw.a_log[dir * 4 + h]) * softplusf_(a_raw + sw.dt_bias[dir * 4 + h]); gvec[64 + i] = sigmoidf_(b_raw); }
    { float t0[8], t1[8];
#pragma unroll
      for (int e = 0; e < 8; ++e) { t0[e] = kv[e]; t1[e] = kv[8 + e]; }
      *(LAS u32x4*)(KL + i * 136 + sub * 16) = pack8f(t0); *(LAS u32x4*)(KL + i * 136 + sub * 16 + 8) = pack8f(t1);
#pragma unroll
      for (int e = 0; e < 8; ++e) { t0[e] = qv[e]; t1[e] = qv[8 + e]; }
      *(LAS u32x4*)(QL + i * 136 + sub * 16) = pack8f(t0); *(LAS u32x4*)(QL + i * 136 + sub * 16 + 8) = pack8f(t1); }
    LDS_BARRIER();
    if (wid == 0) { float g = 0.f;
#pragma unroll 8
        for (int t = 0; t < 64; ++t) { const float x = gvec[t]; g += (t <= lane) ? x : 0.f; }
        gvec[128 + lane] = g; }
    LDS_BARRIER();
    for (int z_ = tid; z_ < 64 * 72 / 8; z_ += 512) ((LAS u32x4*)TT)[z_] = (u32x4){0u, 0u, 0u, 0u};
    { const float Gi = gvec[128 + i], GL = gvec[128 + 63], be = gvec[64 + i], eG = __expf(Gi), eLG = __expf(GL - Gi), beG = be * eG;
#pragma unroll
      for (int e = 0; e < 16; e += 2) { const int c = sub * 16 + e, is = i ^ (sub << 3);
          const unsigned pv = pk2(be * vv[e], be * vv[e + 1]), pk = pk2(beG * kv[e], beG * kv[e + 1]), pb = pk2(kv[e] * eLG, kv[e + 1] * eLG);
          VT[c * 72 + is] = (bf16)pv; VT[(c + 1) * 72 + is] = (bf16)(pv >> 16); KBT[c * 72 + is] = (bf16)pk; KBT[(c + 1) * 72 + is] = (bf16)(pk >> 16); BHT[c * 72 + is] = (bf16)pb; BHT[(c + 1) * 72 + is] = (bf16)(pb >> 16); }
      if (tid < 128) ((float*)(task + 98304))[tid] = __expf(GL); }
    { const int mat = wid >> 2, tm = wid & 3;
      const LAS bf16* Am = mat ? QL : KL;
      bf16x8 af[4];
#pragma unroll
      for (int k = 0; k < 4; ++k) af[k] = *(const LAS bf16x8*)(Am + (16 * tm + r16) * 136 + k * 32 + q4 * 8);
#pragma unroll
      for (int tn = 0; tn < 4; ++tn) {
          if (tm >= tn) { f32x4 acc = (f32x4){0.f, 0.f, 0.f, 0.f};
#pragma unroll
              for (int k = 0; k < 4; ++k) acc = MFMA16(af[k], *(const LAS bf16x8*)(KL + (16 * tn + r16) * 136 + k * 32 + q4 * 8), acc);
              const float Gj = gvec[128 + 16 * tn + r16]; const int tj = 16 * tn + r16;
              if (mat == 0) {
#pragma unroll
                  for (int e = 0; e < 4; ++e) { const int ti = 16 * tm + 4 * q4 + e; AAB[ti * 65 + tj] = (ti > tj) ? -gvec[64 + ti] * acc[e] * __expf(fminf(gvec[128 + ti] - Gj, 0.f)) : 0.f; }
              } else {
#pragma unroll
                  for (int e = 0; e < 4; ++e) { const int ti = 16 * tm + 4 * q4 + e; AQBL[ti * 72 + tj] = f2bf((ti >= tj) ? acc[e] * __expf(fminf(gvec[128 + ti] - Gj, 0.f)) : 0.f); } }
          } else if (mat) {
#pragma unroll
              for (int e = 0; e < 4; ++e) AQBL[(16 * tm + 4 * q4 + e) * 72 + 16 * tn + r16] = 0; } } }
    LDS_BARRIER();
    inv_blocked(AAB, TF, TT, INVS, wid, lane, tid, [](int) {});
    LAS bf16* WTT = (LAS bf16*)(lds + 99328); LAS bf16* ULT = (LAS bf16*)(lds + 99328 + 18432);
    { const int mat = wid >> 2, tm = wid & 3;
      const bf16x8 t0 = *(const LAS bf16x8*)(TT + (16 * tm + r16) * 72 + q4 * 8), t1 = *(const LAS bf16x8*)(TT + (16 * tm + r16) * 72 + 32 + q4 * 8); const LAS bf16* Bm = mat ? KBT : VT;
      LAS bf16* dst = mat ? WTT : ULT; const float sg = mat ? -1.f : 1.f;
#pragma unroll
      for (int tn = 0; tn < 8; ++tn) { f32x4 z = MFMA16(t0, FRAGS(Bm, 16 * tn + r16, 0, 4), ((f32x4){0.f, 0.f, 0.f, 0.f})); z = MFMA16(t1, FRAGS(Bm, 16 * tn + r16, 1, 4), z);
          u32x2 o; o.x = pk2(sg * z[0], sg * z[1]); o.y = pk2(sg * z[2], sg * z[3]); *(LAS u32x2*)(dst + (16 * tn + r16) * 72 + 16 * tm + 4 * q4) = o; } }
    LDS_BARRIER();
    {
#define FRAG(Mx, row, k) (*(const LAS bf16x8*)((Mx) + (row) * 72 + (k) * 32 + q4 * 8))
      const bf16x8 w0 = FRAG(WTT, 16 * wid + r16, 0), w1 = FRAG(WTT, 16 * wid + r16, 1);
      const bf16x8 h0 = FRAGS(BHT, 16 * wid + r16, 0, 4), h1 = FRAGS(BHT, 16 * wid + r16, 1, 4);
#pragma unroll
      for (int tn = 0; tn < 8; ++tn) {
          f32x4 acc = MFMA16(w0, FRAGS(BHT, 16 * tn + r16, 0, 4), ((f32x4){0.f, 0.f, 0.f, 0.f})); acc = MFMA16(w1, FRAGS(BHT, 16 * tn + r16, 1, 4), acc);
          u32x2 o; o.x = pk2(acc[0], acc[1]); o.y = pk2(acc[2], acc[3]); *(u32x2*)(task + 0 + FRAGOFF(16 * tn + r16, 16 * wid + 4 * q4, 4)) = o; }
#pragma unroll
      for (int tn = 0; tn < 8; ++tn) {
          f32x4 acc = MFMA16(h0, FRAG(ULT, 16 * tn + r16, 0), ((f32x4){0.f, 0.f, 0.f, 0.f})); acc = MFMA16(h1, FRAG(ULT, 16 * tn + r16, 1), acc);
          u32x2 o; o.x = pk2(acc[0], acc[1]); o.y = pk2(acc[2], acc[3]); *(u32x2*)(task + 49152 + ((wid * 4 + (tn >> 1)) * 64 + lane) * 16 + (tn & 1) * 8) = o; }
#pragma unroll
      for (int tn = 0; tn < 4; ++tn) {
          f32x4 acc = MFMA16(w0, FRAG(AQBL, 16 * tn + r16, 0), ((f32x4){0.f, 0.f, 0.f, 0.f})); acc = MFMA16(w1, FRAG(AQBL, 16 * tn + r16, 1), acc);
          const int t = 16 * tn + r16; const float eG = __expf(gvec[128 + t]); const u32x2 qq = *(const LAS u32x2*)(QL + t * 136 + 16 * wid + 4 * q4);
          u32x2 o; o.x = pk2(acc[0] + eG * bflo(qq.x), acc[1] + eG * bfhi(qq.x)); o.y = pk2(acc[2] + eG * bflo(qq.y), acc[3] + eG * bfhi(qq.y)); *(u32x2*)(task + 32768 + FRAGOFF(t, 16 * wid + 4 * q4, 4)) = o; }
      { const int tm = wid >> 1; const bf16x8 a0 = FRAG(AQBL, 16 * tm + r16, 0), a1 = FRAG(AQBL, 16 * tm + r16, 1);
#pragma unroll
        for (int j = 0; j < 4; ++j) { const int tn = (wid & 1) * 4 + j;
            f32x4 acc = MFMA16(a0, FRAG(ULT, 16 * tn + r16, 0), ((f32x4){0.f, 0.f, 0.f, 0.f})); acc = MFMA16(a1, FRAG(ULT, 16 * tn + r16, 1), acc);
            u32x2 o; o.x = pk2(acc[0], acc[1]); o.y = pk2(acc[2], acc[3]); *(u32x2*)(task + 81920 + ((tm * 4 + (tn >> 1)) * 64 + lane) * 16 + (tn & 1) * 8) = o; } }
#undef FRAG
    }
    LDS_BARRIER();
}

template <int NK, bool LOC> struct S2FA { bf16x8 wt[NK / 32]; u32x4 ul; };
template <int NK, bool LOC> struct S2FB { bf16x8 qt[NK / 32], aqb[2], bht[2]; u32x4 yl, kl; f32x4 gl; float gls; };
template <int NK, bool LOC>
DI void s2_load_a(S2FA<NK, LOC>& f, const uchar* task, int o_wt, int o_ul, int ulh, int tm, int lane) {
    const int r16 = lane & 15, q4 = lane >> 4;
#pragma unroll
    for (int k = 0; k < NK / 32; ++k) f.wt[k] = *(const bf16x8*)(task + o_wt + ((size_t)(16 * tm + r16) * NK + k * 32 + q4 * 8) * 2);
    f.ul = *(const u32x4*)(task + o_ul + (size_t)(ulh * 64 + lane) * 16);
}
template <int NK, bool LOC>
DI void s2_load_b(S2FB<NK, LOC>& f, const uchar* task, int o_qt, int o_aqb, int o_bht, int o_yl, int ulh, int o_kl, int o_gl, int tm, int cm, int ch, int lane) {
    const int r16 = lane & 15, q4 = lane >> 4;
#pragma unroll
    for (int k = 0; k < NK / 32; ++k) f.qt[k] = *(const bf16x8*)(task + o_qt + ((size_t)(16 * tm + r16) * NK + k * 32 + q4 * 8) * 2);
    if (LOC) f.yl = *(const u32x4*)(task + o_yl + (size_t)(ulh * 64 + lane) * 16);
#pragma unroll
    for (int k = 0; k < 2; ++k) { f.aqb[k] = *(const bf16x8*)(task + o_aqb + ((size_t)(16 * tm + r16) * 64 + k * 32 + q4 * 8) * 2); f.bht[k] = *(const bf16x8*)(task + o_bht + ((size_t)(16 * cm + r16) * 64 + k * 32 + q4 * 8) * 2); }
    if (LOC) f.kl = *(const u32x4*)(task + o_kl + (size_t)((cm * 2 + ch) * 64 + lane) * 16);
    if (LOC) f.gl = *(const f32x4*)(task + o_gl + (size_t)(16 * cm + 4 * q4) * 4); else f.gls = *(const float*)(task + o_gl);
}
template <int NK, bool LOC>
DI void s2_step(const S2FA<NK, LOC>& fa, const S2FB<NK, LOC>& fb, f32x4 (&H)[NK / 32], const LAS bf16* Hc, LAS bf16* Hn, LAS bf16* UT, float* Y, int ycol0, int b, int dir, int ci, int tm, int tn0, int cm, int ctn0, int lane) {
    constexpr int NH = NK / 32, LDH = NK + 8;
    const int r16 = lane & 15, q4 = lane >> 4;
    f32x4 U[2], Yv[2];
    U[0] = (f32x4){bflo(fa.ul.x), bfhi(fa.ul.x), bflo(fa.ul.y), bfhi(fa.ul.y)}; U[1] = (f32x4){bflo(fa.ul.z), bfhi(fa.ul.z), bflo(fa.ul.w), bfhi(fa.ul.w)};
#pragma unroll
    for (int j = 0; j < 2; ++j) {
#pragma unroll
        for (int k = 0; k < NK / 32; ++k) { const bf16x8 hb = *(const LAS bf16x8*)(Hc + (16 * (tn0 + j) + r16) * LDH + k * 32 + q4 * 8); U[j] = MFMA16(fa.wt[k], hb, U[j]); }
        u32x2 o; o.x = pk2(U[j][0], U[j][1]); o.y = pk2(U[j][2], U[j][3]);
        *(LAS u32x2*)(UT + (16 * (tn0 + j) + r16) * 72 + 16 * tm + 4 * q4) = o;
    }
    LDS_BARRIER();
    if (LOC) { Yv[0] = (f32x4){bflo(fb.yl.x), bfhi(fb.yl.x), bflo(fb.yl.y), bfhi(fb.yl.y)}; Yv[1] = (f32x4){bflo(fb.yl.z), bfhi(fb.yl.z), bflo(fb.yl.w), bfhi(fb.yl.w)}; }
    else { Yv[0] = (f32x4){0.f, 0.f, 0.f, 0.f}; Yv[1] = Yv[0]; }
#pragma unroll
    for (int j = 0; j < 2; ++j) {
#pragma unroll
        for (int k = 0; k < NK / 32; ++k) { const bf16x8 hb = *(const LAS bf16x8*)(Hc + (16 * (tn0 + j) + r16) * LDH + k * 32 + q4 * 8); Yv[j] = MFMA16(fb.qt[k], hb, Yv[j]); }
#pragma unroll
        for (int k = 0; k < 2; ++k) { const bf16x8 ub = *(const LAS bf16x8*)(UT + (16 * (tn0 + j) + r16) * 72 + k * 32 + q4 * 8); Yv[j] = MFMA16(fb.aqb[k], ub, Yv[j]); }
#pragma unroll
        for (int e = 0; e < 4; ++e) Y[(size_t)row_of(b, dir, ci, 16 * tm + 4 * q4 + e) * 512 + ycol0 + 16 * (tn0 + j) + r16] = Yv[j][e];
    }
#pragma unroll
    for (int j = 0; j < NH; ++j) {
        f32x4 h = LOC ? H[j] * fb.gl : H[j] * fb.gls;
        if (LOC) { if (j == 0) h += (f32x4){bflo(fb.kl.x), bfhi(fb.kl.x), bflo(fb.kl.y), bfhi(fb.kl.y)}; else h += (f32x4){bflo(fb.kl.z), bfhi(fb.kl.z), bflo(fb.kl.w), bfhi(fb.kl.w)}; }
#pragma unroll
        for (int k = 0; k < 2; ++k) { const bf16x8 ub = *(const LAS bf16x8*)(UT + (16 * (ctn0 + j) + r16) * 72 + k * 32 + q4 * 8); h = MFMA16(fb.bht[k], ub, h); }
        H[j] = h;
        u32x2 o; o.x = pk2(h[0], h[1]); o.y = pk2(h[2], h[3]);
        *(LAS u32x2*)(Hn + (16 * (ctn0 + j) + r16) * LDH + 16 * cm + 4 * q4) = o;
    }
    LDS_BARRIER();
}
template <int NK, bool LOC>
DI void s2_scan(LAS uchar* lds, const uchar* task0, int task_bytes, int o_wt, int o_qt, int o_aqb, int o_bht, int o_ul, int ulq, int o_yl, int o_kl, int o_gl,
                float* Y, int ycol0, int b, int dir, int tid) {
    constexpr int NH = NK / 32, LDH = NK + 8;
    LAS bf16* HT = (LAS bf16*)lds;
    LAS bf16* UT = (LAS bf16*)(lds + 2 * 64 * LDH * 2);
    const int lane = tid & 63, wid = tid >> 6;
    const int tm = wid >> 1, tn0 = (wid & 1) * 2;
    const int cm = (NK == 64) ? (wid >> 1) : wid, ctn0 = (NK == 64) ? (wid & 1) * 2 : 0;
    const int ulh = tm * ulq + (wid & 1);
    for (int i = tid; i < 64 * LDH * 2 / 16; i += 512) ((LAS u32x4*)HT)[i] = (u32x4){0u, 0u, 0u, 0u};
    f32x4 H[NH];
#pragma unroll
    for (int j = 0; j < NH; ++j) H[j] = (f32x4){0.f, 0.f, 0.f, 0.f};
    S2FA<NK, LOC> a0, a1, a2; S2FB<NK, LOC> b0, b1, b2;
#define TASKP(c) (task0 + (size_t)((c) < cf::NCH ? (c) : cf::NCH - 1) * task_bytes)
#define LDA(f, c) s2_load_a<NK, LOC>(f, TASKP(c), o_wt, o_ul, ulh, tm, lane)
#define LDB(f, c) s2_load_b<NK, LOC>(f, TASKP(c), o_qt, o_aqb, o_bht, o_yl, ulh, o_kl, o_gl, tm, cm, (wid & 1), lane)
#define STP(fa, fb, c) s2_step<NK, LOC>(fa, fb, H, HT + ((c) & 1) * 64 * LDH, HT + (((c) + 1) & 1) * 64 * LDH, UT, Y, ycol0, b, dir, (c), tm, tn0, cm, ctn0, lane)
    LDA(a0, 0); LDB(b0, 0); LDA(a1, 1); LDB(b1, 1);
    LDS_BARRIER();
#pragma unroll 2
    for (int ci = 0; ci < cf::NCH; ++ci) {
        LDA(a2, ci + 2); LDB(b2, ci + 2); STP(a0, b0, ci);
        a0 = a1; a1 = a2; b0 = b1; b1 = b2;
    }
#undef TASKP
#undef LDA
#undef LDB
#undef STP
}

template <int NK, bool VECG> struct S2N { bf16x8 m[NK / 32], q[NK / 32]; u32x4 n[NK / 64], y; f32x4 gl; float gls; };
template <int NK, bool VECG>
DI void s2n_load(S2N<NK, VECG>& f, const uchar* task, int o_m, int o_q, int o_n, int o_y, int o_gl, int tm, int cm, int nh0, int yh, int lane) {
    const int r16 = lane & 15, q4 = lane >> 4;
#pragma unroll
    for (int k = 0; k < NK / 32; ++k) { f.m[k] = *(const bf16x8*)(task + o_m + (size_t)((cm * (NK / 32) + k) * 64 + lane) * 16); f.q[k] = *(const bf16x8*)(task + o_q + (size_t)((tm * (NK / 32) + k) * 64 + lane) * 16); }
#pragma unroll
    for (int j = 0; j < NK / 64; ++j) f.n[j] = *(const u32x4*)(task + o_n + (size_t)((nh0 + j) * 64 + lane) * 16);
    f.y = *(const u32x4*)(task + o_y + (size_t)(yh * 64 + lane) * 16);
    if (VECG) f.gl = *(const f32x4*)(task + o_gl + (size_t)(16 * cm + 4 * q4) * 4); else f.gls = *(const float*)(task + o_gl);
}
template <int NK, bool VECG>
DI void s2n_step(const S2N<NK, VECG>& f, f32x4 (&H)[NK / 32], const LAS bf16* Hc, LAS bf16* Hn, LAS float* YS, float* Y, int ycol0, int b, int dir, int ci, int tm, int tn0, int cm, int ctn0, int wid, int lane) {
    constexpr int NH = NK / 32, LDH = NK + 8;
    const int r16 = lane & 15, q4 = lane >> 4;
#pragma unroll
    for (int j = 0; j < NH; ++j) {
        const u32x4 nn = f.n[j >> 1];
        f32x4 h = VECG ? H[j] * f.gl : H[j] * f.gls;
        h += (j & 1) ? (f32x4){bflo(nn.z), bfhi(nn.z), bflo(nn.w), bfhi(nn.w)} : (f32x4){bflo(nn.x), bfhi(nn.x), bflo(nn.y), bfhi(nn.y)};
#pragma unroll
        for (int k = 0; k < NK / 32; ++k) { const bf16x8 hb = *(const LAS bf16x8*)(Hc + (16 * (ctn0 + j) + r16) * LDH + k * 32 + q4 * 8); h = MFMA16(f.m[k], hb, h); }
        H[j] = h;
        u32x2 o; o.x = pk2(h[0], h[1]); o.y = pk2(h[2], h[3]);
        *(LAS u32x2*)(Hn + (16 * (ctn0 + j) + r16) * LDH + 16 * cm + 4 * q4) = o;
    }
#pragma unroll
    for (int j = 0; j < 2; ++j) {
        f32x4 yv = j ? (f32x4){bflo(f.y.z), bfhi(f.y.z), bflo(f.y.w), bfhi(f.y.w)} : (f32x4){bflo(f.y.x), bfhi(f.y.x), bflo(f.y.y), bfhi(f.y.y)};
#pragma unroll
        for (int k = 0; k < NK / 32; ++k) { const bf16x8 hb = *(const LAS bf16x8*)(Hc + (16 * (tn0 + j) + r16) * LDH + k * 32 + q4 * 8); yv = MFMA16(f.q[k], hb, yv); }
#pragma unroll
        for (int e = 0; e < 4; ++e) YS[(16 * tm + 4 * q4 + e) * 65 + 16 * (tn0 + j) + r16] = yv[e];
    }
    LDS_BARRIER();
#pragma unroll
    for (int e = 0; e < 8; ++e) { const int t = 8 * wid + e;
        Y[(size_t)row_of(b, dir, ci, t) * 512 + ycol0 + lane] = YS[t * 65 + lane]; }
}
template <int NK, bool VECG>
DI void s2n_scan(LAS uchar* lds, const uchar* task0, int task_bytes, int o_m, int o_q, int o_n, int o_y, int o_gl, int nq, int vs, float* Y, int ycol0, int b, int dir, int tid) {
    constexpr int NH = NK / 32, LDH = NK + 8;
    LAS bf16* HT = (LAS bf16*)lds;
    LAS float* YSB = (LAS float*)(lds + 2 * 64 * LDH * 2);
    const int lane = tid & 63, wid = __builtin_amdgcn_readfirstlane(tid >> 6);
    const int tm = wid >> 1, tn0 = (wid & 1) * 2;
    const int cm = (NK == 64) ? (wid >> 1) : wid, ctn0 = (NK == 64) ? (wid & 1) * 2 : 0;
    const int nh0 = (NK == 64) ? (cm * nq + (wid & 1)) : (cm * nq + vs * 2), yh = tm * nq + vs * 2 + (wid & 1);
    for (int i = tid; i < 64 * LDH * 2 / 16; i += 512) ((LAS u32x4*)HT)[i] = (u32x4){0u, 0u, 0u, 0u};
    f32x4 H[NH];
#pragma unroll
    for (int j = 0; j < NH; ++j) H[j] = (f32x4){0.f, 0.f, 0.f, 0.f};
#define TP(c) (task0 + (size_t)((c) < cf::NCH ? (c) : cf::NCH - 1) * task_bytes)
#define LD(f, c) s2n_load<NK, VECG>(f, TP(c), o_m, o_q, o_n, o_y, o_gl, tm, cm, nh0, yh, lane)
#define ST(f, c) s2n_step<NK, VECG>(f, H, HT + ((c) & 1) * 64 * LDH, HT + (((c) + 1) & 1) * 64 * LDH, YSB + ((c) & 1) * 64 * 65, Y, ycol0, b, dir, (c), tm, tn0, cm, ctn0, wid, lane)
    if constexpr (NK == 64) {
        S2N<NK, VECG> f0, f1, f2, f3;
        LD(f0, 0); LD(f1, 1); LD(f2, 2);
        LDS_BARRIER();
#pragma unroll 1
        for (int ci = 0; ci < cf::NCH; ci += 4) {
            LD(f3, ci + 3); ST(f0, ci);
            LD(f0, ci + 4); ST(f1, ci + 1);
            LD(f1, ci + 5); ST(f2, ci + 2);
            LD(f2, ci + 6); ST(f3, ci + 3);
        }
    } else {
        S2N<NK, VECG> f0, f1, f2;
        LD(f0, 0); LD(f1, 1);
        LDS_BARRIER();
#pragma unroll 1
        for (int ci = 0; ci + 2 < cf::NCH; ci += 3) {
            LD(f2, ci + 2); ST(f0, ci);
            LD(f0, ci + 3); ST(f1, ci + 1);
            LD(f1, ci + 4); ST(f2, ci + 2);
        }
        ST(f0, cf::NCH - 2); ST(f1, cf::NCH - 1);
    }
#undef TP
#undef LD
#undef ST
}
namespace at {
constexpr int DQ = 192, DV = 128, NW = 8, QBLK = 32, KVBLK = 64;
constexpr float SCALE = 0.07216878364870322f;
constexpr float THR = 8.f;
constexpr int SHM_V = KVBLK * DV * 2, SHM_K = KVBLK * DQ * 2, SHM_Q = NW * 8 * 1024, SHM_ATTN = 2 * SHM_V + 2 * SHM_K + NW * 64 * 4 + SHM_Q;
#define KSWZ(row, colB) ((row) * 384 + ((colB) ^ (((row) & 7) << 4)))
#define SBAR() __builtin_amdgcn_sched_barrier(0)
DI int crow(int r, int hi) { return (r & 3) + 8 * (r >> 2) + 4 * hi; }
DI unsigned cvtpk(float lo, float hi) { const f32x2 v = {lo, hi}; return __builtin_bit_cast(unsigned, __builtin_convertvector(v, bf16x2_t)); }
DI void partialSM(f32x16& p0, f32x16& p1, float& m_reg, float& mn, float& alpha) {
  constexpr float C = SCALE * 1.4426950408889634f;
  float pmax = p0[0];
#pragma unroll
  for (int r = 1; r < 16; ++r) pmax = fmaxf(pmax, p0[r]);
#pragma unroll
  for (int r = 0; r < 16; ++r) pmax = fmaxf(pmax, p1[r]);
  { auto rr = __builtin_amdgcn_permlane32_swap(__float_as_uint(pmax), __float_as_uint(pmax), false, false);
    pmax = fmaxf(__uint_as_float(rr[0]), __uint_as_float(rr[1])); }
  if (__builtin_expect(__all(pmax - m_reg <= THR / SCALE), 1)) { mn = m_reg; alpha = 1.f; }
  else { mn = fmaxf(m_reg, pmax); alpha = __builtin_amdgcn_exp2f((m_reg - mn) * C); m_reg = mn; }
  float mnC = -mn * C;
#pragma unroll
  for (int r = 0; r < 16; ++r) p0[r] = fmaf(p0[r], C, mnC);
#pragma unroll
  for (int r = 0; r < 16; ++r) p1[r] = fmaf(p1[r], C, mnC);
#pragma unroll
  for (int r = 0; r < 16; ++r) p0[r] = __builtin_amdgcn_exp2f(p0[r]);
}
DI void finishSM(f32x16& p0, f32x16& p1, float alpha, float& l_reg, bf16x8& pa0, bf16x8& pa1, bf16x8& pa2, bf16x8& pa3) {
#pragma unroll
  for (int r = 0; r < 16; ++r) p1[r] = __builtin_amdgcn_exp2f(p1[r]);
  float ps = 0;
#pragma unroll
  for (int r = 0; r < 16; ++r) ps += p0[r];
#pragma unroll
  for (int r = 0; r < 16; ++r) ps += p1[r];
  { auto rr = __builtin_amdgcn_permlane32_swap(__float_as_uint(ps), __float_as_uint(ps), false, false);
    ps = __uint_as_float(rr[0]) + __uint_as_float(rr[1]); }
  l_reg = l_reg * alpha + ps;
#define PK4(P, BASE, OUT) do { unsigned a0 = cvtpk(P[BASE + 0], P[BASE + 1]), a1 = cvtpk(P[BASE + 2], P[BASE + 3]);   \
    unsigned b0 = cvtpk(P[BASE + 4], P[BASE + 5]), b1 = cvtpk(P[BASE + 6], P[BASE + 7]);                              \
    auto r0 = __builtin_amdgcn_permlane32_swap(a0, b0, false, false); auto r1 = __builtin_amdgcn_permlane32_swap(a1, b1, false, false); \
    u32x4 w = {r0[0], r1[0], r0[1], r1[1]}; OUT = *reinterpret_cast<bf16x8*>(&w); } while (0)
  PK4(p0, 0, pa0); PK4(p0, 8, pa1); PK4(p1, 0, pa2); PK4(p1, 8, pa3);
#undef PK4
}
constexpr int NQR = 4;
DI void qkt(f32x16& p0, f32x16& p1, const LAS char* Ks, const bf16x8* qr, const LAS char* qlds, int r32, int hi) {
  p0 = f32x16{}; p1 = f32x16{};
#pragma unroll
  for (int d0 = 0; d0 < 12; ++d0) { int cb = (d0 * 16 + hi * 8) * 2;
    const bf16x8 qf = (d0 < NQR) ? qr[d0] : *(const LAS bf16x8*)(qlds + (d0 - NQR) * 1024);
    bf16x8 b0 = *(const LAS bf16x8*)(Ks + KSWZ(r32, cb));
    bf16x8 b1 = *(const LAS bf16x8*)(Ks + KSWZ(32 + r32, cb));
    p0 = __builtin_amdgcn_mfma_f32_32x32x16_bf16(b0, qf, p0, 0, 0, 0);
    p1 = __builtin_amdgcn_mfma_f32_32x32x16_bf16(b1, qf, p1, 0, 0, 0); }
}
DI int v_st(int k, int c) { const int kk = (k & ~0xC) | ((k & 4) << 1) | ((k & 8) >> 1); return ((kk >> 3) * 4 + (c >> 5)) * 512 + ((kk & 7) * 32 + (c & 31)) * 2; }
DI int v_rd_base(int lane) { return ((lane & 3) << 3) | (((lane >> 2) & 3) << 6) | (((lane >> 4) & 1) << 5) | (((lane >> 5) & 1) << 8); }
constexpr int v_rd_off(int d0, int ks, int half) { return d0 * 512 + ks * 4096 + half * 2048; }
template <int OFF> DI s16x4 tr_read(int vb) { s16x4 r; asm volatile("ds_read_b64_tr_b16 %0, %1 offset:%2" : "=&v"(r) : "v"(vb), "i"(OFF) : "memory"); return r; }
template <int D0> DI void pv_one(f32x16& od, int vb, bf16x8 pa0, bf16x8 pa1, bf16x8 pa2, bf16x8 pa3) {
  const s16x4 l0 = tr_read<v_rd_off(D0, 0, 0)>(vb), h0 = tr_read<v_rd_off(D0, 0, 1)>(vb), l1 = tr_read<v_rd_off(D0, 1, 0)>(vb), h1 = tr_read<v_rd_off(D0, 1, 1)>(vb);
  const s16x4 l2 = tr_read<v_rd_off(D0, 2, 0)>(vb), h2 = tr_read<v_rd_off(D0, 2, 1)>(vb), l3 = tr_read<v_rd_off(D0, 3, 0)>(vb), h3 = tr_read<v_rd_off(D0, 3, 1)>(vb);
  asm volatile("s_waitcnt lgkmcnt(0)" ::: "memory"); SBAR();
#define PK(L, H) (bf16x8){L[0], L[1], L[2], L[3], H[0], H[1], H[2], H[3]}
  od = __builtin_amdgcn_mfma_f32_32x32x16_bf16(pa0, PK(l0, h0), od, 0, 0, 0);
  od = __builtin_amdgcn_mfma_f32_32x32x16_bf16(pa1, PK(l1, h1), od, 0, 0, 0);
  od = __builtin_amdgcn_mfma_f32_32x32x16_bf16(pa2, PK(l2, h2), od, 0, 0, 0);
  od = __builtin_amdgcn_mfma_f32_32x32x16_bf16(pa3, PK(l3, h3), od, 0, 0, 0);
#undef PK
}
DI void pv_d0(f32x16* o, int vb, bf16x8 pa0, bf16x8 pa1, bf16x8 pa2, bf16x8 pa3) {
  pv_one<0>(o[0], vb, pa0, pa1, pa2, pa3); pv_one<1>(o[1], vb, pa0, pa1, pa2, pa3); pv_one<2>(o[2], vb, pa0, pa1, pa2, pa3); pv_one<3>(o[3], vb, pa0, pa1, pa2, pa3);
}
DI void attn_unit(const bf16* __restrict__ Qb, const bf16* __restrict__ Kh, const bf16* __restrict__ Vh, bf16* __restrict__ Ob, int seq, const float* rope, int pos0, LAS char* lds, const int tid) {
  constexpr int LDQ = cf::QP, LDKK = cf::KP, LDVV = cf::VP, LDO = cf::D;
  const int wid = __builtin_amdgcn_readfirstlane(tid >> 6), lane = tid & 63, r32 = lane & 31, hi = lane >> 5;
  LAS char* V_lds = lds; LAS char* K_lds = lds + 2 * SHM_V;
  LAS float* ws = (LAS float*)(lds + 2 * SHM_V + 2 * SHM_K) + wid * 64; LAS float* li_l = ws; LAS float* al_l = ws + 32;
  LAS char* qlds = lds + 2 * SHM_V + 2 * SHM_K + NW * 64 * 4 + wid * (12 - NQR) * 1024 + lane * 16;
  float m_reg = -1e30f, l_reg = 0; f32x16 o[4] = {}; bf16x8 qr[12];
  const bf16* Qw = Qb + (long)(wid * QBLK + r32) * LDQ + hi * 8;
#pragma unroll
  for (int d0 = 0; d0 < 12; ++d0) qr[d0] = *reinterpret_cast<const bf16x8*>(Qw + d0 * 16);
  if (rope) { const int t = pos0 + wid * QBLK + r32;
#pragma unroll
    for (int ax = 0; ax < 2; ++ax) { const int pos = ax ? (t & 63) : (t >> 6);
      const f32x4 c0 = *(const f32x4*)(rope + pos * 16 + hi * 8), c1 = *(const f32x4*)(rope + pos * 16 + hi * 8 + 4), s0 = *(const f32x4*)(rope + 1024 + pos * 16 + hi * 8), s1 = *(const f32x4*)(rope + 1024 + pos * 16 + hi * 8 + 4);
      float x1[8], x2[8], o1[8], o2[8]; unpack8(__builtin_bit_cast(u32x4, qr[8 + 2 * ax]), x1); unpack8(__builtin_bit_cast(u32x4, qr[9 + 2 * ax]), x2);
#pragma unroll
      for (int e = 0; e < 8; ++e) { const float c = e < 4 ? c0[e] : c1[e - 4], s = e < 4 ? s0[e] : s1[e - 4]; o1[e] = x1[e] * c - x2[e] * s; o2[e] = x1[e] * s + x2[e] * c; }
      qr[8 + 2 * ax] = __builtin_bit_cast(bf16x8, pack8f(o1)); qr[9 + 2 * ax] = __builtin_bit_cast(bf16x8, pack8f(o2)); } }
#pragma unroll
  for (int d0 = NQR; d0 < 12; ++d0) *(LAS bf16x8*)(qlds + (d0 - NQR) * 1024) = qr[d0];
  const int sr = tid >> 4, sc = (tid & 15) * 8, vst0 = v_st(sr, sc), vst1 = v_st(32 + sr, sc);
  int kr_[3], kc_[3];
#pragma unroll
  for (int j = 0; j < 3; ++j) { const int q = tid + 512 * j; kr_[j] = q / 24; kc_[j] = (q % 24) * 8; }
  const int vb0 = (int)(uintptr_t)V_lds + v_rd_base(lane);
  bf16x8 vs0 = {}, vs1 = {}, ks0 = {}, ks1 = {}, ks2 = {};
#define SLOAD(k0) do { vs0 = *(const bf16x8*)(&Vh[(long)((k0) + sr) * LDVV + sc]); vs1 = *(const bf16x8*)(&Vh[(long)((k0) + 32 + sr) * LDVV + sc]); \
    ks0 = *(const bf16x8*)(&Kh[(long)((k0) + kr_[0]) * LDKK + kc_[0]]); ks1 = *(const bf16x8*)(&Kh[(long)((k0) + kr_[1]) * LDKK + kc_[1]]); ks2 = *(const bf16x8*)(&Kh[(long)((k0) + kr_[2]) * LDKK + kc_[2]]); } while (0)
#define SWRITE(b) do { *(LAS bf16x8*)(V_lds + (b) * SHM_V + vst0) = vs0; *(LAS bf16x8*)(V_lds + (b) * SHM_V + vst1) = vs1; \
    *(LAS bf16x8*)(K_lds + (b) * SHM_K + KSWZ(kr_[0], kc_[0] * 2)) = ks0; *(LAS bf16x8*)(K_lds + (b) * SHM_K + KSWZ(kr_[1], kc_[1] * 2)) = ks1; *(LAS bf16x8*)(K_lds + (b) * SHM_K + KSWZ(kr_[2], kc_[2] * 2)) = ks2; } while (0)
#define SWAIT() asm volatile("s_waitcnt vmcnt(0)" ::: "memory")
#define RESC(a) do { if (__any((a) < 1.f)) { if (hi == 0) al_l[r32] = (a); asm volatile("s_waitcnt lgkmcnt(0)" ::: "memory"); \
    _Pragma("unroll") for (int d = 0; d < 4; ++d) _Pragma("unroll") for (int r = 0; r < 16; ++r) o[d][r] *= al_l[crow(r, hi)]; } } while (0)
  f32x16 pA0 = {}, pA1 = {}, pB0 = {}, pB1 = {}; float mnA = 0.f, mnB = 0.f, alA = 1.f, alB = 1.f; bf16x8 pa0 = {}, pa1 = {}, pa2 = {}, pa3 = {}; const int NT = seq / KVBLK;
  SLOAD(0); SWAIT(); SWRITE(0); __syncthreads();
  qkt(pA0, pA1, K_lds, qr, qlds, r32, hi); partialSM(pA0, pA1, m_reg, mnA, alA);
  SLOAD(KVBLK);
  SWAIT(); SWRITE(1); __syncthreads();
  for (int j = 1; j + 1 < NT; j += 2) {
    SBAR(); qkt(pB0, pB1, K_lds + SHM_K, qr, qlds, r32, hi);
    finishSM(pA0, pA1, alA, l_reg, pa0, pa1, pa2, pa3); SBAR();
    SLOAD((j + 1) * KVBLK); SBAR();
    pv_d0(o, vb0, pa0, pa1, pa2, pa3); partialSM(pB0, pB1, m_reg, mnB, alB);
    __syncthreads(); SWAIT(); SWRITE(0);
    RESC(alB); __syncthreads();
    SBAR(); qkt(pA0, pA1, K_lds, qr, qlds, r32, hi);
    finishSM(pB0, pB1, alB, l_reg, pa0, pa1, pa2, pa3); SBAR();
    SLOAD((j + 2) * KVBLK); SBAR();
    pv_d0(o, vb0 + (int)SHM_V, pa0, pa1, pa2, pa3); partialSM(pA0, pA1, m_reg, mnA, alA);
    __syncthreads(); SWAIT(); SWRITE(1);
    RESC(alA); __syncthreads();
  }
  SBAR(); qkt(pB0, pB1, K_lds + SHM_K, qr, qlds, r32, hi);
  finishSM(pA0, pA1, alA, l_reg, pa0, pa1, pa2, pa3); SBAR();
  pv_d0(o, vb0, pa0, pa1, pa2, pa3); partialSM(pB0, pB1, m_reg, mnB, alB);
  __syncthreads(); RESC(alB);
  finishSM(pB0, pB1, alB, l_reg, pa0, pa1, pa2, pa3); SBAR();
  pv_d0(o, vb0 + (int)SHM_V, pa0, pa1, pa2, pa3);
  if (hi == 0) li_l[r32] = l_reg; asm volatile("s_waitcnt lgkmcnt(0)" ::: "memory");
  float rli[16];
#pragma unroll
  for (int r = 0; r < 16; ++r) rli[r] = __builtin_amdgcn_rcpf(li_l[crow(r, hi)]);
  bf16* Ow = Ob + (long)(wid * QBLK) * LDO;
#pragma unroll
  for (int r = 0; r < 16; ++r) { int orow = crow(r, hi);
#pragma unroll
    for (int d0 = 0; d0 < 4; ++d0) Ow[(long)orow * LDO + d0 * 32 + r32] = f2bf(o[d0][r] * rli[r]); }
  __syncthreads();
#undef SLOAD
#undef SWRITE
#undef SWAIT
#undef RESC
}
#undef KSWZ
}
#if defined(PROBE)
DI void fatomic_max(unsigned* p, float v) { atomicMax(p, __builtin_bit_cast(unsigned, fabsf(v))); }
DI float pshift(const bf16* P, int R, int lo, int hi, int col, const float* mu, int mucol) {
    const float c = bf2f(P[(size_t)R * cf::PC + col]), p = (R - 1 >= lo) ? bf2f(P[(size_t)(R - 1) * cf::PC + col]) : 0.f, n = (R + 1 < hi) ? bf2f(P[(size_t)(R + 1) * cf::PC + col]) : 0.f;
    return c + (0.5f * (p + n) - c) * mu[mucol];
}
__global__ void __launch_bounds__(256) probe(In in, uchar* ws, unsigned* res, float* scratch) {
    using namespace cf;
    __shared__ float sh[4352 + 1024];
    const int tid = threadIdx.x, bx = blockIdx.x;
    const bf16* P = (const bf16*)(ws + WS_P); const bf16* Qb = (const bf16*)(ws + WS_Q); const bf16* Kb = (const bf16*)(ws + WS_K); const bf16* Vb = (const bf16*)(ws + WS_V); const bf16* MIX = (const bf16*)(ws + WS_XM);
    const float* YR = (const float*)(ws + WS_YR); const float* YG = (const float*)(ws + WS_YG);
    if (bx < 8) {
        const int h = bx, b = 1;
        for (int which = 0; which < 4; ++which) {
            const bool isctx = which == 3; const int t = which == 0 ? 0 : which == 1 ? 1000 : which == 2 ? 4095 : 5;
            const int row = b * SEGT + (isctx ? t : CTX + t), nkeys = isctx ? CTX : SEGT;
            if (tid < 192) { float q = bf2f(Qb[(size_t)row * QP + h * 192 + tid]); sh[4352 + tid] = q; }
            __syncthreads();
            if (tid < 192 && tid >= 128 && !isctx) { const int j = tid - 128, ax = j >> 5, half = (j >> 4) & 1, f = j & 15; const float pos = ax ? (float)(t & 63) : (float)(t >> 6);
                const float ang = pos * powf(10000.f, -(float)f / 16.f), c = cosf(ang), s = sinf(ang);
                const float x1 = sh[4352 + 128 + ax * 32 + f], x2 = sh[4352 + 128 + ax * 32 + 16 + f];
                sh[4352 + 512 + j] = half ? (x1 * s + x2 * c) : (x1 * c - x2 * s); }
            __syncthreads();
            if (tid < 64 && !isctx) sh[4352 + 128 + tid] = sh[4352 + 512 + tid];
            __syncthreads();
            for (int kk = tid; kk < nkeys; kk += 256) { const int krow = b * SEGT + kk; const bool kctx = kk < CTX; const int kt = kk - CTX;
                float s = 0.f;
                for (int d = 0; d < 128; ++d) s += sh[4352 + d] * bf2f(Kb[(size_t)krow * KP + h * 192 + d]);
                for (int j = 0; j < 64; ++j) { const int ax = j >> 5, half = (j >> 4) & 1, f = j & 15;
                    float kv;
                    if (kctx) kv = bf2f(P[(size_t)krow * PC + C_KR + j]);
                    else { const float pos = ax ? (float)(kt & 63) : (float)(kt >> 6), ang = pos * powf(10000.f, -(float)f / 16.f), c = cosf(ang), sn = sinf(ang);
                        const float x1 = bf2f(P[(size_t)krow * PC + C_KR + ax * 32 + f]), x2 = bf2f(P[(size_t)krow * PC + C_KR + ax * 32 + 16 + f]);
                        kv = half ? (x1 * sn + x2 * c) : (x1 * c - x2 * sn); }
                    s += sh[4352 + 128 + j] * kv; }
                sh[kk] = s * 0.07216878364870322f; }
            __syncthreads();
            float mx = -1e30f; for (int kk = 0; kk < nkeys; ++kk) mx = fmaxf(mx, sh[kk]);
            float den = 0.f; for (int kk = 0; kk < nkeys; ++kk) den += __expf(sh[kk] - mx);
            if (tid < 128) { float o = 0.f; for (int kk = 0; kk < nkeys; ++kk) o += __expf(sh[kk] - mx) * bf2f(Vb[(size_t)(b * SEGT + kk) * VP + h * 128 + tid]);
                o /= den; const float got = bf2f(MIX[(size_t)row * D + h * 128 + tid]); fatomic_max(res + 0, got - o); fatomic_max(res + 16, o); }
            __syncthreads();
        }
    } else if (bx < 10) {
        if (tid >= 64) return;
        const int b = 1, h = 3, dir = bx - 8, lane = tid, hc = h * 64 + lane;
        const float* mu = in.p[11]; float S[64]; float cumw = 1.f;
        const uchar* task = ws + WS_RWT + (size_t)((((b * 8 + h) * 2 + dir) * NCH) + 0) * RW_TASK;
#pragma unroll
        for (int k = 0; k < 64; ++k) S[k] = 0.f;
        for (int step = 0; step < SEGT; ++step) {
            const int R = row_of(b, dir, step >> 6, step & 63), s = R % SEGT, lo = b * SEGT + (s < CTX ? 0 : CTX), hi = b * SEGT + (s < CTX ? CTX : SEGT);
            const float r = pshift(P, R, lo, hi, C_RW + hc, mu, hc), k = pshift(P, R, lo, hi, C_RW + 512 + hc, mu, 512 + hc), v = pshift(P, R, lo, hi, C_RW + 1024 + hc, mu, 1024 + hc);
            if (lane < 32) { sh[lane] = tanhf(pshift(P, R, lo, hi, C_RW + RW_WD + dir * 32 + lane, mu, RW_WD + dir * 32 + lane)); sh[32 + lane] = pshift(P, R, lo, hi, C_RW + RW_AD + dir * 32 + lane, mu, RW_AD + dir * 32 + lane); }
            __builtin_amdgcn_s_waitcnt(0); __builtin_amdgcn_wave_barrier();
            float lw = in.p[12][dir * 512 + hc], la = in.p[14][dir * 512 + hc];
            for (int rr = 0; rr < 32; ++rr) { lw += sh[rr] * in.p[13][((size_t)dir * 32 + rr) * 512 + hc]; la += sh[32 + rr] * in.p[15][((size_t)dir * 32 + rr) * 512 + hc]; }
            const float wlog = -log1pf(expf(-lw)) - 0.5f, w = expf(-expf(wlog)), alr = 1.f / (1.f + expf(-la));
            float kk = k * in.p[17][hc]; sh[400 + lane] = kk * kk; __builtin_amdgcn_s_waitcnt(0); __builtin_amdgcn_wave_barrier(); float nn = 0.f; for (int jj = 0; jj < 64; ++jj) nn += sh[400 + jj]; kk *= rsqrtf(nn + 1e-12f);
            const float kd = k * (1.f + (alr - 1.f) * in.p[18][hc]), a = -kk, bb = kk * alr;
            if (dir == 0 && step < 64) { cumw *= w;
#ifdef S1DBG
                const float qt = (S1DBG == 1) ? alr : kk,
#else
                const float qt = r * cumw,
#endif
                got = bf2f(((const bf16*)(task + 8192))[step * 64 + lane]); fatomic_max(res + 9, got - qt); fatomic_max(res + 25, qt);
                scratch[(size_t)8 * SEGT * 64 + step * 64 + lane] = bb; scratch[(size_t)8 * SEGT * 64 + 4096 + step * 64 + lane] = cumw;
                if (step == 63) { const float gl = ((const float*)(task + 57344))[lane]; fatomic_max(res + 8, gl - cumw); fatomic_max(res + 24, cumw);
                    for (int t2 = 0; t2 < 64; ++t2) { const float bh = scratch[(size_t)8 * SEGT * 64 + t2 * 64 + lane] * cumw / scratch[(size_t)8 * SEGT * 64 + 4096 + t2 * 64 + lane], gb = bf2f(((const bf16*)(task + 24576))[lane * 64 + t2]); fatomic_max(res + 10, gb - bh); fatomic_max(res + 26, bh); } } }
            sh[64 + lane] = a; sh[128 + lane] = bb; sh[192 + lane] = kd; sh[256 + lane] = w; sh[320 + lane] = r;
            __builtin_amdgcn_s_waitcnt(0); __builtin_amdgcn_wave_barrier();
            float sa = 0.f;
#pragma unroll
            for (int kx = 0; kx < 64; ++kx) sa += S[kx] * sh[64 + kx];
            float y = 0.f;
#pragma unroll
            for (int kx = 0; kx < 64; ++kx) { S[kx] = S[kx] * sh[256 + kx] + sa * sh[128 + kx] + v * sh[192 + kx]; y += S[kx] * sh[320 + kx]; }
            scratch[((size_t)dir * SEGT + (R - b * SEGT)) * 64 + lane] = y;
            __builtin_amdgcn_s_waitcnt(0); __builtin_amdgcn_wave_barrier();
        }
    } else if (bx < 12) {
        const int b = 2, h = 1, dir = bx - 10, c = tid & 127;
        float S[128];
#pragma unroll
        for (int k = 0; k < 128; ++k) S[k] = 0.f;
        const float A = expf(in.p[23][dir * 4 + h]), dtb = in.p[24][dir * 4 + h];
        for (int step = 0; step < SEGT; ++step) {
            const int R = row_of(b, dir, step >> 6, step & 63), s = R % SEGT, lo = b * SEGT + (s < CTX ? 0 : CTX), hi = b * SEGT + (s < CTX ? CTX : SEGT);
            float x[3];
            for (int w = 0; w < 3; ++w) { float acc = 0.f; const int col = w * 512 + h * 128 + c;
                for (int j = 0; j < 5; ++j) { const int Rj = R + j - 2; if (Rj >= lo && Rj < hi) acc += in.p[22][(size_t)j * 1536 + col] * bf2f(P[(size_t)Rj * PC + C_GD + col]); }
                x[w] = acc / (1.f + expf(-acc)); }
            if (tid < 128) { sh[tid] = x[0] * x[0]; sh[128 + tid] = x[1] * x[1]; }
            __syncthreads();
            float sq = 0.f, sk = 0.f; for (int j = 0; j < 128; ++j) { sq += sh[j]; sk += sh[128 + j]; }
            __syncthreads();
            const float q = x[0] * rsqrtf(sq + 1e-12f) * 0.08838834764831845f, k = x[1] * rsqrtf(sk + 1e-12f), v = x[2];
            const float a_raw = bf2f(P[(size_t)R * PC + C_GD + GD_A + dir * 4 + h]), b_raw = bf2f(P[(size_t)R * PC + C_GD + GD_B + dir * 4 + h]);
            const float z = a_raw + dtb, g = -A * (z > 20.f ? z : log1pf(expf(z))), eg = expf(g), beta = 1.f / (1.f + expf(-b_raw));
            if (tid < 128) { sh[256 + tid] = k; sh[384 + tid] = q; }
            __syncthreads();
            if (tid < 128) { float ks = 0.f;
#pragma unroll
                for (int kx = 0; kx < 128; ++kx) ks += sh[256 + kx] * S[kx];
                float o = 0.f;
#pragma unroll
                for (int kx = 0; kx < 128; ++kx) { S[kx] = eg * (S[kx] - beta * sh[256 + kx] * ks) + beta * sh[256 + kx] * v; o += sh[384 + kx] * S[kx]; }
                scratch[(size_t)2 * SEGT * 64 + ((size_t)dir * SEGT + (R - b * SEGT)) * 128 + c] = o; }
            __syncthreads();
        }
    }
}
__global__ void probe_cmp(uchar* ws, unsigned* res, const float* scratch) {
    using namespace cf;
    const float* YR = (const float*)(ws + WS_YR); const float* YG = (const float*)(ws + WS_YG);
    for (int i = blockIdx.x * blockDim.x + threadIdx.x; i < SEGT * 64; i += gridDim.x * blockDim.x) { const int s = i >> 6, v = i & 63, b = 1, h = 3; const size_t row = (size_t)b * SEGT + s;
        const float r0 = scratch[(size_t)s * 64 + v], r1 = scratch[((size_t)SEGT + s) * 64 + v], g0 = YR[row * 512 + h * 64 + v], g1 = YR[((size_t)M + row) * 512 + h * 64 + v];
        fatomic_max(res + 1, (g0 + g1) - (r0 + r1)); fatomic_max(res + 17, r0 + r1);
        fatomic_max(res + 3, g0 - r0); fatomic_max(res + 19, r0);
        fatomic_max(res + 4, g1 - r1); fatomic_max(res + 20, r1);
        if (s < 64) { fatomic_max(res + 5, g0 - r0); fatomic_max(res + 21, r0); }
        if (s >= 64 && s < 128) { fatomic_max(res + 6, g0 - r0); fatomic_max(res + 22, r0); }
        if (s >= 256 && s < 320) { fatomic_max(res + 7, g0 - r0); fatomic_max(res + 23, r0); }
    }
    for (int i = blockIdx.x * blockDim.x + threadIdx.x; i < SEGT * 128; i += gridDim.x * blockDim.x) { const int s = i >> 7, v = i & 127, b = 2, h = 1; const size_t row = (size_t)b * SEGT + s;
        const float* sg = scratch + (size_t)2 * SEGT * 64;
        const float ref = sg[(size_t)s * 128 + v] + sg[((size_t)SEGT + s) * 128 + v], got = YG[row * 512 + h * 128 + v] + YG[((size_t)M + row) * 512 + h * 128 + v];
        fatomic_max(res + 2, got - ref); fatomic_max(res + 18, ref); }
}
__global__ void probe_out(float* out, const unsigned* res, int selA, int selB) {
    if (blockIdx.x == 0 && threadIdx.x == 0) {
        out[0] = 1.0e5f * __builtin_bit_cast(float, res[selA]) / __builtin_bit_cast(float, res[16 + selA]);
        out[1] = 1.0e5f * __builtin_bit_cast(float, res[selB]) / __builtin_bit_cast(float, res[16 + selB]); }
}
#endif
constexpr int NWAVES = 8, NPH = 3 + 9 * cf::DEPTH;
struct Args { In in; float* out; uchar* ws; int g_lo, g_hi; };
static_assert(sizeof(Args) == 34 * 8 + 8 + 8 + 8, "Args has no padding");

__global__ void __launch_bounds__(NWAVES * 64, 2) fwd(Args args) {
    using namespace cf;
    extern __shared__ __attribute__((aligned(16))) unsigned char lds_raw[];
    LAS uchar* lds = (LAS uchar*)lds_raw;
    const int bx = blockIdx.x, G = gridDim.x, wv = __builtin_amdgcn_readfirstlane(threadIdx.x >> 6);
    auto lane_now = [&]() { unsigned ones = ~0u; asm volatile("" : "+s"(ones)); return (int)__builtin_amdgcn_mbcnt_hi(ones, __builtin_amdgcn_mbcnt_lo(ones, 0u)); };
#define TID() (wv * 64 + lane_now())
    const In& in = args.in;
    volatile LAS unsigned* MISC = (volatile LAS unsigned*)(lds + MISC_OFF);
    { const int tid = threadIdx.x; if (tid < 32) MISC[tid] = 0u; }
    __syncthreads();
    const int g_lo = args.g_lo, g_hi = args.g_hi;
    unsigned* barw = (unsigned*)(args.ws + WS_CTL) + CW_BAR;
    if (g_hi - g_lo > 1) (void)xcd_barrier_post(barw, MISC + 8);
#ifndef PH_MASK
#define PH_MASK 0xfff
#endif
#define PHK(g) ((g) < 3 ? (g) : 3 + ((g) - 3) % 9)
#ifndef DUP_PHASE
#define DUP_PHASE -1
#endif
#define NREP(k) ((DUP_PHASE == (k)) ? 2 : 1)
#define OPQ(v) asm volatile("" : "+v"(v))
#define IN(g) (((PH_MASK >> PHK(g)) & 1) && args.g_lo <= (g) && (g) < args.g_hi)
#ifdef TIMING
#define STAMP(i) do { if (blockIdx.x == 0 && TID() == 0) ((unsigned long long*)(args.ws + 16384))[i] = __builtin_amdgcn_s_memrealtime(); } while (0)
#else
#define STAMP(i) do {} while (0)
#endif
#define SEAM(g) do { if (args.g_lo <= (g) && (g) + 1 < args.g_hi) { XcdBarrier bar_; bar_.bar = (unsigned*)(args.ws + WS_CTL) + CW_BAR; bar_.x = xb_xcc_id(); bar_.st = (volatile LAS unsigned*)(lds + MISC_OFF) + 8; xcd_barrier(bar_); } STAMP((g) + 1); } while (0)

#define OPQS(v) asm volatile("" : "+s"(v))
#define LOCALS int l = lq; OPQS(l); size_t zq_ = 0; OPQS(zq_); uchar* ws = args.ws + zq_; float* X = (float*)(ws + WS_X); bf16* XM = (bf16*)(ws + WS_XM); bf16* P = (bf16*)(ws + WS_P); \
    bf16* CQN = (bf16*)(ws + WS_CQN); bf16* CKVN = (bf16*)(ws + WS_CKVN); bf16* Qb = (bf16*)(ws + WS_Q); bf16* Kb = (bf16*)(ws + WS_K); bf16* Vb = (bf16*)(ws + WS_V); \
    bf16* HFF = (bf16*)(ws + WS_HFF); float* YR = (float*)(ws + WS_YR); float* YG = (float*)(ws + WS_YG); float* GATE = (float*)(ws + WS_GATE); float* BONUS = (float*)(ws + WS_BONUS); \
    const float* MODV = (const float*)(ws + WS_MODV); const float* ROPE = (const float*)(ws + WS_ROPE); const float* modl = MODV + (size_t)l * 5 * MODS; \
    (void)X; (void)XM; (void)P; (void)CQN; (void)CKVN; (void)Qb; (void)Kb; (void)Vb; (void)HFF; (void)YR; (void)YG; (void)GATE; (void)BONUS; (void)ROPE; (void)modl; int t_ = TID(); OPQ(t_);

    STAMP(0);
    if (IN(0)) { const int lq = 0; LOCALS; phase_prologue(in, ws, lds, G, bx, t_); }
#ifdef DUP_PRO
    { XcdBarrier bar_; bar_.bar = (unsigned*)(args.ws + WS_CTL) + CW_BAR; bar_.x = xb_xcc_id(); bar_.st = (volatile LAS unsigned*)(lds + MISC_OFF) + 8; xcd_barrier(bar_); }
    if (IN(0)) { const int lq = 0; LOCALS; phase_prologue(in, ws, lds, G, bx, t_); }
#endif
    SEAM(0);
#ifdef DUP_BAR
    for (int nb_ = 0; nb_ < DUP_BAR; ++nb_) { XcdBarrier bar_; bar_.bar = (unsigned*)(args.ws + WS_CTL) + CW_BAR; bar_.x = xb_xcc_id(); bar_.st = (volatile LAS unsigned*)(lds + MISC_OFF) + 8; xcd_barrier(bar_); }
#endif
    if (IN(1)) { const int lq = 0; LOCALS; phase_modreduce(in, ws, G, bx, t_); }
    SEAM(1);
    if (IN(2)) { const int lq = 0; LOCALS; phase_modulate(X, XM, MODV, 0, D, G, bx, t_); }
    SEAM(2);

#pragma unroll 1
    for (int lq = 0; lq < DEPTH; ++lq) {
        const int g0 = 3 + 9 * lq;
        if (IN(g0 + 0)) for (int rep_ = 0; rep_ < NREP(0); ++rep_) { if (rep_) { XcdBarrier bar_; bar_.bar = (unsigned*)(args.ws + WS_CTL) + CW_BAR; bar_.x = xb_xcc_id(); bar_.st = (volatile LAS unsigned*)(lds + MISC_OFF) + 8; xcd_barrier(bar_); } LOCALS;
            pg8::Gemm g{XM, (const bf16*)(ws + WS_WIN) + (size_t)l * PC * D, M, PC, D, D}; pg8::StaticOrder S; S.init(M, PC, G, bx);
            pg8::EpiStore E{P, PC};
            pg8::gemm_phase<pg8::EpiStore, pg8::StaticOrder, true, true>(lds, g, S, E, t_);
        }
        SEAM(g0 + 0);
        if (IN(g0 + 1)) for (int rep_ = 0; rep_ < NREP(1); ++rep_) { if (rep_) { XcdBarrier bar_; bar_.bar = (unsigned*)(args.ws + WS_CTL) + CW_BAR; bar_.x = xb_xcc_id(); bar_.st = (volatile LAS unsigned*)(lds + MISC_OFF) + 8; xcd_barrier(bar_); } LOCALS;
#ifndef NO_MLAPREP
            mla_prep_rows(P, CQN, CKVN, Kb, in.p[7] + l * 512, in.p[8] + l * 512, ROPE, G, bx, t_);
#endif
            ScanW sw; sw.mu = in.p[11] + l * RW_COLS; sw.w0 = in.p[12] + l * 1024; sw.a0 = in.p[14] + l * 1024; sw.k_k = in.p[17] + l * 512; sw.k_a = in.p[18] + l * 512; sw.r_k = in.p[19] + l * 512;
            sw.W2T = (const bf16*)(ws + WS_W2T) + (size_t)l * 2 * 512 * 32; sw.A2T = (const bf16*)(ws + WS_A2T) + (size_t)l * 2 * 512 * 32; sw.G2T = (const bf16*)(ws + WS_G2T) + (size_t)l * 512 * 96;
            sw.conv = in.p[22] + l * 5 * 1536; sw.a_log = in.p[23] + l * 8; sw.dt_bias = in.p[24] + l * 8;
            {
                const int combo = bx & 15, h = combo >> 1, dir = combo & 1, nbl = (G >> 4) > 0 ? (G >> 4) : 1;
                int j = bx >> 4; unsigned chk = 0u;
                { int tw = TID(); OPQ(tw); rw_stage_weights(lds, sw, h, dir, tw); }

#pragma unroll 1
                for (; j < 272; j += nbl) { int tt = TID(); OPQ(tt);
#ifndef NO_S1R
                    const int jr = 271 - j;
                    const int b = jr / NCH, ci = jr % NCH, jn = (j + nbl < 272) ? j + nbl : j, tk = ((b * 8 + h) * 2 + dir) * NCH + ci;
                    s1_rwkv(lds, P, sw, ws + WS_RWT + (size_t)tk * RW_TASK, GATE, BONUS + (size_t)dir * M * 8, b, h, dir, ci, tt, chk, (271 - jn) / NCH, (271 - jn) % NCH);
#ifdef DUP_S1R
                    OPQ(tt); s1_rwkv(lds, P, sw, ws + WS_RWT + (size_t)tk * RW_TASK, GATE, BONUS + (size_t)dir * M * 8, b, h, dir, ci, tt, chk, (271 - jn) / NCH, (271 - jn) % NCH);
#endif
#endif
                }
                if (chk == 0x9e3779b9u) ((unsigned*)(ws + WS_CTL))[32] = chk;
            }
            {
                const int combo = bx & 7, h = combo >> 1, dir = combo & 1, nbl = (G >> 3) > 0 ? (G >> 3) : 1;
                __syncthreads();
                { int tw = TID(); OPQ(tw); gd_stage_weights(lds, sw, h, tw); }
#pragma unroll 1
                for (int j = bx >> 3; j < 272; j += nbl) { int tt = TID(); OPQ(tt);
#ifndef NO_S1G
                    const int jr = 271 - j, b = jr / NCH, ci = jr % NCH, tg = ((b * 4 + h) * 2 + dir) * NCH + ci;
                    s1_gdn(lds, P, sw, ws + WS_GDT + (size_t)tg * GD_TASK, b, h, dir, ci, tt);
#ifdef DUP_S1G
                    OPQ(tt); s1_gdn(lds, P, sw, ws + WS_GDT + (size_t)tg * GD_TASK, b, h, dir, ci, tt);
#endif
#endif
                }
            }
        }
        SEAM(g0 + 1);
        if (IN(g0 + 2)) for (int rep_ = 0; rep_ < NREP(2); ++rep_) { if (rep_) { XcdBarrier bar_; bar_.bar = (unsigned*)(args.ws + WS_CTL) + CW_BAR; bar_.x = xb_xcc_id(); bar_.st = (volatile LAS unsigned*)(lds + MISC_OFF) + 8; xcd_barrier(bar_); } LOCALS;
            const bool split = G >= 256;
#pragma unroll 1
#ifdef DUP_S2
            for (int rs_ = 0; rs_ < 2; ++rs_)
#endif
            for (int s = bx; s < 128; s += (split ? 1 << 20 : G)) {
#ifndef NO_S2R
                if (s < 64) { const int b = s >> 4, h = (s >> 1) & 7, dir = s & 1;
                    s2n_scan<64, true>(lds, ws + WS_RWT + (size_t)(((b * 8 + h) * 2 + dir) * NCH) * RW_TASK, RW_TASK, 0, 8192, 16384, 24576, 32768, 2, 0,
                                      YR + (size_t)dir * M * 512, h * 64, b, dir, t_); }
#endif
#ifndef NO_S2G
                if (s >= 64) { const int g = s - 64, vs = g & 1, dir = (g >> 1) & 1, h = (g >> 2) & 3, b = g >> 4;
                    s2n_scan<128, false>(lds, ws + WS_GDT + (size_t)(((b * 4 + h) * 2 + dir) * NCH) * GD_TASK, GD_TASK, 0, 32768, 49152, 81920, 98304, 4, vs,
                                        YG + (size_t)dir * M * 512, h * 128 + vs * 64, b, dir, t_); }
#endif
                __syncthreads();
            }
            OPQ(t_);
#ifndef NO_UPGEMM
            if (!split || bx >= 128) { const int Gg = split ? G - 128 : G, cg = split ? bx - 128 : bx;
#ifdef DUP_UPG
                for (int rg_ = 0; rg_ < 2; ++rg_) {
#endif
                { pg8::Gemm g{CQN, (const bf16*)(ws + WS_WUQ) + (size_t)l * 1536 * 512, M, 1536, 512, 512}; pg8::StaticOrder S; S.init(M, 1536, Gg, cg);
                  pg8::EpiStore E{Qb, QP}; pg8::gemm_phase<pg8::EpiStore, pg8::StaticOrder, true, true>(lds, g, S, E, t_); }
                __syncthreads(); OPQ(t_);
                { pg8::Gemm g{CKVN, (const bf16*)(ws + WS_WUKV) + (size_t)l * 2048 * 512, M, 2048, 512, 512}; pg8::StaticOrder S; S.init(M, 2048, Gg, cg);
                  pg8::EpiKV E{Kb, Vb}; pg8::gemm_phase<pg8::EpiKV, pg8::StaticOrder, true, true>(lds, g, S, E, t_); }
#ifdef DUP_UPG
                __syncthreads(); OPQ(t_); }
#endif
            }
#endif
        }
        SEAM(g0 + 2);
        if (IN(g0 + 3)) for (int rep_ = 0; rep_ < NREP(3); ++rep_) { if (rep_) { XcdBarrier bar_; bar_.bar = (unsigned*)(args.ws + WS_CTL) + CW_BAR; bar_.x = xb_xcc_id(); bar_.st = (volatile LAS unsigned*)(lds + MISC_OFF) + 8; xcd_barrier(bar_); } LOCALS;
#ifndef NO_MIXROWS
            mix_rows(P, YR, YG, GATE, BONUS, XM, in.p[11] + l * RW_COLS, in.p[20] + l * 512, in.p[21] + l * 512, in.p[25] + l * 128, G, bx, t_);
#endif
#ifndef NO_ATTN
            const int nunits = 512 + (l < DEPTH - 1 ? 32 : 0);
#pragma unroll 1
            for (int u = bx; u < nunits; u += G) { int tt = TID(); OPQ(tt);
                if (u < 512) { const int x = u & 7, j = u >> 3, bh = x + 8 * (j >> 4), qb = j & 15, b = bh >> 3, h = bh & 7;
                    const size_t qrow = (size_t)b * SEGT + CTX + qb * 256, krow = (size_t)b * SEGT;
                    at::attn_unit(Qb + qrow * QP + h * 192, Kb + krow * KP + h * 192, Vb + krow * VP + h * 128, XM + qrow * D + h * 128, SEGT, ROPE, qb * 256, (LAS char*)lds, tt); }
                else { const int bh = u - 512, b = bh >> 3, h = bh & 7; const size_t qrow = (size_t)b * SEGT;
                    at::attn_unit(Qb + qrow * QP + h * 192, Kb + qrow * KP + h * 192, Vb + qrow * VP + h * 128, XM + qrow * D + h * 128, CTX, nullptr, 0, (LAS char*)lds, tt); }
            }
#endif
        }
        SEAM(g0 + 3);
        if (IN(g0 + 4)) for (int rep_ = 0; rep_ < NREP(4); ++rep_) { if (rep_) { XcdBarrier bar_; bar_.bar = (unsigned*)(args.ws + WS_CTL) + CW_BAR; bar_.x = xb_xcc_id(); bar_.st = (volatile LAS unsigned*)(lds + MISC_OFF) + 8; xcd_barrier(bar_); } LOCALS;
            { pg8::Gemm g{XM, (const bf16*)(ws + WS_WOUT) + (size_t)l * D * D, M, D, D, D}; pg8::LatOrder S; S.init(D, G, bx);
              float alpha_ = ALPHA; OPQ(alpha_); pg8::EpiRes E{X, modl + 2 * D, MODS, alpha_};
              pg8::gemm_phase<pg8::EpiRes, pg8::LatOrder, true, true>(lds, g, S, E, t_);
#ifdef DUP_E
              __syncthreads(); OPQ(t_); { pg8::EpiStore E2{(bf16*)(ws + WS_HFF), D}; pg8::gemm_phase<pg8::EpiStore, pg8::LatOrder, true, true>(lds, g, S, E2, t_); }
#endif
            }
            if (l < DEPTH - 1) { __syncthreads(); OPQ(t_);
              pg8::Gemm g{XM, (const bf16*)(ws + WS_WOUT) + (size_t)l * D * D, M, D, D / 8, D}; pg8::CtxSplitOrder S; S.init(D, 8, D / 8, G, bx);
              pg8::EpiPart E{(float*)(ws + WS_PART)};
              pg8::gemm_phase<pg8::EpiPart, pg8::CtxSplitOrder, true, true>(lds, g, S, E, t_); }
        }
        SEAM(g0 + 4);
        if (IN(g0 + 5)) for (int rep_ = 0; rep_ < NREP(5); ++rep_) { if (rep_) { XcdBarrier bar_; bar_.bar = (unsigned*)(args.ws + WS_CTL) + CW_BAR; bar_.x = xb_xcc_id(); bar_.st = (volatile LAS unsigned*)(lds + MISC_OFF) + 8; xcd_barrier(bar_); } LOCALS; phase_ln(X, in.p[27] + l * D, in.p[28] + l * D, XM, modl, 3 * D, 4 * D, nullptr, (l < DEPTH - 1) ? (const float*)(ws + WS_PART) : nullptr, 8, modl + 4 * MODS + 2 * D, l == DEPTH - 1, G, bx, t_);
#ifdef DUP_LN
            { XcdBarrier bar_; bar_.bar = (unsigned*)(args.ws + WS_CTL) + CW_BAR; bar_.x = xb_xcc_id(); bar_.st = (volatile LAS unsigned*)(lds + MISC_OFF) + 8; xcd_barrier(bar_); }
            OPQ(t_); phase_ln(X, in.p[27] + l * D, in.p[28] + l * D, XM, modl, 3 * D, 4 * D, (float*)(ws + WS_Q), nullptr, 0, nullptr, true, G, bx, t_);
#endif
        }
        SEAM(g0 + 5);
        if (IN(g0 + 6)) for (int rep_ = 0; rep_ < NREP(6); ++rep_) { if (rep_) { XcdBarrier bar_; bar_.bar = (unsigned*)(args.ws + WS_CTL) + CW_BAR; bar_.x = xb_xcc_id(); bar_.st = (volatile LAS unsigned*)(lds + MISC_OFF) + 8; xcd_barrier(bar_); } LOCALS;
            pg8::Gemm g{XM, (const bf16*)(ws + WS_WGU) + (size_t)l * 2 * DFF * D, M, 2 * DFF, D, D}; pg8::EpiSwiGLU E{HFF, DFF};
            if (l < DEPTH - 1) { pg8::StaticOrder S; S.init(M, 2 * DFF, G, bx); pg8::gemm_phase<pg8::EpiSwiGLU, pg8::StaticOrder, true, true>(lds, g, S, E, t_); }
            else { pg8::LatOrder S; S.init(2 * DFF, G, bx); pg8::gemm_phase<pg8::EpiSwiGLU, pg8::LatOrder, true, true>(lds, g, S, E, t_); }
        }
        SEAM(g0 + 6);
        if (IN(g0 + 7)) for (int rep_ = 0; rep_ < NREP(7); ++rep_) { if (rep_) { XcdBarrier bar_; bar_.bar = (unsigned*)(args.ws + WS_CTL) + CW_BAR; bar_.x = xb_xcc_id(); bar_.st = (volatile LAS unsigned*)(lds + MISC_OFF) + 8; xcd_barrier(bar_); } LOCALS;
            { pg8::Gemm g{HFF, (const bf16*)(ws + WS_WDN) + (size_t)l * D * DFF, M, D, DFF, DFF}; pg8::LatOrder S; S.init(D, G, bx);
              float alpha_ = ALPHA; OPQ(alpha_); pg8::EpiRes E{X, modl + 5 * D, MODS, alpha_};
              pg8::gemm_phase<pg8::EpiRes, pg8::LatOrder, true, true>(lds, g, S, E, t_);
#ifdef DUP_H
              __syncthreads(); OPQ(t_); { pg8::EpiStore E2{(bf16*)(ws + WS_Q), D}; pg8::gemm_phase<pg8::EpiStore, pg8::LatOrder, true, true>(lds, g, S, E2, t_); }
#endif
            }
            if (l < DEPTH - 1) { __syncthreads(); OPQ(t_);
              pg8::Gemm g{HFF, (const bf16*)(ws + WS_WDN) + (size_t)l * D * DFF, M, D, DFF / 4, DFF}; pg8::CtxSplitOrder S; S.init(D, 4, DFF / 4, G, bx);
              pg8::EpiPart E{(float*)(ws + WS_PART)};
              pg8::gemm_phase<pg8::EpiPart, pg8::CtxSplitOrder, true, true>(lds, g, S, E, t_); }
        }
        SEAM(g0 + 7);
        if (IN(g0 + 8)) for (int rep_ = 0; rep_ < NREP(8); ++rep_) { if (rep_) { XcdBarrier bar_; bar_.bar = (unsigned*)(args.ws + WS_CTL) + CW_BAR; bar_.x = xb_xcc_id(); bar_.st = (volatile LAS unsigned*)(lds + MISC_OFF) + 8; xcd_barrier(bar_); } LOCALS;
            if (l < DEPTH - 1) phase_ln(X, in.p[32] + l * D, in.p[33] + l * D, XM, modl + 5 * MODS, 0, D, nullptr, (const float*)(ws + WS_PART), 4, modl + 4 * MODS + 5 * D, false, G, bx, t_);
            else phase_ln(X, in.p[32] + l * D, in.p[33] + l * D, XM, modl, 0, D, args.out, nullptr, 0, nullptr, true, G, bx, t_);
        }
        SEAM(g0 + 8);
    }
#ifdef TIMING
    __syncthreads();
    if (blockIdx.x == 0 && TID() == 0) { const unsigned long long* st = (const unsigned long long*)(args.ws + 16384); unsigned long long tot = 0;
        for (int g = 0; g < NPH; ++g) { const int cls = g < 3 ? 0 : 1 + (g - 3) % 9; if ((TIMING >> cls) & 1) tot += st[g + 1] - st[g]; }
        args.out[0] = (float)tot * 0.01f; }
#endif
#undef IN
#undef SEAM
}


#if defined(DBG_STOP)
__global__ void dbg_dump(float* out, const unsigned char* ws, int kind, size_t off, int pitch, size_t stride) {
    const size_t n = (size_t)cf::NB * cf::SEQ * cf::D;
    for (size_t i = (size_t)blockIdx.x * blockDim.x + threadIdx.x; i < n; i += (size_t)gridDim.x * blockDim.x) {
        const size_t rr = i / cf::D, c = i % cf::D, b = rr / cf::SEQ, t = rr % cf::SEQ, row = b * cf::SEGT + cf::CTX + t;
        float v;
        if (kind == 0) v = ((const float*)(ws + WS_X))[row * cf::D + c];
        else if (kind == 1) v = bf2f(((const bf16*)(ws + off))[row * (size_t)pitch + c]);
        else if (kind == 3) v = ((const float*)(ws + off))[(i * stride)];
        else if (kind == 4) v = ((const float*)(ws + off))[i % ((size_t)pitch * 1024)];
        else v = bf2f(((const bf16*)(ws + off))[i * stride]);
        if (!(fabsf(v) < 3.0e38f)) v = 1.0e30f;
        out[i] = v;
    }
}
#endif
#ifndef MK_MULTI
#define MK_MULTI 0
#endif
extern "C" void kernel_launch(void* const* d_in, const int* in_sizes, int n_in, void* d_out, int out_size, void* d_ws, size_t ws_size, hipStream_t stream) {
    static int grid = 0;
    if (grid == 0) {
        if (n_in != 34 || out_size != cf::NB * cf::SEQ * cf::D || ws_size < WS_END) { fprintf(stderr, "kernel_launch: shape mismatch (n_in %d out %d ws %zu)\n", n_in, out_size, ws_size); grid = -1; return; }
        int dev = 0, cus = 0;
        if (hipGetDevice(&dev) != hipSuccess || hipDeviceGetAttribute(&cus, hipDeviceAttributeMultiprocessorCount, dev) != hipSuccess) { grid = -1; return; }
        if (hipFuncSetAttribute((const void*)fwd, hipFuncAttributeMaxDynamicSharedMemorySize, LDS_BYTES) != hipSuccess) { fprintf(stderr, "kernel_launch: hipFuncSetAttribute failed\n"); grid = -1; return; }
        int per_cu = 0;
        if (hipOccupancyMaxActiveBlocksPerMultiprocessor(&per_cu, (const void*)fwd, NWAVES * 64, LDS_BYTES) != hipSuccess || per_cu < 1) fprintf(stderr, "kernel_launch: occupancy query says %d\n", per_cu);
        (void)hipGetLastError();
        grid = cus;
    }
    if (grid < 0) return;
    (void)hipMemsetAsync((char*)d_ws, 0, ZERO_BYTES, stream);
    Args a{};
    for (int i = 0; i < 34; ++i) a.in.p[i] = (const float*)d_in[i];
    a.out = (float*)d_out; a.ws = (uchar*)d_ws;
#if defined(PROBE)
    for (int g = 0; g < 7; ++g) { a.g_lo = g; a.g_hi = g + 1; hipLaunchKernelGGL(fwd, dim3(grid), dim3(NWAVES * 64), LDS_BYTES, stream, a); }
    { unsigned* res = (unsigned*)d_ws + 64; float* scratch = (float*)((char*)d_ws + WS_HFF + (400ull << 20));
      scratch = (float*)((char*)d_ws + WS_END);
      hipLaunchKernelGGL(probe, dim3(12), dim3(256), 0, stream, a.in, (uchar*)d_ws, res, scratch);
      hipLaunchKernelGGL(probe_cmp, dim3(256), dim3(256), 0, stream, (uchar*)d_ws, res, (const float*)scratch);
      for (int g = 7; g < NPH; ++g) { a.g_lo = g; a.g_hi = g + 1; hipLaunchKernelGGL(fwd, dim3(grid), dim3(NWAVES * 64), LDS_BYTES, stream, a); }
      hipLaunchKernelGGL(probe_out, dim3(1), dim3(64), 0, stream, (float*)d_out, (const unsigned*)res, PROBE_SELA, PROBE_SELB); }
#elif defined(DBG_STOP)
    for (int g = 0; g < DBG_STOP; ++g) { a.g_lo = g; a.g_hi = g + 1; hipLaunchKernelGGL(fwd, dim3(grid), dim3(NWAVES * 64), LDS_BYTES, stream, a); }
    hipLaunchKernelGGL(dbg_dump, dim3(2048), dim3(256), 0, stream, (float*)d_out, (const unsigned char*)d_ws, DBG_KIND, (size_t)DBG_OFF, DBG_PITCH, (size_t)DBG_STRIDE);
#elif MK_MULTI
    for (int g = 0; g < NPH; ++g) { a.g_lo = g; a.g_hi = g + 1; hipLaunchKernelGGL(fwd, dim3(grid), dim3(NWAVES * 64), LDS_BYTES, stream, a); }
#else
    a.g_lo = 0; a.g_hi = NPH;
    hipLaunchKernelGGL(fwd, dim3(grid), dim3(NWAVES * 64), LDS_BYTES, stream, a);
#endif
    const hipError_t le = hipPeekAtLastError();
    if (le != hipSuccess) fprintf(stderr, "kernel_launch: launch failed: %s\n", hipGetErrorName(le));
}
```
